# Optimizing an MI355X kernel written in HIP

```python
import math
import jax
import jax.numpy as jnp
from jax import lax
import numpy as np

D_MODEL = 1024
BATCH = 16
SEQ = 4096
DEPTH = 1

RMS_EPS = 1e-5
HG_EXPAND = 128
HG_HEADS = D_MODEL // HG_EXPAND
HG_DK = HG_EXPAND
HG_DV = D_MODEL // HG_HEADS
HG_FDIM = HG_HEADS * HG_DK
HG_VW = HG_HEADS * HG_DV
HG_CHUNK = 64
SWA_HEADS = 16
SWA_KV_HEADS = 4
SWA_GROUP = SWA_HEADS // SWA_KV_HEADS
SWA_HEAD_DIM = 64
SWA_QW = SWA_HEADS * SWA_HEAD_DIM
SWA_KW = SWA_KV_HEADS * SWA_HEAD_DIM
SWA_WINDOW = 128
SWA_BLOCK = 128
T5_BUCKETS = 32
T5_MAX_EXACT = 16
T5_MAX_DIST = 128
MEM_LEN = 256
XA_HEADS = 4
XA_HEAD_DIM = D_MODEL // XA_HEADS
N_EXPERTS = 32
TOP_K = 4
D_FF = D_MODEL
SWIGLU_ALPHA = 1.702
SWIGLU_LIMIT = 7.0
MOE_BLOCK = 128
IN_WIDTHS = (HG_FDIM, HG_FDIM, HG_VW, HG_VW, SWA_QW, SWA_KW, SWA_KW, D_MODEL, D_MODEL)
IN_COLS = sum(IN_WIDTHS)

kernel_name = 'hybrid_hgrn2_swa_sink_moe_block'


def rms_norm(x, gain):
    xf = x.astype(jnp.float32)
    y = xf * lax.rsqrt(jnp.mean(xf * xf, axis=-1, keepdims=True) + RMS_EPS)
    return (y * gain.astype(jnp.float32)).astype(x.dtype)


def split_points():
    pts, acc = [], 0
    for w in IN_WIDTHS[:-1]:
        acc += w
        pts.append(acc)
    return pts


def hgrn2_mixer(q, f_logit, i, g, lb, norm_gain):
    B, S, _ = q.shape
    nc = S // HG_CHUNK
    f32 = jnp.float32
    ff = f_logit.astype(f32)
    lbf = lb.astype(f32)
    log_f = jnp.logaddexp(jnp.log(lbf), jnp.log1p(-lbf) + jax.nn.log_sigmoid(ff))
    k = (1.0 - lbf) * jax.nn.sigmoid(-ff)
    qf = jax.nn.silu(q.astype(f32))

    def to_chunks(t, d):
        return t.reshape(B, nc, HG_CHUNK, HG_HEADS, d).transpose(1, 0, 3, 2, 4)

    xs = (to_chunks(qf, HG_DK), to_chunks(k, HG_DK), to_chunks(i.astype(f32), HG_DV), to_chunks(log_f, HG_DK))
    causal = jnp.tril(jnp.ones((HG_CHUNK, HG_CHUNK), dtype=bool))

    def step(state, inp):
        qb, kb, vb, gb = inp
        G = jnp.cumsum(gb, axis=2)
        o_inter = jnp.einsum('bhtk,bhkv->bhtv', qb * jnp.exp(G), state)
        diff = G[:, :, :, None, :] - G[:, :, None, :, :]
        decay = jnp.exp(jnp.where(causal[:, :, None], diff, -jnp.inf))
        attn = jnp.einsum('bhtk,bhsk,bhtsk->bhts', qb, kb, decay)
        o_intra = jnp.einsum('bhts,bhsv->bhtv', attn, vb)
        G_last = G[:, :, -1:, :]
        k_dec = kb * jnp.exp(G_last - G)
        new_state = jnp.exp(G_last[:, :, 0, :])[..., None] * state + jnp.einsum('bhsk,bhsv->bhkv', k_dec, vb)
        return new_state, o_inter + o_intra

    state0 = jnp.zeros((B, HG_HEADS, HG_DK, HG_DV), f32)
    _, o = lax.scan(step, state0, xs)
    o = o.transpose(1, 0, 3, 2, 4).reshape(B, S, HG_HEADS, HG_DV)
    o = rms_norm(o, norm_gain) * jax.nn.silu(g.astype(f32).reshape(B, S, HG_HEADS, HG_DV))
    return o.reshape(B, S, HG_VW).astype(i.dtype)


def t5_bucket(dist):
    n = jnp.maximum(dist, 0)
    nf = jnp.maximum(n, 1).astype(jnp.float32)
    large = T5_MAX_EXACT + (jnp.log(nf / T5_MAX_EXACT) / math.log(T5_MAX_DIST / T5_MAX_EXACT)
                            * (T5_BUCKETS - T5_MAX_EXACT)).astype(jnp.int32)
    large = jnp.minimum(large, T5_BUCKETS - 1)
    return jnp.where(n < T5_MAX_EXACT, n, large)


def swa_mixer(q, k, v, sinks, t5_table):
    B, S, _ = q.shape
    nb = S // SWA_BLOCK
    qb = q.reshape(B, nb, SWA_BLOCK, SWA_KV_HEADS, SWA_GROUP, SWA_HEAD_DIM)
    kr = k.reshape(B, nb, SWA_BLOCK, SWA_KV_HEADS, SWA_HEAD_DIM)
    vr = v.reshape(B, nb, SWA_BLOCK, SWA_KV_HEADS, SWA_HEAD_DIM)

    def with_prev(t):
        prev = jnp.pad(t[:, :-1], ((0, 0), (1, 0), (0, 0), (0, 0), (0, 0)))
        return jnp.concatenate([prev, t], axis=2)

    kb, vb = with_prev(kr), with_prev(vr)
    t_loc = jnp.arange(SWA_BLOCK, dtype=jnp.int32)[:, None]
    s_loc = jnp.arange(2 * SWA_BLOCK, dtype=jnp.int32)[None, :]
    dist = t_loc + SWA_BLOCK - s_loc
    in_band = (dist >= 0) & (dist < SWA_WINDOW)
    key_exists = (jnp.arange(nb)[:, None] > 0) | (s_loc >= SWA_BLOCK)
    mask = in_band[None] & key_exists[:, None, :]
    bias = t5_table.astype(jnp.float32)[t5_bucket(dist)]
    bias = bias.transpose(2, 0, 1).reshape(SWA_KV_HEADS, SWA_GROUP, 1, SWA_BLOCK, 2 * SWA_BLOCK)
    scores = jnp.einsum('bnqhgd,bnkhd->bhgnqk', qb, kb).astype(jnp.float32) * (SWA_HEAD_DIM ** -0.5) + bias
    scores = jnp.where(mask, scores, -jnp.inf)
    sink = jnp.broadcast_to(sinks.astype(jnp.float32).reshape(SWA_KV_HEADS, SWA_GROUP, 1, 1, 1),
                            scores.shape[:-1] + (1,))
    probs = jax.nn.softmax(jnp.concatenate([scores, sink], axis=-1), axis=-1)[..., :-1]
    out = jnp.einsum('bhgnqk,bnkhd->bnqhgd', probs.astype(v.dtype), vb)
    return out.reshape(B, S, SWA_QW)


def memory_cross_attention(h, mem, w_q, w_k, w_v, w_o):
    B, S, _ = h.shape
    M = mem.shape[1]
    q = (h @ w_q).reshape(B, S, XA_HEADS, XA_HEAD_DIM)
    k = (mem @ w_k).reshape(B, M, XA_HEADS, XA_HEAD_DIM)
    v = (mem @ w_v).reshape(B, M, XA_HEADS, XA_HEAD_DIM)
    s = jnp.einsum('bqhd,bkhd->bhqk', q, k).astype(jnp.float32) * (XA_HEAD_DIM ** -0.5)
    p = jax.nn.softmax(s, axis=-1).astype(h.dtype)
    o = jnp.einsum('bhqk,bkhd->bqhd', p, v).reshape(B, S, XA_HEADS * XA_HEAD_DIM)
    return o @ w_o


def moe_ffn(h, w_router, b_router, w_gate_up, b_gate_up, w_down, b_down):
    B, S, D = h.shape
    xt = h.reshape(-1, D)
    n = xt.shape[0]
    logits = (xt @ w_router + b_router).astype(jnp.float32)
    top_val, top_idx = lax.top_k(logits, TOP_K)
    gates = jax.nn.softmax(top_val, axis=-1)
    n_assign = n * TOP_K
    e_flat = top_idx.reshape(-1).astype(jnp.int32)
    tok_flat = jnp.repeat(jnp.arange(n, dtype=jnp.int32), TOP_K)
    g_flat = gates.reshape(-1)
    order = jnp.argsort(e_flat)
    e_sorted = e_flat[order]
    counts = jnp.zeros((N_EXPERTS,), jnp.int32).at[e_flat].add(1)
    starts = jnp.cumsum(counts) - counts
    padded = (counts + MOE_BLOCK - 1) // MOE_BLOCK * MOE_BLOCK
    pad_ends = jnp.cumsum(padded)
    pad_starts = pad_ends - padded
    rank = jnp.arange(n_assign, dtype=jnp.int32) - starts[e_sorted]
    dest = pad_starts[e_sorted] + rank
    cap = -(-n_assign // MOE_BLOCK) * MOE_BLOCK + N_EXPERTS * MOE_BLOCK
    n_blocks = cap // MOE_BLOCK
    tok_buf = jnp.zeros((cap,), jnp.int32).at[dest].set(tok_flat[order])
    gate_buf = jnp.zeros((cap,), jnp.float32).at[dest].set(g_flat[order])
    block_start = jnp.arange(n_blocks, dtype=jnp.int32) * MOE_BLOCK
    block_expert = jnp.minimum(jnp.searchsorted(pad_ends, block_start, side='right'), N_EXPERTS - 1)

    def expert_block(args):
        toks, gts, e = args
        xb = xt[toks]
        gu = xb @ w_gate_up[e] + b_gate_up[e]
        x_glu, x_lin = jnp.split(gu, 2, axis=-1)
        x_glu = jnp.minimum(x_glu, SWIGLU_LIMIT)
        x_lin = jnp.clip(x_lin, -SWIGLU_LIMIT, SWIGLU_LIMIT)
        act = x_glu * jax.nn.sigmoid(SWIGLU_ALPHA * x_glu) * (x_lin + 1.0)
        y = act @ w_down[e] + b_down[e]
        return (y.astype(jnp.float32) * gts[:, None])

    y_buf = lax.map(expert_block, (tok_buf.reshape(n_blocks, MOE_BLOCK),
                                   gate_buf.reshape(n_blocks, MOE_BLOCK), block_expert))
    out = jnp.zeros((n, D), jnp.float32).at[tok_buf].add(y_buf.reshape(cap, D))
    return out.astype(h.dtype).reshape(B, S, D)


def setup_inputs(seed: int = 0) -> dict:
    key = jax.random.key(seed)
    ks = jax.random.split(key, 26)
    L, D, E = DEPTH, D_MODEL, N_EXPERTS

    def nrm(k, shape, scale):
        return scale * jax.random.normal(k, shape, jnp.float32)

    return {
        'x': nrm(ks[0], (BATCH, SEQ, D), 1.0),
        'mem': nrm(ks[1], (BATCH, MEM_LEN, D), 1.0),
        't5_table': nrm(ks[2], (T5_BUCKETS, SWA_HEADS), 0.5),
        'lb_logits': nrm(ks[3], (DEPTH + 1, HG_FDIM), 0.5),
        'norm_mix': 1.0 + nrm(ks[4], (L, D), 0.1),
        'w_in': nrm(ks[5], (L, D, IN_COLS), D ** -0.5),
        'b_gates': nrm(ks[6], (L, 2, D), 0.1),
        'hg_norm_gain': 1.0 + nrm(ks[7], (L, HG_DV), 0.1),
        'swa_sinks': nrm(ks[8], (L, SWA_HEADS), 0.5),
        'w_branch_a': nrm(ks[9], (L, HG_VW, D), HG_VW ** -0.5),
        'w_branch_b': nrm(ks[10], (L, SWA_QW, D), SWA_QW ** -0.5),
        'w_mix_out': nrm(ks[11], (L, D, D), D ** -0.5),
        'norm_xa': 1.0 + nrm(ks[12], (L, D), 0.1),
        'xa_w_q': nrm(ks[13], (L, D, XA_HEADS * XA_HEAD_DIM), D ** -0.5),
        'xa_w_k': nrm(ks[14], (L, D, XA_HEADS * XA_HEAD_DIM), D ** -0.5),
        'xa_w_v': nrm(ks[15], (L, D, XA_HEADS * XA_HEAD_DIM), D ** -0.5),
        'xa_w_o': nrm(ks[16], (L, XA_HEADS * XA_HEAD_DIM, D), (XA_HEADS * XA_HEAD_DIM) ** -0.5),
        'norm_ffn': 1.0 + nrm(ks[17], (L, D), 0.1),
        'w_router': nrm(ks[18], (L, D, E), D ** -0.5),
        'b_router': nrm(ks[19], (L, E), 0.01),
        'w_gate_up': nrm(ks[20], (L, E, D, 2 * D_FF), D ** -0.5),
        'b_gate_up': nrm(ks[21], (L, E, 2 * D_FF), 0.02),
        'w_down': nrm(ks[22], (L, E, D_FF, D), D_FF ** -0.5),
        'b_down': nrm(ks[23], (L, E, D), 0.02),
        'norm_final': 1.0 + nrm(ks[24], (D,), 0.1),
    }


def reference(x, mem, t5_table, lb_logits, norm_mix, w_in, b_gates, hg_norm_gain, swa_sinks,
              w_branch_a, w_branch_b, w_mix_out, norm_xa, xa_w_q, xa_w_k, xa_w_v, xa_w_o,
              norm_ffn, w_router, b_router, w_gate_up, b_gate_up, w_down, b_down, norm_final):
    lower_bounds = jnp.cumsum(jax.nn.softmax(lb_logits.astype(jnp.float32), axis=0), axis=0)
    pts = split_points()
    for l in range(DEPTH):
        h = rms_norm(x, norm_mix[l])
        proj = h @ w_in[l]
        hq, hf, hi, hg, sq, sk, sv, ga, gb = jnp.split(proj, pts, axis=-1)
        o_a = hgrn2_mixer(hq, hf, hi, hg, lower_bounds[l], hg_norm_gain[l])
        o_b = swa_mixer(sq, sk, sv, swa_sinks[l], t5_table)
        gate_a = jax.nn.sigmoid(ga + b_gates[l, 0])
        gate_b = jax.nn.sigmoid(gb + b_gates[l, 1])
        merged = gate_a * (o_a @ w_branch_a[l]) + gate_b * (o_b @ w_branch_b[l])
        x = x + merged @ w_mix_out[l]
        x = x + memory_cross_attention(rms_norm(x, norm_xa[l]), mem,
                                       xa_w_q[l], xa_w_k[l], xa_w_v[l], xa_w_o[l])
        x = x + moe_ffn(rms_norm(x, norm_ffn[l]), w_router[l], b_router[l],
                        w_gate_up[l], b_gate_up[l], w_down[l], b_down[l])
    return rms_norm(x, norm_final)
```

```cpp
#include <hip/hip_runtime.h>
#include <cstdio>
#include <cstdint>
namespace pg8 {
#define PG8_LAS __attribute__((address_space(3)))
typedef unsigned short bf16_t;
typedef short bf16x8 __attribute__((ext_vector_type(8)));
typedef float f32x4 __attribute__((ext_vector_type(4)));
typedef unsigned u32x4 __attribute__((ext_vector_type(4)));
constexpr int BM = 256, BK = 64, HALF = 128, HTB = HALF * BK * 2  , STAGE_BYTES = 8 * HTB, NXCD = 8, WGM = 8;

__host__ __device__ __forceinline__ int lds_byte(int r, int c) { const int st = (r >> 4) * 2 + (c >> 5), rr = r & 15, cc = c & 31, ob = rr * 64 + cc * 2; return st * 1024 + (ob ^ (((ob >> 9) & 1) << 5)); }
__host__ __device__ __forceinline__ void stage_rc(int b, int& R, int& C) { const int st = b / 1024, sb = b % 1024, swz = sb ^ (((sb >> 9) & 1) << 5); R = (st >> 1) * 16 + swz / 64; C = (st & 1) * 32 + (swz % 64) / 2; }
__host__ __device__ __forceinline__ int perm32(int rho) { const int n = rho >> 4, i = rho & 15; return 8 * (i >> 2) + 4 * n + (i & 3); }

struct Unit { int pm, pn; };
struct Gemm { const bf16_t* A; const bf16_t* Bt; int M, N, K; };

struct StaticOrder {
    int nM, nN, nwg, G, c;
    __host__ __device__ void init(int M, int N, int G_, int c_) { nM = M / BM; nN = N / BM; nwg = nM * nN; G = G_; c = c_; }
    __host__ __device__ bool next(int i, Unit& u) const {
        const long L = (long)i * G + c; if (L >= nwg) return false;
        int wgid = (int)L; { const int q = nwg / NXCD, r = nwg % NXCD, xcd = wgid % NXCD, off = wgid / NXCD; wgid = (xcd < r ? xcd * (q + 1) : r * (q + 1) + (xcd - r) * q) + off; }
        const int nig = WGM * nN, gid = wgid / nig, fm = gid * WGM, gsz = (nM - fm) < WGM ? (nM - fm) : WGM;
        u.pm = fm + ((wgid % nig) % gsz); u.pn = (wgid % nig) / gsz; return true;
    }
    __device__ __forceinline__ void a_ready(const Unit&) const {}
    __device__ __forceinline__ void done(const Unit&) const {}
};

__device__ __forceinline__ unsigned cvt_pk_bf16(float lo, float hi) { unsigned r; asm volatile("v_cvt_pk_bf16_f32 %0, %1, %2" : "=v"(r) : "v"(lo), "v"(hi)); return r; }
typedef float f32x2 __attribute__((ext_vector_type(2)));
template <class Epi, class Sched, bool ALIGN_EPI = false, bool SP2 = false>
__device__ __forceinline__ void gemm_phase(PG8_LAS unsigned char* lds, const Gemm g, const Sched& S, const Epi& E, const int wave_in) {
    int tid_ = (int)__builtin_amdgcn_mbcnt_hi(~0u, __builtin_amdgcn_mbcnt_lo(~0u, 0u)) + 64 * wave_in; asm volatile("" : "+v"(tid_));
    const int tid = tid_, wid = __builtin_amdgcn_readfirstlane(tid >> 6), lane = tid & 63, wr = wid >> 2, wc = wid & 3, fr = lane & 15, fq = lane >> 4;
    const int K = g.K, nt = K / BK;
    unsigned voffA[2], voffB[2];
#pragma unroll
    for (int i = 0; i < 2; ++i) { int R, C; stage_rc(tid * 16 + i * 8192, R, C); const int Rb = Epi::PERM ? ((R & ~31) + perm32(R & 31)) : R;
        voffA[i] = (unsigned)(R * K + C) * 2u; voffB[i] = (unsigned)(Rb * K + C) * 2u; }
    const size_t kstep = (size_t)(BK * 2);
    const size_t hstep = (size_t)HALF * K * 2;
    const size_t tstep = 2 * hstep;
    const unsigned ldsw = (unsigned)wid * 1024u;
    const int aoff = lds_byte(wr * 64 + fr, fq * 8), boff = lds_byte(wc * 32 + fr, fq * 8);
#define PG8_SA(b, h) (((b) * 2 + (h)) * HTB)
#define PG8_SB(b, h) ((4 + (b) * 2 + (h)) * HTB)
#define PG8_STAGE(bufoff, gbase, voff) do { _Pragma("unroll") for (int _i = 0; _i < 2; ++_i) \
        __builtin_amdgcn_global_load_lds((const unsigned*)((const char*)(gbase) + (voff)[_i]), (PG8_LAS unsigned*)(lds + (bufoff) + ldsw + _i * 8192), 16, 0, 0); } while (0)
#define PG8_LDA(dst, b, h) do { _Pragma("unroll") for (int m = 0; m < 4; ++m) _Pragma("unroll") for (int k = 0; k < 2; ++k) dst[m][k] = *(const PG8_LAS bf16x8*)(lds + PG8_SA(b, h) + aoff + m * 2048 + k * 1024); } while (0)
#define PG8_LDB(dst, b, h) do { _Pragma("unroll") for (int n = 0; n < 2; ++n) _Pragma("unroll") for (int k = 0; k < 2; ++k) dst[n][k] = *(const PG8_LAS bf16x8*)(lds + PG8_SB(b, h) + boff + n * 2048 + k * 1024); } while (0)
#define PG8_MMA(ai, bj, At, Bt) do { __builtin_amdgcn_s_setprio(1); _Pragma("unroll") for (int m = 0; m < 4; ++m) _Pragma("unroll") for (int n = 0; n < 2; ++n) _Pragma("unroll") for (int k = 0; k < 2; ++k) \
        acc[ai][bj][m][n] = __builtin_amdgcn_mfma_f32_16x16x32_bf16(Bt[n][k], At[m][k], acc[ai][bj][m][n], 0, 0, 0); __builtin_amdgcn_s_setprio(0); } while (0)
#define PG8_WAIT_V(n) asm volatile("s_waitcnt vmcnt(" #n ")" ::: "memory")
#define PG8_WAIT_L(n) asm volatile("s_waitcnt lgkmcnt(" #n ")" ::: "memory")
#define PG8_BAR __builtin_amdgcn_s_barrier()
#define PG8_SCHED __builtin_amdgcn_sched_barrier(0)
    Unit cur, nxt; int ui = 0;
    if (!S.next(0, cur)) return;
    f32x4 acc[2][2][4][2];
#pragma unroll
    for (int a = 0; a < 2; ++a)
#pragma unroll
        for (int b = 0; b < 2; ++b)
#pragma unroll
            for (int m = 0; m < 4; ++m)
#pragma unroll
                for (int n = 0; n < 2; ++n) acc[a][b][m][n] = (f32x4){0.f, 0.f, 0.f, 0.f};
    bf16x8 At[4][2], B0[2][2], B1[2][2];
    const char* cA = (const char*)g.A + (size_t)cur.pm * tstep; const char* cB = (const char*)g.Bt + (size_t)cur.pn * tstep;
    S.a_ready(cur);
    if constexpr (SP2) {
        PG8_STAGE(PG8_SB(0, 0), cB, voffB); PG8_STAGE(PG8_SB(0, 1), cB + hstep, voffB); PG8_STAGE(PG8_SA(0, 0), cA, voffA); PG8_STAGE(PG8_SA(0, 1), cA + hstep, voffA);
        if (wr == 1) PG8_BAR;
        PG8_WAIT_V(2); PG8_BAR;
        PG8_STAGE(PG8_SB(1, 0), cB + kstep, voffB); PG8_STAGE(PG8_SA(1, 0), cA + kstep, voffA); PG8_STAGE(PG8_SB(1, 1), cB + hstep + kstep, voffB);
        PG8_WAIT_V(6); PG8_BAR;
    } else {
        PG8_STAGE(PG8_SB(0, 0), cB, voffB); PG8_STAGE(PG8_SA(0, 0), cA, voffA); PG8_STAGE(PG8_SB(0, 1), cB + hstep, voffB); PG8_STAGE(PG8_SA(0, 1), cA + hstep, voffA);
        if (wr == 1) PG8_BAR;
        PG8_WAIT_V(4); PG8_BAR;
        PG8_STAGE(PG8_SB(1, 0), cB + kstep, voffB); PG8_STAGE(PG8_SA(1, 0), cA + kstep, voffA); PG8_STAGE(PG8_SB(1, 1), cB + hstep + kstep, voffB);
        PG8_WAIT_V(6); PG8_BAR;
    }
    for (;;) {
        const bool has_next = S.next(ui + 1, nxt);
        const char* nA = has_next ? (const char*)g.A + (size_t)nxt.pm * tstep : cA; const char* nB = has_next ? (const char*)g.Bt + (size_t)nxt.pn * tstep : cB;
        for (int t = 0; t < nt; t += 2) {
            const bool last = (t == nt - 2);
            const char* a1 = cA + (size_t)(t + 1) * kstep;
            const char* a2 = last ? nA : cA + (size_t)(t + 2) * kstep; const char* b2 = last ? nB : cB + (size_t)(t + 2) * kstep;
            const char* a3 = a2 + kstep; const char* b3 = b2 + kstep;
            if (last && has_next) S.a_ready(nxt);
            if constexpr (SP2) {
            PG8_LDB(B0, 0, 0); PG8_LDB(B1, 0, 1); PG8_SCHED; PG8_LDA(At, 0, 0); PG8_STAGE(PG8_SA(1, 1), a1 + hstep, voffA);
            PG8_WAIT_V(8); PG8_WAIT_L(0); PG8_BAR; PG8_MMA(0, 0, At, B0); PG8_MMA(0, 1, At, B1); PG8_BAR; PG8_SCHED;
            PG8_LDA(At, 0, 1); PG8_STAGE(PG8_SB(0, 0), b2, voffB); PG8_STAGE(PG8_SB(0, 1), b2 + hstep, voffB); PG8_STAGE(PG8_SA(0, 0), a2, voffA);
            PG8_WAIT_V(8); PG8_WAIT_L(0); PG8_BAR; PG8_MMA(1, 0, At, B0); PG8_MMA(1, 1, At, B1); PG8_BAR; PG8_SCHED;
            PG8_LDB(B0, 1, 0); PG8_LDB(B1, 1, 1); PG8_SCHED; PG8_LDA(At, 1, 0); PG8_STAGE(PG8_SA(0, 1), a2 + hstep, voffA);
            PG8_WAIT_V(8); PG8_WAIT_L(0); PG8_BAR; PG8_MMA(0, 0, At, B0); PG8_MMA(0, 1, At, B1); PG8_BAR; PG8_SCHED;
            PG8_LDA(At, 1, 1); PG8_STAGE(PG8_SB(1, 0), b3, voffB); PG8_STAGE(PG8_SB(1, 1), b3 + hstep, voffB); PG8_STAGE(PG8_SA(1, 0), a3, voffA);
            PG8_WAIT_V(8); PG8_WAIT_L(0); PG8_BAR; PG8_MMA(1, 0, At, B0); PG8_MMA(1, 1, At, B1); PG8_BAR; PG8_SCHED;
            } else {
            PG8_LDB(B0, 0, 0); PG8_SCHED; PG8_LDA(At, 0, 0); PG8_STAGE(PG8_SA(1, 1), a1 + hstep, voffA);
            PG8_WAIT_L(8); PG8_BAR; PG8_WAIT_L(0); PG8_MMA(0, 0, At, B0); PG8_BAR; PG8_SCHED;
            PG8_LDB(B1, 0, 1); PG8_STAGE(PG8_SB(0, 0), b2, voffB);
            PG8_BAR; PG8_WAIT_L(0); PG8_MMA(0, 1, At, B1); PG8_BAR;
            PG8_LDA(At, 0, 1); PG8_STAGE(PG8_SA(0, 0), a2, voffA);
            PG8_BAR; PG8_WAIT_L(0); PG8_MMA(1, 0, At, B0); PG8_BAR; PG8_SCHED;
            PG8_STAGE(PG8_SB(0, 1), b2 + hstep, voffB);
            PG8_WAIT_V(6); PG8_BAR; PG8_MMA(1, 1, At, B1); PG8_BAR;
            PG8_LDB(B0, 1, 0); PG8_SCHED; PG8_LDA(At, 1, 0); PG8_STAGE(PG8_SA(0, 1), a2 + hstep, voffA);
            PG8_WAIT_L(8); PG8_BAR; PG8_WAIT_L(0); PG8_MMA(0, 0, At, B0); PG8_BAR; PG8_SCHED;
            PG8_LDB(B1, 1, 1); PG8_STAGE(PG8_SB(1, 0), b3, voffB);
            PG8_BAR; PG8_WAIT_L(0); PG8_MMA(0, 1, At, B1); PG8_BAR;
            PG8_LDA(At, 1, 1); PG8_STAGE(PG8_SA(1, 0), a3, voffA);
            PG8_BAR; PG8_WAIT_L(0); PG8_MMA(1, 0, At, B0); PG8_BAR; PG8_SCHED;
            PG8_STAGE(PG8_SB(1, 1), b3 + hstep, voffB);
            PG8_WAIT_V(6); PG8_BAR; PG8_MMA(1, 1, At, B1); PG8_BAR;
            }
        }
        if constexpr (ALIGN_EPI) { if (wr == 0) PG8_BAR; }
        if constexpr (!Epi::AFTER_DRAIN) { E(acc, cur, wr, wc, fr, fq); S.done(cur); }
        if (!has_next) break;
#pragma unroll
        for (int a = 0; a < 2; ++a)
#pragma unroll
            for (int b = 0; b < 2; ++b)
#pragma unroll
                for (int m = 0; m < 4; ++m)
#pragma unroll
                    for (int n = 0; n < 2; ++n) acc[a][b][m][n] = (f32x4){0.f, 0.f, 0.f, 0.f};
        cur = nxt; cA = nA; cB = nB; ++ui;
        if constexpr (ALIGN_EPI) { if (wr == 1) PG8_BAR; }
    }
    PG8_WAIT_V(0);
    if constexpr (!ALIGN_EPI) { if (wr == 0) PG8_BAR; }
    PG8_BAR;
    if constexpr (Epi::AFTER_DRAIN) { E.fused(acc, cur, wr, wc, fr, fq, lds, wid, lane); S.done(cur); }
#undef PG8_SA
#undef PG8_SB
#undef PG8_STAGE
#undef PG8_LDA
#undef PG8_LDB
#undef PG8_MMA
#undef PG8_WAIT_V
#undef PG8_WAIT_L
#undef PG8_BAR
#undef PG8_SCHED
}
}

#ifndef PG8_SP2
#define PG8_SP2 true
#endif
#ifndef PG8_ALIGN
#define PG8_ALIGN true
#endif

constexpr int NTOK = 65536, DM = 1024, NCOL = 7680, SEQ = 4096, NBATCH = 16, HTOK = 32768, MEMLEN = 256;
constexpr int C_HQ = 0, C_HF = 1024, C_HI = 2048, C_HG = 3072, C_SQ = 4096, C_SK = 5120, C_SV = 5376, C_GA = 5632, C_GB = 6656;
constexpr int NEXP = 32, TOPK = 4, CAPH = HTOK * TOPK + NEXP * 256;
constexpr float RMS_EPS = 1e-5f;
constexpr size_t MiB = (size_t)1 << 20;
constexpr size_t WS_ZERO_BYTES = 2 * MiB;
constexpr size_t WS_GCNT = 1 * MiB;
constexpr int CW_TMO = 0, CW_BAR = 4096;
constexpr size_t WS_LB = 2 * MiB, WS_LUT = 2 * MiB + 4096, WS_BLKE = 2 * MiB + 16384, WS_NBT = 2 * MiB + 32768;
constexpr size_t WS_TOPE = 3 * MiB, WS_TOPG = 4 * MiB, WS_TOPR = 5 * MiB, WS_TOPP = 6 * MiB, WS_RGATE = 7 * MiB, WS_RRSTD = 8 * MiB, WS_D12 = 10 * MiB;
constexpr size_t WS_WIN = 16 * MiB, WS_WA = 31 * MiB, WS_WB = 33 * MiB, WS_WMIX = 35 * MiB, WS_WQ = 37 * MiB, WS_WK = 39 * MiB, WS_WV = 41 * MiB, WS_WO = 43 * MiB, WS_WR = 45 * MiB;
constexpr size_t WS_MEMBF = 46 * MiB, WS_KX = 54 * MiB, WS_VXT = 62 * MiB;
constexpr size_t WS_XBF = 72 * MiB;
constexpr size_t WS_PROJ = 200 * MiB, WS_OA = 680 * MiB, WS_OB = 744 * MiB, WS_TM = 808 * MiB;
constexpr size_t WS_Q = 664 * MiB;
constexpr size_t WS_WGU = 200 * MiB, WS_WD = 328 * MiB, WS_ACT = 392 * MiB, WS_Y = 664 * MiB, WS_SSQ1 = 936 * MiB, WS_SSQ2 = 940 * MiB, WS_END = 944 * MiB;
constexpr size_t OUT_US = 128 * MiB;

#define GAS __attribute__((address_space(1)))
#define LAS __attribute__((address_space(3)))
typedef unsigned short bf16;
typedef unsigned v4u __attribute__((ext_vector_type(4)));
typedef unsigned v2u __attribute__((ext_vector_type(2)));
typedef float f32x4 __attribute__((ext_vector_type(4)));
typedef short bf16x8 __attribute__((ext_vector_type(8)));
typedef short s16x4 __attribute__((ext_vector_type(4)));
#define RLX_AGENT __ATOMIC_RELAXED, __HIP_MEMORY_SCOPE_AGENT
#define LDS_WAIT() asm volatile("s_waitcnt lgkmcnt(0)" ::: "memory")
#define CFENCE() asm volatile("" ::: "memory")
__device__ __forceinline__ unsigned f2bf(float f) { unsigned u = __builtin_bit_cast(unsigned, f); return (u + 0x7fffu + ((u >> 16) & 1u)) >> 16; }
typedef float f32x2_t __attribute__((ext_vector_type(2))); typedef __bf16 bf16x2_t __attribute__((ext_vector_type(2)));
__device__ __forceinline__ unsigned pk2(float lo, float hi) { f32x2_t v = {lo, hi}; bf16x2_t b = __builtin_convertvector(v, bf16x2_t); return __builtin_bit_cast(unsigned, b); }
__device__ __forceinline__ float bflo(unsigned w) { return __builtin_bit_cast(float, w << 16); }
__device__ __forceinline__ float bfhi(unsigned w) { return __builtin_bit_cast(float, w & 0xffff0000u); }
__device__ __forceinline__ float sigm(float x) { return 1.f / (1.f + __expf(-x)); }
__device__ __forceinline__ float wave_sum(float v) {
#pragma unroll
    for (int o = 1; o < 64; o <<= 1) v += __shfl_xor(v, o);
    return v;
}
__device__ __forceinline__ f32x4 mfma16(bf16x8 a, bf16x8 b, f32x4 c) { return __builtin_amdgcn_mfma_f32_16x16x32_bf16(a, b, c, 0, 0, 0); }
__device__ __forceinline__ s16x4 vtr(const LAS unsigned char* p) { return __builtin_bit_cast(s16x4, __builtin_amdgcn_ds_read_tr16_b64_v4i16((LAS s16x4*)p)); }
__device__ __forceinline__ bf16x8 cat8(s16x4 lo, s16x4 hi) { return __builtin_shufflevector(lo, hi, 0, 1, 2, 3, 4, 5, 6, 7); }
__device__ __forceinline__ bf16x8 pack8(f32x4 a, f32x4 b) { v4u w; w.x = pk2(a[0], a[1]); w.y = pk2(a[2], a[3]); w.z = pk2(b[0], b[1]); w.w = pk2(b[2], b[3]); return __builtin_bit_cast(bf16x8, w); }
__device__ __forceinline__ float rstd16(const float* ssqp, size_t row) { const f32x4* p = (const f32x4*)(ssqp + row * 16); const f32x4 a = p[0], b = p[1], c = p[2], d = p[3];
    const float s = ((a[0] + a[1]) + (a[2] + a[3])) + ((b[0] + b[1]) + (b[2] + b[3])) + ((c[0] + c[1]) + (c[2] + c[3])) + ((d[0] + d[1]) + (d[2] + d[3])); return rsqrtf(s * (1.f / 1024.f) + 1e-5f); }
__device__ __forceinline__ unsigned ld_agent(const unsigned* p) { return __hip_atomic_load(p, RLX_AGENT); }


#define XB_TMO      128
#define XB_XCNT(j)  (256  + 64 * (j))
#define XB_XSUB(j)  (1280 + 64 * (j))
#define XB_XGEN(j)  (2304 + 64 * (j))
#define XB_TOP      3328
#define XB_TOPGEN   3392
#define XCD_BAR_WORDS 3456
#define XB_SPIN_CAP (1u << 18)

__device__ __forceinline__ unsigned xb_ld(unsigned* p)              { return __hip_atomic_load(p, __ATOMIC_RELAXED, __HIP_MEMORY_SCOPE_AGENT); }
__device__ __forceinline__ unsigned xb_add(unsigned* p, unsigned v) { return __hip_atomic_fetch_add(p, v, __ATOMIC_RELAXED, __HIP_MEMORY_SCOPE_AGENT); }
__device__ __forceinline__ unsigned xb_xcc_id() { return (unsigned)__builtin_amdgcn_s_getreg((3 << 11) | 20) & 0xFu; }
#define XB_SPIN(cond, bar) do { unsigned _sp = 0; while (cond) { __builtin_amdgcn_s_sleep(1); \
    if ((++_sp & 255u) == 0u) { if (xb_ld(&(bar)[XB_TMO])) break; if (_sp > XB_SPIN_CAP) { atomicAdd(&(bar)[XB_TMO], 1u); break; } } } } while (0)

struct XcdBarrier {
    unsigned* bar; unsigned x; int t0;
    volatile LAS unsigned* st;
};

__device__ __forceinline__ bool xb_is_t0(int wave) { return wave == 0 && __builtin_amdgcn_mbcnt_hi(~0u, __builtin_amdgcn_mbcnt_lo(~0u, 0u)) == 0u; }
__device__ __forceinline__ XcdBarrier xcd_barrier_post(unsigned* bar, volatile LAS unsigned* st, int wave) {
    XcdBarrier b; b.bar = bar; b.x = xb_xcc_id(); b.st = st; b.t0 = wave;
    if (xb_is_t0(wave)) (void)xb_add(&bar[XB_XCNT(b.x)], 1u);
    return b;
}
__device__ __forceinline__ void xcd_barrier_complete(unsigned* bar, unsigned x, unsigned& nloc, unsigned& nx) {
    const unsigned G = gridDim.x * gridDim.y * gridDim.z;
    unsigned sum, cnt, mine, sp = 0u;
    for (;;) {
        sum = 0u; cnt = 0u; mine = 0u;
#pragma unroll
        for (unsigned j = 0; j < 16; ++j) { const unsigned c = xb_ld(&bar[XB_XCNT(j)]); sum += c; cnt += (c > 0u) ? 1u : 0u; mine = (j == x) ? c : mine; }
        if (sum == G) break;
        __builtin_amdgcn_s_sleep(1);
        if ((++sp & 255u) == 0u) { if (xb_ld(&bar[XB_TMO])) break; if (sp > XB_SPIN_CAP) { atomicAdd(&bar[XB_TMO], 1u); break; } }
    }
    nloc = mine > 0u ? mine : 1u; nx = cnt > 0u ? cnt : 1u;
}

__device__ __forceinline__ void xcd_barrier(const XcdBarrier& b) {
    asm volatile("s_waitcnt vmcnt(0)" ::: "memory");
    __syncthreads();
    if (xb_is_t0(b.t0)) {
        unsigned* bar = b.bar;
        __builtin_amdgcn_s_waitcnt(0);
        unsigned nloc = b.st[0], nx = b.st[1];
        if (nloc == 0u) { xcd_barrier_complete(bar, b.x, nloc, nx); b.st[0] = nloc; b.st[1] = nx; }
        const unsigned old = xb_add(&bar[XB_XSUB(b.x)], 1u);
        const unsigned gen = old / nloc;
        if (old + 1u == (gen + 1u) * nloc) {
            __builtin_amdgcn_fence(__ATOMIC_RELEASE, "agent");
            asm volatile("s_waitcnt vmcnt(0)" ::: "memory");
            const unsigned og = xb_add(&bar[XB_TOP], 1u);
            const unsigned tg = og / nx;
            if (og + 1u == (tg + 1u) * nx) xb_add(&bar[XB_TOPGEN], 1u);
            else XB_SPIN(xb_ld(&bar[XB_TOPGEN]) == tg, bar);
            __builtin_amdgcn_fence(__ATOMIC_ACQUIRE, "agent");
            xb_add(&bar[XB_XGEN(b.x)], 1u);
            asm volatile("s_waitcnt vmcnt(0)" ::: "memory");
        } else {
            XB_SPIN(xb_ld(&bar[XB_XGEN(b.x)]) == gen, bar);
            __builtin_amdgcn_fence(__ATOMIC_ACQUIRE, "agent");
            asm volatile("s_waitcnt vmcnt(0)" ::: "memory");
        }
    }
    __syncthreads();
}

struct Args {
    const float* in[25];
    float* out; unsigned char* ws;
    int ph_lo, ph_hi;
};

using pg8::Unit;
struct EpiStore {
    static constexpr bool PERM = true, AFTER_DRAIN = false;
    bf16* O; int ldc; const float* ssq;
    __device__ __forceinline__ void operator()(const f32x4 (&acc)[2][2][4][2], const Unit& u, int wr, int wc, int fr, int fq) const {
        const int row0 = u.pm * 256 + wr * 64 + fr, col0 = u.pn * 256 + wc * 32 + 8 * fq;
#pragma unroll
        for (int ai = 0; ai < 2; ++ai)
#pragma unroll
            for (int m = 0; m < 4; ++m) { const int row = row0 + ai * 128 + m * 16; float sc = 1.f; if (ssq) sc = rstd16(ssq, (size_t)row);
                bf16* rowp = O + (size_t)row * ldc + col0;
#pragma unroll
                for (int bj = 0; bj < 2; ++bj) { const f32x4 v0 = acc[ai][bj][m][0] * sc, v1 = acc[ai][bj][m][1] * sc;
                    v4u w; w.x = pk2(v0[0], v0[1]); w.y = pk2(v0[2], v0[3]); w.z = pk2(v1[0], v1[1]); w.w = pk2(v1[2], v1[3]);
                    *(v4u*)(rowp + bj * 128) = w; } }
    }
};
template <bool ADD> struct EpiGate {
    static constexpr bool PERM = true, AFTER_DRAIN = false;
    bf16* T; const bf16* proj; int gcol; const float* bias;
    __device__ __forceinline__ void operator()(const f32x4 (&acc)[2][2][4][2], const Unit& u, int wr, int wc, int fr, int fq) const {
        const int row0 = u.pm * 256 + wr * 64 + fr, col0 = u.pn * 256 + wc * 32 + 8 * fq;
        f32x4 bv[2][2];
#pragma unroll
        for (int bj = 0; bj < 2; ++bj)
#pragma unroll
            for (int n = 0; n < 2; ++n) bv[bj][n] = *(const f32x4*)(bias + col0 + bj * 128 + 4 * n);
#pragma unroll
        for (int ai = 0; ai < 2; ++ai)
#pragma unroll
            for (int m = 0; m < 4; ++m) { const int row = row0 + ai * 128 + m * 16;
#pragma unroll
                for (int bj = 0; bj < 2; ++bj) {
                    const v4u gw = *(const v4u*)(proj + (size_t)row * NCOL + gcol + col0 + bj * 128);
                    bf16* tp = T + (size_t)row * DM + col0 + bj * 128;
                    float r[8];
                    r[0] = sigm(bflo(gw.x) + bv[bj][0][0]) * acc[ai][bj][m][0][0]; r[1] = sigm(bfhi(gw.x) + bv[bj][0][1]) * acc[ai][bj][m][0][1];
                    r[2] = sigm(bflo(gw.y) + bv[bj][0][2]) * acc[ai][bj][m][0][2]; r[3] = sigm(bfhi(gw.y) + bv[bj][0][3]) * acc[ai][bj][m][0][3];
                    r[4] = sigm(bflo(gw.z) + bv[bj][1][0]) * acc[ai][bj][m][1][0]; r[5] = sigm(bfhi(gw.z) + bv[bj][1][1]) * acc[ai][bj][m][1][1];
                    r[6] = sigm(bflo(gw.w) + bv[bj][1][2]) * acc[ai][bj][m][1][2]; r[7] = sigm(bfhi(gw.w) + bv[bj][1][3]) * acc[ai][bj][m][1][3];
                    if (ADD) { const v4u tw = *(const v4u*)tp;
                        r[0] += bflo(tw.x); r[1] += bfhi(tw.x); r[2] += bflo(tw.y); r[3] += bfhi(tw.y); r[4] += bflo(tw.z); r[5] += bfhi(tw.z); r[6] += bflo(tw.w); r[7] += bfhi(tw.w); }
                    v4u w; w.x = pk2(r[0], r[1]); w.y = pk2(r[2], r[3]); w.z = pk2(r[4], r[5]); w.w = pk2(r[6], r[7]);
                    *(v4u*)tp = w; } }
    }
};
struct EpiResid {
    static constexpr bool PERM = false, AFTER_DRAIN = false;
    const float* base; float* out; bf16* obf; float* ssq;
    __device__ __forceinline__ void operator()(const f32x4 (&acc)[2][2][4][2], const Unit& u, int wr, int wc, int fr, int fq) const {
        const int row0 = u.pm * 256 + wr * 64 + fr, col0 = u.pn * 256 + wc * 32 + 4 * fq;
#pragma unroll
        for (int ai = 0; ai < 2; ++ai)
#pragma unroll
            for (int m = 0; m < 4; ++m) { const int row = row0 + ai * 128 + m * 16; const size_t off = (size_t)row * DM + col0; float ss = 0.f;
#pragma unroll
                for (int bj = 0; bj < 2; ++bj)
#pragma unroll
                    for (int n = 0; n < 2; ++n) { const f32x4 bs = *(const f32x4*)(base + off + bj * 128 + n * 16); const f32x4 v = bs + acc[ai][bj][m][n];
                        *(f32x4*)(out + off + bj * 128 + n * 16) = v;
                        v2u w; w.x = pk2(v[0], v[1]); w.y = pk2(v[2], v[3]); *(v2u*)(obf + off + bj * 128 + n * 16) = w;
                        ss += (v[0] * v[0] + v[1] * v[1]) + (v[2] * v[2] + v[3] * v[3]); }
                ss += __shfl_xor(ss, 16); ss += __shfl_xor(ss, 32);
                if (fq == 0) ssq[(size_t)row * 16 + (u.pn & 3) * 4 + wc] = ss;
                CFENCE(); }
    }
};
struct EpiSwiglu {
    static constexpr bool PERM = true, AFTER_DRAIN = false;
    bf16* act; const float* bgu; const float* row_rstd;
    __device__ __forceinline__ void operator()(const f32x4 (&acc)[2][2][4][2], const Unit& u, int wr, int wc, int fr, int fq) const {
        const int e = u.pn >> 3, pnl = u.pn & 7;
        const int row0 = u.pm * 256 + wr * 64 + fr, cl0 = pnl * 128 + wc * 32 + 8 * fq;
        f32x4 bg[2], bl[2];
#pragma unroll
        for (int n = 0; n < 2; ++n) { bg[n] = *(const f32x4*)(bgu + e * 2048 + cl0 + 4 * n); bl[n] = *(const f32x4*)(bgu + e * 2048 + 1024 + cl0 + 4 * n); }
#pragma unroll
        for (int ai = 0; ai < 2; ++ai)
#pragma unroll
            for (int m = 0; m < 4; ++m) { const int row = row0 + ai * 128 + m * 16; const float rs = row_rstd[row];
                float r[8];
#pragma unroll
                for (int n = 0; n < 2; ++n)
#pragma unroll
                    for (int j = 0; j < 4; ++j) { float gl = acc[ai][0][m][n][j] * rs + bg[n][j], li = acc[ai][1][m][n][j] * rs + bl[n][j];
                        gl = fminf(gl, 7.0f); li = fminf(fmaxf(li, -7.0f), 7.0f);
                        r[n * 4 + j] = gl * sigm(1.702f * gl) * (li + 1.0f); }
                v4u w; w.x = pk2(r[0], r[1]); w.y = pk2(r[2], r[3]); w.z = pk2(r[4], r[5]); w.w = pk2(r[6], r[7]);
                *(v4u*)(act + (size_t)row * DM + cl0) = w; }
    }
};
struct EpiDown {
    static constexpr bool PERM = true, AFTER_DRAIN = false;
    bf16* y; const float* bd; const float* row_gate;
    __device__ __forceinline__ void operator()(const f32x4 (&acc)[2][2][4][2], const Unit& u, int wr, int wc, int fr, int fq) const {
        const int e = u.pn >> 2, pnl = u.pn & 3;
        const int row0 = u.pm * 256 + wr * 64 + fr, col0 = pnl * 256 + wc * 32 + 8 * fq;
        f32x4 bv[2][2];
#pragma unroll
        for (int bj = 0; bj < 2; ++bj)
#pragma unroll
            for (int n = 0; n < 2; ++n) bv[bj][n] = *(const f32x4*)(bd + e * 1024 + col0 + bj * 128 + 4 * n);
#pragma unroll
        for (int ai = 0; ai < 2; ++ai)
#pragma unroll
            for (int m = 0; m < 4; ++m) { const int row = row0 + ai * 128 + m * 16; const float gt = row_gate[row];
#pragma unroll
                for (int bj = 0; bj < 2; ++bj) { const f32x4 v0 = (acc[ai][bj][m][0] + bv[bj][0]) * gt, v1 = (acc[ai][bj][m][1] + bv[bj][1]) * gt;
                    v4u w; w.x = pk2(v0[0], v0[1]); w.y = pk2(v0[2], v0[3]); w.z = pk2(v1[0], v1[1]); w.w = pk2(v1[2], v1[3]);
                    *(v4u*)(y + (size_t)row * DM + col0 + bj * 128) = w; } }
    }
};
struct GroupedOrder {
    int nunits, npn, G, c; const unsigned* blk_expert;
    __device__ __forceinline__ bool next(int i, Unit& u) const {
        const long L = (long)i * G + c; if (L >= nunits) return false;
        const int rb = (int)(L / npn), pn = (int)(L % npn);
        const int e = (int)__builtin_amdgcn_readfirstlane(ld_agent(blk_expert + rb));
        u.pm = rb; u.pn = e * npn + pn; return true;
    }
    __device__ __forceinline__ void a_ready(const Unit&) const {}
    __device__ __forceinline__ void done(const Unit&) const {}
};

constexpr int RING_BYTES = 131072, MISC_OFF = RING_BYTES + 320, LDS_BYTES = 147456;

struct Ctx { LAS unsigned char* lds; int tid, lane, wave, G, gw, ngw; };

template <class RowMap>
__device__ __forceinline__ void transpose_item(const float* W, int K, int N, bf16* WT, const float* gain, LAS float* scr, int item, int lane, RowMap rm) {
    const int nblk = N / 32, kb = item / nblk, nb = item % nblk, k0 = 64 * kb, n0 = 32 * nb;
#pragma unroll 8
    for (int i = 0; i < 32; ++i) { const int kk = 2 * i + (lane >> 5); float v = W[(size_t)(k0 + kk) * N + n0 + (lane & 31)]; if (gain) v *= gain[k0 + kk]; scr[kk * 33 + (lane & 31)] = v; }
    LDS_WAIT();
    const int c = lane & 7;
#pragma unroll
    for (int j = 0; j < 4; ++j) { const int n = (lane >> 3) + 8 * j; const LAS float* s = scr + (8 * c) * 33 + n;
        v4u o; o.x = pk2(s[0 * 33], s[1 * 33]); o.y = pk2(s[2 * 33], s[3 * 33]); o.z = pk2(s[4 * 33], s[5 * 33]); o.w = pk2(s[6 * 33], s[7 * 33]);
        *(v4u*)(WT + (size_t)rm(n0 + n) * K + k0 + 8 * c) = o; }
    LDS_WAIT();
}
struct RowId { int off; __device__ __forceinline__ int operator()(int n) const { return off + n; } };
struct RowGU { int e; __device__ __forceinline__ int operator()(int n) const { const int j = n & 1023; return e * 2048 + (j >> 7) * 256 + (n >> 10) * 128 + (j & 127); } };

__device__ __forceinline__ void rms_row_to_bf16(const float* xrow, const float* gain, bf16* orow, int lane) {
    const f32x4* xr = (const f32x4*)xrow + lane; const f32x4* gr = (const f32x4*)gain + lane;
    f32x4 v[4]; float s = 0.f;
#pragma unroll
    for (int j = 0; j < 4; ++j) { v[j] = xr[64 * j]; s += (v[j][0] * v[j][0] + v[j][1] * v[j][1]) + (v[j][2] * v[j][2] + v[j][3] * v[j][3]); }
    const float rstd = rsqrtf(wave_sum(s) * (1.f / DM) + RMS_EPS);
    unsigned long long* o8 = (unsigned long long*)orow + lane;
#pragma unroll
    for (int j = 0; j < 4; ++j) { const f32x4 g = gr[64 * j]; const f32x4 w = v[j] * rstd * g;
        o8[64 * j] = (unsigned long long)pk2(w[0], w[1]) | ((unsigned long long)pk2(w[2], w[3]) << 32); }
}

__device__ __forceinline__ void phase_prologue(const Args& a, const Ctx& c) {
    LAS float* scr = (LAS float*)(c.lds + c.wave * 16384);
    unsigned char* ws = a.ws;
    constexpr int I_IN = 16 * (NCOL / 32), I_SQ = 16 * 32, I_R = 16;
    constexpr int NIT = I_IN + 7 * I_SQ + I_R;
    for (int it = c.gw; it < NIT; it += c.ngw) {
        int r = it;
        if (r < I_IN) { transpose_item(a.in[5], DM, NCOL, (bf16*)(ws + WS_WIN), nullptr, scr, r, c.lane, RowId{0}); continue; } r -= I_IN;
        if (r < I_SQ) { transpose_item(a.in[9], DM, DM, (bf16*)(ws + WS_WA), nullptr, scr, r, c.lane, RowId{0}); continue; } r -= I_SQ;
        if (r < I_SQ) { transpose_item(a.in[10], DM, DM, (bf16*)(ws + WS_WB), nullptr, scr, r, c.lane, RowId{0}); continue; } r -= I_SQ;
        if (r < I_SQ) { transpose_item(a.in[11], DM, DM, (bf16*)(ws + WS_WMIX), nullptr, scr, r, c.lane, RowId{0}); continue; } r -= I_SQ;
        if (r < I_SQ) { transpose_item(a.in[13], DM, DM, (bf16*)(ws + WS_WQ), a.in[12], scr, r, c.lane, RowId{0}); continue; } r -= I_SQ;
        if (r < I_SQ) { transpose_item(a.in[14], DM, DM, (bf16*)(ws + WS_WK), nullptr, scr, r, c.lane, RowId{0}); continue; } r -= I_SQ;
        if (r < I_SQ) { transpose_item(a.in[15], DM, DM, (bf16*)(ws + WS_WV), nullptr, scr, r, c.lane, RowId{0}); continue; } r -= I_SQ;
        if (r < I_SQ) { transpose_item(a.in[16], DM, DM, (bf16*)(ws + WS_WO), nullptr, scr, r, c.lane, RowId{0}); continue; } r -= I_SQ;
        transpose_item(a.in[18], DM, NEXP, (bf16*)(ws + WS_WR), a.in[17], scr, r, c.lane, RowId{0});
    }
    { const size_t n8 = (size_t)NBATCH * MEMLEN * DM / 8; const float* mem = a.in[1]; bf16* mb = (bf16*)(ws + WS_MEMBF);
      for (size_t i = (size_t)c.gw * 64 + c.lane; i < n8; i += (size_t)c.ngw * 64) { const f32x4 v0 = *(const f32x4*)(mem + i * 8), v1 = *(const f32x4*)(mem + i * 8 + 4);
          v4u w; w.x = pk2(v0[0], v0[1]); w.y = pk2(v0[2], v0[3]); w.z = pk2(v1[0], v1[1]); w.w = pk2(v1[2], v1[3]); *(v4u*)(mb + i * 8) = w; } }
    if (c.gw == 0) {
        float* lb = (float*)(ws + WS_LB); const float* lbl = a.in[3];
        for (int k = c.lane; k < 1024; k += 64) lb[k] = 1.f / (1.f + expf(lbl[1024 + k] - lbl[k]));
    }
    if (c.gw == 1) {
        float* lut = (float*)(ws + WS_LUT); const float* t5 = a.in[2];
        for (int i = c.lane; i < 16 * 128; i += 64) { const int h = i >> 7, d = i & 127; int b = d;
            if (d >= 16) { b = 16 + (int)(logf((float)d * (1.f / 16.f)) / logf(8.f) * 16.f); b = b < 31 ? b : 31; }
            lut[i] = t5[b * 16 + h]; }
    }
}

__device__ __forceinline__ void phase_norm1(const Args& a, const Ctx& c, int hb) {
    const float* x = a.in[0] + (size_t)hb * HTOK * DM; bf16* xn = (bf16*)(a.ws + WS_TM);
    for (int m = c.gw; m < HTOK; m += c.ngw) rms_row_to_bf16(x + (size_t)m * DM, a.in[4], xn + (size_t)m * DM, c.lane);
}

constexpr int SWA_VB = 32 * 144;
constexpr int SWA_LUT_OFF = 8 * 2 * SWA_VB;
__device__ __forceinline__ void swa_unit(const bf16* proj, bf16* ob, int bl, int kvh, int tt, const LAS float* lut, LAS unsigned char* vbuf, const float* sinks, int lane) {
    const int l15 = lane & 15, g = lane >> 4, q4 = l15 >> 2, p4 = lane & 3;
    const int t0 = tt * 16; const size_t rowb = (size_t)bl * SEQ;
    bf16x8 qf[4][2];
#pragma unroll
    for (int gq = 0; gq < 4; ++gq)
#pragma unroll
        for (int ks = 0; ks < 2; ++ks) qf[gq][ks] = *(const bf16x8*)(proj + (rowb + t0 + l15) * NCOL + C_SQ + (kvh * 4 + gq) * 64 + ks * 32 + 8 * g);
    float mx[4], ls[4]; f32x4 o[4][4];
#pragma unroll
    for (int gq = 0; gq < 4; ++gq) { mx[gq] = sinks[kvh * 4 + gq]; ls[gq] = 1.f;
#pragma unroll
        for (int dt = 0; dt < 4; ++dt) o[gq][dt] = (f32x4){0.f, 0.f, 0.f, 0.f}; }
    for (int c = 0; c < 5; ++c) {
        const int kc = t0 - 144 + 32 * c;
        if (kc + 31 < 0) continue;
        LAS unsigned char* vb = vbuf + (c & 1) * SWA_VB;
#pragma unroll
        for (int i = 0; i < 4; ++i) { const int p = lane + 64 * i, key = p >> 3, d8 = p & 7; int kr = kc + key; kr = kr < 0 ? 0 : kr;
            const v4u vv = *(const v4u*)(proj + (rowb + kr) * NCOL + C_SV + kvh * 64 + d8 * 8);
            *(LAS v4u*)(vb + key * 144 + d8 * 16) = vv; }
        f32x4 s[4][2];
#pragma unroll
        for (int ksub = 0; ksub < 2; ++ksub) { int kr = kc + 16 * ksub + l15; kr = kr < 0 ? 0 : kr;
            const bf16* kp = proj + (rowb + kr) * NCOL + C_SK + kvh * 64 + 8 * g;
            const bf16x8 k0 = *(const bf16x8*)kp, k1 = *(const bf16x8*)(kp + 32);
#pragma unroll
            for (int gq = 0; gq < 4; ++gq) { f32x4 z = (f32x4){0.f, 0.f, 0.f, 0.f}; z = mfma16(k0, qf[gq][0], z); s[gq][ksub] = mfma16(k1, qf[gq][1], z); } }
        bf16x8 pf[4];
#pragma unroll
        for (int gq = 0; gq < 4; ++gq) { const int hq = kvh * 4 + gq; float cm = -1e30f;
#pragma unroll
            for (int ksub = 0; ksub < 2; ++ksub)
#pragma unroll
                for (int r = 0; r < 4; ++r) { const int key = kc + 16 * ksub + 4 * g + r, dist = t0 + l15 - key; const bool ok = (dist >= 0) && (dist < 128) && (key >= 0);
                    const int di = dist < 0 ? 0 : (dist > 127 ? 127 : dist);
                    float v = s[gq][ksub][r] * 0.125f + lut[hq * 128 + di]; v = ok ? v : -1e30f; s[gq][ksub][r] = v; cm = fmaxf(cm, v); }
            cm = fmaxf(cm, __shfl_xor(cm, 16)); cm = fmaxf(cm, __shfl_xor(cm, 32));
            const float mn = fmaxf(mx[gq], cm), alpha = __expf(mx[gq] - mn); mx[gq] = mn; float rs = 0.f;
#pragma unroll
            for (int ksub = 0; ksub < 2; ++ksub)
#pragma unroll
                for (int r = 0; r < 4; ++r) { const float p = __expf(s[gq][ksub][r] - mn); s[gq][ksub][r] = p; rs += p; }
            rs += __shfl_xor(rs, 16); rs += __shfl_xor(rs, 32);
            ls[gq] = ls[gq] * alpha + rs;
#pragma unroll
            for (int dt = 0; dt < 4; ++dt) o[gq][dt] = o[gq][dt] * alpha;
            pf[gq] = pack8(s[gq][0], s[gq][1]); }
        CFENCE();
#pragma unroll
        for (int dt = 0; dt < 4; ++dt) {
            const s16x4 lo = vtr(vb + (4 * g + q4) * 144 + (16 * dt + 4 * p4) * 2), hi = vtr(vb + (16 + 4 * g + q4) * 144 + (16 * dt + 4 * p4) * 2);
            const bf16x8 vf = cat8(lo, hi);
#pragma unroll
            for (int gq = 0; gq < 4; ++gq) o[gq][dt] = mfma16(vf, pf[gq], o[gq][dt]); }
        CFENCE();
    }
#pragma unroll
    for (int gq = 0; gq < 4; ++gq) { const float inv = 1.f / ls[gq];
#pragma unroll
        for (int dt = 0; dt < 4; ++dt) { const f32x4 v = o[gq][dt] * inv; v2u w; w.x = pk2(v[0], v[1]); w.y = pk2(v[2], v[3]);
            *(v2u*)(ob + (rowb + t0 + l15) * DM + (kvh * 4 + gq) * 64 + 16 * dt + 4 * g) = w; } }
}
__device__ __forceinline__ void phase_swa(const Args& a, const Ctx& c) {
    const bf16* proj = (const bf16*)(a.ws + WS_PROJ); bf16* ob = (bf16*)(a.ws + WS_OB);
    LAS float* lut = (LAS float*)(c.lds + SWA_LUT_OFF); const float* glut = (const float*)(a.ws + WS_LUT);
    for (int i = c.tid; i < 16 * 128; i += 512) lut[i] = glut[i];
    __syncthreads();
    LAS unsigned char* vbuf = c.lds + c.wave * 2 * SWA_VB;
    constexpr int NU = 8 * 4 * 256;
    for (int u = c.gw; u < NU; u += c.ngw) { const int tt = u & 255, kvh = (u >> 8) & 3, bl = u >> 10; swa_unit(proj, ob, bl, kvh, tt, lut, vbuf, a.in[8], c.lane); }
    __syncthreads();
}

constexpr int HG_LF = 0, HG_KP = 33792, HG_VT = 51200, HG_GT = 68608, HG_QP = 70656, HG_SSQ = 88064;
__device__ __forceinline__ void hg_scan(LAS unsigned char* lds, int tid, float (&loc)[16], float& pre, float& Gm, float& Gl) {
    const int ch = tid & 127, grp = tid >> 7;
    const LAS float* LF = (const LAS float*)(lds + HG_LF); LAS float* GT = (LAS float*)(lds + HG_GT);
    float run = 0.f;
#pragma unroll
    for (int i = 0; i < 16; ++i) { run += LF[(16 * grp + i) * 132 + ch]; loc[i] = run; }
    GT[grp * 128 + ch] = run;
    __syncthreads();
    const float g0 = GT[ch], g1 = GT[128 + ch], g2 = GT[256 + ch], g3 = GT[384 + ch];
    pre = (grp > 0 ? g0 : 0.f) + (grp > 1 ? g1 : 0.f) + (grp > 2 ? g2 : 0.f);
    Gm = g0 + g1; Gl = Gm + g2 + g3;
}
__device__ __forceinline__ void phase_hgA(const Args& a, const Ctx& c) {
    const bf16* proj = (const bf16*)(a.ws + WS_PROJ); bf16* US = (bf16*)((unsigned char*)a.out + OUT_US); float* D12 = (float*)(a.ws + WS_D12); const float* lb = (const float*)(a.ws + WS_LB);
    LAS unsigned char* lds = c.lds; const int tid = c.tid, lane = c.lane, w = c.wave;
    const int l15 = lane & 15, g = lane >> 4, q4 = l15 >> 2, p4 = lane & 3;
    constexpr int NU = 8 * 8 * 64;
    int u = blockIdx.x; if (u >= NU) return;
    v4u rf[2], rv[2];
#define HGA_LOAD(uu) do { const int cc_ = (uu) & 63, h_ = ((uu) >> 6) & 7, bl_ = (uu) >> 9; const size_t row0_ = (size_t)bl_ * SEQ + cc_ * 64; \
        _Pragma("unroll") for (int i = 0; i < 2; ++i) { const int p = tid + 512 * i, tok = p >> 4, c8 = p & 15; const bf16* rp = proj + (row0_ + tok) * NCOL + h_ * 128 + c8 * 8; \
            rf[i] = *(const v4u*)(rp + C_HF); rv[i] = *(const v4u*)(rp + C_HI); } } while (0)
    HGA_LOAD(u);
    for (;;) {
        const int h = (u >> 6) & 7;
#pragma unroll
        for (int i = 0; i < 2; ++i) { const int p = tid + 512 * i, tok = p >> 4, c8 = p & 15;
            const f32x4 lb0 = *(const f32x4*)(lb + h * 128 + c8 * 8), lb1 = *(const f32x4*)(lb + h * 128 + c8 * 8 + 4);
            const unsigned fw[4] = {rf[i].x, rf[i].y, rf[i].z, rf[i].w}; f32x4 o0, o1;
#pragma unroll
            for (int j = 0; j < 4; ++j) { const float lbl = j < 2 ? lb0[2 * j] : lb1[2 * j - 4], lbh = j < 2 ? lb0[2 * j + 1] : lb1[2 * j - 3];
                const float fl = lbl + (1.f - lbl) * sigm(bflo(fw[j])), fh = lbh + (1.f - lbh) * sigm(bfhi(fw[j]));
                if (j < 2) { o0[2 * j] = __logf(fl); o0[2 * j + 1] = __logf(fh); } else { o1[2 * j - 4] = __logf(fl); o1[2 * j - 3] = __logf(fh); } }
            LAS float* lfp = (LAS float*)(lds + HG_LF) + tok * 132 + c8 * 8; *(LAS f32x4*)lfp = o0; *(LAS f32x4*)(lfp + 4) = o1;
            *(LAS v4u*)(lds + HG_VT + tok * 272 + c8 * 16) = rv[i]; }
        const int ucur = u; const int un = u + gridDim.x; const bool has_next = un < NU;
        if (has_next) HGA_LOAD(un);
        __syncthreads();
        float loc[16], pre, Gm, Gl; hg_scan(lds, tid, loc, pre, Gm, Gl);
        { const int ch = tid & 127, grp = tid >> 7; LAS bf16* KP = (LAS bf16*)(lds + HG_KP);
#pragma unroll
          for (int i = 0; i < 16; ++i) { const float lfi = loc[i] - (i ? loc[i - 1] : 0.f), G = pre + loc[i];
              const float kp = (1.f - __expf(lfi)) * __expf(fminf(Gm - G, 80.f)); KP[(16 * grp + i) * 136 + ch] = (bf16)f2bf(kp); }
          if (grp == 0) { D12[(size_t)ucur * 256 + ch] = __expf(Gm); D12[(size_t)ucur * 256 + 128 + ch] = __expf(Gl - Gm); } }
        __syncthreads();
        { bf16x8 af[2];
#pragma unroll
          for (int ks = 0; ks < 2; ++ks) { const LAS unsigned char* bp = lds + HG_KP + (32 * ks + 8 * g + q4) * 272 + (16 * w + 4 * p4) * 2; af[ks] = cat8(vtr(bp), vtr(bp + 4 * 272)); }
#pragma unroll
          for (int vt = 0; vt < 8; ++vt) { f32x4 acc = (f32x4){0.f, 0.f, 0.f, 0.f};
#pragma unroll
              for (int ks = 0; ks < 2; ++ks) { const LAS unsigned char* bp = lds + HG_VT + (32 * ks + 8 * g + q4) * 272 + (16 * vt + 4 * p4) * 2; acc = mfma16(af[ks], cat8(vtr(bp), vtr(bp + 4 * 272)), acc); }
              v2u wv; wv.x = pk2(acc[0], acc[1]); wv.y = pk2(acc[2], acc[3]);
              *(v2u*)(US + ((size_t)ucur * 128 + 16 * vt + l15) * 128 + 16 * w + 4 * g) = wv; } }
        __syncthreads();
        if (!has_next) break;
        u = un;
    }
}
__device__ __forceinline__ void phase_hgB(const Args& a, const Ctx& c) {
    bf16* US = (bf16*)((unsigned char*)a.out + OUT_US); const float* D12 = (const float*)(a.ws + WS_D12);
    const int gt = c.gw * 64 + c.lane;
    for (int e = gt; e < 64 * 2048; e += c.ngw * 64) {
        const int bh = e >> 11, r = e & 2047, k8 = r & 15;
        float S[8];
#pragma unroll
        for (int j = 0; j < 8; ++j) S[j] = 0.f;
        for (int c0 = 0; c0 < 64; c0 += 4) {
            v4u uw[4]; f32x4 d1[4][2], d2[4][2];
#pragma unroll
            for (int cc = 0; cc < 4; ++cc) { const size_t un = (size_t)bh * 64 + c0 + cc;
                uw[cc] = *(const v4u*)(US + un * 16384 + (size_t)r * 8);
                d1[cc][0] = *(const f32x4*)(D12 + un * 256 + k8 * 8); d1[cc][1] = *(const f32x4*)(D12 + un * 256 + k8 * 8 + 4);
                d2[cc][0] = *(const f32x4*)(D12 + un * 256 + 128 + k8 * 8); d2[cc][1] = *(const f32x4*)(D12 + un * 256 + 128 + k8 * 8 + 4); }
#pragma unroll
            for (int cc = 0; cc < 4; ++cc) { const size_t un = (size_t)bh * 64 + c0 + cc;
                const unsigned ww[4] = {uw[cc].x, uw[cc].y, uw[cc].z, uw[cc].w}; float sp[8];
#pragma unroll
                for (int j = 0; j < 8; ++j) { const float d1v = d1[cc][j >> 2][j & 3], d2v = d2[cc][j >> 2][j & 3]; const float uv = (j & 1) ? bfhi(ww[j >> 1]) : bflo(ww[j >> 1]);
                    sp[j] = d1v * S[j]; S[j] = d2v * (sp[j] + uv); }
                v4u o; o.x = pk2(sp[0], sp[1]); o.y = pk2(sp[2], sp[3]); o.z = pk2(sp[4], sp[5]); o.w = pk2(sp[6], sp[7]);
                *(v4u*)(US + un * 16384 + (size_t)r * 8) = o; }
        }
    }
}
__device__ __forceinline__ void phase_hgC(const Args& a, const Ctx& c) {
    const bf16* proj = (const bf16*)(a.ws + WS_PROJ); const bf16* US = (const bf16*)((unsigned char*)a.out + OUT_US); bf16* oa = (bf16*)(a.ws + WS_OA);
    const float* lb = (const float*)(a.ws + WS_LB); const float* hgain = a.in[7];
    LAS unsigned char* lds = c.lds; const int tid = c.tid, lane = c.lane, w = c.wave;
    const int l15 = lane & 15, g = lane >> 4, q4 = l15 >> 2, p4 = lane & 3;
    constexpr int NU = 8 * 8 * 64;
    int u = blockIdx.x; if (u >= NU) return;
    v4u rq[2], rf[2], rv[2];
#define HGC_LOAD(uu) do { const int cc_ = (uu) & 63, h_ = ((uu) >> 6) & 7, bl_ = (uu) >> 9; const size_t row0_ = (size_t)bl_ * SEQ + cc_ * 64; \
        _Pragma("unroll") for (int i = 0; i < 2; ++i) { const int p = tid + 512 * i, tok = p >> 4, c8 = p & 15; const bf16* rp = proj + (row0_ + tok) * NCOL + h_ * 128 + c8 * 8; \
            rq[i] = *(const v4u*)(rp + C_HQ); rf[i] = *(const v4u*)(rp + C_HF); rv[i] = *(const v4u*)(rp + C_HI); } } while (0)
    HGC_LOAD(u);
    const f32x4 gn = *(const f32x4*)(hgain + 16 * w + 4 * g);
    for (;;) {
        const int cc = u & 63, h = (u >> 6) & 7, bl = u >> 9; const size_t row0 = (size_t)bl * SEQ + cc * 64;
#pragma unroll
        for (int i = 0; i < 2; ++i) { const int p = tid + 512 * i, tok = p >> 4, c8 = p & 15;
            const f32x4 lb0 = *(const f32x4*)(lb + h * 128 + c8 * 8), lb1 = *(const f32x4*)(lb + h * 128 + c8 * 8 + 4);
            const unsigned fw[4] = {rf[i].x, rf[i].y, rf[i].z, rf[i].w}; f32x4 o0, o1;
#pragma unroll
            for (int j = 0; j < 4; ++j) { const float lbl = j < 2 ? lb0[2 * j] : lb1[2 * j - 4], lbh = j < 2 ? lb0[2 * j + 1] : lb1[2 * j - 3];
                const float fl = lbl + (1.f - lbl) * sigm(bflo(fw[j])), fh = lbh + (1.f - lbh) * sigm(bfhi(fw[j]));
                if (j < 2) { o0[2 * j] = __logf(fl); o0[2 * j + 1] = __logf(fh); } else { o1[2 * j - 4] = __logf(fl); o1[2 * j - 3] = __logf(fh); } }
            LAS float* lfp = (LAS float*)(lds + HG_LF) + tok * 132 + c8 * 8; *(LAS f32x4*)lfp = o0; *(LAS f32x4*)(lfp + 4) = o1;
            *(LAS v4u*)(lds + HG_VT + tok * 272 + c8 * 16) = rv[i];
            *(LAS v4u*)(lds + HG_QP + tok * 272 + c8 * 16) = rq[i]; }
        const int ucur = u; const int un = u + gridDim.x; const bool has_next = un < NU;
        if (has_next) HGC_LOAD(un);
        bf16x8 sf[4];
#pragma unroll
        for (int ks = 0; ks < 4; ++ks) sf[ks] = *(const bf16x8*)(US + ((size_t)ucur * 128 + 16 * w + l15) * 128 + 32 * ks + 8 * g);
        __syncthreads();
        float loc[16], pre, Gm, Gl; hg_scan(lds, tid, loc, pre, Gm, Gl);
        { const int ch = tid & 127, grp = tid >> 7; LAS bf16* KP = (LAS bf16*)(lds + HG_KP); LAS bf16* QP = (LAS bf16*)(lds + HG_QP);
#pragma unroll
          for (int i = 0; i < 16; ++i) { const float lfi = loc[i] - (i ? loc[i - 1] : 0.f), G = pre + loc[i];
              const float kp = (1.f - __expf(lfi)) * __expf(fminf(Gm - G, 80.f)); KP[(16 * grp + i) * 136 + ch] = (bf16)f2bf(kp);
              const float qr = __builtin_bit_cast(float, (unsigned)QP[(16 * grp + i) * 136 + ch] << 16);
              const float qp = qr * sigm(qr) * __expf(fminf(G - Gm, 80.f)); QP[(16 * grp + i) * 136 + ch] = (bf16)f2bf(qp); } }
        __syncthreads();
        f32x4 o[4];
        {
            bf16x8 vf[2];
#pragma unroll
            for (int kk = 0; kk < 2; ++kk) { const LAS unsigned char* bp = lds + HG_VT + (32 * kk + 4 * g + q4) * 272 + (16 * w + 4 * p4) * 2; vf[kk] = cat8(vtr(bp), vtr(bp + 16 * 272)); }
#pragma unroll
            for (int tt = 0; tt < 4; ++tt) {
                bf16x8 qf[4];
#pragma unroll
                for (int ks = 0; ks < 4; ++ks) qf[ks] = *(const LAS bf16x8*)(lds + HG_QP + (16 * tt + l15) * 272 + (32 * ks + 8 * g) * 2);
                f32x4 acc = (f32x4){0.f, 0.f, 0.f, 0.f};
#pragma unroll
                for (int ks = 0; ks < 4; ++ks) acc = mfma16(sf[ks], qf[ks], acc);
                f32x4 at[4];
#pragma unroll
                for (int st = 0; st < 4; ++st) { at[st] = (f32x4){0.f, 0.f, 0.f, 0.f};
                    if (st <= tt) {
#pragma unroll
                        for (int ks = 0; ks < 4; ++ks) { const bf16x8 kf = *(const LAS bf16x8*)(lds + HG_KP + (16 * st + l15) * 272 + (32 * ks + 8 * g) * 2); at[st] = mfma16(kf, qf[ks], at[st]); }
                        if (st == tt) {
#pragma unroll
                            for (int r = 0; r < 4; ++r) at[st][r] = (4 * g + r <= l15) ? at[st][r] : 0.f; } } }
                acc = mfma16(vf[0], pack8(at[0], at[1]), acc);
                if (tt >= 2) acc = mfma16(vf[1], pack8(at[2], at[3]), acc);
                o[tt] = acc; }
        }
        { LAS float* SSQ = (LAS float*)(lds + HG_SSQ);
#pragma unroll
          for (int tt = 0; tt < 4; ++tt) { float s = (o[tt][0] * o[tt][0] + o[tt][1] * o[tt][1]) + (o[tt][2] * o[tt][2] + o[tt][3] * o[tt][3]);
              s += __shfl_xor(s, 16); s += __shfl_xor(s, 32); if (g == 0) SSQ[w * 64 + 16 * tt + l15] = s; }
          __syncthreads();
#pragma unroll
          for (int tt = 0; tt < 4; ++tt) { float s = 0.f;
#pragma unroll
              for (int ww = 0; ww < 8; ++ww) s += SSQ[ww * 64 + 16 * tt + l15];
              const float rstd = rsqrtf(s * (1.f / 128.f) + RMS_EPS);
              const size_t row = row0 + 16 * tt + l15;
              const v2u gw = *(const v2u*)(proj + row * NCOL + C_HG + h * 128 + 16 * w + 4 * g);
              const float g0 = bflo(gw.x), g1 = bfhi(gw.x), g2 = bflo(gw.y), g3 = bfhi(gw.y);
              const float r0 = o[tt][0] * rstd * gn[0] * (g0 * sigm(g0)), r1 = o[tt][1] * rstd * gn[1] * (g1 * sigm(g1));
              const float r2 = o[tt][2] * rstd * gn[2] * (g2 * sigm(g2)), r3 = o[tt][3] * rstd * gn[3] * (g3 * sigm(g3));
              v2u wv; wv.x = pk2(r0, r1); wv.y = pk2(r2, r3);
              *(v2u*)(oa + row * DM + h * 128 + 16 * w + 4 * g) = wv; } }
        if (!has_next) break;
        u = un;
    }
    __syncthreads();
}

constexpr int XA_NQT = 1;
__device__ __forceinline__ void xa_unit(bf16* qo, const bf16* kx, const bf16* vxt, int b, int h, int qt0, int lane) {
    const int l15 = lane & 15, g = lane >> 4;
    const size_t row0 = (size_t)b * SEQ + qt0 * 16;
    bf16x8 qf[XA_NQT][8];
#pragma unroll
    for (int qt = 0; qt < XA_NQT; ++qt)
#pragma unroll
        for (int ks = 0; ks < 8; ++ks) qf[qt][ks] = *(const bf16x8*)(qo + (row0 + 16 * qt + l15) * DM + h * 256 + 32 * ks + 8 * g);
    float mx[XA_NQT], ls[XA_NQT]; f32x4 o[XA_NQT][16];
#pragma unroll
    for (int qt = 0; qt < XA_NQT; ++qt) { mx[qt] = -1e30f; ls[qt] = 0.f;
#pragma unroll
        for (int dt = 0; dt < 16; ++dt) o[qt][dt] = (f32x4){0.f, 0.f, 0.f, 0.f}; }
    const bf16* kb = kx + (size_t)b * MEMLEN * DM + h * 256 + 8 * g;
    const bf16* vb = vxt + (size_t)(h * 256 + l15) * (NBATCH * MEMLEN) + b * MEMLEN + 4 * g;
    for (int kc = 0; kc < MEMLEN; kc += 32) {
        f32x4 s[XA_NQT][2];
#pragma unroll
        for (int ksub = 0; ksub < 2; ++ksub) {
#pragma unroll
            for (int qt = 0; qt < XA_NQT; ++qt) s[qt][ksub] = (f32x4){0.f, 0.f, 0.f, 0.f};
            const bf16* kp = kb + (size_t)(kc + 16 * ksub + l15) * DM;
#pragma unroll
            for (int ks = 0; ks < 8; ++ks) { const bf16x8 kf = *(const bf16x8*)(kp + 32 * ks);
#pragma unroll
                for (int qt = 0; qt < XA_NQT; ++qt) s[qt][ksub] = mfma16(kf, qf[qt][ks], s[qt][ksub]); } }
        bf16x8 pf[XA_NQT];
#pragma unroll
        for (int qt = 0; qt < XA_NQT; ++qt) { float cm = -1e30f;
#pragma unroll
            for (int ksub = 0; ksub < 2; ++ksub)
#pragma unroll
                for (int r = 0; r < 4; ++r) { const float v = s[qt][ksub][r] * 0.0625f; s[qt][ksub][r] = v; cm = fmaxf(cm, v); }
            cm = fmaxf(cm, __shfl_xor(cm, 16)); cm = fmaxf(cm, __shfl_xor(cm, 32));
            const float mn = fmaxf(mx[qt], cm), alpha = __expf(mx[qt] - mn); mx[qt] = mn; float rs = 0.f;
#pragma unroll
            for (int ksub = 0; ksub < 2; ++ksub)
#pragma unroll
                for (int r = 0; r < 4; ++r) { const float p = __expf(s[qt][ksub][r] - mn); s[qt][ksub][r] = p; rs += p; }
            rs += __shfl_xor(rs, 16); rs += __shfl_xor(rs, 32);
            ls[qt] = ls[qt] * alpha + rs;
#pragma unroll
            for (int dt = 0; dt < 16; ++dt) o[qt][dt] = o[qt][dt] * alpha;
            pf[qt] = pack8(s[qt][0], s[qt][1]); }
#pragma unroll
        for (int dt = 0; dt < 16; ++dt) { const bf16* vp = vb + (size_t)(16 * dt) * (NBATCH * MEMLEN) + kc;
            const s16x4 lo = *(const s16x4*)vp, hi = *(const s16x4*)(vp + 16);
            const bf16x8 vf = cat8(lo, hi);
#pragma unroll
            for (int qt = 0; qt < XA_NQT; ++qt) o[qt][dt] = mfma16(vf, pf[qt], o[qt][dt]); }
    }
#pragma unroll
    for (int qt = 0; qt < XA_NQT; ++qt) { const float inv = 1.f / ls[qt];
#pragma unroll
        for (int dt = 0; dt < 16; ++dt) { const f32x4 v = o[qt][dt] * inv; v2u w; w.x = pk2(v[0], v[1]); w.y = pk2(v[2], v[3]);
            *(v2u*)(qo + (row0 + 16 * qt + l15) * DM + h * 256 + 16 * dt + 4 * g) = w; } }
}
__device__ __forceinline__ void phase_xa(const Args& a, const Ctx& c) {
    bf16* qo = (bf16*)(a.ws + WS_Q); const bf16* kx = (const bf16*)(a.ws + WS_KX); const bf16* vxt = (const bf16*)(a.ws + WS_VXT);
    constexpr int QPU = 16 * XA_NQT, UPB = SEQ / QPU;
    constexpr int NU = NBATCH * 4 * UPB;
    for (int u = c.gw; u < NU; u += c.ngw) { const int qi = u % UPB, h = (u / UPB) & 3, b = u / (UPB * 4); xa_unit(qo, kx, vxt, b, h, qi * XA_NQT, c.lane); }
}

__device__ __forceinline__ void phase_expert_weights(const Args& a, const Ctx& c) {
    LAS float* scr = (LAS float*)(c.lds + c.wave * 16384);
    constexpr int I_GU = 16 * 64, I_D = 16 * 32;
    constexpr int NIT = NEXP * (I_GU + I_D);
    for (int it = c.gw; it < NIT; it += c.ngw) {
        if (it < NEXP * I_GU) { const int e = it / I_GU, r = it % I_GU; transpose_item(a.in[20] + (size_t)e * DM * 2048, DM, 2048, (bf16*)(a.ws + WS_WGU), a.in[17], scr, r, c.lane, RowGU{e});     }
        else { const int r2 = it - NEXP * I_GU, e = r2 / I_D, r = r2 % I_D; transpose_item(a.in[22] + (size_t)e * DM * DM, DM, DM, (bf16*)(a.ws + WS_WD), nullptr, scr, r, c.lane, RowId{e * 1024}); }
    }
    __syncthreads();
}
__device__ __forceinline__ void phase_router(const Args& a, const Ctx& c) {
    const bf16* xb = (const bf16*)(a.ws + WS_XBF); const bf16* wr = (const bf16*)(a.ws + WS_WR); const float* ssq2 = (const float*)(a.ws + WS_SSQ2); const float* br = a.in[19];
    int* tope = (int*)(a.ws + WS_TOPE); float* topg = (float*)(a.ws + WS_TOPG); int* topr = (int*)(a.ws + WS_TOPR); unsigned* gcnt = (unsigned*)(a.ws + WS_GCNT);
    LAS unsigned char* lds = c.lds; const int lane = c.lane, w = c.wave, l15 = lane & 15, g = lane >> 4;
    LAS float* LG = (LAS float*)(lds + w * 4096);
    LAS int* LE = (LAS int*)(lds + w * 4096 + 2560);
    LAS unsigned* CNT = (LAS unsigned*)(lds + 32768); LAS unsigned* BASE = CNT + 32;
    for (int it = blockIdx.x; it < NTOK / 128; it += gridDim.x) {
        const int tok0 = it * 128 + w * 16; const int half = tok0 >= HTOK;
        if (c.tid < 32) CNT[c.tid] = 0u;
        f32x4 acc[2] = {(f32x4){0.f, 0.f, 0.f, 0.f}, (f32x4){0.f, 0.f, 0.f, 0.f}};
        const bf16* ap = xb + (size_t)(tok0 + l15) * DM + 8 * g;
#pragma unroll 8
        for (int ks = 0; ks < 32; ++ks) { const bf16x8 af = *(const bf16x8*)(ap + 32 * ks);
#pragma unroll
            for (int nt = 0; nt < 2; ++nt) { const bf16x8 bf = *(const bf16x8*)(wr + (size_t)(16 * nt + l15) * DM + 32 * ks + 8 * g); acc[nt] = mfma16(af, bf, acc[nt]); } }
#pragma unroll
        for (int nt = 0; nt < 2; ++nt)
#pragma unroll
            for (int r = 0; r < 4; ++r) { const int t = 4 * g + r; const float rs = rstd16(ssq2, (size_t)(tok0 + t)); LG[t * 33 + 16 * nt + l15] = acc[nt][r] * rs + br[16 * nt + l15]; }
        LDS_WAIT();
        if (lane < 16) { float v[32];
#pragma unroll
            for (int e = 0; e < 32; ++e) v[e] = LG[lane * 33 + e];
            int se[4]; float sv[4];
#pragma unroll
            for (int k = 0; k < 4; ++k) { float best = -3e38f; int bi = 0;
#pragma unroll
                for (int e = 0; e < 32; ++e) { const bool bt = v[e] > best; best = bt ? v[e] : best; bi = bt ? e : bi; }
                se[k] = bi; sv[k] = best;
#pragma unroll
                for (int e = 0; e < 32; ++e) v[e] = (e == bi) ? -3e38f : v[e]; }
            const float e1 = __expf(sv[1] - sv[0]), e2 = __expf(sv[2] - sv[0]), e3 = __expf(sv[3] - sv[0]); const float inv = 1.f / (1.f + e1 + e2 + e3);
            const int tok = tok0 + lane;
            *(int4*)(tope + (size_t)tok * 4) = make_int4(se[0], se[1], se[2], se[3]);
            *(float4*)(topg + (size_t)tok * 4) = make_float4(inv, e1 * inv, e2 * inv, e3 * inv);
#pragma unroll
            for (int k = 0; k < 4; ++k) LE[lane * 4 + k] = se[k]; }
        __syncthreads();
        const int myE = LE[lane];
        const unsigned lr = atomicAdd((unsigned*)&CNT[myE], 1u);
        __syncthreads();
        if (c.tid < 32) { const unsigned n = CNT[c.tid]; BASE[c.tid] = n ? atomicAdd(gcnt + (half * 32 + c.tid) * 16, n) : 0u; }
        __syncthreads();
        topr[(size_t)(tok0 + (lane >> 2)) * 4 + (lane & 3)] = (int)(BASE[myE] + lr);
        __syncthreads();
    }
}
__device__ __forceinline__ void phase_gather(const Args& a, const Ctx& c, int hb) {
    const bf16* xb = (const bf16*)(a.ws + WS_XBF); bf16* xg = (bf16*)(a.ws + WS_Y); const float* ssq2 = (const float*)(a.ws + WS_SSQ2);
    const int* tope = (const int*)(a.ws + WS_TOPE); const float* topg = (const float*)(a.ws + WS_TOPG); const int* topr = (const int*)(a.ws + WS_TOPR); int* topp = (int*)(a.ws + WS_TOPP);
    float* rgate = (float*)(a.ws + WS_RGATE); float* rrstd = (float*)(a.ws + WS_RRSTD);
    unsigned* blke = (unsigned*)(a.ws + WS_BLKE) + hb * 1024; unsigned* nbt = (unsigned*)(a.ws + WS_NBT) + hb * 64; const unsigned* gcnt = (const unsigned*)(a.ws + WS_GCNT);
    LAS unsigned* BS = (LAS unsigned*)(c.lds); LAS unsigned* CN = BS + 64;
    if (c.tid == 0) { unsigned acc = 0; for (int e = 0; e < 32; ++e) { const unsigned n = ld_agent(gcnt + (hb * 32 + e) * 16); CN[e] = n; BS[e] = acc; acc += (n + 255u) >> 8; } BS[32] = acc; }
    __syncthreads();
    if (blockIdx.x == 0) { if (c.tid == 0) nbt[0] = BS[32];
        for (int e = 0; e < 32; ++e) { const int b0 = BS[e], b1 = BS[e + 1]; for (int b = b0 + c.tid; b < b1; b += 512) blke[b] = (unsigned)e; } }
    for (int i = c.gw; i < HTOK * 4; i += c.ngw) { const int tok = hb * HTOK + (i >> 2), k = i & 3;
        const int e = tope[(size_t)tok * 4 + k]; const int pos = (int)BS[e] * 256 + topr[(size_t)tok * 4 + k];
        const v4u* src = (const v4u*)(xb + (size_t)tok * DM) + c.lane * 2; v4u* dst = (v4u*)(xg + (size_t)pos * DM) + c.lane * 2;
        const v4u v0 = src[0], v1 = src[1]; dst[0] = v0; dst[1] = v1;
        if (c.lane == 0) { rgate[pos] = topg[(size_t)tok * 4 + k]; rrstd[pos] = rstd16(ssq2, (size_t)tok); topp[(size_t)tok * 4 + k] = pos; } }
    for (int e = 0; e < 32; ++e) { const int p0 = (int)BS[e] * 256 + (int)CN[e], p1 = (int)BS[e + 1] * 256;
        for (int p = p0 + c.gw; p < p1; p += c.ngw) { v4u* dst = (v4u*)(xg + (size_t)p * DM) + c.lane * 2; const v4u z = (v4u){0u, 0u, 0u, 0u}; dst[0] = z; dst[1] = z;
            if (c.lane == 0) { rgate[p] = 0.f; rrstd[p] = 0.f; } } }
    __syncthreads();
}
__device__ __forceinline__ void phase_combine(const Args& a, const Ctx& c, int hb) {
    const bf16* y = (const bf16*)(a.ws + WS_Y); const int* topp = (const int*)(a.ws + WS_TOPP); const float* gf = a.in[24];
    for (int i = c.gw; i < HTOK; i += c.ngw) { const int tok = hb * HTOK + i;
        const int4 pp = *(const int4*)(topp + (size_t)tok * 4); const int ps[4] = {pp.x, pp.y, pp.z, pp.w};
        float* xr = a.out + (size_t)tok * DM + c.lane * 16;
        f32x4 v[4];
#pragma unroll
        for (int j = 0; j < 4; ++j) v[j] = *(const f32x4*)(xr + 4 * j);
#pragma unroll
        for (int k = 0; k < 4; ++k) { const v4u* yp = (const v4u*)(y + (size_t)ps[k] * DM + c.lane * 16); const v4u y0 = yp[0], y1 = yp[1];
            v[0][0] += bflo(y0.x); v[0][1] += bfhi(y0.x); v[0][2] += bflo(y0.y); v[0][3] += bfhi(y0.y); v[1][0] += bflo(y0.z); v[1][1] += bfhi(y0.z); v[1][2] += bflo(y0.w); v[1][3] += bfhi(y0.w);
            v[2][0] += bflo(y1.x); v[2][1] += bfhi(y1.x); v[2][2] += bflo(y1.y); v[2][3] += bfhi(y1.y); v[3][0] += bflo(y1.z); v[3][1] += bfhi(y1.z); v[3][2] += bflo(y1.w); v[3][3] += bfhi(y1.w); }
        float s = 0.f;
#pragma unroll
        for (int j = 0; j < 4; ++j) s += (v[j][0] * v[j][0] + v[j][1] * v[j][1]) + (v[j][2] * v[j][2] + v[j][3] * v[j][3]);
        const float rstd = rsqrtf(wave_sum(s) * (1.f / DM) + RMS_EPS);
#pragma unroll
        for (int j = 0; j < 4; ++j) { const f32x4 gg = *(const f32x4*)(gf + c.lane * 16 + 4 * j); *(f32x4*)(xr + 4 * j) = v[j] * rstd * gg; } }
}

#ifndef MK_PER_PHASE_LAUNCH
#define MK_PER_PHASE_LAUNCH 0
#endif
constexpr int NPHASES = 29;
#ifndef MK_OFF
#define MK_OFF 0u
#endif
#define MKP(k) (((MK_OFF >> (k)) & 1u) == 0u)
#define GSCHED PG8_ALIGN, PG8_SP2
typedef const __attribute__((address_space(4))) Args* KArgP;
#if defined(__HIP_DEVICE_COMPILE__)
__device__ __forceinline__ Args ldargs() { KArgP kp = (KArgP)__builtin_amdgcn_kernarg_segment_ptr(); asm volatile("" : "+s"(kp)); Args r; __builtin_memcpy(&r, (const void*)kp, sizeof(Args)); return r; }
#else
__device__ __forceinline__ Args ldargs() { return Args{}; }
#endif
__global__ void __launch_bounds__(512, 2) mk_fwd(Args a_) {
    extern __shared__ __attribute__((aligned(16))) unsigned char lds_raw[];
    Ctx c; c.lds = (LAS unsigned char*)lds_raw; c.tid = threadIdx.x; c.lane = c.tid & 63; c.wave = __builtin_amdgcn_readfirstlane(c.tid >> 6); const int wv = c.wave;
    c.G = gridDim.x; c.gw = blockIdx.x * 8 + c.wave; c.ngw = c.G * 8;
    volatile LAS unsigned* MISC = (volatile LAS unsigned*)(c.lds + MISC_OFF);
    for (int u = c.tid; u < (LDS_BYTES - RING_BYTES) / 4; u += 512) ((LAS unsigned*)(c.lds + RING_BYTES))[u] = 0u;
    __syncthreads();
    const int ph_lo = a_.ph_lo, ph_hi = a_.ph_hi;
    const bool fused = (ph_hi - ph_lo) > 1;
    unsigned* barw = (unsigned*)a_.ws + CW_BAR;
    XcdBarrier bar; bar.bar = barw; bar.x = 0; bar.st = MISC + 8; bar.t0 = wv;
    if (fused) bar = xcd_barrier_post(barw, MISC + 8, wv);
    int pc = 0;
#define PH_ON (pc >= ph_lo && pc < ph_hi)
#define PH_END do { if (PH_ON && pc + 1 < ph_hi) xcd_barrier(bar); ++pc; OPQ(c); } while (0)
    LAS unsigned char* ring = c.lds;
#define OPQ(cc) do { cc.lane = (int)__builtin_amdgcn_mbcnt_hi(~0u, __builtin_amdgcn_mbcnt_lo(~0u, 0u)); asm volatile("" : "+v"(cc.lane)); cc.wave = wv; cc.tid = wv * 64 + cc.lane; cc.gw = blockIdx.x * 8 + wv; } while (0)

    if (MKP(0) && PH_ON) { const Args a = ldargs(); unsigned char* ws = a.ws; (void)ws;  phase_prologue(a, c); __syncthreads(); }
    PH_END;
#pragma unroll
    for (int hb = 0; hb < 2; ++hb) {
        const size_t toff = (size_t)hb * HTOK;
        if (MKP(1) && PH_ON) { const Args a = ldargs(); phase_norm1(a, c, hb); }
        PH_END;
        if (MKP(2) && PH_ON) { const Args a = ldargs(); unsigned char* ws = a.ws; (void)ws;  pg8::Gemm g{(const bf16*)(ws + WS_TM), (const bf16*)(ws + WS_WIN), HTOK, NCOL, DM}; pg8::StaticOrder S; S.init(HTOK, NCOL, c.G, (int)blockIdx.x);
            EpiStore E{(bf16*)(ws + WS_PROJ), NCOL, nullptr}; pg8::gemm_phase<EpiStore, pg8::StaticOrder, GSCHED>(ring, g, S, E, wv); }
        PH_END;
        if (MKP(3) && PH_ON) { const Args a = ldargs(); unsigned char* ws = a.ws; (void)ws;  phase_hgA(a, c); phase_swa(a, c); }
        PH_END;
        if (MKP(4) && PH_ON) { const Args a = ldargs(); phase_hgB(a, c); }
        PH_END;
        if (MKP(5) && PH_ON) { const Args a = ldargs(); phase_hgC(a, c); }
        PH_END;
        if (MKP(6) && PH_ON) { const Args a = ldargs(); unsigned char* ws = a.ws; (void)ws;  pg8::Gemm g{(const bf16*)(ws + WS_OA), (const bf16*)(ws + WS_WA), HTOK, DM, DM}; pg8::StaticOrder S; S.init(HTOK, DM, c.G, (int)blockIdx.x);
            EpiGate<false> E{(bf16*)(ws + WS_TM), (const bf16*)(ws + WS_PROJ), C_GA, a.in[6]}; pg8::gemm_phase<EpiGate<false>, pg8::StaticOrder, GSCHED>(ring, g, S, E, wv); }
        PH_END;
        if (MKP(7) && PH_ON) { const Args a = ldargs(); unsigned char* ws = a.ws; (void)ws;  pg8::Gemm g{(const bf16*)(ws + WS_OB), (const bf16*)(ws + WS_WB), HTOK, DM, DM}; pg8::StaticOrder S; S.init(HTOK, DM, c.G, (int)blockIdx.x);
            EpiGate<true> E{(bf16*)(ws + WS_TM), (const bf16*)(ws + WS_PROJ), C_GB, a.in[6] + DM}; pg8::gemm_phase<EpiGate<true>, pg8::StaticOrder, GSCHED>(ring, g, S, E, wv); }
        PH_END;
        if (MKP(8) && PH_ON) { const Args a = ldargs(); unsigned char* ws = a.ws; (void)ws;  pg8::Gemm g{(const bf16*)(ws + WS_TM), (const bf16*)(ws + WS_WMIX), HTOK, DM, DM}; pg8::StaticOrder S; S.init(HTOK, DM, c.G, (int)blockIdx.x);
            EpiResid E{a.in[0] + toff * DM, a.out + toff * DM, (bf16*)(ws + WS_XBF) + toff * DM, (float*)(ws + WS_SSQ1) + toff * 16}; pg8::gemm_phase<EpiResid, pg8::StaticOrder, GSCHED>(ring, g, S, E, wv); }
        PH_END;
    }
    if (MKP(9) && PH_ON) { const Args a = ldargs(); unsigned char* ws = a.ws; (void)ws;
        phase_expert_weights(a, c);
        { pg8::Gemm g{(const bf16*)(ws + WS_MEMBF), (const bf16*)(ws + WS_WK), NBATCH * MEMLEN, DM, DM}; pg8::StaticOrder S; S.init(NBATCH * MEMLEN, DM, c.G, (int)blockIdx.x);
          EpiStore E{(bf16*)(ws + WS_KX), DM, nullptr}; pg8::gemm_phase<EpiStore, pg8::StaticOrder, GSCHED>(ring, g, S, E, wv); }
        { pg8::Gemm g{(const bf16*)(ws + WS_WV), (const bf16*)(ws + WS_MEMBF), DM, NBATCH * MEMLEN, DM}; pg8::StaticOrder S; S.init(DM, NBATCH * MEMLEN, c.G, (int)((blockIdx.x + 64) % c.G));
          EpiStore E{(bf16*)(ws + WS_VXT), NBATCH * MEMLEN, nullptr}; pg8::gemm_phase<EpiStore, pg8::StaticOrder, GSCHED>(ring, g, S, E, wv); }
        { pg8::Gemm g{(const bf16*)(ws + WS_XBF), (const bf16*)(ws + WS_WQ), NTOK, DM, DM}; pg8::StaticOrder S; S.init(NTOK, DM, c.G, (int)blockIdx.x);
          EpiStore E{(bf16*)(ws + WS_Q), DM, (const float*)(ws + WS_SSQ1)}; pg8::gemm_phase<EpiStore, pg8::StaticOrder, GSCHED>(ring, g, S, E, wv); }
    }
    PH_END;
    if (MKP(10) && PH_ON) { const Args a = ldargs(); phase_xa(a, c); }
    PH_END;
    if (MKP(11) && PH_ON) { const Args a = ldargs(); unsigned char* ws = a.ws; (void)ws;  pg8::Gemm g{(const bf16*)(ws + WS_Q), (const bf16*)(ws + WS_WO), NTOK, DM, DM}; pg8::StaticOrder S; S.init(NTOK, DM, c.G, (int)blockIdx.x);
        EpiResid E{a.out, a.out, (bf16*)(ws + WS_XBF), (float*)(ws + WS_SSQ2)}; pg8::gemm_phase<EpiResid, pg8::StaticOrder, GSCHED>(ring, g, S, E, wv); }
    PH_END;
    if (MKP(12) && PH_ON) { const Args a = ldargs(); phase_router(a, c); }
    PH_END;
#pragma unroll
    for (int hb = 0; hb < 2; ++hb) {
        if (MKP(13) && PH_ON) { const Args a = ldargs(); phase_gather(a, c, hb); }
        PH_END;
        if (MKP(14) && PH_ON) { const Args a = ldargs(); unsigned char* ws = a.ws; (void)ws;  const int nb = (int)__builtin_amdgcn_readfirstlane(ld_agent((const unsigned*)(ws + WS_NBT) + hb * 64));
            pg8::Gemm g{(const bf16*)(ws + WS_Y), (const bf16*)(ws + WS_WGU), CAPH, NEXP * 2048, DM}; GroupedOrder S{nb * 8, 8, c.G, (int)blockIdx.x, (const unsigned*)(ws + WS_BLKE) + hb * 1024};
            EpiSwiglu E{(bf16*)(ws + WS_ACT), a.in[21], (const float*)(ws + WS_RRSTD)}; pg8::gemm_phase<EpiSwiglu, GroupedOrder, GSCHED>(ring, g, S, E, wv); }
        PH_END;
        if (MKP(15) && PH_ON) { const Args a = ldargs(); unsigned char* ws = a.ws; (void)ws;  const int nb = (int)__builtin_amdgcn_readfirstlane(ld_agent((const unsigned*)(ws + WS_NBT) + hb * 64));
            pg8::Gemm g{(const bf16*)(ws + WS_ACT), (const bf16*)(ws + WS_WD), CAPH, NEXP * 1024, DM}; GroupedOrder S{nb * 4, 4, c.G, (int)blockIdx.x, (const unsigned*)(ws + WS_BLKE) + hb * 1024};
            EpiDown E{(bf16*)(ws + WS_Y), a.in[23], (const float*)(ws + WS_RGATE)}; pg8::gemm_phase<EpiDown, GroupedOrder, GSCHED>(ring, g, S, E, wv); }
        PH_END;
        if (MKP(16) && PH_ON) { const Args a = ldargs(); phase_combine(a, c, hb); }
        PH_END;
    }
#undef PH_ON
#undef PH_END
}

#if defined(MK_DBG_STOP)
#ifndef MK_DBG_SRC_OUT
#define MK_DBG_SRC_OUT 0
#endif
#ifndef MK_DBG_F32
#define MK_DBG_F32 0
#endif
__global__ void dbg_dump(const unsigned short* src, float* out, size_t n, size_t N) {
    for (size_t i = (size_t)blockIdx.x * blockDim.x + threadIdx.x; i < N; i += (size_t)gridDim.x * blockDim.x) {
        if (i < n) { float v = MK_DBG_F32 ? ((const float*)src)[i] : __builtin_bit_cast(float, (unsigned)src[i] << 16); if (!(fabsf(v) < 1e30f)) v = 12345.f; out[i] = v; }
        else if (!MK_DBG_SRC_OUT) out[i] = 0.f;
    }
}
__global__ void dbg_zero_upper(float* out, size_t n0, size_t N) { for (size_t i = n0 + (size_t)blockIdx.x * blockDim.x + threadIdx.x; i < N; i += (size_t)gridDim.x * blockDim.x) out[i] = 0.f; }
#endif
extern "C" void kernel_launch(void* const* d_in, const int* in_sizes, int n_in, void* d_out, int out_size, void* d_ws, size_t ws_size, hipStream_t stream) {
    static int grid = 0;
    if (grid == 0) {
        if (n_in != 25 || out_size != NTOK * DM || ws_size < WS_END) { fprintf(stderr, "kernel_launch: unexpected problem shape (n_in %d, out %d, ws %zu); nothing launched\n", n_in, out_size, ws_size); grid = -1; return; }
        int dev = 0, cus = 0, per_cu = 0;
        if (hipGetDevice(&dev) != hipSuccess || hipDeviceGetAttribute(&cus, hipDeviceAttributeMultiprocessorCount, dev) != hipSuccess) { grid = -1; return; }
        if (hipFuncSetAttribute((const void*)mk_fwd, hipFuncAttributeMaxDynamicSharedMemorySize, LDS_BYTES) != hipSuccess) { fprintf(stderr, "kernel_launch: hipFuncSetAttribute failed\n"); grid = -1; return; }
        if (hipOccupancyMaxActiveBlocksPerMultiprocessor(&per_cu, (const void*)mk_fwd, 512, LDS_BYTES) != hipSuccess || per_cu < 1) { fprintf(stderr, "kernel_launch: occupancy query reports %d blocks per CU\n", per_cu); }
        (void)hipGetLastError();
        grid = cus;
    }
    if (grid < 0) return;
    (void)in_sizes;
    hipMemsetAsync(d_ws, 0, WS_ZERO_BYTES, stream);
    Args a{};
    for (int i = 0; i < 25; ++i) a.in[i] = (const float*)d_in[i];
    a.out = (float*)d_out; a.ws = (unsigned char*)d_ws;
#if defined(MK_DBG_STOP)
    for (int p = 0; p < MK_DBG_STOP; ++p) { a.ph_lo = p; a.ph_hi = p + 1; hipLaunchKernelGGL(mk_fwd, dim3(grid), dim3(512), LDS_BYTES, stream, a); }
    hipLaunchKernelGGL(dbg_dump, dim3(2048), dim3(256), 0, stream, (const unsigned short*)((const unsigned char*)(MK_DBG_SRC_OUT ? d_out : d_ws) + (size_t)MK_DBG_OFF_MIB * MiB), (float*)d_out, (size_t)MK_DBG_MIB * MiB / (MK_DBG_F32 ? 4 : 2), (size_t)NTOK * DM);
    if (MK_DBG_SRC_OUT) hipLaunchKernelGGL(dbg_zero_upper, dim3(2048), dim3(256), 0, stream, (float*)d_out, (size_t)MK_DBG_MIB * MiB / 2, (size_t)NTOK * DM);
#elif MK_PER_PHASE_LAUNCH
    for (int p = 0; p < NPHASES; ++p) { a.ph_lo = p; a.ph_hi = p + 1; hipLaunchKernelGGL(mk_fwd, dim3(grid), dim3(512), LDS_BYTES, stream, a); }
#else
    a.ph_lo = 0; a.ph_hi = NPHASES;
    hipLaunchKernelGGL(mk_fwd, dim3(grid), dim3(512), LDS_BYTES, stream, a);
#endif
}
```

```cpp
#include <hip/hip_runtime.h>
#include <cstdio>
#include <cstdint>
namespace pg8 {
#define PG8_LAS __attribute__((address_space(3)))
typedef unsigned short bf16_t;
typedef short bf16x8 __attribute__((ext_vector_type(8)));
typedef float f32x4 __attribute__((ext_vector_type(4)));
typedef unsigned u32x4 __attribute__((ext_vector_type(4)));
constexpr int BM = 256, BK = 64, HALF = 128, HTB = HALF * BK * 2  , STAGE_BYTES = 8 * HTB, NXCD = 8, WGM = 8;

__host__ __device__ __forceinline__ int lds_byte(int r, int c) { const int st = (r >> 4) * 2 + (c >> 5), rr = r & 15, cc = c & 31, ob = rr * 64 + cc * 2; return st * 1024 + (ob ^ (((ob >> 9) & 1) << 5)); }
__host__ __device__ __forceinline__ void stage_rc(int b, int& R, int& C) { const int st = b / 1024, sb = b % 1024, swz = sb ^ (((sb >> 9) & 1) << 5); R = (st >> 1) * 16 + swz / 64; C = (st & 1) * 32 + (swz % 64) / 2; }
__host__ __device__ __forceinline__ int perm32(int rho) { const int n = rho >> 4, i = rho & 15; return 8 * (i >> 2) + 4 * n + (i & 3); }

struct Unit { int pm, pn; };
struct Gemm { const bf16_t* A; const bf16_t* Bt; int M, N, K; };

struct StaticOrder {
    int nM, nN, nwg, G, c;
    __host__ __device__ void init(int M, int N, int G_, int c_) { nM = M / BM; nN = N / BM; nwg = nM * nN; G = G_; c = c_; }
    __host__ __device__ bool next(int i, Unit& u) const {
        const long L = (long)i * G + c; if (L >= nwg) return false;
        int wgid = (int)L; { const int q = nwg / NXCD, r = nwg % NXCD, xcd = wgid % NXCD, off = wgid / NXCD; wgid = (xcd < r ? xcd * (q + 1) : r * (q + 1) + (xcd - r) * q) + off; }
        const int nig = WGM * nN, gid = wgid / nig, fm = gid * WGM, gsz = (nM - fm) < WGM ? (nM - fm) : WGM;
        u.pm = fm + ((wgid % nig) % gsz); u.pn = (wgid % nig) / gsz; return true;
    }
    __device__ __forceinline__ void a_ready(const Unit&) const {}
    __device__ __forceinline__ void done(const Unit&) const {}
};

__device__ __forceinline__ unsigned cvt_pk_bf16(float lo, float hi) { unsigned r; asm volatile("v_cvt_pk_bf16_f32 %0, %1, %2" : "=v"(r) : "v"(lo), "v"(hi)); return r; }
typedef float f32x2 __attribute__((ext_vector_type(2)));
template <class Epi, class Sched, bool ALIGN_EPI = false, bool SP2 = false>
__device__ __forceinline__ void gemm_phase(PG8_LAS unsigned char* lds, const Gemm g, const Sched& S, const Epi& E, const int wave_in) {
    int tid_ = (int)__builtin_amdgcn_mbcnt_hi(~0u, __builtin_amdgcn_mbcnt_lo(~0u, 0u)) + 64 * wave_in; asm volatile("" : "+v"(tid_));
    const int tid = tid_, wid = __builtin_amdgcn_readfirstlane(tid >> 6), lane = tid & 63, wr = wid >> 2, wc = wid & 3, fr = lane & 15, fq = lane >> 4;
    const int K = g.K, nt = K / BK;
    unsigned voffA[2], voffB[2];
#pragma unroll
    for (int i = 0; i < 2; ++i) { int R, C; stage_rc(tid * 16 + i * 8192, R, C); const int Rb = Epi::PERM ? ((R & ~31) + perm32(R & 31)) : R;
        voffA[i] = (unsigned)(R * K + C) * 2u; voffB[i] = (unsigned)(Rb * K + C) * 2u; }
    const size_t kstep = (size_t)(BK * 2);
    const size_t hstep = (size_t)HALF * K * 2;
    const size_t tstep = 2 * hstep;
    const unsigned ldsw = (unsigned)wid * 1024u;
    const int aoff = lds_byte(wr * 64 + fr, fq * 8), boff = lds_byte(wc * 32 + fr, fq * 8);
#define PG8_SA(b, h) (((b) * 2 + (h)) * HTB)
#define PG8_SB(b, h) ((4 + (b) * 2 + (h)) * HTB)
#define PG8_STAGE(bufoff, gbase, voff) do { _Pragma("unroll") for (int _i = 0; _i < 2; ++_i) \
        __builtin_amdgcn_global_load_lds((const unsigned*)((const char*)(gbase) + (voff)[_i]), (PG8_LAS unsigned*)(lds + (bufoff) + ldsw + _i * 8192), 16, 0, 0); } while (0)
#define PG8_LDA(dst, b, h) do { _Pragma("unroll") for (int m = 0; m < 4; ++m) _Pragma("unroll") for (int k = 0; k < 2; ++k) dst[m][k] = *(const PG8_LAS bf16x8*)(lds + PG8_SA(b, h) + aoff + m * 2048 + k * 1024); } while (0)
#define PG8_LDB(dst, b, h) do { _Pragma("unroll") for (int n = 0; n < 2; ++n) _Pragma("unroll") for (int k = 0; k < 2; ++k) dst[n][k] = *(const PG8_LAS bf16x8*)(lds + PG8_SB(b, h) + boff + n * 2048 + k * 1024); } while (0)
#define PG8_MMA(ai, bj, At, Bt) do { __builtin_amdgcn_s_setprio(1); _Pragma("unroll") for (int m = 0; m < 4; ++m) _Pragma("unroll") for (int n = 0; n < 2; ++n) _Pragma("unroll") for (int k = 0; k < 2; ++k) \
        acc[ai][bj][m][n] = __builtin_amdgcn_mfma_f32_16x16x32_bf16(Bt[n][k], At[m][k], acc[ai][bj][m][n], 0, 0, 0); __builtin_amdgcn_s_setprio(0); } while (0)
#define PG8_WAIT_V(n) asm volatile("s_waitcnt vmcnt(" #n ")" ::: "memory")
#define PG8_WAIT_L(n) asm volatile("s_waitcnt lgkmcnt(" #n ")" ::: "memory")
#define PG8_BAR __builtin_amdgcn_s_barrier()
#define PG8_SCHED __builtin_amdgcn_sched_barrier(0)
    Unit cur, nxt; int ui = 0;
    if (!S.next(0, cur)) return;
    f32x4 acc[2][2][4][2];
#pragma unroll
    for (int a = 0; a < 2; ++a)
#pragma unroll
        for (int b = 0; b < 2; ++b)
#pragma unroll
            for (int m = 0; m < 4; ++m)
#pragma unroll
                for (int n = 0; n < 2; ++n) acc[a][b][m][n] = (f32x4){0.f, 0.f, 0.f, 0.f};
    bf16x8 At[4][2], B0[2][2], B1[2][2];
    const char* cA = (const char*)g.A + (size_t)cur.pm * tstep; const char* cB = (const char*)g.Bt + (size_t)cur.pn * tstep;
    S.a_ready(cur);
    if constexpr (SP2) {
        PG8_STAGE(PG8_SB(0, 0), cB, voffB); PG8_STAGE(PG8_SB(0, 1), cB + hstep, voffB); PG8_STAGE(PG8_SA(0, 0), cA, voffA); PG8_STAGE(PG8_SA(0, 1), cA + hstep, voffA);
        if (wr == 1) PG8_BAR;
        PG8_WAIT_V(2); PG8_BAR;
        PG8_STAGE(PG8_SB(1, 0), cB + kstep, voffB); PG8_STAGE(PG8_SA(1, 0), cA + kstep, voffA); PG8_STAGE(PG8_SB(1, 1), cB + hstep + kstep, voffB);
        PG8_WAIT_V(6); PG8_BAR;
    } else {
        PG8_STAGE(PG8_SB(0, 0), cB, voffB); PG8_STAGE(PG8_SA(0, 0), cA, voffA); PG8_STAGE(PG8_SB(0, 1), cB + hstep, voffB); PG8_STAGE(PG8_SA(0, 1), cA + hstep, voffA);
        if (wr == 1) PG8_BAR;
        PG8_WAIT_V(4); PG8_BAR;
        PG8_STAGE(PG8_SB(1, 0), cB + kstep, voffB); PG8_STAGE(PG8_SA(1, 0), cA + kstep, voffA); PG8_STAGE(PG8_SB(1, 1), cB + hstep + kstep, voffB);
        PG8_WAIT_V(6); PG8_BAR;
    }
    for (;;) {
        const bool has_next = S.next(ui + 1, nxt);
        const char* nA = has_next ? (const char*)g.A + (size_t)nxt.pm * tstep : cA; const char* nB = has_next ? (const char*)g.Bt + (size_t)nxt.pn * tstep : cB;
        for (int t = 0; t < nt; t += 2) {
            const bool last = (t == nt - 2);
            const char* a1 = cA + (size_t)(t + 1) * kstep;
            const char* a2 = last ? nA : cA + (size_t)(t + 2) * kstep; const char* b2 = last ? nB : cB + (size_t)(t + 2) * kstep;
            const char* a3 = a2 + kstep; const char* b3 = b2 + kstep;
            if (last && has_next) S.a_ready(nxt);
            if constexpr (SP2) {
            PG8_LDB(B0, 0, 0); PG8_LDB(B1, 0, 1); PG8_SCHED; PG8_LDA(At, 0, 0); PG8_STAGE(PG8_SA(1, 1), a1 + hstep, voffA);
            PG8_WAIT_V(8); PG8_WAIT_L(0); PG8_BAR; PG8_MMA(0, 0, At, B0); PG8_MMA(0, 1, At, B1); PG8_BAR; PG8_SCHED;
            PG8_LDA(At, 0, 1); PG8_STAGE(PG8_SB(0, 0), b2, voffB); PG8_STAGE(PG8_SB(0, 1), b2 + hstep, voffB); PG8_STAGE(PG8_SA(0, 0), a2, voffA);
            PG8_WAIT_V(8); PG8_WAIT_L(0); PG8_BAR; PG8_MMA(1, 0, At, B0); PG8_MMA(1, 1, At, B1); PG8_BAR; PG8_SCHED;
            PG8_LDB(B0, 1, 0); PG8_LDB(B1, 1, 1); PG8_SCHED; PG8_LDA(At, 1, 0); PG8_STAGE(PG8_SA(0, 1), a2 + hstep, voffA);
            PG8_WAIT_V(8); PG8_WAIT_L(0); PG8_BAR; PG8_MMA(0, 0, At, B0); PG8_MMA(0, 1, At, B1); PG8_BAR; PG8_SCHED;
            PG8_LDA(At, 1, 1); PG8_STAGE(PG8_SB(1, 0), b3, voffB); PG8_STAGE(PG8_SB(1, 1), b3 + hstep, voffB); PG8_STAGE(PG8_SA(1, 0), a3, voffA);
            PG8_WAIT_V(8); PG8_WAIT_L(0); PG8_BAR; PG8_MMA(1, 0, At, B0); PG8_MMA(1, 1, At, B1); PG8_BAR; PG8_SCHED;
            } else {
            PG8_LDB(B0, 0, 0); PG8_SCHED; PG8_LDA(At, 0, 0); PG8_STAGE(PG8_SA(1, 1), a1 + hstep, voffA);
            PG8_WAIT_L(8); PG8_BAR; PG8_WAIT_L(0); PG8_MMA(0, 0, At, B0); PG8_BAR; PG8_SCHED;
            PG8_LDB(B1, 0, 1); PG8_STAGE(PG8_SB(0, 0), b2, voffB);
            PG8_BAR; PG8_WAIT_L(0); PG8_MMA(0, 1, At, B1); PG8_BAR;
            PG8_LDA(At, 0, 1); PG8_STAGE(PG8_SA(0, 0), a2, voffA);
            PG8_BAR; PG8_WAIT_L(0); PG8_MMA(1, 0, At, B0); PG8_BAR; PG8_SCHED;
            PG8_STAGE(PG8_SB(0, 1), b2 + hstep, voffB);
            PG8_WAIT_V(6); PG8_BAR; PG8_MMA(1, 1, At, B1); PG8_BAR;
            PG8_LDB(B0, 1, 0); PG8_SCHED; PG8_LDA(At, 1, 0); PG8_STAGE(PG8_SA(0, 1), a2 + hstep, voffA);
            PG8_WAIT_L(8); PG8_BAR; PG8_WAIT_L(0); PG8_MMA(0, 0, At, B0); PG8_BAR; PG8_SCHED;
            PG8_LDB(B1, 1, 1); PG8_STAGE(PG8_SB(1, 0), b3, voffB);
            PG8_BAR; PG8_WAIT_L(0); PG8_MMA(0, 1, At, B1); PG8_BAR;
            PG8_LDA(At, 1, 1); PG8_STAGE(PG8_SA(1, 0), a3, voffA);
            PG8_BAR; PG8_WAIT_L(0); PG8_MMA(1, 0, At, B0); PG8_BAR; PG8_SCHED;
            PG8_STAGE(PG8_SB(1, 1), b3 + hstep, voffB);
            PG8_WAIT_V(6); PG8_BAR; PG8_MMA(1, 1, At, B1); PG8_BAR;
            }
        }
        if constexpr (ALIGN_EPI) { if (wr == 0) PG8_BAR; }
        if constexpr (!Epi::AFTER_DRAIN) { E(acc, cur, wr, wc, fr, fq); S.done(cur); }
        if (!has_next) break;
#pragma unroll
        for (int a = 0; a < 2; ++a)
#pragma unroll
            for (int b = 0; b < 2; ++b)
#pragma unroll
                for (int m = 0; m < 4; ++m)
#pragma unroll
                    for (int n = 0; n < 2; ++n) acc[a][b][m][n] = (f32x4){0.f, 0.f, 0.f, 0.f};
        cur = nxt; cA = nA; cB = nB; ++ui;
        if constexpr (ALIGN_EPI) { if (wr == 1) PG8_BAR; }
    }
    PG8_WAIT_V(0);
    if constexpr (!ALIGN_EPI) { if (wr == 0) PG8_BAR; }
    PG8_BAR;
    if constexpr (Epi::AFTER_DRAIN) { E.fused(acc, cur, wr, wc, fr, fq, lds, wid, lane); S.done(cur); }
#undef PG8_SA
#undef PG8_SB
#undef PG8_STAGE
#undef PG8_LDA
#undef PG8_LDB
#undef PG8_MMA
#undef PG8_WAIT_V
#undef PG8_WAIT_L
#undef PG8_BAR
#undef PG8_SCHED
}
}

#ifndef PG8_SP2
#define PG8_SP2 true
#endif
#ifndef PG8_ALIGN
#define PG8_ALIGN true
#endif

constexpr int NTOK = 65536, DM = 1024, NCOL = 7680, SEQ = 4096, NBATCH = 16, HTOK = 32768, MEMLEN = 256;
constexpr int C_HQ = 0, C_HF = 1024, C_HI = 2048, C_HG = 3072, C_SQ = 4096, C_SK = 5120, C_SV = 5376, C_GA = 5632, C_GB = 6656;
constexpr int NEXP = 32, TOPK = 4, CAPH = HTOK * TOPK + NEXP * 256;
constexpr float RMS_EPS = 1e-5f;
constexpr size_t MiB = (size_t)1 << 20;
constexpr size_t WS_ZERO_BYTES = 2 * MiB;
constexpr size_t WS_GCNT = 1 * MiB;
constexpr int CW_TMO = 0, CW_BAR = 4096;
constexpr size_t WS_LB = 2 * MiB, WS_LUT = 2 * MiB + 4096, WS_BLKE = 2 * MiB + 16384, WS_NBT = 2 * MiB + 32768;
constexpr size_t WS_TOPE = 3 * MiB, WS_TOPG = 4 * MiB, WS_TOPR = 5 * MiB, WS_TOPP = 6 * MiB, WS_RGATE = 7 * MiB, WS_RRSTD = 8 * MiB, WS_D12 = 10 * MiB;
constexpr size_t WS_WIN = 16 * MiB, WS_WA = 31 * MiB, WS_WB = 33 * MiB, WS_WMIX = 35 * MiB, WS_WQ = 37 * MiB, WS_WK = 39 * MiB, WS_WV = 41 * MiB, WS_WO = 43 * MiB, WS_WR = 45 * MiB;
constexpr size_t WS_MEMBF = 46 * MiB, WS_KX = 54 * MiB, WS_VXT = 62 * MiB;
constexpr size_t WS_XBF = 72 * MiB;
constexpr size_t WS_PROJ = 200 * MiB, WS_OA = 680 * MiB, WS_OB = 744 * MiB, WS_TM = 808 * MiB;
constexpr size_t WS_Q = 664 * MiB, WS_O = 792 * MiB;
constexpr size_t WS_WGU = 200 * MiB, WS_WD = 328 * MiB, WS_ACT = 392 * MiB, WS_Y = 664 * MiB, WS_SSQ1 = 936 * MiB, WS_SSQ2 = 940 * MiB, WS_END = 944 * MiB;
constexpr size_t OUT_US = 128 * MiB;

#define GAS __attribute__((address_space(1)))
#define LAS __attribute__((address_space(3)))
typedef unsigned short bf16;
typedef unsigned v4u __attribute__((ext_vector_type(4)));
typedef unsigned v2u __attribute__((ext_vector_type(2)));
typedef float f32x4 __attribute__((ext_vector_type(4)));
typedef short bf16x8 __attribute__((ext_vector_type(8)));
typedef short s16x4 __attribute__((ext_vector_type(4)));
#define RLX_AGENT __ATOMIC_RELAXED, __HIP_MEMORY_SCOPE_AGENT
#define LDS_WAIT() asm volatile("s_waitcnt lgkmcnt(0)" ::: "memory")
#define CFENCE() asm volatile("" ::: "memory")
__device__ __forceinline__ unsigned f2bf(float f) { unsigned u = __builtin_bit_cast(unsigned, f); return (u + 0x7fffu + ((u >> 16) & 1u)) >> 16; }
typedef float f32x2_t __attribute__((ext_vector_type(2))); typedef __bf16 bf16x2_t __attribute__((ext_vector_type(2)));
__device__ __forceinline__ unsigned pk2(float lo, float hi) { f32x2_t v = {lo, hi}; bf16x2_t b = __builtin_convertvector(v, bf16x2_t); return __builtin_bit_cast(unsigned, b); }
__device__ __forceinline__ float bflo(unsigned w) { return __builtin_bit_cast(float, w << 16); }
__device__ __forceinline__ float bfhi(unsigned w) { return __builtin_bit_cast(float, w & 0xffff0000u); }
__device__ __forceinline__ float sigm(float x) { return 1.f / (1.f + __expf(-x)); }
__device__ __forceinline__ float wave_sum(float v) {
#pragma unroll
    for (int o = 1; o < 64; o <<= 1) v += __shfl_xor(v, o);
    return v;
}
__device__ __forceinline__ f32x4 mfma16(bf16x8 a, bf16x8 b, f32x4 c) { return __builtin_amdgcn_mfma_f32_16x16x32_bf16(a, b, c, 0, 0, 0); }
__device__ __forceinline__ s16x4 vtr(const LAS unsigned char* p) { return __builtin_bit_cast(s16x4, __builtin_amdgcn_ds_read_tr16_b64_v4i16((LAS s16x4*)p)); }
__device__ __forceinline__ bf16x8 cat8(s16x4 lo, s16x4 hi) { return __builtin_shufflevector(lo, hi, 0, 1, 2, 3, 4, 5, 6, 7); }
__device__ __forceinline__ bf16x8 pack8(f32x4 a, f32x4 b) { v4u w; w.x = pk2(a[0], a[1]); w.y = pk2(a[2], a[3]); w.z = pk2(b[0], b[1]); w.w = pk2(b[2], b[3]); return __builtin_bit_cast(bf16x8, w); }
__device__ __forceinline__ float rstd16(const float* ssqp, size_t row) { const f32x4* p = (const f32x4*)(ssqp + row * 16); const f32x4 a = p[0], b = p[1], c = p[2], d = p[3];
    const float s = ((a[0] + a[1]) + (a[2] + a[3])) + ((b[0] + b[1]) + (b[2] + b[3])) + ((c[0] + c[1]) + (c[2] + c[3])) + ((d[0] + d[1]) + (d[2] + d[3])); return rsqrtf(s * (1.f / 1024.f) + 1e-5f); }
__device__ __forceinline__ unsigned ld_agent(const unsigned* p) { return __hip_atomic_load(p, RLX_AGENT); }


#define XB_TMO      128
#define XB_XCNT(j)  (256  + 64 * (j))
#define XB_XSUB(j)  (1280 + 64 * (j))
#define XB_XGEN(j)  (2304 + 64 * (j))
#define XB_TOP      3328
#define XB_TOPGEN   3392
#define XCD_BAR_WORDS 3456
#define XB_SPIN_CAP (1u << 18)

__device__ __forceinline__ unsigned xb_ld(unsigned* p)              { return __hip_atomic_load(p, __ATOMIC_RELAXED, __HIP_MEMORY_SCOPE_AGENT); }
__device__ __forceinline__ unsigned xb_add(unsigned* p, unsigned v) { return __hip_atomic_fetch_add(p, v, __ATOMIC_RELAXED, __HIP_MEMORY_SCOPE_AGENT); }
__device__ __forceinline__ unsigned xb_xcc_id() { return (unsigned)__builtin_amdgcn_s_getreg((3 << 11) | 20) & 0xFu; }
#define XB_SPIN(cond, bar) do { unsigned _sp = 0; while (cond) { __builtin_amdgcn_s_sleep(1); \
    if ((++_sp & 255u) == 0u) { if (xb_ld(&(bar)[XB_TMO])) break; if (_sp > XB_SPIN_CAP) { atomicAdd(&(bar)[XB_TMO], 1u); break; } } } } while (0)

struct XcdBarrier {
    unsigned* bar; unsigned x; int t0;
    volatile LAS unsigned* st;
};

__device__ __forceinline__ bool xb_is_t0(int wave) { return wave == 0 && __builtin_amdgcn_mbcnt_hi(~0u, __builtin_amdgcn_mbcnt_lo(~0u, 0u)) == 0u; }
__device__ __forceinline__ XcdBarrier xcd_barrier_post(unsigned* bar, volatile LAS unsigned* st, int wave) {
    XcdBarrier b; b.bar = bar; b.x = xb_xcc_id(); b.st = st; b.t0 = wave;
    if (xb_is_t0(wave)) (void)xb_add(&bar[XB_XCNT(b.x)], 1u);
    return b;
}
__device__ __forceinline__ void xcd_barrier_complete(unsigned* bar, unsigned x, unsigned& nloc, unsigned& nx) {
    const unsigned G = gridDim.x * gridDim.y * gridDim.z;
    unsigned sum, cnt, mine, sp = 0u;
    for (;;) {
        sum = 0u; cnt = 0u; mine = 0u;
#pragma unroll
        for (unsigned j = 0; j < 16; ++j) { const unsigned c = xb_ld(&bar[XB_XCNT(j)]); sum += c; cnt += (c > 0u) ? 1u : 0u; mine = (j == x) ? c : mine; }
        if (sum == G) break;
        __builtin_amdgcn_s_sleep(1);
        if ((++sp & 255u) == 0u) { if (xb_ld(&bar[XB_TMO])) break; if (sp > XB_SPIN_CAP) { atomicAdd(&bar[XB_TMO], 1u); break; } }
    }
    nloc = mine > 0u ? mine : 1u; nx = cnt > 0u ? cnt : 1u;
}

__device__ __forceinline__ void xcd_barrier(const XcdBarrier& b) {
    asm volatile("s_waitcnt vmcnt(0)" ::: "memory");
    __syncthreads();
    if (xb_is_t0(b.t0)) {
        unsigned* bar = b.bar;
        __builtin_amdgcn_s_waitcnt(0);
        unsigned nloc = b.st[0], nx = b.st[1];
        if (nloc == 0u) { xcd_barrier_complete(bar, b.x, nloc, nx); b.st[0] = nloc; b.st[1] = nx; }
        const unsigned old = xb_add(&bar[XB_XSUB(b.x)], 1u);
        const unsigned gen = old / nloc;
        if (old + 1u == (gen + 1u) * nloc) {
            __builtin_amdgcn_fence(__ATOMIC_RELEASE, "agent");
            asm volatile("s_waitcnt vmcnt(0)" ::: "memory");
            const unsigned og = xb_add(&bar[XB_TOP], 1u);
            const unsigned tg = og / nx;
            if (og + 1u == (tg + 1u) * nx) xb_add(&bar[XB_TOPGEN], 1u);
            else XB_SPIN(xb_ld(&bar[XB_TOPGEN]) == tg, bar);
            __builtin_amdgcn_fence(__ATOMIC_ACQUIRE, "agent");
            xb_add(&bar[XB_XGEN(b.x)], 1u);
            asm volatile("s_waitcnt vmcnt(0)" ::: "memory");
        } else {
            XB_SPIN(xb_ld(&bar[XB_XGEN(b.x)]) == gen, bar);
            __builtin_amdgcn_fence(__ATOMIC_ACQUIRE, "agent");
            asm volatile("s_waitcnt vmcnt(0)" ::: "memory");
        }
    }
    __syncthreads();
}

struct Args {
    const float* in[25];
    float* out; unsigned char* ws;
    int ph_lo, ph_hi;
};

using pg8::Unit;
struct EpiStore {
    static constexpr bool PERM = true, AFTER_DRAIN = false;
    bf16* O; int ldc; const float* ssq;
    __device__ __forceinline__ void operator()(const f32x4 (&acc)[2][2][4][2], const Unit& u, int wr, int wc, int fr, int fq) const {
        const int row0 = u.pm * 256 + wr * 64 + fr, col0 = u.pn * 256 + wc * 32 + 8 * fq;
#pragma unroll
        for (int ai = 0; ai < 2; ++ai)
#pragma unroll
            for (int m = 0; m < 4; ++m) { const int row = row0 + ai * 128 + m * 16; float sc = 1.f; if (ssq) sc = rstd16(ssq, (size_t)row);
                bf16* rowp = O + (size_t)row * ldc + col0;
#pragma unroll
                for (int bj = 0; bj < 2; ++bj) { const f32x4 v0 = acc[ai][bj][m][0] * sc, v1 = acc[ai][bj][m][1] * sc;
                    v4u w; w.x = pk2(v0[0], v0[1]); w.y = pk2(v0[2], v0[3]); w.z = pk2(v1[0], v1[1]); w.w = pk2(v1[2], v1[3]);
                    *(v4u*)(rowp + bj * 128) = w; } }
    }
};
template <bool ADD> struct EpiGate {
    static constexpr bool PERM = true, AFTER_DRAIN = false;
    bf16* T; const bf16* proj; int gcol; const float* bias;
    __device__ __forceinline__ void operator()(const f32x4 (&acc)[2][2][4][2], const Unit& u, int wr, int wc, int fr, int fq) const {
        const int row0 = u.pm * 256 + wr * 64 + fr, col0 = u.pn * 256 + wc * 32 + 8 * fq;
        f32x4 bv[2][2];
#pragma unroll
        for (int bj = 0; bj < 2; ++bj)
#pragma unroll
            for (int n = 0; n < 2; ++n) bv[bj][n] = *(const f32x4*)(bias + col0 + bj * 128 + 4 * n);
#pragma unroll
        for (int ai = 0; ai < 2; ++ai)
#pragma unroll
            for (int m = 0; m < 4; ++m) { const int row = row0 + ai * 128 + m * 16;
#pragma unroll
                for (int bj = 0; bj < 2; ++bj) {
                    const v4u gw = *(const v4u*)(proj + (size_t)row * NCOL + gcol + col0 + bj * 128);
                    bf16* tp = T + (size_t)row * DM + col0 + bj * 128;
                    float r[8];
                    r[0] = sigm(bflo(gw.x) + bv[bj][0][0]) * acc[ai][bj][m][0][0]; r[1] = sigm(bfhi(gw.x) + bv[bj][0][1]) * acc[ai][bj][m][0][1];
                    r[2] = sigm(bflo(gw.y) + bv[bj][0][2]) * acc[ai][bj][m][0][2]; r[3] = sigm(bfhi(gw.y) + bv[bj][0][3]) * acc[ai][bj][m][0][3];
                    r[4] = sigm(bflo(gw.z) + bv[bj][1][0]) * acc[ai][bj][m][1][0]; r[5] = sigm(bfhi(gw.z) + bv[bj][1][1]) * acc[ai][bj][m][1][1];
                    r[6] = sigm(bflo(gw.w) + bv[bj][1][2]) * acc[ai][bj][m][1][2]; r[7] = sigm(bfhi(gw.w) + bv[bj][1][3]) * acc[ai][bj][m][1][3];
                    if (ADD) { const v4u tw = *(const v4u*)tp;
                        r[0] += bflo(tw.x); r[1] += bfhi(tw.x); r[2] += bflo(tw.y); r[3] += bfhi(tw.y); r[4] += bflo(tw.z); r[5] += bfhi(tw.z); r[6] += bflo(tw.w); r[7] += bfhi(tw.w); }
                    v4u w; w.x = pk2(r[0], r[1]); w.y = pk2(r[2], r[3]); w.z = pk2(r[4], r[5]); w.w = pk2(r[6], r[7]);
                    *(v4u*)tp = w; } }
    }
};
template <bool BF> struct EpiResid {
    static constexpr bool PERM = true, AFTER_DRAIN = false;
    const float* base; bf16* obf; float* ssq;
    __device__ __forceinline__ void operator()(const f32x4 (&acc)[2][2][4][2], const Unit& u, int wr, int wc, int fr, int fq) const {
        const int row0 = u.pm * 256 + wr * 64 + fr, col0 = u.pn * 256 + wc * 32 + 8 * fq;
#pragma unroll
        for (int ai = 0; ai < 2; ++ai)
#pragma unroll
            for (int m = 0; m < 4; ++m) { const int row = row0 + ai * 128 + m * 16; const size_t off = (size_t)row * DM + col0; float ss = 0.f;
#pragma unroll
                for (int bj = 0; bj < 2; ++bj) { f32x4 b0, b1;
                    if (BF) { const v4u bw = *(const v4u*)(obf + off + bj * 128); b0 = (f32x4){bflo(bw.x), bfhi(bw.x), bflo(bw.y), bfhi(bw.y)}; b1 = (f32x4){bflo(bw.z), bfhi(bw.z), bflo(bw.w), bfhi(bw.w)}; }
                    else { b0 = *(const f32x4*)(base + off + bj * 128); b1 = *(const f32x4*)(base + off + bj * 128 + 4); }
                    const f32x4 v0 = b0 + acc[ai][bj][m][0], v1 = b1 + acc[ai][bj][m][1];
                    v4u w; w.x = pk2(v0[0], v0[1]); w.y = pk2(v0[2], v0[3]); w.z = pk2(v1[0], v1[1]); w.w = pk2(v1[2], v1[3]);
                    *(v4u*)(obf + off + bj * 128) = w;
                    ss += ((v0[0] * v0[0] + v0[1] * v0[1]) + (v0[2] * v0[2] + v0[3] * v0[3])) + ((v1[0] * v1[0] + v1[1] * v1[1]) + (v1[2] * v1[2] + v1[3] * v1[3])); }
                ss += __shfl_xor(ss, 16); ss += __shfl_xor(ss, 32);
                if (fq == 0) ssq[(size_t)row * 16 + (u.pn & 3) * 4 + wc] = ss;
                CFENCE(); }
    }
};
struct EpiSwiglu {
    static constexpr bool PERM = true, AFTER_DRAIN = false;
    bf16* act; const float* bgu; const float* row_rstd;
    __device__ __forceinline__ void operator()(const f32x4 (&acc)[2][2][4][2], const Unit& u, int wr, int wc, int fr, int fq) const {
        const int e = u.pn >> 3, pnl = u.pn & 7;
        const int row0 = u.pm * 256 + wr * 64 + fr, cl0 = pnl * 128 + wc * 32 + 8 * fq;
        f32x4 bg[2], bl[2];
#pragma unroll
        for (int n = 0; n < 2; ++n) { bg[n] = *(const f32x4*)(bgu + e * 2048 + cl0 + 4 * n); bl[n] = *(const f32x4*)(bgu + e * 2048 + 1024 + cl0 + 4 * n); }
#pragma unroll
        for (int ai = 0; ai < 2; ++ai)
#pragma unroll
            for (int m = 0; m < 4; ++m) { const int row = row0 + ai * 128 + m * 16; const float rs = row_rstd[row];
                float r[8];
#pragma unroll
                for (int n = 0; n < 2; ++n)
#pragma unroll
                    for (int j = 0; j < 4; ++j) { float gl = acc[ai][0][m][n][j] * rs + bg[n][j], li = acc[ai][1][m][n][j] * rs + bl[n][j];
                        gl = fminf(gl, 7.0f); li = fminf(fmaxf(li, -7.0f), 7.0f);
                        r[n * 4 + j] = gl * sigm(1.702f * gl) * (li + 1.0f); }
                v4u w; w.x = pk2(r[0], r[1]); w.y = pk2(r[2], r[3]); w.z = pk2(r[4], r[5]); w.w = pk2(r[6], r[7]);
                *(v4u*)(act + (size_t)row * DM + cl0) = w; }
    }
};
struct EpiDown {
    static constexpr bool PERM = true, AFTER_DRAIN = false;
    bf16* y; const float* bd; const float* row_gate;
    __device__ __forceinline__ void operator()(const f32x4 (&acc)[2][2][4][2], const Unit& u, int wr, int wc, int fr, int fq) const {
        const int e = u.pn >> 2, pnl = u.pn & 3;
        const int row0 = u.pm * 256 + wr * 64 + fr, col0 = pnl * 256 + wc * 32 + 8 * fq;
        f32x4 bv[2][2];
#pragma unroll
        for (int bj = 0; bj < 2; ++bj)
#pragma unroll
            for (int n = 0; n < 2; ++n) bv[bj][n] = *(const f32x4*)(bd + e * 1024 + col0 + bj * 128 + 4 * n);
#pragma unroll
        for (int ai = 0; ai < 2; ++ai)
#pragma unroll
            for (int m = 0; m < 4; ++m) { const int row = row0 + ai * 128 + m * 16; const float gt = row_gate[row];
#pragma unroll
                for (int bj = 0; bj < 2; ++bj) { const f32x4 v0 = (acc[ai][bj][m][0] + bv[bj][0]) * gt, v1 = (acc[ai][bj][m][1] + bv[bj][1]) * gt;
                    v4u w; w.x = pk2(v0[0], v0[1]); w.y = pk2(v0[2], v0[3]); w.z = pk2(v1[0], v1[1]); w.w = pk2(v1[2], v1[3]);
                    *(v4u*)(y + (size_t)row * DM + col0 + bj * 128) = w; } }
    }
};
struct GroupedOrder {
    int nunits, npn, G, c; const unsigned* blk_expert;
    __device__ __forceinline__ bool next(int i, Unit& u) const {
        const long L = (long)i * G + c; if (L >= nunits) return false;
        const int rb = (int)(L / npn), pn = (int)(L % npn);
        const int e = (int)__builtin_amdgcn_readfirstlane(ld_agent(blk_expert + rb));
        u.pm = rb; u.pn = e * npn + pn; return true;
    }
    __device__ __forceinline__ void a_ready(const Unit&) const {}
    __device__ __forceinline__ void done(const Unit&) const {}
};

constexpr int RING_BYTES = 131072, MISC_OFF = RING_BYTES + 320, LDS_BYTES = 147456;

struct Ctx { LAS unsigned char* lds; int tid, lane, wave, G, gw, ngw; };

template <class RowMap>
__device__ __forceinline__ void transpose_item(const float* W, int K, int N, bf16* WT, const float* gain, LAS float* scr, int item, int lane, RowMap rm) {
    const int nblk = N / 32, kb = item / nblk, nb = item % nblk, k0 = 64 * kb, n0 = 32 * nb;
#pragma unroll 8
    for (int i = 0; i < 32; ++i) { const int kk = 2 * i + (lane >> 5); float v = W[(size_t)(k0 + kk) * N + n0 + (lane & 31)]; if (gain) v *= gain[k0 + kk]; scr[kk * 33 + (lane & 31)] = v; }
    LDS_WAIT();
    const int c = lane & 7;
#pragma unroll
    for (int j = 0; j < 4; ++j) { const int n = (lane >> 3) + 8 * j; const LAS float* s = scr + (8 * c) * 33 + n;
        v4u o; o.x = pk2(s[0 * 33], s[1 * 33]); o.y = pk2(s[2 * 33], s[3 * 33]); o.z = pk2(s[4 * 33], s[5 * 33]); o.w = pk2(s[6 * 33], s[7 * 33]);
        *(v4u*)(WT + (size_t)rm(n0 + n) * K + k0 + 8 * c) = o; }
    LDS_WAIT();
}
struct RowId { int off; __device__ __forceinline__ int operator()(int n) const { return off + n; } };
struct RowGU { int e; __device__ __forceinline__ int operator()(int n) const { const int j = n & 1023; return e * 2048 + (j >> 7) * 256 + (n >> 10) * 128 + (j & 127); } };

__device__ __forceinline__ void rms_row_to_bf16(const float* xrow, const float* gain, bf16* orow, int lane) {
    const f32x4* xr = (const f32x4*)xrow + lane; const f32x4* gr = (const f32x4*)gain + lane;
    f32x4 v[4]; float s = 0.f;
#pragma unroll
    for (int j = 0; j < 4; ++j) { v[j] = xr[64 * j]; s += (v[j][0] * v[j][0] + v[j][1] * v[j][1]) + (v[j][2] * v[j][2] + v[j][3] * v[j][3]); }
    const float rstd = rsqrtf(wave_sum(s) * (1.f / DM) + RMS_EPS);
    unsigned long long* o8 = (unsigned long long*)orow + lane;
#pragma unroll
    for (int j = 0; j < 4; ++j) { const f32x4 g = gr[64 * j]; const f32x4 w = v[j] * rstd * g;
        o8[64 * j] = (unsigned long long)pk2(w[0], w[1]) | ((unsigned long long)pk2(w[2], w[3]) << 32); }
}

__device__ __forceinline__ void phase_prologue(const Args& a, const Ctx& c) {
    LAS float* scr = (LAS float*)(c.lds + c.wave * 16384);
    unsigned char* ws = a.ws;
    constexpr int I_IN = 16 * (NCOL / 32), I_SQ = 16 * 32, I_R = 16;
    constexpr int NIT = I_IN + 7 * I_SQ + I_R;
    for (int it = c.gw; it < NIT; it += c.ngw) {
        int r = it;
        if (r < I_IN) { transpose_item(a.in[5], DM, NCOL, (bf16*)(ws + WS_WIN), nullptr, scr, r, c.lane, RowId{0}); continue; } r -= I_IN;
        if (r < I_SQ) { transpose_item(a.in[9], DM, DM, (bf16*)(ws + WS_WA), nullptr, scr, r, c.lane, RowId{0}); continue; } r -= I_SQ;
        if (r < I_SQ) { transpose_item(a.in[10], DM, DM, (bf16*)(ws + WS_WB), nullptr, scr, r, c.lane, RowId{0}); continue; } r -= I_SQ;
        if (r < I_SQ) { transpose_item(a.in[11], DM, DM, (bf16*)(ws + WS_WMIX), nullptr, scr, r, c.lane, RowId{0}); continue; } r -= I_SQ;
        if (r < I_SQ) { transpose_item(a.in[13], DM, DM, (bf16*)(ws + WS_WQ), a.in[12], scr, r, c.lane, RowId{0}); continue; } r -= I_SQ;
        if (r < I_SQ) { transpose_item(a.in[14], DM, DM, (bf16*)(ws + WS_WK), nullptr, scr, r, c.lane, RowId{0}); continue; } r -= I_SQ;
        if (r < I_SQ) { transpose_item(a.in[15], DM, DM, (bf16*)(ws + WS_WV), nullptr, scr, r, c.lane, RowId{0}); continue; } r -= I_SQ;
        if (r < I_SQ) { transpose_item(a.in[16], DM, DM, (bf16*)(ws + WS_WO), nullptr, scr, r, c.lane, RowId{0}); continue; } r -= I_SQ;
        transpose_item(a.in[18], DM, NEXP, (bf16*)(ws + WS_WR), a.in[17], scr, r, c.lane, RowId{0});
    }
    { const size_t n8 = (size_t)NBATCH * MEMLEN * DM / 8; const float* mem = a.in[1]; bf16* mb = (bf16*)(ws + WS_MEMBF);
      for (size_t i = (size_t)c.gw * 64 + c.lane; i < n8; i += (size_t)c.ngw * 64) { const f32x4 v0 = *(const f32x4*)(mem + i * 8), v1 = *(const f32x4*)(mem + i * 8 + 4);
          v4u w; w.x = pk2(v0[0], v0[1]); w.y = pk2(v0[2], v0[3]); w.z = pk2(v1[0], v1[1]); w.w = pk2(v1[2], v1[3]); *(v4u*)(mb + i * 8) = w; } }
    if (c.gw == 0) {
        float* lb = (float*)(ws + WS_LB); const float* lbl = a.in[3];
        for (int k = c.lane; k < 1024; k += 64) lb[k] = 1.f / (1.f + expf(lbl[1024 + k] - lbl[k]));
    }
    if (c.gw == 1) {
        float* lut = (float*)(ws + WS_LUT); const float* t5 = a.in[2];
        for (int i = c.lane; i < 16 * 128; i += 64) { const int h = i >> 7, d = i & 127; int b = d;
            if (d >= 16) { b = 16 + (int)(logf((float)d * (1.f / 16.f)) / logf(8.f) * 16.f); b = b < 31 ? b : 31; }
            lut[i] = t5[b * 16 + h]; }
    }
}

__device__ __forceinline__ void phase_norm1(const Args& a, const Ctx& c, int hb) {
    const float* x = a.in[0] + (size_t)hb * HTOK * DM; bf16* xn = (bf16*)(a.ws + WS_TM);
    for (int m = c.gw; m < HTOK; m += c.ngw) rms_row_to_bf16(x + (size_t)m * DM, a.in[4], xn + (size_t)m * DM, c.lane);
}

constexpr int SWA_VB = 32 * 144;
constexpr int SWA_LUT_OFF = 8 * 2 * SWA_VB;
__device__ __forceinline__ void swa_unit(const bf16* proj, bf16* ob, int bl, int kvh, int tt, const LAS float* lut, LAS unsigned char* vbuf, const float* sinks, int lane) {
    const int l15 = lane & 15, g = lane >> 4, q4 = l15 >> 2, p4 = lane & 3;
    const int t0 = tt * 16; const size_t rowb = (size_t)bl * SEQ;
    bf16x8 qf[4][2];
#pragma unroll
    for (int gq = 0; gq < 4; ++gq)
#pragma unroll
        for (int ks = 0; ks < 2; ++ks) qf[gq][ks] = *(const bf16x8*)(proj + (rowb + t0 + l15) * NCOL + C_SQ + (kvh * 4 + gq) * 64 + ks * 32 + 8 * g);
    float mx[4], ls[4]; f32x4 o[4][4];
#pragma unroll
    for (int gq = 0; gq < 4; ++gq) { mx[gq] = sinks[kvh * 4 + gq]; ls[gq] = 1.f;
#pragma unroll
        for (int dt = 0; dt < 4; ++dt) o[gq][dt] = (f32x4){0.f, 0.f, 0.f, 0.f}; }
    for (int c = 0; c < 5; ++c) {
        const int kc = t0 - 144 + 32 * c;
        if (kc + 31 < 0) continue;
        LAS unsigned char* vb = vbuf + (c & 1) * SWA_VB;
#pragma unroll
        for (int i = 0; i < 4; ++i) { const int p = lane + 64 * i, key = p >> 3, d8 = p & 7; int kr = kc + key; kr = kr < 0 ? 0 : kr;
            const v4u vv = *(const v4u*)(proj + (rowb + kr) * NCOL + C_SV + kvh * 64 + d8 * 8);
            *(LAS v4u*)(vb + key * 144 + d8 * 16) = vv; }
        f32x4 s[4][2];
#pragma unroll
        for (int ksub = 0; ksub < 2; ++ksub) { int kr = kc + 16 * ksub + l15; kr = kr < 0 ? 0 : kr;
            const bf16* kp = proj + (rowb + kr) * NCOL + C_SK + kvh * 64 + 8 * g;
            const bf16x8 k0 = *(const bf16x8*)kp, k1 = *(const bf16x8*)(kp + 32);
#pragma unroll
            for (int gq = 0; gq < 4; ++gq) { f32x4 z = (f32x4){0.f, 0.f, 0.f, 0.f}; z = mfma16(k0, qf[gq][0], z); s[gq][ksub] = mfma16(k1, qf[gq][1], z); } }
        bf16x8 pf[4];
#pragma unroll
        for (int gq = 0; gq < 4; ++gq) { const int hq = kvh * 4 + gq; float cm = -1e30f;
#pragma unroll
            for (int ksub = 0; ksub < 2; ++ksub)
#pragma unroll
                for (int r = 0; r < 4; ++r) { const int key = kc + 16 * ksub + 4 * g + r, dist = t0 + l15 - key; const bool ok = (dist >= 0) && (dist < 128) && (key >= 0);
                    const int di = dist < 0 ? 0 : (dist > 127 ? 127 : dist);
                    float v = s[gq][ksub][r] * 0.125f + lut[hq * 128 + di]; v = ok ? v : -1e30f; s[gq][ksub][r] = v; cm = fmaxf(cm, v); }
            cm = fmaxf(cm, __shfl_xor(cm, 16)); cm = fmaxf(cm, __shfl_xor(cm, 32));
            const float mn = fmaxf(mx[gq], cm), alpha = __expf(mx[gq] - mn); mx[gq] = mn; float rs = 0.f;
#pragma unroll
            for (int ksub = 0; ksub < 2; ++ksub)
#pragma unroll
                for (int r = 0; r < 4; ++r) { const float p = __expf(s[gq][ksub][r] - mn); s[gq][ksub][r] = p; rs += p; }
            rs += __shfl_xor(rs, 16); rs += __shfl_xor(rs, 32);
            ls[gq] = ls[gq] * alpha + rs;
#pragma unroll
            for (int dt = 0; dt < 4; ++dt) o[gq][dt] = o[gq][dt] * alpha;
            pf[gq] = pack8(s[gq][0], s[gq][1]); }
        CFENCE();
#pragma unroll
        for (int dt = 0; dt < 4; ++dt) {
            const s16x4 lo = vtr(vb + (4 * g + q4) * 144 + (16 * dt + 4 * p4) * 2), hi = vtr(vb + (16 + 4 * g + q4) * 144 + (16 * dt + 4 * p4) * 2);
            const bf16x8 vf = cat8(lo, hi);
#pragma unroll
            for (int gq = 0; gq < 4; ++gq) o[gq][dt] = mfma16(vf, pf[gq], o[gq][dt]); }
        CFENCE();
    }
#pragma unroll
    for (int gq = 0; gq < 4; ++gq) { const float inv = 1.f / ls[gq];
#pragma unroll
        for (int dt = 0; dt < 4; ++dt) { const f32x4 v = o[gq][dt] * inv; v2u w; w.x = pk2(v[0], v[1]); w.y = pk2(v[2], v[3]);
            *(v2u*)(ob + (rowb + t0 + l15) * DM + (kvh * 4 + gq) * 64 + 16 * dt + 4 * g) = w; } }
}
__device__ __forceinline__ void phase_swa(const Args& a, const Ctx& c) {
    const bf16* proj = (const bf16*)(a.ws + WS_PROJ); bf16* ob = (bf16*)(a.ws + WS_OB);
    LAS float* lut = (LAS float*)(c.lds + SWA_LUT_OFF); const float* glut = (const float*)(a.ws + WS_LUT);
    for (int i = c.tid; i < 16 * 128; i += 512) lut[i] = glut[i];
    __syncthreads();
    LAS unsigned char* vbuf = c.lds + c.wave * 2 * SWA_VB;
    constexpr int NU = 8 * 4 * 256;
    for (int u = c.gw; u < NU; u += c.ngw) { const int tt = u & 255, kvh = (u >> 8) & 3, bl = u >> 10; swa_unit(proj, ob, bl, kvh, tt, lut, vbuf, a.in[8], c.lane); }
    __syncthreads();
}

constexpr int HG_LF = 0, HG_KP = 33792, HG_VT = 51200, HG_GT = 68608, HG_QP = 70656, HG_SSQ = 88064;
__device__ __forceinline__ void hg_scan(LAS unsigned char* lds, int tid, float (&loc)[16], float& pre, float& Gm, float& Gl) {
    const int ch = tid & 127, grp = tid >> 7;
    const LAS float* LF = (const LAS float*)(lds + HG_LF); LAS float* GT = (LAS float*)(lds + HG_GT);
    float run = 0.f;
#pragma unroll
    for (int i = 0; i < 16; ++i) { run += LF[(16 * grp + i) * 132 + ch]; loc[i] = run; }
    GT[grp * 128 + ch] = run;
    __syncthreads();
    const float g0 = GT[ch], g1 = GT[128 + ch], g2 = GT[256 + ch], g3 = GT[384 + ch];
    pre = (grp > 0 ? g0 : 0.f) + (grp > 1 ? g1 : 0.f) + (grp > 2 ? g2 : 0.f);
    Gm = g0 + g1; Gl = Gm + g2 + g3;
}
__device__ __forceinline__ void phase_hgA(const Args& a, const Ctx& c) {
    const bf16* proj = (const bf16*)(a.ws + WS_PROJ); bf16* US = (bf16*)((unsigned char*)a.out + OUT_US); float* D12 = (float*)(a.ws + WS_D12); const float* lb = (const float*)(a.ws + WS_LB);
    LAS unsigned char* lds = c.lds; const int tid = c.tid, lane = c.lane, w = c.wave;
    const int l15 = lane & 15, g = lane >> 4, q4 = l15 >> 2, p4 = lane & 3;
    constexpr int NU = 8 * 8 * 64;
    int u = blockIdx.x; if (u >= NU) return;
    v4u rf[2], rv[2];
#define HGA_LOAD(uu) do { const int cc_ = (uu) & 63, h_ = ((uu) >> 6) & 7, bl_ = (uu) >> 9; const size_t row0_ = (size_t)bl_ * SEQ + cc_ * 64; \
        _Pragma("unroll") for (int i = 0; i < 2; ++i) { const int p = tid + 512 * i, tok = p >> 4, c8 = p & 15; const bf16* rp = proj + (row0_ + tok) * NCOL + h_ * 128 + c8 * 8; \
            rf[i] = *(const v4u*)(rp + C_HF); rv[i] = *(const v4u*)(rp + C_HI); } } while (0)
    HGA_LOAD(u);
    for (;;) {
        const int h = (u >> 6) & 7;
#pragma unroll
        for (int i = 0; i < 2; ++i) { const int p = tid + 512 * i, tok = p >> 4, c8 = p & 15;
            const f32x4 lb0 = *(const f32x4*)(lb + h * 128 + c8 * 8), lb1 = *(const f32x4*)(lb + h * 128 + c8 * 8 + 4);
            const unsigned fw[4] = {rf[i].x, rf[i].y, rf[i].z, rf[i].w}; f32x4 o0, o1;
#pragma unroll
            for (int j = 0; j < 4; ++j) { const float lbl = j < 2 ? lb0[2 * j] : lb1[2 * j - 4], lbh = j < 2 ? lb0[2 * j + 1] : lb1[2 * j - 3];
                const float fl = lbl + (1.f - lbl) * sigm(bflo(fw[j])), fh = lbh + (1.f - lbh) * sigm(bfhi(fw[j]));
                if (j < 2) { o0[2 * j] = __logf(fl); o0[2 * j + 1] = __logf(fh); } else { o1[2 * j - 4] = __logf(fl); o1[2 * j - 3] = __logf(fh); } }
            LAS float* lfp = (LAS float*)(lds + HG_LF) + tok * 132 + c8 * 8; *(LAS f32x4*)lfp = o0; *(LAS f32x4*)(lfp + 4) = o1;
            *(LAS v4u*)(lds + HG_VT + tok * 272 + c8 * 16) = rv[i]; }
        const int ucur = u; const int un = u + gridDim.x; const bool has_next = un < NU;
        if (has_next) HGA_LOAD(un);
        __syncthreads();
        float loc[16], pre, Gm, Gl; hg_scan(lds, tid, loc, pre, Gm, Gl);
        { const int ch = tid & 127, grp = tid >> 7; LAS bf16* KP = (LAS bf16*)(lds + HG_KP);
#pragma unroll
          for (int i = 0; i < 16; ++i) { const float lfi = loc[i] - (i ? loc[i - 1] : 0.f), G = pre + loc[i];
              const float kp = (1.f - __expf(lfi)) * __expf(fminf(Gm - G, 80.f)); KP[(16 * grp + i) * 136 + ch] = (bf16)f2bf(kp); }
          if (grp == 0) { D12[(size_t)ucur * 256 + ch] = __expf(Gm); D12[(size_t)ucur * 256 + 128 + ch] = __expf(Gl - Gm); } }
        __syncthreads();
        { bf16x8 af[2];
#pragma unroll
          for (int ks = 0; ks < 2; ++ks) { const LAS unsigned char* bp = lds + HG_KP + (32 * ks + 8 * g + q4) * 272 + (16 * w + 4 * p4) * 2; af[ks] = cat8(vtr(bp), vtr(bp + 4 * 272)); }
#pragma unroll
          for (int vt = 0; vt < 8; ++vt) { f32x4 acc = (f32x4){0.f, 0.f, 0.f, 0.f};
#pragma unroll
              for (int ks = 0; ks < 2; ++ks) { const LAS unsigned char* bp = lds + HG_VT + (32 * ks + 8 * g + q4) * 272 + (16 * vt + 4 * p4) * 2; acc = mfma16(af[ks], cat8(vtr(bp), vtr(bp + 4 * 272)), acc); }
              v2u wv; wv.x = pk2(acc[0], acc[1]); wv.y = pk2(acc[2], acc[3]);
              *(v2u*)(US + ((size_t)ucur * 128 + 16 * vt + l15) * 128 + 16 * w + 4 * g) = wv; } }
        __syncthreads();
        if (!has_next) break;
        u = un;
    }
}
__device__ __forceinline__ void phase_hgB(const Args& a, const Ctx& c) {
    bf16* US = (bf16*)((unsigned char*)a.out + OUT_US); const float* D12 = (const float*)(a.ws + WS_D12);
    const int gt = c.gw * 64 + c.lane;
    for (int e = gt; e < 64 * 2048; e += c.ngw * 64) {
        const int bh = e >> 11, r = e & 2047, k8 = r & 15;
        float S[8];
#pragma unroll
        for (int j = 0; j < 8; ++j) S[j] = 0.f;
        for (int c0 = 0; c0 < 64; c0 += 4) {
            v4u uw[4]; f32x4 d1[4][2], d2[4][2];
#pragma unroll
            for (int cc = 0; cc < 4; ++cc) { const size_t un = (size_t)bh * 64 + c0 + cc;
                uw[cc] = *(const v4u*)(US + un * 16384 + (size_t)r * 8);
                d1[cc][0] = *(const f32x4*)(D12 + un * 256 + k8 * 8); d1[cc][1] = *(const f32x4*)(D12 + un * 256 + k8 * 8 + 4);
                d2[cc][0] = *(const f32x4*)(D12 + un * 256 + 128 + k8 * 8); d2[cc][1] = *(const f32x4*)(D12 + un * 256 + 128 + k8 * 8 + 4); }
#pragma unroll
            for (int cc = 0; cc < 4; ++cc) { const size_t un = (size_t)bh * 64 + c0 + cc;
                const unsigned ww[4] = {uw[cc].x, uw[cc].y, uw[cc].z, uw[cc].w}; float sp[8];
#pragma unroll
                for (int j = 0; j < 8; ++j) { const float d1v = d1[cc][j >> 2][j & 3], d2v = d2[cc][j >> 2][j & 3]; const float uv = (j & 1) ? bfhi(ww[j >> 1]) : bflo(ww[j >> 1]);
                    sp[j] = d1v * S[j]; S[j] = d2v * (sp[j] + uv); }
                v4u o; o.x = pk2(sp[0], sp[1]); o.y = pk2(sp[2], sp[3]); o.z = pk2(sp[4], sp[5]); o.w = pk2(sp[6], sp[7]);
                *(v4u*)(US + un * 16384 + (size_t)r * 8) = o; }
        }
    }
}
__device__ __forceinline__ void phase_hgC(const Args& a, const Ctx& c) {
    const bf16* proj = (const bf16*)(a.ws + WS_PROJ); const bf16* US = (const bf16*)((unsigned char*)a.out + OUT_US); bf16* oa = (bf16*)(a.ws + WS_OA);
    const float* lb = (const float*)(a.ws + WS_LB); const float* hgain = a.in[7];
    LAS unsigned char* lds = c.lds; const int tid = c.tid, lane = c.lane, w = c.wave;
    const int l15 = lane & 15, g = lane >> 4, q4 = l15 >> 2, p4 = lane & 3;
    constexpr int NU = 8 * 8 * 64;
    int u = blockIdx.x; if (u >= NU) return;
    v4u rq[2], rf[2], rv[2];
#define HGC_LOAD(uu) do { const int cc_ = (uu) & 63, h_ = ((uu) >> 6) & 7, bl_ = (uu) >> 9; const size_t row0_ = (size_t)bl_ * SEQ + cc_ * 64; \
        _Pragma("unroll") for (int i = 0; i < 2; ++i) { const int p = tid + 512 * i, tok = p >> 4, c8 = p & 15; const bf16* rp = proj + (row0_ + tok) * NCOL + h_ * 128 + c8 * 8; \
            rq[i] = *(const v4u*)(rp + C_HQ); rf[i] = *(const v4u*)(rp + C_HF); rv[i] = *(const v4u*)(rp + C_HI); } } while (0)
    HGC_LOAD(u);
    const f32x4 gn = *(const f32x4*)(hgain + 16 * w + 4 * g);
    for (;;) {
        const int cc = u & 63, h = (u >> 6) & 7, bl = u >> 9; const size_t row0 = (size_t)bl * SEQ + cc * 64;
#pragma unroll
        for (int i = 0; i < 2; ++i) { const int p = tid + 512 * i, tok = p >> 4, c8 = p & 15;
            const f32x4 lb0 = *(const f32x4*)(lb + h * 128 + c8 * 8), lb1 = *(const f32x4*)(lb + h * 128 + c8 * 8 + 4);
            const unsigned fw[4] = {rf[i].x, rf[i].y, rf[i].z, rf[i].w}; f32x4 o0, o1;
#pragma unroll
            for (int j = 0; j < 4; ++j) { const float lbl = j < 2 ? lb0[2 * j] : lb1[2 * j - 4], lbh = j < 2 ? lb0[2 * j + 1] : lb1[2 * j - 3];
                const float fl = lbl + (1.f - lbl) * sigm(bflo(fw[j])), fh = lbh + (1.f - lbh) * sigm(bfhi(fw[j]));
                if (j < 2) { o0[2 * j] = __logf(fl); o0[2 * j + 1] = __logf(fh); } else { o1[2 * j - 4] = __logf(fl); o1[2 * j - 3] = __logf(fh); } }
            LAS float* lfp = (LAS float*)(lds + HG_LF) + tok * 132 + c8 * 8; *(LAS f32x4*)lfp = o0; *(LAS f32x4*)(lfp + 4) = o1;
            *(LAS v4u*)(lds + HG_VT + tok * 272 + c8 * 16) = rv[i];
            *(LAS v4u*)(lds + HG_QP + tok * 272 + c8 * 16) = rq[i]; }
        const int ucur = u; const int un = u + gridDim.x; const bool has_next = un < NU;
        if (has_next) HGC_LOAD(un);
        bf16x8 sf[4];
#pragma unroll
        for (int ks = 0; ks < 4; ++ks) sf[ks] = *(const bf16x8*)(US + ((size_t)ucur * 128 + 16 * w + l15) * 128 + 32 * ks + 8 * g);
        __syncthreads();
        float loc[16], pre, Gm, Gl; hg_scan(lds, tid, loc, pre, Gm, Gl);
        { const int ch = tid & 127, grp = tid >> 7; LAS bf16* KP = (LAS bf16*)(lds + HG_KP); LAS bf16* QP = (LAS bf16*)(lds + HG_QP);
#pragma unroll
          for (int i = 0; i < 16; ++i) { const float lfi = loc[i] - (i ? loc[i - 1] : 0.f), G = pre + loc[i];
              const float kp = (1.f - __expf(lfi)) * __expf(fminf(Gm - G, 80.f)); KP[(16 * grp + i) * 136 + ch] = (bf16)f2bf(kp);
              const float qr = __builtin_bit_cast(float, (unsigned)QP[(16 * grp + i) * 136 + ch] << 16);
              const float qp = qr * sigm(qr) * __expf(fminf(G - Gm, 80.f)); QP[(16 * grp + i) * 136 + ch] = (bf16)f2bf(qp); } }
        __syncthreads();
        f32x4 o[4];
        {
            bf16x8 vf[2];
#pragma unroll
            for (int kk = 0; kk < 2; ++kk) { const LAS unsigned char* bp = lds + HG_VT + (32 * kk + 4 * g + q4) * 272 + (16 * w + 4 * p4) * 2; vf[kk] = cat8(vtr(bp), vtr(bp + 16 * 272)); }
#pragma unroll
            for (int tt = 0; tt < 4; ++tt) {
                bf16x8 qf[4];
#pragma unroll
                for (int ks = 0; ks < 4; ++ks) qf[ks] = *(const LAS bf16x8*)(lds + HG_QP + (16 * tt + l15) * 272 + (32 * ks + 8 * g) * 2);
                f32x4 acc = (f32x4){0.f, 0.f, 0.f, 0.f};
#pragma unroll
                for (int ks = 0; ks < 4; ++ks) acc = mfma16(sf[ks], qf[ks], acc);
                f32x4 at[4];
#pragma unroll
                for (int st = 0; st < 4; ++st) { at[st] = (f32x4){0.f, 0.f, 0.f, 0.f};
                    if (st <= tt) {
#pragma unroll
                        for (int ks = 0; ks < 4; ++ks) { const bf16x8 kf = *(const LAS bf16x8*)(lds + HG_KP + (16 * st + l15) * 272 + (32 * ks + 8 * g) * 2); at[st] = mfma16(kf, qf[ks], at[st]); }
                        if (st == tt) {
#pragma unroll
                            for (int r = 0; r < 4; ++r) at[st][r] = (4 * g + r <= l15) ? at[st][r] : 0.f; } } }
                acc = mfma16(vf[0], pack8(at[0], at[1]), acc);
                if (tt >= 2) acc = mfma16(vf[1], pack8(at[2], at[3]), acc);
                o[tt] = acc; }
        }
        { LAS float* SSQ = (LAS float*)(lds + HG_SSQ);
#pragma unroll
          for (int tt = 0; tt < 4; ++tt) { float s = (o[tt][0] * o[tt][0] + o[tt][1] * o[tt][1]) + (o[tt][2] * o[tt][2] + o[tt][3] * o[tt][3]);
              s += __shfl_xor(s, 16); s += __shfl_xor(s, 32); if (g == 0) SSQ[w * 64 + 16 * tt + l15] = s; }
          __syncthreads();
#pragma unroll
          for (int tt = 0; tt < 4; ++tt) { float s = 0.f;
#pragma unroll
              for (int ww = 0; ww < 8; ++ww) s += SSQ[ww * 64 + 16 * tt + l15];
              const float rstd = rsqrtf(s * (1.f / 128.f) + RMS_EPS);
              const size_t row = row0 + 16 * tt + l15;
              const v2u gw = *(const v2u*)(proj + row * NCOL + C_HG + h * 128 + 16 * w + 4 * g);
              const float g0 = bflo(gw.x), g1 = bfhi(gw.x), g2 = bflo(gw.y), g3 = bfhi(gw.y);
              const float r0 = o[tt][0] * rstd * gn[0] * (g0 * sigm(g0)), r1 = o[tt][1] * rstd * gn[1] * (g1 * sigm(g1));
              const float r2 = o[tt][2] * rstd * gn[2] * (g2 * sigm(g2)), r3 = o[tt][3] * rstd * gn[3] * (g3 * sigm(g3));
              v2u wv; wv.x = pk2(r0, r1); wv.y = pk2(r2, r3);
              *(v2u*)(oa + row * DM + h * 128 + 16 * w + 4 * g) = wv; } }
        if (!has_next) break;
        u = un;
    }
    __syncthreads();
}

typedef float f32x16 __attribute__((ext_vector_type(16)));
constexpr int XA_KROW = 528, XA_VROW = 72, XA_KB = 32 * XA_KROW, XA_VB = 256 * XA_VROW, XA_STAGE = XA_KB + XA_VB;
__device__ __forceinline__ void phase_xa(const Args& a, const Ctx& c) {
    const bf16* qg = (const bf16*)(a.ws + WS_Q); bf16* og = (bf16*)(a.ws + WS_O); const bf16* kx = (const bf16*)(a.ws + WS_KX); const bf16* vxt = (const bf16*)(a.ws + WS_VXT);
    LAS unsigned char* lds = c.lds; const int tid = c.tid, lane = c.lane, w = c.wave;
    const int l31 = lane & 31, hh = lane >> 5, qt = w & 3, dh = w >> 2;
    constexpr int NU = NBATCH * 4 * (SEQ / 128);
    int u = blockIdx.x; if (u >= NU) return;
    v4u rk[2], rv[2];
#define XA_LOAD(uu, kc) do { const int b_ = (uu) >> 7, h_ = ((uu) >> 5) & 3; \
        _Pragma("unroll") for (int i = 0; i < 2; ++i) { const int p = tid + 512 * i; \
            rk[i] = *(const v4u*)(kx + (size_t)(b_ * MEMLEN + (kc) * 32 + (p >> 5)) * DM + h_ * 256 + (p & 31) * 8); \
            rv[i] = *(const v4u*)(vxt + (size_t)(h_ * 256 + (p >> 2)) * (NBATCH * MEMLEN) + b_ * MEMLEN + (kc) * 32 + (p & 3) * 8); } } while (0)
#define XA_STORE(buf) do { LAS unsigned char* sb = lds + (buf) * XA_STAGE; \
        _Pragma("unroll") for (int i = 0; i < 2; ++i) { const int p = tid + 512 * i; \
            *(LAS v4u*)(sb + (p >> 5) * XA_KROW + (p & 31) * 16) = rk[i]; \
            LAS v2u* vp = (LAS v2u*)(sb + XA_KB + (p >> 2) * XA_VROW + (p & 3) * 16); v2u lo; lo.x = rv[i].x; lo.y = rv[i].y; v2u hi; hi.x = rv[i].z; hi.y = rv[i].w; vp[0] = lo; vp[1] = hi; } } while (0)
    XA_LOAD(u, 0); XA_STORE(0);
    int par = 0;
    for (;;) {
        const int b = u >> 7, h = (u >> 5) & 3, qb = u & 31;
        const size_t row0 = (size_t)b * SEQ + qb * 128 + qt * 32;
        bf16x8 qf[16];
#pragma unroll
        for (int ks = 0; ks < 16; ++ks) qf[ks] = *(const bf16x8*)(qg + (row0 + l31) * DM + h * 256 + 16 * ks + 8 * hh);
        float mx = -1e30f, ls = 0.f; f32x16 o[4];
#pragma unroll
        for (int dt = 0; dt < 4; ++dt)
#pragma unroll
            for (int r = 0; r < 16; ++r) o[dt][r] = 0.f;
        const int un = u + gridDim.x; const bool has_next = un < NU;
        for (int kc = 0; kc < 8; ++kc) {
            __syncthreads();
            const bool more = (kc < 7) || has_next;
            if (more) { if (kc < 7) XA_LOAD(u, kc + 1); else XA_LOAD(un, 0); }
            const LAS unsigned char* kb = lds + par * XA_STAGE; const LAS unsigned char* vb = kb + XA_KB;
            f32x16 s;
#pragma unroll
            for (int r = 0; r < 16; ++r) s[r] = 0.f;
#pragma unroll
            for (int ks = 0; ks < 16; ++ks) { const bf16x8 kf = *(const LAS bf16x8*)(kb + l31 * XA_KROW + (16 * ks + 8 * hh) * 2); s = __builtin_amdgcn_mfma_f32_32x32x16_bf16(kf, qf[ks], s, 0, 0, 0); }
            float cm = -1e30f;
#pragma unroll
            for (int r = 0; r < 16; ++r) { s[r] *= 0.0625f; cm = fmaxf(cm, s[r]); }
            cm = fmaxf(cm, __shfl_xor(cm, 32));
            const float mn = fmaxf(mx, cm), alpha = __expf(mx - mn); mx = mn; float rs = 0.f;
#pragma unroll
            for (int r = 0; r < 16; ++r) { s[r] = __expf(s[r] - mn); rs += s[r]; }
            rs += __shfl_xor(rs, 32); ls = ls * alpha + rs;
#pragma unroll
            for (int dt = 0; dt < 4; ++dt)
#pragma unroll
                for (int r = 0; r < 16; ++r) o[dt][r] *= alpha;
            bf16x8 pf[2];
#pragma unroll
            for (int st = 0; st < 2; ++st) { v4u pw; pw.x = pk2(s[8 * st], s[8 * st + 1]); pw.y = pk2(s[8 * st + 2], s[8 * st + 3]); pw.z = pk2(s[8 * st + 4], s[8 * st + 5]); pw.w = pk2(s[8 * st + 6], s[8 * st + 7]); pf[st] = __builtin_bit_cast(bf16x8, pw); }
#pragma unroll
            for (int dt = 0; dt < 4; ++dt) { const LAS unsigned char* vrow = vb + (128 * dh + 32 * dt + l31) * XA_VROW + 8 * hh;
#pragma unroll
                for (int st = 0; st < 2; ++st) { const s16x4 lo = *(const LAS s16x4*)(vrow + 32 * st), hi = *(const LAS s16x4*)(vrow + 32 * st + 16);
                    o[dt] = __builtin_amdgcn_mfma_f32_32x32x16_bf16(cat8(lo, hi), pf[st], o[dt], 0, 0, 0); } }
            if (more) XA_STORE(par ^ 1);
            par ^= 1;
        }
        const float inv = 1.f / ls;
#pragma unroll
        for (int dt = 0; dt < 4; ++dt)
#pragma unroll
            for (int rg = 0; rg < 4; ++rg) { v2u wv; wv.x = pk2(o[dt][4 * rg] * inv, o[dt][4 * rg + 1] * inv); wv.y = pk2(o[dt][4 * rg + 2] * inv, o[dt][4 * rg + 3] * inv);
                *(v2u*)(og + (row0 + l31) * DM + h * 256 + 128 * dh + 32 * dt + 8 * rg + 4 * hh) = wv; }
        if (!has_next) break;
        u = un;
    }
    __syncthreads();
#undef XA_LOAD
#undef XA_STORE
}

__device__ __forceinline__ void phase_expert_weights(const Args& a, const Ctx& c) {
    LAS float* scr = (LAS float*)(c.lds + c.wave * 16384);
    constexpr int I_GU = 16 * 64, I_D = 16 * 32;
    constexpr int NIT = NEXP * (I_GU + I_D);
    for (int it = c.gw; it < NIT; it += c.ngw) {
        if (it < NEXP * I_GU) { const int e = it / I_GU, r = it % I_GU; transpose_item(a.in[20] + (size_t)e * DM * 2048, DM, 2048, (bf16*)(a.ws + WS_WGU), a.in[17], scr, r, c.lane, RowGU{e});     }
        else { const int r2 = it - NEXP * I_GU, e = r2 / I_D, r = r2 % I_D; transpose_item(a.in[22] + (size_t)e * DM * DM, DM, DM, (bf16*)(a.ws + WS_WD), nullptr, scr, r, c.lane, RowId{e * 1024}); }
    }
    __syncthreads();
}
__device__ __forceinline__ void phase_router(const Args& a, const Ctx& c) {
    const bf16* xb = (const bf16*)(a.ws + WS_XBF); const bf16* wr = (const bf16*)(a.ws + WS_WR); const float* ssq2 = (const float*)(a.ws + WS_SSQ2); const float* br = a.in[19];
    int* tope = (int*)(a.ws + WS_TOPE); float* topg = (float*)(a.ws + WS_TOPG); int* topr = (int*)(a.ws + WS_TOPR); unsigned* gcnt = (unsigned*)(a.ws + WS_GCNT);
    LAS unsigned char* lds = c.lds; const int lane = c.lane, w = c.wave, l15 = lane & 15, g = lane >> 4;
    LAS float* LG = (LAS float*)(lds + w * 4096);
    LAS int* LE = (LAS int*)(lds + w * 4096 + 2560);
    LAS unsigned* CNT = (LAS unsigned*)(lds + 32768); LAS unsigned* BASE = CNT + 32;
    for (int it = blockIdx.x; it < NTOK / 128; it += gridDim.x) {
        const int tok0 = it * 128 + w * 16; const int half = tok0 >= HTOK;
        if (c.tid < 32) CNT[c.tid] = 0u;
        f32x4 acc[2] = {(f32x4){0.f, 0.f, 0.f, 0.f}, (f32x4){0.f, 0.f, 0.f, 0.f}};
        const bf16* ap = xb + (size_t)(tok0 + l15) * DM + 8 * g;
#pragma unroll 8
        for (int ks = 0; ks < 32; ++ks) { const bf16x8 af = *(const bf16x8*)(ap + 32 * ks);
#pragma unroll
            for (int nt = 0; nt < 2; ++nt) { const bf16x8 bf = *(const bf16x8*)(wr + (size_t)(16 * nt + l15) * DM + 32 * ks + 8 * g); acc[nt] = mfma16(af, bf, acc[nt]); } }
#pragma unroll
        for (int nt = 0; nt < 2; ++nt)
#pragma unroll
            for (int r = 0; r < 4; ++r) { const int t = 4 * g + r; const float rs = rstd16(ssq2, (size_t)(tok0 + t)); LG[t * 33 + 16 * nt + l15] = acc[nt][r] * rs + br[16 * nt + l15]; }
        LDS_WAIT();
        if (lane < 16) { float v[32];
#pragma unroll
            for (int e = 0; e < 32; ++e) v[e] = LG[lane * 33 + e];
            int se[4]; float sv[4];
#pragma unroll
            for (int k = 0; k < 4; ++k) { float best = -3e38f; int bi = 0;
#pragma unroll
                for (int e = 0; e < 32; ++e) { const bool bt = v[e] > best; best = bt ? v[e] : best; bi = bt ? e : bi; }
                se[k] = bi; sv[k] = best;
#pragma unroll
                for (int e = 0; e < 32; ++e) v[e] = (e == bi) ? -3e38f : v[e]; }
            const float e1 = __expf(sv[1] - sv[0]), e2 = __expf(sv[2] - sv[0]), e3 = __expf(sv[3] - sv[0]); const float inv = 1.f / (1.f + e1 + e2 + e3);
            const int tok = tok0 + lane;
            *(int4*)(tope + (size_t)tok * 4) = make_int4(se[0], se[1], se[2], se[3]);
            *(float4*)(topg + (size_t)tok * 4) = make_float4(inv, e1 * inv, e2 * inv, e3 * inv);
#pragma unroll
            for (int k = 0; k < 4; ++k) LE[lane * 4 + k] = se[k]; }
        __syncthreads();
        const int myE = LE[lane];
        const unsigned lr = atomicAdd((unsigned*)&CNT[myE], 1u);
        __syncthreads();
        if (c.tid < 32) { const unsigned n = CNT[c.tid]; BASE[c.tid] = n ? atomicAdd(gcnt + (half * 32 + c.tid) * 16, n) : 0u; }
        __syncthreads();
        topr[(size_t)(tok0 + (lane >> 2)) * 4 + (lane & 3)] = (int)(BASE[myE] + lr);
        __syncthreads();
    }
}
__device__ __forceinline__ void phase_gather(const Args& a, const Ctx& c, int hb) {
    const bf16* xb = (const bf16*)(a.ws + WS_XBF); bf16* xg = (bf16*)(a.ws + WS_Y); const float* ssq2 = (const float*)(a.ws + WS_SSQ2);
    const int* tope = (const int*)(a.ws + WS_TOPE); const float* topg = (const float*)(a.ws + WS_TOPG); const int* topr = (const int*)(a.ws + WS_TOPR); int* topp = (int*)(a.ws + WS_TOPP);
    float* rgate = (float*)(a.ws + WS_RGATE); float* rrstd = (float*)(a.ws + WS_RRSTD);
    unsigned* blke = (unsigned*)(a.ws + WS_BLKE) + hb * 1024; unsigned* nbt = (unsigned*)(a.ws + WS_NBT) + hb * 64; const unsigned* gcnt = (const unsigned*)(a.ws + WS_GCNT);
    LAS unsigned* BS = (LAS unsigned*)(c.lds); LAS unsigned* CN = BS + 64;
    if (c.tid == 0) { unsigned acc = 0; for (int e = 0; e < 32; ++e) { const unsigned n = ld_agent(gcnt + (hb * 32 + e) * 16); CN[e] = n; BS[e] = acc; acc += (n + 255u) >> 8; } BS[32] = acc; }
    __syncthreads();
    if (blockIdx.x == 0) { if (c.tid == 0) nbt[0] = BS[32];
        for (int e = 0; e < 32; ++e) { const int b0 = BS[e], b1 = BS[e + 1]; for (int b = b0 + c.tid; b < b1; b += 512) blke[b] = (unsigned)e; } }
    for (int i = c.gw; i < HTOK * 4; i += c.ngw) { const int tok = hb * HTOK + (i >> 2), k = i & 3;
        const int e = tope[(size_t)tok * 4 + k]; const int pos = (int)BS[e] * 256 + topr[(size_t)tok * 4 + k];
        const v4u* src = (const v4u*)(xb + (size_t)tok * DM) + c.lane * 2; v4u* dst = (v4u*)(xg + (size_t)pos * DM) + c.lane * 2;
        const v4u v0 = src[0], v1 = src[1]; dst[0] = v0; dst[1] = v1;
        if (c.lane == 0) { rgate[pos] = topg[(size_t)tok * 4 + k]; rrstd[pos] = rstd16(ssq2, (size_t)tok); topp[(size_t)tok * 4 + k] = pos; } }
    for (int e = 0; e < 32; ++e) { const int p0 = (int)BS[e] * 256 + (int)CN[e], p1 = (int)BS[e + 1] * 256;
        for (int p = p0 + c.gw; p < p1; p += c.ngw) { v4u* dst = (v4u*)(xg + (size_t)p * DM) + c.lane * 2; const v4u z = (v4u){0u, 0u, 0u, 0u}; dst[0] = z; dst[1] = z;
            if (c.lane == 0) { rgate[p] = 0.f; rrstd[p] = 0.f; } } }
    __syncthreads();
}
__device__ __forceinline__ void add16(f32x4 (&v)[4], const v4u y0, const v4u y1) {
    v[0][0] += bflo(y0.x); v[0][1] += bfhi(y0.x); v[0][2] += bflo(y0.y); v[0][3] += bfhi(y0.y); v[1][0] += bflo(y0.z); v[1][1] += bfhi(y0.z); v[1][2] += bflo(y0.w); v[1][3] += bfhi(y0.w);
    v[2][0] += bflo(y1.x); v[2][1] += bfhi(y1.x); v[2][2] += bflo(y1.y); v[2][3] += bfhi(y1.y); v[3][0] += bflo(y1.z); v[3][1] += bfhi(y1.z); v[3][2] += bflo(y1.w); v[3][3] += bfhi(y1.w);
}
__device__ __forceinline__ void phase_combine(const Args& a, const Ctx& c, int hb) {
    const bf16* y = (const bf16*)(a.ws + WS_Y); const bf16* xb = (const bf16*)(a.ws + WS_XBF); const int* topp = (const int*)(a.ws + WS_TOPP); const float* gf = a.in[24];
    for (int i = c.gw; i < HTOK; i += c.ngw) { const int tok = hb * HTOK + i;
        const int4 pp = *(const int4*)(topp + (size_t)tok * 4); const int ps[4] = {pp.x, pp.y, pp.z, pp.w};
        f32x4 v[4];
#pragma unroll
        for (int j = 0; j < 4; ++j) v[j] = (f32x4){0.f, 0.f, 0.f, 0.f};
        { const v4u* xp = (const v4u*)(xb + (size_t)tok * DM + c.lane * 16); add16(v, xp[0], xp[1]); }
#pragma unroll
        for (int k = 0; k < 4; ++k) { const v4u* yp = (const v4u*)(y + (size_t)ps[k] * DM + c.lane * 16); add16(v, yp[0], yp[1]); }
        float s = 0.f;
#pragma unroll
        for (int j = 0; j < 4; ++j) s += (v[j][0] * v[j][0] + v[j][1] * v[j][1]) + (v[j][2] * v[j][2] + v[j][3] * v[j][3]);
        const float rstd = rsqrtf(wave_sum(s) * (1.f / DM) + RMS_EPS);
        float* xr = a.out + (size_t)tok * DM + c.lane * 16;
#pragma unroll
        for (int j = 0; j < 4; ++j) { const f32x4 gg = *(const f32x4*)(gf + c.lane * 16 + 4 * j); *(f32x4*)(xr + 4 * j) = v[j] * rstd * gg; } }
}

#ifndef MK_PER_PHASE_LAUNCH
#define MK_PER_PHASE_LAUNCH 0
#endif
constexpr int NPHASES = 31;
#ifndef MK_OFF
#define MK_OFF 0u
#endif
#define MKP(k) (((MK_OFF >> (k)) & 1u) == 0u)
#define GSCHED PG8_ALIGN, PG8_SP2
typedef const __attribute__((address_space(4))) Args* KArgP;
#if defined(__HIP_DEVICE_COMPILE__)
__device__ __forceinline__ Args ldargs() { KArgP kp = (KArgP)__builtin_amdgcn_kernarg_segment_ptr(); asm volatile("" : "+s"(kp)); Args r; __builtin_memcpy(&r, (const void*)kp, sizeof(Args)); return r; }
#else
__device__ __forceinline__ Args ldargs() { return Args{}; }
#endif
__global__ void __launch_bounds__(512, 2) mk_fwd(Args a_) {
    extern __shared__ __attribute__((aligned(16))) unsigned char lds_raw[];
    Ctx c; c.lds = (LAS unsigned char*)lds_raw; c.tid = threadIdx.x; c.lane = c.tid & 63; c.wave = __builtin_amdgcn_readfirstlane(c.tid >> 6); const int wv = c.wave;
    c.G = gridDim.x; c.gw = blockIdx.x * 8 + c.wave; c.ngw = c.G * 8;
    volatile LAS unsigned* MISC = (volatile LAS unsigned*)(c.lds + MISC_OFF);
    for (int u = c.tid; u < (LDS_BYTES - RING_BYTES) / 4; u += 512) ((LAS unsigned*)(c.lds + RING_BYTES))[u] = 0u;
    __syncthreads();
    const int ph_lo = a_.ph_lo, ph_hi = a_.ph_hi;
    const bool fused = (ph_hi - ph_lo) > 1;
    unsigned* barw = (unsigned*)a_.ws + CW_BAR;
    XcdBarrier bar; bar.bar = barw; bar.x = 0; bar.st = MISC + 8; bar.t0 = wv;
    if (fused) bar = xcd_barrier_post(barw, MISC + 8, wv);
    int pc = 0;
#define PH_ON (pc >= ph_lo && pc < ph_hi)
#define PH_END do { if (PH_ON && pc + 1 < ph_hi) xcd_barrier(bar); ++pc; OPQ(c); } while (0)
    LAS unsigned char* ring = c.lds;
#define OPQ(cc) do { cc.lane = (int)__builtin_amdgcn_mbcnt_hi(~0u, __builtin_amdgcn_mbcnt_lo(~0u, 0u)); asm volatile("" : "+v"(cc.lane)); cc.wave = wv; cc.tid = wv * 64 + cc.lane; cc.gw = blockIdx.x * 8 + wv; } while (0)

    if (MKP(0) && PH_ON) { const Args a = ldargs(); unsigned char* ws = a.ws; (void)ws;  phase_prologue(a, c); __syncthreads(); }
    PH_END;
#pragma unroll
    for (int hb = 0; hb < 2; ++hb) {
        const size_t toff = (size_t)hb * HTOK;
        if (MKP(1) && PH_ON) { const Args a = ldargs(); phase_norm1(a, c, hb); }
        PH_END;
        if (MKP(2) && PH_ON) { const Args a = ldargs(); unsigned char* ws = a.ws; (void)ws;  pg8::Gemm g{(const bf16*)(ws + WS_TM), (const bf16*)(ws + WS_WIN), HTOK, NCOL, DM}; pg8::StaticOrder S; S.init(HTOK, NCOL, c.G, (int)blockIdx.x);
            EpiStore E{(bf16*)(ws + WS_PROJ), NCOL, nullptr}; pg8::gemm_phase<EpiStore, pg8::StaticOrder, GSCHED>(ring, g, S, E, wv); }
        PH_END;
        if (MKP(3) && PH_ON) { const Args a = ldargs(); unsigned char* ws = a.ws; (void)ws;  phase_hgA(a, c); }
        PH_END;
        if (MKP(17) && PH_ON) { const Args a = ldargs(); phase_swa(a, c); }
        PH_END;
        if (MKP(4) && PH_ON) { const Args a = ldargs(); phase_hgB(a, c); }
        PH_END;
        if (MKP(5) && PH_ON) { const Args a = ldargs(); phase_hgC(a, c); }
        PH_END;
        if (MKP(6) && PH_ON) { const Args a = ldargs(); unsigned char* ws = a.ws; (void)ws;  pg8::Gemm g{(const bf16*)(ws + WS_OA), (const bf16*)(ws + WS_WA), HTOK, DM, DM}; pg8::StaticOrder S; S.init(HTOK, DM, c.G, (int)blockIdx.x);
            EpiGate<false> E{(bf16*)(ws + WS_TM), (const bf16*)(ws + WS_PROJ), C_GA, a.in[6]}; pg8::gemm_phase<EpiGate<false>, pg8::StaticOrder, GSCHED>(ring, g, S, E, wv); }
        PH_END;
        if (MKP(7) && PH_ON) { const Args a = ldargs(); unsigned char* ws = a.ws; (void)ws;  pg8::Gemm g{(const bf16*)(ws + WS_OB), (const bf16*)(ws + WS_WB), HTOK, DM, DM}; pg8::StaticOrder S; S.init(HTOK, DM, c.G, (int)blockIdx.x);
            EpiGate<true> E{(bf16*)(ws + WS_TM), (const bf16*)(ws + WS_PROJ), C_GB, a.in[6] + DM}; pg8::gemm_phase<EpiGate<true>, pg8::StaticOrder, GSCHED>(ring, g, S, E, wv); }
        PH_END;
        if (MKP(8) && PH_ON) { const Args a = ldargs(); unsigned char* ws = a.ws; (void)ws;  pg8::Gemm g{(const bf16*)(ws + WS_TM), (const bf16*)(ws + WS_WMIX), HTOK, DM, DM}; pg8::StaticOrder S; S.init(HTOK, DM, c.G, (int)blockIdx.x);
            EpiResid<false> E{a.in[0] + toff * DM, (bf16*)(ws + WS_XBF) + toff * DM, (float*)(ws + WS_SSQ1) + toff * 16}; pg8::gemm_phase<EpiResid<false>, pg8::StaticOrder, GSCHED>(ring, g, S, E, wv); }
        PH_END;
    }
    if (MKP(9) && PH_ON) { const Args a = ldargs(); unsigned char* ws = a.ws; (void)ws;
        phase_expert_weights(a, c);
        { pg8::Gemm g{(const bf16*)(ws + WS_MEMBF), (const bf16*)(ws + WS_WK), NBATCH * MEMLEN, DM, DM}; pg8::StaticOrder S; S.init(NBATCH * MEMLEN, DM, c.G, (int)blockIdx.x);
          EpiStore E{(bf16*)(ws + WS_KX), DM, nullptr}; pg8::gemm_phase<EpiStore, pg8::StaticOrder, GSCHED>(ring, g, S, E, wv); }
        { pg8::Gemm g{(const bf16*)(ws + WS_WV), (const bf16*)(ws + WS_MEMBF), DM, NBATCH * MEMLEN, DM}; pg8::StaticOrder S; S.init(DM, NBATCH * MEMLEN, c.G, (int)((blockIdx.x + 64) % c.G));
          EpiStore E{(bf16*)(ws + WS_VXT), NBATCH * MEMLEN, nullptr}; pg8::gemm_phase<EpiStore, pg8::StaticOrder, GSCHED>(ring, g, S, E, wv); }
        { pg8::Gemm g{(const bf16*)(ws + WS_XBF), (const bf16*)(ws + WS_WQ), NTOK, DM, DM}; pg8::StaticOrder S; S.init(NTOK, DM, c.G, (int)blockIdx.x);
          EpiStore E{(bf16*)(ws + WS_Q), DM, (const float*)(ws + WS_SSQ1)}; pg8::gemm_phase<EpiStore, pg8::StaticOrder, GSCHED>(ring, g, S, E, wv); }
    }
    PH_END;
    if (MKP(10) && PH_ON) { const Args a = ldargs(); phase_xa(a, c); }
    PH_END;
    if (MKP(11) && PH_ON) { const Args a = ldargs(); unsigned char* ws = a.ws; (void)ws;  pg8::Gemm g{(const bf16*)(ws + WS_O), (const bf16*)(ws + WS_WO), NTOK, DM, DM}; pg8::StaticOrder S; S.init(NTOK, DM, c.G, (int)blockIdx.x);
        EpiResid<true> E{nullptr, (bf16*)(ws + WS_XBF), (float*)(ws + WS_SSQ2)}; pg8::gemm_phase<EpiResid<true>, pg8::StaticOrder, GSCHED>(ring, g, S, E, wv); }
    PH_END;
    if (MKP(12) && PH_ON) { const Args a = ldargs(); phase_router(a, c); }
    PH_END;
#pragma unroll
    for (int hb = 0; hb < 2; ++hb) {
        if (MKP(13) && PH_ON) { const Args a = ldargs(); phase_gather(a, c, hb); }
        PH_END;
        if (MKP(14) && PH_ON) { const Args a = ldargs(); unsigned char* ws = a.ws; (void)ws;  const int nb = (int)__builtin_amdgcn_readfirstlane(ld_agent((const unsigned*)(ws + WS_NBT) + hb * 64));
            pg8::Gemm g{(const bf16*)(ws + WS_Y), (const bf16*)(ws + WS_WGU), CAPH, NEXP * 2048, DM}; GroupedOrder S{nb * 8, 8, c.G, (int)blockIdx.x, (const unsigned*)(ws + WS_BLKE) + hb * 1024};
            EpiSwiglu E{(bf16*)(ws + WS_ACT), a.in[21], (const float*)(ws + WS_RRSTD)}; pg8::gemm_phase<EpiSwiglu, GroupedOrder, GSCHED>(ring, g, S, E, wv); }
        PH_END;
        if (MKP(15) && PH_ON) { const Args a = ldargs(); unsigned char* ws = a.ws; (void)ws;  const int nb = (int)__builtin_amdgcn_readfirstlane(ld_agent((const unsigned*)(ws + WS_NBT) + hb * 64));
            pg8::Gemm g{(const bf16*)(ws + WS_ACT), (const bf16*)(ws + WS_WD), CAPH, NEXP * 1024, DM}; GroupedOrder S{nb * 4, 4, c.G, (int)blockIdx.x, (const unsigned*)(ws + WS_BLKE) + hb * 1024};
            EpiDown E{(bf16*)(ws + WS_Y), a.in[23], (const float*)(ws + WS_RGATE)}; pg8::gemm_phase<EpiDown, GroupedOrder, GSCHED>(ring, g, S, E, wv); }
        PH_END;
        if (MKP(16) && PH_ON) { const Args a = ldargs(); phase_combine(a, c, hb); }
        PH_END;
    }
#undef PH_ON
#undef PH_END
}

#if defined(MK_DBG_STOP)
#ifndef MK_DBG_SRC_OUT
#define MK_DBG_SRC_OUT 0
#endif
#ifndef MK_DBG_F32
#define MK_DBG_F32 0
#endif
__global__ void dbg_dump(const unsigned short* src, float* out, size_t n, size_t N) {
    for (size_t i = (size_t)blockIdx.x * blockDim.x + threadIdx.x; i < N; i += (size_t)gridDim.x * blockDim.x) {
        if (i < n) { float v = MK_DBG_F32 ? ((const float*)src)[i] : __builtin_bit_cast(float, (unsigned)src[i] << 16); if (!(fabsf(v) < 1e30f)) v = 12345.f; out[i] = v; }
        else if (!MK_DBG_SRC_OUT) out[i] = 0.f;
    }
}
__global__ void dbg_zero_upper(float* out, size_t n0, size_t N) { for (size_t i = n0 + (size_t)blockIdx.x * blockDim.x + threadIdx.x; i < N; i += (size_t)gridDim.x * blockDim.x) out[i] = 0.f; }
#endif
extern "C" void kernel_launch(void* const* d_in, const int* in_sizes, int n_in, void* d_out, int out_size, void* d_ws, size_t ws_size, hipStream_t stream) {
    static int grid = 0;
    if (grid == 0) {
        if (n_in != 25 || out_size != NTOK * DM || ws_size < WS_END) { fprintf(stderr, "kernel_launch: unexpected problem shape (n_in %d, out %d, ws %zu); nothing launched\n", n_in, out_size, ws_size); grid = -1; return; }
        int dev = 0, cus = 0, per_cu = 0;
        if (hipGetDevice(&dev) != hipSuccess || hipDeviceGetAttribute(&cus, hipDeviceAttributeMultiprocessorCount, dev) != hipSuccess) { grid = -1; return; }
        if (hipFuncSetAttribute((const void*)mk_fwd, hipFuncAttributeMaxDynamicSharedMemorySize, LDS_BYTES) != hipSuccess) { fprintf(stderr, "kernel_launch: hipFuncSetAttribute failed\n"); grid = -1; return; }
        if (hipOccupancyMaxActiveBlocksPerMultiprocessor(&per_cu, (const void*)mk_fwd, 512, LDS_BYTES) != hipSuccess || per_cu < 1) { fprintf(stderr, "kernel_launch: occupancy query reports %d blocks per CU\n", per_cu); }
        (void)hipGetLastError();
        grid = cus;
    }
    if (grid < 0) return;
    (void)in_sizes;
    hipMemsetAsync(d_ws, 0, WS_ZERO_BYTES, stream);
    Args a{};
    for (int i = 0; i < 25; ++i) a.in[i] = (const float*)d_in[i];
    a.out = (float*)d_out; a.ws = (unsigned char*)d_ws;
#if defined(MK_DBG_STOP)
    for (int p = 0; p < MK_DBG_STOP; ++p) { a.ph_lo = p; a.ph_hi = p + 1; hipLaunchKernelGGL(mk_fwd, dim3(grid), dim3(512), LDS_BYTES, stream, a); }
    hipLaunchKernelGGL(dbg_dump, dim3(2048), dim3(256), 0, stream, (const unsigned short*)((const unsigned char*)(MK_DBG_SRC_OUT ? d_out : d_ws) + (size_t)MK_DBG_OFF_MIB * MiB), (float*)d_out, (size_t)MK_DBG_MIB * MiB / (MK_DBG_F32 ? 4 : 2), (size_t)NTOK * DM);
    if (MK_DBG_SRC_OUT) hipLaunchKernelGGL(dbg_zero_upper, dim3(2048), dim3(256), 0, stream, (float*)d_out, (size_t)MK_DBG_MIB * MiB / 2, (size_t)NTOK * DM);
#elif MK_PER_PHASE_LAUNCH
    for (int p = 0; p < NPHASES; ++p) { a.ph_lo = p; a.ph_hi = p + 1; hipLaunchKernelGGL(mk_fwd, dim3(grid), dim3(512), LDS_BYTES, stream, a);
#if defined(MK_REP_PC)
        if (p == MK_REP_PC) for (int r = 0; r < MK_REP_N; ++r) { if (p == 22) (void)hipMemsetAsync((char*)d_ws + WS_GCNT, 0, 4096, stream); hipLaunchKernelGGL(mk_fwd, dim3(grid), dim3(512), LDS_BYTES, stream, a); }
#endif
    }
#else
    a.ph_lo = 0; a.ph_hi = NPHASES;
    hipLaunchKernelGGL(mk_fwd, dim3(grid), dim3(512), LDS_BYTES, stream, a);
#endif
}
```

```cpp
#include <hip/hip_runtime.h>
#include <cstdio>
#include <cstdint>
namespace pg8 {
#define PG8_LAS __attribute__((address_space(3)))
typedef unsigned short bf16_t;
typedef short bf16x8 __attribute__((ext_vector_type(8)));
typedef float f32x4 __attribute__((ext_vector_type(4)));
typedef unsigned u32x4 __attribute__((ext_vector_type(4)));
constexpr int BM = 256, BK = 64, HALF = 128, HTB = HALF * BK * 2  , STAGE_BYTES = 8 * HTB, NXCD = 8, WGM = 8;

__host__ __device__ __forceinline__ int lds_byte(int r, int c) { const int st = (r >> 4) * 2 + (c >> 5), rr = r & 15, cc = c & 31, ob = rr * 64 + cc * 2; return st * 1024 + (ob ^ (((ob >> 9) & 1) << 5)); }
__host__ __device__ __forceinline__ void stage_rc(int b, int& R, int& C) { const int st = b / 1024, sb = b % 1024, swz = sb ^ (((sb >> 9) & 1) << 5); R = (st >> 1) * 16 + swz / 64; C = (st & 1) * 32 + (swz % 64) / 2; }
__host__ __device__ __forceinline__ int perm32(int rho) { const int n = rho >> 4, i = rho & 15; return 8 * (i >> 2) + 4 * n + (i & 3); }

struct Unit { int pm, pn, aux, cnt; };
struct Gemm { const bf16_t* A; const bf16_t* Bt; int M, N, K; };

struct StaticOrder {
    int nM, nN, nwg, G, c;
    __host__ __device__ void init(int M, int N, int G_, int c_) { nM = M / BM; nN = N / BM; nwg = nM * nN; G = G_; c = c_; }
    __host__ __device__ bool next(int i, Unit& u) const {
        const long L = (long)i * G + c; if (L >= nwg) return false;
        int wgid = (int)L; { const int q = nwg / NXCD, r = nwg % NXCD, xcd = wgid % NXCD, off = wgid / NXCD; wgid = (xcd < r ? xcd * (q + 1) : r * (q + 1) + (xcd - r) * q) + off; }
        const int nig = WGM * nN, gid = wgid / nig, fm = gid * WGM, gsz = (nM - fm) < WGM ? (nM - fm) : WGM;
        u.pm = fm + ((wgid % nig) % gsz); u.pn = (wgid % nig) / gsz; return true;
    }
    __device__ __forceinline__ void a_ready(const Unit&) const {}
    __device__ __forceinline__ void done(const Unit&) const {}
};

__device__ __forceinline__ unsigned cvt_pk_bf16(float lo, float hi) { unsigned r; asm volatile("v_cvt_pk_bf16_f32 %0, %1, %2" : "=v"(r) : "v"(lo), "v"(hi)); return r; }
typedef float f32x2 __attribute__((ext_vector_type(2)));
template <class Epi, class Sched, bool ALIGN_EPI = false, bool SP2 = false>
__device__ __forceinline__ void gemm_phase(PG8_LAS unsigned char* lds, const Gemm g, const Sched& S, const Epi& E, const int wave_in) {
    unsigned z_ = 0u; asm volatile("" : "+v"(z_)); const int tid_ = (int)__builtin_amdgcn_mbcnt_hi(~0u, __builtin_amdgcn_mbcnt_lo(~0u, z_)) + 64 * wave_in;
    const int tid = tid_, wid = __builtin_amdgcn_readfirstlane(tid >> 6), lane = tid & 63, wr = wid >> 2, wc = wid & 3, fr = lane & 15, fq = lane >> 4;
    const int K = g.K, nt = K / BK;
    unsigned voffA[2], voffB[2];
#pragma unroll
    for (int i = 0; i < 2; ++i) { int R, C; stage_rc(tid * 16 + i * 8192, R, C); const int Rb = Epi::PERM ? ((R & ~31) + perm32(R & 31)) : R;
        voffA[i] = (unsigned)(R * K + C) * 2u; voffB[i] = (unsigned)(Rb * K + C) * 2u; }
    const size_t kstep = (size_t)(BK * 2);
    const size_t hstep = (size_t)HALF * K * 2;
    const size_t tstep = 2 * hstep;
    const unsigned ldsw = (unsigned)wid * 1024u;
    const int aoff = lds_byte(wr * 64 + fr, fq * 8), boff = lds_byte(wc * 32 + fr, fq * 8);
#define PG8_SA(b, h) (((b) * 2 + (h)) * HTB)
#define PG8_SB(b, h) ((4 + (b) * 2 + (h)) * HTB)
#define PG8_STAGE(bufoff, gbase, voff) do { _Pragma("unroll") for (int _i = 0; _i < 2; ++_i) \
        __builtin_amdgcn_global_load_lds((const unsigned*)((const char*)(gbase) + (voff)[_i]), (PG8_LAS unsigned*)(lds + (bufoff) + ldsw + _i * 8192), 16, 0, 0); } while (0)
#define PG8_LDA(dst, b, h) do { _Pragma("unroll") for (int m = 0; m < 4; ++m) _Pragma("unroll") for (int k = 0; k < 2; ++k) dst[m][k] = *(const PG8_LAS bf16x8*)(lds + PG8_SA(b, h) + aoff + m * 2048 + k * 1024); } while (0)
#define PG8_LDB(dst, b, h) do { _Pragma("unroll") for (int n = 0; n < 2; ++n) _Pragma("unroll") for (int k = 0; k < 2; ++k) dst[n][k] = *(const PG8_LAS bf16x8*)(lds + PG8_SB(b, h) + boff + n * 2048 + k * 1024); } while (0)
#define PG8_MMA(ai, bj, At, Bt) do { __builtin_amdgcn_s_setprio(1); _Pragma("unroll") for (int m = 0; m < 4; ++m) _Pragma("unroll") for (int n = 0; n < 2; ++n) _Pragma("unroll") for (int k = 0; k < 2; ++k) \
        acc[ai][bj][m][n] = __builtin_amdgcn_mfma_f32_16x16x32_bf16(Bt[n][k], At[m][k], acc[ai][bj][m][n], 0, 0, 0); __builtin_amdgcn_s_setprio(0); } while (0)
#define PG8_WAIT_V(n) asm volatile("s_waitcnt vmcnt(" #n ")" ::: "memory")
#define PG8_WAIT_L(n) asm volatile("s_waitcnt lgkmcnt(" #n ")" ::: "memory")
#define PG8_BAR __builtin_amdgcn_s_barrier()
#define PG8_SCHED __builtin_amdgcn_sched_barrier(0)
    Unit cur, nxt; int ui = 0;
    if (!S.next(0, cur)) return;
    f32x4 acc[2][2][4][2];
#pragma unroll
    for (int a = 0; a < 2; ++a)
#pragma unroll
        for (int b = 0; b < 2; ++b)
#pragma unroll
            for (int m = 0; m < 4; ++m)
#pragma unroll
                for (int n = 0; n < 2; ++n) acc[a][b][m][n] = (f32x4){0.f, 0.f, 0.f, 0.f};
    bf16x8 At[4][2], B0[2][2], B1[2][2];
    const char* cA = (const char*)g.A + (size_t)cur.pm * tstep; const char* cB = (const char*)g.Bt + (size_t)cur.pn * tstep;
    S.a_ready(cur);
    if constexpr (SP2) {
        PG8_STAGE(PG8_SB(0, 0), cB, voffB); PG8_STAGE(PG8_SB(0, 1), cB + hstep, voffB); PG8_STAGE(PG8_SA(0, 0), cA, voffA); PG8_STAGE(PG8_SA(0, 1), cA + hstep, voffA);
        if (wr == 1) PG8_BAR;
        PG8_WAIT_V(2); PG8_BAR;
        PG8_STAGE(PG8_SB(1, 0), cB + kstep, voffB); PG8_STAGE(PG8_SA(1, 0), cA + kstep, voffA); PG8_STAGE(PG8_SB(1, 1), cB + hstep + kstep, voffB);
        PG8_WAIT_V(6); PG8_BAR;
    } else {
        PG8_STAGE(PG8_SB(0, 0), cB, voffB); PG8_STAGE(PG8_SA(0, 0), cA, voffA); PG8_STAGE(PG8_SB(0, 1), cB + hstep, voffB); PG8_STAGE(PG8_SA(0, 1), cA + hstep, voffA);
        if (wr == 1) PG8_BAR;
        PG8_WAIT_V(4); PG8_BAR;
        PG8_STAGE(PG8_SB(1, 0), cB + kstep, voffB); PG8_STAGE(PG8_SA(1, 0), cA + kstep, voffA); PG8_STAGE(PG8_SB(1, 1), cB + hstep + kstep, voffB);
        PG8_WAIT_V(6); PG8_BAR;
    }
    for (;;) {
        const bool has_next = S.next(ui + 1, nxt);
        const char* nA = has_next ? (const char*)g.A + (size_t)nxt.pm * tstep : cA; const char* nB = has_next ? (const char*)g.Bt + (size_t)nxt.pn * tstep : cB;
        for (int t = 0; t < nt; t += 2) {
            const bool last = (t == nt - 2);
            const char* a1 = cA + (size_t)(t + 1) * kstep;
            const char* a2 = last ? nA : cA + (size_t)(t + 2) * kstep; const char* b2 = last ? nB : cB + (size_t)(t + 2) * kstep;
            const char* a3 = a2 + kstep; const char* b3 = b2 + kstep;
            if (last && has_next) S.a_ready(nxt);
            if constexpr (SP2) {
            PG8_LDB(B0, 0, 0); PG8_LDB(B1, 0, 1); PG8_SCHED; PG8_LDA(At, 0, 0); PG8_STAGE(PG8_SA(1, 1), a1 + hstep, voffA);
            PG8_WAIT_V(8); PG8_WAIT_L(0); PG8_BAR; PG8_MMA(0, 0, At, B0); PG8_MMA(0, 1, At, B1); PG8_BAR; PG8_SCHED;
            PG8_LDA(At, 0, 1); PG8_STAGE(PG8_SB(0, 0), b2, voffB); PG8_STAGE(PG8_SB(0, 1), b2 + hstep, voffB); PG8_STAGE(PG8_SA(0, 0), a2, voffA);
            PG8_WAIT_V(8); PG8_WAIT_L(0); PG8_BAR; PG8_MMA(1, 0, At, B0); PG8_MMA(1, 1, At, B1); PG8_BAR; PG8_SCHED;
            PG8_LDB(B0, 1, 0); PG8_LDB(B1, 1, 1); PG8_SCHED; PG8_LDA(At, 1, 0); PG8_STAGE(PG8_SA(0, 1), a2 + hstep, voffA);
            PG8_WAIT_V(8); PG8_WAIT_L(0); PG8_BAR; PG8_MMA(0, 0, At, B0); PG8_MMA(0, 1, At, B1); PG8_BAR; PG8_SCHED;
            PG8_LDA(At, 1, 1); PG8_STAGE(PG8_SB(1, 0), b3, voffB); PG8_STAGE(PG8_SB(1, 1), b3 + hstep, voffB); PG8_STAGE(PG8_SA(1, 0), a3, voffA);
            PG8_WAIT_V(8); PG8_WAIT_L(0); PG8_BAR; PG8_MMA(1, 0, At, B0); PG8_MMA(1, 1, At, B1); PG8_BAR; PG8_SCHED;
            } else {
            PG8_LDB(B0, 0, 0); PG8_SCHED; PG8_LDA(At, 0, 0); PG8_STAGE(PG8_SA(1, 1), a1 + hstep, voffA);
            PG8_WAIT_L(8); PG8_BAR; PG8_WAIT_L(0); PG8_MMA(0, 0, At, B0); PG8_BAR; PG8_SCHED;
            PG8_LDB(B1, 0, 1); PG8_STAGE(PG8_SB(0, 0), b2, voffB);
            PG8_BAR; PG8_WAIT_L(0); PG8_MMA(0, 1, At, B1); PG8_BAR;
            PG8_LDA(At, 0, 1); PG8_STAGE(PG8_SA(0, 0), a2, voffA);
            PG8_BAR; PG8_WAIT_L(0); PG8_MMA(1, 0, At, B0); PG8_BAR; PG8_SCHED;
            PG8_STAGE(PG8_SB(0, 1), b2 + hstep, voffB);
            PG8_WAIT_V(6); PG8_BAR; PG8_MMA(1, 1, At, B1); PG8_BAR;
            PG8_LDB(B0, 1, 0); PG8_SCHED; PG8_LDA(At, 1, 0); PG8_STAGE(PG8_SA(0, 1), a2 + hstep, voffA);
            PG8_WAIT_L(8); PG8_BAR; PG8_WAIT_L(0); PG8_MMA(0, 0, At, B0); PG8_BAR; PG8_SCHED;
            PG8_LDB(B1, 1, 1); PG8_STAGE(PG8_SB(1, 0), b3, voffB);
            PG8_BAR; PG8_WAIT_L(0); PG8_MMA(0, 1, At, B1); PG8_BAR;
            PG8_LDA(At, 1, 1); PG8_STAGE(PG8_SA(1, 0), a3, voffA);
            PG8_BAR; PG8_WAIT_L(0); PG8_MMA(1, 0, At, B0); PG8_BAR; PG8_SCHED;
            PG8_STAGE(PG8_SB(1, 1), b3 + hstep, voffB);
            PG8_WAIT_V(6); PG8_BAR; PG8_MMA(1, 1, At, B1); PG8_BAR;
            }
        }
        if constexpr (ALIGN_EPI) { if (wr == 0) PG8_BAR; }
        if constexpr (!Epi::AFTER_DRAIN) { E(acc, cur, wr, wc, fr, fq); S.done(cur); }
        if (!has_next) break;
#pragma unroll
        for (int a = 0; a < 2; ++a)
#pragma unroll
            for (int b = 0; b < 2; ++b)
#pragma unroll
                for (int m = 0; m < 4; ++m)
#pragma unroll
                    for (int n = 0; n < 2; ++n) acc[a][b][m][n] = (f32x4){0.f, 0.f, 0.f, 0.f};
        cur = nxt; cA = nA; cB = nB; ++ui;
        if constexpr (ALIGN_EPI) { if (wr == 1) PG8_BAR; }
    }
    PG8_WAIT_V(0);
    if constexpr (!ALIGN_EPI) { if (wr == 0) PG8_BAR; }
    PG8_BAR;
    if constexpr (Epi::AFTER_DRAIN) { E.fused(acc, cur, wr, wc, fr, fq, lds, wid, lane); S.done(cur); }
#undef PG8_SA
#undef PG8_SB
#undef PG8_STAGE
#undef PG8_LDA
#undef PG8_LDB
#undef PG8_MMA
#undef PG8_WAIT_V
#undef PG8_WAIT_L
#undef PG8_BAR
#undef PG8_SCHED
}
template <class Epi, class Sched>
__device__ __forceinline__ void gemm_phase_gather(PG8_LAS unsigned char* lds, const Gemm g, const Sched& S, const Epi& E, const int wave_in) {
    unsigned z_ = 0u; asm volatile("" : "+v"(z_)); const int tid_ = (int)__builtin_amdgcn_mbcnt_hi(~0u, __builtin_amdgcn_mbcnt_lo(~0u, z_)) + 64 * wave_in;
    const int tid = tid_, wid = __builtin_amdgcn_readfirstlane(tid >> 6), lane = tid & 63, wr = wid >> 2, wc = wid & 3, fr = lane & 15, fq = lane >> 4;
    constexpr bool ALIGN_EPI = true, SP2 = true;
    const int K = g.K, nt = K / BK;
    unsigned voffB[2]; int RA0; unsigned CA0;
#pragma unroll
    for (int i = 0; i < 2; ++i) { int R, C; stage_rc(tid * 16 + i * 8192, R, C); const int Rb = Epi::PERM ? ((R & ~31) + perm32(R & 31)) : R;
        if (i == 0) { RA0 = R; CA0 = (unsigned)C * 2u; } voffB[i] = (unsigned)(Rb * K + C) * 2u; }
    unsigned ro[2], rn[2][2];
    const size_t kstep = (size_t)(BK * 2);
    const size_t hstep = (size_t)HALF * K * 2;
    const size_t tstep = 2 * hstep;
    const unsigned ldsw = (unsigned)wid * 1024u;
    const int aoff = lds_byte(wr * 64 + fr, fq * 8), boff = lds_byte(wc * 32 + fr, fq * 8);
#define PG8_SA(b, h) (((b) * 2 + (h)) * HTB)
#define PG8_SB(b, h) ((4 + (b) * 2 + (h)) * HTB)
#define PG8_STAGE(bufoff, gbase, voff) do { _Pragma("unroll") for (int _i = 0; _i < 2; ++_i) \
        __builtin_amdgcn_global_load_lds((const unsigned*)((const char*)(gbase) + (voff)[_i]), (PG8_LAS unsigned*)(lds + (bufoff) + ldsw + _i * 8192), 16, 0, 0); } while (0)
#define PG8_STAGE_G(bufoff, kbyte, pk) do { _Pragma("unroll") for (int _i = 0; _i < 2; ++_i) { const unsigned _row = _i ? ((pk) >> 16) : ((pk) & 0xffffu); \
        __builtin_amdgcn_global_load_lds((const unsigned*)((const char*)g.A + (kbyte) + (_row * ((unsigned)K * 2u) + CA0)), (PG8_LAS unsigned*)(lds + (bufoff) + ldsw + _i * 8192), 16, 0, 0); } } while (0)
#define PG8_LDA(dst, b, h) do { _Pragma("unroll") for (int m = 0; m < 4; ++m) _Pragma("unroll") for (int k = 0; k < 2; ++k) dst[m][k] = *(const PG8_LAS bf16x8*)(lds + PG8_SA(b, h) + aoff + m * 2048 + k * 1024); } while (0)
#define PG8_LDB(dst, b, h) do { _Pragma("unroll") for (int n = 0; n < 2; ++n) _Pragma("unroll") for (int k = 0; k < 2; ++k) dst[n][k] = *(const PG8_LAS bf16x8*)(lds + PG8_SB(b, h) + boff + n * 2048 + k * 1024); } while (0)
#define PG8_MMA(ai, bj, At, Bt) do { __builtin_amdgcn_s_setprio(1); _Pragma("unroll") for (int m = 0; m < 4; ++m) _Pragma("unroll") for (int n = 0; n < 2; ++n) _Pragma("unroll") for (int k = 0; k < 2; ++k) \
        acc[ai][bj][m][n] = __builtin_amdgcn_mfma_f32_16x16x32_bf16(Bt[n][k], At[m][k], acc[ai][bj][m][n], 0, 0, 0); __builtin_amdgcn_s_setprio(0); } while (0)
#define PG8_WAIT_V(n) asm volatile("s_waitcnt vmcnt(" #n ")" ::: "memory")
#define PG8_WAIT_L(n) asm volatile("s_waitcnt lgkmcnt(" #n ")" ::: "memory")
#define PG8_BAR __builtin_amdgcn_s_barrier()
#define PG8_SCHED __builtin_amdgcn_sched_barrier(0)
    Unit cur, nxt; int ui = 0;
    if (!S.next(0, cur)) return;
    f32x4 acc[2][2][4][2];
#pragma unroll
    for (int a = 0; a < 2; ++a)
#pragma unroll
        for (int b = 0; b < 2; ++b)
#pragma unroll
            for (int m = 0; m < 4; ++m)
#pragma unroll
                for (int n = 0; n < 2; ++n) acc[a][b][m][n] = (f32x4){0.f, 0.f, 0.f, 0.f};
    bf16x8 At[4][2], B0[2][2], B1[2][2];
    const char* cB = (const char*)g.Bt + (size_t)cur.pn * tstep;
    S.a_ready(cur);
    S.rows(cur, RA0, rn); ro[0] = rn[0][0] | (rn[0][1] << 16); ro[1] = rn[1][0] | (rn[1][1] << 16);
    if constexpr (SP2) {
        PG8_STAGE(PG8_SB(0, 0), cB, voffB); PG8_STAGE(PG8_SB(0, 1), cB + hstep, voffB); PG8_STAGE_G(PG8_SA(0, 0), 0, ro[0]); PG8_STAGE_G(PG8_SA(0, 1), 0, ro[1]);
        if (wr == 1) PG8_BAR;
        PG8_WAIT_V(2); PG8_BAR;
        PG8_STAGE(PG8_SB(1, 0), cB + kstep, voffB); PG8_STAGE_G(PG8_SA(1, 0), kstep, ro[0]); PG8_STAGE(PG8_SB(1, 1), cB + hstep + kstep, voffB);
        PG8_WAIT_V(6); PG8_BAR;
    }
    for (;;) {
        const bool has_next = S.next(ui + 1, nxt);
        const char* nB = has_next ? (const char*)g.Bt + (size_t)nxt.pn * tstep : cB;
        for (int t = 0; t < nt; t += 2) {
            const bool last = (t == nt - 2);
            const size_t k1 = (size_t)(t + 1) * kstep, k2 = last ? (size_t)0 : (size_t)(t + 2) * kstep, k3 = k2 + kstep;
            const char* b2 = last ? nB : cB + (size_t)(t + 2) * kstep; const char* b3 = b2 + kstep;
            if (t == nt - 4 && has_next) S.rows(nxt, RA0, rn);
            const unsigned c1 = ro[1];
            unsigned s0 = ro[0], s1 = ro[1];
            if (last && has_next) { unsigned q0 = rn[0][0], q1 = rn[0][1], q2 = rn[1][0], q3 = rn[1][1]; asm volatile("" : "+v"(q0), "+v"(q1), "+v"(q2), "+v"(q3));
                s0 = q0 | (q1 << 16); s1 = q2 | (q3 << 16); ro[0] = s0; ro[1] = s1; }
            if (last && has_next) S.a_ready(nxt);
            if constexpr (SP2) {
            PG8_LDB(B0, 0, 0); PG8_LDB(B1, 0, 1); PG8_SCHED; PG8_LDA(At, 0, 0); PG8_STAGE_G(PG8_SA(1, 1), k1, c1);
            PG8_WAIT_V(8); PG8_WAIT_L(0); PG8_BAR; PG8_MMA(0, 0, At, B0); PG8_MMA(0, 1, At, B1); PG8_BAR; PG8_SCHED;
            PG8_LDA(At, 0, 1); PG8_STAGE(PG8_SB(0, 0), b2, voffB); PG8_STAGE(PG8_SB(0, 1), b2 + hstep, voffB); PG8_STAGE_G(PG8_SA(0, 0), k2, s0);
            PG8_WAIT_V(8); PG8_WAIT_L(0); PG8_BAR; PG8_MMA(1, 0, At, B0); PG8_MMA(1, 1, At, B1); PG8_BAR; PG8_SCHED;
            PG8_LDB(B0, 1, 0); PG8_LDB(B1, 1, 1); PG8_SCHED; PG8_LDA(At, 1, 0); PG8_STAGE_G(PG8_SA(0, 1), k2, s1);
            PG8_WAIT_V(8); PG8_WAIT_L(0); PG8_BAR; PG8_MMA(0, 0, At, B0); PG8_MMA(0, 1, At, B1); PG8_BAR; PG8_SCHED;
            PG8_LDA(At, 1, 1); PG8_STAGE(PG8_SB(1, 0), b3, voffB); PG8_STAGE(PG8_SB(1, 1), b3 + hstep, voffB); PG8_STAGE_G(PG8_SA(1, 0), k3, s0);
            PG8_WAIT_V(8); PG8_WAIT_L(0); PG8_BAR; PG8_MMA(1, 0, At, B0); PG8_MMA(1, 1, At, B1); PG8_BAR; PG8_SCHED;
            }
        }
        if constexpr (ALIGN_EPI) { if (wr == 0) PG8_BAR; }
        if constexpr (!Epi::AFTER_DRAIN) { E(acc, cur, wr, wc, fr, fq); S.done(cur); }
        if (!has_next) break;
#pragma unroll
        for (int a = 0; a < 2; ++a)
#pragma unroll
            for (int b = 0; b < 2; ++b)
#pragma unroll
                for (int m = 0; m < 4; ++m)
#pragma unroll
                    for (int n = 0; n < 2; ++n) acc[a][b][m][n] = (f32x4){0.f, 0.f, 0.f, 0.f};
        cur = nxt; cB = nB; ++ui;
        if constexpr (ALIGN_EPI) { if (wr == 1) PG8_BAR; }
    }
    PG8_WAIT_V(0);
    if constexpr (!ALIGN_EPI) { if (wr == 0) PG8_BAR; }
    PG8_BAR;
    if constexpr (Epi::AFTER_DRAIN) { E.fused(acc, cur, wr, wc, fr, fq, lds, wid, lane); S.done(cur); }
#undef PG8_SA
#undef PG8_SB
#undef PG8_STAGE
#undef PG8_STAGE_G
#undef PG8_LDA
#undef PG8_LDB
#undef PG8_MMA
#undef PG8_WAIT_V
#undef PG8_WAIT_L
#undef PG8_BAR
#undef PG8_SCHED
}
}

#ifndef PG8_SP2
#define PG8_SP2 true
#endif
#ifndef PG8_ALIGN
#define PG8_ALIGN true
#endif

constexpr int NTOK = 65536, DM = 1024, NCOL = 7680, SEQ = 4096, NBATCH = 16, HTOK = 32768, MEMLEN = 256;
constexpr int C_HQ = 0, C_HF = 1024, C_HI = 2048, C_HG = 3072, C_SQ = 4096, C_SK = 5120, C_SV = 5376, C_GA = 5632, C_GB = 6656;
constexpr int NEXP = 32, TOPK = 4, CAPH = HTOK * TOPK + NEXP * 256;
constexpr float RMS_EPS = 1e-5f;
constexpr size_t MiB = (size_t)1 << 20;
constexpr size_t WS_ZERO_BYTES = 2 * MiB;
constexpr size_t WS_GCNT = 1 * MiB;
constexpr int CW_TMO = 0, CW_BAR = 4096;
constexpr size_t WS_LB = 2 * MiB, WS_LUT = 2 * MiB + 4096, WS_BLKE = 2 * MiB + 16384, WS_NBT = 2 * MiB + 32768;
constexpr size_t WS_TOPE = 3 * MiB, WS_TOPG = 4 * MiB, WS_TOPR = 5 * MiB, WS_TOPP = 6 * MiB, WS_RGATE = 7 * MiB, WS_RRSTD = 8 * MiB, WS_D12 = 10 * MiB;
constexpr size_t WS_WIN = 16 * MiB, WS_WA = 31 * MiB, WS_WB = 33 * MiB, WS_WMIX = 35 * MiB, WS_WQ = 37 * MiB, WS_WK = 39 * MiB, WS_WV = 41 * MiB, WS_WO = 43 * MiB, WS_WR = 45 * MiB;
constexpr size_t WS_MEMBF = 46 * MiB, WS_KX = 54 * MiB, WS_VXT = 62 * MiB;
constexpr size_t WS_XBF = 72 * MiB;
constexpr size_t WS_PROJ = 200 * MiB, WS_OA = 680 * MiB, WS_OB = 744 * MiB, WS_TM = 808 * MiB;
constexpr size_t WS_Q = 664 * MiB, WS_O = 792 * MiB;
constexpr size_t WS_WGU = 200 * MiB, WS_WD = 328 * MiB, WS_ACT = 392 * MiB, WS_Y = 664 * MiB, WS_SSQ1 = 936 * MiB, WS_SSQ2 = 940 * MiB, WS_RTOK = 944 * MiB, WS_RGATE2 = 952 * MiB, WS_RRSTD2 = 960 * MiB, WS_END = 968 * MiB;
constexpr size_t OUT_US = 128 * MiB;

#define GAS __attribute__((address_space(1)))
#define LAS __attribute__((address_space(3)))
typedef unsigned short bf16;
typedef unsigned v4u __attribute__((ext_vector_type(4)));
typedef unsigned v2u __attribute__((ext_vector_type(2)));
typedef float f32x4 __attribute__((ext_vector_type(4)));
typedef short bf16x8 __attribute__((ext_vector_type(8)));
typedef short s16x4 __attribute__((ext_vector_type(4)));
#define RLX_AGENT __ATOMIC_RELAXED, __HIP_MEMORY_SCOPE_AGENT
#define LDS_WAIT() asm volatile("s_waitcnt lgkmcnt(0)" ::: "memory")
#define CFENCE() asm volatile("" ::: "memory")
__device__ __forceinline__ unsigned f2bf(float f) { unsigned u = __builtin_bit_cast(unsigned, f); return (u + 0x7fffu + ((u >> 16) & 1u)) >> 16; }
typedef float f32x2_t __attribute__((ext_vector_type(2))); typedef __bf16 bf16x2_t __attribute__((ext_vector_type(2)));
__device__ __forceinline__ unsigned pk2(float lo, float hi) { f32x2_t v = {lo, hi}; bf16x2_t b = __builtin_convertvector(v, bf16x2_t); return __builtin_bit_cast(unsigned, b); }
__device__ __forceinline__ float bflo(unsigned w) { return __builtin_bit_cast(float, w << 16); }
__device__ __forceinline__ float bfhi(unsigned w) { return __builtin_bit_cast(float, w & 0xffff0000u); }
__device__ __forceinline__ float sigm(float x) { return 1.f / (1.f + __expf(-x)); }
__device__ __forceinline__ float shx(float v, int mask, int lane) { return __builtin_bit_cast(float, __builtin_amdgcn_ds_bpermute((lane ^ mask) << 2, __builtin_bit_cast(int, v))); }
__device__ __forceinline__ float wave_sum(float v, int lane) {
#pragma unroll
    for (int o = 1; o < 64; o <<= 1) v += shx(v, o, lane);
    return v;
}
__device__ __forceinline__ f32x4 mfma16(bf16x8 a, bf16x8 b, f32x4 c) { return __builtin_amdgcn_mfma_f32_16x16x32_bf16(a, b, c, 0, 0, 0); }
__device__ __forceinline__ s16x4 vtr(const LAS unsigned char* p) { return __builtin_bit_cast(s16x4, __builtin_amdgcn_ds_read_tr16_b64_v4i16((LAS s16x4*)p)); }
__device__ __forceinline__ bf16x8 cat8(s16x4 lo, s16x4 hi) { return __builtin_shufflevector(lo, hi, 0, 1, 2, 3, 4, 5, 6, 7); }
__device__ __forceinline__ bf16x8 pack8(f32x4 a, f32x4 b) { v4u w; w.x = pk2(a[0], a[1]); w.y = pk2(a[2], a[3]); w.z = pk2(b[0], b[1]); w.w = pk2(b[2], b[3]); return __builtin_bit_cast(bf16x8, w); }
__device__ __forceinline__ float rstd16(const float* ssqp, size_t row) { const f32x4* p = (const f32x4*)(ssqp + row * 16); const f32x4 a = p[0], b = p[1], c = p[2], d = p[3];
    const float s = ((a[0] + a[1]) + (a[2] + a[3])) + ((b[0] + b[1]) + (b[2] + b[3])) + ((c[0] + c[1]) + (c[2] + c[3])) + ((d[0] + d[1]) + (d[2] + d[3])); return rsqrtf(s * (1.f / 1024.f) + 1e-5f); }
__device__ __forceinline__ unsigned ld_agent(const unsigned* p) { return __hip_atomic_load(p, RLX_AGENT); }


#define XB_TMO      128
#define XB_XCNT(j)  (256  + 64 * (j))
#define XB_XSUB(j)  (1280 + 64 * (j))
#define XB_XGEN(j)  (2304 + 64 * (j))
#define XB_TOP      3328
#define XB_TOPGEN   3392
#define XCD_BAR_WORDS 3456
#define XB_SPIN_CAP (1u << 18)

__device__ __forceinline__ unsigned xb_ld(unsigned* p)              { return __hip_atomic_load(p, __ATOMIC_RELAXED, __HIP_MEMORY_SCOPE_AGENT); }
__device__ __forceinline__ unsigned xb_add(unsigned* p, unsigned v) { return __hip_atomic_fetch_add(p, v, __ATOMIC_RELAXED, __HIP_MEMORY_SCOPE_AGENT); }
__device__ __forceinline__ unsigned xb_xcc_id() { return (unsigned)__builtin_amdgcn_s_getreg((3 << 11) | 20) & 0xFu; }
#define XB_SPIN(cond, bar) do { unsigned _sp = 0; while (cond) { __builtin_amdgcn_s_sleep(1); \
    if ((++_sp & 255u) == 0u) { if (xb_ld(&(bar)[XB_TMO])) break; if (_sp > XB_SPIN_CAP) { atomicAdd(&(bar)[XB_TMO], 1u); break; } } } } while (0)

struct XcdBarrier {
    unsigned* bar; unsigned x; int t0;
    volatile LAS unsigned* st;
};

__device__ __forceinline__ bool xb_is_t0(int wave) { return wave == 0 && __builtin_amdgcn_mbcnt_hi(~0u, __builtin_amdgcn_mbcnt_lo(~0u, 0u)) == 0u; }
__device__ __forceinline__ XcdBarrier xcd_barrier_post(unsigned* bar, volatile LAS unsigned* st, int wave) {
    XcdBarrier b; b.bar = bar; b.x = xb_xcc_id(); b.st = st; b.t0 = wave;
    if (xb_is_t0(wave)) (void)xb_add(&bar[XB_XCNT(b.x)], 1u);
    return b;
}
__device__ __forceinline__ void xcd_barrier_complete(unsigned* bar, unsigned x, unsigned& nloc, unsigned& nx) {
    const unsigned G = gridDim.x * gridDim.y * gridDim.z;
    unsigned sum, cnt, mine, sp = 0u;
    for (;;) {
        sum = 0u; cnt = 0u; mine = 0u;
#pragma unroll
        for (unsigned j = 0; j < 16; ++j) { const unsigned c = xb_ld(&bar[XB_XCNT(j)]); sum += c; cnt += (c > 0u) ? 1u : 0u; mine = (j == x) ? c : mine; }
        if (sum == G) break;
        __builtin_amdgcn_s_sleep(1);
        if ((++sp & 255u) == 0u) { if (xb_ld(&bar[XB_TMO])) break; if (sp > XB_SPIN_CAP) { atomicAdd(&bar[XB_TMO], 1u); break; } }
    }
    nloc = mine > 0u ? mine : 1u; nx = cnt > 0u ? cnt : 1u;
}

__device__ __forceinline__ void xcd_barrier(const XcdBarrier& b) {
    asm volatile("s_waitcnt vmcnt(0)" ::: "memory");
    __syncthreads();
    if (xb_is_t0(b.t0)) {
        unsigned* bar = b.bar;
        __builtin_amdgcn_s_waitcnt(0);
        unsigned nloc = b.st[0], nx = b.st[1];
        if (nloc == 0u) { xcd_barrier_complete(bar, b.x, nloc, nx); b.st[0] = nloc; b.st[1] = nx; }
        const unsigned old = xb_add(&bar[XB_XSUB(b.x)], 1u);
        const unsigned gen = old / nloc;
        if (old + 1u == (gen + 1u) * nloc) {
            __builtin_amdgcn_fence(__ATOMIC_RELEASE, "agent");
            asm volatile("s_waitcnt vmcnt(0)" ::: "memory");
            const unsigned og = xb_add(&bar[XB_TOP], 1u);
            const unsigned tg = og / nx;
            if (og + 1u == (tg + 1u) * nx) xb_add(&bar[XB_TOPGEN], 1u);
            else XB_SPIN(xb_ld(&bar[XB_TOPGEN]) == tg, bar);
            __builtin_amdgcn_fence(__ATOMIC_ACQUIRE, "agent");
            xb_add(&bar[XB_XGEN(b.x)], 1u);
            asm volatile("s_waitcnt vmcnt(0)" ::: "memory");
        } else {
            XB_SPIN(xb_ld(&bar[XB_XGEN(b.x)]) == gen, bar);
            __builtin_amdgcn_fence(__ATOMIC_ACQUIRE, "agent");
            asm volatile("s_waitcnt vmcnt(0)" ::: "memory");
        }
    }
    __syncthreads();
}

struct Args {
    const float* in[25];
    float* out; unsigned char* ws;
    int ph_lo, ph_hi;
};

using pg8::Unit;
struct EpiStore {
    static constexpr bool PERM = true, AFTER_DRAIN = false;
    bf16* O; int ldc; const float* ssq;
    __device__ __forceinline__ void operator()(const f32x4 (&acc)[2][2][4][2], const Unit& u, int wr, int wc, int fr, int fq) const {
        const int row0 = u.pm * 256 + wr * 64 + fr, col0 = u.pn * 256 + wc * 32 + 8 * fq;
#pragma unroll
        for (int ai = 0; ai < 2; ++ai) { float sc[4];
#pragma unroll
            for (int m = 0; m < 4; ++m) sc[m] = ssq ? rstd16(ssq, (size_t)(row0 + ai * 128 + m * 16)) : 1.f;
#pragma unroll
            for (int m = 0; m < 4; ++m) { const int row = row0 + ai * 128 + m * 16; bf16* rowp = O + (size_t)row * ldc + col0;
#pragma unroll
                for (int bj = 0; bj < 2; ++bj) { const f32x4 v0 = acc[ai][bj][m][0] * sc[m], v1 = acc[ai][bj][m][1] * sc[m];
                    v4u w; w.x = pk2(v0[0], v0[1]); w.y = pk2(v0[2], v0[3]); w.z = pk2(v1[0], v1[1]); w.w = pk2(v1[2], v1[3]);
                    *(v4u*)(rowp + bj * 128) = w; } } }
    }
};
template <bool ADD> struct EpiGate {
    static constexpr bool PERM = true, AFTER_DRAIN = false;
    bf16* T; const bf16* proj; int gcol; const float* bias;
    __device__ __forceinline__ void operator()(const f32x4 (&acc)[2][2][4][2], const Unit& u, int wr, int wc, int fr, int fq) const {
        const int row0 = u.pm * 256 + wr * 64 + fr, col0 = u.pn * 256 + wc * 32 + 8 * fq;
        f32x4 bv[2][2];
#pragma unroll
        for (int bj = 0; bj < 2; ++bj)
#pragma unroll
            for (int n = 0; n < 2; ++n) bv[bj][n] = *(const f32x4*)(bias + col0 + bj * 128 + 4 * n);
#pragma unroll
        for (int am = 0; am < 4; ++am) { const int ai = am >> 1, mh = am & 1; v4u gw[2][2], tw[2][2];
#pragma unroll
            for (int mm = 0; mm < 2; ++mm)
#pragma unroll
                for (int bj = 0; bj < 2; ++bj) { const int row = row0 + ai * 128 + (2 * mh + mm) * 16; gw[mm][bj] = *(const v4u*)(proj + (size_t)row * NCOL + gcol + col0 + bj * 128);
                    if (ADD) tw[mm][bj] = *(const v4u*)(T + (size_t)row * DM + col0 + bj * 128); }
#pragma unroll
            for (int mm = 0; mm < 2; ++mm)
#pragma unroll
                for (int bj = 0; bj < 2; ++bj) { const int m = 2 * mh + mm; const int row = row0 + ai * 128 + m * 16; const v4u g4 = gw[mm][bj]; float r[8];
                    r[0] = sigm(bflo(g4.x) + bv[bj][0][0]) * acc[ai][bj][m][0][0]; r[1] = sigm(bfhi(g4.x) + bv[bj][0][1]) * acc[ai][bj][m][0][1];
                    r[2] = sigm(bflo(g4.y) + bv[bj][0][2]) * acc[ai][bj][m][0][2]; r[3] = sigm(bfhi(g4.y) + bv[bj][0][3]) * acc[ai][bj][m][0][3];
                    r[4] = sigm(bflo(g4.z) + bv[bj][1][0]) * acc[ai][bj][m][1][0]; r[5] = sigm(bfhi(g4.z) + bv[bj][1][1]) * acc[ai][bj][m][1][1];
                    r[6] = sigm(bflo(g4.w) + bv[bj][1][2]) * acc[ai][bj][m][1][2]; r[7] = sigm(bfhi(g4.w) + bv[bj][1][3]) * acc[ai][bj][m][1][3];
                    if (ADD) { const v4u t4 = tw[mm][bj];
                        r[0] += bflo(t4.x); r[1] += bfhi(t4.x); r[2] += bflo(t4.y); r[3] += bfhi(t4.y); r[4] += bflo(t4.z); r[5] += bfhi(t4.z); r[6] += bflo(t4.w); r[7] += bfhi(t4.w); }
                    v4u w; w.x = pk2(r[0], r[1]); w.y = pk2(r[2], r[3]); w.z = pk2(r[4], r[5]); w.w = pk2(r[6], r[7]);
                    *(v4u*)(T + (size_t)row * DM + col0 + bj * 128) = w; } }
    }
};
template <bool BF> struct EpiResid {
    static constexpr bool PERM = true, AFTER_DRAIN = false;
    const float* base; bf16* obf; float* ssq;
    __device__ __forceinline__ void operator()(const f32x4 (&acc)[2][2][4][2], const Unit& u, int wr, int wc, int fr, int fq) const {
        const int row0 = u.pm * 256 + wr * 64 + fr, col0 = u.pn * 256 + wc * 32 + 8 * fq;
#pragma unroll
        for (int ai = 0; ai < 2; ++ai)
#pragma unroll
            for (int mh = 0; mh < 2; ++mh) { f32x4 b0[2][2], b1[2][2];
#pragma unroll
                for (int mm = 0; mm < 2; ++mm)
#pragma unroll
                    for (int bj = 0; bj < 2; ++bj) { const size_t off = (size_t)(row0 + ai * 128 + (2 * mh + mm) * 16) * DM + col0 + bj * 128;
                        if (BF) { const v4u bw = *(const v4u*)(obf + off); b0[mm][bj] = (f32x4){bflo(bw.x), bfhi(bw.x), bflo(bw.y), bfhi(bw.y)}; b1[mm][bj] = (f32x4){bflo(bw.z), bfhi(bw.z), bflo(bw.w), bfhi(bw.w)}; }
                        else { b0[mm][bj] = *(const f32x4*)(base + off); b1[mm][bj] = *(const f32x4*)(base + off + 4); } }
#pragma unroll
                for (int mm = 0; mm < 2; ++mm) { const int m = 2 * mh + mm; const int row = row0 + ai * 128 + m * 16; float ss = 0.f;
#pragma unroll
                    for (int bj = 0; bj < 2; ++bj) { const size_t off = (size_t)row * DM + col0 + bj * 128;
                        const f32x4 v0 = b0[mm][bj] + acc[ai][bj][m][0], v1 = b1[mm][bj] + acc[ai][bj][m][1];
                        v4u w; w.x = pk2(v0[0], v0[1]); w.y = pk2(v0[2], v0[3]); w.z = pk2(v1[0], v1[1]); w.w = pk2(v1[2], v1[3]);
                        *(v4u*)(obf + off) = w;
                        ss += ((v0[0] * v0[0] + v0[1] * v0[1]) + (v0[2] * v0[2] + v0[3] * v0[3])) + ((v1[0] * v1[0] + v1[1] * v1[1]) + (v1[2] * v1[2] + v1[3] * v1[3])); }
                    { const int ln_ = fr + 16 * fq; ss += shx(ss, 16, ln_); ss += shx(ss, 32, ln_); }
                    if (fq == 0) ssq[(size_t)row * 16 + (u.pn & 3) * 4 + wc] = ss; } }
    }
};
struct EpiSwiglu {
    static constexpr bool PERM = true, AFTER_DRAIN = false;
    bf16* act; const float* bgu; const float* row_rstd;
    __device__ __forceinline__ void operator()(const f32x4 (&acc)[2][2][4][2], const Unit& u, int wr, int wc, int fr, int fq) const {
        const int e = u.pn >> 3, pnl = u.pn & 7;
        const int rr0 = wr * 64 + fr, cl0 = pnl * 128 + wc * 32 + 8 * fq;
        f32x4 bg[2], bl[2]; float rs[2][4];
#pragma unroll
        for (int n = 0; n < 2; ++n) { bg[n] = *(const f32x4*)(bgu + e * 2048 + cl0 + 4 * n); bl[n] = *(const f32x4*)(bgu + e * 2048 + 1024 + cl0 + 4 * n); }
#pragma unroll
        for (int ai = 0; ai < 2; ++ai)
#pragma unroll
            for (int m = 0; m < 4; ++m) rs[ai][m] = row_rstd[u.aux + rr0 + ai * 128 + m * 16];
#pragma unroll
        for (int ai = 0; ai < 2; ++ai)
#pragma unroll
            for (int m = 0; m < 4; ++m) { const int row = u.pm * 256 + rr0 + ai * 128 + m * 16;
                float r[8];
#pragma unroll
                for (int n = 0; n < 2; ++n)
#pragma unroll
                    for (int j = 0; j < 4; ++j) { float gl = acc[ai][0][m][n][j] * rs[ai][m] + bg[n][j], li = acc[ai][1][m][n][j] * rs[ai][m] + bl[n][j];
                        gl = fminf(gl, 7.0f); li = fminf(fmaxf(li, -7.0f), 7.0f);
                        r[n * 4 + j] = gl * sigm(1.702f * gl) * (li + 1.0f); }
                v4u w; w.x = pk2(r[0], r[1]); w.y = pk2(r[2], r[3]); w.z = pk2(r[4], r[5]); w.w = pk2(r[6], r[7]);
                *(v4u*)(act + (size_t)row * DM + cl0) = w; }
    }
};
struct EpiDown {
    static constexpr bool PERM = true, AFTER_DRAIN = false;
    bf16* y; const float* bd; const float* row_gate;
    __device__ __forceinline__ void operator()(const f32x4 (&acc)[2][2][4][2], const Unit& u, int wr, int wc, int fr, int fq) const {
        const int e = u.pn >> 2, pnl = u.pn & 3;
        const int rr0 = wr * 64 + fr, col0 = pnl * 256 + wc * 32 + 8 * fq;
        f32x4 bv[2][2]; float gt[2][4];
#pragma unroll
        for (int bj = 0; bj < 2; ++bj)
#pragma unroll
            for (int n = 0; n < 2; ++n) bv[bj][n] = *(const f32x4*)(bd + e * 1024 + col0 + bj * 128 + 4 * n);
#pragma unroll
        for (int ai = 0; ai < 2; ++ai)
#pragma unroll
            for (int m = 0; m < 4; ++m) gt[ai][m] = row_gate[u.aux + rr0 + ai * 128 + m * 16];
#pragma unroll
        for (int ai = 0; ai < 2; ++ai)
#pragma unroll
            for (int m = 0; m < 4; ++m) { const int row = u.pm * 256 + rr0 + ai * 128 + m * 16;
#pragma unroll
                for (int bj = 0; bj < 2; ++bj) { const f32x4 v0 = (acc[ai][bj][m][0] + bv[bj][0]) * gt[ai][m], v1 = (acc[ai][bj][m][1] + bv[bj][1]) * gt[ai][m];
                    v4u w; w.x = pk2(v0[0], v0[1]); w.y = pk2(v0[2], v0[3]); w.z = pk2(v1[0], v1[1]); w.w = pk2(v1[2], v1[3]);
                    *(v4u*)(y + (size_t)row * DM + col0 + bj * 128) = w; } }
    }
};
struct GroupedOrder {
    int nunits, npn, G, c, half; const LAS unsigned* tab; const int* row_tok;
    __device__ __forceinline__ bool next(int i, Unit& u) const {
        const long L = (long)i * G + c; if (L >= nunits) return false;
        const int rb = (int)(L / npn), pn = (int)(L % npn);
        int e = 0;
#pragma unroll 4
        for (int k = 1; k < 32; ++k) e = (rb >= (int)tab[32 + k]) ? k : e;
        e = __builtin_amdgcn_readfirstlane(e);
        const int j = rb - (int)__builtin_amdgcn_readfirstlane(tab[32 + e]), cn = (int)__builtin_amdgcn_readfirstlane(tab[e]) - 256 * j;
        u.pm = rb; u.pn = e * npn + pn; u.aux = (half * 32 + e) * HTOK + 256 * j; u.cnt = cn < 256 ? cn : 256; return true;
    }
    __device__ __forceinline__ void rows(const Unit& u, int RA0, unsigned (&rn)[2][2]) const {
#pragma unroll
        for (int h = 0; h < 2; ++h) { const int r0 = h * 128 + RA0, r1 = r0 + 64, cm = u.cnt - 1;
            rn[h][0] = (unsigned)row_tok[u.aux + (r0 < cm ? r0 : cm)]; rn[h][1] = (unsigned)row_tok[u.aux + (r1 < cm ? r1 : cm)]; }
    }
    __device__ __forceinline__ void a_ready(const Unit&) const {}
    __device__ __forceinline__ void done(const Unit&) const {}
};
constexpr int MOE_TAB_OFF = 131072 + 1024;
__device__ __forceinline__ void moe_tables(const unsigned char* ws, int hb, LAS unsigned char* lds, int tid) {
    LAS unsigned* tab = (LAS unsigned*)(lds + MOE_TAB_OFF); const unsigned* gcnt = (const unsigned*)(ws + WS_GCNT);
    __syncthreads();
    if (tid < 32) tab[tid] = ld_agent(gcnt + (hb * 32 + tid) * 16);
    __syncthreads();
    if (tid == 0) { unsigned acc = 0; for (int e = 0; e < 32; ++e) { tab[32 + e] = acc; acc += (tab[e] + 255u) >> 8; } tab[64] = acc; }
    __syncthreads();
}

constexpr int RING_BYTES = 131072, MISC_OFF = RING_BYTES + 320, LDS_BYTES = 147456;

struct Ctx { LAS unsigned char* lds; int tid, lane, wave, G, gw, ngw; };

template <class RowMap>
__device__ __forceinline__ void transpose_item(const float* W, int K, int N, bf16* WT, const float* gain, LAS float* scr, int item, int lane, RowMap rm) {
    const int nblk = N / 32, kb = item / nblk, nb = item % nblk, k0 = 64 * kb, n0 = 32 * nb;
#pragma unroll 8
    for (int i = 0; i < 32; ++i) { const int kk = 2 * i + (lane >> 5); float v = W[(size_t)(k0 + kk) * N + n0 + (lane & 31)]; if (gain) v *= gain[k0 + kk]; scr[kk * 33 + (lane & 31)] = v; }
    LDS_WAIT();
    const int c = lane & 7;
#pragma unroll
    for (int j = 0; j < 4; ++j) { const int n = (lane >> 3) + 8 * j; const LAS float* s = scr + (8 * c) * 33 + n;
        v4u o; o.x = pk2(s[0 * 33], s[1 * 33]); o.y = pk2(s[2 * 33], s[3 * 33]); o.z = pk2(s[4 * 33], s[5 * 33]); o.w = pk2(s[6 * 33], s[7 * 33]);
        *(v4u*)(WT + (size_t)rm(n0 + n) * K + k0 + 8 * c) = o; }
    LDS_WAIT();
}
struct RowId { int off; __device__ __forceinline__ int operator()(int n) const { return off + n; } };
struct RowGU { int e; __device__ __forceinline__ int operator()(int n) const { const int j = n & 1023; return e * 2048 + (j >> 7) * 256 + (n >> 10) * 128 + (j & 127); } };

__device__ __forceinline__ void rms_row_to_bf16(const float* xrow, const float* gain, bf16* orow, int lane) {
    const f32x4* xr = (const f32x4*)xrow + lane; const f32x4* gr = (const f32x4*)gain + lane;
    f32x4 v[4]; float s = 0.f;
#pragma unroll
    for (int j = 0; j < 4; ++j) { v[j] = xr[64 * j]; s += (v[j][0] * v[j][0] + v[j][1] * v[j][1]) + (v[j][2] * v[j][2] + v[j][3] * v[j][3]); }
    const float rstd = rsqrtf(wave_sum(s, lane) * (1.f / DM) + RMS_EPS);
    unsigned long long* o8 = (unsigned long long*)orow + lane;
#pragma unroll
    for (int j = 0; j < 4; ++j) { const f32x4 g = gr[64 * j]; const f32x4 w = v[j] * rstd * g;
        o8[64 * j] = (unsigned long long)pk2(w[0], w[1]) | ((unsigned long long)pk2(w[2], w[3]) << 32); }
}

__device__ __forceinline__ void phase_prologue(const Args& a, const Ctx& c) {
    LAS float* scr = (LAS float*)(c.lds + c.wave * 16384);
    unsigned char* ws = a.ws;
    constexpr int I_IN = 16 * (NCOL / 32), I_SQ = 16 * 32, I_R = 16;
    constexpr int NIT = I_IN + 7 * I_SQ + I_R;
    for (int it = c.gw; it < NIT; it += c.ngw) {
        int r = it;
        if (r < I_IN) { transpose_item(a.in[5], DM, NCOL, (bf16*)(ws + WS_WIN), nullptr, scr, r, c.lane, RowId{0}); continue; } r -= I_IN;
        if (r < I_SQ) { transpose_item(a.in[9], DM, DM, (bf16*)(ws + WS_WA), nullptr, scr, r, c.lane, RowId{0}); continue; } r -= I_SQ;
        if (r < I_SQ) { transpose_item(a.in[10], DM, DM, (bf16*)(ws + WS_WB), nullptr, scr, r, c.lane, RowId{0}); continue; } r -= I_SQ;
        if (r < I_SQ) { transpose_item(a.in[11], DM, DM, (bf16*)(ws + WS_WMIX), nullptr, scr, r, c.lane, RowId{0}); continue; } r -= I_SQ;
        if (r < I_SQ) { transpose_item(a.in[13], DM, DM, (bf16*)(ws + WS_WQ), a.in[12], scr, r, c.lane, RowId{0}); continue; } r -= I_SQ;
        if (r < I_SQ) { transpose_item(a.in[14], DM, DM, (bf16*)(ws + WS_WK), nullptr, scr, r, c.lane, RowId{0}); continue; } r -= I_SQ;
        if (r < I_SQ) { transpose_item(a.in[15], DM, DM, (bf16*)(ws + WS_WV), nullptr, scr, r, c.lane, RowId{0}); continue; } r -= I_SQ;
        if (r < I_SQ) { transpose_item(a.in[16], DM, DM, (bf16*)(ws + WS_WO), nullptr, scr, r, c.lane, RowId{0}); continue; } r -= I_SQ;
        transpose_item(a.in[18], DM, NEXP, (bf16*)(ws + WS_WR), a.in[17], scr, r, c.lane, RowId{0});
    }
    { const size_t n8 = (size_t)NBATCH * MEMLEN * DM / 8; const float* mem = a.in[1]; bf16* mb = (bf16*)(ws + WS_MEMBF);
      for (size_t i = (size_t)c.gw * 64 + c.lane; i < n8; i += (size_t)c.ngw * 64) { const f32x4 v0 = *(const f32x4*)(mem + i * 8), v1 = *(const f32x4*)(mem + i * 8 + 4);
          v4u w; w.x = pk2(v0[0], v0[1]); w.y = pk2(v0[2], v0[3]); w.z = pk2(v1[0], v1[1]); w.w = pk2(v1[2], v1[3]); *(v4u*)(mb + i * 8) = w; } }
    if (c.gw == 0) {
        float* lb = (float*)(ws + WS_LB); const float* lbl = a.in[3];
        for (int k = c.lane; k < 1024; k += 64) lb[k] = 1.f / (1.f + expf(lbl[1024 + k] - lbl[k]));
    }
    if (c.gw == 1) {
        float* lut = (float*)(ws + WS_LUT); const float* t5 = a.in[2];
        for (int i = c.lane; i < 16 * 128; i += 64) { const int h = i >> 7, d = i & 127; int b = d;
            if (d >= 16) { b = 16 + (int)(logf((float)d * (1.f / 16.f)) / logf(8.f) * 16.f); b = b < 31 ? b : 31; }
            lut[i] = t5[b * 16 + h]; }
    }
}

__device__ __forceinline__ void phase_norm1(const Args& a, const Ctx& c, int hb) {
    const float* x = a.in[0] + (size_t)hb * HTOK * DM; bf16* xn = (bf16*)(a.ws + WS_TM);
    for (int m = c.gw; m < HTOK; m += c.ngw) rms_row_to_bf16(x + (size_t)m * DM, a.in[4], xn + (size_t)m * DM, c.lane);
}

constexpr int SWA_VB = 32 * 144;
constexpr int SWA_LUT_OFF = 8 * 2 * SWA_VB;
__device__ __forceinline__ void swa_unit(const bf16* proj, bf16* ob, int bl, int kvh, int tt, const LAS float* lut, LAS unsigned char* vbuf, const float* sinks, int lane) {
    const int l15 = lane & 15, g = lane >> 4, q4 = l15 >> 2, p4 = lane & 3;
    const int t0 = tt * 16; const size_t rowb = (size_t)bl * SEQ;
    bf16x8 qf[4][2];
#pragma unroll
    for (int gq = 0; gq < 4; ++gq)
#pragma unroll
        for (int ks = 0; ks < 2; ++ks) qf[gq][ks] = *(const bf16x8*)(proj + (rowb + t0 + l15) * NCOL + C_SQ + (kvh * 4 + gq) * 64 + ks * 32 + 8 * g);
    float mx[4], ls[4]; f32x4 o[4][4];
#pragma unroll
    for (int gq = 0; gq < 4; ++gq) { mx[gq] = sinks[kvh * 4 + gq]; ls[gq] = 1.f;
#pragma unroll
        for (int dt = 0; dt < 4; ++dt) o[gq][dt] = (f32x4){0.f, 0.f, 0.f, 0.f}; }
    for (int c = 0; c < 5; ++c) {
        const int kc = t0 - 144 + 32 * c;
        if (kc + 31 < 0) continue;
        LAS unsigned char* vb = vbuf + (c & 1) * SWA_VB;
#pragma unroll
        for (int i = 0; i < 4; ++i) { const int p = lane + 64 * i, key = p >> 3, d8 = p & 7; int kr = kc + key; kr = kr < 0 ? 0 : kr;
            const v4u vv = *(const v4u*)(proj + (rowb + kr) * NCOL + C_SV + kvh * 64 + d8 * 8);
            *(LAS v4u*)(vb + key * 144 + d8 * 16) = vv; }
        f32x4 s[4][2];
#pragma unroll
        for (int ksub = 0; ksub < 2; ++ksub) { int kr = kc + 16 * ksub + l15; kr = kr < 0 ? 0 : kr;
            const bf16* kp = proj + (rowb + kr) * NCOL + C_SK + kvh * 64 + 8 * g;
            const bf16x8 k0 = *(const bf16x8*)kp, k1 = *(const bf16x8*)(kp + 32);
#pragma unroll
            for (int gq = 0; gq < 4; ++gq) { f32x4 z = (f32x4){0.f, 0.f, 0.f, 0.f}; z = mfma16(k0, qf[gq][0], z); s[gq][ksub] = mfma16(k1, qf[gq][1], z); } }
        bf16x8 pf[4];
#pragma unroll
        for (int gq = 0; gq < 4; ++gq) { const int hq = kvh * 4 + gq; float cm = -1e30f;
#pragma unroll
            for (int ksub = 0; ksub < 2; ++ksub)
#pragma unroll
                for (int r = 0; r < 4; ++r) { const int key = kc + 16 * ksub + 4 * g + r, dist = t0 + l15 - key; const bool ok = (dist >= 0) && (dist < 128) && (key >= 0);
                    const int di = dist < 0 ? 0 : (dist > 127 ? 127 : dist);
                    float v = s[gq][ksub][r] * 0.125f + lut[hq * 128 + di]; v = ok ? v : -1e30f; s[gq][ksub][r] = v; cm = fmaxf(cm, v); }
            cm = fmaxf(cm, shx(cm, 16, lane)); cm = fmaxf(cm, shx(cm, 32, lane));
            const float mn = fmaxf(mx[gq], cm), alpha = __expf(mx[gq] - mn); mx[gq] = mn; float rs = 0.f;
#pragma unroll
            for (int ksub = 0; ksub < 2; ++ksub)
#pragma unroll
                for (int r = 0; r < 4; ++r) { const float p = __expf(s[gq][ksub][r] - mn); s[gq][ksub][r] = p; rs += p; }
            rs += shx(rs, 16, lane); rs += shx(rs, 32, lane);
            ls[gq] = ls[gq] * alpha + rs;
#pragma unroll
            for (int dt = 0; dt < 4; ++dt) o[gq][dt] = o[gq][dt] * alpha;
            pf[gq] = pack8(s[gq][0], s[gq][1]); }
        CFENCE();
#pragma unroll
        for (int dt = 0; dt < 4; ++dt) {
            const s16x4 lo = vtr(vb + (4 * g + q4) * 144 + (16 * dt + 4 * p4) * 2), hi = vtr(vb + (16 + 4 * g + q4) * 144 + (16 * dt + 4 * p4) * 2);
            const bf16x8 vf = cat8(lo, hi);
#pragma unroll
            for (int gq = 0; gq < 4; ++gq) o[gq][dt] = mfma16(vf, pf[gq], o[gq][dt]); }
        CFENCE();
    }
#pragma unroll
    for (int gq = 0; gq < 4; ++gq) { const float inv = 1.f / ls[gq];
#pragma unroll
        for (int dt = 0; dt < 4; ++dt) { const f32x4 v = o[gq][dt] * inv; v2u w; w.x = pk2(v[0], v[1]); w.y = pk2(v[2], v[3]);
            *(v2u*)(ob + (rowb + t0 + l15) * DM + (kvh * 4 + gq) * 64 + 16 * dt + 4 * g) = w; } }
}
__device__ __forceinline__ void phase_swa(const Args& a, const Ctx& c) {
    const bf16* proj = (const bf16*)(a.ws + WS_PROJ); bf16* ob = (bf16*)(a.ws + WS_OB);
    LAS float* lut = (LAS float*)(c.lds + SWA_LUT_OFF); const float* glut = (const float*)(a.ws + WS_LUT);
    for (int i = c.tid; i < 16 * 128; i += 512) lut[i] = glut[i];
    __syncthreads();
    LAS unsigned char* vbuf = c.lds + c.wave * 2 * SWA_VB;
    constexpr int NU = 8 * 4 * 256;
    for (int u = c.gw; u < NU; u += c.ngw) { const int tt = u & 255, kvh = (u >> 8) & 3, bl = u >> 10; swa_unit(proj, ob, bl, kvh, tt, lut, vbuf, a.in[8], c.lane); }
    __syncthreads();
}

constexpr int HG_LF = 0, HG_KP = 33792, HG_VT = 51200, HG_GT = 68608, HG_QP = 70656, HG_SSQ = 88064;
__device__ __forceinline__ void hg_scan(LAS unsigned char* lds, int tid, float (&loc)[16], float& pre, float& Gm, float& Gl) {
    const int ch = tid & 127, grp = tid >> 7;
    const LAS float* LF = (const LAS float*)(lds + HG_LF); LAS float* GT = (LAS float*)(lds + HG_GT);
    float run = 0.f;
#pragma unroll
    for (int i = 0; i < 16; ++i) { run += LF[(16 * grp + i) * 132 + ch]; loc[i] = run; }
    GT[grp * 128 + ch] = run;
    __syncthreads();
    const float g0 = GT[ch], g1 = GT[128 + ch], g2 = GT[256 + ch], g3 = GT[384 + ch];
    pre = (grp > 0 ? g0 : 0.f) + (grp > 1 ? g1 : 0.f) + (grp > 2 ? g2 : 0.f);
    Gm = g0 + g1; Gl = Gm + g2 + g3;
}
__device__ __forceinline__ void phase_hgA(const Args& a, const Ctx& c) {
    const bf16* proj = (const bf16*)(a.ws + WS_PROJ); bf16* US = (bf16*)((unsigned char*)a.out + OUT_US); float* D12 = (float*)(a.ws + WS_D12); const float* lb = (const float*)(a.ws + WS_LB);
    LAS unsigned char* lds = c.lds; const int tid = c.tid, lane = c.lane, w = c.wave;
    const int l15 = lane & 15, g = lane >> 4, q4 = l15 >> 2, p4 = lane & 3;
    constexpr int NU = 8 * 8 * 64;
    int u = blockIdx.x; if (u >= NU) return;
    v4u rf[2], rv[2];
#define HGA_LOAD(uu) do { const int cc_ = (uu) & 63, h_ = ((uu) >> 6) & 7, bl_ = (uu) >> 9; const size_t row0_ = (size_t)bl_ * SEQ + cc_ * 64; \
        _Pragma("unroll") for (int i = 0; i < 2; ++i) { const int p = tid + 512 * i, tok = p >> 4, c8 = p & 15; const bf16* rp = proj + (row0_ + tok) * NCOL + h_ * 128 + c8 * 8; \
            rf[i] = *(const v4u*)(rp + C_HF); rv[i] = *(const v4u*)(rp + C_HI); } } while (0)
    HGA_LOAD(u);
    for (;;) {
        const int h = (u >> 6) & 7;
#pragma unroll
        for (int i = 0; i < 2; ++i) { const int p = tid + 512 * i, tok = p >> 4, c8 = p & 15;
            const f32x4 lb0 = *(const f32x4*)(lb + h * 128 + c8 * 8), lb1 = *(const f32x4*)(lb + h * 128 + c8 * 8 + 4);
            const unsigned fw[4] = {rf[i].x, rf[i].y, rf[i].z, rf[i].w}; f32x4 o0, o1;
#pragma unroll
            for (int j = 0; j < 4; ++j) { const float lbl = j < 2 ? lb0[2 * j] : lb1[2 * j - 4], lbh = j < 2 ? lb0[2 * j + 1] : lb1[2 * j - 3];
                const float fl = lbl + (1.f - lbl) * sigm(bflo(fw[j])), fh = lbh + (1.f - lbh) * sigm(bfhi(fw[j]));
                if (j < 2) { o0[2 * j] = __logf(fl); o0[2 * j + 1] = __logf(fh); } else { o1[2 * j - 4] = __logf(fl); o1[2 * j - 3] = __logf(fh); } }
            LAS float* lfp = (LAS float*)(lds + HG_LF) + tok * 132 + c8 * 8; *(LAS f32x4*)lfp = o0; *(LAS f32x4*)(lfp + 4) = o1;
            *(LAS v4u*)(lds + HG_VT + tok * 272 + c8 * 16) = rv[i]; }
        const int ucur = u; const int un = u + gridDim.x; const bool has_next = un < NU;
        if (has_next) HGA_LOAD(un);
        __syncthreads();
        float loc[16], pre, Gm, Gl; hg_scan(lds, tid, loc, pre, Gm, Gl);
        { const int ch = tid & 127, grp = tid >> 7; LAS bf16* KP = (LAS bf16*)(lds + HG_KP);
#pragma unroll
          for (int i = 0; i < 16; ++i) { const float lfi = loc[i] - (i ? loc[i - 1] : 0.f), G = pre + loc[i];
              const float kp = (1.f - __expf(lfi)) * __expf(fminf(Gm - G, 80.f)); KP[(16 * grp + i) * 136 + ch] = (bf16)f2bf(kp); }
          if (grp == 0) { D12[(size_t)ucur * 256 + ch] = __expf(Gm); D12[(size_t)ucur * 256 + 128 + ch] = __expf(Gl - Gm); } }
        __syncthreads();
        { bf16x8 af[2];
#pragma unroll
          for (int ks = 0; ks < 2; ++ks) { const LAS unsigned char* bp = lds + HG_KP + (32 * ks + 8 * g + q4) * 272 + (16 * w + 4 * p4) * 2; af[ks] = cat8(vtr(bp), vtr(bp + 4 * 272)); }
#pragma unroll
          for (int vt = 0; vt < 8; ++vt) { f32x4 acc = (f32x4){0.f, 0.f, 0.f, 0.f};
#pragma unroll
              for (int ks = 0; ks < 2; ++ks) { const LAS unsigned char* bp = lds + HG_VT + (32 * ks + 8 * g + q4) * 272 + (16 * vt + 4 * p4) * 2; acc = mfma16(af[ks], cat8(vtr(bp), vtr(bp + 4 * 272)), acc); }
              v2u wv; wv.x = pk2(acc[0], acc[1]); wv.y = pk2(acc[2], acc[3]);
              *(v2u*)(US + ((size_t)ucur * 128 + 16 * vt + l15) * 128 + 16 * w + 4 * g) = wv; } }
        __syncthreads();
        if (!has_next) break;
        u = un;
    }
}
__device__ __forceinline__ void phase_hgB(const Args& a, const Ctx& c) {
    bf16* US = (bf16*)((unsigned char*)a.out + OUT_US); const float* D12 = (const float*)(a.ws + WS_D12);
    const int gt = c.gw * 64 + c.lane;
    for (int e = gt; e < 64 * 2048; e += c.ngw * 64) {
        const int bh = e >> 11, r = e & 2047, k8 = r & 15;
        float S[8];
#pragma unroll
        for (int j = 0; j < 8; ++j) S[j] = 0.f;
        for (int c0 = 0; c0 < 64; c0 += 4) {
            v4u uw[4]; f32x4 d1[4][2], d2[4][2];
#pragma unroll
            for (int cc = 0; cc < 4; ++cc) { const size_t un = (size_t)bh * 64 + c0 + cc;
                uw[cc] = *(const v4u*)(US + un * 16384 + (size_t)r * 8);
                d1[cc][0] = *(const f32x4*)(D12 + un * 256 + k8 * 8); d1[cc][1] = *(const f32x4*)(D12 + un * 256 + k8 * 8 + 4);
                d2[cc][0] = *(const f32x4*)(D12 + un * 256 + 128 + k8 * 8); d2[cc][1] = *(const f32x4*)(D12 + un * 256 + 128 + k8 * 8 + 4); }
#pragma unroll
            for (int cc = 0; cc < 4; ++cc) { const size_t un = (size_t)bh * 64 + c0 + cc;
                const unsigned ww[4] = {uw[cc].x, uw[cc].y, uw[cc].z, uw[cc].w}; float sp[8];
#pragma unroll
                for (int j = 0; j < 8; ++j) { const float d1v = d1[cc][j >> 2][j & 3], d2v = d2[cc][j >> 2][j & 3]; const float uv = (j & 1) ? bfhi(ww[j >> 1]) : bflo(ww[j >> 1]);
                    sp[j] = d1v * S[j]; S[j] = d2v * (sp[j] + uv); }
                v4u o; o.x = pk2(sp[0], sp[1]); o.y = pk2(sp[2], sp[3]); o.z = pk2(sp[4], sp[5]); o.w = pk2(sp[6], sp[7]);
                *(v4u*)(US + un * 16384 + (size_t)r * 8) = o; }
        }
    }
}
__device__ __forceinline__ void phase_hgC(const Args& a, const Ctx& c) {
    const bf16* proj = (const bf16*)(a.ws + WS_PROJ); const bf16* US = (const bf16*)((unsigned char*)a.out + OUT_US); bf16* oa = (bf16*)(a.ws + WS_OA);
    const float* lb = (const float*)(a.ws + WS_LB); const float* hgain = a.in[7];
    LAS unsigned char* lds = c.lds; const int tid = c.tid, lane = c.lane, w = c.wave;
    const int l15 = lane & 15, g = lane >> 4, q4 = l15 >> 2, p4 = lane & 3;
    constexpr int NU = 8 * 8 * 64;
    int u = blockIdx.x; if (u >= NU) return;
    v4u rq[2], rf[2], rv[2];
#define HGC_LOAD(uu) do { const int cc_ = (uu) & 63, h_ = ((uu) >> 6) & 7, bl_ = (uu) >> 9; const size_t row0_ = (size_t)bl_ * SEQ + cc_ * 64; \
        _Pragma("unroll") for (int i = 0; i < 2; ++i) { const int p = tid + 512 * i, tok = p >> 4, c8 = p & 15; const bf16* rp = proj + (row0_ + tok) * NCOL + h_ * 128 + c8 * 8; \
            rq[i] = *(const v4u*)(rp + C_HQ); rf[i] = *(const v4u*)(rp + C_HF); rv[i] = *(const v4u*)(rp + C_HI); } } while (0)
    HGC_LOAD(u);
    const f32x4 gn = *(const f32x4*)(hgain + 16 * w + 4 * g);
    for (;;) {
        const int cc = u & 63, h = (u >> 6) & 7, bl = u >> 9; const size_t row0 = (size_t)bl * SEQ + cc * 64;
#pragma unroll
        for (int i = 0; i < 2; ++i) { const int p = tid + 512 * i, tok = p >> 4, c8 = p & 15;
            const f32x4 lb0 = *(const f32x4*)(lb + h * 128 + c8 * 8), lb1 = *(const f32x4*)(lb + h * 128 + c8 * 8 + 4);
            const unsigned fw[4] = {rf[i].x, rf[i].y, rf[i].z, rf[i].w}; f32x4 o0, o1;
#pragma unroll
            for (int j = 0; j < 4; ++j) { const float lbl = j < 2 ? lb0[2 * j] : lb1[2 * j - 4], lbh = j < 2 ? lb0[2 * j + 1] : lb1[2 * j - 3];
                const float fl = lbl + (1.f - lbl) * sigm(bflo(fw[j])), fh = lbh + (1.f - lbh) * sigm(bfhi(fw[j]));
                if (j < 2) { o0[2 * j] = __logf(fl); o0[2 * j + 1] = __logf(fh); } else { o1[2 * j - 4] = __logf(fl); o1[2 * j - 3] = __logf(fh); } }
            LAS float* lfp = (LAS float*)(lds + HG_LF) + tok * 132 + c8 * 8; *(LAS f32x4*)lfp = o0; *(LAS f32x4*)(lfp + 4) = o1;
            *(LAS v4u*)(lds + HG_VT + tok * 272 + c8 * 16) = rv[i];
            *(LAS v4u*)(lds + HG_QP + tok * 272 + c8 * 16) = rq[i]; }
        const int ucur = u; const int un = u + gridDim.x; const bool has_next = un < NU;
        if (has_next) HGC_LOAD(un);
        bf16x8 sf[4];
#pragma unroll
        for (int ks = 0; ks < 4; ++ks) sf[ks] = *(const bf16x8*)(US + ((size_t)ucur * 128 + 16 * w + l15) * 128 + 32 * ks + 8 * g);
        __syncthreads();
        float loc[16], pre, Gm, Gl; hg_scan(lds, tid, loc, pre, Gm, Gl);
        { const int ch = tid & 127, grp = tid >> 7; LAS bf16* KP = (LAS bf16*)(lds + HG_KP); LAS bf16* QP = (LAS bf16*)(lds + HG_QP);
#pragma unroll
          for (int i = 0; i < 16; ++i) { const float lfi = loc[i] - (i ? loc[i - 1] : 0.f), G = pre + loc[i];
              const float kp = (1.f - __expf(lfi)) * __expf(fminf(Gm - G, 80.f)); KP[(16 * grp + i) * 136 + ch] = (bf16)f2bf(kp);
              const float qr = __builtin_bit_cast(float, (unsigned)QP[(16 * grp + i) * 136 + ch] << 16);
              const float qp = qr * sigm(qr) * __expf(fminf(G - Gm, 80.f)); QP[(16 * grp + i) * 136 + ch] = (bf16)f2bf(qp); } }
        __syncthreads();
        f32x4 o[4];
        {
            bf16x8 vf[2];
#pragma unroll
            for (int kk = 0; kk < 2; ++kk) { const LAS unsigned char* bp = lds + HG_VT + (32 * kk + 4 * g + q4) * 272 + (16 * w + 4 * p4) * 2; vf[kk] = cat8(vtr(bp), vtr(bp + 16 * 272)); }
#pragma unroll
            for (int tt = 0; tt < 4; ++tt) {
                bf16x8 qf[4];
#pragma unroll
                for (int ks = 0; ks < 4; ++ks) qf[ks] = *(const LAS bf16x8*)(lds + HG_QP + (16 * tt + l15) * 272 + (32 * ks + 8 * g) * 2);
                f32x4 acc = (f32x4){0.f, 0.f, 0.f, 0.f};
#pragma unroll
                for (int ks = 0; ks < 4; ++ks) acc = mfma16(sf[ks], qf[ks], acc);
                f32x4 at[4];
#pragma unroll
                for (int st = 0; st < 4; ++st) { at[st] = (f32x4){0.f, 0.f, 0.f, 0.f};
                    if (st <= tt) {
#pragma unroll
                        for (int ks = 0; ks < 4; ++ks) { const bf16x8 kf = *(const LAS bf16x8*)(lds + HG_KP + (16 * st + l15) * 272 + (32 * ks + 8 * g) * 2); at[st] = mfma16(kf, qf[ks], at[st]); }
                        if (st == tt) {
#pragma unroll
                            for (int r = 0; r < 4; ++r) at[st][r] = (4 * g + r <= l15) ? at[st][r] : 0.f; } } }
                acc = mfma16(vf[0], pack8(at[0], at[1]), acc);
                if (tt >= 2) acc = mfma16(vf[1], pack8(at[2], at[3]), acc);
                o[tt] = acc; }
        }
        { LAS float* SSQ = (LAS float*)(lds + HG_SSQ);
#pragma unroll
          for (int tt = 0; tt < 4; ++tt) { float s = (o[tt][0] * o[tt][0] + o[tt][1] * o[tt][1]) + (o[tt][2] * o[tt][2] + o[tt][3] * o[tt][3]);
              s += shx(s, 16, lane); s += shx(s, 32, lane); if (g == 0) SSQ[w * 64 + 16 * tt + l15] = s; }
          __syncthreads();
#pragma unroll
          for (int tt = 0; tt < 4; ++tt) { float s = 0.f;
#pragma unroll
              for (int ww = 0; ww < 8; ++ww) s += SSQ[ww * 64 + 16 * tt + l15];
              const float rstd = rsqrtf(s * (1.f / 128.f) + RMS_EPS);
              const size_t row = row0 + 16 * tt + l15;
              const v2u gw = *(const v2u*)(proj + row * NCOL + C_HG + h * 128 + 16 * w + 4 * g);
              const float g0 = bflo(gw.x), g1 = bfhi(gw.x), g2 = bflo(gw.y), g3 = bfhi(gw.y);
              const float r0 = o[tt][0] * rstd * gn[0] * (g0 * sigm(g0)), r1 = o[tt][1] * rstd * gn[1] * (g1 * sigm(g1));
              const float r2 = o[tt][2] * rstd * gn[2] * (g2 * sigm(g2)), r3 = o[tt][3] * rstd * gn[3] * (g3 * sigm(g3));
              v2u wv; wv.x = pk2(r0, r1); wv.y = pk2(r2, r3);
              *(v2u*)(oa + row * DM + h * 128 + 16 * w + 4 * g) = wv; } }
        if (!has_next) break;
        u = un;
    }
    __syncthreads();
}

typedef float f32x16 __attribute__((ext_vector_type(16)));
constexpr int XA_KROW = 528, XA_VROW = 72, XA_KB = 32 * XA_KROW, XA_VB = 256 * XA_VROW, XA_STAGE = XA_KB + XA_VB;
__device__ __forceinline__ void phase_xa(const Args& a, const Ctx& c) {
    const bf16* qg = (const bf16*)(a.ws + WS_Q); bf16* og = (bf16*)(a.ws + WS_O); const bf16* kx = (const bf16*)(a.ws + WS_KX); const bf16* vxt = (const bf16*)(a.ws + WS_VXT);
    LAS unsigned char* lds = c.lds; const int tid = c.tid, lane = c.lane, w = c.wave;
    const int l31 = lane & 31, hh = lane >> 5, qt = w & 3, dh = w >> 2;
    constexpr int NU = NBATCH * 4 * (SEQ / 128);
    int u = blockIdx.x; if (u >= NU) return;
    v4u rk[2], rv[2];
#define XA_LOAD(uu, kc) do { const int b_ = (uu) >> 7, h_ = ((uu) >> 5) & 3; \
        _Pragma("unroll") for (int i = 0; i < 2; ++i) { const int p = tid + 512 * i; \
            rk[i] = *(const v4u*)(kx + (size_t)(b_ * MEMLEN + (kc) * 32 + (p >> 5)) * DM + h_ * 256 + (p & 31) * 8); \
            rv[i] = *(const v4u*)(vxt + (size_t)(h_ * 256 + (p >> 2)) * (NBATCH * MEMLEN) + b_ * MEMLEN + (kc) * 32 + (p & 3) * 8); } } while (0)
#define XA_STORE(buf) do { LAS unsigned char* sb = lds + (buf) * XA_STAGE; \
        _Pragma("unroll") for (int i = 0; i < 2; ++i) { const int p = tid + 512 * i; \
            *(LAS v4u*)(sb + (p >> 5) * XA_KROW + (p & 31) * 16) = rk[i]; \
            LAS v2u* vp = (LAS v2u*)(sb + XA_KB + (p >> 2) * XA_VROW + (p & 3) * 16); v2u lo; lo.x = rv[i].x; lo.y = rv[i].y; v2u hi; hi.x = rv[i].z; hi.y = rv[i].w; vp[0] = lo; vp[1] = hi; } } while (0)
    XA_LOAD(u, 0); XA_STORE(0);
    int par = 0;
    for (;;) {
        const int b = u >> 7, h = (u >> 5) & 3, qb = u & 31;
        const size_t row0 = (size_t)b * SEQ + qb * 128 + qt * 32;
        bf16x8 qf[16];
#pragma unroll
        for (int ks = 0; ks < 16; ++ks) qf[ks] = *(const bf16x8*)(qg + (row0 + l31) * DM + h * 256 + 16 * ks + 8 * hh);
        float mx = -1e30f, ls = 0.f; f32x16 o[4];
#pragma unroll
        for (int dt = 0; dt < 4; ++dt)
#pragma unroll
            for (int r = 0; r < 16; ++r) o[dt][r] = 0.f;
        const int un = u + gridDim.x; const bool has_next = un < NU;
        for (int kc = 0; kc < 8; ++kc) {
            __syncthreads();
            const bool more = (kc < 7) || has_next;
            if (more) { if (kc < 7) XA_LOAD(u, kc + 1); else XA_LOAD(un, 0); }
            const LAS unsigned char* kb = lds + par * XA_STAGE; const LAS unsigned char* vb = kb + XA_KB;
            f32x16 s;
#pragma unroll
            for (int r = 0; r < 16; ++r) s[r] = 0.f;
#pragma unroll
            for (int ks = 0; ks < 16; ++ks) { const bf16x8 kf = *(const LAS bf16x8*)(kb + l31 * XA_KROW + (16 * ks + 8 * hh) * 2); s = __builtin_amdgcn_mfma_f32_32x32x16_bf16(kf, qf[ks], s, 0, 0, 0); }
            float cm = -1e30f;
#pragma unroll
            for (int r = 0; r < 16; ++r) { s[r] *= 0.0625f; cm = fmaxf(cm, s[r]); }
            cm = fmaxf(cm, shx(cm, 32, lane));
            const float mn = fmaxf(mx, cm), alpha = __expf(mx - mn); mx = mn; float rs = 0.f;
#pragma unroll
            for (int r = 0; r < 16; ++r) { s[r] = __expf(s[r] - mn); rs += s[r]; }
            rs += shx(rs, 32, lane); ls = ls * alpha + rs;
#pragma unroll
            for (int dt = 0; dt < 4; ++dt)
#pragma unroll
                for (int r = 0; r < 16; ++r) o[dt][r] *= alpha;
            bf16x8 pf[2];
#pragma unroll
            for (int st = 0; st < 2; ++st) { v4u pw; pw.x = pk2(s[8 * st], s[8 * st + 1]); pw.y = pk2(s[8 * st + 2], s[8 * st + 3]); pw.z = pk2(s[8 * st + 4], s[8 * st + 5]); pw.w = pk2(s[8 * st + 6], s[8 * st + 7]); pf[st] = __builtin_bit_cast(bf16x8, pw); }
#pragma unroll
            for (int dt = 0; dt < 4; ++dt) { const LAS unsigned char* vrow = vb + (128 * dh + 32 * dt + l31) * XA_VROW + 8 * hh;
#pragma unroll
                for (int st = 0; st < 2; ++st) { const s16x4 lo = *(const LAS s16x4*)(vrow + 32 * st), hi = *(const LAS s16x4*)(vrow + 32 * st + 16);
                    o[dt] = __builtin_amdgcn_mfma_f32_32x32x16_bf16(cat8(lo, hi), pf[st], o[dt], 0, 0, 0); } }
            if (more) XA_STORE(par ^ 1);
            par ^= 1;
        }
        const float inv = 1.f / ls;
#pragma unroll
        for (int dt = 0; dt < 4; ++dt)
#pragma unroll
            for (int rg = 0; rg < 4; ++rg) { v2u wv; wv.x = pk2(o[dt][4 * rg] * inv, o[dt][4 * rg + 1] * inv); wv.y = pk2(o[dt][4 * rg + 2] * inv, o[dt][4 * rg + 3] * inv);
                *(v2u*)(og + (row0 + l31) * DM + h * 256 + 128 * dh + 32 * dt + 8 * rg + 4 * hh) = wv; }
        if (!has_next) break;
        u = un;
    }
    __syncthreads();
#undef XA_LOAD
#undef XA_STORE
}

__device__ __forceinline__ void phase_expert_weights(const Args& a, const Ctx& c) {
    LAS float* scr = (LAS float*)(c.lds + c.wave * 16384);
    constexpr int I_GU = 16 * 64, I_D = 16 * 32;
    constexpr int NIT = NEXP * (I_GU + I_D);
    for (int it = c.gw; it < NIT; it += c.ngw) {
        if (it < NEXP * I_GU) { const int e = it / I_GU, r = it % I_GU; transpose_item(a.in[20] + (size_t)e * DM * 2048, DM, 2048, (bf16*)(a.ws + WS_WGU), a.in[17], scr, r, c.lane, RowGU{e});     }
        else { const int r2 = it - NEXP * I_GU, e = r2 / I_D, r = r2 % I_D; transpose_item(a.in[22] + (size_t)e * DM * DM, DM, DM, (bf16*)(a.ws + WS_WD), nullptr, scr, r, c.lane, RowId{e * 1024}); }
    }
    __syncthreads();
}
__device__ __forceinline__ void phase_router(const Args& a, const Ctx& c) {
    const bf16* xb = (const bf16*)(a.ws + WS_XBF); const bf16* wr = (const bf16*)(a.ws + WS_WR); const float* ssq2 = (const float*)(a.ws + WS_SSQ2); const float* br = a.in[19];
    int* tope = (int*)(a.ws + WS_TOPE); float* topg = (float*)(a.ws + WS_TOPG); int* topr = (int*)(a.ws + WS_TOPR); unsigned* gcnt = (unsigned*)(a.ws + WS_GCNT);
    LAS unsigned char* lds = c.lds; const int lane = c.lane, w = c.wave, l15 = lane & 15, g = lane >> 4;
    LAS float* LG = (LAS float*)(lds + w * 4096);
    LAS int* LE = (LAS int*)(lds + w * 4096 + 2560); LAS float* LGT = (LAS float*)(lds + w * 4096 + 2816);
    int* rtok = (int*)(a.ws + WS_RTOK); float* rgate = (float*)(a.ws + WS_RGATE2); float* rrstd = (float*)(a.ws + WS_RRSTD2);
    LAS unsigned* CNT = (LAS unsigned*)(lds + 32768); LAS unsigned* BASE = CNT + 32;
    for (int it = blockIdx.x; it < NTOK / 128; it += gridDim.x) {
        const int tok0 = it * 128 + w * 16; const int half = tok0 >= HTOK;
        if (c.tid < 32) CNT[c.tid] = 0u;
        f32x4 acc[2] = {(f32x4){0.f, 0.f, 0.f, 0.f}, (f32x4){0.f, 0.f, 0.f, 0.f}};
        const bf16* ap = xb + (size_t)(tok0 + l15) * DM + 8 * g;
#pragma unroll 8
        for (int ks = 0; ks < 32; ++ks) { const bf16x8 af = *(const bf16x8*)(ap + 32 * ks);
#pragma unroll
            for (int nt = 0; nt < 2; ++nt) { const bf16x8 bf = *(const bf16x8*)(wr + (size_t)(16 * nt + l15) * DM + 32 * ks + 8 * g); acc[nt] = mfma16(af, bf, acc[nt]); } }
#pragma unroll
        for (int nt = 0; nt < 2; ++nt)
#pragma unroll
            for (int r = 0; r < 4; ++r) { const int t = 4 * g + r; const float rs = rstd16(ssq2, (size_t)(tok0 + t)); LG[t * 33 + 16 * nt + l15] = acc[nt][r] * rs + br[16 * nt + l15]; }
        LDS_WAIT();
        if (lane < 16) { float v[32];
#pragma unroll
            for (int e = 0; e < 32; ++e) v[e] = LG[lane * 33 + e];
            int se[4]; float sv[4];
#pragma unroll
            for (int k = 0; k < 4; ++k) { float best = -3e38f; int bi = 0;
#pragma unroll
                for (int e = 0; e < 32; ++e) { const bool bt = v[e] > best; best = bt ? v[e] : best; bi = bt ? e : bi; }
                se[k] = bi; sv[k] = best;
#pragma unroll
                for (int e = 0; e < 32; ++e) v[e] = (e == bi) ? -3e38f : v[e]; }
            const float e1 = __expf(sv[1] - sv[0]), e2 = __expf(sv[2] - sv[0]), e3 = __expf(sv[3] - sv[0]); const float inv = 1.f / (1.f + e1 + e2 + e3);
            const int tok = tok0 + lane;
            *(int4*)(tope + (size_t)tok * 4) = make_int4(se[0], se[1], se[2], se[3]);
            *(float4*)(topg + (size_t)tok * 4) = make_float4(inv, e1 * inv, e2 * inv, e3 * inv);
#pragma unroll
            for (int k = 0; k < 4; ++k) LE[lane * 4 + k] = se[k];
            LGT[lane * 4 + 0] = inv; LGT[lane * 4 + 1] = e1 * inv; LGT[lane * 4 + 2] = e2 * inv; LGT[lane * 4 + 3] = e3 * inv; }
        __syncthreads();
        const int myE = LE[lane];
        const unsigned lr = atomicAdd((unsigned*)&CNT[myE], 1u);
        __syncthreads();
        if (c.tid < 32) { const unsigned n = CNT[c.tid]; BASE[c.tid] = n ? atomicAdd(gcnt + (half * 32 + c.tid) * 16, n) : 0u; }
        __syncthreads();
        { const int rank = (int)(BASE[myE] + lr), tok = tok0 + (lane >> 2); topr[(size_t)tok * 4 + (lane & 3)] = rank;
          const size_t ri = (size_t)(half * 32 + myE) * HTOK + rank; rtok[ri] = tok; rgate[ri] = LGT[lane]; rrstd[ri] = rstd16(ssq2, (size_t)tok); }
        __syncthreads();
    }
}
__device__ __forceinline__ void add16(f32x4 (&v)[4], const v4u y0, const v4u y1) {
    v[0][0] += bflo(y0.x); v[0][1] += bfhi(y0.x); v[0][2] += bflo(y0.y); v[0][3] += bfhi(y0.y); v[1][0] += bflo(y0.z); v[1][1] += bfhi(y0.z); v[1][2] += bflo(y0.w); v[1][3] += bfhi(y0.w);
    v[2][0] += bflo(y1.x); v[2][1] += bfhi(y1.x); v[2][2] += bflo(y1.y); v[2][3] += bfhi(y1.y); v[3][0] += bflo(y1.z); v[3][1] += bfhi(y1.z); v[3][2] += bflo(y1.w); v[3][3] += bfhi(y1.w);
}
__device__ __forceinline__ void phase_combine(const Args& a, const Ctx& c, int hb) {
    const bf16* y = (const bf16*)(a.ws + WS_Y); const bf16* xb = (const bf16*)(a.ws + WS_XBF); const int* tope = (const int*)(a.ws + WS_TOPE); const int* topr = (const int*)(a.ws + WS_TOPR); const float* gf = a.in[24];
    moe_tables(a.ws, hb, c.lds, c.tid);
    const LAS unsigned* tab = (const LAS unsigned*)(c.lds + MOE_TAB_OFF);
    for (int i = c.gw; i < HTOK; i += c.ngw) { const int tok = hb * HTOK + i;
        const int4 ee = *(const int4*)(tope + (size_t)tok * 4), rr = *(const int4*)(topr + (size_t)tok * 4);
        const int ps[4] = {(int)tab[32 + ee.x] * 256 + rr.x, (int)tab[32 + ee.y] * 256 + rr.y, (int)tab[32 + ee.z] * 256 + rr.z, (int)tab[32 + ee.w] * 256 + rr.w};
        f32x4 v[4];
#pragma unroll
        for (int j = 0; j < 4; ++j) v[j] = (f32x4){0.f, 0.f, 0.f, 0.f};
        { const v4u* xp = (const v4u*)(xb + (size_t)tok * DM + c.lane * 16); add16(v, xp[0], xp[1]); }
#pragma unroll
        for (int k = 0; k < 4; ++k) { const v4u* yp = (const v4u*)(y + (size_t)ps[k] * DM + c.lane * 16); add16(v, yp[0], yp[1]); }
        float s = 0.f;
#pragma unroll
        for (int j = 0; j < 4; ++j) s += (v[j][0] * v[j][0] + v[j][1] * v[j][1]) + (v[j][2] * v[j][2] + v[j][3] * v[j][3]);
        const float rstd = rsqrtf(wave_sum(s, c.lane) * (1.f / DM) + RMS_EPS);
        float* xr = a.out + (size_t)tok * DM + c.lane * 16;
#pragma unroll
        for (int j = 0; j < 4; ++j) { const f32x4 gg = *(const f32x4*)(gf + c.lane * 16 + 4 * j); *(f32x4*)(xr + 4 * j) = v[j] * rstd * gg; } }
}

#ifndef MK_PER_PHASE_LAUNCH
#define MK_PER_PHASE_LAUNCH 0
#endif
constexpr int NPHASES = 29;
#ifndef MK_OFF
#define MK_OFF 0u
#endif
#define MKP(k) (((MK_OFF >> (k)) & 1u) == 0u)
#define GSCHED PG8_ALIGN, PG8_SP2
typedef const __attribute__((address_space(4))) Args* KArgP;
#if defined(__HIP_DEVICE_COMPILE__)
__device__ __forceinline__ Args ldargs() { KArgP kp = (KArgP)__builtin_amdgcn_kernarg_segment_ptr(); asm volatile("" : "+s"(kp)); Args r;
#pragma unroll
    for (int i = 0; i < 25; ++i) r.in[i] = kp->in[i];
    r.out = kp->out; r.ws = kp->ws; r.ph_lo = kp->ph_lo; r.ph_hi = kp->ph_hi; return r; }
#else
__device__ __forceinline__ Args ldargs() { return Args{}; }
#endif
__global__ void __launch_bounds__(512, 2) mk_fwd(Args a_) {
    extern __shared__ __attribute__((aligned(16))) unsigned char lds_raw[];
    Ctx c; c.lds = (LAS unsigned char*)lds_raw; c.tid = threadIdx.x; c.lane = c.tid & 63; c.wave = __builtin_amdgcn_readfirstlane(c.tid >> 6); const int wv = c.wave;
    c.G = gridDim.x; c.gw = blockIdx.x * 8 + c.wave; c.ngw = c.G * 8;
    volatile LAS unsigned* MISC = (volatile LAS unsigned*)(c.lds + MISC_OFF);
    for (int u = c.tid; u < (LDS_BYTES - RING_BYTES) / 4; u += 512) ((LAS unsigned*)(c.lds + RING_BYTES))[u] = 0u;
    __syncthreads();
    const int ph_lo = a_.ph_lo, ph_hi = a_.ph_hi;
    const bool fused = (ph_hi - ph_lo) > 1;
    unsigned* barw = (unsigned*)a_.ws + CW_BAR;
    XcdBarrier bar; bar.bar = barw; bar.x = 0; bar.st = MISC + 8; bar.t0 = wv;
    if (fused) bar = xcd_barrier_post(barw, MISC + 8, wv);
    int pc = 0;
#define PH_ON (pc >= ph_lo && pc < ph_hi)
#define PH_END do { if (PH_ON && pc + 1 < ph_hi) xcd_barrier(bar); ++pc; OPQ(c); } while (0)
    LAS unsigned char* ring = c.lds;
#define OPQ(cc) do { { unsigned z_ = 0u; asm volatile("" : "+v"(z_)); cc.lane = (int)__builtin_amdgcn_mbcnt_hi(~0u, __builtin_amdgcn_mbcnt_lo(~0u, z_)); } cc.wave = wv; cc.tid = wv * 64 + cc.lane; { int gw_ = (int)blockIdx.x * 8 + wv; asm volatile("" : "+s"(gw_)); cc.gw = gw_; } } while (0)

    if (MKP(0) && PH_ON) { const Args a = ldargs(); unsigned char* ws = a.ws; (void)ws;  phase_prologue(a, c); __syncthreads(); }
    PH_END;
#pragma unroll
    for (int hb = 0; hb < 2; ++hb) {
        const size_t toff = (size_t)hb * HTOK;
        if (MKP(1) && PH_ON) { const Args a = ldargs(); phase_norm1(a, c, hb); }
        PH_END;
        if (MKP(2) && PH_ON) { const Args a = ldargs(); unsigned char* ws = a.ws; (void)ws;  pg8::Gemm g{(const bf16*)(ws + WS_TM), (const bf16*)(ws + WS_WIN), HTOK, NCOL, DM}; pg8::StaticOrder S; S.init(HTOK, NCOL, c.G, (int)blockIdx.x);
            EpiStore E{(bf16*)(ws + WS_PROJ), NCOL, nullptr}; pg8::gemm_phase<EpiStore, pg8::StaticOrder, GSCHED>(ring, g, S, E, wv); }
        PH_END;
        if (MKP(3) && PH_ON) { const Args a = ldargs(); unsigned char* ws = a.ws; (void)ws;  phase_hgA(a, c); }
        PH_END;
        if (MKP(17) && PH_ON) { const Args a = ldargs(); phase_swa(a, c); }
        PH_END;
        if (MKP(4) && PH_ON) { const Args a = ldargs(); phase_hgB(a, c); }
        PH_END;
        if (MKP(5) && PH_ON) { const Args a = ldargs(); phase_hgC(a, c); }
        PH_END;
        if (MKP(6) && PH_ON) { const Args a = ldargs(); unsigned char* ws = a.ws; (void)ws;  pg8::Gemm g{(const bf16*)(ws + WS_OA), (const bf16*)(ws + WS_WA), HTOK, DM, DM}; pg8::StaticOrder S; S.init(HTOK, DM, c.G, (int)blockIdx.x);
            EpiGate<false> E{(bf16*)(ws + WS_TM), (const bf16*)(ws + WS_PROJ), C_GA, a.in[6]}; pg8::gemm_phase<EpiGate<false>, pg8::StaticOrder, GSCHED>(ring, g, S, E, wv); }
        PH_END;
        if (MKP(7) && PH_ON) { const Args a = ldargs(); unsigned char* ws = a.ws; (void)ws;  pg8::Gemm g{(const bf16*)(ws + WS_OB), (const bf16*)(ws + WS_WB), HTOK, DM, DM}; pg8::StaticOrder S; S.init(HTOK, DM, c.G, (int)blockIdx.x);
            EpiGate<true> E{(bf16*)(ws + WS_TM), (const bf16*)(ws + WS_PROJ), C_GB, a.in[6] + DM}; pg8::gemm_phase<EpiGate<true>, pg8::StaticOrder, GSCHED>(ring, g, S, E, wv); }
        PH_END;
        if (MKP(8) && PH_ON) { const Args a = ldargs(); unsigned char* ws = a.ws; (void)ws;  pg8::Gemm g{(const bf16*)(ws + WS_TM), (const bf16*)(ws + WS_WMIX), HTOK, DM, DM}; pg8::StaticOrder S; S.init(HTOK, DM, c.G, (int)blockIdx.x);
            EpiResid<false> E{a.in[0] + toff * DM, (bf16*)(ws + WS_XBF) + toff * DM, (float*)(ws + WS_SSQ1) + toff * 16}; pg8::gemm_phase<EpiResid<false>, pg8::StaticOrder, GSCHED>(ring, g, S, E, wv); }
        PH_END;
    }
    if (MKP(9) && PH_ON) { const Args a = ldargs(); unsigned char* ws = a.ws; (void)ws;
        phase_expert_weights(a, c);
        { pg8::Gemm g{(const bf16*)(ws + WS_MEMBF), (const bf16*)(ws + WS_WK), NBATCH * MEMLEN, DM, DM}; pg8::StaticOrder S; S.init(NBATCH * MEMLEN, DM, c.G, (int)blockIdx.x);
          EpiStore E{(bf16*)(ws + WS_KX), DM, nullptr}; pg8::gemm_phase<EpiStore, pg8::StaticOrder, GSCHED>(ring, g, S, E, wv); }
        { pg8::Gemm g{(const bf16*)(ws + WS_WV), (const bf16*)(ws + WS_MEMBF), DM, NBATCH * MEMLEN, DM}; pg8::StaticOrder S; S.init(DM, NBATCH * MEMLEN, c.G, (int)((blockIdx.x + 64) % c.G));
          EpiStore E{(bf16*)(ws + WS_VXT), NBATCH * MEMLEN, nullptr}; pg8::gemm_phase<EpiStore, pg8::StaticOrder, GSCHED>(ring, g, S, E, wv); }
        { pg8::Gemm g{(const bf16*)(ws + WS_XBF), (const bf16*)(ws + WS_WQ), NTOK, DM, DM}; pg8::StaticOrder S; S.init(NTOK, DM, c.G, (int)blockIdx.x);
          EpiStore E{(bf16*)(ws + WS_Q), DM, (const float*)(ws + WS_SSQ1)}; pg8::gemm_phase<EpiStore, pg8::StaticOrder, GSCHED>(ring, g, S, E, wv); }
    }
    PH_END;
    if (MKP(10) && PH_ON) { const Args a = ldargs(); phase_xa(a, c); }
    PH_END;
    if (MKP(11) && PH_ON) { const Args a = ldargs(); unsigned char* ws = a.ws; (void)ws;  pg8::Gemm g{(const bf16*)(ws + WS_O), (const bf16*)(ws + WS_WO), NTOK, DM, DM}; pg8::StaticOrder S; S.init(NTOK, DM, c.G, (int)blockIdx.x);
        EpiResid<true> E{nullptr, (bf16*)(ws + WS_XBF), (float*)(ws + WS_SSQ2)}; pg8::gemm_phase<EpiResid<true>, pg8::StaticOrder, GSCHED>(ring, g, S, E, wv); }
    PH_END;
    if (MKP(12) && PH_ON) { const Args a = ldargs(); phase_router(a, c); }
    PH_END;
#pragma unroll
    for (int hb = 0; hb < 2; ++hb) {
        if (MKP(14) && PH_ON) { const Args a = ldargs(); unsigned char* ws = a.ws; moe_tables(ws, hb, c.lds, c.tid);
            const LAS unsigned* tab = (const LAS unsigned*)(c.lds + MOE_TAB_OFF); const int nb = (int)__builtin_amdgcn_readfirstlane(tab[64]);
            pg8::Gemm g{(const bf16*)(ws + WS_XBF), (const bf16*)(ws + WS_WGU), NTOK, NEXP * 2048, DM}; GroupedOrder S{nb * 8, 8, c.G, (int)blockIdx.x, hb, tab, (const int*)(ws + WS_RTOK)};
            EpiSwiglu E{(bf16*)(ws + WS_ACT), a.in[21], (const float*)(ws + WS_RRSTD2)}; pg8::gemm_phase_gather<EpiSwiglu, GroupedOrder>(ring, g, S, E, wv); }
        PH_END;
        if (MKP(15) && PH_ON) { const Args a = ldargs(); unsigned char* ws = a.ws; moe_tables(ws, hb, c.lds, c.tid);
            const LAS unsigned* tab = (const LAS unsigned*)(c.lds + MOE_TAB_OFF); const int nb = (int)__builtin_amdgcn_readfirstlane(tab[64]);
            pg8::Gemm g{(const bf16*)(ws + WS_ACT), (const bf16*)(ws + WS_WD), CAPH, NEXP * 1024, DM}; GroupedOrder S{nb * 4, 4, c.G, (int)blockIdx.x, hb, tab, (const int*)(ws + WS_RTOK)};
            EpiDown E{(bf16*)(ws + WS_Y), a.in[23], (const float*)(ws + WS_RGATE2)}; pg8::gemm_phase<EpiDown, GroupedOrder, GSCHED>(ring, g, S, E, wv); }
        PH_END;
        if (MKP(16) && PH_ON) { const Args a = ldargs(); phase_combine(a, c, hb); }
        PH_END;
    }
#undef PH_ON
#undef PH_END
}

#if defined(MK_DBG_STOP)
#ifndef MK_DBG_SRC_OUT
#define MK_DBG_SRC_OUT 0
#endif
#ifndef MK_DBG_F32
#define MK_DBG_F32 0
#endif
__global__ void dbg_dump(const unsigned short* src, float* out, size_t n, size_t N) {
    for (size_t i = (size_t)blockIdx.x * blockDim.x + threadIdx.x; i < N; i += (size_t)gridDim.x * blockDim.x) {
        if (i < n) { float v = MK_DBG_F32 ? ((const float*)src)[i] : __builtin_bit_cast(float, (unsigned)src[i] << 16); if (!(fabsf(v) < 1e30f)) v = 12345.f; out[i] = v; }
        else if (!MK_DBG_SRC_OUT) out[i] = 0.f;
    }
}
__global__ void dbg_zero_upper(float* out, size_t n0, size_t N) { for (size_t i = n0 + (size_t)blockIdx.x * blockDim.x + threadIdx.x; i < N; i += (size_t)gridDim.x * blockDim.x) out[i] = 0.f; }
#endif
extern "C" void kernel_launch(void* const* d_in, const int* in_sizes, int n_in, void* d_out, int out_size, void* d_ws, size_t ws_size, hipStream_t stream) {
    static int grid = 0;
    if (grid == 0) {
        if (n_in != 25 || out_size != NTOK * DM || ws_size < WS_END) { fprintf(stderr, "kernel_launch: unexpected problem shape (n_in %d, out %d, ws %zu); nothing launched\n", n_in, out_size, ws_size); grid = -1; return; }
        int dev = 0, cus = 0, per_cu = 0;
        if (hipGetDevice(&dev) != hipSuccess || hipDeviceGetAttribute(&cus, hipDeviceAttributeMultiprocessorCount, dev) != hipSuccess) { grid = -1; return; }
        if (hipFuncSetAttribute((const void*)mk_fwd, hipFuncAttributeMaxDynamicSharedMemorySize, LDS_BYTES) != hipSuccess) { fprintf(stderr, "kernel_launch: hipFuncSetAttribute failed\n"); grid = -1; return; }
        if (hipOccupancyMaxActiveBlocksPerMultiprocessor(&per_cu, (const void*)mk_fwd, 512, LDS_BYTES) != hipSuccess || per_cu < 1) { fprintf(stderr, "kernel_launch: occupancy query reports %d blocks per CU\n", per_cu); }
        (void)hipGetLastError();
        grid = cus;
    }
    if (grid < 0) return;
    (void)in_sizes;
    hipMemsetAsync(d_ws, 0, WS_ZERO_BYTES, stream);
    Args a{};
    for (int i = 0; i < 25; ++i) a.in[i] = (const float*)d_in[i];
    a.out = (float*)d_out; a.ws = (unsigned char*)d_ws;
#if defined(MK_DBG_STOP)
    for (int p = 0; p < MK_DBG_STOP; ++p) { a.ph_lo = p; a.ph_hi = p + 1; hipLaunchKernelGGL(mk_fwd, dim3(grid), dim3(512), LDS_BYTES, stream, a); }
    hipLaunchKernelGGL(dbg_dump, dim3(2048), dim3(256), 0, stream, (const unsigned short*)((const unsigned char*)(MK_DBG_SRC_OUT ? d_out : d_ws) + (size_t)MK_DBG_OFF_MIB * MiB), (float*)d_out, (size_t)MK_DBG_MIB * MiB / (MK_DBG_F32 ? 4 : 2), (size_t)NTOK * DM);
    if (MK_DBG_SRC_OUT) hipLaunchKernelGGL(dbg_zero_upper, dim3(2048), dim3(256), 0, stream, (float*)d_out, (size_t)MK_DBG_MIB * MiB / 2, (size_t)NTOK * DM);
#elif MK_PER_PHASE_LAUNCH
    for (int p = 0; p < NPHASES; ++p) { a.ph_lo = p; a.ph_hi = p + 1; hipLaunchKernelGGL(mk_fwd, dim3(grid), dim3(512), LDS_BYTES, stream, a);
#if defined(MK_REP_PC)
        if (p == MK_REP_PC) for (int r = 0; r < MK_REP_N; ++r) { if (p == 22 && false) (void)hipMemsetAsync((char*)d_ws + WS_GCNT, 0, 4096, stream); hipLaunchKernelGGL(mk_fwd, dim3(grid), dim3(512), LDS_BYTES, stream, a); }
#endif
    }
#else
    a.ph_lo = 0; a.ph_hi = NPHASES;
    hipLaunchKernelGGL(mk_fwd, dim3(grid), dim3(512), LDS_BYTES, stream, a);
#endif
}
```

```cpp
#include <hip/hip_runtime.h>
#include <cstdio>
#include <cstdint>
namespace pg8 {
#define PG8_LAS __attribute__((address_space(3)))
typedef unsigned short bf16_t;
typedef short bf16x8 __attribute__((ext_vector_type(8)));
typedef float f32x4 __attribute__((ext_vector_type(4)));
typedef unsigned u32x4 __attribute__((ext_vector_type(4)));
constexpr int BM = 256, BK = 64, HALF = 128, HTB = HALF * BK * 2  , STAGE_BYTES = 8 * HTB, NXCD = 8, WGM = 8;

__host__ __device__ __forceinline__ int lds_byte(int r, int c) { const int st = (r >> 4) * 2 + (c >> 5), rr = r & 15, cc = c & 31, ob = rr * 64 + cc * 2; return st * 1024 + (ob ^ (((ob >> 9) & 1) << 5)); }
__host__ __device__ __forceinline__ void stage_rc(int b, int& R, int& C) { const int st = b / 1024, sb = b % 1024, swz = sb ^ (((sb >> 9) & 1) << 5); R = (st >> 1) * 16 + swz / 64; C = (st & 1) * 32 + (swz % 64) / 2; }
__host__ __device__ __forceinline__ int perm32(int rho) { const int n = rho >> 4, i = rho & 15; return 8 * (i >> 2) + 4 * n + (i & 3); }

struct Unit { int pm, pn, aux, cnt; };
struct Gemm { const bf16_t* A; const bf16_t* Bt; int M, N, K; };

struct StaticOrder {
    int nM, nN, nwg, G, c;
    __host__ __device__ void init(int M, int N, int G_, int c_) { nM = M / BM; nN = N / BM; nwg = nM * nN; G = G_; c = c_; }
    __host__ __device__ bool next(int i, Unit& u) const {
        const long L = (long)i * G + c; if (L >= nwg) return false;
        int wgid = (int)L; { const int q = nwg / NXCD, r = nwg % NXCD, xcd = wgid % NXCD, off = wgid / NXCD; wgid = (xcd < r ? xcd * (q + 1) : r * (q + 1) + (xcd - r) * q) + off; }
        const int nig = WGM * nN, gid = wgid / nig, fm = gid * WGM, gsz = (nM - fm) < WGM ? (nM - fm) : WGM;
        u.pm = fm + ((wgid % nig) % gsz); u.pn = (wgid % nig) / gsz; return true;
    }
    __device__ __forceinline__ void a_ready(const Unit&) const {}
    __device__ __forceinline__ void done(const Unit&) const {}
};

__device__ __forceinline__ unsigned cvt_pk_bf16(float lo, float hi) { unsigned r; asm volatile("v_cvt_pk_bf16_f32 %0, %1, %2" : "=v"(r) : "v"(lo), "v"(hi)); return r; }
typedef float f32x2 __attribute__((ext_vector_type(2)));
template <class Epi, class Sched, bool ALIGN_EPI = false, bool SP2 = false>
__device__ __forceinline__ void gemm_phase(PG8_LAS unsigned char* lds, const Gemm g, const Sched& S, const Epi& E, const int wave_in) {
    unsigned z_ = 0u; asm volatile("" : "+v"(z_)); const int tid_ = (int)__builtin_amdgcn_mbcnt_hi(~0u, __builtin_amdgcn_mbcnt_lo(~0u, z_)) + 64 * wave_in;
    const int tid = tid_, wid = __builtin_amdgcn_readfirstlane(tid >> 6), lane = tid & 63, wr = wid >> 2, wc = wid & 3, fr = lane & 15, fq = lane >> 4;
    const int K = g.K, nt = K / BK;
    unsigned voffA[2], voffB[2];
#pragma unroll
    for (int i = 0; i < 2; ++i) { int R, C; stage_rc(tid * 16 + i * 8192, R, C); const int Rb = Epi::PERM ? ((R & ~31) + perm32(R & 31)) : R;
        voffA[i] = (unsigned)(R * K + C) * 2u; voffB[i] = (unsigned)(Rb * K + C) * 2u; }
    const size_t kstep = (size_t)(BK * 2);
    const size_t hstep = (size_t)HALF * K * 2;
    const size_t tstep = 2 * hstep;
    const unsigned ldsw = (unsigned)wid * 1024u;
    const int aoff = lds_byte(wr * 64 + fr, fq * 8), boff = lds_byte(wc * 32 + fr, fq * 8);
#define PG8_SA(b, h) (((b) * 2 + (h)) * HTB)
#define PG8_SB(b, h) ((4 + (b) * 2 + (h)) * HTB)
#define PG8_STAGE(bufoff, gbase, voff) do { _Pragma("unroll") for (int _i = 0; _i < 2; ++_i) \
        __builtin_amdgcn_global_load_lds((const unsigned*)((const char*)(gbase) + (voff)[_i]), (PG8_LAS unsigned*)(lds + (bufoff) + ldsw + _i * 8192), 16, 0, 0); } while (0)
#define PG8_LDA(dst, b, h) do { _Pragma("unroll") for (int m = 0; m < 4; ++m) _Pragma("unroll") for (int k = 0; k < 2; ++k) dst[m][k] = *(const PG8_LAS bf16x8*)(lds + PG8_SA(b, h) + aoff + m * 2048 + k * 1024); } while (0)
#define PG8_LDB(dst, b, h) do { _Pragma("unroll") for (int n = 0; n < 2; ++n) _Pragma("unroll") for (int k = 0; k < 2; ++k) dst[n][k] = *(const PG8_LAS bf16x8*)(lds + PG8_SB(b, h) + boff + n * 2048 + k * 1024); } while (0)
#define PG8_MMA(ai, bj, At, Bt) do { __builtin_amdgcn_s_setprio(1); _Pragma("unroll") for (int m = 0; m < 4; ++m) _Pragma("unroll") for (int n = 0; n < 2; ++n) _Pragma("unroll") for (int k = 0; k < 2; ++k) \
        acc[ai][bj][m][n] = __builtin_amdgcn_mfma_f32_16x16x32_bf16(Bt[n][k], At[m][k], acc[ai][bj][m][n], 0, 0, 0); __builtin_amdgcn_s_setprio(0); } while (0)
#define PG8_WAIT_V(n) asm volatile("s_waitcnt vmcnt(" #n ")" ::: "memory")
#define PG8_WAIT_L(n) asm volatile("s_waitcnt lgkmcnt(" #n ")" ::: "memory")
#define PG8_BAR __builtin_amdgcn_s_barrier()
#define PG8_SCHED __builtin_amdgcn_sched_barrier(0)
    Unit cur, nxt; int ui = 0;
    if (!S.next(0, cur)) return;
    f32x4 acc[2][2][4][2];
#pragma unroll
    for (int a = 0; a < 2; ++a)
#pragma unroll
        for (int b = 0; b < 2; ++b)
#pragma unroll
            for (int m = 0; m < 4; ++m)
#pragma unroll
                for (int n = 0; n < 2; ++n) acc[a][b][m][n] = (f32x4){0.f, 0.f, 0.f, 0.f};
    bf16x8 At[4][2], B0[2][2], B1[2][2];
    const char* cA = (const char*)g.A + (size_t)cur.pm * tstep; const char* cB = (const char*)g.Bt + (size_t)cur.pn * tstep;
    S.a_ready(cur);
    if constexpr (SP2) {
        PG8_STAGE(PG8_SB(0, 0), cB, voffB); PG8_STAGE(PG8_SB(0, 1), cB + hstep, voffB); PG8_STAGE(PG8_SA(0, 0), cA, voffA); PG8_STAGE(PG8_SA(0, 1), cA + hstep, voffA);
        if (wr == 1) PG8_BAR;
        PG8_WAIT_V(2); PG8_BAR;
        PG8_STAGE(PG8_SB(1, 0), cB + kstep, voffB); PG8_STAGE(PG8_SA(1, 0), cA + kstep, voffA); PG8_STAGE(PG8_SB(1, 1), cB + hstep + kstep, voffB);
        PG8_WAIT_V(6); PG8_BAR;
    } else {
        PG8_STAGE(PG8_SB(0, 0), cB, voffB); PG8_STAGE(PG8_SA(0, 0), cA, voffA); PG8_STAGE(PG8_SB(0, 1), cB + hstep, voffB); PG8_STAGE(PG8_SA(0, 1), cA + hstep, voffA);
        if (wr == 1) PG8_BAR;
        PG8_WAIT_V(4); PG8_BAR;
        PG8_STAGE(PG8_SB(1, 0), cB + kstep, voffB); PG8_STAGE(PG8_SA(1, 0), cA + kstep, voffA); PG8_STAGE(PG8_SB(1, 1), cB + hstep + kstep, voffB);
        PG8_WAIT_V(6); PG8_BAR;
    }
    for (;;) {
        const bool has_next = S.next(ui + 1, nxt);
        const char* nA = has_next ? (const char*)g.A + (size_t)nxt.pm * tstep : cA; const char* nB = has_next ? (const char*)g.Bt + (size_t)nxt.pn * tstep : cB;
        for (int t = 0; t < nt; t += 2) {
            const bool last = (t == nt - 2);
            const char* a1 = cA + (size_t)(t + 1) * kstep;
            const char* a2 = last ? nA : cA + (size_t)(t + 2) * kstep; const char* b2 = last ? nB : cB + (size_t)(t + 2) * kstep;
            const char* a3 = a2 + kstep; const char* b3 = b2 + kstep;
            if (last && has_next) S.a_ready(nxt);
            if constexpr (SP2) {
            PG8_LDB(B0, 0, 0); PG8_LDB(B1, 0, 1); PG8_SCHED; PG8_LDA(At, 0, 0); PG8_STAGE(PG8_SA(1, 1), a1 + hstep, voffA);
            PG8_WAIT_V(8); PG8_WAIT_L(0); PG8_BAR; PG8_MMA(0, 0, At, B0); PG8_MMA(0, 1, At, B1); PG8_BAR; PG8_SCHED;
            PG8_LDA(At, 0, 1); PG8_STAGE(PG8_SB(0, 0), b2, voffB); PG8_STAGE(PG8_SB(0, 1), b2 + hstep, voffB); PG8_STAGE(PG8_SA(0, 0), a2, voffA);
            PG8_WAIT_V(8); PG8_WAIT_L(0); PG8_BAR; PG8_MMA(1, 0, At, B0); PG8_MMA(1, 1, At, B1); PG8_BAR; PG8_SCHED;
            PG8_LDB(B0, 1, 0); PG8_LDB(B1, 1, 1); PG8_SCHED; PG8_LDA(At, 1, 0); PG8_STAGE(PG8_SA(0, 1), a2 + hstep, voffA);
            PG8_WAIT_V(8); PG8_WAIT_L(0); PG8_BAR; PG8_MMA(0, 0, At, B0); PG8_MMA(0, 1, At, B1); PG8_BAR; PG8_SCHED;
            PG8_LDA(At, 1, 1); PG8_STAGE(PG8_SB(1, 0), b3, voffB); PG8_STAGE(PG8_SB(1, 1), b3 + hstep, voffB); PG8_STAGE(PG8_SA(1, 0), a3, voffA);
            PG8_WAIT_V(8); PG8_WAIT_L(0); PG8_BAR; PG8_MMA(1, 0, At, B0); PG8_MMA(1, 1, At, B1); PG8_BAR; PG8_SCHED;
            } else {
            PG8_LDB(B0, 0, 0); PG8_SCHED; PG8_LDA(At, 0, 0); PG8_STAGE(PG8_SA(1, 1), a1 + hstep, voffA);
            PG8_WAIT_L(8); PG8_BAR; PG8_WAIT_L(0); PG8_MMA(0, 0, At, B0); PG8_BAR; PG8_SCHED;
            PG8_LDB(B1, 0, 1); PG8_STAGE(PG8_SB(0, 0), b2, voffB);
            PG8_BAR; PG8_WAIT_L(0); PG8_MMA(0, 1, At, B1); PG8_BAR;
            PG8_LDA(At, 0, 1); PG8_STAGE(PG8_SA(0, 0), a2, voffA);
            PG8_BAR; PG8_WAIT_L(0); PG8_MMA(1, 0, At, B0); PG8_BAR; PG8_SCHED;
            PG8_STAGE(PG8_SB(0, 1), b2 + hstep, voffB);
            PG8_WAIT_V(6); PG8_BAR; PG8_MMA(1, 1, At, B1); PG8_BAR;
            PG8_LDB(B0, 1, 0); PG8_SCHED; PG8_LDA(At, 1, 0); PG8_STAGE(PG8_SA(0, 1), a2 + hstep, voffA);
            PG8_WAIT_L(8); PG8_BAR; PG8_WAIT_L(0); PG8_MMA(0, 0, At, B0); PG8_BAR; PG8_SCHED;
            PG8_LDB(B1, 1, 1); PG8_STAGE(PG8_SB(1, 0), b3, voffB);
            PG8_BAR; PG8_WAIT_L(0); PG8_MMA(0, 1, At, B1); PG8_BAR;
            PG8_LDA(At, 1, 1); PG8_STAGE(PG8_SA(1, 0), a3, voffA);
            PG8_BAR; PG8_WAIT_L(0); PG8_MMA(1, 0, At, B0); PG8_BAR; PG8_SCHED;
            PG8_STAGE(PG8_SB(1, 1), b3 + hstep, voffB);
            PG8_WAIT_V(6); PG8_BAR; PG8_MMA(1, 1, At, B1); PG8_BAR;
            }
        }
        if constexpr (ALIGN_EPI) { if (wr == 0) PG8_BAR; }
        if constexpr (!Epi::AFTER_DRAIN) { E(acc, cur, wr, wc, fr, fq); S.done(cur); }
        if (!has_next) break;
#pragma unroll
        for (int a = 0; a < 2; ++a)
#pragma unroll
            for (int b = 0; b < 2; ++b)
#pragma unroll
                for (int m = 0; m < 4; ++m)
#pragma unroll
                    for (int n = 0; n < 2; ++n) acc[a][b][m][n] = (f32x4){0.f, 0.f, 0.f, 0.f};
        cur = nxt; cA = nA; cB = nB; ++ui;
        if constexpr (ALIGN_EPI) { if (wr == 1) PG8_BAR; }
    }
    PG8_WAIT_V(0);
    if constexpr (!ALIGN_EPI) { if (wr == 0) PG8_BAR; }
    PG8_BAR;
    if constexpr (Epi::AFTER_DRAIN) { E.fused(acc, cur, wr, wc, fr, fq, lds, wid, lane); S.done(cur); }
#undef PG8_SA
#undef PG8_SB
#undef PG8_STAGE
#undef PG8_LDA
#undef PG8_LDB
#undef PG8_MMA
#undef PG8_WAIT_V
#undef PG8_WAIT_L
#undef PG8_BAR
#undef PG8_SCHED
}
template <class Epi, class Sched>
__device__ __forceinline__ void gemm_phase_gather(PG8_LAS unsigned char* lds, const Gemm g, const Sched& S, const Epi& E, const int wave_in) {
    unsigned z_ = 0u; asm volatile("" : "+v"(z_)); const int tid_ = (int)__builtin_amdgcn_mbcnt_hi(~0u, __builtin_amdgcn_mbcnt_lo(~0u, z_)) + 64 * wave_in;
    const int tid = tid_, wid = __builtin_amdgcn_readfirstlane(tid >> 6), lane = tid & 63, wr = wid >> 2, wc = wid & 3, fr = lane & 15, fq = lane >> 4;
    constexpr bool ALIGN_EPI = true, SP2 = true;
    const int K = g.K, nt = K / BK;
    unsigned voffB[2]; int RA0; unsigned CA0;
#pragma unroll
    for (int i = 0; i < 2; ++i) { int R, C; stage_rc(tid * 16 + i * 8192, R, C); const int Rb = Epi::PERM ? ((R & ~31) + perm32(R & 31)) : R;
        if (i == 0) { RA0 = R; CA0 = (unsigned)C * 2u; } voffB[i] = (unsigned)(Rb * K + C) * 2u; }
    unsigned ro[2], rn[2][2];
    const size_t kstep = (size_t)(BK * 2);
    const size_t hstep = (size_t)HALF * K * 2;
    const size_t tstep = 2 * hstep;
    const unsigned ldsw = (unsigned)wid * 1024u;
    const int aoff = lds_byte(wr * 64 + fr, fq * 8), boff = lds_byte(wc * 32 + fr, fq * 8);
#define PG8_SA(b, h) (((b) * 2 + (h)) * HTB)
#define PG8_SB(b, h) ((4 + (b) * 2 + (h)) * HTB)
#define PG8_STAGE(bufoff, gbase, voff) do { _Pragma("unroll") for (int _i = 0; _i < 2; ++_i) \
        __builtin_amdgcn_global_load_lds((const unsigned*)((const char*)(gbase) + (voff)[_i]), (PG8_LAS unsigned*)(lds + (bufoff) + ldsw + _i * 8192), 16, 0, 0); } while (0)
#define PG8_STAGE_G(bufoff, kbyte, pk) do { _Pragma("unroll") for (int _i = 0; _i < 2; ++_i) { const unsigned _row = _i ? ((pk) >> 16) : ((pk) & 0xffffu); \
        __builtin_amdgcn_global_load_lds((const unsigned*)((const char*)g.A + (kbyte) + (_row * ((unsigned)K * 2u) + CA0)), (PG8_LAS unsigned*)(lds + (bufoff) + ldsw + _i * 8192), 16, 0, 0); } } while (0)
#define PG8_LDA(dst, b, h) do { _Pragma("unroll") for (int m = 0; m < 4; ++m) _Pragma("unroll") for (int k = 0; k < 2; ++k) dst[m][k] = *(const PG8_LAS bf16x8*)(lds + PG8_SA(b, h) + aoff + m * 2048 + k * 1024); } while (0)
#define PG8_LDB(dst, b, h) do { _Pragma("unroll") for (int n = 0; n < 2; ++n) _Pragma("unroll") for (int k = 0; k < 2; ++k) dst[n][k] = *(const PG8_LAS bf16x8*)(lds + PG8_SB(b, h) + boff + n * 2048 + k * 1024); } while (0)
#define PG8_MMA(ai, bj, At, Bt) do { __builtin_amdgcn_s_setprio(1); _Pragma("unroll") for (int m = 0; m < 4; ++m) _Pragma("unroll") for (int n = 0; n < 2; ++n) _Pragma("unroll") for (int k = 0; k < 2; ++k) \
        acc[ai][bj][m][n] = __builtin_amdgcn_mfma_f32_16x16x32_bf16(Bt[n][k], At[m][k], acc[ai][bj][m][n], 0, 0, 0); __builtin_amdgcn_s_setprio(0); } while (0)
#define PG8_WAIT_V(n) asm volatile("s_waitcnt vmcnt(" #n ")" ::: "memory")
#define PG8_WAIT_L(n) asm volatile("s_waitcnt lgkmcnt(" #n ")" ::: "memory")
#define PG8_BAR __builtin_amdgcn_s_barrier()
#define PG8_SCHED __builtin_amdgcn_sched_barrier(0)
    Unit cur, nxt; int ui = 0;
    if (!S.next(0, cur)) return;
    f32x4 acc[2][2][4][2];
#pragma unroll
    for (int a = 0; a < 2; ++a)
#pragma unroll
        for (int b = 0; b < 2; ++b)
#pragma unroll
            for (int m = 0; m < 4; ++m)
#pragma unroll
                for (int n = 0; n < 2; ++n) acc[a][b][m][n] = (f32x4){0.f, 0.f, 0.f, 0.f};
    bf16x8 At[4][2], B0[2][2], B1[2][2];
    const char* cB = (const char*)g.Bt + (size_t)cur.pn * tstep;
    S.a_ready(cur);
    S.rows(cur, RA0, rn); ro[0] = rn[0][0] | (rn[0][1] << 16); ro[1] = rn[1][0] | (rn[1][1] << 16);
    if constexpr (SP2) {
        PG8_STAGE(PG8_SB(0, 0), cB, voffB); PG8_STAGE(PG8_SB(0, 1), cB + hstep, voffB); PG8_STAGE_G(PG8_SA(0, 0), 0, ro[0]); PG8_STAGE_G(PG8_SA(0, 1), 0, ro[1]);
        if (wr == 1) PG8_BAR;
        PG8_WAIT_V(2); PG8_BAR;
        PG8_STAGE(PG8_SB(1, 0), cB + kstep, voffB); PG8_STAGE_G(PG8_SA(1, 0), kstep, ro[0]); PG8_STAGE(PG8_SB(1, 1), cB + hstep + kstep, voffB);
        PG8_WAIT_V(6); PG8_BAR;
    }
    for (;;) {
        const bool has_next = S.next(ui + 1, nxt);
        const char* nB = has_next ? (const char*)g.Bt + (size_t)nxt.pn * tstep : cB;
        for (int t = 0; t < nt; t += 2) {
            const bool last = (t == nt - 2);
            const size_t k1 = (size_t)(t + 1) * kstep, k2 = last ? (size_t)0 : (size_t)(t + 2) * kstep, k3 = k2 + kstep;
            const char* b2 = last ? nB : cB + (size_t)(t + 2) * kstep; const char* b3 = b2 + kstep;
            if (t == nt - 4 && has_next) S.rows(nxt, RA0, rn);
            const unsigned c1 = ro[1];
            unsigned s0 = ro[0], s1 = ro[1];
            if (last && has_next) { unsigned q0 = rn[0][0], q1 = rn[0][1], q2 = rn[1][0], q3 = rn[1][1]; asm volatile("" : "+v"(q0), "+v"(q1), "+v"(q2), "+v"(q3));
                s0 = q0 | (q1 << 16); s1 = q2 | (q3 << 16); ro[0] = s0; ro[1] = s1; }
            if (last && has_next) S.a_ready(nxt);
            if constexpr (SP2) {
            PG8_LDB(B0, 0, 0); PG8_LDB(B1, 0, 1); PG8_SCHED; PG8_LDA(At, 0, 0); PG8_STAGE_G(PG8_SA(1, 1), k1, c1);
            PG8_WAIT_V(8); PG8_WAIT_L(0); PG8_BAR; PG8_MMA(0, 0, At, B0); PG8_MMA(0, 1, At, B1); PG8_BAR; PG8_SCHED;
            PG8_LDA(At, 0, 1); PG8_STAGE(PG8_SB(0, 0), b2, voffB); PG8_STAGE(PG8_SB(0, 1), b2 + hstep, voffB); PG8_STAGE_G(PG8_SA(0, 0), k2, s0);
            PG8_WAIT_V(8); PG8_WAIT_L(0); PG8_BAR; PG8_MMA(1, 0, At, B0); PG8_MMA(1, 1, At, B1); PG8_BAR; PG8_SCHED;
            PG8_LDB(B0, 1, 0); PG8_LDB(B1, 1, 1); PG8_SCHED; PG8_LDA(At, 1, 0); PG8_STAGE_G(PG8_SA(0, 1), k2, s1);
            PG8_WAIT_V(8); PG8_WAIT_L(0); PG8_BAR; PG8_MMA(0, 0, At, B0); PG8_MMA(0, 1, At, B1); PG8_BAR; PG8_SCHED;
            PG8_LDA(At, 1, 1); PG8_STAGE(PG8_SB(1, 0), b3, voffB); PG8_STAGE(PG8_SB(1, 1), b3 + hstep, voffB); PG8_STAGE_G(PG8_SA(1, 0), k3, s0);
            PG8_WAIT_V(8); PG8_WAIT_L(0); PG8_BAR; PG8_MMA(1, 0, At, B0); PG8_MMA(1, 1, At, B1); PG8_BAR; PG8_SCHED;
            }
        }
        if constexpr (ALIGN_EPI) { if (wr == 0) PG8_BAR; }
        if constexpr (!Epi::AFTER_DRAIN) { E(acc, cur, wr, wc, fr, fq); S.done(cur); }
        if (!has_next) break;
#pragma unroll
        for (int a = 0; a < 2; ++a)
#pragma unroll
            for (int b = 0; b < 2; ++b)
#pragma unroll
                for (int m = 0; m < 4; ++m)
#pragma unroll
                    for (int n = 0; n < 2; ++n) acc[a][b][m][n] = (f32x4){0.f, 0.f, 0.f, 0.f};
        cur = nxt; cB = nB; ++ui;
        if constexpr (ALIGN_EPI) { if (wr == 1) PG8_BAR; }
    }
    PG8_WAIT_V(0);
    if constexpr (!ALIGN_EPI) { if (wr == 0) PG8_BAR; }
    PG8_BAR;
    if constexpr (Epi::AFTER_DRAIN) { E.fused(acc, cur, wr, wc, fr, fq, lds, wid, lane); S.done(cur); }
#undef PG8_SA
#undef PG8_SB
#undef PG8_STAGE
#undef PG8_STAGE_G
#undef PG8_LDA
#undef PG8_LDB
#undef PG8_MMA
#undef PG8_WAIT_V
#undef PG8_WAIT_L
#undef PG8_BAR
#undef PG8_SCHED
}
}

#ifndef PG8_SP2
#define PG8_SP2 true
#endif
#ifndef PG8_ALIGN
#define PG8_ALIGN true
#endif

constexpr int NTOK = 65536, DM = 1024, NCOL = 7680, SEQ = 4096, NBATCH = 16, HTOK = 32768, MEMLEN = 256;
constexpr int C_HQ = 0, C_HF = 1024, C_HI = 2048, C_HG = 3072, C_SQ = 4096, C_SK = 5120, C_SV = 5376, C_GA = 5632, C_GB = 6656;
constexpr int NEXP = 32, TOPK = 4, CAPH = HTOK * TOPK + NEXP * 256;
constexpr float RMS_EPS = 1e-5f;
constexpr size_t MiB = (size_t)1 << 20;
constexpr size_t WS_ZERO_BYTES = 2 * MiB;
constexpr size_t WS_GCNT = 1 * MiB;
constexpr int CW_TMO = 0, CW_BAR = 4096;
constexpr size_t WS_LB = 2 * MiB, WS_LUT = 2 * MiB + 4096, WS_BLKE = 2 * MiB + 16384, WS_NBT = 2 * MiB + 32768;
constexpr size_t WS_TOPE = 3 * MiB, WS_TOPG = 4 * MiB, WS_TOPR = 5 * MiB, WS_TOPP = 6 * MiB, WS_RGATE = 7 * MiB, WS_RRSTD = 8 * MiB, WS_D12 = 10 * MiB;
constexpr size_t WS_WIN = 16 * MiB, WS_WA = 31 * MiB, WS_WB = 33 * MiB, WS_WMIX = 35 * MiB, WS_WQ = 37 * MiB, WS_WK = 39 * MiB, WS_WV = 41 * MiB, WS_WO = 43 * MiB, WS_WR = 45 * MiB;
constexpr size_t WS_MEMBF = 46 * MiB, WS_KX = 54 * MiB, WS_VXT = 62 * MiB;
constexpr size_t WS_XBF = 72 * MiB;
constexpr size_t WS_PROJ = 200 * MiB, WS_OA = 680 * MiB, WS_OB = 744 * MiB, WS_TM = 808 * MiB;
constexpr size_t WS_Q = 664 * MiB, WS_O = 792 * MiB;
constexpr size_t WS_WGU = 200 * MiB, WS_WD = 328 * MiB, WS_ACT = 392 * MiB, WS_Y = 664 * MiB, WS_SSQ1 = 936 * MiB, WS_SSQ2 = 940 * MiB, WS_RTOK = 944 * MiB, WS_RGATE2 = 952 * MiB, WS_RRSTD2 = 960 * MiB, WS_END = 968 * MiB;
constexpr size_t OUT_US = 128 * MiB;

#define GAS __attribute__((address_space(1)))
#define LAS __attribute__((address_space(3)))
typedef unsigned short bf16;
typedef unsigned v4u __attribute__((ext_vector_type(4)));
typedef unsigned v2u __attribute__((ext_vector_type(2)));
typedef float f32x4 __attribute__((ext_vector_type(4)));
typedef short bf16x8 __attribute__((ext_vector_type(8)));
typedef short s16x4 __attribute__((ext_vector_type(4)));
#define RLX_AGENT __ATOMIC_RELAXED, __HIP_MEMORY_SCOPE_AGENT
#define LDS_WAIT() asm volatile("s_waitcnt lgkmcnt(0)" ::: "memory")
#define CFENCE() asm volatile("" ::: "memory")
__device__ __forceinline__ unsigned f2bf(float f) { unsigned u = __builtin_bit_cast(unsigned, f); return (u + 0x7fffu + ((u >> 16) & 1u)) >> 16; }
typedef float f32x2_t __attribute__((ext_vector_type(2))); typedef __bf16 bf16x2_t __attribute__((ext_vector_type(2)));
__device__ __forceinline__ unsigned pk2(float lo, float hi) { f32x2_t v = {lo, hi}; bf16x2_t b = __builtin_convertvector(v, bf16x2_t); return __builtin_bit_cast(unsigned, b); }
__device__ __forceinline__ float bflo(unsigned w) { return __builtin_bit_cast(float, w << 16); }
__device__ __forceinline__ float bfhi(unsigned w) { return __builtin_bit_cast(float, w & 0xffff0000u); }
__device__ __forceinline__ float sigm(float x) { return 1.f / (1.f + __expf(-x)); }
__device__ __forceinline__ float shx(float v, int mask, int lane) { return __builtin_bit_cast(float, __builtin_amdgcn_ds_bpermute((lane ^ mask) << 2, __builtin_bit_cast(int, v))); }
__device__ __forceinline__ float wave_sum(float v, int lane) {
#pragma unroll
    for (int o = 1; o < 64; o <<= 1) v += shx(v, o, lane);
    return v;
}
__device__ __forceinline__ f32x4 mfma16(bf16x8 a, bf16x8 b, f32x4 c) { return __builtin_amdgcn_mfma_f32_16x16x32_bf16(a, b, c, 0, 0, 0); }
__device__ __forceinline__ s16x4 vtr(const LAS unsigned char* p) { return __builtin_bit_cast(s16x4, __builtin_amdgcn_ds_read_tr16_b64_v4i16((LAS s16x4*)p)); }
__device__ __forceinline__ bf16x8 cat8(s16x4 lo, s16x4 hi) { return __builtin_shufflevector(lo, hi, 0, 1, 2, 3, 4, 5, 6, 7); }
__device__ __forceinline__ bf16x8 pack8(f32x4 a, f32x4 b) { v4u w; w.x = pk2(a[0], a[1]); w.y = pk2(a[2], a[3]); w.z = pk2(b[0], b[1]); w.w = pk2(b[2], b[3]); return __builtin_bit_cast(bf16x8, w); }
__device__ __forceinline__ float rstd16(const float* ssqp, size_t row) { const f32x4* p = (const f32x4*)(ssqp + row * 16); const f32x4 a = p[0], b = p[1], c = p[2], d = p[3];
    const float s = ((a[0] + a[1]) + (a[2] + a[3])) + ((b[0] + b[1]) + (b[2] + b[3])) + ((c[0] + c[1]) + (c[2] + c[3])) + ((d[0] + d[1]) + (d[2] + d[3])); return rsqrtf(s * (1.f / 1024.f) + 1e-5f); }
__device__ __forceinline__ unsigned ld_agent(const unsigned* p) { return __hip_atomic_load(p, RLX_AGENT); }


#define XB_TMO      128
#define XB_XCNT(j)  (256  + 64 * (j))
#define XB_XSUB(j)  (1280 + 64 * (j))
#define XB_XGEN(j)  (2304 + 64 * (j))
#define XB_TOP      3328
#define XB_TOPGEN   3392
#define XCD_BAR_WORDS 3456
#define XB_SPIN_CAP (1u << 18)

__device__ __forceinline__ unsigned xb_ld(unsigned* p)              { return __hip_atomic_load(p, __ATOMIC_RELAXED, __HIP_MEMORY_SCOPE_AGENT); }
__device__ __forceinline__ unsigned xb_add(unsigned* p, unsigned v) { return __hip_atomic_fetch_add(p, v, __ATOMIC_RELAXED, __HIP_MEMORY_SCOPE_AGENT); }
__device__ __forceinline__ unsigned xb_xcc_id() { return (unsigned)__builtin_amdgcn_s_getreg((3 << 11) | 20) & 0xFu; }
#define XB_SPIN(cond, bar) do { unsigned _sp = 0; while (cond) { __builtin_amdgcn_s_sleep(1); \
    if ((++_sp & 255u) == 0u) { if (xb_ld(&(bar)[XB_TMO])) break; if (_sp > XB_SPIN_CAP) { atomicAdd(&(bar)[XB_TMO], 1u); break; } } } } while (0)

struct XcdBarrier {
    unsigned* bar; unsigned x; int t0;
    volatile LAS unsigned* st;
};

__device__ __forceinline__ bool xb_is_t0(int wave) { return wave == 0 && __builtin_amdgcn_mbcnt_hi(~0u, __builtin_amdgcn_mbcnt_lo(~0u, 0u)) == 0u; }
__device__ __forceinline__ XcdBarrier xcd_barrier_post(unsigned* bar, volatile LAS unsigned* st, int wave) {
    XcdBarrier b; b.bar = bar; b.x = xb_xcc_id(); b.st = st; b.t0 = wave;
    if (xb_is_t0(wave)) (void)xb_add(&bar[XB_XCNT(b.x)], 1u);
    return b;
}
__device__ __forceinline__ void xcd_barrier_complete(unsigned* bar, unsigned x, unsigned& nloc, unsigned& nx) {
    const unsigned G = gridDim.x * gridDim.y * gridDim.z;
    unsigned sum, cnt, mine, sp = 0u;
    for (;;) {
        sum = 0u; cnt = 0u; mine = 0u;
#pragma unroll
        for (unsigned j = 0; j < 16; ++j) { const unsigned c = xb_ld(&bar[XB_XCNT(j)]); sum += c; cnt += (c > 0u) ? 1u : 0u; mine = (j == x) ? c : mine; }
        if (sum == G) break;
        __builtin_amdgcn_s_sleep(1);
        if ((++sp & 255u) == 0u) { if (xb_ld(&bar[XB_TMO])) break; if (sp > XB_SPIN_CAP) { atomicAdd(&bar[XB_TMO], 1u); break; } }
    }
    nloc = mine > 0u ? mine : 1u; nx = cnt > 0u ? cnt : 1u;
}

__device__ __forceinline__ void xcd_barrier(const XcdBarrier& b) {
    asm volatile("s_waitcnt vmcnt(0)" ::: "memory");
    __syncthreads();
    if (xb_is_t0(b.t0)) {
        unsigned* bar = b.bar;
        __builtin_amdgcn_s_waitcnt(0);
        unsigned nloc = b.st[0], nx = b.st[1];
        if (nloc == 0u) { xcd_barrier_complete(bar, b.x, nloc, nx); b.st[0] = nloc; b.st[1] = nx; }
        const unsigned old = xb_add(&bar[XB_XSUB(b.x)], 1u);
        const unsigned gen = old / nloc;
        if (old + 1u == (gen + 1u) * nloc) {
            __builtin_amdgcn_fence(__ATOMIC_RELEASE, "agent");
            asm volatile("s_waitcnt vmcnt(0)" ::: "memory");
            const unsigned og = xb_add(&bar[XB_TOP], 1u);
            const unsigned tg = og / nx;
            if (og + 1u == (tg + 1u) * nx) xb_add(&bar[XB_TOPGEN], 1u);
            else XB_SPIN(xb_ld(&bar[XB_TOPGEN]) == tg, bar);
            __builtin_amdgcn_fence(__ATOMIC_ACQUIRE, "agent");
            xb_add(&bar[XB_XGEN(b.x)], 1u);
            asm volatile("s_waitcnt vmcnt(0)" ::: "memory");
        } else {
            XB_SPIN(xb_ld(&bar[XB_XGEN(b.x)]) == gen, bar);
            __builtin_amdgcn_fence(__ATOMIC_ACQUIRE, "agent");
            asm volatile("s_waitcnt vmcnt(0)" ::: "memory");
        }
    }
    __syncthreads();
}

struct Args {
    const float* in[25];
    float* out; unsigned char* ws;
    int ph_lo, ph_hi;
};

using pg8::Unit;
struct EpiStore {
    static constexpr bool PERM = true, AFTER_DRAIN = false;
    bf16* O; int ldc; const float* ssq;
    __device__ __forceinline__ void operator()(const f32x4 (&acc)[2][2][4][2], const Unit& u, int wr, int wc, int fr, int fq) const {
        const int row0 = u.pm * 256 + wr * 64 + fr, col0 = u.pn * 256 + wc * 32 + 8 * fq;
#pragma unroll
        for (int ai = 0; ai < 2; ++ai) { float sc[4];
#pragma unroll
            for (int m = 0; m < 4; ++m) sc[m] = ssq ? rstd16(ssq, (size_t)(row0 + ai * 128 + m * 16)) : 1.f;
#pragma unroll
            for (int m = 0; m < 4; ++m) { const int row = row0 + ai * 128 + m * 16; bf16* rowp = O + (size_t)row * ldc + col0;
#pragma unroll
                for (int bj = 0; bj < 2; ++bj) { const f32x4 v0 = acc[ai][bj][m][0] * sc[m], v1 = acc[ai][bj][m][1] * sc[m];
                    v4u w; w.x = pk2(v0[0], v0[1]); w.y = pk2(v0[2], v0[3]); w.z = pk2(v1[0], v1[1]); w.w = pk2(v1[2], v1[3]);
                    *(v4u*)(rowp + bj * 128) = w; } } }
    }
};
template <bool ADD> struct EpiGate {
    static constexpr bool PERM = true, AFTER_DRAIN = false;
    bf16* T; const bf16* proj; int gcol; const float* bias;
    __device__ __forceinline__ void operator()(const f32x4 (&acc)[2][2][4][2], const Unit& u, int wr, int wc, int fr, int fq) const {
        const int row0 = u.pm * 256 + wr * 64 + fr, col0 = u.pn * 256 + wc * 32 + 8 * fq;
        f32x4 bv[2][2];
#pragma unroll
        for (int bj = 0; bj < 2; ++bj)
#pragma unroll
            for (int n = 0; n < 2; ++n) bv[bj][n] = *(const f32x4*)(bias + col0 + bj * 128 + 4 * n);
#pragma unroll
        for (int am = 0; am < 4; ++am) { const int ai = am >> 1, mh = am & 1; v4u gw[2][2], tw[2][2];
#pragma unroll
            for (int mm = 0; mm < 2; ++mm)
#pragma unroll
                for (int bj = 0; bj < 2; ++bj) { const int row = row0 + ai * 128 + (2 * mh + mm) * 16; gw[mm][bj] = *(const v4u*)(proj + (size_t)row * NCOL + gcol + col0 + bj * 128);
                    if (ADD) tw[mm][bj] = *(const v4u*)(T + (size_t)row * DM + col0 + bj * 128); }
#pragma unroll
            for (int mm = 0; mm < 2; ++mm)
#pragma unroll
                for (int bj = 0; bj < 2; ++bj) { const int m = 2 * mh + mm; const int row = row0 + ai * 128 + m * 16; const v4u g4 = gw[mm][bj]; float r[8];
                    r[0] = sigm(bflo(g4.x) + bv[bj][0][0]) * acc[ai][bj][m][0][0]; r[1] = sigm(bfhi(g4.x) + bv[bj][0][1]) * acc[ai][bj][m][0][1];
                    r[2] = sigm(bflo(g4.y) + bv[bj][0][2]) * acc[ai][bj][m][0][2]; r[3] = sigm(bfhi(g4.y) + bv[bj][0][3]) * acc[ai][bj][m][0][3];
                    r[4] = sigm(bflo(g4.z) + bv[bj][1][0]) * acc[ai][bj][m][1][0]; r[5] = sigm(bfhi(g4.z) + bv[bj][1][1]) * acc[ai][bj][m][1][1];
                    r[6] = sigm(bflo(g4.w) + bv[bj][1][2]) * acc[ai][bj][m][1][2]; r[7] = sigm(bfhi(g4.w) + bv[bj][1][3]) * acc[ai][bj][m][1][3];
                    if (ADD) { const v4u t4 = tw[mm][bj];
                        r[0] += bflo(t4.x); r[1] += bfhi(t4.x); r[2] += bflo(t4.y); r[3] += bfhi(t4.y); r[4] += bflo(t4.z); r[5] += bfhi(t4.z); r[6] += bflo(t4.w); r[7] += bfhi(t4.w); }
                    v4u w; w.x = pk2(r[0], r[1]); w.y = pk2(r[2], r[3]); w.z = pk2(r[4], r[5]); w.w = pk2(r[6], r[7]);
                    *(v4u*)(T + (size_t)row * DM + col0 + bj * 128) = w; } }
    }
};
template <bool BF> struct EpiResid {
    static constexpr bool PERM = true, AFTER_DRAIN = false;
    const float* base; bf16* obf; float* ssq;
    __device__ __forceinline__ void operator()(const f32x4 (&acc)[2][2][4][2], const Unit& u, int wr, int wc, int fr, int fq) const {
        const int row0 = u.pm * 256 + wr * 64 + fr, col0 = u.pn * 256 + wc * 32 + 8 * fq;
#pragma unroll
        for (int ai = 0; ai < 2; ++ai)
#pragma unroll
            for (int mh = 0; mh < 2; ++mh) { f32x4 b0[2][2], b1[2][2];
#pragma unroll
                for (int mm = 0; mm < 2; ++mm)
#pragma unroll
                    for (int bj = 0; bj < 2; ++bj) { const size_t off = (size_t)(row0 + ai * 128 + (2 * mh + mm) * 16) * DM + col0 + bj * 128;
                        if (BF) { const v4u bw = *(const v4u*)(obf + off); b0[mm][bj] = (f32x4){bflo(bw.x), bfhi(bw.x), bflo(bw.y), bfhi(bw.y)}; b1[mm][bj] = (f32x4){bflo(bw.z), bfhi(bw.z), bflo(bw.w), bfhi(bw.w)}; }
                        else { b0[mm][bj] = *(const f32x4*)(base + off); b1[mm][bj] = *(const f32x4*)(base + off + 4); } }
#pragma unroll
                for (int mm = 0; mm < 2; ++mm) { const int m = 2 * mh + mm; const int row = row0 + ai * 128 + m * 16; float ss = 0.f;
#pragma unroll
                    for (int bj = 0; bj < 2; ++bj) { const size_t off = (size_t)row * DM + col0 + bj * 128;
                        const f32x4 v0 = b0[mm][bj] + acc[ai][bj][m][0], v1 = b1[mm][bj] + acc[ai][bj][m][1];
                        v4u w; w.x = pk2(v0[0], v0[1]); w.y = pk2(v0[2], v0[3]); w.z = pk2(v1[0], v1[1]); w.w = pk2(v1[2], v1[3]);
                        *(v4u*)(obf + off) = w;
                        ss += ((v0[0] * v0[0] + v0[1] * v0[1]) + (v0[2] * v0[2] + v0[3] * v0[3])) + ((v1[0] * v1[0] + v1[1] * v1[1]) + (v1[2] * v1[2] + v1[3] * v1[3])); }
                    { const int ln_ = fr + 16 * fq; ss += shx(ss, 16, ln_); ss += shx(ss, 32, ln_); }
                    if (fq == 0) ssq[(size_t)row * 16 + (u.pn & 3) * 4 + wc] = ss; } }
    }
};
struct EpiSwiglu {
    static constexpr bool PERM = true, AFTER_DRAIN = false;
    bf16* act; const float* bgu; const float* row_rstd;
    __device__ __forceinline__ void operator()(const f32x4 (&acc)[2][2][4][2], const Unit& u, int wr, int wc, int fr, int fq) const {
        const int e = u.pn >> 3, pnl = u.pn & 7;
        const int rr0 = wr * 64 + fr, cl0 = pnl * 128 + wc * 32 + 8 * fq;
        f32x4 bg[2], bl[2]; float rs[2][4];
#pragma unroll
        for (int n = 0; n < 2; ++n) { bg[n] = *(const f32x4*)(bgu + e * 2048 + cl0 + 4 * n); bl[n] = *(const f32x4*)(bgu + e * 2048 + 1024 + cl0 + 4 * n); }
#pragma unroll
        for (int ai = 0; ai < 2; ++ai)
#pragma unroll
            for (int m = 0; m < 4; ++m) rs[ai][m] = row_rstd[u.aux + rr0 + ai * 128 + m * 16];
#pragma unroll
        for (int ai = 0; ai < 2; ++ai)
#pragma unroll
            for (int m = 0; m < 4; ++m) { const int row = u.pm * 256 + rr0 + ai * 128 + m * 16;
                float r[8];
#pragma unroll
                for (int n = 0; n < 2; ++n)
#pragma unroll
                    for (int j = 0; j < 4; ++j) { float gl = acc[ai][0][m][n][j] * rs[ai][m] + bg[n][j], li = acc[ai][1][m][n][j] * rs[ai][m] + bl[n][j];
                        gl = fminf(gl, 7.0f); li = fminf(fmaxf(li, -7.0f), 7.0f);
                        r[n * 4 + j] = gl * sigm(1.702f * gl) * (li + 1.0f); }
                v4u w; w.x = pk2(r[0], r[1]); w.y = pk2(r[2], r[3]); w.z = pk2(r[4], r[5]); w.w = pk2(r[6], r[7]);
                *(v4u*)(act + (size_t)row * DM + cl0) = w; }
    }
};
struct EpiDown {
    static constexpr bool PERM = true, AFTER_DRAIN = false;
    bf16* y; const float* bd; const float* row_gate;
    __device__ __forceinline__ void operator()(const f32x4 (&acc)[2][2][4][2], const Unit& u, int wr, int wc, int fr, int fq) const {
        const int e = u.pn >> 2, pnl = u.pn & 3;
        const int rr0 = wr * 64 + fr, col0 = pnl * 256 + wc * 32 + 8 * fq;
        f32x4 bv[2][2]; float gt[2][4];
#pragma unroll
        for (int bj = 0; bj < 2; ++bj)
#pragma unroll
            for (int n = 0; n < 2; ++n) bv[bj][n] = *(const f32x4*)(bd + e * 1024 + col0 + bj * 128 + 4 * n);
#pragma unroll
        for (int ai = 0; ai < 2; ++ai)
#pragma unroll
            for (int m = 0; m < 4; ++m) gt[ai][m] = row_gate[u.aux + rr0 + ai * 128 + m * 16];
#pragma unroll
        for (int ai = 0; ai < 2; ++ai)
#pragma unroll
            for (int m = 0; m < 4; ++m) { const int row = u.pm * 256 + rr0 + ai * 128 + m * 16;
#pragma unroll
                for (int bj = 0; bj < 2; ++bj) { const f32x4 v0 = (acc[ai][bj][m][0] + bv[bj][0]) * gt[ai][m], v1 = (acc[ai][bj][m][1] + bv[bj][1]) * gt[ai][m];
                    v4u w; w.x = pk2(v0[0], v0[1]); w.y = pk2(v0[2], v0[3]); w.z = pk2(v1[0], v1[1]); w.w = pk2(v1[2], v1[3]);
                    *(v4u*)(y + (size_t)row * DM + col0 + bj * 128) = w; } }
    }
};
struct GroupedOrder {
    int nunits, npn, G, c, half; const LAS unsigned* tab; const int* row_tok;
    __device__ __forceinline__ bool next(int i, Unit& u) const {
        const long L = (long)i * G + c; if (L >= nunits) return false;
        const int rb = (int)(L / npn), pn = (int)(L % npn);
        int e = 0;
#pragma unroll 4
        for (int k = 1; k < 32; ++k) e = (rb >= (int)tab[32 + k]) ? k : e;
        e = __builtin_amdgcn_readfirstlane(e);
        const int j = rb - (int)__builtin_amdgcn_readfirstlane(tab[32 + e]), cn = (int)__builtin_amdgcn_readfirstlane(tab[e]) - 256 * j;
        u.pm = rb; u.pn = e * npn + pn; u.aux = (half * 32 + e) * HTOK + 256 * j; u.cnt = cn < 256 ? cn : 256; return true;
    }
    __device__ __forceinline__ void rows(const Unit& u, int RA0, unsigned (&rn)[2][2]) const {
#pragma unroll
        for (int h = 0; h < 2; ++h) { const int r0 = h * 128 + RA0, r1 = r0 + 64, cm = u.cnt - 1;
            rn[h][0] = (unsigned)row_tok[u.aux + (r0 < cm ? r0 : cm)]; rn[h][1] = (unsigned)row_tok[u.aux + (r1 < cm ? r1 : cm)]; }
    }
    __device__ __forceinline__ void a_ready(const Unit&) const {}
    __device__ __forceinline__ void done(const Unit&) const {}
};
constexpr int MOE_TAB_OFF = 131072 + 1024;
__device__ __forceinline__ void moe_tables(const unsigned char* ws, int hb, LAS unsigned char* lds, int tid) {
    LAS unsigned* tab = (LAS unsigned*)(lds + MOE_TAB_OFF); const unsigned* gcnt = (const unsigned*)(ws + WS_GCNT);
    __syncthreads();
    if (tid < 32) tab[tid] = ld_agent(gcnt + (hb * 32 + tid) * 16);
    __syncthreads();
    if (tid == 0) { unsigned acc = 0; for (int e = 0; e < 32; ++e) { tab[32 + e] = acc; acc += (tab[e] + 255u) >> 8; } tab[64] = acc; }
    __syncthreads();
}

constexpr int RING_BYTES = 131072, MISC_OFF = RING_BYTES + 320, LDS_BYTES = 147456;

struct Ctx { LAS unsigned char* lds; int tid, lane, wave, G, gw, ngw; };

struct TItem { f32x4 v[8]; float gv[8]; };
__device__ __forceinline__ void titem_load(TItem& t, const float* W, int N, const float* gain, int k0, int n0, int lane) {
#pragma unroll
    for (int i = 0; i < 8; ++i) { const int kk = 8 * i + (lane >> 3); t.v[i] = *(const f32x4*)(W + (size_t)(k0 + kk) * N + n0 + (lane & 7) * 4); t.gv[i] = gain ? gain[k0 + kk] : 1.f; }
}
__device__ __forceinline__ void titem_to_lds(const TItem& t, LAS float* scr, int lane) {
#pragma unroll
    for (int i = 0; i < 8; ++i) { const int kk = 8 * i + (lane >> 3); LAS float* p = scr + kk * 33 + (lane & 7) * 4;
        p[0] = t.v[i][0] * t.gv[i]; p[1] = t.v[i][1] * t.gv[i]; p[2] = t.v[i][2] * t.gv[i]; p[3] = t.v[i][3] * t.gv[i]; }
    LDS_WAIT();
}
template <class RowMap>
__device__ __forceinline__ void titem_out(int K, bf16* WT, const LAS float* scr, int k0, int n0, int lane, RowMap rm) {
    const int c = lane & 7;
#pragma unroll
    for (int j = 0; j < 4; ++j) { const int n = (lane >> 3) + 8 * j; const LAS float* s = scr + (8 * c) * 33 + n;
        v4u o; o.x = pk2(s[0 * 33], s[1 * 33]); o.y = pk2(s[2 * 33], s[3 * 33]); o.z = pk2(s[4 * 33], s[5 * 33]); o.w = pk2(s[6 * 33], s[7 * 33]);
        *(v4u*)(WT + (size_t)rm(n0 + n) * K + k0 + 8 * c) = o; }
    LDS_WAIT();
}
template <class RowMap>
__device__ __forceinline__ void transpose_item(const float* W, int K, int N, bf16* WT, const float* gain, LAS float* scr, int item, int lane, RowMap rm) {
    const int nblk = N / 32, kb = item / nblk, nb = item % nblk, k0 = 64 * kb, n0 = 32 * nb;
    TItem t; titem_load(t, W, N, gain, k0, n0, lane); titem_to_lds(t, scr, lane); titem_out(K, WT, scr, k0, n0, lane, rm);
}
struct RowId { int off; __device__ __forceinline__ int operator()(int n) const { return off + n; } };
struct RowGU { int e; __device__ __forceinline__ int operator()(int n) const { const int j = n & 1023; return e * 2048 + (j >> 7) * 256 + (n >> 10) * 128 + (j & 127); } };

__device__ __forceinline__ void rms_row_to_bf16(const float* xrow, const float* gain, bf16* orow, int lane) {
    const f32x4* xr = (const f32x4*)xrow + lane; const f32x4* gr = (const f32x4*)gain + lane;
    f32x4 v[4]; float s = 0.f;
#pragma unroll
    for (int j = 0; j < 4; ++j) { v[j] = xr[64 * j]; s += (v[j][0] * v[j][0] + v[j][1] * v[j][1]) + (v[j][2] * v[j][2] + v[j][3] * v[j][3]); }
    const float rstd = rsqrtf(wave_sum(s, lane) * (1.f / DM) + RMS_EPS);
    unsigned long long* o8 = (unsigned long long*)orow + lane;
#pragma unroll
    for (int j = 0; j < 4; ++j) { const f32x4 g = gr[64 * j]; const f32x4 w = v[j] * rstd * g;
        o8[64 * j] = (unsigned long long)pk2(w[0], w[1]) | ((unsigned long long)pk2(w[2], w[3]) << 32); }
}

__device__ __forceinline__ void phase_prologue(const Args& a, const Ctx& c) {
    LAS float* scr = (LAS float*)(c.lds + c.wave * 16384);
    unsigned char* ws = a.ws;
    constexpr int I_IN = 16 * (NCOL / 32), I_SQ = 16 * 32, I_R = 16;
    constexpr int NIT = I_IN + 7 * I_SQ + I_R;
    for (int it = c.gw; it < NIT; it += c.ngw) {
        int r = it;
        if (r < I_IN) { transpose_item(a.in[5], DM, NCOL, (bf16*)(ws + WS_WIN), nullptr, scr, r, c.lane, RowId{0}); continue; } r -= I_IN;
        if (r < I_SQ) { transpose_item(a.in[9], DM, DM, (bf16*)(ws + WS_WA), nullptr, scr, r, c.lane, RowId{0}); continue; } r -= I_SQ;
        if (r < I_SQ) { transpose_item(a.in[10], DM, DM, (bf16*)(ws + WS_WB), nullptr, scr, r, c.lane, RowId{0}); continue; } r -= I_SQ;
        if (r < I_SQ) { transpose_item(a.in[11], DM, DM, (bf16*)(ws + WS_WMIX), nullptr, scr, r, c.lane, RowId{0}); continue; } r -= I_SQ;
        if (r < I_SQ) { transpose_item(a.in[13], DM, DM, (bf16*)(ws + WS_WQ), a.in[12], scr, r, c.lane, RowId{0}); continue; } r -= I_SQ;
        if (r < I_SQ) { transpose_item(a.in[14], DM, DM, (bf16*)(ws + WS_WK), nullptr, scr, r, c.lane, RowId{0}); continue; } r -= I_SQ;
        if (r < I_SQ) { transpose_item(a.in[15], DM, DM, (bf16*)(ws + WS_WV), nullptr, scr, r, c.lane, RowId{0}); continue; } r -= I_SQ;
        if (r < I_SQ) { transpose_item(a.in[16], DM, DM, (bf16*)(ws + WS_WO), nullptr, scr, r, c.lane, RowId{0}); continue; } r -= I_SQ;
        transpose_item(a.in[18], DM, NEXP, (bf16*)(ws + WS_WR), a.in[17], scr, r, c.lane, RowId{0});
    }
    { const size_t n8 = (size_t)NBATCH * MEMLEN * DM / 8; const float* mem = a.in[1]; bf16* mb = (bf16*)(ws + WS_MEMBF);
      for (size_t i = (size_t)c.gw * 64 + c.lane; i < n8; i += (size_t)c.ngw * 64) { const f32x4 v0 = *(const f32x4*)(mem + i * 8), v1 = *(const f32x4*)(mem + i * 8 + 4);
          v4u w; w.x = pk2(v0[0], v0[1]); w.y = pk2(v0[2], v0[3]); w.z = pk2(v1[0], v1[1]); w.w = pk2(v1[2], v1[3]); *(v4u*)(mb + i * 8) = w; } }
    if (c.gw == 0) {
        float* lb = (float*)(ws + WS_LB); const float* lbl = a.in[3];
        for (int k = c.lane; k < 1024; k += 64) lb[k] = 1.f / (1.f + expf(lbl[1024 + k] - lbl[k]));
    }
    if (c.gw == 1) {
        float* lut = (float*)(ws + WS_LUT); const float* t5 = a.in[2];
        for (int i = c.lane; i < 16 * 128; i += 64) { const int h = i >> 7, d = i & 127; int b = d;
            if (d >= 16) { b = 16 + (int)(logf((float)d * (1.f / 16.f)) / logf(8.f) * 16.f); b = b < 31 ? b : 31; }
            lut[i] = t5[b * 16 + h]; }
    }
}

__device__ __forceinline__ void phase_norm1(const Args& a, const Ctx& c, int hb) {
    const float* x = a.in[0] + (size_t)hb * HTOK * DM; bf16* xn = (bf16*)(a.ws + WS_TM);
    for (int m = c.gw; m < HTOK; m += c.ngw) rms_row_to_bf16(x + (size_t)m * DM, a.in[4], xn + (size_t)m * DM, c.lane);
}

constexpr int SWA_VB = 32 * 144;
constexpr int SWA_LUT_OFF = 8 * 2 * SWA_VB;
__device__ __forceinline__ void swa_unit(const bf16* proj, bf16* ob, int bl, int kvh, int tt, const LAS float* lut, LAS unsigned char* vbuf, const float* sinks, int lane) {
    const int l15 = lane & 15, g = lane >> 4, q4 = l15 >> 2, p4 = lane & 3;
    const int t0 = tt * 16; const size_t rowb = (size_t)bl * SEQ;
    bf16x8 qf[4][2];
#pragma unroll
    for (int gq = 0; gq < 4; ++gq)
#pragma unroll
        for (int ks = 0; ks < 2; ++ks) qf[gq][ks] = *(const bf16x8*)(proj + (rowb + t0 + l15) * NCOL + C_SQ + (kvh * 4 + gq) * 64 + ks * 32 + 8 * g);
    float mx[4], ls[4]; f32x4 o[4][4];
#pragma unroll
    for (int gq = 0; gq < 4; ++gq) { mx[gq] = sinks[kvh * 4 + gq]; ls[gq] = 1.f;
#pragma unroll
        for (int dt = 0; dt < 4; ++dt) o[gq][dt] = (f32x4){0.f, 0.f, 0.f, 0.f}; }
    for (int c = 0; c < 5; ++c) {
        const int kc = t0 - 144 + 32 * c;
        if (kc + 31 < 0) continue;
        LAS unsigned char* vb = vbuf + (c & 1) * SWA_VB;
#pragma unroll
        for (int i = 0; i < 4; ++i) { const int p = lane + 64 * i, key = p >> 3, d8 = p & 7; int kr = kc + key; kr = kr < 0 ? 0 : kr;
            const v4u vv = *(const v4u*)(proj + (rowb + kr) * NCOL + C_SV + kvh * 64 + d8 * 8);
            *(LAS v4u*)(vb + key * 144 + d8 * 16) = vv; }
        f32x4 s[4][2];
#pragma unroll
        for (int ksub = 0; ksub < 2; ++ksub) { int kr = kc + 16 * ksub + l15; kr = kr < 0 ? 0 : kr;
            const bf16* kp = proj + (rowb + kr) * NCOL + C_SK + kvh * 64 + 8 * g;
            const bf16x8 k0 = *(const bf16x8*)kp, k1 = *(const bf16x8*)(kp + 32);
#pragma unroll
            for (int gq = 0; gq < 4; ++gq) { f32x4 z = (f32x4){0.f, 0.f, 0.f, 0.f}; z = mfma16(k0, qf[gq][0], z); s[gq][ksub] = mfma16(k1, qf[gq][1], z); } }
        bf16x8 pf[4];
#pragma unroll
        for (int gq = 0; gq < 4; ++gq) { const int hq = kvh * 4 + gq; float cm = -1e30f;
#pragma unroll
            for (int ksub = 0; ksub < 2; ++ksub)
#pragma unroll
                for (int r = 0; r < 4; ++r) { const int key = kc + 16 * ksub + 4 * g + r, dist = t0 + l15 - key; const bool ok = (dist >= 0) && (dist < 128) && (key >= 0);
                    const int di = dist < 0 ? 0 : (dist > 127 ? 127 : dist);
                    float v = s[gq][ksub][r] * 0.125f + lut[hq * 128 + di]; v = ok ? v : -1e30f; s[gq][ksub][r] = v; cm = fmaxf(cm, v); }
            cm = fmaxf(cm, shx(cm, 16, lane)); cm = fmaxf(cm, shx(cm, 32, lane));
            const float mn = fmaxf(mx[gq], cm), alpha = __expf(mx[gq] - mn); mx[gq] = mn; float rs = 0.f;
#pragma unroll
            for (int ksub = 0; ksub < 2; ++ksub)
#pragma unroll
                for (int r = 0; r < 4; ++r) { const float p = __expf(s[gq][ksub][r] - mn); s[gq][ksub][r] = p; rs += p; }
            rs += shx(rs, 16, lane); rs += shx(rs, 32, lane);
            ls[gq] = ls[gq] * alpha + rs;
#pragma unroll
            for (int dt = 0; dt < 4; ++dt) o[gq][dt] = o[gq][dt] * alpha;
            pf[gq] = pack8(s[gq][0], s[gq][1]); }
        CFENCE();
#pragma unroll
        for (int dt = 0; dt < 4; ++dt) {
            const s16x4 lo = vtr(vb + (4 * g + q4) * 144 + (16 * dt + 4 * p4) * 2), hi = vtr(vb + (16 + 4 * g + q4) * 144 + (16 * dt + 4 * p4) * 2);
            const bf16x8 vf = cat8(lo, hi);
#pragma unroll
            for (int gq = 0; gq < 4; ++gq) o[gq][dt] = mfma16(vf, pf[gq], o[gq][dt]); }
        CFENCE();
    }
#pragma unroll
    for (int gq = 0; gq < 4; ++gq) { const float inv = 1.f / ls[gq];
#pragma unroll
        for (int dt = 0; dt < 4; ++dt) { const f32x4 v = o[gq][dt] * inv; v2u w; w.x = pk2(v[0], v[1]); w.y = pk2(v[2], v[3]);
            *(v2u*)(ob + (rowb + t0 + l15) * DM + (kvh * 4 + gq) * 64 + 16 * dt + 4 * g) = w; } }
}
__device__ __forceinline__ void phase_swa(const Args& a, const Ctx& c) {
    const bf16* proj = (const bf16*)(a.ws + WS_PROJ); bf16* ob = (bf16*)(a.ws + WS_OB);
    LAS float* lut = (LAS float*)(c.lds + SWA_LUT_OFF); const float* glut = (const float*)(a.ws + WS_LUT);
    for (int i = c.tid; i < 16 * 128; i += 512) lut[i] = glut[i];
    __syncthreads();
    LAS unsigned char* vbuf = c.lds + c.wave * 2 * SWA_VB;
    constexpr int NU = 8 * 4 * 256;
    for (int u = c.gw; u < NU; u += c.ngw) { const int tt = u & 255, kvh = (u >> 8) & 3, bl = u >> 10; swa_unit(proj, ob, bl, kvh, tt, lut, vbuf, a.in[8], c.lane); }
    __syncthreads();
}

constexpr int HG_LF = 0, HG_KP = 33792, HG_VT = 51200, HG_GT = 68608, HG_QP = 70656, HG_SSQ = 88064;
__device__ __forceinline__ void hg_scan(LAS unsigned char* lds, int tid, float (&loc)[16], float& pre, float& Gm, float& Gl) {
    const int ch = tid & 127, grp = tid >> 7;
    const LAS float* LF = (const LAS float*)(lds + HG_LF); LAS float* GT = (LAS float*)(lds + HG_GT);
    float run = 0.f;
#pragma unroll
    for (int i = 0; i < 16; ++i) { run += LF[(16 * grp + i) * 132 + ch]; loc[i] = run; }
    GT[grp * 128 + ch] = run;
    __syncthreads();
    const float g0 = GT[ch], g1 = GT[128 + ch], g2 = GT[256 + ch], g3 = GT[384 + ch];
    pre = (grp > 0 ? g0 : 0.f) + (grp > 1 ? g1 : 0.f) + (grp > 2 ? g2 : 0.f);
    Gm = g0 + g1; Gl = Gm + g2 + g3;
}
__device__ __forceinline__ void phase_hgA(const Args& a, const Ctx& c) {
    const bf16* proj = (const bf16*)(a.ws + WS_PROJ); bf16* US = (bf16*)((unsigned char*)a.out + OUT_US); float* D12 = (float*)(a.ws + WS_D12); const float* lb = (const float*)(a.ws + WS_LB);
    LAS unsigned char* lds = c.lds; const int tid = c.tid, lane = c.lane, w = c.wave;
    const int l15 = lane & 15, g = lane >> 4, q4 = l15 >> 2, p4 = lane & 3;
    constexpr int NU = 8 * 8 * 64;
    int u = blockIdx.x; if (u >= NU) return;
    v4u rf[2], rv[2];
#define HGA_LOAD(uu) do { const int cc_ = (uu) & 63, h_ = ((uu) >> 6) & 7, bl_ = (uu) >> 9; const size_t row0_ = (size_t)bl_ * SEQ + cc_ * 64; \
        _Pragma("unroll") for (int i = 0; i < 2; ++i) { const int p = tid + 512 * i, tok = p >> 4, c8 = p & 15; const bf16* rp = proj + (row0_ + tok) * NCOL + h_ * 128 + c8 * 8; \
            rf[i] = *(const v4u*)(rp + C_HF); rv[i] = *(const v4u*)(rp + C_HI); } } while (0)
    HGA_LOAD(u);
    for (;;) {
        const int h = (u >> 6) & 7;
#pragma unroll
        for (int i = 0; i < 2; ++i) { const int p = tid + 512 * i, tok = p >> 4, c8 = p & 15;
            const f32x4 lb0 = *(const f32x4*)(lb + h * 128 + c8 * 8), lb1 = *(const f32x4*)(lb + h * 128 + c8 * 8 + 4);
            const unsigned fw[4] = {rf[i].x, rf[i].y, rf[i].z, rf[i].w}; f32x4 o0, o1;
#pragma unroll
            for (int j = 0; j < 4; ++j) { const float lbl = j < 2 ? lb0[2 * j] : lb1[2 * j - 4], lbh = j < 2 ? lb0[2 * j + 1] : lb1[2 * j - 3];
                const float fl = lbl + (1.f - lbl) * sigm(bflo(fw[j])), fh = lbh + (1.f - lbh) * sigm(bfhi(fw[j]));
                if (j < 2) { o0[2 * j] = __logf(fl); o0[2 * j + 1] = __logf(fh); } else { o1[2 * j - 4] = __logf(fl); o1[2 * j - 3] = __logf(fh); } }
            LAS float* lfp = (LAS float*)(lds + HG_LF) + tok * 132 + c8 * 8; *(LAS f32x4*)lfp = o0; *(LAS f32x4*)(lfp + 4) = o1;
            *(LAS v4u*)(lds + HG_VT + tok * 272 + c8 * 16) = rv[i]; }
        const int ucur = u; const int un = u + gridDim.x; const bool has_next = un < NU;
        if (has_next) HGA_LOAD(un);
        __syncthreads();
        float loc[16], pre, Gm, Gl; hg_scan(lds, tid, loc, pre, Gm, Gl);
        { const int ch = tid & 127, grp = tid >> 7; LAS bf16* KP = (LAS bf16*)(lds + HG_KP);
#pragma unroll
          for (int i = 0; i < 16; ++i) { const float lfi = loc[i] - (i ? loc[i - 1] : 0.f), G = pre + loc[i];
              const float kp = (1.f - __expf(lfi)) * __expf(fminf(Gm - G, 80.f)); KP[(16 * grp + i) * 136 + ch] = (bf16)f2bf(kp); }
          if (grp == 0) { D12[(size_t)ucur * 256 + ch] = __expf(Gm); D12[(size_t)ucur * 256 + 128 + ch] = __expf(Gl - Gm); } }
        __syncthreads();
        { bf16x8 af[2];
#pragma unroll
          for (int ks = 0; ks < 2; ++ks) { const LAS unsigned char* bp = lds + HG_KP + (32 * ks + 8 * g + q4) * 272 + (16 * w + 4 * p4) * 2; af[ks] = cat8(vtr(bp), vtr(bp + 4 * 272)); }
#pragma unroll
          for (int vt = 0; vt < 8; ++vt) { f32x4 acc = (f32x4){0.f, 0.f, 0.f, 0.f};
#pragma unroll
              for (int ks = 0; ks < 2; ++ks) { const LAS unsigned char* bp = lds + HG_VT + (32 * ks + 8 * g + q4) * 272 + (16 * vt + 4 * p4) * 2; acc = mfma16(af[ks], cat8(vtr(bp), vtr(bp + 4 * 272)), acc); }
              v2u wv; wv.x = pk2(acc[0], acc[1]); wv.y = pk2(acc[2], acc[3]);
              *(v2u*)(US + ((size_t)ucur * 128 + 16 * vt + l15) * 128 + 16 * w + 4 * g) = wv; } }
        __syncthreads();
        if (!has_next) break;
        u = un;
    }
}
__device__ __forceinline__ void phase_hgB(const Args& a, const Ctx& c) {
    bf16* US = (bf16*)((unsigned char*)a.out + OUT_US); const float* D12 = (const float*)(a.ws + WS_D12);
    const int gt = c.gw * 64 + c.lane;
    for (int e = gt; e < 64 * 2048; e += c.ngw * 64) {
        const int bh = e >> 11, r = e & 2047, k8 = r & 15;
        float S[8];
#pragma unroll
        for (int j = 0; j < 8; ++j) S[j] = 0.f;
        for (int c0 = 0; c0 < 64; c0 += 4) {
            v4u uw[4]; f32x4 d1[4][2], d2[4][2];
#pragma unroll
            for (int cc = 0; cc < 4; ++cc) { const size_t un = (size_t)bh * 64 + c0 + cc;
                uw[cc] = *(const v4u*)(US + un * 16384 + (size_t)r * 8);
                d1[cc][0] = *(const f32x4*)(D12 + un * 256 + k8 * 8); d1[cc][1] = *(const f32x4*)(D12 + un * 256 + k8 * 8 + 4);
                d2[cc][0] = *(const f32x4*)(D12 + un * 256 + 128 + k8 * 8); d2[cc][1] = *(const f32x4*)(D12 + un * 256 + 128 + k8 * 8 + 4); }
#pragma unroll
            for (int cc = 0; cc < 4; ++cc) { const size_t un = (size_t)bh * 64 + c0 + cc;
                const unsigned ww[4] = {uw[cc].x, uw[cc].y, uw[cc].z, uw[cc].w}; float sp[8];
#pragma unroll
                for (int j = 0; j < 8; ++j) { const float d1v = d1[cc][j >> 2][j & 3], d2v = d2[cc][j >> 2][j & 3]; const float uv = (j & 1) ? bfhi(ww[j >> 1]) : bflo(ww[j >> 1]);
                    sp[j] = d1v * S[j]; S[j] = d2v * (sp[j] + uv); }
                v4u o; o.x = pk2(sp[0], sp[1]); o.y = pk2(sp[2], sp[3]); o.z = pk2(sp[4], sp[5]); o.w = pk2(sp[6], sp[7]);
                *(v4u*)(US + un * 16384 + (size_t)r * 8) = o; }
        }
    }
}
__device__ __forceinline__ void phase_hgC(const Args& a, const Ctx& c) {
    const bf16* proj = (const bf16*)(a.ws + WS_PROJ); const bf16* US = (const bf16*)((unsigned char*)a.out + OUT_US); bf16* oa = (bf16*)(a.ws + WS_OA);
    const float* lb = (const float*)(a.ws + WS_LB); const float* hgain = a.in[7];
    LAS unsigned char* lds = c.lds; const int tid = c.tid, lane = c.lane, w = c.wave;
    const int l15 = lane & 15, g = lane >> 4, q4 = l15 >> 2, p4 = lane & 3;
    constexpr int NU = 8 * 8 * 64;
    int u = blockIdx.x; if (u >= NU) return;
    v4u rq[2], rf[2], rv[2];
#define HGC_LOAD(uu) do { const int cc_ = (uu) & 63, h_ = ((uu) >> 6) & 7, bl_ = (uu) >> 9; const size_t row0_ = (size_t)bl_ * SEQ + cc_ * 64; \
        _Pragma("unroll") for (int i = 0; i < 2; ++i) { const int p = tid + 512 * i, tok = p >> 4, c8 = p & 15; const bf16* rp = proj + (row0_ + tok) * NCOL + h_ * 128 + c8 * 8; \
            rq[i] = *(const v4u*)(rp + C_HQ); rf[i] = *(const v4u*)(rp + C_HF); rv[i] = *(const v4u*)(rp + C_HI); } } while (0)
    HGC_LOAD(u);
    const f32x4 gn = *(const f32x4*)(hgain + 16 * w + 4 * g);
    for (;;) {
        const int cc = u & 63, h = (u >> 6) & 7, bl = u >> 9; const size_t row0 = (size_t)bl * SEQ + cc * 64;
#pragma unroll
        for (int i = 0; i < 2; ++i) { const int p = tid + 512 * i, tok = p >> 4, c8 = p & 15;
            const f32x4 lb0 = *(const f32x4*)(lb + h * 128 + c8 * 8), lb1 = *(const f32x4*)(lb + h * 128 + c8 * 8 + 4);
            const unsigned fw[4] = {rf[i].x, rf[i].y, rf[i].z, rf[i].w}; f32x4 o0, o1;
#pragma unroll
            for (int j = 0; j < 4; ++j) { const float lbl = j < 2 ? lb0[2 * j] : lb1[2 * j - 4], lbh = j < 2 ? lb0[2 * j + 1] : lb1[2 * j - 3];
                const float fl = lbl + (1.f - lbl) * sigm(bflo(fw[j])), fh = lbh + (1.f - lbh) * sigm(bfhi(fw[j]));
                if (j < 2) { o0[2 * j] = __logf(fl); o0[2 * j + 1] = __logf(fh); } else { o1[2 * j - 4] = __logf(fl); o1[2 * j - 3] = __logf(fh); } }
            LAS float* lfp = (LAS float*)(lds + HG_LF) + tok * 132 + c8 * 8; *(LAS f32x4*)lfp = o0; *(LAS f32x4*)(lfp + 4) = o1;
            *(LAS v4u*)(lds + HG_VT + tok * 272 + c8 * 16) = rv[i];
            *(LAS v4u*)(lds + HG_QP + tok * 272 + c8 * 16) = rq[i]; }
        const int ucur = u; const int un = u + gridDim.x; const bool has_next = un < NU;
        if (has_next) HGC_LOAD(un);
        bf16x8 sf[4];
#pragma unroll
        for (int ks = 0; ks < 4; ++ks) sf[ks] = *(const bf16x8*)(US + ((size_t)ucur * 128 + 16 * w + l15) * 128 + 32 * ks + 8 * g);
        __syncthreads();
        float loc[16], pre, Gm, Gl; hg_scan(lds, tid, loc, pre, Gm, Gl);
        { const int ch = tid & 127, grp = tid >> 7; LAS bf16* KP = (LAS bf16*)(lds + HG_KP); LAS bf16* QP = (LAS bf16*)(lds + HG_QP);
#pragma unroll
          for (int i = 0; i < 16; ++i) { const float lfi = loc[i] - (i ? loc[i - 1] : 0.f), G = pre + loc[i];
              const float kp = (1.f - __expf(lfi)) * __expf(fminf(Gm - G, 80.f)); KP[(16 * grp + i) * 136 + ch] = (bf16)f2bf(kp);
              const float qr = __builtin_bit_cast(float, (unsigned)QP[(16 * grp + i) * 136 + ch] << 16);
              const float qp = qr * sigm(qr) * __expf(fminf(G - Gm, 80.f)); QP[(16 * grp + i) * 136 + ch] = (bf16)f2bf(qp); } }
        __syncthreads();
        f32x4 o[4];
        {
            bf16x8 vf[2];
#pragma unroll
            for (int kk = 0; kk < 2; ++kk) { const LAS unsigned char* bp = lds + HG_VT + (32 * kk + 4 * g + q4) * 272 + (16 * w + 4 * p4) * 2; vf[kk] = cat8(vtr(bp), vtr(bp + 16 * 272)); }
#pragma unroll
            for (int tt = 0; tt < 4; ++tt) {
                bf16x8 qf[4];
#pragma unroll
                for (int ks = 0; ks < 4; ++ks) qf[ks] = *(const LAS bf16x8*)(lds + HG_QP + (16 * tt + l15) * 272 + (32 * ks + 8 * g) * 2);
                f32x4 acc = (f32x4){0.f, 0.f, 0.f, 0.f};
#pragma unroll
                for (int ks = 0; ks < 4; ++ks) acc = mfma16(sf[ks], qf[ks], acc);
                f32x4 at[4];
#pragma unroll
                for (int st = 0; st < 4; ++st) { at[st] = (f32x4){0.f, 0.f, 0.f, 0.f};
                    if (st <= tt) {
#pragma unroll
                        for (int ks = 0; ks < 4; ++ks) { const bf16x8 kf = *(const LAS bf16x8*)(lds + HG_KP + (16 * st + l15) * 272 + (32 * ks + 8 * g) * 2); at[st] = mfma16(kf, qf[ks], at[st]); }
                        if (st == tt) {
#pragma unroll
                            for (int r = 0; r < 4; ++r) at[st][r] = (4 * g + r <= l15) ? at[st][r] : 0.f; } } }
                acc = mfma16(vf[0], pack8(at[0], at[1]), acc);
                if (tt >= 2) acc = mfma16(vf[1], pack8(at[2], at[3]), acc);
                o[tt] = acc; }
        }
        { LAS float* SSQ = (LAS float*)(lds + HG_SSQ);
#pragma unroll
          for (int tt = 0; tt < 4; ++tt) { float s = (o[tt][0] * o[tt][0] + o[tt][1] * o[tt][1]) + (o[tt][2] * o[tt][2] + o[tt][3] * o[tt][3]);
              s += shx(s, 16, lane); s += shx(s, 32, lane); if (g == 0) SSQ[w * 64 + 16 * tt + l15] = s; }
          __syncthreads();
#pragma unroll
          for (int tt = 0; tt < 4; ++tt) { float s = 0.f;
#pragma unroll
              for (int ww = 0; ww < 8; ++ww) s += SSQ[ww * 64 + 16 * tt + l15];
              const float rstd = rsqrtf(s * (1.f / 128.f) + RMS_EPS);
              const size_t row = row0 + 16 * tt + l15;
              const v2u gw = *(const v2u*)(proj + row * NCOL + C_HG + h * 128 + 16 * w + 4 * g);
              const float g0 = bflo(gw.x), g1 = bfhi(gw.x), g2 = bflo(gw.y), g3 = bfhi(gw.y);
              const float r0 = o[tt][0] * rstd * gn[0] * (g0 * sigm(g0)), r1 = o[tt][1] * rstd * gn[1] * (g1 * sigm(g1));
              const float r2 = o[tt][2] * rstd * gn[2] * (g2 * sigm(g2)), r3 = o[tt][3] * rstd * gn[3] * (g3 * sigm(g3));
              v2u wv; wv.x = pk2(r0, r1); wv.y = pk2(r2, r3);
              *(v2u*)(oa + row * DM + h * 128 + 16 * w + 4 * g) = wv; } }
        if (!has_next) break;
        u = un;
    }
    __syncthreads();
}

typedef float f32x16 __attribute__((ext_vector_type(16)));
constexpr int XA_KROW = 528, XA_VROW = 72, XA_KB = 32 * XA_KROW, XA_VB = 256 * XA_VROW, XA_STAGE = XA_KB + XA_VB;
__device__ __forceinline__ void phase_xa(const Args& a, const Ctx& c) {
    const bf16* qg = (const bf16*)(a.ws + WS_Q); bf16* og = (bf16*)(a.ws + WS_O); const bf16* kx = (const bf16*)(a.ws + WS_KX); const bf16* vxt = (const bf16*)(a.ws + WS_VXT);
    LAS unsigned char* lds = c.lds; const int tid = c.tid, lane = c.lane, w = c.wave;
    const int l31 = lane & 31, hh = lane >> 5, qt = w & 3, dh = w >> 2;
    constexpr int NU = NBATCH * 4 * (SEQ / 128);
    int u = blockIdx.x; if (u >= NU) return;
    v4u rk[2], rv[2];
#define XA_LOAD(uu, kc) do { const int b_ = (uu) >> 7, h_ = ((uu) >> 5) & 3; \
        _Pragma("unroll") for (int i = 0; i < 2; ++i) { const int p = tid + 512 * i; \
            rk[i] = *(const v4u*)(kx + (size_t)(b_ * MEMLEN + (kc) * 32 + (p >> 5)) * DM + h_ * 256 + (p & 31) * 8); \
            rv[i] = *(const v4u*)(vxt + (size_t)(h_ * 256 + (p >> 2)) * (NBATCH * MEMLEN) + b_ * MEMLEN + (kc) * 32 + (p & 3) * 8); } } while (0)
#define XA_STORE(buf) do { LAS unsigned char* sb = lds + (buf) * XA_STAGE; \
        _Pragma("unroll") for (int i = 0; i < 2; ++i) { const int p = tid + 512 * i; \
            *(LAS v4u*)(sb + (p >> 5) * XA_KROW + (p & 31) * 16) = rk[i]; \
            LAS v2u* vp = (LAS v2u*)(sb + XA_KB + (p >> 2) * XA_VROW + (p & 3) * 16); v2u lo; lo.x = rv[i].x; lo.y = rv[i].y; v2u hi; hi.x = rv[i].z; hi.y = rv[i].w; vp[0] = lo; vp[1] = hi; } } while (0)
    XA_LOAD(u, 0); XA_STORE(0);
    int par = 0;
    for (;;) {
        const int b = u >> 7, h = (u >> 5) & 3, qb = u & 31;
        const size_t row0 = (size_t)b * SEQ + qb * 128 + qt * 32;
        bf16x8 qf[16];
#pragma unroll
        for (int ks = 0; ks < 16; ++ks) qf[ks] = *(const bf16x8*)(qg + (row0 + l31) * DM + h * 256 + 16 * ks + 8 * hh);
        float mx = -1e30f, ls = 0.f; f32x16 o[4];
#pragma unroll
        for (int dt = 0; dt < 4; ++dt)
#pragma unroll
            for (int r = 0; r < 16; ++r) o[dt][r] = 0.f;
        const int un = u + gridDim.x; const bool has_next = un < NU;
        for (int kc = 0; kc < 8; ++kc) {
            __syncthreads();
            const bool more = (kc < 7) || has_next;
            if (more) { if (kc < 7) XA_LOAD(u, kc + 1); else XA_LOAD(un, 0); }
            const LAS unsigned char* kb = lds + par * XA_STAGE; const LAS unsigned char* vb = kb + XA_KB;
            f32x16 s;
#pragma unroll
            for (int r = 0; r < 16; ++r) s[r] = 0.f;
#pragma unroll
            for (int ks = 0; ks < 16; ++ks) { const bf16x8 kf = *(const LAS bf16x8*)(kb + l31 * XA_KROW + (16 * ks + 8 * hh) * 2); s = __builtin_amdgcn_mfma_f32_32x32x16_bf16(kf, qf[ks], s, 0, 0, 0); }
            float cm = -1e30f;
#pragma unroll
            for (int r = 0; r < 16; ++r) { s[r] *= 0.0625f; cm = fmaxf(cm, s[r]); }
            cm = fmaxf(cm, shx(cm, 32, lane));
            const float mn = fmaxf(mx, cm), alpha = __expf(mx - mn); mx = mn; float rs = 0.f;
#pragma unroll
            for (int r = 0; r < 16; ++r) { s[r] = __expf(s[r] - mn); rs += s[r]; }
            rs += shx(rs, 32, lane); ls = ls * alpha + rs;
#pragma unroll
            for (int dt = 0; dt < 4; ++dt)
#pragma unroll
                for (int r = 0; r < 16; ++r) o[dt][r] *= alpha;
            bf16x8 pf[2];
#pragma unroll
            for (int st = 0; st < 2; ++st) { v4u pw; pw.x = pk2(s[8 * st], s[8 * st + 1]); pw.y = pk2(s[8 * st + 2], s[8 * st + 3]); pw.z = pk2(s[8 * st + 4], s[8 * st + 5]); pw.w = pk2(s[8 * st + 6], s[8 * st + 7]); pf[st] = __builtin_bit_cast(bf16x8, pw); }
#pragma unroll
            for (int dt = 0; dt < 4; ++dt) { const LAS unsigned char* vrow = vb + (128 * dh + 32 * dt + l31) * XA_VROW + 8 * hh;
#pragma unroll
                for (int st = 0; st < 2; ++st) { const s16x4 lo = *(const LAS s16x4*)(vrow + 32 * st), hi = *(const LAS s16x4*)(vrow + 32 * st + 16);
                    o[dt] = __builtin_amdgcn_mfma_f32_32x32x16_bf16(cat8(lo, hi), pf[st], o[dt], 0, 0, 0); } }
            if (more) XA_STORE(par ^ 1);
            par ^= 1;
        }
        const float inv = 1.f / ls;
#pragma unroll
        for (int dt = 0; dt < 4; ++dt)
#pragma unroll
            for (int rg = 0; rg < 4; ++rg) { v2u wv; wv.x = pk2(o[dt][4 * rg] * inv, o[dt][4 * rg + 1] * inv); wv.y = pk2(o[dt][4 * rg + 2] * inv, o[dt][4 * rg + 3] * inv);
                *(v2u*)(og + (row0 + l31) * DM + h * 256 + 128 * dh + 32 * dt + 8 * rg + 4 * hh) = wv; }
        if (!has_next) break;
        u = un;
    }
    __syncthreads();
#undef XA_LOAD
#undef XA_STORE
}

__device__ __forceinline__ void phase_expert_weights(const Args& a, const Ctx& c) {
    LAS float* scr = (LAS float*)(c.lds + c.wave * 16384);
    constexpr int I_GU = 16 * 64, I_D = 16 * 32;
    constexpr int NGU = NEXP * I_GU, NIT = NEXP * (I_GU + I_D);
#define EW_GEO(it, W_, N_, k0_, n0_) const bool gu_##W_ = (it) < NGU; const int r_##W_ = gu_##W_ ? (it) : (it) - NGU; const int e_##W_ = gu_##W_ ? r_##W_ / I_GU : r_##W_ / I_D; \
        const int q_##W_ = gu_##W_ ? r_##W_ % I_GU : r_##W_ % I_D; const int N_ = gu_##W_ ? 2048 : 1024; const int nblk_##W_ = N_ / 32; const int k0_ = 64 * (q_##W_ / nblk_##W_), n0_ = 32 * (q_##W_ % nblk_##W_); \
        const float* W_ = gu_##W_ ? a.in[20] + (size_t)e_##W_ * DM * 2048 : a.in[22] + (size_t)e_##W_ * DM * DM
    int it = c.gw; if (it >= NIT) { __syncthreads(); return; }
    TItem t;
    { EW_GEO(it, W0, N0, k00, n00); titem_load(t, W0, N0, gu_W0 ? a.in[17] : nullptr, k00, n00, c.lane); }
    for (;;) {
        EW_GEO(it, Wc, Nc, k0c, n0c);
        titem_to_lds(t, scr, c.lane);
        const int itn = it + c.ngw; const bool more = itn < NIT;
        if (more) { EW_GEO(itn, Wn, Nn, k0n, n0n); titem_load(t, Wn, Nn, gu_Wn ? a.in[17] : nullptr, k0n, n0n, c.lane); }
        if (gu_Wc) titem_out(DM, (bf16*)(a.ws + WS_WGU), scr, k0c, n0c, c.lane, RowGU{e_Wc});
        else titem_out(DM, (bf16*)(a.ws + WS_WD), scr, k0c, n0c, c.lane, RowId{e_Wc * 1024});
        if (!more) break;
        it = itn;
    }
#undef EW_GEO
    __syncthreads();
}
__device__ __forceinline__ void phase_router(const Args& a, const Ctx& c) {
    const bf16* xb = (const bf16*)(a.ws + WS_XBF); const bf16* wr = (const bf16*)(a.ws + WS_WR); const float* ssq2 = (const float*)(a.ws + WS_SSQ2); const float* br = a.in[19];
    int* tope = (int*)(a.ws + WS_TOPE); float* topg = (float*)(a.ws + WS_TOPG); int* topr = (int*)(a.ws + WS_TOPR); unsigned* gcnt = (unsigned*)(a.ws + WS_GCNT);
    LAS unsigned char* lds = c.lds; const int lane = c.lane, w = c.wave, l15 = lane & 15, g = lane >> 4;
    LAS float* LG = (LAS float*)(lds + w * 4096);
    LAS int* LE = (LAS int*)(lds + w * 4096 + 2560); LAS float* LGT = (LAS float*)(lds + w * 4096 + 2816);
    int* rtok = (int*)(a.ws + WS_RTOK); float* rgate = (float*)(a.ws + WS_RGATE2); float* rrstd = (float*)(a.ws + WS_RRSTD2);
    LAS unsigned* CNT = (LAS unsigned*)(lds + 32768); LAS unsigned* BASE = CNT + 32;
    for (int it = blockIdx.x; it < NTOK / 128; it += gridDim.x) {
        const int tok0 = it * 128 + w * 16; const int half = tok0 >= HTOK;
        if (c.tid < 32) CNT[c.tid] = 0u;
        f32x4 acc[2] = {(f32x4){0.f, 0.f, 0.f, 0.f}, (f32x4){0.f, 0.f, 0.f, 0.f}};
        const bf16* ap = xb + (size_t)(tok0 + l15) * DM + 8 * g;
#pragma unroll 8
        for (int ks = 0; ks < 32; ++ks) { const bf16x8 af = *(const bf16x8*)(ap + 32 * ks);
#pragma unroll
            for (int nt = 0; nt < 2; ++nt) { const bf16x8 bf = *(const bf16x8*)(wr + (size_t)(16 * nt + l15) * DM + 32 * ks + 8 * g); acc[nt] = mfma16(af, bf, acc[nt]); } }
#pragma unroll
        for (int nt = 0; nt < 2; ++nt)
#pragma unroll
            for (int r = 0; r < 4; ++r) { const int t = 4 * g + r; const float rs = rstd16(ssq2, (size_t)(tok0 + t)); LG[t * 33 + 16 * nt + l15] = acc[nt][r] * rs + br[16 * nt + l15]; }
        LDS_WAIT();
        if (lane < 16) { float v[32];
#pragma unroll
            for (int e = 0; e < 32; ++e) v[e] = LG[lane * 33 + e];
            int se[4]; float sv[4];
#pragma unroll
            for (int k = 0; k < 4; ++k) { float best = -3e38f; int bi = 0;
#pragma unroll
                for (int e = 0; e < 32; ++e) { const bool bt = v[e] > best; best = bt ? v[e] : best; bi = bt ? e : bi; }
                se[k] = bi; sv[k] = best;
#pragma unroll
                for (int e = 0; e < 32; ++e) v[e] = (e == bi) ? -3e38f : v[e]; }
            const float e1 = __expf(sv[1] - sv[0]), e2 = __expf(sv[2] - sv[0]), e3 = __expf(sv[3] - sv[0]); const float inv = 1.f / (1.f + e1 + e2 + e3);
            const int tok = tok0 + lane;
            *(int4*)(tope + (size_t)tok * 4) = make_int4(se[0], se[1], se[2], se[3]);
            *(float4*)(topg + (size_t)tok * 4) = make_float4(inv, e1 * inv, e2 * inv, e3 * inv);
#pragma unroll
            for (int k = 0; k < 4; ++k) LE[lane * 4 + k] = se[k];
            LGT[lane * 4 + 0] = inv; LGT[lane * 4 + 1] = e1 * inv; LGT[lane * 4 + 2] = e2 * inv; LGT[lane * 4 + 3] = e3 * inv; }
        __syncthreads();
        const int myE = LE[lane];
        const unsigned lr = atomicAdd((unsigned*)&CNT[myE], 1u);
        __syncthreads();
        if (c.tid < 32) { const unsigned n = CNT[c.tid]; BASE[c.tid] = n ? atomicAdd(gcnt + (half * 32 + c.tid) * 16, n) : 0u; }
        __syncthreads();
        { const int rank = (int)(BASE[myE] + lr), tok = tok0 + (lane >> 2); topr[(size_t)tok * 4 + (lane & 3)] = rank;
          const size_t ri = (size_t)(half * 32 + myE) * HTOK + rank; rtok[ri] = tok; rgate[ri] = LGT[lane]; rrstd[ri] = rstd16(ssq2, (size_t)tok); }
        __syncthreads();
    }
}
__device__ __forceinline__ void add16(f32x4 (&v)[4], const v4u y0, const v4u y1) {
    v[0][0] += bflo(y0.x); v[0][1] += bfhi(y0.x); v[0][2] += bflo(y0.y); v[0][3] += bfhi(y0.y); v[1][0] += bflo(y0.z); v[1][1] += bfhi(y0.z); v[1][2] += bflo(y0.w); v[1][3] += bfhi(y0.w);
    v[2][0] += bflo(y1.x); v[2][1] += bfhi(y1.x); v[2][2] += bflo(y1.y); v[2][3] += bfhi(y1.y); v[3][0] += bflo(y1.z); v[3][1] += bfhi(y1.z); v[3][2] += bflo(y1.w); v[3][3] += bfhi(y1.w);
}
__device__ __forceinline__ void phase_combine(const Args& a, const Ctx& c, int hb) {
    const bf16* y = (const bf16*)(a.ws + WS_Y); const bf16* xb = (const bf16*)(a.ws + WS_XBF); const int* tope = (const int*)(a.ws + WS_TOPE); const int* topr = (const int*)(a.ws + WS_TOPR); const float* gf = a.in[24];
    moe_tables(a.ws, hb, c.lds, c.tid);
    const LAS unsigned* tab = (const LAS unsigned*)(c.lds + MOE_TAB_OFF);
    for (int i = c.gw; i < HTOK; i += c.ngw) { const int tok = hb * HTOK + i;
        const int4 ee = *(const int4*)(tope + (size_t)tok * 4), rr = *(const int4*)(topr + (size_t)tok * 4);
        const int ps[4] = {(int)tab[32 + ee.x] * 256 + rr.x, (int)tab[32 + ee.y] * 256 + rr.y, (int)tab[32 + ee.z] * 256 + rr.z, (int)tab[32 + ee.w] * 256 + rr.w};
        f32x4 v[4];
#pragma unroll
        for (int j = 0; j < 4; ++j) v[j] = (f32x4){0.f, 0.f, 0.f, 0.f};
        { const v4u* xp = (const v4u*)(xb + (size_t)tok * DM + c.lane * 16); add16(v, xp[0], xp[1]); }
#pragma unroll
        for (int k = 0; k < 4; ++k) { const v4u* yp = (const v4u*)(y + (size_t)ps[k] * DM + c.lane * 16); add16(v, yp[0], yp[1]); }
        float s = 0.f;
#pragma unroll
        for (int j = 0; j < 4; ++j) s += (v[j][0] * v[j][0] + v[j][1] * v[j][1]) + (v[j][2] * v[j][2] + v[j][3] * v[j][3]);
        const float rstd = rsqrtf(wave_sum(s, c.lane) * (1.f / DM) + RMS_EPS);
        float* xr = a.out + (size_t)tok * DM + c.lane * 16;
#pragma unroll
        for (int j = 0; j < 4; ++j) { const f32x4 gg = *(const f32x4*)(gf + c.lane * 16 + 4 * j); *(f32x4*)(xr + 4 * j) = v[j] * rstd * gg; } }
}

#ifndef MK_PER_PHASE_LAUNCH
#define MK_PER_PHASE_LAUNCH 0
#endif
constexpr int NPHASES = 29;
#ifndef MK_OFF
#define MK_OFF 0u
#endif
#define MKP(k) (((MK_OFF >> (k)) & 1u) == 0u)
#define GSCHED PG8_ALIGN, PG8_SP2
typedef const __attribute__((address_space(4))) Args* KArgP;
#if defined(__HIP_DEVICE_COMPILE__)
__device__ __forceinline__ Args ldargs() { KArgP kp = (KArgP)__builtin_amdgcn_kernarg_segment_ptr(); asm volatile("" : "+s"(kp)); Args r;
#pragma unroll
    for (int i = 0; i < 25; ++i) r.in[i] = kp->in[i];
    r.out = kp->out; r.ws = kp->ws; r.ph_lo = kp->ph_lo; r.ph_hi = kp->ph_hi; return r; }
#else
__device__ __forceinline__ Args ldargs() { return Args{}; }
#endif
__global__ void __launch_bounds__(512, 2) mk_fwd(Args a_) {
    extern __shared__ __attribute__((aligned(16))) unsigned char lds_raw[];
    Ctx c; c.lds = (LAS unsigned char*)lds_raw; c.tid = threadIdx.x; c.lane = c.tid & 63; c.wave = __builtin_amdgcn_readfirstlane(c.tid >> 6); const int wv = c.wave;
    c.G = gridDim.x; c.gw = blockIdx.x * 8 + c.wave; c.ngw = c.G * 8;
    volatile LAS unsigned* MISC = (volatile LAS unsigned*)(c.lds + MISC_OFF);
    for (int u = c.tid; u < (LDS_BYTES - RING_BYTES) / 4; u += 512) ((LAS unsigned*)(c.lds + RING_BYTES))[u] = 0u;
    __syncthreads();
    const int ph_lo = a_.ph_lo, ph_hi = a_.ph_hi;
    const bool fused = (ph_hi - ph_lo) > 1;
    unsigned* barw = (unsigned*)a_.ws + CW_BAR;
    XcdBarrier bar; bar.bar = barw; bar.x = 0; bar.st = MISC + 8; bar.t0 = wv;
    if (fused) bar = xcd_barrier_post(barw, MISC + 8, wv);
    int pc = 0;
#define PH_ON (pc >= ph_lo && pc < ph_hi)
#define PH_END do { if (PH_ON && pc + 1 < ph_hi) xcd_barrier(bar); ++pc; OPQ(c); } while (0)
    LAS unsigned char* ring = c.lds;
#define OPQ(cc) do { { unsigned z_ = 0u; asm volatile("" : "+v"(z_)); cc.lane = (int)__builtin_amdgcn_mbcnt_hi(~0u, __builtin_amdgcn_mbcnt_lo(~0u, z_)); } cc.wave = wv; cc.tid = wv * 64 + cc.lane; { int gw_ = (int)blockIdx.x * 8 + wv; asm volatile("" : "+s"(gw_)); cc.gw = gw_; } } while (0)

    if (MKP(0) && PH_ON) { const Args a = ldargs(); unsigned char* ws = a.ws; (void)ws;  phase_prologue(a, c); __syncthreads(); }
    PH_END;
#pragma unroll
    for (int hb = 0; hb < 2; ++hb) {
        const size_t toff = (size_t)hb * HTOK;
        if (MKP(1) && PH_ON) { const Args a = ldargs(); phase_norm1(a, c, hb); }
        PH_END;
        if (MKP(2) && PH_ON) { const Args a = ldargs(); unsigned char* ws = a.ws; (void)ws;  pg8::Gemm g{(const bf16*)(ws + WS_TM), (const bf16*)(ws + WS_WIN), HTOK, NCOL, DM}; pg8::StaticOrder S; S.init(HTOK, NCOL, c.G, (int)blockIdx.x);
            EpiStore E{(bf16*)(ws + WS_PROJ), NCOL, nullptr}; pg8::gemm_phase<EpiStore, pg8::StaticOrder, GSCHED>(ring, g, S, E, wv); }
        PH_END;
        if (MKP(3) && PH_ON) { const Args a = ldargs(); unsigned char* ws = a.ws; (void)ws;  phase_hgA(a, c); }
        PH_END;
        if (MKP(17) && PH_ON) { const Args a = ldargs(); phase_swa(a, c); }
        PH_END;
        if (MKP(4) && PH_ON) { const Args a = ldargs(); phase_hgB(a, c); }
        PH_END;
        if (MKP(5) && PH_ON) { const Args a = ldargs(); phase_hgC(a, c); }
        PH_END;
        if (MKP(6) && PH_ON) { const Args a = ldargs(); unsigned char* ws = a.ws; (void)ws;  pg8::Gemm g{(const bf16*)(ws + WS_OA), (const bf16*)(ws + WS_WA), HTOK, DM, DM}; pg8::StaticOrder S; S.init(HTOK, DM, c.G, (int)blockIdx.x);
            EpiGate<false> E{(bf16*)(ws + WS_TM), (const bf16*)(ws + WS_PROJ), C_GA, a.in[6]}; pg8::gemm_phase<EpiGate<false>, pg8::StaticOrder, GSCHED>(ring, g, S, E, wv); }
        PH_END;
        if (MKP(7) && PH_ON) { const Args a = ldargs(); unsigned char* ws = a.ws; (void)ws;  pg8::Gemm g{(const bf16*)(ws + WS_OB), (const bf16*)(ws + WS_WB), HTOK, DM, DM}; pg8::StaticOrder S; S.init(HTOK, DM, c.G, (int)blockIdx.x);
            EpiGate<true> E{(bf16*)(ws + WS_TM), (const bf16*)(ws + WS_PROJ), C_GB, a.in[6] + DM}; pg8::gemm_phase<EpiGate<true>, pg8::StaticOrder, GSCHED>(ring, g, S, E, wv); }
        PH_END;
        if (MKP(8) && PH_ON) { const Args a = ldargs(); unsigned char* ws = a.ws; (void)ws;  pg8::Gemm g{(const bf16*)(ws + WS_TM), (const bf16*)(ws + WS_WMIX), HTOK, DM, DM}; pg8::StaticOrder S; S.init(HTOK, DM, c.G, (int)blockIdx.x);
            EpiResid<false> E{a.in[0] + toff * DM, (bf16*)(ws + WS_XBF) + toff * DM, (float*)(ws + WS_SSQ1) + toff * 16}; pg8::gemm_phase<EpiResid<false>, pg8::StaticOrder, GSCHED>(ring, g, S, E, wv); }
        PH_END;
    }
    if (MKP(9) && PH_ON) { const Args a = ldargs(); unsigned char* ws = a.ws; (void)ws;
        phase_expert_weights(a, c);
        { pg8::Gemm g{(const bf16*)(ws + WS_MEMBF), (const bf16*)(ws + WS_WK), NBATCH * MEMLEN, DM, DM}; pg8::StaticOrder S; S.init(NBATCH * MEMLEN, DM, c.G, (int)blockIdx.x);
          EpiStore E{(bf16*)(ws + WS_KX), DM, nullptr}; pg8::gemm_phase<EpiStore, pg8::StaticOrder, GSCHED>(ring, g, S, E, wv); }
        { pg8::Gemm g{(const bf16*)(ws + WS_WV), (const bf16*)(ws + WS_MEMBF), DM, NBATCH * MEMLEN, DM}; pg8::StaticOrder S; S.init(DM, NBATCH * MEMLEN, c.G, (int)((blockIdx.x + 64) % c.G));
          EpiStore E{(bf16*)(ws + WS_VXT), NBATCH * MEMLEN, nullptr}; pg8::gemm_phase<EpiStore, pg8::StaticOrder, GSCHED>(ring, g, S, E, wv); }
        { pg8::Gemm g{(const bf16*)(ws + WS_XBF), (const bf16*)(ws + WS_WQ), NTOK, DM, DM}; pg8::StaticOrder S; S.init(NTOK, DM, c.G, (int)blockIdx.x);
          EpiStore E{(bf16*)(ws + WS_Q), DM, (const float*)(ws + WS_SSQ1)}; pg8::gemm_phase<EpiStore, pg8::StaticOrder, GSCHED>(ring, g, S, E, wv); }
    }
    PH_END;
    if (MKP(10) && PH_ON) { const Args a = ldargs(); phase_xa(a, c); }
    PH_END;
    if (MKP(11) && PH_ON) { const Args a = ldargs(); unsigned char* ws = a.ws; (void)ws;  pg8::Gemm g{(const bf16*)(ws + WS_O), (const bf16*)(ws + WS_WO), NTOK, DM, DM}; pg8::StaticOrder S; S.init(NTOK, DM, c.G, (int)blockIdx.x);
        EpiResid<true> E{nullptr, (bf16*)(ws + WS_XBF), (float*)(ws + WS_SSQ2)}; pg8::gemm_phase<EpiResid<true>, pg8::StaticOrder, GSCHED>(ring, g, S, E, wv); }
    PH_END;
    if (MKP(12) && PH_ON) { const Args a = ldargs(); phase_router(a, c); }
    PH_END;
#pragma unroll
    for (int hb = 0; hb < 2; ++hb) {
        if (MKP(14) && PH_ON) { const Args a = ldargs(); unsigned char* ws = a.ws; moe_tables(ws, hb, c.lds, c.tid);
            const LAS unsigned* tab = (const LAS unsigned*)(c.lds + MOE_TAB_OFF); const int nb = (int)__builtin_amdgcn_readfirstlane(tab[64]);
            pg8::Gemm g{(const bf16*)(ws + WS_XBF), (const bf16*)(ws + WS_WGU), NTOK, NEXP * 2048, DM}; GroupedOrder S{nb * 8, 8, c.G, (int)blockIdx.x, hb, tab, (const int*)(ws + WS_RTOK)};
            EpiSwiglu E{(bf16*)(ws + WS_ACT), a.in[21], (const float*)(ws + WS_RRSTD2)}; pg8::gemm_phase_gather<EpiSwiglu, GroupedOrder>(ring, g, S, E, wv); }
        PH_END;
        if (MKP(15) && PH_ON) { const Args a = ldargs(); unsigned char* ws = a.ws; moe_tables(ws, hb, c.lds, c.tid);
            const LAS unsigned* tab = (const LAS unsigned*)(c.lds + MOE_TAB_OFF); const int nb = (int)__builtin_amdgcn_readfirstlane(tab[64]);
            pg8::Gemm g{(const bf16*)(ws + WS_ACT), (const bf16*)(ws + WS_WD), CAPH, NEXP * 1024, DM}; GroupedOrder S{nb * 4, 4, c.G, (int)blockIdx.x, hb, tab, (const int*)(ws + WS_RTOK)};
            EpiDown E{(bf16*)(ws + WS_Y), a.in[23], (const float*)(ws + WS_RGATE2)}; pg8::gemm_phase<EpiDown, GroupedOrder, GSCHED>(ring, g, S, E, wv); }
        PH_END;
        if (MKP(16) && PH_ON) { const Args a = ldargs(); phase_combine(a, c, hb); }
        PH_END;
    }
#undef PH_ON
#undef PH_END
}

#if defined(MK_DBG_STOP)
#ifndef MK_DBG_SRC_OUT
#define MK_DBG_SRC_OUT 0
#endif
#ifndef MK_DBG_F32
#define MK_DBG_F32 0
#endif
__global__ void dbg_dump(const unsigned short* src, float* out, size_t n, size_t N) {
    for (size_t i = (size_t)blockIdx.x * blockDim.x + threadIdx.x; i < N; i += (size_t)gridDim.x * blockDim.x) {
        if (i < n) { float v = MK_DBG_F32 ? ((const float*)src)[i] : __builtin_bit_cast(float, (unsigned)src[i] << 16); if (!(fabsf(v) < 1e30f)) v = 12345.f; out[i] = v; }
        else if (!MK_DBG_SRC_OUT) out[i] = 0.f;
    }
}
__global__ void dbg_zero_upper(float* out, size_t n0, size_t N) { for (size_t i = n0 + (size_t)blockIdx.x * blockDim.x + threadIdx.x; i < N; i += (size_t)gridDim.x * blockDim.x) out[i] = 0.f; }
#endif
extern "C" void kernel_launch(void* const* d_in, const int* in_sizes, int n_in, void* d_out, int out_size, void* d_ws, size_t ws_size, hipStream_t stream) {
    static int grid = 0;
    if (grid == 0) {
        if (n_in != 25 || out_size != NTOK * DM || ws_size < WS_END) { fprintf(stderr, "kernel_launch: unexpected problem shape (n_in %d, out %d, ws %zu); nothing launched\n", n_in, out_size, ws_size); grid = -1; return; }
        int dev = 0, cus = 0, per_cu = 0;
        if (hipGetDevice(&dev) != hipSuccess || hipDeviceGetAttribute(&cus, hipDeviceAttributeMultiprocessorCount, dev) != hipSuccess) { grid = -1; return; }
        if (hipFuncSetAttribute((const void*)mk_fwd, hipFuncAttributeMaxDynamicSharedMemorySize, LDS_BYTES) != hipSuccess) { fprintf(stderr, "kernel_launch: hipFuncSetAttribute failed\n"); grid = -1; return; }
        if (hipOccupancyMaxActiveBlocksPerMultiprocessor(&per_cu, (const void*)mk_fwd, 512, LDS_BYTES) != hipSuccess || per_cu < 1) { fprintf(stderr, "kernel_launch: occupancy query reports %d blocks per CU\n", per_cu); }
        (void)hipGetLastError();
        grid = cus;
    }
    if (grid < 0) return;
    (void)in_sizes;
    hipMemsetAsync(d_ws, 0, WS_ZERO_BYTES, stream);
    Args a{};
    for (int i = 0; i < 25; ++i) a.in[i] = (const float*)d_in[i];
    a.out = (float*)d_out; a.ws = (unsigned char*)d_ws;
#if defined(MK_DBG_STOP)
    for (int p = 0; p < MK_DBG_STOP; ++p) { a.ph_lo = p; a.ph_hi = p + 1; hipLaunchKernelGGL(mk_fwd, dim3(grid), dim3(512), LDS_BYTES, stream, a); }
    hipLaunchKernelGGL(dbg_dump, dim3(2048), dim3(256), 0, stream, (const unsigned short*)((const unsigned char*)(MK_DBG_SRC_OUT ? d_out : d_ws) + (size_t)MK_DBG_OFF_MIB * MiB), (float*)d_out, (size_t)MK_DBG_MIB * MiB / (MK_DBG_F32 ? 4 : 2), (size_t)NTOK * DM);
    if (MK_DBG_SRC_OUT) hipLaunchKernelGGL(dbg_zero_upper, dim3(2048), dim3(256), 0, stream, (float*)d_out, (size_t)MK_DBG_MIB * MiB / 2, (size_t)NTOK * DM);
#elif MK_PER_PHASE_LAUNCH
    for (int p = 0; p < NPHASES; ++p) { a.ph_lo = p; a.ph_hi = p + 1; hipLaunchKernelGGL(mk_fwd, dim3(grid), dim3(512), LDS_BYTES, stream, a);
#if defined(MK_REP_PC)
        if (p == MK_REP_PC) for (int r = 0; r < MK_REP_N; ++r) { if (p == 22 && false) (void)hipMemsetAsync((char*)d_ws + WS_GCNT, 0, 4096, stream); hipLaunchKernelGGL(mk_fwd, dim3(grid), dim3(512), LDS_BYTES, stream, a); }
#endif
    }
#else
    a.ph_lo = 0; a.ph_hi = NPHASES;
    hipLaunchKernelGGL(mk_fwd, dim3(grid), dim3(512), LDS_BYTES, stream, a);
#endif
}
```

```cpp
#include <hip/hip_runtime.h>
#include <cstdio>
#include <cstdint>
namespace pg8 {
#define PG8_LAS __attribute__((address_space(3)))
typedef unsigned short bf16_t;
typedef short bf16x8 __attribute__((ext_vector_type(8)));
typedef float f32x4 __attribute__((ext_vector_type(4)));
typedef unsigned u32x4 __attribute__((ext_vector_type(4)));
constexpr int BM = 256, BK = 64, HALF = 128, HTB = HALF * BK * 2  , STAGE_BYTES = 8 * HTB, NXCD = 8, WGM = 8;

__host__ __device__ __forceinline__ int lds_byte(int r, int c) { const int st = (r >> 4) * 2 + (c >> 5), rr = r & 15, cc = c & 31, ob = rr * 64 + cc * 2; return st * 1024 + (ob ^ (((ob >> 9) & 1) << 5)); }
__host__ __device__ __forceinline__ void stage_rc(int b, int& R, int& C) { const int st = b / 1024, sb = b % 1024, swz = sb ^ (((sb >> 9) & 1) << 5); R = (st >> 1) * 16 + swz / 64; C = (st & 1) * 32 + (swz % 64) / 2; }
__host__ __device__ __forceinline__ int perm32(int rho) { const int n = rho >> 4, i = rho & 15; return 8 * (i >> 2) + 4 * n + (i & 3); }

struct Unit { int pm, pn, aux, cnt; };
struct Gemm { const bf16_t* A; const bf16_t* Bt; int M, N, K; };

struct StaticOrder {
    int nM, nN, nwg, G, c;
    __host__ __device__ void init(int M, int N, int G_, int c_) { nM = M / BM; nN = N / BM; nwg = nM * nN; G = G_; c = c_; }
    __host__ __device__ bool next(int i, Unit& u) const {
        const long L = (long)i * G + c; if (L >= nwg) return false;
        int wgid = (int)L; { const int q = nwg / NXCD, r = nwg % NXCD, xcd = wgid % NXCD, off = wgid / NXCD; wgid = (xcd < r ? xcd * (q + 1) : r * (q + 1) + (xcd - r) * q) + off; }
        const int nig = WGM * nN, gid = wgid / nig, fm = gid * WGM, gsz = (nM - fm) < WGM ? (nM - fm) : WGM;
        u.pm = fm + ((wgid % nig) % gsz); u.pn = (wgid % nig) / gsz; return true;
    }
    __device__ __forceinline__ void a_ready(const Unit&) const {}
    __device__ __forceinline__ void done(const Unit&) const {}
};

__device__ __forceinline__ unsigned cvt_pk_bf16(float lo, float hi) { unsigned r; asm volatile("v_cvt_pk_bf16_f32 %0, %1, %2" : "=v"(r) : "v"(lo), "v"(hi)); return r; }
typedef float f32x2 __attribute__((ext_vector_type(2)));
template <class Epi, class Sched, bool ALIGN_EPI = false, bool SP2 = false>
__device__ __forceinline__ void gemm_phase(PG8_LAS unsigned char* lds, const Gemm g, const Sched& S, const Epi& E, const int wave_in) {
    unsigned z_ = 0u; asm volatile("" : "+v"(z_)); const int tid_ = (int)__builtin_amdgcn_mbcnt_hi(~0u, __builtin_amdgcn_mbcnt_lo(~0u, z_)) + 64 * wave_in;
    const int tid = tid_, wid = __builtin_amdgcn_readfirstlane(tid >> 6), lane = tid & 63, wr = wid >> 2, wc = wid & 3, fr = lane & 15, fq = lane >> 4;
    const int K = g.K, nt = K / BK;
    unsigned voffA[2], voffB[2];
#pragma unroll
    for (int i = 0; i < 2; ++i) { int R, C; stage_rc(tid * 16 + i * 8192, R, C); const int Rb = Epi::PERM ? ((R & ~31) + perm32(R & 31)) : R;
        voffA[i] = (unsigned)(R * K + C) * 2u; voffB[i] = (unsigned)(Rb * K + C) * 2u; }
    const size_t kstep = (size_t)(BK * 2);
    const size_t hstep = (size_t)HALF * K * 2;
    const size_t tstep = 2 * hstep;
    const unsigned ldsw = (unsigned)wid * 1024u;
    const int aoff = lds_byte(wr * 64 + fr, fq * 8), boff = lds_byte(wc * 32 + fr, fq * 8);
#define PG8_SA(b, h) (((b) * 2 + (h)) * HTB)
#define PG8_SB(b, h) ((4 + (b) * 2 + (h)) * HTB)
#define PG8_STAGE(bufoff, gbase, voff) do { _Pragma("unroll") for (int _i = 0; _i < 2; ++_i) \
        __builtin_amdgcn_global_load_lds((const unsigned*)((const char*)(gbase) + (voff)[_i]), (PG8_LAS unsigned*)(lds + (bufoff) + ldsw + _i * 8192), 16, 0, 0); } while (0)
#define PG8_LDA(dst, b, h) do { _Pragma("unroll") for (int m = 0; m < 4; ++m) _Pragma("unroll") for (int k = 0; k < 2; ++k) dst[m][k] = *(const PG8_LAS bf16x8*)(lds + PG8_SA(b, h) + aoff + m * 2048 + k * 1024); } while (0)
#define PG8_LDB(dst, b, h) do { _Pragma("unroll") for (int n = 0; n < 2; ++n) _Pragma("unroll") for (int k = 0; k < 2; ++k) dst[n][k] = *(const PG8_LAS bf16x8*)(lds + PG8_SB(b, h) + boff + n * 2048 + k * 1024); } while (0)
#define PG8_MMA(ai, bj, At, Bt) do { __builtin_amdgcn_s_setprio(1); _Pragma("unroll") for (int m = 0; m < 4; ++m) _Pragma("unroll") for (int n = 0; n < 2; ++n) _Pragma("unroll") for (int k = 0; k < 2; ++k) \
        acc[ai][bj][m][n] = __builtin_amdgcn_mfma_f32_16x16x32_bf16(Bt[n][k], At[m][k], acc[ai][bj][m][n], 0, 0, 0); __builtin_amdgcn_s_setprio(0); } while (0)
#define PG8_WAIT_V(n) asm volatile("s_waitcnt vmcnt(" #n ")" ::: "memory")
#define PG8_WAIT_L(n) asm volatile("s_waitcnt lgkmcnt(" #n ")" ::: "memory")
#define PG8_BAR __builtin_amdgcn_s_barrier()
#define PG8_SCHED __builtin_amdgcn_sched_barrier(0)
    Unit cur, nxt; int ui = 0;
    if (!S.next(0, cur)) return;
    f32x4 acc[2][2][4][2];
#pragma unroll
    for (int a = 0; a < 2; ++a)
#pragma unroll
        for (int b = 0; b < 2; ++b)
#pragma unroll
            for (int m = 0; m < 4; ++m)
#pragma unroll
                for (int n = 0; n < 2; ++n) acc[a][b][m][n] = (f32x4){0.f, 0.f, 0.f, 0.f};
    bf16x8 At[4][2], B0[2][2], B1[2][2];
    const char* cA = (const char*)g.A + (size_t)cur.pm * tstep; const char* cB = (const char*)g.Bt + (size_t)cur.pn * tstep;
    S.a_ready(cur);
    if constexpr (SP2) {
        PG8_STAGE(PG8_SB(0, 0), cB, voffB); PG8_STAGE(PG8_SB(0, 1), cB + hstep, voffB); PG8_STAGE(PG8_SA(0, 0), cA, voffA); PG8_STAGE(PG8_SA(0, 1), cA + hstep, voffA);
        if (wr == 1) PG8_BAR;
        PG8_WAIT_V(2); PG8_BAR;
        PG8_STAGE(PG8_SB(1, 0), cB + kstep, voffB); PG8_STAGE(PG8_SA(1, 0), cA + kstep, voffA); PG8_STAGE(PG8_SB(1, 1), cB + hstep + kstep, voffB);
        PG8_WAIT_V(6); PG8_BAR;
    } else {
        PG8_STAGE(PG8_SB(0, 0), cB, voffB); PG8_STAGE(PG8_SA(0, 0), cA, voffA); PG8_STAGE(PG8_SB(0, 1), cB + hstep, voffB); PG8_STAGE(PG8_SA(0, 1), cA + hstep, voffA);
        if (wr == 1) PG8_BAR;
        PG8_WAIT_V(4); PG8_BAR;
        PG8_STAGE(PG8_SB(1, 0), cB + kstep, voffB); PG8_STAGE(PG8_SA(1, 0), cA + kstep, voffA); PG8_STAGE(PG8_SB(1, 1), cB + hstep + kstep, voffB);
        PG8_WAIT_V(6); PG8_BAR;
    }
    for (;;) {
        const bool has_next = S.next(ui + 1, nxt);
        const char* nA = has_next ? (const char*)g.A + (size_t)nxt.pm * tstep : cA; const char* nB = has_next ? (const char*)g.Bt + (size_t)nxt.pn * tstep : cB;
        for (int t = 0; t < nt; t += 2) {
            const bool last = (t == nt - 2);
            const char* a1 = cA + (size_t)(t + 1) * kstep;
            const char* a2 = last ? nA : cA + (size_t)(t + 2) * kstep; const char* b2 = last ? nB : cB + (size_t)(t + 2) * kstep;
            const char* a3 = a2 + kstep; const char* b3 = b2 + kstep;
            if (last && has_next) S.a_ready(nxt);
            if constexpr (SP2) {
            PG8_LDB(B0, 0, 0); PG8_LDB(B1, 0, 1); PG8_SCHED; PG8_LDA(At, 0, 0); PG8_STAGE(PG8_SA(1, 1), a1 + hstep, voffA);
            PG8_WAIT_V(8); PG8_WAIT_L(0); PG8_BAR; PG8_MMA(0, 0, At, B0); PG8_MMA(0, 1, At, B1); PG8_BAR; PG8_SCHED;
            PG8_LDA(At, 0, 1); PG8_STAGE(PG8_SB(0, 0), b2, voffB); PG8_STAGE(PG8_SB(0, 1), b2 + hstep, voffB); PG8_STAGE(PG8_SA(0, 0), a2, voffA);
            PG8_WAIT_V(8); PG8_WAIT_L(0); PG8_BAR; PG8_MMA(1, 0, At, B0); PG8_MMA(1, 1, At, B1); PG8_BAR; PG8_SCHED;
            PG8_LDB(B0, 1, 0); PG8_LDB(B1, 1, 1); PG8_SCHED; PG8_LDA(At, 1, 0); PG8_STAGE(PG8_SA(0, 1), a2 + hstep, voffA);
            PG8_WAIT_V(8); PG8_WAIT_L(0); PG8_BAR; PG8_MMA(0, 0, At, B0); PG8_MMA(0, 1, At, B1); PG8_BAR; PG8_SCHED;
            PG8_LDA(At, 1, 1); PG8_STAGE(PG8_SB(1, 0), b3, voffB); PG8_STAGE(PG8_SB(1, 1), b3 + hstep, voffB); PG8_STAGE(PG8_SA(1, 0), a3, voffA);
            PG8_WAIT_V(8); PG8_WAIT_L(0); PG8_BAR; PG8_MMA(1, 0, At, B0); PG8_MMA(1, 1, At, B1); PG8_BAR; PG8_SCHED;
            } else {
            PG8_LDB(B0, 0, 0); PG8_SCHED; PG8_LDA(At, 0, 0); PG8_STAGE(PG8_SA(1, 1), a1 + hstep, voffA);
            PG8_WAIT_L(8); PG8_BAR; PG8_WAIT_L(0); PG8_MMA(0, 0, At, B0); PG8_BAR; PG8_SCHED;
            PG8_LDB(B1, 0, 1); PG8_STAGE(PG8_SB(0, 0), b2, voffB);
            PG8_BAR; PG8_WAIT_L(0); PG8_MMA(0, 1, At, B1); PG8_BAR;
            PG8_LDA(At, 0, 1); PG8_STAGE(PG8_SA(0, 0), a2, voffA);
            PG8_BAR; PG8_WAIT_L(0); PG8_MMA(1, 0, At, B0); PG8_BAR; PG8_SCHED;
            PG8_STAGE(PG8_SB(0, 1), b2 + hstep, voffB);
            PG8_WAIT_V(6); PG8_BAR; PG8_MMA(1, 1, At, B1); PG8_BAR;
            PG8_LDB(B0, 1, 0); PG8_SCHED; PG8_LDA(At, 1, 0); PG8_STAGE(PG8_SA(0, 1), a2 + hstep, voffA);
            PG8_WAIT_L(8); PG8_BAR; PG8_WAIT_L(0); PG8_MMA(0, 0, At, B0); PG8_BAR; PG8_SCHED;
            PG8_LDB(B1, 1, 1); PG8_STAGE(PG8_SB(1, 0), b3, voffB);
            PG8_BAR; PG8_WAIT_L(0); PG8_MMA(0, 1, At, B1); PG8_BAR;
            PG8_LDA(At, 1, 1); PG8_STAGE(PG8_SA(1, 0), a3, voffA);
            PG8_BAR; PG8_WAIT_L(0); PG8_MMA(1, 0, At, B0); PG8_BAR; PG8_SCHED;
            PG8_STAGE(PG8_SB(1, 1), b3 + hstep, voffB);
            PG8_WAIT_V(6); PG8_BAR; PG8_MMA(1, 1, At, B1); PG8_BAR;
            }
        }
        if constexpr (ALIGN_EPI) { if (wr == 0) PG8_BAR; }
        if constexpr (!Epi::AFTER_DRAIN) { E(acc, cur, wr, wc, fr, fq); S.done(cur); }
        if (!has_next) break;
#pragma unroll
        for (int a = 0; a < 2; ++a)
#pragma unroll
            for (int b = 0; b < 2; ++b)
#pragma unroll
                for (int m = 0; m < 4; ++m)
#pragma unroll
                    for (int n = 0; n < 2; ++n) acc[a][b][m][n] = (f32x4){0.f, 0.f, 0.f, 0.f};
        cur = nxt; cA = nA; cB = nB; ++ui;
        if constexpr (ALIGN_EPI) { if (wr == 1) PG8_BAR; }
    }
    PG8_WAIT_V(0);
    if constexpr (!ALIGN_EPI) { if (wr == 0) PG8_BAR; }
    PG8_BAR;
    if constexpr (Epi::AFTER_DRAIN) { E.fused(acc, cur, wr, wc, fr, fq, lds, wid, lane); S.done(cur); }
#undef PG8_SA
#undef PG8_SB
#undef PG8_STAGE
#undef PG8_LDA
#undef PG8_LDB
#undef PG8_MMA
#undef PG8_WAIT_V
#undef PG8_WAIT_L
#undef PG8_BAR
#undef PG8_SCHED
}
template <class Epi, class Sched>
__device__ __forceinline__ void gemm_phase_gather(PG8_LAS unsigned char* lds, const Gemm g, const Sched& S, const Epi& E, const int wave_in) {
    unsigned z_ = 0u; asm volatile("" : "+v"(z_)); const int tid_ = (int)__builtin_amdgcn_mbcnt_hi(~0u, __builtin_amdgcn_mbcnt_lo(~0u, z_)) + 64 * wave_in;
    const int tid = tid_, wid = __builtin_amdgcn_readfirstlane(tid >> 6), lane = tid & 63, wr = wid >> 2, wc = wid & 3, fr = lane & 15, fq = lane >> 4;
    constexpr bool ALIGN_EPI = true, SP2 = true;
    const int K = g.K, nt = K / BK;
    unsigned voffB[2]; int RA0; unsigned CA0;
#pragma unroll
    for (int i = 0; i < 2; ++i) { int R, C; stage_rc(tid * 16 + i * 8192, R, C); const int Rb = Epi::PERM ? ((R & ~31) + perm32(R & 31)) : R;
        if (i == 0) { RA0 = R; CA0 = (unsigned)C * 2u; } voffB[i] = (unsigned)(Rb * K + C) * 2u; }
    unsigned ro[2], rn[2][2];
    const size_t kstep = (size_t)(BK * 2);
    const size_t hstep = (size_t)HALF * K * 2;
    const size_t tstep = 2 * hstep;
    const unsigned ldsw = (unsigned)wid * 1024u;
    const int aoff = lds_byte(wr * 64 + fr, fq * 8), boff = lds_byte(wc * 32 + fr, fq * 8);
#define PG8_SA(b, h) (((b) * 2 + (h)) * HTB)
#define PG8_SB(b, h) ((4 + (b) * 2 + (h)) * HTB)
#define PG8_STAGE(bufoff, gbase, voff) do { _Pragma("unroll") for (int _i = 0; _i < 2; ++_i) \
        __builtin_amdgcn_global_load_lds((const unsigned*)((const char*)(gbase) + (voff)[_i]), (PG8_LAS unsigned*)(lds + (bufoff) + ldsw + _i * 8192), 16, 0, 0); } while (0)
#define PG8_STAGE_G(bufoff, kbyte, pk) do { _Pragma("unroll") for (int _i = 0; _i < 2; ++_i) { const unsigned _row = _i ? ((pk) >> 16) : ((pk) & 0xffffu); \
        __builtin_amdgcn_global_load_lds((const unsigned*)((const char*)g.A + (kbyte) + (_row * ((unsigned)K * 2u) + CA0)), (PG8_LAS unsigned*)(lds + (bufoff) + ldsw + _i * 8192), 16, 0, 0); } } while (0)
#define PG8_LDA(dst, b, h) do { _Pragma("unroll") for (int m = 0; m < 4; ++m) _Pragma("unroll") for (int k = 0; k < 2; ++k) dst[m][k] = *(const PG8_LAS bf16x8*)(lds + PG8_SA(b, h) + aoff + m * 2048 + k * 1024); } while (0)
#define PG8_LDB(dst, b, h) do { _Pragma("unroll") for (int n = 0; n < 2; ++n) _Pragma("unroll") for (int k = 0; k < 2; ++k) dst[n][k] = *(const PG8_LAS bf16x8*)(lds + PG8_SB(b, h) + boff + n * 2048 + k * 1024); } while (0)
#define PG8_MMA(ai, bj, At, Bt) do { __builtin_amdgcn_s_setprio(1); _Pragma("unroll") for (int m = 0; m < 4; ++m) _Pragma("unroll") for (int n = 0; n < 2; ++n) _Pragma("unroll") for (int k = 0; k < 2; ++k) \
        acc[ai][bj][m][n] = __builtin_amdgcn_mfma_f32_16x16x32_bf16(Bt[n][k], At[m][k], acc[ai][bj][m][n], 0, 0, 0); __builtin_amdgcn_s_setprio(0); } while (0)
#define PG8_WAIT_V(n) asm volatile("s_waitcnt vmcnt(" #n ")" ::: "memory")
#define PG8_WAIT_L(n) asm volatile("s_waitcnt lgkmcnt(" #n ")" ::: "memory")
#define PG8_BAR __builtin_amdgcn_s_barrier()
#define PG8_SCHED __builtin_amdgcn_sched_barrier(0)
    Unit cur, nxt; int ui = 0;
    if (!S.next(0, cur)) return;
    f32x4 acc[2][2][4][2];
#pragma unroll
    for (int a = 0; a < 2; ++a)
#pragma unroll
        for (int b = 0; b < 2; ++b)
#pragma unroll
            for (int m = 0; m < 4; ++m)
#pragma unroll
                for (int n = 0; n < 2; ++n) acc[a][b][m][n] = (f32x4){0.f, 0.f, 0.f, 0.f};
    bf16x8 At[4][2], B0[2][2], B1[2][2];
    const char* cB = (const char*)g.Bt + (size_t)cur.pn * tstep;
    S.a_ready(cur);
    S.rows(cur, RA0, rn); ro[0] = rn[0][0] | (rn[0][1] << 16); ro[1] = rn[1][0] | (rn[1][1] << 16);
    if constexpr (SP2) {
        PG8_STAGE(PG8_SB(0, 0), cB, voffB); PG8_STAGE(PG8_SB(0, 1), cB + hstep, voffB); PG8_STAGE_G(PG8_SA(0, 0), 0, ro[0]); PG8_STAGE_G(PG8_SA(0, 1), 0, ro[1]);
        if (wr == 1) PG8_BAR;
        PG8_WAIT_V(2); PG8_BAR;
        PG8_STAGE(PG8_SB(1, 0), cB + kstep, voffB); PG8_STAGE_G(PG8_SA(1, 0), kstep, ro[0]); PG8_STAGE(PG8_SB(1, 1), cB + hstep + kstep, voffB);
        PG8_WAIT_V(6); PG8_BAR;
    }
    for (;;) {
        const bool has_next = S.next(ui + 1, nxt);
        const char* nB = has_next ? (const char*)g.Bt + (size_t)nxt.pn * tstep : cB;
        for (int t = 0; t < nt; t += 2) {
            const bool last = (t == nt - 2);
            const size_t k1 = (size_t)(t + 1) * kstep, k2 = last ? (size_t)0 : (size_t)(t + 2) * kstep, k3 = k2 + kstep;
            const char* b2 = last ? nB : cB + (size_t)(t + 2) * kstep; const char* b3 = b2 + kstep;
            if (t == nt - 4 && has_next) S.rows(nxt, RA0, rn);
            const unsigned c1 = ro[1];
            unsigned s0 = ro[0], s1 = ro[1];
            if (last && has_next) { unsigned q0 = rn[0][0], q1 = rn[0][1], q2 = rn[1][0], q3 = rn[1][1]; asm volatile("" : "+v"(q0), "+v"(q1), "+v"(q2), "+v"(q3));
                s0 = q0 | (q1 << 16); s1 = q2 | (q3 << 16); ro[0] = s0; ro[1] = s1; }
            if (last && has_next) S.a_ready(nxt);
            if constexpr (SP2) {
            PG8_LDB(B0, 0, 0); PG8_LDB(B1, 0, 1); PG8_SCHED; PG8_LDA(At, 0, 0); PG8_STAGE_G(PG8_SA(1, 1), k1, c1);
            PG8_WAIT_V(8); PG8_WAIT_L(0); PG8_BAR; PG8_MMA(0, 0, At, B0); PG8_MMA(0, 1, At, B1); PG8_BAR; PG8_SCHED;
            PG8_LDA(At, 0, 1); PG8_STAGE(PG8_SB(0, 0), b2, voffB); PG8_STAGE(PG8_SB(0, 1), b2 + hstep, voffB); PG8_STAGE_G(PG8_SA(0, 0), k2, s0);
            PG8_WAIT_V(8); PG8_WAIT_L(0); PG8_BAR; PG8_MMA(1, 0, At, B0); PG8_MMA(1, 1, At, B1); PG8_BAR; PG8_SCHED;
            PG8_LDB(B0, 1, 0); PG8_LDB(B1, 1, 1); PG8_SCHED; PG8_LDA(At, 1, 0); PG8_STAGE_G(PG8_SA(0, 1), k2, s1);
            PG8_WAIT_V(8); PG8_WAIT_L(0); PG8_BAR; PG8_MMA(0, 0, At, B0); PG8_MMA(0, 1, At, B1); PG8_BAR; PG8_SCHED;
            PG8_LDA(At, 1, 1); PG8_STAGE(PG8_SB(1, 0), b3, voffB); PG8_STAGE(PG8_SB(1, 1), b3 + hstep, voffB); PG8_STAGE_G(PG8_SA(1, 0), k3, s0);
            PG8_WAIT_V(8); PG8_WAIT_L(0); PG8_BAR; PG8_MMA(1, 0, At, B0); PG8_MMA(1, 1, At, B1); PG8_BAR; PG8_SCHED;
            }
        }
        if constexpr (ALIGN_EPI) { if (wr == 0) PG8_BAR; }
        if constexpr (!Epi::AFTER_DRAIN) { E(acc, cur, wr, wc, fr, fq); S.done(cur); }
        if (!has_next) break;
#pragma unroll
        for (int a = 0; a < 2; ++a)
#pragma unroll
            for (int b = 0; b < 2; ++b)
#pragma unroll
                for (int m = 0; m < 4; ++m)
#pragma unroll
                    for (int n = 0; n < 2; ++n) acc[a][b][m][n] = (f32x4){0.f, 0.f, 0.f, 0.f};
        cur = nxt; cB = nB; ++ui;
        if constexpr (ALIGN_EPI) { if (wr == 1) PG8_BAR; }
    }
    PG8_WAIT_V(0);
    if constexpr (!ALIGN_EPI) { if (wr == 0) PG8_BAR; }
    PG8_BAR;
    if constexpr (Epi::AFTER_DRAIN) { E.fused(acc, cur, wr, wc, fr, fq, lds, wid, lane); S.done(cur); }
#undef PG8_SA
#undef PG8_SB
#undef PG8_STAGE
#undef PG8_STAGE_G
#undef PG8_LDA
#undef PG8_LDB
#undef PG8_MMA
#undef PG8_WAIT_V
#undef PG8_WAIT_L
#undef PG8_BAR
#undef PG8_SCHED
}
typedef int v8i_t __attribute__((ext_vector_type(8)));
template <class Epi, class Sched, bool ALIGN_EPI = false, bool SP2 = false>
__device__ __forceinline__ void gemm_phase8(PG8_LAS unsigned char* lds, const Gemm g, const Sched& S, const Epi& E, const int wave_in) {
    unsigned z_ = 0u; asm volatile("" : "+v"(z_)); const int tid_ = (int)__builtin_amdgcn_mbcnt_hi(~0u, __builtin_amdgcn_mbcnt_lo(~0u, z_)) + 64 * wave_in;
    const int tid = tid_, wid = __builtin_amdgcn_readfirstlane(tid >> 6), lane = tid & 63, wr = wid >> 2, wc = wid & 3, fr = lane & 15, fq = lane >> 4;
    const int K = g.K, nt = K / (2 * BK);
    unsigned voffA[2], voffB[2];
#pragma unroll
    for (int i = 0; i < 2; ++i) { int R, C; stage_rc(tid * 16 + i * 8192, R, C); const int Rb = Epi::PERM ? ((R & ~31) + perm32(R & 31)) : R;
        voffA[i] = (unsigned)(R * K + C * 2); voffB[i] = (unsigned)(Rb * K + C * 2); }
    const size_t kstep = (size_t)(BK * 2);
    const size_t hstep = (size_t)HALF * K;
    const size_t tstep = 2 * hstep;
    const unsigned ldsw = (unsigned)wid * 1024u;
    const int aoff = lds_byte(wr * 64 + fr, fq * 16), boff = lds_byte(wc * 32 + fr, fq * 16);
#define PG8_SA(b, h) (((b) * 2 + (h)) * HTB)
#define PG8_SB(b, h) ((4 + (b) * 2 + (h)) * HTB)
#define PG8_STAGE(bufoff, gbase, voff) do { _Pragma("unroll") for (int _i = 0; _i < 2; ++_i) \
        __builtin_amdgcn_global_load_lds((const unsigned*)((const char*)(gbase) + (voff)[_i]), (PG8_LAS unsigned*)(lds + (bufoff) + ldsw + _i * 8192), 16, 0, 0); } while (0)
#define PG8_LDA(dst, b, h) do { _Pragma("unroll") for (int m = 0; m < 4; ++m) { const PG8_LAS u32x4* p_ = (const PG8_LAS u32x4*)(lds + PG8_SA(b, h) + aoff + m * 2048); const u32x4 lo_ = p_[0], hi_ = p_[1]; dst[m] = (v8i_t){(int)lo_.x, (int)lo_.y, (int)lo_.z, (int)lo_.w, (int)hi_.x, (int)hi_.y, (int)hi_.z, (int)hi_.w}; } } while (0)
#define PG8_LDB(dst, b, h) do { _Pragma("unroll") for (int n = 0; n < 2; ++n) { const PG8_LAS u32x4* p_ = (const PG8_LAS u32x4*)(lds + PG8_SB(b, h) + boff + n * 2048); const u32x4 lo_ = p_[0], hi_ = p_[1]; dst[n] = (v8i_t){(int)lo_.x, (int)lo_.y, (int)lo_.z, (int)lo_.w, (int)hi_.x, (int)hi_.y, (int)hi_.z, (int)hi_.w}; } } while (0)
#define PG8_MMA(ai, bj, At, Bt) do { __builtin_amdgcn_s_setprio(1); _Pragma("unroll") for (int m = 0; m < 4; ++m) _Pragma("unroll") for (int n = 0; n < 2; ++n) \
        asm volatile("v_mfma_f32_16x16x128_f8f6f4 %0, %1, %2, %0" : "+v"(acc[ai][bj][m][n]) : "v"(Bt[n]), "v"(At[m])); __builtin_amdgcn_s_setprio(0); } while (0)
#define PG8_WAIT_V(n) asm volatile("s_waitcnt vmcnt(" #n ")" ::: "memory")
#define PG8_WAIT_L(n) asm volatile("s_waitcnt lgkmcnt(" #n ")" ::: "memory")
#define PG8_BAR __builtin_amdgcn_s_barrier()
#define PG8_SCHED __builtin_amdgcn_sched_barrier(0)
    Unit cur, nxt; int ui = 0;
    if (!S.next(0, cur)) return;
    f32x4 acc[2][2][4][2];
#pragma unroll
    for (int a = 0; a < 2; ++a)
#pragma unroll
        for (int b = 0; b < 2; ++b)
#pragma unroll
            for (int m = 0; m < 4; ++m)
#pragma unroll
                for (int n = 0; n < 2; ++n) acc[a][b][m][n] = (f32x4){0.f, 0.f, 0.f, 0.f};
    v8i_t At[4], B0[2], B1[2];
    const char* cA = (const char*)g.A + (size_t)cur.pm * tstep; const char* cB = (const char*)g.Bt + (size_t)cur.pn * tstep;
    S.a_ready(cur);
    if constexpr (SP2) {
        PG8_STAGE(PG8_SB(0, 0), cB, voffB); PG8_STAGE(PG8_SB(0, 1), cB + hstep, voffB); PG8_STAGE(PG8_SA(0, 0), cA, voffA); PG8_STAGE(PG8_SA(0, 1), cA + hstep, voffA);
        if (wr == 1) PG8_BAR;
        PG8_WAIT_V(2); PG8_BAR;
        PG8_STAGE(PG8_SB(1, 0), cB + kstep, voffB); PG8_STAGE(PG8_SA(1, 0), cA + kstep, voffA); PG8_STAGE(PG8_SB(1, 1), cB + hstep + kstep, voffB);
        PG8_WAIT_V(6); PG8_BAR;
    } else {
        PG8_STAGE(PG8_SB(0, 0), cB, voffB); PG8_STAGE(PG8_SA(0, 0), cA, voffA); PG8_STAGE(PG8_SB(0, 1), cB + hstep, voffB); PG8_STAGE(PG8_SA(0, 1), cA + hstep, voffA);
        if (wr == 1) PG8_BAR;
        PG8_WAIT_V(4); PG8_BAR;
        PG8_STAGE(PG8_SB(1, 0), cB + kstep, voffB); PG8_STAGE(PG8_SA(1, 0), cA + kstep, voffA); PG8_STAGE(PG8_SB(1, 1), cB + hstep + kstep, voffB);
        PG8_WAIT_V(6); PG8_BAR;
    }
    for (;;) {
        const bool has_next = S.next(ui + 1, nxt);
        const char* nA = has_next ? (const char*)g.A + (size_t)nxt.pm * tstep : cA; const char* nB = has_next ? (const char*)g.Bt + (size_t)nxt.pn * tstep : cB;
#pragma nounroll
        for (int t = 0; t < nt; t += 2) {
            const bool last = (t == nt - 2);
            const char* a1 = cA + (size_t)(t + 1) * kstep;
            const char* a2 = last ? nA : cA + (size_t)(t + 2) * kstep; const char* b2 = last ? nB : cB + (size_t)(t + 2) * kstep;
            const char* a3 = a2 + kstep; const char* b3 = b2 + kstep;
            if (last && has_next) S.a_ready(nxt);
            if constexpr (SP2) {
            PG8_LDB(B0, 0, 0); PG8_LDB(B1, 0, 1); PG8_SCHED; PG8_LDA(At, 0, 0); PG8_STAGE(PG8_SA(1, 1), a1 + hstep, voffA);
            PG8_WAIT_V(8); PG8_WAIT_L(0); PG8_BAR; PG8_MMA(0, 0, At, B0); PG8_MMA(0, 1, At, B1); PG8_BAR; PG8_SCHED;
            PG8_LDA(At, 0, 1); PG8_STAGE(PG8_SB(0, 0), b2, voffB); PG8_STAGE(PG8_SB(0, 1), b2 + hstep, voffB); PG8_STAGE(PG8_SA(0, 0), a2, voffA);
            PG8_WAIT_V(8); PG8_WAIT_L(0); PG8_BAR; PG8_MMA(1, 0, At, B0); PG8_MMA(1, 1, At, B1); PG8_BAR; PG8_SCHED;
            PG8_LDB(B0, 1, 0); PG8_LDB(B1, 1, 1); PG8_SCHED; PG8_LDA(At, 1, 0); PG8_STAGE(PG8_SA(0, 1), a2 + hstep, voffA);
            PG8_WAIT_V(8); PG8_WAIT_L(0); PG8_BAR; PG8_MMA(0, 0, At, B0); PG8_MMA(0, 1, At, B1); PG8_BAR; PG8_SCHED;
            PG8_LDA(At, 1, 1); PG8_STAGE(PG8_SB(1, 0), b3, voffB); PG8_STAGE(PG8_SB(1, 1), b3 + hstep, voffB); PG8_STAGE(PG8_SA(1, 0), a3, voffA);
            PG8_WAIT_V(8); PG8_WAIT_L(0); PG8_BAR; PG8_MMA(1, 0, At, B0); PG8_MMA(1, 1, At, B1); PG8_BAR; PG8_SCHED;
            } else {
            PG8_LDB(B0, 0, 0); PG8_SCHED; PG8_LDA(At, 0, 0); PG8_STAGE(PG8_SA(1, 1), a1 + hstep, voffA);
            PG8_WAIT_L(8); PG8_BAR; PG8_WAIT_L(0); PG8_MMA(0, 0, At, B0); PG8_BAR; PG8_SCHED;
            PG8_LDB(B1, 0, 1); PG8_STAGE(PG8_SB(0, 0), b2, voffB);
            PG8_BAR; PG8_WAIT_L(0); PG8_MMA(0, 1, At, B1); PG8_BAR;
            PG8_LDA(At, 0, 1); PG8_STAGE(PG8_SA(0, 0), a2, voffA);
            PG8_BAR; PG8_WAIT_L(0); PG8_MMA(1, 0, At, B0); PG8_BAR; PG8_SCHED;
            PG8_STAGE(PG8_SB(0, 1), b2 + hstep, voffB);
            PG8_WAIT_V(6); PG8_BAR; PG8_MMA(1, 1, At, B1); PG8_BAR;
            PG8_LDB(B0, 1, 0); PG8_SCHED; PG8_LDA(At, 1, 0); PG8_STAGE(PG8_SA(0, 1), a2 + hstep, voffA);
            PG8_WAIT_L(8); PG8_BAR; PG8_WAIT_L(0); PG8_MMA(0, 0, At, B0); PG8_BAR; PG8_SCHED;
            PG8_LDB(B1, 1, 1); PG8_STAGE(PG8_SB(1, 0), b3, voffB);
            PG8_BAR; PG8_WAIT_L(0); PG8_MMA(0, 1, At, B1); PG8_BAR;
            PG8_LDA(At, 1, 1); PG8_STAGE(PG8_SA(1, 0), a3, voffA);
            PG8_BAR; PG8_WAIT_L(0); PG8_MMA(1, 0, At, B0); PG8_BAR; PG8_SCHED;
            PG8_STAGE(PG8_SB(1, 1), b3 + hstep, voffB);
            PG8_WAIT_V(6); PG8_BAR; PG8_MMA(1, 1, At, B1); PG8_BAR;
            }
        }
        asm volatile("s_nop 15\n\ts_nop 15" ::: "memory");
        if constexpr (ALIGN_EPI) { if (wr == 0) PG8_BAR; }
        if constexpr (!Epi::AFTER_DRAIN) { E(acc, cur, wr, wc, fr, fq); S.done(cur); }
        if (!has_next) break;
#pragma unroll
        for (int a = 0; a < 2; ++a)
#pragma unroll
            for (int b = 0; b < 2; ++b)
#pragma unroll
                for (int m = 0; m < 4; ++m)
#pragma unroll
                    for (int n = 0; n < 2; ++n) acc[a][b][m][n] = (f32x4){0.f, 0.f, 0.f, 0.f};
        cur = nxt; cA = nA; cB = nB; ++ui;
        if constexpr (ALIGN_EPI) { if (wr == 1) PG8_BAR; }
    }
    PG8_WAIT_V(0);
    if constexpr (!ALIGN_EPI) { if (wr == 0) PG8_BAR; }
    PG8_BAR;
    if constexpr (Epi::AFTER_DRAIN) { E.fused(acc, cur, wr, wc, fr, fq, lds, wid, lane); S.done(cur); }
#undef PG8_SA
#undef PG8_SB
#undef PG8_STAGE
#undef PG8_LDA
#undef PG8_LDB
#undef PG8_MMA
#undef PG8_WAIT_V
#undef PG8_WAIT_L
#undef PG8_BAR
#undef PG8_SCHED
}
template <class Epi, class Sched>
__device__ __forceinline__ void gemm_phase_gather8(PG8_LAS unsigned char* lds, const Gemm g, const Sched& S, const Epi& E, const int wave_in) {
    unsigned z_ = 0u; asm volatile("" : "+v"(z_)); const int tid_ = (int)__builtin_amdgcn_mbcnt_hi(~0u, __builtin_amdgcn_mbcnt_lo(~0u, z_)) + 64 * wave_in;
    const int tid = tid_, wid = __builtin_amdgcn_readfirstlane(tid >> 6), lane = tid & 63, wr = wid >> 2, wc = wid & 3, fr = lane & 15, fq = lane >> 4;
    constexpr bool ALIGN_EPI = true, SP2 = true;
    const int K = g.K, nt = K / (2 * BK);
    unsigned voffB[2]; int RA0; unsigned CA0;
#pragma unroll
    for (int i = 0; i < 2; ++i) { int R, C; stage_rc(tid * 16 + i * 8192, R, C); const int Rb = Epi::PERM ? ((R & ~31) + perm32(R & 31)) : R;
        if (i == 0) { RA0 = R; CA0 = (unsigned)C * 2u; } voffB[i] = (unsigned)(Rb * K + C * 2); }
    unsigned ro[2], rn[2][2];
    const size_t kstep = (size_t)(BK * 2);
    const size_t hstep = (size_t)HALF * K;
    const size_t tstep = 2 * hstep;
    const unsigned ldsw = (unsigned)wid * 1024u;
    const int aoff = lds_byte(wr * 64 + fr, fq * 16), boff = lds_byte(wc * 32 + fr, fq * 16);
#define PG8_SA(b, h) (((b) * 2 + (h)) * HTB)
#define PG8_SB(b, h) ((4 + (b) * 2 + (h)) * HTB)
#define PG8_STAGE(bufoff, gbase, voff) do { _Pragma("unroll") for (int _i = 0; _i < 2; ++_i) \
        __builtin_amdgcn_global_load_lds((const unsigned*)((const char*)(gbase) + (voff)[_i]), (PG8_LAS unsigned*)(lds + (bufoff) + ldsw + _i * 8192), 16, 0, 0); } while (0)
#define PG8_STAGE_G(bufoff, kbyte, pk) do { _Pragma("unroll") for (int _i = 0; _i < 2; ++_i) { const unsigned _row = _i ? ((pk) >> 16) : ((pk) & 0xffffu); \
        __builtin_amdgcn_global_load_lds((const unsigned*)((const char*)g.A + (kbyte) + (_row * (unsigned)K + CA0)), (PG8_LAS unsigned*)(lds + (bufoff) + ldsw + _i * 8192), 16, 0, 0); } } while (0)
#define PG8_LDA(dst, b, h) do { _Pragma("unroll") for (int m = 0; m < 4; ++m) { const PG8_LAS u32x4* p_ = (const PG8_LAS u32x4*)(lds + PG8_SA(b, h) + aoff + m * 2048); const u32x4 lo_ = p_[0], hi_ = p_[1]; dst[m] = (v8i_t){(int)lo_.x, (int)lo_.y, (int)lo_.z, (int)lo_.w, (int)hi_.x, (int)hi_.y, (int)hi_.z, (int)hi_.w}; } } while (0)
#define PG8_LDB(dst, b, h) do { _Pragma("unroll") for (int n = 0; n < 2; ++n) { const PG8_LAS u32x4* p_ = (const PG8_LAS u32x4*)(lds + PG8_SB(b, h) + boff + n * 2048); const u32x4 lo_ = p_[0], hi_ = p_[1]; dst[n] = (v8i_t){(int)lo_.x, (int)lo_.y, (int)lo_.z, (int)lo_.w, (int)hi_.x, (int)hi_.y, (int)hi_.z, (int)hi_.w}; } } while (0)
#define PG8_MMA(ai, bj, At, Bt) do { __builtin_amdgcn_s_setprio(1); _Pragma("unroll") for (int m = 0; m < 4; ++m) _Pragma("unroll") for (int n = 0; n < 2; ++n) \
        asm volatile("v_mfma_f32_16x16x128_f8f6f4 %0, %1, %2, %0" : "+v"(acc[ai][bj][m][n]) : "v"(Bt[n]), "v"(At[m])); __builtin_amdgcn_s_setprio(0); } while (0)
#define PG8_WAIT_V(n) asm volatile("s_waitcnt vmcnt(" #n ")" ::: "memory")
#define PG8_WAIT_L(n) asm volatile("s_waitcnt lgkmcnt(" #n ")" ::: "memory")
#define PG8_BAR __builtin_amdgcn_s_barrier()
#define PG8_SCHED __builtin_amdgcn_sched_barrier(0)
    Unit cur, nxt; int ui = 0;
    if (!S.next(0, cur)) return;
    f32x4 acc[2][2][4][2];
#pragma unroll
    for (int a = 0; a < 2; ++a)
#pragma unroll
        for (int b = 0; b < 2; ++b)
#pragma unroll
            for (int m = 0; m < 4; ++m)
#pragma unroll
                for (int n = 0; n < 2; ++n) acc[a][b][m][n] = (f32x4){0.f, 0.f, 0.f, 0.f};
    v8i_t At[4], B0[2], B1[2];
    const char* cB = (const char*)g.Bt + (size_t)cur.pn * tstep;
    S.a_ready(cur);
    S.rows(cur, RA0, rn); ro[0] = rn[0][0] | (rn[0][1] << 16); ro[1] = rn[1][0] | (rn[1][1] << 16);
    if constexpr (SP2) {
        PG8_STAGE(PG8_SB(0, 0), cB, voffB); PG8_STAGE(PG8_SB(0, 1), cB + hstep, voffB); PG8_STAGE_G(PG8_SA(0, 0), 0, ro[0]); PG8_STAGE_G(PG8_SA(0, 1), 0, ro[1]);
        if (wr == 1) PG8_BAR;
        PG8_WAIT_V(2); PG8_BAR;
        PG8_STAGE(PG8_SB(1, 0), cB + kstep, voffB); PG8_STAGE_G(PG8_SA(1, 0), kstep, ro[0]); PG8_STAGE(PG8_SB(1, 1), cB + hstep + kstep, voffB);
        PG8_WAIT_V(6); PG8_BAR;
    }
    for (;;) {
        const bool has_next = S.next(ui + 1, nxt);
        const char* nB = has_next ? (const char*)g.Bt + (size_t)nxt.pn * tstep : cB;
#pragma nounroll
        for (int t = 0; t < nt; t += 2) {
            const bool last = (t == nt - 2);
            const size_t k1 = (size_t)(t + 1) * kstep, k2 = last ? (size_t)0 : (size_t)(t + 2) * kstep, k3 = k2 + kstep;
            const char* b2 = last ? nB : cB + (size_t)(t + 2) * kstep; const char* b3 = b2 + kstep;
            if (t == nt - 4 && has_next) S.rows(nxt, RA0, rn);
            const unsigned c1 = ro[1];
            unsigned s0 = ro[0], s1 = ro[1];
            if (last && has_next) { unsigned q0 = rn[0][0], q1 = rn[0][1], q2 = rn[1][0], q3 = rn[1][1]; asm volatile("" : "+v"(q0), "+v"(q1), "+v"(q2), "+v"(q3));
                s0 = q0 | (q1 << 16); s1 = q2 | (q3 << 16); ro[0] = s0; ro[1] = s1; }
            if (last && has_next) S.a_ready(nxt);
            if constexpr (SP2) {
            PG8_LDB(B0, 0, 0); PG8_LDB(B1, 0, 1); PG8_SCHED; PG8_LDA(At, 0, 0); PG8_STAGE_G(PG8_SA(1, 1), k1, c1);
            PG8_WAIT_V(8); PG8_WAIT_L(0); PG8_BAR; PG8_MMA(0, 0, At, B0); PG8_MMA(0, 1, At, B1); PG8_BAR; PG8_SCHED;
            PG8_LDA(At, 0, 1); PG8_STAGE(PG8_SB(0, 0), b2, voffB); PG8_STAGE(PG8_SB(0, 1), b2 + hstep, voffB); PG8_STAGE_G(PG8_SA(0, 0), k2, s0);
            PG8_WAIT_V(8); PG8_WAIT_L(0); PG8_BAR; PG8_MMA(1, 0, At, B0); PG8_MMA(1, 1, At, B1); PG8_BAR; PG8_SCHED;
            PG8_LDB(B0, 1, 0); PG8_LDB(B1, 1, 1); PG8_SCHED; PG8_LDA(At, 1, 0); PG8_STAGE_G(PG8_SA(0, 1), k2, s1);
            PG8_WAIT_V(8); PG8_WAIT_L(0); PG8_BAR; PG8_MMA(0, 0, At, B0); PG8_MMA(0, 1, At, B1); PG8_BAR; PG8_SCHED;
            PG8_LDA(At, 1, 1); PG8_STAGE(PG8_SB(1, 0), b3, voffB); PG8_STAGE(PG8_SB(1, 1), b3 + hstep, voffB); PG8_STAGE_G(PG8_SA(1, 0), k3, s0);
            PG8_WAIT_V(8); PG8_WAIT_L(0); PG8_BAR; PG8_MMA(1, 0, At, B0); PG8_MMA(1, 1, At, B1); PG8_BAR; PG8_SCHED;
            }
        }
        asm volatile("s_nop 15\n\ts_nop 15" ::: "memory");
        if constexpr (ALIGN_EPI) { if (wr == 0) PG8_BAR; }
        if constexpr (!Epi::AFTER_DRAIN) { E(acc, cur, wr, wc, fr, fq); S.done(cur); }
        if (!has_next) break;
#pragma unroll
        for (int a = 0; a < 2; ++a)
#pragma unroll
            for (int b = 0; b < 2; ++b)
#pragma unroll
                for (int m = 0; m < 4; ++m)
#pragma unroll
                    for (int n = 0; n < 2; ++n) acc[a][b][m][n] = (f32x4){0.f, 0.f, 0.f, 0.f};
        cur = nxt; cB = nB; ++ui;
        if constexpr (ALIGN_EPI) { if (wr == 1) PG8_BAR; }
    }
    PG8_WAIT_V(0);
    if constexpr (!ALIGN_EPI) { if (wr == 0) PG8_BAR; }
    PG8_BAR;
    if constexpr (Epi::AFTER_DRAIN) { E.fused(acc, cur, wr, wc, fr, fq, lds, wid, lane); S.done(cur); }
#undef PG8_SA
#undef PG8_SB
#undef PG8_STAGE
#undef PG8_STAGE_G
#undef PG8_LDA
#undef PG8_LDB
#undef PG8_MMA
#undef PG8_WAIT_V
#undef PG8_WAIT_L
#undef PG8_BAR
#undef PG8_SCHED
}
}

#ifndef PG8_SP2
#define PG8_SP2 true
#endif
#ifndef PG8_ALIGN
#define PG8_ALIGN true
#endif

constexpr int NTOK = 65536, DM = 1024, NCOL = 7680, SEQ = 4096, NBATCH = 16, HTOK = 32768, MEMLEN = 256;
constexpr int C_HQ = 0, C_HF = 1024, C_HI = 2048, C_HG = 3072, C_SQ = 4096, C_SK = 5120, C_SV = 5376, C_GA = 5632, C_GB = 6656;
constexpr int NEXP = 32, TOPK = 4, CAPH = HTOK * TOPK + NEXP * 256;
constexpr float RMS_EPS = 1e-5f;
constexpr size_t MiB = (size_t)1 << 20;
constexpr size_t WS_ZERO_BYTES = 2 * MiB;
constexpr size_t WS_GCNT = 1 * MiB;
constexpr int CW_TMO = 0, CW_BAR = 4096;
constexpr size_t WS_LB = 2 * MiB, WS_LUT = 2 * MiB + 4096, WS_BLKE = 2 * MiB + 16384, WS_NBT = 2 * MiB + 32768;
constexpr size_t WS_TOPE = 3 * MiB, WS_TOPG = 4 * MiB, WS_TOPR = 5 * MiB, WS_TOPP = 6 * MiB, WS_RGATE = 7 * MiB, WS_RRSTD = 8 * MiB, WS_D12 = 10 * MiB;
constexpr size_t WS_WIN = 16 * MiB, WS_WA = 31 * MiB, WS_WB = 33 * MiB, WS_WMIX = 35 * MiB, WS_WQ = 37 * MiB, WS_WK = 39 * MiB, WS_WV = 41 * MiB, WS_WO = 43 * MiB, WS_WR = 45 * MiB;
constexpr size_t WS_MEMBF = 46 * MiB, WS_KX = 54 * MiB, WS_VXT = 62 * MiB;
constexpr size_t WS_XBF = 72 * MiB;
constexpr size_t WS_PROJ = 200 * MiB, WS_OA = 680 * MiB, WS_OB = 744 * MiB, WS_TM = 808 * MiB;
constexpr size_t WS_Q = 664 * MiB, WS_O = 792 * MiB;
constexpr size_t WS_X2F8 = 296 * MiB;
constexpr size_t WS_WGU = 200 * MiB, WS_WD = 264 * MiB, WS_ACT = 392 * MiB, WS_Y = 664 * MiB, WS_SSQ1 = 936 * MiB, WS_SSQ2 = 940 * MiB, WS_RTOK = 944 * MiB, WS_RGATE2 = 952 * MiB, WS_RRSTD2 = 960 * MiB, WS_END = 968 * MiB;
constexpr size_t OUT_US = 128 * MiB;

#define GAS __attribute__((address_space(1)))
#define LAS __attribute__((address_space(3)))
typedef unsigned short bf16;
typedef unsigned v4u __attribute__((ext_vector_type(4)));
typedef unsigned v2u __attribute__((ext_vector_type(2)));
typedef float f32x4 __attribute__((ext_vector_type(4)));
typedef short bf16x8 __attribute__((ext_vector_type(8)));
typedef short s16x4 __attribute__((ext_vector_type(4)));
#define RLX_AGENT __ATOMIC_RELAXED, __HIP_MEMORY_SCOPE_AGENT
#define LDS_WAIT() asm volatile("s_waitcnt lgkmcnt(0)" ::: "memory")
#define CFENCE() asm volatile("" ::: "memory")
__device__ __forceinline__ unsigned f2bf(float f) { unsigned u = __builtin_bit_cast(unsigned, f); return (u + 0x7fffu + ((u >> 16) & 1u)) >> 16; }
typedef float f32x2_t __attribute__((ext_vector_type(2))); typedef __bf16 bf16x2_t __attribute__((ext_vector_type(2)));
__device__ __forceinline__ unsigned pk2(float lo, float hi) { f32x2_t v = {lo, hi}; bf16x2_t b = __builtin_convertvector(v, bf16x2_t); return __builtin_bit_cast(unsigned, b); }
__device__ __forceinline__ unsigned pk4f8(float a, float b, float c, float d) { int r = 0; r = __builtin_amdgcn_cvt_pk_fp8_f32(a, b, r, false); r = __builtin_amdgcn_cvt_pk_fp8_f32(c, d, r, true); return (unsigned)r; }
constexpr float F8_WSCALE = 64.f, F8_WINV = 1.f / 64.f;
__device__ __forceinline__ float bflo(unsigned w) { return __builtin_bit_cast(float, w << 16); }
__device__ __forceinline__ float bfhi(unsigned w) { return __builtin_bit_cast(float, w & 0xffff0000u); }
__device__ __forceinline__ float sigm(float x) { return 1.f / (1.f + __expf(-x)); }
__device__ __forceinline__ float shx(float v, int mask, int lane) { return __builtin_bit_cast(float, __builtin_amdgcn_ds_bpermute((lane ^ mask) << 2, __builtin_bit_cast(int, v))); }
__device__ __forceinline__ float wave_sum(float v, int lane) {
#pragma unroll
    for (int o = 1; o < 64; o <<= 1) v += shx(v, o, lane);
    return v;
}
__device__ __forceinline__ f32x4 mfma16(bf16x8 a, bf16x8 b, f32x4 c) { return __builtin_amdgcn_mfma_f32_16x16x32_bf16(a, b, c, 0, 0, 0); }
__device__ __forceinline__ s16x4 vtr(const LAS unsigned char* p) { return __builtin_bit_cast(s16x4, __builtin_amdgcn_ds_read_tr16_b64_v4i16((LAS s16x4*)p)); }
__device__ __forceinline__ bf16x8 cat8(s16x4 lo, s16x4 hi) { return __builtin_shufflevector(lo, hi, 0, 1, 2, 3, 4, 5, 6, 7); }
__device__ __forceinline__ bf16x8 pack8(f32x4 a, f32x4 b) { v4u w; w.x = pk2(a[0], a[1]); w.y = pk2(a[2], a[3]); w.z = pk2(b[0], b[1]); w.w = pk2(b[2], b[3]); return __builtin_bit_cast(bf16x8, w); }
__device__ __forceinline__ float rstd16(const float* ssqp, size_t row) { const f32x4* p = (const f32x4*)(ssqp + row * 16); const f32x4 a = p[0], b = p[1], c = p[2], d = p[3];
    const float s = ((a[0] + a[1]) + (a[2] + a[3])) + ((b[0] + b[1]) + (b[2] + b[3])) + ((c[0] + c[1]) + (c[2] + c[3])) + ((d[0] + d[1]) + (d[2] + d[3])); return rsqrtf(s * (1.f / 1024.f) + 1e-5f); }
__device__ __forceinline__ unsigned ld_agent(const unsigned* p) { return __hip_atomic_load(p, RLX_AGENT); }


#define XB_TMO      128
#define XB_XCNT(j)  (256  + 64 * (j))
#define XB_XSUB(j)  (1280 + 64 * (j))
#define XB_XGEN(j)  (2304 + 64 * (j))
#define XB_TOP      3328
#define XB_TOPGEN   3392
#define XCD_BAR_WORDS 3456
#define XB_SPIN_CAP (1u << 18)

__device__ __forceinline__ unsigned xb_ld(unsigned* p)              { return __hip_atomic_load(p, __ATOMIC_RELAXED, __HIP_MEMORY_SCOPE_AGENT); }
__device__ __forceinline__ unsigned xb_add(unsigned* p, unsigned v) { return __hip_atomic_fetch_add(p, v, __ATOMIC_RELAXED, __HIP_MEMORY_SCOPE_AGENT); }
__device__ __forceinline__ unsigned xb_xcc_id() { return (unsigned)__builtin_amdgcn_s_getreg((3 << 11) | 20) & 0xFu; }
#define XB_SPIN(cond, bar) do { unsigned _sp = 0; while (cond) { __builtin_amdgcn_s_sleep(1); \
    if ((++_sp & 255u) == 0u) { if (xb_ld(&(bar)[XB_TMO])) break; if (_sp > XB_SPIN_CAP) { atomicAdd(&(bar)[XB_TMO], 1u); break; } } } } while (0)

struct XcdBarrier {
    unsigned* bar; unsigned x; int t0;
    volatile LAS unsigned* st;
};

__device__ __forceinline__ bool xb_is_t0(int wave) { return wave == 0 && __builtin_amdgcn_mbcnt_hi(~0u, __builtin_amdgcn_mbcnt_lo(~0u, 0u)) == 0u; }
__device__ __forceinline__ XcdBarrier xcd_barrier_post(unsigned* bar, volatile LAS unsigned* st, int wave) {
    XcdBarrier b; b.bar = bar; b.x = xb_xcc_id(); b.st = st; b.t0 = wave;
    if (xb_is_t0(wave)) (void)xb_add(&bar[XB_XCNT(b.x)], 1u);
    return b;
}
__device__ __forceinline__ void xcd_barrier_complete(unsigned* bar, unsigned x, unsigned& nloc, unsigned& nx) {
    const unsigned G = gridDim.x * gridDim.y * gridDim.z;
    unsigned sum, cnt, mine, sp = 0u;
    for (;;) {
        sum = 0u; cnt = 0u; mine = 0u;
#pragma unroll
        for (unsigned j = 0; j < 16; ++j) { const unsigned c = xb_ld(&bar[XB_XCNT(j)]); sum += c; cnt += (c > 0u) ? 1u : 0u; mine = (j == x) ? c : mine; }
        if (sum == G) break;
        __builtin_amdgcn_s_sleep(1);
        if ((++sp & 255u) == 0u) { if (xb_ld(&bar[XB_TMO])) break; if (sp > XB_SPIN_CAP) { atomicAdd(&bar[XB_TMO], 1u); break; } }
    }
    nloc = mine > 0u ? mine : 1u; nx = cnt > 0u ? cnt : 1u;
}

__device__ __forceinline__ void xcd_barrier(const XcdBarrier& b) {
    asm volatile("s_waitcnt vmcnt(0)" ::: "memory");
    __syncthreads();
    if (xb_is_t0(b.t0)) {
        unsigned* bar = b.bar;
        __builtin_amdgcn_s_waitcnt(0);
        unsigned nloc = b.st[0], nx = b.st[1];
        if (nloc == 0u) { xcd_barrier_complete(bar, b.x, nloc, nx); b.st[0] = nloc; b.st[1] = nx; }
        const unsigned old = xb_add(&bar[XB_XSUB(b.x)], 1u);
        const unsigned gen = old / nloc;
        if (old + 1u == (gen + 1u) * nloc) {
            __builtin_amdgcn_fence(__ATOMIC_RELEASE, "agent");
            asm volatile("s_waitcnt vmcnt(0)" ::: "memory");
            const unsigned og = xb_add(&bar[XB_TOP], 1u);
            const unsigned tg = og / nx;
            if (og + 1u == (tg + 1u) * nx) xb_add(&bar[XB_TOPGEN], 1u);
            else XB_SPIN(xb_ld(&bar[XB_TOPGEN]) == tg, bar);
            __builtin_amdgcn_fence(__ATOMIC_ACQUIRE, "agent");
            xb_add(&bar[XB_XGEN(b.x)], 1u);
            asm volatile("s_waitcnt vmcnt(0)" ::: "memory");
        } else {
            XB_SPIN(xb_ld(&bar[XB_XGEN(b.x)]) == gen, bar);
            __builtin_amdgcn_fence(__ATOMIC_ACQUIRE, "agent");
            asm volatile("s_waitcnt vmcnt(0)" ::: "memory");
        }
    }
    __syncthreads();
}

struct Args {
    const float* in[25];
    float* out; unsigned char* ws;
    int ph_lo, ph_hi;
};

using pg8::Unit;
struct EpiStore {
    static constexpr bool PERM = true, AFTER_DRAIN = false;
    bf16* O; int ldc; const float* ssq;
    __device__ __forceinline__ void operator()(const f32x4 (&acc)[2][2][4][2], const Unit& u, int wr, int wc, int fr, int fq) const {
        const int row0 = u.pm * 256 + wr * 64 + fr, col0 = u.pn * 256 + wc * 32 + 8 * fq;
#pragma unroll
        for (int ai = 0; ai < 2; ++ai) { float sc[4];
#pragma unroll
            for (int m = 0; m < 4; ++m) sc[m] = ssq ? rstd16(ssq, (size_t)(row0 + ai * 128 + m * 16)) : 1.f;
#pragma unroll
            for (int m = 0; m < 4; ++m) { const int row = row0 + ai * 128 + m * 16; bf16* rowp = O + (size_t)row * ldc + col0;
#pragma unroll
                for (int bj = 0; bj < 2; ++bj) { const f32x4 v0 = acc[ai][bj][m][0] * sc[m], v1 = acc[ai][bj][m][1] * sc[m];
                    v4u w; w.x = pk2(v0[0], v0[1]); w.y = pk2(v0[2], v0[3]); w.z = pk2(v1[0], v1[1]); w.w = pk2(v1[2], v1[3]);
                    *(v4u*)(rowp + bj * 128) = w; } } }
    }
};
template <bool ADD> struct EpiGate {
    static constexpr bool PERM = true, AFTER_DRAIN = false;
    bf16* T; const bf16* proj; int gcol; const float* bias;
    __device__ __forceinline__ void operator()(const f32x4 (&acc)[2][2][4][2], const Unit& u, int wr, int wc, int fr, int fq) const {
        const int row0 = u.pm * 256 + wr * 64 + fr, col0 = u.pn * 256 + wc * 32 + 8 * fq;
        f32x4 bv[2][2];
#pragma unroll
        for (int bj = 0; bj < 2; ++bj)
#pragma unroll
            for (int n = 0; n < 2; ++n) bv[bj][n] = *(const f32x4*)(bias + col0 + bj * 128 + 4 * n);
#pragma unroll
        for (int am = 0; am < 4; ++am) { const int ai = am >> 1, mh = am & 1; v4u gw[2][2], tw[2][2];
#pragma unroll
            for (int mm = 0; mm < 2; ++mm)
#pragma unroll
                for (int bj = 0; bj < 2; ++bj) { const int row = row0 + ai * 128 + (2 * mh + mm) * 16; gw[mm][bj] = *(const v4u*)(proj + (size_t)row * NCOL + gcol + col0 + bj * 128);
                    if (ADD) tw[mm][bj] = *(const v4u*)(T + (size_t)row * DM + col0 + bj * 128); }
#pragma unroll
            for (int mm = 0; mm < 2; ++mm)
#pragma unroll
                for (int bj = 0; bj < 2; ++bj) { const int m = 2 * mh + mm; const int row = row0 + ai * 128 + m * 16; const v4u g4 = gw[mm][bj]; float r[8];
                    r[0] = sigm(bflo(g4.x) + bv[bj][0][0]) * acc[ai][bj][m][0][0]; r[1] = sigm(bfhi(g4.x) + bv[bj][0][1]) * acc[ai][bj][m][0][1];
                    r[2] = sigm(bflo(g4.y) + bv[bj][0][2]) * acc[ai][bj][m][0][2]; r[3] = sigm(bfhi(g4.y) + bv[bj][0][3]) * acc[ai][bj][m][0][3];
                    r[4] = sigm(bflo(g4.z) + bv[bj][1][0]) * acc[ai][bj][m][1][0]; r[5] = sigm(bfhi(g4.z) + bv[bj][1][1]) * acc[ai][bj][m][1][1];
                    r[6] = sigm(bflo(g4.w) + bv[bj][1][2]) * acc[ai][bj][m][1][2]; r[7] = sigm(bfhi(g4.w) + bv[bj][1][3]) * acc[ai][bj][m][1][3];
                    if (ADD) { const v4u t4 = tw[mm][bj];
                        r[0] += bflo(t4.x); r[1] += bfhi(t4.x); r[2] += bflo(t4.y); r[3] += bfhi(t4.y); r[4] += bflo(t4.z); r[5] += bfhi(t4.z); r[6] += bflo(t4.w); r[7] += bfhi(t4.w); }
                    v4u w; w.x = pk2(r[0], r[1]); w.y = pk2(r[2], r[3]); w.z = pk2(r[4], r[5]); w.w = pk2(r[6], r[7]);
                    *(v4u*)(T + (size_t)row * DM + col0 + bj * 128) = w; } }
    }
};
template <bool BF> struct EpiResid {
    static constexpr bool PERM = true, AFTER_DRAIN = false;
    const float* base; bf16* obf; float* ssq; unsigned char* f8;
    __device__ __forceinline__ void operator()(const f32x4 (&acc)[2][2][4][2], const Unit& u, int wr, int wc, int fr, int fq) const {
        const int row0 = u.pm * 256 + wr * 64 + fr, col0 = u.pn * 256 + wc * 32 + 8 * fq;
#pragma unroll
        for (int ai = 0; ai < 2; ++ai)
#pragma unroll
            for (int mh = 0; mh < 2; ++mh) { f32x4 b0[2][2], b1[2][2];
#pragma unroll
                for (int mm = 0; mm < 2; ++mm)
#pragma unroll
                    for (int bj = 0; bj < 2; ++bj) { const size_t off = (size_t)(row0 + ai * 128 + (2 * mh + mm) * 16) * DM + col0 + bj * 128;
                        if (BF) { const v4u bw = *(const v4u*)(obf + off); b0[mm][bj] = (f32x4){bflo(bw.x), bfhi(bw.x), bflo(bw.y), bfhi(bw.y)}; b1[mm][bj] = (f32x4){bflo(bw.z), bfhi(bw.z), bflo(bw.w), bfhi(bw.w)}; }
                        else { b0[mm][bj] = *(const f32x4*)(base + off); b1[mm][bj] = *(const f32x4*)(base + off + 4); } }
#pragma unroll
                for (int mm = 0; mm < 2; ++mm) { const int m = 2 * mh + mm; const int row = row0 + ai * 128 + m * 16; float ss = 0.f;
#pragma unroll
                    for (int bj = 0; bj < 2; ++bj) { const size_t off = (size_t)row * DM + col0 + bj * 128;
                        const f32x4 v0 = b0[mm][bj] + acc[ai][bj][m][0], v1 = b1[mm][bj] + acc[ai][bj][m][1];
                        v4u w; w.x = pk2(v0[0], v0[1]); w.y = pk2(v0[2], v0[3]); w.z = pk2(v1[0], v1[1]); w.w = pk2(v1[2], v1[3]);
                        *(v4u*)(obf + off) = w;
                        if (f8) { v2u q; q.x = pk4f8(v0[0], v0[1], v0[2], v0[3]); q.y = pk4f8(v1[0], v1[1], v1[2], v1[3]); *(v2u*)(f8 + off) = q; }
                        ss += ((v0[0] * v0[0] + v0[1] * v0[1]) + (v0[2] * v0[2] + v0[3] * v0[3])) + ((v1[0] * v1[0] + v1[1] * v1[1]) + (v1[2] * v1[2] + v1[3] * v1[3])); }
                    { const int ln_ = fr + 16 * fq; ss += shx(ss, 16, ln_); ss += shx(ss, 32, ln_); }
                    if (fq == 0) ssq[(size_t)row * 16 + (u.pn & 3) * 4 + wc] = ss; } }
    }
};
struct EpiSwiglu {
    static constexpr bool PERM = true, AFTER_DRAIN = false;
    unsigned char* act; const float* bgu; const float* row_rstd;
    __device__ __forceinline__ void operator()(const f32x4 (&acc)[2][2][4][2], const Unit& u, int wr, int wc, int fr, int fq) const {
        const int e = u.pn >> 3, pnl = u.pn & 7;
        const int rr0 = wr * 64 + fr, cl0 = pnl * 128 + wc * 32 + 8 * fq;
        f32x4 bg[2], bl[2]; float rs[2][4];
#pragma unroll
        for (int n = 0; n < 2; ++n) { bg[n] = *(const f32x4*)(bgu + e * 2048 + cl0 + 4 * n); bl[n] = *(const f32x4*)(bgu + e * 2048 + 1024 + cl0 + 4 * n); }
#pragma unroll
        for (int ai = 0; ai < 2; ++ai)
#pragma unroll
            for (int m = 0; m < 4; ++m) rs[ai][m] = row_rstd[u.aux + rr0 + ai * 128 + m * 16] * F8_WINV;
#pragma unroll
        for (int ai = 0; ai < 2; ++ai)
#pragma unroll
            for (int m = 0; m < 4; ++m) { const int row = u.pm * 256 + rr0 + ai * 128 + m * 16;
                float r[8];
#pragma unroll
                for (int n = 0; n < 2; ++n)
#pragma unroll
                    for (int j = 0; j < 4; ++j) { float gl = acc[ai][0][m][n][j] * rs[ai][m] + bg[n][j], li = acc[ai][1][m][n][j] * rs[ai][m] + bl[n][j];
                        gl = fminf(gl, 7.0f); li = fminf(fmaxf(li, -7.0f), 7.0f);
                        r[n * 4 + j] = gl * sigm(1.702f * gl) * (li + 1.0f); }
                v2u w; w.x = pk4f8(r[0], r[1], r[2], r[3]); w.y = pk4f8(r[4], r[5], r[6], r[7]);
                *(v2u*)(act + (size_t)row * DM + cl0) = w; }
    }
};
struct EpiDown {
    static constexpr bool PERM = true, AFTER_DRAIN = false;
    bf16* y; const float* bd; const float* row_gate;
    __device__ __forceinline__ void operator()(const f32x4 (&acc)[2][2][4][2], const Unit& u, int wr, int wc, int fr, int fq) const {
        const int e = u.pn >> 2, pnl = u.pn & 3;
        const int rr0 = wr * 64 + fr, col0 = pnl * 256 + wc * 32 + 8 * fq;
        f32x4 bv[2][2]; float gt[2][4];
#pragma unroll
        for (int bj = 0; bj < 2; ++bj)
#pragma unroll
            for (int n = 0; n < 2; ++n) bv[bj][n] = *(const f32x4*)(bd + e * 1024 + col0 + bj * 128 + 4 * n);
#pragma unroll
        for (int ai = 0; ai < 2; ++ai)
#pragma unroll
            for (int m = 0; m < 4; ++m) gt[ai][m] = row_gate[u.aux + rr0 + ai * 128 + m * 16];
#pragma unroll
        for (int ai = 0; ai < 2; ++ai)
#pragma unroll
            for (int m = 0; m < 4; ++m) { const int row = u.pm * 256 + rr0 + ai * 128 + m * 16;
#pragma unroll
                for (int bj = 0; bj < 2; ++bj) { const f32x4 v0 = (acc[ai][bj][m][0] * F8_WINV + bv[bj][0]) * gt[ai][m], v1 = (acc[ai][bj][m][1] * F8_WINV + bv[bj][1]) * gt[ai][m];
                    v4u w; w.x = pk2(v0[0], v0[1]); w.y = pk2(v0[2], v0[3]); w.z = pk2(v1[0], v1[1]); w.w = pk2(v1[2], v1[3]);
                    *(v4u*)(y + (size_t)row * DM + col0 + bj * 128) = w; } }
    }
};
struct GroupedOrder {
    int nunits, npn, G, c, half; const LAS unsigned* tab; const int* row_tok;
    __device__ __forceinline__ bool next(int i, Unit& u) const {
        const long L = (long)i * G + c; if (L >= nunits) return false;
        const int rb = (int)(L / npn), pn = (int)(L % npn);
        int e = 0;
#pragma unroll 4
        for (int k = 1; k < 32; ++k) e = (rb >= (int)tab[32 + k]) ? k : e;
        e = __builtin_amdgcn_readfirstlane(e);
        const int j = rb - (int)__builtin_amdgcn_readfirstlane(tab[32 + e]), cn = (int)__builtin_amdgcn_readfirstlane(tab[e]) - 256 * j;
        u.pm = rb; u.pn = e * npn + pn; u.aux = (half * 32 + e) * HTOK + 256 * j; u.cnt = cn < 256 ? cn : 256; return true;
    }
    __device__ __forceinline__ void rows(const Unit& u, int RA0, unsigned (&rn)[2][2]) const {
#pragma unroll
        for (int h = 0; h < 2; ++h) { const int r0 = h * 128 + RA0, r1 = r0 + 64, cm = u.cnt - 1;
            rn[h][0] = (unsigned)row_tok[u.aux + (r0 < cm ? r0 : cm)]; rn[h][1] = (unsigned)row_tok[u.aux + (r1 < cm ? r1 : cm)]; }
    }
    __device__ __forceinline__ void a_ready(const Unit&) const {}
    __device__ __forceinline__ void done(const Unit&) const {}
};
constexpr int MOE_TAB_OFF = 131072 + 1024;
__device__ __forceinline__ void moe_tables(const unsigned char* ws, int hb, LAS unsigned char* lds, int tid) {
    LAS unsigned* tab = (LAS unsigned*)(lds + MOE_TAB_OFF); const unsigned* gcnt = (const unsigned*)(ws + WS_GCNT);
    __syncthreads();
    if (tid < 32) tab[tid] = ld_agent(gcnt + (hb * 32 + tid) * 16);
    __syncthreads();
    if (tid == 0) { unsigned acc = 0; for (int e = 0; e < 32; ++e) { tab[32 + e] = acc; acc += (tab[e] + 255u) >> 8; } tab[64] = acc; }
    __syncthreads();
}

constexpr int RING_BYTES = 131072, MISC_OFF = RING_BYTES + 320, LDS_BYTES = 147456;

struct Ctx { LAS unsigned char* lds; int tid, lane, wave, G, gw, ngw; };

struct TItem { f32x4 v[8]; float gv[8]; };
__device__ __forceinline__ void titem_load(TItem& t, const float* W, int N, const float* gain, int k0, int n0, int lane) {
#pragma unroll
    for (int i = 0; i < 8; ++i) { const int kk = 8 * i + (lane >> 3); t.v[i] = *(const f32x4*)(W + (size_t)(k0 + kk) * N + n0 + (lane & 7) * 4); t.gv[i] = gain ? gain[k0 + kk] : 1.f; }
}
__device__ __forceinline__ void titem_to_lds(const TItem& t, LAS float* scr, int lane) {
#pragma unroll
    for (int i = 0; i < 8; ++i) { const int kk = 8 * i + (lane >> 3); LAS float* p = scr + kk * 33 + (lane & 7) * 4;
        p[0] = t.v[i][0] * t.gv[i]; p[1] = t.v[i][1] * t.gv[i]; p[2] = t.v[i][2] * t.gv[i]; p[3] = t.v[i][3] * t.gv[i]; }
    LDS_WAIT();
}
template <class RowMap>
__device__ __forceinline__ void titem_out(int K, bf16* WT, const LAS float* scr, int k0, int n0, int lane, RowMap rm) {
    const int c = lane & 7;
#pragma unroll
    for (int j = 0; j < 4; ++j) { const int n = (lane >> 3) + 8 * j; const LAS float* s = scr + (8 * c) * 33 + n;
        v4u o; o.x = pk2(s[0 * 33], s[1 * 33]); o.y = pk2(s[2 * 33], s[3 * 33]); o.z = pk2(s[4 * 33], s[5 * 33]); o.w = pk2(s[6 * 33], s[7 * 33]);
        *(v4u*)(WT + (size_t)rm(n0 + n) * K + k0 + 8 * c) = o; }
    LDS_WAIT();
}
template <class RowMap>
__device__ __forceinline__ void titem_out8(int K, unsigned char* WT, const LAS float* scr, int k0, int n0, int lane, RowMap rm) {
    const int c = lane & 7;
#pragma unroll
    for (int j = 0; j < 4; ++j) { const int n = (lane >> 3) + 8 * j; const LAS float* s = scr + (8 * c) * 33 + n;
        v2u o; o.x = pk4f8(s[0 * 33] * F8_WSCALE, s[1 * 33] * F8_WSCALE, s[2 * 33] * F8_WSCALE, s[3 * 33] * F8_WSCALE); o.y = pk4f8(s[4 * 33] * F8_WSCALE, s[5 * 33] * F8_WSCALE, s[6 * 33] * F8_WSCALE, s[7 * 33] * F8_WSCALE);
        *(v2u*)(WT + (size_t)rm(n0 + n) * K + k0 + 8 * c) = o; }
    LDS_WAIT();
}
template <class RowMap>
__device__ __forceinline__ void transpose_item(const float* W, int K, int N, bf16* WT, const float* gain, LAS float* scr, int item, int lane, RowMap rm) {
    const int nblk = N / 32, kb = item / nblk, nb = item % nblk, k0 = 64 * kb, n0 = 32 * nb;
    TItem t; titem_load(t, W, N, gain, k0, n0, lane); titem_to_lds(t, scr, lane); titem_out(K, WT, scr, k0, n0, lane, rm);
}
struct RowId { int off; __device__ __forceinline__ int operator()(int n) const { return off + n; } };
struct RowGU { int e; __device__ __forceinline__ int operator()(int n) const { const int j = n & 1023; return e * 2048 + (j >> 7) * 256 + (n >> 10) * 128 + (j & 127); } };

__device__ __forceinline__ void rms_row_to_bf16(const float* xrow, const float* gain, bf16* orow, int lane) {
    const f32x4* xr = (const f32x4*)xrow + lane; const f32x4* gr = (const f32x4*)gain + lane;
    f32x4 v[4]; float s = 0.f;
#pragma unroll
    for (int j = 0; j < 4; ++j) { v[j] = xr[64 * j]; s += (v[j][0] * v[j][0] + v[j][1] * v[j][1]) + (v[j][2] * v[j][2] + v[j][3] * v[j][3]); }
    const float rstd = rsqrtf(wave_sum(s, lane) * (1.f / DM) + RMS_EPS);
    unsigned long long* o8 = (unsigned long long*)orow + lane;
#pragma unroll
    for (int j = 0; j < 4; ++j) { const f32x4 g = gr[64 * j]; const f32x4 w = v[j] * rstd * g;
        o8[64 * j] = (unsigned long long)pk2(w[0], w[1]) | ((unsigned long long)pk2(w[2], w[3]) << 32); }
}

__device__ __forceinline__ void phase_prologue(const Args& a, const Ctx& c) {
    LAS float* scr = (LAS float*)(c.lds + c.wave * 16384);
    unsigned char* ws = a.ws;
    constexpr int I_IN = 16 * (NCOL / 32), I_SQ = 16 * 32, I_R = 16;
    constexpr int NIT = I_IN + 7 * I_SQ + I_R;
    for (int it = c.gw; it < NIT; it += c.ngw) {
        int r = it;
        if (r < I_IN) { transpose_item(a.in[5], DM, NCOL, (bf16*)(ws + WS_WIN), nullptr, scr, r, c.lane, RowId{0}); continue; } r -= I_IN;
        if (r < I_SQ) { transpose_item(a.in[9], DM, DM, (bf16*)(ws + WS_WA), nullptr, scr, r, c.lane, RowId{0}); continue; } r -= I_SQ;
        if (r < I_SQ) { transpose_item(a.in[10], DM, DM, (bf16*)(ws + WS_WB), nullptr, scr, r, c.lane, RowId{0}); continue; } r -= I_SQ;
        if (r < I_SQ) { transpose_item(a.in[11], DM, DM, (bf16*)(ws + WS_WMIX), nullptr, scr, r, c.lane, RowId{0}); continue; } r -= I_SQ;
        if (r < I_SQ) { transpose_item(a.in[13], DM, DM, (bf16*)(ws + WS_WQ), a.in[12], scr, r, c.lane, RowId{0}); continue; } r -= I_SQ;
        if (r < I_SQ) { transpose_item(a.in[14], DM, DM, (bf16*)(ws + WS_WK), nullptr, scr, r, c.lane, RowId{0}); continue; } r -= I_SQ;
        if (r < I_SQ) { transpose_item(a.in[15], DM, DM, (bf16*)(ws + WS_WV), nullptr, scr, r, c.lane, RowId{0}); continue; } r -= I_SQ;
        if (r < I_SQ) { transpose_item(a.in[16], DM, DM, (bf16*)(ws + WS_WO), nullptr, scr, r, c.lane, RowId{0}); continue; } r -= I_SQ;
        transpose_item(a.in[18], DM, NEXP, (bf16*)(ws + WS_WR), a.in[17], scr, r, c.lane, RowId{0});
    }
    { const size_t n8 = (size_t)NBATCH * MEMLEN * DM / 8; const float* mem = a.in[1]; bf16* mb = (bf16*)(ws + WS_MEMBF);
      for (size_t i = (size_t)c.gw * 64 + c.lane; i < n8; i += (size_t)c.ngw * 64) { const f32x4 v0 = *(const f32x4*)(mem + i * 8), v1 = *(const f32x4*)(mem + i * 8 + 4);
          v4u w; w.x = pk2(v0[0], v0[1]); w.y = pk2(v0[2], v0[3]); w.z = pk2(v1[0], v1[1]); w.w = pk2(v1[2], v1[3]); *(v4u*)(mb + i * 8) = w; } }
    if (c.gw == 0) {
        float* lb = (float*)(ws + WS_LB); const float* lbl = a.in[3];
        for (int k = c.lane; k < 1024; k += 64) lb[k] = 1.f / (1.f + expf(lbl[1024 + k] - lbl[k]));
    }
    if (c.gw == 1) {
        float* lut = (float*)(ws + WS_LUT); const float* t5 = a.in[2];
        for (int i = c.lane; i < 16 * 128; i += 64) { const int h = i >> 7, d = i & 127; int b = d;
            if (d >= 16) { b = 16 + (int)(logf((float)d * (1.f / 16.f)) / logf(8.f) * 16.f); b = b < 31 ? b : 31; }
            lut[i] = t5[b * 16 + h]; }
    }
}

__device__ __forceinline__ void phase_norm1(const Args& a, const Ctx& c, int hb) {
    const float* x = a.in[0] + (size_t)hb * HTOK * DM; bf16* xn = (bf16*)(a.ws + WS_TM);
    for (int m = c.gw; m < HTOK; m += c.ngw) rms_row_to_bf16(x + (size_t)m * DM, a.in[4], xn + (size_t)m * DM, c.lane);
}

constexpr int SWA_VB = 32 * 144;
constexpr int SWA_LUT_OFF = 8 * 2 * SWA_VB;
__device__ __forceinline__ void swa_unit(const bf16* proj, bf16* ob, int bl, int kvh, int tt, const LAS float* lut, LAS unsigned char* vbuf, const float* sinks, int lane) {
    const int l15 = lane & 15, g = lane >> 4, q4 = l15 >> 2, p4 = lane & 3;
    const int t0 = tt * 16; const size_t rowb = (size_t)bl * SEQ;
    bf16x8 qf[4][2];
#pragma unroll
    for (int gq = 0; gq < 4; ++gq)
#pragma unroll
        for (int ks = 0; ks < 2; ++ks) qf[gq][ks] = *(const bf16x8*)(proj + (rowb + t0 + l15) * NCOL + C_SQ + (kvh * 4 + gq) * 64 + ks * 32 + 8 * g);
    float mx[4], ls[4]; f32x4 o[4][4];
#pragma unroll
    for (int gq = 0; gq < 4; ++gq) { mx[gq] = sinks[kvh * 4 + gq]; ls[gq] = 1.f;
#pragma unroll
        for (int dt = 0; dt < 4; ++dt) o[gq][dt] = (f32x4){0.f, 0.f, 0.f, 0.f}; }
    for (int c = 0; c < 5; ++c) {
        const int kc = t0 - 144 + 32 * c;
        if (kc + 31 < 0) continue;
        LAS unsigned char* vb = vbuf + (c & 1) * SWA_VB;
#pragma unroll
        for (int i = 0; i < 4; ++i) { const int p = lane + 64 * i, key = p >> 3, d8 = p & 7; int kr = kc + key; kr = kr < 0 ? 0 : kr;
            const v4u vv = *(const v4u*)(proj + (rowb + kr) * NCOL + C_SV + kvh * 64 + d8 * 8);
            *(LAS v4u*)(vb + key * 144 + d8 * 16) = vv; }
        f32x4 s[4][2];
#pragma unroll
        for (int ksub = 0; ksub < 2; ++ksub) { int kr = kc + 16 * ksub + l15; kr = kr < 0 ? 0 : kr;
            const bf16* kp = proj + (rowb + kr) * NCOL + C_SK + kvh * 64 + 8 * g;
            const bf16x8 k0 = *(const bf16x8*)kp, k1 = *(const bf16x8*)(kp + 32);
#pragma unroll
            for (int gq = 0; gq < 4; ++gq) { f32x4 z = (f32x4){0.f, 0.f, 0.f, 0.f}; z = mfma16(k0, qf[gq][0], z); s[gq][ksub] = mfma16(k1, qf[gq][1], z); } }
        bf16x8 pf[4];
#pragma unroll
        for (int gq = 0; gq < 4; ++gq) { const int hq = kvh * 4 + gq; float cm = -1e30f;
#pragma unroll
            for (int ksub = 0; ksub < 2; ++ksub)
#pragma unroll
                for (int r = 0; r < 4; ++r) { const int key = kc + 16 * ksub + 4 * g + r, dist = t0 + l15 - key; const bool ok = (dist >= 0) && (dist < 128) && (key >= 0);
                    const int di = dist < 0 ? 0 : (dist > 127 ? 127 : dist);
                    float v = s[gq][ksub][r] * 0.125f + lut[hq * 128 + di]; v = ok ? v : -1e30f; s[gq][ksub][r] = v; cm = fmaxf(cm, v); }
            cm = fmaxf(cm, shx(cm, 16, lane)); cm = fmaxf(cm, shx(cm, 32, lane));
            const float mn = fmaxf(mx[gq], cm), alpha = __expf(mx[gq] - mn); mx[gq] = mn; float rs = 0.f;
#pragma unroll
            for (int ksub = 0; ksub < 2; ++ksub)
#pragma unroll
                for (int r = 0; r < 4; ++r) { const float p = __expf(s[gq][ksub][r] - mn); s[gq][ksub][r] = p; rs += p; }
            rs += shx(rs, 16, lane); rs += shx(rs, 32, lane);
            ls[gq] = ls[gq] * alpha + rs;
#pragma unroll
            for (int dt = 0; dt < 4; ++dt) o[gq][dt] = o[gq][dt] * alpha;
            pf[gq] = pack8(s[gq][0], s[gq][1]); }
        CFENCE();
#pragma unroll
        for (int dt = 0; dt < 4; ++dt) {
            const s16x4 lo = vtr(vb + (4 * g + q4) * 144 + (16 * dt + 4 * p4) * 2), hi = vtr(vb + (16 + 4 * g + q4) * 144 + (16 * dt + 4 * p4) * 2);
            const bf16x8 vf = cat8(lo, hi);
#pragma unroll
            for (int gq = 0; gq < 4; ++gq) o[gq][dt] = mfma16(vf, pf[gq], o[gq][dt]); }
        CFENCE();
    }
#pragma unroll
    for (int gq = 0; gq < 4; ++gq) { const float inv = 1.f / ls[gq];
#pragma unroll
        for (int dt = 0; dt < 4; ++dt) { const f32x4 v = o[gq][dt] * inv; v2u w; w.x = pk2(v[0], v[1]); w.y = pk2(v[2], v[3]);
            *(v2u*)(ob + (rowb + t0 + l15) * DM + (kvh * 4 + gq) * 64 + 16 * dt + 4 * g) = w; } }
}
__device__ __forceinline__ void phase_swa(const Args& a, const Ctx& c) {
    const bf16* proj = (const bf16*)(a.ws + WS_PROJ); bf16* ob = (bf16*)(a.ws + WS_OB);
    LAS float* lut = (LAS float*)(c.lds + SWA_LUT_OFF); const float* glut = (const float*)(a.ws + WS_LUT);
    for (int i = c.tid; i < 16 * 128; i += 512) lut[i] = glut[i];
    __syncthreads();
    LAS unsigned char* vbuf = c.lds + c.wave * 2 * SWA_VB;
    constexpr int NU = 8 * 4 * 256;
    for (int u = c.gw; u < NU; u += c.ngw) { const int tt = u & 255, kvh = (u >> 8) & 3, bl = u >> 10; swa_unit(proj, ob, bl, kvh, tt, lut, vbuf, a.in[8], c.lane); }
    __syncthreads();
}

constexpr int HG_LF = 0, HG_KP = 33792, HG_VT = 51200, HG_GT = 68608, HG_QP = 70656, HG_SSQ = 88064;
__device__ __forceinline__ void hg_scan(LAS unsigned char* lds, int tid, float (&loc)[16], float& pre, float& Gm, float& Gl) {
    const int ch = tid & 127, grp = tid >> 7;
    const LAS float* LF = (const LAS float*)(lds + HG_LF); LAS float* GT = (LAS float*)(lds + HG_GT);
    float run = 0.f;
#pragma unroll
    for (int i = 0; i < 16; ++i) { run += LF[(16 * grp + i) * 132 + ch]; loc[i] = run; }
    GT[grp * 128 + ch] = run;
    __syncthreads();
    const float g0 = GT[ch], g1 = GT[128 + ch], g2 = GT[256 + ch], g3 = GT[384 + ch];
    pre = (grp > 0 ? g0 : 0.f) + (grp > 1 ? g1 : 0.f) + (grp > 2 ? g2 : 0.f);
    Gm = g0 + g1; Gl = Gm + g2 + g3;
}
__device__ __forceinline__ void phase_hgA(const Args& a, const Ctx& c) {
    const bf16* proj = (const bf16*)(a.ws + WS_PROJ); bf16* US = (bf16*)((unsigned char*)a.out + OUT_US); float* D12 = (float*)(a.ws + WS_D12); const float* lb = (const float*)(a.ws + WS_LB);
    LAS unsigned char* lds = c.lds; const int tid = c.tid, lane = c.lane, w = c.wave;
    const int l15 = lane & 15, g = lane >> 4, q4 = l15 >> 2, p4 = lane & 3;
    constexpr int NU = 8 * 8 * 64;
    int u = blockIdx.x; if (u >= NU) return;
    v4u rf[2], rv[2];
#define HGA_LOAD(uu) do { const int cc_ = (uu) & 63, h_ = ((uu) >> 6) & 7, bl_ = (uu) >> 9; const size_t row0_ = (size_t)bl_ * SEQ + cc_ * 64; \
        _Pragma("unroll") for (int i = 0; i < 2; ++i) { const int p = tid + 512 * i, tok = p >> 4, c8 = p & 15; const bf16* rp = proj + (row0_ + tok) * NCOL + h_ * 128 + c8 * 8; \
            rf[i] = *(const v4u*)(rp + C_HF); rv[i] = *(const v4u*)(rp + C_HI); } } while (0)
    HGA_LOAD(u);
    for (;;) {
        const int h = (u >> 6) & 7;
#pragma unroll
        for (int i = 0; i < 2; ++i) { const int p = tid + 512 * i, tok = p >> 4, c8 = p & 15;
            const f32x4 lb0 = *(const f32x4*)(lb + h * 128 + c8 * 8), lb1 = *(const f32x4*)(lb + h * 128 + c8 * 8 + 4);
            const unsigned fw[4] = {rf[i].x, rf[i].y, rf[i].z, rf[i].w}; f32x4 o0, o1;
#pragma unroll
            for (int j = 0; j < 4; ++j) { const float lbl = j < 2 ? lb0[2 * j] : lb1[2 * j - 4], lbh = j < 2 ? lb0[2 * j + 1] : lb1[2 * j - 3];
                const float fl = lbl + (1.f - lbl) * sigm(bflo(fw[j])), fh = lbh + (1.f - lbh) * sigm(bfhi(fw[j]));
                if (j < 2) { o0[2 * j] = __logf(fl); o0[2 * j + 1] = __logf(fh); } else { o1[2 * j - 4] = __logf(fl); o1[2 * j - 3] = __logf(fh); } }
            LAS float* lfp = (LAS float*)(lds + HG_LF) + tok * 132 + c8 * 8; *(LAS f32x4*)lfp = o0; *(LAS f32x4*)(lfp + 4) = o1;
            *(LAS v4u*)(lds + HG_VT + tok * 272 + c8 * 16) = rv[i]; }
        const int ucur = u; const int un = u + gridDim.x; const bool has_next = un < NU;
        if (has_next) HGA_LOAD(un);
        __syncthreads();
        float loc[16], pre, Gm, Gl; hg_scan(lds, tid, loc, pre, Gm, Gl);
        { const int ch = tid & 127, grp = tid >> 7; LAS bf16* KP = (LAS bf16*)(lds + HG_KP);
#pragma unroll
          for (int i = 0; i < 16; ++i) { const float lfi = loc[i] - (i ? loc[i - 1] : 0.f), G = pre + loc[i];
              const float kp = (1.f - __expf(lfi)) * __expf(fminf(Gm - G, 80.f)); KP[(16 * grp + i) * 136 + ch] = (bf16)f2bf(kp); }
          if (grp == 0) { D12[(size_t)ucur * 256 + ch] = __expf(Gm); D12[(size_t)ucur * 256 + 128 + ch] = __expf(Gl - Gm); } }
        __syncthreads();
        { bf16x8 af[2];
#pragma unroll
          for (int ks = 0; ks < 2; ++ks) { const LAS unsigned char* bp = lds + HG_KP + (32 * ks + 8 * g + q4) * 272 + (16 * w + 4 * p4) * 2; af[ks] = cat8(vtr(bp), vtr(bp + 4 * 272)); }
#pragma unroll
          for (int vt = 0; vt < 8; ++vt) { f32x4 acc = (f32x4){0.f, 0.f, 0.f, 0.f};
#pragma unroll
              for (int ks = 0; ks < 2; ++ks) { const LAS unsigned char* bp = lds + HG_VT + (32 * ks + 8 * g + q4) * 272 + (16 * vt + 4 * p4) * 2; acc = mfma16(af[ks], cat8(vtr(bp), vtr(bp + 4 * 272)), acc); }
              v2u wv; wv.x = pk2(acc[0], acc[1]); wv.y = pk2(acc[2], acc[3]);
              *(v2u*)(US + ((size_t)ucur * 128 + 16 * vt + l15) * 128 + 16 * w + 4 * g) = wv; } }
        __syncthreads();
        if (!has_next) break;
        u = un;
    }
}
__device__ __forceinline__ void phase_hgB(const Args& a, const Ctx& c) {
    bf16* US = (bf16*)((unsigned char*)a.out + OUT_US); const float* D12 = (const float*)(a.ws + WS_D12);
    const int gt = c.gw * 64 + c.lane;
    for (int e = gt; e < 64 * 2048; e += c.ngw * 64) {
        const int bh = e >> 11, r = e & 2047, k8 = r & 15;
        float S[8];
#pragma unroll
        for (int j = 0; j < 8; ++j) S[j] = 0.f;
        for (int c0 = 0; c0 < 64; c0 += 4) {
            v4u uw[4]; f32x4 d1[4][2], d2[4][2];
#pragma unroll
            for (int cc = 0; cc < 4; ++cc) { const size_t un = (size_t)bh * 64 + c0 + cc;
                uw[cc] = *(const v4u*)(US + un * 16384 + (size_t)r * 8);
                d1[cc][0] = *(const f32x4*)(D12 + un * 256 + k8 * 8); d1[cc][1] = *(const f32x4*)(D12 + un * 256 + k8 * 8 + 4);
                d2[cc][0] = *(const f32x4*)(D12 + un * 256 + 128 + k8 * 8); d2[cc][1] = *(const f32x4*)(D12 + un * 256 + 128 + k8 * 8 + 4); }
#pragma unroll
            for (int cc = 0; cc < 4; ++cc) { const size_t un = (size_t)bh * 64 + c0 + cc;
                const unsigned ww[4] = {uw[cc].x, uw[cc].y, uw[cc].z, uw[cc].w}; float sp[8];
#pragma unroll
                for (int j = 0; j < 8; ++j) { const float d1v = d1[cc][j >> 2][j & 3], d2v = d2[cc][j >> 2][j & 3]; const float uv = (j & 1) ? bfhi(ww[j >> 1]) : bflo(ww[j >> 1]);
                    sp[j] = d1v * S[j]; S[j] = d2v * (sp[j] + uv); }
                v4u o; o.x = pk2(sp[0], sp[1]); o.y = pk2(sp[2], sp[3]); o.z = pk2(sp[4], sp[5]); o.w = pk2(sp[6], sp[7]);
                *(v4u*)(US + un * 16384 + (size_t)r * 8) = o; }
        }
    }
}
__device__ __forceinline__ void phase_hgC(const Args& a, const Ctx& c) {
    const bf16* proj = (const bf16*)(a.ws + WS_PROJ); const bf16* US = (const bf16*)((unsigned char*)a.out + OUT_US); bf16* oa = (bf16*)(a.ws + WS_OA);
    const float* lb = (const float*)(a.ws + WS_LB); const float* hgain = a.in[7];
    LAS unsigned char* lds = c.lds; const int tid = c.tid, lane = c.lane, w = c.wave;
    const int l15 = lane & 15, g = lane >> 4, q4 = l15 >> 2, p4 = lane & 3;
    constexpr int NU = 8 * 8 * 64;
    int u = blockIdx.x; if (u >= NU) return;
    v4u rq[2], rf[2], rv[2];
#define HGC_LOAD(uu) do { const int cc_ = (uu) & 63, h_ = ((uu) >> 6) & 7, bl_ = (uu) >> 9; const size_t row0_ = (size_t)bl_ * SEQ + cc_ * 64; \
        _Pragma("unroll") for (int i = 0; i < 2; ++i) { const int p = tid + 512 * i, tok = p >> 4, c8 = p & 15; const bf16* rp = proj + (row0_ + tok) * NCOL + h_ * 128 + c8 * 8; \
            rq[i] = *(const v4u*)(rp + C_HQ); rf[i] = *(const v4u*)(rp + C_HF); rv[i] = *(const v4u*)(rp + C_HI); } } while (0)
    HGC_LOAD(u);
    const f32x4 gn = *(const f32x4*)(hgain + 16 * w + 4 * g);
    for (;;) {
        const int cc = u & 63, h = (u >> 6) & 7, bl = u >> 9; const size_t row0 = (size_t)bl * SEQ + cc * 64;
#pragma unroll
        for (int i = 0; i < 2; ++i) { const int p = tid + 512 * i, tok = p >> 4, c8 = p & 15;
            const f32x4 lb0 = *(const f32x4*)(lb + h * 128 + c8 * 8), lb1 = *(const f32x4*)(lb + h * 128 + c8 * 8 + 4);
            const unsigned fw[4] = {rf[i].x, rf[i].y, rf[i].z, rf[i].w}; f32x4 o0, o1;
#pragma unroll
            for (int j = 0; j < 4; ++j) { const float lbl = j < 2 ? lb0[2 * j] : lb1[2 * j - 4], lbh = j < 2 ? lb0[2 * j + 1] : lb1[2 * j - 3];
                const float fl = lbl + (1.f - lbl) * sigm(bflo(fw[j])), fh = lbh + (1.f - lbh) * sigm(bfhi(fw[j]));
                if (j < 2) { o0[2 * j] = __logf(fl); o0[2 * j + 1] = __logf(fh); } else { o1[2 * j - 4] = __logf(fl); o1[2 * j - 3] = __logf(fh); } }
            LAS float* lfp = (LAS float*)(lds + HG_LF) + tok * 132 + c8 * 8; *(LAS f32x4*)lfp = o0; *(LAS f32x4*)(lfp + 4) = o1;
            *(LAS v4u*)(lds + HG_VT + tok * 272 + c8 * 16) = rv[i];
            *(LAS v4u*)(lds + HG_QP + tok * 272 + c8 * 16) = rq[i]; }
        const int ucur = u; const int un = u + gridDim.x; const bool has_next = un < NU;
        if (has_next) HGC_LOAD(un);
        bf16x8 sf[4];
#pragma unroll
        for (int ks = 0; ks < 4; ++ks) sf[ks] = *(const bf16x8*)(US + ((size_t)ucur * 128 + 16 * w + l15) * 128 + 32 * ks + 8 * g);
        __syncthreads();
        float loc[16], pre, Gm, Gl; hg_scan(lds, tid, loc, pre, Gm, Gl);
        { const int ch = tid & 127, grp = tid >> 7; LAS bf16* KP = (LAS bf16*)(lds + HG_KP); LAS bf16* QP = (LAS bf16*)(lds + HG_QP);
#pragma unroll
          for (int i = 0; i < 16; ++i) { const float lfi = loc[i] - (i ? loc[i - 1] : 0.f), G = pre + loc[i];
              const float kp = (1.f - __expf(lfi)) * __expf(fminf(Gm - G, 80.f)); KP[(16 * grp + i) * 136 + ch] = (bf16)f2bf(kp);
              const float qr = __builtin_bit_cast(float, (unsigned)QP[(16 * grp + i) * 136 + ch] << 16);
              const float qp = qr * sigm(qr) * __expf(fminf(G - Gm, 80.f)); QP[(16 * grp + i) * 136 + ch] = (bf16)f2bf(qp); } }
        __syncthreads();
        f32x4 o[4];
        {
            bf16x8 vf[2];
#pragma unroll
            for (int kk = 0; kk < 2; ++kk) { const LAS unsigned char* bp = lds + HG_VT + (32 * kk + 4 * g + q4) * 272 + (16 * w + 4 * p4) * 2; vf[kk] = cat8(vtr(bp), vtr(bp + 16 * 272)); }
#pragma unroll
            for (int tt = 0; tt < 4; ++tt) {
                bf16x8 qf[4];
#pragma unroll
                for (int ks = 0; ks < 4; ++ks) qf[ks] = *(const LAS bf16x8*)(lds + HG_QP + (16 * tt + l15) * 272 + (32 * ks + 8 * g) * 2);
                f32x4 acc = (f32x4){0.f, 0.f, 0.f, 0.f};
#pragma unroll
                for (int ks = 0; ks < 4; ++ks) acc = mfma16(sf[ks], qf[ks], acc);
                f32x4 at[4];
#pragma unroll
                for (int st = 0; st < 4; ++st) { at[st] = (f32x4){0.f, 0.f, 0.f, 0.f};
                    if (st <= tt) {
#pragma unroll
                        for (int ks = 0; ks < 4; ++ks) { const bf16x8 kf = *(const LAS bf16x8*)(lds + HG_KP + (16 * st + l15) * 272 + (32 * ks + 8 * g) * 2); at[st] = mfma16(kf, qf[ks], at[st]); }
                        if (st == tt) {
#pragma unroll
                            for (int r = 0; r < 4; ++r) at[st][r] = (4 * g + r <= l15) ? at[st][r] : 0.f; } } }
                acc = mfma16(vf[0], pack8(at[0], at[1]), acc);
                if (tt >= 2) acc = mfma16(vf[1], pack8(at[2], at[3]), acc);
                o[tt] = acc; }
        }
        { LAS float* SSQ = (LAS float*)(lds + HG_SSQ);
#pragma unroll
          for (int tt = 0; tt < 4; ++tt) { float s = (o[tt][0] * o[tt][0] + o[tt][1] * o[tt][1]) + (o[tt][2] * o[tt][2] + o[tt][3] * o[tt][3]);
              s += shx(s, 16, lane); s += shx(s, 32, lane); if (g == 0) SSQ[w * 64 + 16 * tt + l15] = s; }
          __syncthreads();
#pragma unroll
          for (int tt = 0; tt < 4; ++tt) { float s = 0.f;
#pragma unroll
              for (int ww = 0; ww < 8; ++ww) s += SSQ[ww * 64 + 16 * tt + l15];
              const float rstd = rsqrtf(s * (1.f / 128.f) + RMS_EPS);
              const size_t row = row0 + 16 * tt + l15;
              const v2u gw = *(const v2u*)(proj + row * NCOL + C_HG + h * 128 + 16 * w + 4 * g);
              const float g0 = bflo(gw.x), g1 = bfhi(gw.x), g2 = bflo(gw.y), g3 = bfhi(gw.y);
              const float r0 = o[tt][0] * rstd * gn[0] * (g0 * sigm(g0)), r1 = o[tt][1] * rstd * gn[1] * (g1 * sigm(g1));
              const float r2 = o[tt][2] * rstd * gn[2] * (g2 * sigm(g2)), r3 = o[tt][3] * rstd * gn[3] * (g3 * sigm(g3));
              v2u wv; wv.x = pk2(r0, r1); wv.y = pk2(r2, r3);
              *(v2u*)(oa + row * DM + h * 128 + 16 * w + 4 * g) = wv; } }
        if (!has_next) break;
        u = un;
    }
    __syncthreads();
}

typedef float f32x16 __attribute__((ext_vector_type(16)));
constexpr int XA_KROW = 528, XA_VROW = 72, XA_KB = 32 * XA_KROW, XA_VB = 256 * XA_VROW, XA_STAGE = XA_KB + XA_VB;
__device__ __forceinline__ void phase_xa(const Args& a, const Ctx& c) {
    const bf16* qg = (const bf16*)(a.ws + WS_Q); bf16* og = (bf16*)(a.ws + WS_O); const bf16* kx = (const bf16*)(a.ws + WS_KX); const bf16* vxt = (const bf16*)(a.ws + WS_VXT);
    LAS unsigned char* lds = c.lds; const int tid = c.tid, lane = c.lane, w = c.wave;
    const int l31 = lane & 31, hh = lane >> 5, qt = w & 3, dh = w >> 2;
    constexpr int NU = NBATCH * 4 * (SEQ / 128);
    int u = blockIdx.x; if (u >= NU) return;
    v4u rk[2], rv[2];
#define XA_LOAD(uu, kc) do { const int b_ = (uu) >> 7, h_ = ((uu) >> 5) & 3; \
        _Pragma("unroll") for (int i = 0; i < 2; ++i) { const int p = tid + 512 * i; \
            rk[i] = *(const v4u*)(kx + (size_t)(b_ * MEMLEN + (kc) * 32 + (p >> 5)) * DM + h_ * 256 + (p & 31) * 8); \
            rv[i] = *(const v4u*)(vxt + (size_t)(h_ * 256 + (p >> 2)) * (NBATCH * MEMLEN) + b_ * MEMLEN + (kc) * 32 + (p & 3) * 8); } } while (0)
#define XA_STORE(buf) do { LAS unsigned char* sb = lds + (buf) * XA_STAGE; \
        _Pragma("unroll") for (int i = 0; i < 2; ++i) { const int p = tid + 512 * i; \
            *(LAS v4u*)(sb + (p >> 5) * XA_KROW + (p & 31) * 16) = rk[i]; \
            LAS v2u* vp = (LAS v2u*)(sb + XA_KB + (p >> 2) * XA_VROW + (p & 3) * 16); v2u lo; lo.x = rv[i].x; lo.y = rv[i].y; v2u hi; hi.x = rv[i].z; hi.y = rv[i].w; vp[0] = lo; vp[1] = hi; } } while (0)
    XA_LOAD(u, 0); XA_STORE(0);
    int par = 0;
    for (;;) {
        const int b = u >> 7, h = (u >> 5) & 3, qb = u & 31;
        const size_t row0 = (size_t)b * SEQ + qb * 128 + qt * 32;
        bf16x8 qf[16];
#pragma unroll
        for (int ks = 0; ks < 16; ++ks) qf[ks] = *(const bf16x8*)(qg + (row0 + l31) * DM + h * 256 + 16 * ks + 8 * hh);
        float mx = -1e30f, ls = 0.f; f32x16 o[4];
#pragma unroll
        for (int dt = 0; dt < 4; ++dt)
#pragma unroll
            for (int r = 0; r < 16; ++r) o[dt][r] = 0.f;
        const int un = u + gridDim.x; const bool has_next = un < NU;
        for (int kc = 0; kc < 8; ++kc) {
            __syncthreads();
            const bool more = (kc < 7) || has_next;
            if (more) { if (kc < 7) XA_LOAD(u, kc + 1); else XA_LOAD(un, 0); }
            const LAS unsigned char* kb = lds + par * XA_STAGE; const LAS unsigned char* vb = kb + XA_KB;
            f32x16 s;
#pragma unroll
            for (int r = 0; r < 16; ++r) s[r] = 0.f;
#pragma unroll
            for (int ks = 0; ks < 16; ++ks) { const bf16x8 kf = *(const LAS bf16x8*)(kb + l31 * XA_KROW + (16 * ks + 8 * hh) * 2); s = __builtin_amdgcn_mfma_f32_32x32x16_bf16(kf, qf[ks], s, 0, 0, 0); }
            float cm = -1e30f;
#pragma unroll
            for (int r = 0; r < 16; ++r) { s[r] *= 0.0625f; cm = fmaxf(cm, s[r]); }
            cm = fmaxf(cm, shx(cm, 32, lane));
            const float mn = fmaxf(mx, cm), alpha = __expf(mx - mn); mx = mn; float rs = 0.f;
#pragma unroll
            for (int r = 0; r < 16; ++r) { s[r] = __expf(s[r] - mn); rs += s[r]; }
            rs += shx(rs, 32, lane); ls = ls * alpha + rs;
#pragma unroll
            for (int dt = 0; dt < 4; ++dt)
#pragma unroll
                for (int r = 0; r < 16; ++r) o[dt][r] *= alpha;
            bf16x8 pf[2];
#pragma unroll
            for (int st = 0; st < 2; ++st) { v4u pw; pw.x = pk2(s[8 * st], s[8 * st + 1]); pw.y = pk2(s[8 * st + 2], s[8 * st + 3]); pw.z = pk2(s[8 * st + 4], s[8 * st + 5]); pw.w = pk2(s[8 * st + 6], s[8 * st + 7]); pf[st] = __builtin_bit_cast(bf16x8, pw); }
#pragma unroll
            for (int dt = 0; dt < 4; ++dt) { const LAS unsigned char* vrow = vb + (128 * dh + 32 * dt + l31) * XA_VROW + 8 * hh;
#pragma unroll
                for (int st = 0; st < 2; ++st) { const s16x4 lo = *(const LAS s16x4*)(vrow + 32 * st), hi = *(const LAS s16x4*)(vrow + 32 * st + 16);
                    o[dt] = __builtin_amdgcn_mfma_f32_32x32x16_bf16(cat8(lo, hi), pf[st], o[dt], 0, 0, 0); } }
            if (more) XA_STORE(par ^ 1);
            par ^= 1;
        }
        const float inv = 1.f / ls;
#pragma unroll
        for (int dt = 0; dt < 4; ++dt)
#pragma unroll
            for (int rg = 0; rg < 4; ++rg) { v2u wv; wv.x = pk2(o[dt][4 * rg] * inv, o[dt][4 * rg + 1] * inv); wv.y = pk2(o[dt][4 * rg + 2] * inv, o[dt][4 * rg + 3] * inv);
                *(v2u*)(og + (row0 + l31) * DM + h * 256 + 128 * dh + 32 * dt + 8 * rg + 4 * hh) = wv; }
        if (!has_next) break;
        u = un;
    }
    __syncthreads();
#undef XA_LOAD
#undef XA_STORE
}

__device__ __forceinline__ void phase_expert_weights(const Args& a, const Ctx& c) {
    LAS float* scr = (LAS float*)(c.lds + c.wave * 16384);
    constexpr int I_GU = 16 * 64, I_D = 16 * 32;
    constexpr int NGU = NEXP * I_GU, NIT = NEXP * (I_GU + I_D);
#define EW_GEO(it, W_, N_, k0_, n0_) const bool gu_##W_ = (it) < NGU; const int r_##W_ = gu_##W_ ? (it) : (it) - NGU; const int e_##W_ = gu_##W_ ? r_##W_ / I_GU : r_##W_ / I_D; \
        const int q_##W_ = gu_##W_ ? r_##W_ % I_GU : r_##W_ % I_D; const int N_ = gu_##W_ ? 2048 : 1024; const int nblk_##W_ = N_ / 32; const int k0_ = 64 * (q_##W_ / nblk_##W_), n0_ = 32 * (q_##W_ % nblk_##W_); \
        const float* W_ = gu_##W_ ? a.in[20] + (size_t)e_##W_ * DM * 2048 : a.in[22] + (size_t)e_##W_ * DM * DM
    int it = c.gw; if (it >= NIT) { __syncthreads(); return; }
    TItem t;
    { EW_GEO(it, W0, N0, k00, n00); titem_load(t, W0, N0, gu_W0 ? a.in[17] : nullptr, k00, n00, c.lane); }
    for (;;) {
        EW_GEO(it, Wc, Nc, k0c, n0c);
        titem_to_lds(t, scr, c.lane);
        const int itn = it + c.ngw; const bool more = itn < NIT;
        if (more) { EW_GEO(itn, Wn, Nn, k0n, n0n); titem_load(t, Wn, Nn, gu_Wn ? a.in[17] : nullptr, k0n, n0n, c.lane); }
        if (gu_Wc) titem_out8(DM, a.ws + WS_WGU, scr, k0c, n0c, c.lane, RowGU{e_Wc});
        else titem_out8(DM, a.ws + WS_WD, scr, k0c, n0c, c.lane, RowId{e_Wc * 1024});
        if (!more) break;
        it = itn;
    }
#undef EW_GEO
    __syncthreads();
}
__device__ __forceinline__ void phase_router(const Args& a, const Ctx& c) {
    const bf16* xb = (const bf16*)(a.ws + WS_XBF); const bf16* wr = (const bf16*)(a.ws + WS_WR); const float* ssq2 = (const float*)(a.ws + WS_SSQ2); const float* br = a.in[19];
    int* tope = (int*)(a.ws + WS_TOPE); float* topg = (float*)(a.ws + WS_TOPG); int* topr = (int*)(a.ws + WS_TOPR); unsigned* gcnt = (unsigned*)(a.ws + WS_GCNT);
    LAS unsigned char* lds = c.lds; const int lane = c.lane, w = c.wave, l15 = lane & 15, g = lane >> 4;
    LAS float* LG = (LAS float*)(lds + w * 4096);
    LAS int* LE = (LAS int*)(lds + w * 4096 + 2560); LAS float* LGT = (LAS float*)(lds + w * 4096 + 2816);
    int* rtok = (int*)(a.ws + WS_RTOK); float* rgate = (float*)(a.ws + WS_RGATE2); float* rrstd = (float*)(a.ws + WS_RRSTD2);
    LAS unsigned* CNT = (LAS unsigned*)(lds + 32768); LAS unsigned* BASE = CNT + 32;
    for (int it = blockIdx.x; it < NTOK / 128; it += gridDim.x) {
        const int tok0 = it * 128 + w * 16; const int half = tok0 >= HTOK;
        if (c.tid < 32) CNT[c.tid] = 0u;
        f32x4 acc[2] = {(f32x4){0.f, 0.f, 0.f, 0.f}, (f32x4){0.f, 0.f, 0.f, 0.f}};
        const bf16* ap = xb + (size_t)(tok0 + l15) * DM + 8 * g;
#pragma unroll 8
        for (int ks = 0; ks < 32; ++ks) { const bf16x8 af = *(const bf16x8*)(ap + 32 * ks);
#pragma unroll
            for (int nt = 0; nt < 2; ++nt) { const bf16x8 bf = *(const bf16x8*)(wr + (size_t)(16 * nt + l15) * DM + 32 * ks + 8 * g); acc[nt] = mfma16(af, bf, acc[nt]); } }
#pragma unroll
        for (int nt = 0; nt < 2; ++nt)
#pragma unroll
            for (int r = 0; r < 4; ++r) { const int t = 4 * g + r; const float rs = rstd16(ssq2, (size_t)(tok0 + t)); LG[t * 33 + 16 * nt + l15] = acc[nt][r] * rs + br[16 * nt + l15]; }
        LDS_WAIT();
        if (lane < 16) { float v[32];
#pragma unroll
            for (int e = 0; e < 32; ++e) v[e] = LG[lane * 33 + e];
            int se[4]; float sv[4];
#pragma unroll
            for (int k = 0; k < 4; ++k) { float best = -3e38f; int bi = 0;
#pragma unroll
                for (int e = 0; e < 32; ++e) { const bool bt = v[e] > best; best = bt ? v[e] : best; bi = bt ? e : bi; }
                se[k] = bi; sv[k] = best;
#pragma unroll
                for (int e = 0; e < 32; ++e) v[e] = (e == bi) ? -3e38f : v[e]; }
            const float e1 = __expf(sv[1] - sv[0]), e2 = __expf(sv[2] - sv[0]), e3 = __expf(sv[3] - sv[0]); const float inv = 1.f / (1.f + e1 + e2 + e3);
            const int tok = tok0 + lane;
            *(int4*)(tope + (size_t)tok * 4) = make_int4(se[0], se[1], se[2], se[3]);
            *(float4*)(topg + (size_t)tok * 4) = make_float4(inv, e1 * inv, e2 * inv, e3 * inv);
#pragma unroll
            for (int k = 0; k < 4; ++k) LE[lane * 4 + k] = se[k];
            LGT[lane * 4 + 0] = inv; LGT[lane * 4 + 1] = e1 * inv; LGT[lane * 4 + 2] = e2 * inv; LGT[lane * 4 + 3] = e3 * inv; }
        __syncthreads();
        const int myE = LE[lane];
        const unsigned lr = atomicAdd((unsigned*)&CNT[myE], 1u);
        __syncthreads();
        if (c.tid < 32) { const unsigned n = CNT[c.tid]; BASE[c.tid] = n ? atomicAdd(gcnt + (half * 32 + c.tid) * 16, n) : 0u; }
        __syncthreads();
        { const int rank = (int)(BASE[myE] + lr), tok = tok0 + (lane >> 2); topr[(size_t)tok * 4 + (lane & 3)] = rank;
          const size_t ri = (size_t)(half * 32 + myE) * HTOK + rank; rtok[ri] = tok; rgate[ri] = LGT[lane]; rrstd[ri] = rstd16(ssq2, (size_t)tok); }
        __syncthreads();
    }
}
__device__ __forceinline__ void add16(f32x4 (&v)[4], const v4u y0, const v4u y1) {
    v[0][0] += bflo(y0.x); v[0][1] += bfhi(y0.x); v[0][2] += bflo(y0.y); v[0][3] += bfhi(y0.y); v[1][0] += bflo(y0.z); v[1][1] += bfhi(y0.z); v[1][2] += bflo(y0.w); v[1][3] += bfhi(y0.w);
    v[2][0] += bflo(y1.x); v[2][1] += bfhi(y1.x); v[2][2] += bflo(y1.y); v[2][3] += bfhi(y1.y); v[3][0] += bflo(y1.z); v[3][1] += bfhi(y1.z); v[3][2] += bflo(y1.w); v[3][3] += bfhi(y1.w);
}
__device__ __forceinline__ void phase_combine(const Args& a, const Ctx& c, int hb) {
    const bf16* y = (const bf16*)(a.ws + WS_Y); const bf16* xb = (const bf16*)(a.ws + WS_XBF); const int* tope = (const int*)(a.ws + WS_TOPE); const int* topr = (const int*)(a.ws + WS_TOPR); const float* gf = a.in[24];
    moe_tables(a.ws, hb, c.lds, c.tid);
    const LAS unsigned* tab = (const LAS unsigned*)(c.lds + MOE_TAB_OFF);
    for (int i = c.gw; i < HTOK; i += c.ngw) { const int tok = hb * HTOK + i;
        const int4 ee = *(const int4*)(tope + (size_t)tok * 4), rr = *(const int4*)(topr + (size_t)tok * 4);
        const int ps[4] = {(int)tab[32 + ee.x] * 256 + rr.x, (int)tab[32 + ee.y] * 256 + rr.y, (int)tab[32 + ee.z] * 256 + rr.z, (int)tab[32 + ee.w] * 256 + rr.w};
        f32x4 v[4];
#pragma unroll
        for (int j = 0; j < 4; ++j) v[j] = (f32x4){0.f, 0.f, 0.f, 0.f};
        { const v4u* xp = (const v4u*)(xb + (size_t)tok * DM + c.lane * 16); add16(v, xp[0], xp[1]); }
#pragma unroll
        for (int k = 0; k < 4; ++k) { const v4u* yp = (const v4u*)(y + (size_t)ps[k] * DM + c.lane * 16); add16(v, yp[0], yp[1]); }
        float s = 0.f;
#pragma unroll
        for (int j = 0; j < 4; ++j) s += (v[j][0] * v[j][0] + v[j][1] * v[j][1]) + (v[j][2] * v[j][2] + v[j][3] * v[j][3]);
        const float rstd = rsqrtf(wave_sum(s, c.lane) * (1.f / DM) + RMS_EPS);
        float* xr = a.out + (size_t)tok * DM + c.lane * 16;
#pragma unroll
        for (int j = 0; j < 4; ++j) { const f32x4 gg = *(const f32x4*)(gf + c.lane * 16 + 4 * j); *(f32x4*)(xr + 4 * j) = v[j] * rstd * gg; } }
}

#ifndef MK_PER_PHASE_LAUNCH
#define MK_PER_PHASE_LAUNCH 0
#endif
constexpr int NPHASES = 29;
#ifndef MK_OFF
#define MK_OFF 0u
#endif
#define MKP(k) (((MK_OFF >> (k)) & 1u) == 0u)
#define GSCHED PG8_ALIGN, PG8_SP2
typedef const __attribute__((address_space(4))) Args* KArgP;
#if defined(__HIP_DEVICE_COMPILE__)
__device__ __forceinline__ Args ldargs() { KArgP kp = (KArgP)__builtin_amdgcn_kernarg_segment_ptr(); asm volatile("" : "+s"(kp)); Args r;
#pragma unroll
    for (int i = 0; i < 25; ++i) r.in[i] = kp->in[i];
    r.out = kp->out; r.ws = kp->ws; r.ph_lo = kp->ph_lo; r.ph_hi = kp->ph_hi; return r; }
#else
__device__ __forceinline__ Args ldargs() { return Args{}; }
#endif
__global__ void __launch_bounds__(512, 2) mk_fwd(Args a_) {
    extern __shared__ __attribute__((aligned(16))) unsigned char lds_raw[];
    Ctx c; c.lds = (LAS unsigned char*)lds_raw; c.tid = threadIdx.x; c.lane = c.tid & 63; c.wave = __builtin_amdgcn_readfirstlane(c.tid >> 6); const int wv = c.wave;
    c.G = gridDim.x; c.gw = blockIdx.x * 8 + c.wave; c.ngw = c.G * 8;
    volatile LAS unsigned* MISC = (volatile LAS unsigned*)(c.lds + MISC_OFF);
    for (int u = c.tid; u < (LDS_BYTES - RING_BYTES) / 4; u += 512) ((LAS unsigned*)(c.lds + RING_BYTES))[u] = 0u;
    __syncthreads();
    const int ph_lo = a_.ph_lo, ph_hi = a_.ph_hi;
    const bool fused = (ph_hi - ph_lo) > 1;
    unsigned* barw = (unsigned*)a_.ws + CW_BAR;
    XcdBarrier bar; bar.bar = barw; bar.x = 0; bar.st = MISC + 8; bar.t0 = wv;
    if (fused) bar = xcd_barrier_post(barw, MISC + 8, wv);
    int pc = 0;
#define PH_ON (pc >= ph_lo && pc < ph_hi)
#define PH_END do { if (PH_ON && pc + 1 < ph_hi) xcd_barrier(bar); ++pc; OPQ(c); } while (0)
    LAS unsigned char* ring = c.lds;
#define OPQ(cc) do { { unsigned z_ = 0u; asm volatile("" : "+v"(z_)); cc.lane = (int)__builtin_amdgcn_mbcnt_hi(~0u, __builtin_amdgcn_mbcnt_lo(~0u, z_)); } cc.wave = wv; cc.tid = wv * 64 + cc.lane; { int gw_ = (int)blockIdx.x * 8 + wv; asm volatile("" : "+s"(gw_)); cc.gw = gw_; } } while (0)

    if (MKP(0) && PH_ON) { const Args a = ldargs(); unsigned char* ws = a.ws; (void)ws;  phase_prologue(a, c); __syncthreads(); }
    PH_END;
#pragma unroll
    for (int hb = 0; hb < 2; ++hb) {
        const size_t toff = (size_t)hb * HTOK;
        if (MKP(1) && PH_ON) { const Args a = ldargs(); phase_norm1(a, c, hb); }
        PH_END;
        if (MKP(2) && PH_ON) { const Args a = ldargs(); unsigned char* ws = a.ws; (void)ws;  pg8::Gemm g{(const bf16*)(ws + WS_TM), (const bf16*)(ws + WS_WIN), HTOK, NCOL, DM}; pg8::StaticOrder S; S.init(HTOK, NCOL, c.G, (int)blockIdx.x);
            EpiStore E{(bf16*)(ws + WS_PROJ), NCOL, nullptr}; pg8::gemm_phase<EpiStore, pg8::StaticOrder, GSCHED>(ring, g, S, E, wv); }
        PH_END;
        if (MKP(3) && PH_ON) { const Args a = ldargs(); unsigned char* ws = a.ws; (void)ws;  phase_hgA(a, c); }
        PH_END;
        if (MKP(17) && PH_ON) { const Args a = ldargs(); phase_swa(a, c); }
        PH_END;
        if (MKP(4) && PH_ON) { const Args a = ldargs(); phase_hgB(a, c); }
        PH_END;
        if (MKP(5) && PH_ON) { const Args a = ldargs(); phase_hgC(a, c); }
        PH_END;
        if (MKP(6) && PH_ON) { const Args a = ldargs(); unsigned char* ws = a.ws; (void)ws;  pg8::Gemm g{(const bf16*)(ws + WS_OA), (const bf16*)(ws + WS_WA), HTOK, DM, DM}; pg8::StaticOrder S; S.init(HTOK, DM, c.G, (int)blockIdx.x);
            EpiGate<false> E{(bf16*)(ws + WS_TM), (const bf16*)(ws + WS_PROJ), C_GA, a.in[6]}; pg8::gemm_phase<EpiGate<false>, pg8::StaticOrder, GSCHED>(ring, g, S, E, wv); }
        PH_END;
        if (MKP(7) && PH_ON) { const Args a = ldargs(); unsigned char* ws = a.ws; (void)ws;  pg8::Gemm g{(const bf16*)(ws + WS_OB), (const bf16*)(ws + WS_WB), HTOK, DM, DM}; pg8::StaticOrder S; S.init(HTOK, DM, c.G, (int)blockIdx.x);
            EpiGate<true> E{(bf16*)(ws + WS_TM), (const bf16*)(ws + WS_PROJ), C_GB, a.in[6] + DM}; pg8::gemm_phase<EpiGate<true>, pg8::StaticOrder, GSCHED>(ring, g, S, E, wv); }
        PH_END;
        if (MKP(8) && PH_ON) { const Args a = ldargs(); unsigned char* ws = a.ws; (void)ws;  pg8::Gemm g{(const bf16*)(ws + WS_TM), (const bf16*)(ws + WS_WMIX), HTOK, DM, DM}; pg8::StaticOrder S; S.init(HTOK, DM, c.G, (int)blockIdx.x);
            EpiResid<false> E{a.in[0] + toff * DM, (bf16*)(ws + WS_XBF) + toff * DM, (float*)(ws + WS_SSQ1) + toff * 16, nullptr}; pg8::gemm_phase<EpiResid<false>, pg8::StaticOrder, GSCHED>(ring, g, S, E, wv); }
        PH_END;
    }
    if (MKP(9) && PH_ON) { const Args a = ldargs(); unsigned char* ws = a.ws; (void)ws;
        phase_expert_weights(a, c);
        { pg8::Gemm g{(const bf16*)(ws + WS_MEMBF), (const bf16*)(ws + WS_WK), NBATCH * MEMLEN, DM, DM}; pg8::StaticOrder S; S.init(NBATCH * MEMLEN, DM, c.G, (int)blockIdx.x);
          EpiStore E{(bf16*)(ws + WS_KX), DM, nullptr}; pg8::gemm_phase<EpiStore, pg8::StaticOrder, GSCHED>(ring, g, S, E, wv); }
        { pg8::Gemm g{(const bf16*)(ws + WS_WV), (const bf16*)(ws + WS_MEMBF), DM, NBATCH * MEMLEN, DM}; pg8::StaticOrder S; S.init(DM, NBATCH * MEMLEN, c.G, (int)((blockIdx.x + 64) % c.G));
          EpiStore E{(bf16*)(ws + WS_VXT), NBATCH * MEMLEN, nullptr}; pg8::gemm_phase<EpiStore, pg8::StaticOrder, GSCHED>(ring, g, S, E, wv); }
        { pg8::Gemm g{(const bf16*)(ws + WS_XBF), (const bf16*)(ws + WS_WQ), NTOK, DM, DM}; pg8::StaticOrder S; S.init(NTOK, DM, c.G, (int)blockIdx.x);
          EpiStore E{(bf16*)(ws + WS_Q), DM, (const float*)(ws + WS_SSQ1)}; pg8::gemm_phase<EpiStore, pg8::StaticOrder, GSCHED>(ring, g, S, E, wv); }
    }
    PH_END;
    if (MKP(10) && PH_ON) { const Args a = ldargs(); phase_xa(a, c); }
    PH_END;
    if (MKP(11) && PH_ON) { const Args a = ldargs(); unsigned char* ws = a.ws; (void)ws;  pg8::Gemm g{(const bf16*)(ws + WS_O), (const bf16*)(ws + WS_WO), NTOK, DM, DM}; pg8::StaticOrder S; S.init(NTOK, DM, c.G, (int)blockIdx.x);
        EpiResid<true> E{nullptr, (bf16*)(ws + WS_XBF), (float*)(ws + WS_SSQ2), ws + WS_X2F8}; pg8::gemm_phase<EpiResid<true>, pg8::StaticOrder, GSCHED>(ring, g, S, E, wv); }
    PH_END;
    if (MKP(12) && PH_ON) { const Args a = ldargs(); phase_router(a, c); }
    PH_END;
#pragma unroll
    for (int hb = 0; hb < 2; ++hb) {
        if (MKP(14) && PH_ON) { const Args a = ldargs(); unsigned char* ws = a.ws; moe_tables(ws, hb, c.lds, c.tid);
            const LAS unsigned* tab = (const LAS unsigned*)(c.lds + MOE_TAB_OFF); const int nb = (int)__builtin_amdgcn_readfirstlane(tab[64]);
            pg8::Gemm g{(const bf16*)(ws + WS_X2F8), (const bf16*)(ws + WS_WGU), NTOK, NEXP * 2048, DM};              GroupedOrder S{nb * 8, 8, c.G, (int)blockIdx.x, hb, tab, (const int*)(ws + WS_RTOK)};
            EpiSwiglu E{ws + WS_ACT, a.in[21], (const float*)(ws + WS_RRSTD2)}; pg8::gemm_phase_gather8<EpiSwiglu, GroupedOrder>(ring, g, S, E, wv); }
        PH_END;
        if (MKP(15) && PH_ON) { const Args a = ldargs(); unsigned char* ws = a.ws; moe_tables(ws, hb, c.lds, c.tid);
            const LAS unsigned* tab = (const LAS unsigned*)(c.lds + MOE_TAB_OFF); const int nb = (int)__builtin_amdgcn_readfirstlane(tab[64]);
            pg8::Gemm g{(const bf16*)(ws + WS_ACT), (const bf16*)(ws + WS_WD), CAPH, NEXP * 1024, DM}; GroupedOrder S{nb * 4, 4, c.G, (int)blockIdx.x, hb, tab, (const int*)(ws + WS_RTOK)};
            EpiDown E{(bf16*)(ws + WS_Y), a.in[23], (const float*)(ws + WS_RGATE2)}; pg8::gemm_phase8<EpiDown, GroupedOrder, GSCHED>(ring, g, S, E, wv); }
        PH_END;
        if (MKP(16) && PH_ON) { const Args a = ldargs(); phase_combine(a, c, hb); }
        PH_END;
    }
#undef PH_ON
#undef PH_END
}

#if defined(MK_DBG_STOP)
#ifndef MK_DBG_SRC_OUT
#define MK_DBG_SRC_OUT 0
#endif
#ifndef MK_DBG_F32
#define MK_DBG_F32 0
#endif
__global__ void dbg_dump(const unsigned short* src, float* out, size_t n, size_t N) {
    for (size_t i = (size_t)blockIdx.x * blockDim.x + threadIdx.x; i < N; i += (size_t)gridDim.x * blockDim.x) {
        if (i < n) { float v = MK_DBG_F32 ? ((const float*)src)[i] : __builtin_bit_cast(float, (unsigned)src[i] << 16); if (!(fabsf(v) < 1e30f)) v = 12345.f; out[i] = v; }
        else if (!MK_DBG_SRC_OUT) out[i] = 0.f;
    }
}
__global__ void dbg_zero_upper(float* out, size_t n0, size_t N) { for (size_t i = n0 + (size_t)blockIdx.x * blockDim.x + threadIdx.x; i < N; i += (size_t)gridDim.x * blockDim.x) out[i] = 0.f; }
#endif
extern "C" void kernel_launch(void* const* d_in, const int* in_sizes, int n_in, void* d_out, int out_size, void* d_ws, size_t ws_size, hipStream_t stream) {
    static int grid = 0;
    if (grid == 0) {
        if (n_in != 25 || out_size != NTOK * DM || ws_size < WS_END) { fprintf(stderr, "kernel_launch: unexpected problem shape (n_in %d, out %d, ws %zu); nothing launched\n", n_in, out_size, ws_size); grid = -1; return; }
        int dev = 0, cus = 0, per_cu = 0;
        if (hipGetDevice(&dev) != hipSuccess || hipDeviceGetAttribute(&cus, hipDeviceAttributeMultiprocessorCount, dev) != hipSuccess) { grid = -1; return; }
        if (hipFuncSetAttribute((const void*)mk_fwd, hipFuncAttributeMaxDynamicSharedMemorySize, LDS_BYTES) != hipSuccess) { fprintf(stderr, "kernel_launch: hipFuncSetAttribute failed\n"); grid = -1; return; }
        if (hipOccupancyMaxActiveBlocksPerMultiprocessor(&per_cu, (const void*)mk_fwd, 512, LDS_BYTES) != hipSuccess || per_cu < 1) { fprintf(stderr, "kernel_launch: occupancy query reports %d blocks per CU\n", per_cu); }
        (void)hipGetLastError();
        grid = cus;
    }
    if (grid < 0) return;
    (void)in_sizes;
    hipMemsetAsync(d_ws, 0, WS_ZERO_BYTES, stream);
    Args a{};
    for (int i = 0; i < 25; ++i) a.in[i] = (const float*)d_in[i];
    a.out = (float*)d_out; a.ws = (unsigned char*)d_ws;
#if defined(MK_DBG_STOP)
    for (int p = 0; p < MK_DBG_STOP; ++p) { a.ph_lo = p; a.ph_hi = p + 1; hipLaunchKernelGGL(mk_fwd, dim3(grid), dim3(512), LDS_BYTES, stream, a); }
    hipLaunchKernelGGL(dbg_dump, dim3(2048), dim3(256), 0, stream, (const unsigned short*)((const unsigned char*)(MK_DBG_SRC_OUT ? d_out : d_ws) + (size_t)MK_DBG_OFF_MIB * MiB), (float*)d_out, (size_t)MK_DBG_MIB * MiB / (MK_DBG_F32 ? 4 : 2), (size_t)NTOK * DM);
    if (MK_DBG_SRC_OUT) hipLaunchKernelGGL(dbg_zero_upper, dim3(2048), dim3(256), 0, stream, (float*)d_out, (size_t)MK_DBG_MIB * MiB / 2, (size_t)NTOK * DM);
#elif MK_PER_PHASE_LAUNCH
    for (int p = 0; p < NPHASES; ++p) { a.ph_lo = p; a.ph_hi = p + 1; hipLaunchKernelGGL(mk_fwd, dim3(grid), dim3(512), LDS_BYTES, stream, a);
#if defined(MK_REP_PC)
        if (p == MK_REP_PC) for (int r = 0; r < MK_REP_N; ++r) { if (p == 22 && false) (void)hipMemsetAsync((char*)d_ws + WS_GCNT, 0, 4096, stream); hipLaunchKernelGGL(mk_fwd, dim3(grid), dim3(512), LDS_BYTES, stream, a); }
#endif
    }
#else
    a.ph_lo = 0; a.ph_hi = NPHASES;
    hipLaunchKernelGGL(mk_fwd, dim3(grid), dim3(512), LDS_BYTES, stream, a);
#endif
}
```

```cpp
#include <hip/hip_runtime.h>
#include <cstdio>
#include <cstdint>
namespace pg8 {
#define PG8_LAS __attribute__((address_space(3)))
typedef unsigned short bf16_t;
typedef short bf16x8 __attribute__((ext_vector_type(8)));
typedef float f32x4 __attribute__((ext_vector_type(4)));
typedef unsigned u32x4 __attribute__((ext_vector_type(4)));
constexpr int BM = 256, BK = 64, HALF = 128, HTB = HALF * BK * 2  , STAGE_BYTES = 8 * HTB, NXCD = 8, WGM = 8;

__host__ __device__ __forceinline__ int lds_byte(int r, int c) { const int st = (r >> 4) * 2 + (c >> 5), rr = r & 15, cc = c & 31, ob = rr * 64 + cc * 2; return st * 1024 + (ob ^ (((ob >> 9) & 1) << 5)); }
__host__ __device__ __forceinline__ void stage_rc(int b, int& R, int& C) { const int st = b / 1024, sb = b % 1024, swz = sb ^ (((sb >> 9) & 1) << 5); R = (st >> 1) * 16 + swz / 64; C = (st & 1) * 32 + (swz % 64) / 2; }
__host__ __device__ __forceinline__ int perm32(int rho) { const int n = rho >> 4, i = rho & 15; return 8 * (i >> 2) + 4 * n + (i & 3); }

struct Unit { int pm, pn, aux, cnt; };
struct Gemm { const bf16_t* A; const bf16_t* Bt; int M, N, K; };

struct StaticOrder {
    int nM, nN, nwg, G, c;
    __host__ __device__ void init(int M, int N, int G_, int c_) { nM = M / BM; nN = N / BM; nwg = nM * nN; G = G_; c = c_; }
    __host__ __device__ bool next(int i, Unit& u) const {
        const long L = (long)i * G + c; if (L >= nwg) return false;
        int wgid = (int)L; { const int q = nwg / NXCD, r = nwg % NXCD, xcd = wgid % NXCD, off = wgid / NXCD; wgid = (xcd < r ? xcd * (q + 1) : r * (q + 1) + (xcd - r) * q) + off; }
        const int nig = WGM * nN, gid = wgid / nig, fm = gid * WGM, gsz = (nM - fm) < WGM ? (nM - fm) : WGM;
        u.pm = fm + ((wgid % nig) % gsz); u.pn = (wgid % nig) / gsz; return true;
    }
    __device__ __forceinline__ void a_ready(const Unit&) const {}
    __device__ __forceinline__ void done(const Unit&) const {}
};

__device__ __forceinline__ unsigned cvt_pk_bf16(float lo, float hi) { unsigned r; asm volatile("v_cvt_pk_bf16_f32 %0, %1, %2" : "=v"(r) : "v"(lo), "v"(hi)); return r; }
typedef float f32x2 __attribute__((ext_vector_type(2)));
template <class Epi, class Sched, bool ALIGN_EPI = false, bool SP2 = false>
__device__ __forceinline__ void gemm_phase(PG8_LAS unsigned char* lds, const Gemm g, const Sched& S, const Epi& E, const int wave_in) {
    unsigned z_ = 0u; asm volatile("" : "+v"(z_)); const int tid_ = (int)__builtin_amdgcn_mbcnt_hi(~0u, __builtin_amdgcn_mbcnt_lo(~0u, z_)) + 64 * wave_in;
    const int tid = tid_, wid = __builtin_amdgcn_readfirstlane(tid >> 6), lane = tid & 63, wr = wid >> 2, wc = wid & 3, fr = lane & 15, fq = lane >> 4;
    const int K = g.K, nt = K / BK;
    unsigned voffA[2], voffB[2];
#pragma unroll
    for (int i = 0; i < 2; ++i) { int R, C; stage_rc(tid * 16 + i * 8192, R, C); const int Rb = Epi::PERM ? ((R & ~31) + perm32(R & 31)) : R;
        voffA[i] = (unsigned)(R * K + C) * 2u; voffB[i] = (unsigned)(Rb * K + C) * 2u; }
    const size_t kstep = (size_t)(BK * 2);
    const size_t hstep = (size_t)HALF * K * 2;
    const size_t tstep = 2 * hstep;
    const unsigned ldsw = (unsigned)wid * 1024u;
    const int aoff = lds_byte(wr * 64 + fr, fq * 8), boff = lds_byte(wc * 32 + fr, fq * 8);
#define PG8_SA(b, h) (((b) * 2 + (h)) * HTB)
#define PG8_SB(b, h) ((4 + (b) * 2 + (h)) * HTB)
#define PG8_STAGE(bufoff, gbase, voff) do { _Pragma("unroll") for (int _i = 0; _i < 2; ++_i) \
        __builtin_amdgcn_global_load_lds((const unsigned*)((const char*)(gbase) + (voff)[_i]), (PG8_LAS unsigned*)(lds + (bufoff) + ldsw + _i * 8192), 16, 0, 0); } while (0)
#define PG8_LDA(dst, b, h) do { _Pragma("unroll") for (int m = 0; m < 4; ++m) _Pragma("unroll") for (int k = 0; k < 2; ++k) dst[m][k] = *(const PG8_LAS bf16x8*)(lds + PG8_SA(b, h) + aoff + m * 2048 + k * 1024); } while (0)
#define PG8_LDB(dst, b, h) do { _Pragma("unroll") for (int n = 0; n < 2; ++n) _Pragma("unroll") for (int k = 0; k < 2; ++k) dst[n][k] = *(const PG8_LAS bf16x8*)(lds + PG8_SB(b, h) + boff + n * 2048 + k * 1024); } while (0)
#define PG8_MMA(ai, bj, At, Bt) do { __builtin_amdgcn_s_setprio(1); _Pragma("unroll") for (int m = 0; m < 4; ++m) _Pragma("unroll") for (int n = 0; n < 2; ++n) _Pragma("unroll") for (int k = 0; k < 2; ++k) \
        acc[ai][bj][m][n] = __builtin_amdgcn_mfma_f32_16x16x32_bf16(Bt[n][k], At[m][k], acc[ai][bj][m][n], 0, 0, 0); __builtin_amdgcn_s_setprio(0); } while (0)
#define PG8_WAIT_V(n) asm volatile("s_waitcnt vmcnt(" #n ")" ::: "memory")
#define PG8_WAIT_L(n) asm volatile("s_waitcnt lgkmcnt(" #n ")" ::: "memory")
#define PG8_BAR __builtin_amdgcn_s_barrier()
#define PG8_SCHED __builtin_amdgcn_sched_barrier(0)
    Unit cur, nxt; int ui = 0;
    if (!S.next(0, cur)) return;
    f32x4 acc[2][2][4][2];
#pragma unroll
    for (int a = 0; a < 2; ++a)
#pragma unroll
        for (int b = 0; b < 2; ++b)
#pragma unroll
            for (int m = 0; m < 4; ++m)
#pragma unroll
                for (int n = 0; n < 2; ++n) acc[a][b][m][n] = (f32x4){0.f, 0.f, 0.f, 0.f};
    bf16x8 At[4][2], B0[2][2], B1[2][2];
    const char* cA = (const char*)g.A + (size_t)cur.pm * tstep; const char* cB = (const char*)g.Bt + (size_t)cur.pn * tstep;
    S.a_ready(cur);
    if constexpr (SP2) {
        PG8_STAGE(PG8_SB(0, 0), cB, voffB); PG8_STAGE(PG8_SB(0, 1), cB + hstep, voffB); PG8_STAGE(PG8_SA(0, 0), cA, voffA); PG8_STAGE(PG8_SA(0, 1), cA + hstep, voffA);
        if (wr == 1) PG8_BAR;
        PG8_WAIT_V(2); PG8_BAR;
        PG8_STAGE(PG8_SB(1, 0), cB + kstep, voffB); PG8_STAGE(PG8_SA(1, 0), cA + kstep, voffA); PG8_STAGE(PG8_SB(1, 1), cB + hstep + kstep, voffB);
        PG8_WAIT_V(6); PG8_BAR;
    } else {
        PG8_STAGE(PG8_SB(0, 0), cB, voffB); PG8_STAGE(PG8_SA(0, 0), cA, voffA); PG8_STAGE(PG8_SB(0, 1), cB + hstep, voffB); PG8_STAGE(PG8_SA(0, 1), cA + hstep, voffA);
        if (wr == 1) PG8_BAR;
        PG8_WAIT_V(4); PG8_BAR;
        PG8_STAGE(PG8_SB(1, 0), cB + kstep, voffB); PG8_STAGE(PG8_SA(1, 0), cA + kstep, voffA); PG8_STAGE(PG8_SB(1, 1), cB + hstep + kstep, voffB);
        PG8_WAIT_V(6); PG8_BAR;
    }
    for (;;) {
        const bool has_next = S.next(ui + 1, nxt);
        const char* nA = has_next ? (const char*)g.A + (size_t)nxt.pm * tstep : cA; const char* nB = has_next ? (const char*)g.Bt + (size_t)nxt.pn * tstep : cB;
        for (int t = 0; t < nt; t += 2) {
            const bool last = (t == nt - 2);
            const char* a1 = cA + (size_t)(t + 1) * kstep;
            const char* a2 = last ? nA : cA + (size_t)(t + 2) * kstep; const char* b2 = last ? nB : cB + (size_t)(t + 2) * kstep;
            const char* a3 = a2 + kstep; const char* b3 = b2 + kstep;
            if (last && has_next) S.a_ready(nxt);
            if constexpr (SP2) {
            PG8_LDB(B0, 0, 0); PG8_LDB(B1, 0, 1); PG8_SCHED; PG8_LDA(At, 0, 0); PG8_STAGE(PG8_SA(1, 1), a1 + hstep, voffA);
            PG8_WAIT_V(8); PG8_WAIT_L(0); PG8_BAR; PG8_MMA(0, 0, At, B0); PG8_MMA(0, 1, At, B1); PG8_BAR; PG8_SCHED;
            PG8_LDA(At, 0, 1); PG8_STAGE(PG8_SB(0, 0), b2, voffB); PG8_STAGE(PG8_SB(0, 1), b2 + hstep, voffB); PG8_STAGE(PG8_SA(0, 0), a2, voffA);
            PG8_WAIT_V(8); PG8_WAIT_L(0); PG8_BAR; PG8_MMA(1, 0, At, B0); PG8_MMA(1, 1, At, B1); PG8_BAR; PG8_SCHED;
            PG8_LDB(B0, 1, 0); PG8_LDB(B1, 1, 1); PG8_SCHED; PG8_LDA(At, 1, 0); PG8_STAGE(PG8_SA(0, 1), a2 + hstep, voffA);
            PG8_WAIT_V(8); PG8_WAIT_L(0); PG8_BAR; PG8_MMA(0, 0, At, B0); PG8_MMA(0, 1, At, B1); PG8_BAR; PG8_SCHED;
            PG8_LDA(At, 1, 1); PG8_STAGE(PG8_SB(1, 0), b3, voffB); PG8_STAGE(PG8_SB(1, 1), b3 + hstep, voffB); PG8_STAGE(PG8_SA(1, 0), a3, voffA);
            PG8_WAIT_V(8); PG8_WAIT_L(0); PG8_BAR; PG8_MMA(1, 0, At, B0); PG8_MMA(1, 1, At, B1); PG8_BAR; PG8_SCHED;
            } else {
            PG8_LDB(B0, 0, 0); PG8_SCHED; PG8_LDA(At, 0, 0); PG8_STAGE(PG8_SA(1, 1), a1 + hstep, voffA);
            PG8_WAIT_L(8); PG8_BAR; PG8_WAIT_L(0); PG8_MMA(0, 0, At, B0); PG8_BAR; PG8_SCHED;
            PG8_LDB(B1, 0, 1); PG8_STAGE(PG8_SB(0, 0), b2, voffB);
            PG8_BAR; PG8_WAIT_L(0); PG8_MMA(0, 1, At, B1); PG8_BAR;
            PG8_LDA(At, 0, 1); PG8_STAGE(PG8_SA(0, 0), a2, voffA);
            PG8_BAR; PG8_WAIT_L(0); PG8_MMA(1, 0, At, B0); PG8_BAR; PG8_SCHED;
            PG8_STAGE(PG8_SB(0, 1), b2 + hstep, voffB);
            PG8_WAIT_V(6); PG8_BAR; PG8_MMA(1, 1, At, B1); PG8_BAR;
            PG8_LDB(B0, 1, 0); PG8_SCHED; PG8_LDA(At, 1, 0); PG8_STAGE(PG8_SA(0, 1), a2 + hstep, voffA);
            PG8_WAIT_L(8); PG8_BAR; PG8_WAIT_L(0); PG8_MMA(0, 0, At, B0); PG8_BAR; PG8_SCHED;
            PG8_LDB(B1, 1, 1); PG8_STAGE(PG8_SB(1, 0), b3, voffB);
            PG8_BAR; PG8_WAIT_L(0); PG8_MMA(0, 1, At, B1); PG8_BAR;
            PG8_LDA(At, 1, 1); PG8_STAGE(PG8_SA(1, 0), a3, voffA);
            PG8_BAR; PG8_WAIT_L(0); PG8_MMA(1, 0, At, B0); PG8_BAR; PG8_SCHED;
            PG8_STAGE(PG8_SB(1, 1), b3 + hstep, voffB);
            PG8_WAIT_V(6); PG8_BAR; PG8_MMA(1, 1, At, B1); PG8_BAR;
            }
        }
        if constexpr (ALIGN_EPI) { if (wr == 0) PG8_BAR; }
        if constexpr (!Epi::AFTER_DRAIN) { E(acc, cur, wr, wc, fr, fq); S.done(cur); }
        if (!has_next) break;
#pragma unroll
        for (int a = 0; a < 2; ++a)
#pragma unroll
            for (int b = 0; b < 2; ++b)
#pragma unroll
                for (int m = 0; m < 4; ++m)
#pragma unroll
                    for (int n = 0; n < 2; ++n) acc[a][b][m][n] = (f32x4){0.f, 0.f, 0.f, 0.f};
        cur = nxt; cA = nA; cB = nB; ++ui;
        if constexpr (ALIGN_EPI) { if (wr == 1) PG8_BAR; }
    }
    PG8_WAIT_V(0);
    if constexpr (!ALIGN_EPI) { if (wr == 0) PG8_BAR; }
    PG8_BAR;
    if constexpr (Epi::AFTER_DRAIN) { E.fused(acc, cur, wr, wc, fr, fq, lds, wid, lane); S.done(cur); }
#undef PG8_SA
#undef PG8_SB
#undef PG8_STAGE
#undef PG8_LDA
#undef PG8_LDB
#undef PG8_MMA
#undef PG8_WAIT_V
#undef PG8_WAIT_L
#undef PG8_BAR
#undef PG8_SCHED
}
template <class Epi, class Sched>
__device__ __forceinline__ void gemm_phase_gather(PG8_LAS unsigned char* lds, const Gemm g, const Sched& S, const Epi& E, const int wave_in) {
    unsigned z_ = 0u; asm volatile("" : "+v"(z_)); const int tid_ = (int)__builtin_amdgcn_mbcnt_hi(~0u, __builtin_amdgcn_mbcnt_lo(~0u, z_)) + 64 * wave_in;
    const int tid = tid_, wid = __builtin_amdgcn_readfirstlane(tid >> 6), lane = tid & 63, wr = wid >> 2, wc = wid & 3, fr = lane & 15, fq = lane >> 4;
    constexpr bool ALIGN_EPI = true, SP2 = true;
    const int K = g.K, nt = K / BK;
    unsigned voffB[2]; int RA0; unsigned CA0;
#pragma unroll
    for (int i = 0; i < 2; ++i) { int R, C; stage_rc(tid * 16 + i * 8192, R, C); const int Rb = Epi::PERM ? ((R & ~31) + perm32(R & 31)) : R;
        if (i == 0) { RA0 = R; CA0 = (unsigned)C * 2u; } voffB[i] = (unsigned)(Rb * K + C) * 2u; }
    unsigned ro[2], rn[2][2];
    const size_t kstep = (size_t)(BK * 2);
    const size_t hstep = (size_t)HALF * K * 2;
    const size_t tstep = 2 * hstep;
    const unsigned ldsw = (unsigned)wid * 1024u;
    const int aoff = lds_byte(wr * 64 + fr, fq * 8), boff = lds_byte(wc * 32 + fr, fq * 8);
#define PG8_SA(b, h) (((b) * 2 + (h)) * HTB)
#define PG8_SB(b, h) ((4 + (b) * 2 + (h)) * HTB)
#define PG8_STAGE(bufoff, gbase, voff) do { _Pragma("unroll") for (int _i = 0; _i < 2; ++_i) \
        __builtin_amdgcn_global_load_lds((const unsigned*)((const char*)(gbase) + (voff)[_i]), (PG8_LAS unsigned*)(lds + (bufoff) + ldsw + _i * 8192), 16, 0, 0); } while (0)
#define PG8_STAGE_G(bufoff, kbyte, pk) do { _Pragma("unroll") for (int _i = 0; _i < 2; ++_i) { const unsigned _row = _i ? ((pk) >> 16) : ((pk) & 0xffffu); \
        __builtin_amdgcn_global_load_lds((const unsigned*)((const char*)g.A + (kbyte) + (_row * ((unsigned)K * 2u) + CA0)), (PG8_LAS unsigned*)(lds + (bufoff) + ldsw + _i * 8192), 16, 0, 0); } } while (0)
#define PG8_LDA(dst, b, h) do { _Pragma("unroll") for (int m = 0; m < 4; ++m) _Pragma("unroll") for (int k = 0; k < 2; ++k) dst[m][k] = *(const PG8_LAS bf16x8*)(lds + PG8_SA(b, h) + aoff + m * 2048 + k * 1024); } while (0)
#define PG8_LDB(dst, b, h) do { _Pragma("unroll") for (int n = 0; n < 2; ++n) _Pragma("unroll") for (int k = 0; k < 2; ++k) dst[n][k] = *(const PG8_LAS bf16x8*)(lds + PG8_SB(b, h) + boff + n * 2048 + k * 1024); } while (0)
#define PG8_MMA(ai, bj, At, Bt) do { __builtin_amdgcn_s_setprio(1); _Pragma("unroll") for (int m = 0; m < 4; ++m) _Pragma("unroll") for (int n = 0; n < 2; ++n) _Pragma("unroll") for (int k = 0; k < 2; ++k) \
        acc[ai][bj][m][n] = __builtin_amdgcn_mfma_f32_16x16x32_bf16(Bt[n][k], At[m][k], acc[ai][bj][m][n], 0, 0, 0); __builtin_amdgcn_s_setprio(0); } while (0)
#define PG8_WAIT_V(n) asm volatile("s_waitcnt vmcnt(" #n ")" ::: "memory")
#define PG8_WAIT_L(n) asm volatile("s_waitcnt lgkmcnt(" #n ")" ::: "memory")
#define PG8_BAR __builtin_amdgcn_s_barrier()
#define PG8_SCHED __builtin_amdgcn_sched_barrier(0)
    Unit cur, nxt; int ui = 0;
    if (!S.next(0, cur)) return;
    f32x4 acc[2][2][4][2];
#pragma unroll
    for (int a = 0; a < 2; ++a)
#pragma unroll
        for (int b = 0; b < 2; ++b)
#pragma unroll
            for (int m = 0; m < 4; ++m)
#pragma unroll
                for (int n = 0; n < 2; ++n) acc[a][b][m][n] = (f32x4){0.f, 0.f, 0.f, 0.f};
    bf16x8 At[4][2], B0[2][2], B1[2][2];
    const char* cB = (const char*)g.Bt + (size_t)cur.pn * tstep;
    S.a_ready(cur);
    S.rows(cur, RA0, rn); ro[0] = rn[0][0] | (rn[0][1] << 16); ro[1] = rn[1][0] | (rn[1][1] << 16);
    if constexpr (SP2) {
        PG8_STAGE(PG8_SB(0, 0), cB, voffB); PG8_STAGE(PG8_SB(0, 1), cB + hstep, voffB); PG8_STAGE_G(PG8_SA(0, 0), 0, ro[0]); PG8_STAGE_G(PG8_SA(0, 1), 0, ro[1]);
        if (wr == 1) PG8_BAR;
        PG8_WAIT_V(2); PG8_BAR;
        PG8_STAGE(PG8_SB(1, 0), cB + kstep, voffB); PG8_STAGE_G(PG8_SA(1, 0), kstep, ro[0]); PG8_STAGE(PG8_SB(1, 1), cB + hstep + kstep, voffB);
        PG8_WAIT_V(6); PG8_BAR;
    }
    for (;;) {
        const bool has_next = S.next(ui + 1, nxt);
        const char* nB = has_next ? (const char*)g.Bt + (size_t)nxt.pn * tstep : cB;
        for (int t = 0; t < nt; t += 2) {
            const bool last = (t == nt - 2);
            const size_t k1 = (size_t)(t + 1) * kstep, k2 = last ? (size_t)0 : (size_t)(t + 2) * kstep, k3 = k2 + kstep;
            const char* b2 = last ? nB : cB + (size_t)(t + 2) * kstep; const char* b3 = b2 + kstep;
            if (t == nt - 4 && has_next) S.rows(nxt, RA0, rn);
            const unsigned c1 = ro[1];
            unsigned s0 = ro[0], s1 = ro[1];
            if (last && has_next) { unsigned q0 = rn[0][0], q1 = rn[0][1], q2 = rn[1][0], q3 = rn[1][1]; asm volatile("" : "+v"(q0), "+v"(q1), "+v"(q2), "+v"(q3));
                s0 = q0 | (q1 << 16); s1 = q2 | (q3 << 16); ro[0] = s0; ro[1] = s1; }
            if (last && has_next) S.a_ready(nxt);
            if constexpr (SP2) {
            PG8_LDB(B0, 0, 0); PG8_LDB(B1, 0, 1); PG8_SCHED; PG8_LDA(At, 0, 0); PG8_STAGE_G(PG8_SA(1, 1), k1, c1);
            PG8_WAIT_V(8); PG8_WAIT_L(0); PG8_BAR; PG8_MMA(0, 0, At, B0); PG8_MMA(0, 1, At, B1); PG8_BAR; PG8_SCHED;
            PG8_LDA(At, 0, 1); PG8_STAGE(PG8_SB(0, 0), b2, voffB); PG8_STAGE(PG8_SB(0, 1), b2 + hstep, voffB); PG8_STAGE_G(PG8_SA(0, 0), k2, s0);
            PG8_WAIT_V(8); PG8_WAIT_L(0); PG8_BAR; PG8_MMA(1, 0, At, B0); PG8_MMA(1, 1, At, B1); PG8_BAR; PG8_SCHED;
            PG8_LDB(B0, 1, 0); PG8_LDB(B1, 1, 1); PG8_SCHED; PG8_LDA(At, 1, 0); PG8_STAGE_G(PG8_SA(0, 1), k2, s1);
            PG8_WAIT_V(8); PG8_WAIT_L(0); PG8_BAR; PG8_MMA(0, 0, At, B0); PG8_MMA(0, 1, At, B1); PG8_BAR; PG8_SCHED;
            PG8_LDA(At, 1, 1); PG8_STAGE(PG8_SB(1, 0), b3, voffB); PG8_STAGE(PG8_SB(1, 1), b3 + hstep, voffB); PG8_STAGE_G(PG8_SA(1, 0), k3, s0);
            PG8_WAIT_V(8); PG8_WAIT_L(0); PG8_BAR; PG8_MMA(1, 0, At, B0); PG8_MMA(1, 1, At, B1); PG8_BAR; PG8_SCHED;
            }
        }
        if constexpr (ALIGN_EPI) { if (wr == 0) PG8_BAR; }
        if constexpr (!Epi::AFTER_DRAIN) { E(acc, cur, wr, wc, fr, fq); S.done(cur); }
        if (!has_next) break;
#pragma unroll
        for (int a = 0; a < 2; ++a)
#pragma unroll
            for (int b = 0; b < 2; ++b)
#pragma unroll
                for (int m = 0; m < 4; ++m)
#pragma unroll
                    for (int n = 0; n < 2; ++n) acc[a][b][m][n] = (f32x4){0.f, 0.f, 0.f, 0.f};
        cur = nxt; cB = nB; ++ui;
        if constexpr (ALIGN_EPI) { if (wr == 1) PG8_BAR; }
    }
    PG8_WAIT_V(0);
    if constexpr (!ALIGN_EPI) { if (wr == 0) PG8_BAR; }
    PG8_BAR;
    if constexpr (Epi::AFTER_DRAIN) { E.fused(acc, cur, wr, wc, fr, fq, lds, wid, lane); S.done(cur); }
#undef PG8_SA
#undef PG8_SB
#undef PG8_STAGE
#undef PG8_STAGE_G
#undef PG8_LDA
#undef PG8_LDB
#undef PG8_MMA
#undef PG8_WAIT_V
#undef PG8_WAIT_L
#undef PG8_BAR
#undef PG8_SCHED
}
typedef int v8i_t __attribute__((ext_vector_type(8)));
template <class Epi, class Sched, bool ALIGN_EPI = false, bool SP2 = false>
__device__ __forceinline__ void gemm_phase8(PG8_LAS unsigned char* lds, const Gemm g, const Sched& S, const Epi& E, const int wave_in) {
    unsigned z_ = 0u; asm volatile("" : "+v"(z_)); const int tid_ = (int)__builtin_amdgcn_mbcnt_hi(~0u, __builtin_amdgcn_mbcnt_lo(~0u, z_)) + 64 * wave_in;
    const int tid = tid_, wid = __builtin_amdgcn_readfirstlane(tid >> 6), lane = tid & 63, wr = wid >> 2, wc = wid & 3, fr = lane & 15, fq = lane >> 4;
    const int K = g.K, nt = K / (2 * BK);
    unsigned voffA[2], voffB[2];
#pragma unroll
    for (int i = 0; i < 2; ++i) { int R, C; stage_rc(tid * 16 + i * 8192, R, C); const int Rb = Epi::PERM ? ((R & ~31) + perm32(R & 31)) : R;
        voffA[i] = (unsigned)(R * K + C * 2); voffB[i] = (unsigned)(Rb * K + C * 2); }
    const size_t kstep = (size_t)(BK * 2);
    const size_t hstep = (size_t)HALF * K;
    const size_t tstep = 2 * hstep;
    const unsigned ldsw = (unsigned)wid * 1024u;
    const int aoff = lds_byte(wr * 64 + fr, fq * 16), boff = lds_byte(wc * 32 + fr, fq * 16);
#define PG8_SA(b, h) (((b) * 2 + (h)) * HTB)
#define PG8_SB(b, h) ((4 + (b) * 2 + (h)) * HTB)
#define PG8_STAGE(bufoff, gbase, voff) do { _Pragma("unroll") for (int _i = 0; _i < 2; ++_i) \
        __builtin_amdgcn_global_load_lds((const unsigned*)((const char*)(gbase) + (voff)[_i]), (PG8_LAS unsigned*)(lds + (bufoff) + ldsw + _i * 8192), 16, 0, 0); } while (0)
#define PG8_LDA(dst, b, h) do { _Pragma("unroll") for (int m = 0; m < 4; ++m) { const PG8_LAS u32x4* p_ = (const PG8_LAS u32x4*)(lds + PG8_SA(b, h) + aoff + m * 2048); const u32x4 lo_ = p_[0], hi_ = p_[1]; dst[m] = (v8i_t){(int)lo_.x, (int)lo_.y, (int)lo_.z, (int)lo_.w, (int)hi_.x, (int)hi_.y, (int)hi_.z, (int)hi_.w}; } } while (0)
#define PG8_LDB(dst, b, h) do { _Pragma("unroll") for (int n = 0; n < 2; ++n) { const PG8_LAS u32x4* p_ = (const PG8_LAS u32x4*)(lds + PG8_SB(b, h) + boff + n * 2048); const u32x4 lo_ = p_[0], hi_ = p_[1]; dst[n] = (v8i_t){(int)lo_.x, (int)lo_.y, (int)lo_.z, (int)lo_.w, (int)hi_.x, (int)hi_.y, (int)hi_.z, (int)hi_.w}; } } while (0)
#define PG8_MMA(ai, bj, At, Bt) do { __builtin_amdgcn_s_setprio(1); _Pragma("unroll") for (int m = 0; m < 4; ++m) _Pragma("unroll") for (int n = 0; n < 2; ++n) \
        asm volatile("v_mfma_f32_16x16x128_f8f6f4 %0, %1, %2, %0" : "+v"(acc[ai][bj][m][n]) : "v"(Bt[n]), "v"(At[m])); __builtin_amdgcn_s_setprio(0); } while (0)
#define PG8_WAIT_V(n) asm volatile("s_waitcnt vmcnt(" #n ")" ::: "memory")
#define PG8_WAIT_L(n) asm volatile("s_waitcnt lgkmcnt(" #n ")" ::: "memory")
#define PG8_BAR __builtin_amdgcn_s_barrier()
#define PG8_SCHED __builtin_amdgcn_sched_barrier(0)
    Unit cur, nxt; int ui = 0;
    if (!S.next(0, cur)) return;
    f32x4 acc[2][2][4][2];
#pragma unroll
    for (int a = 0; a < 2; ++a)
#pragma unroll
        for (int b = 0; b < 2; ++b)
#pragma unroll
            for (int m = 0; m < 4; ++m)
#pragma unroll
                for (int n = 0; n < 2; ++n) acc[a][b][m][n] = (f32x4){0.f, 0.f, 0.f, 0.f};
    v8i_t At[4], B0[2], B1[2];
    const char* cA = (const char*)g.A + (size_t)cur.pm * tstep; const char* cB = (const char*)g.Bt + (size_t)cur.pn * tstep;
    S.a_ready(cur);
    if constexpr (SP2) {
        PG8_STAGE(PG8_SB(0, 0), cB, voffB); PG8_STAGE(PG8_SB(0, 1), cB + hstep, voffB); PG8_STAGE(PG8_SA(0, 0), cA, voffA); PG8_STAGE(PG8_SA(0, 1), cA + hstep, voffA);
        if (wr == 1) PG8_BAR;
        PG8_WAIT_V(2); PG8_BAR;
        PG8_STAGE(PG8_SB(1, 0), cB + kstep, voffB); PG8_STAGE(PG8_SA(1, 0), cA + kstep, voffA); PG8_STAGE(PG8_SB(1, 1), cB + hstep + kstep, voffB);
        PG8_WAIT_V(6); PG8_BAR;
    } else {
        PG8_STAGE(PG8_SB(0, 0), cB, voffB); PG8_STAGE(PG8_SA(0, 0), cA, voffA); PG8_STAGE(PG8_SB(0, 1), cB + hstep, voffB); PG8_STAGE(PG8_SA(0, 1), cA + hstep, voffA);
        if (wr == 1) PG8_BAR;
        PG8_WAIT_V(4); PG8_BAR;
        PG8_STAGE(PG8_SB(1, 0), cB + kstep, voffB); PG8_STAGE(PG8_SA(1, 0), cA + kstep, voffA); PG8_STAGE(PG8_SB(1, 1), cB + hstep + kstep, voffB);
        PG8_WAIT_V(6); PG8_BAR;
    }
    for (;;) {
        const bool has_next = S.next(ui + 1, nxt);
        const char* nA = has_next ? (const char*)g.A + (size_t)nxt.pm * tstep : cA; const char* nB = has_next ? (const char*)g.Bt + (size_t)nxt.pn * tstep : cB;
#pragma nounroll
        for (int t = 0; t < nt; t += 2) {
            const bool last = (t == nt - 2);
            const char* a1 = cA + (size_t)(t + 1) * kstep;
            const char* a2 = last ? nA : cA + (size_t)(t + 2) * kstep; const char* b2 = last ? nB : cB + (size_t)(t + 2) * kstep;
            const char* a3 = a2 + kstep; const char* b3 = b2 + kstep;
            if (last && has_next) S.a_ready(nxt);
            if constexpr (SP2) {
            PG8_LDB(B0, 0, 0); PG8_LDB(B1, 0, 1); PG8_SCHED; PG8_LDA(At, 0, 0); PG8_STAGE(PG8_SA(1, 1), a1 + hstep, voffA);
            PG8_WAIT_V(8); PG8_WAIT_L(0); PG8_BAR; PG8_MMA(0, 0, At, B0); PG8_MMA(0, 1, At, B1); PG8_BAR; PG8_SCHED;
            PG8_LDA(At, 0, 1); PG8_STAGE(PG8_SB(0, 0), b2, voffB); PG8_STAGE(PG8_SB(0, 1), b2 + hstep, voffB); PG8_STAGE(PG8_SA(0, 0), a2, voffA);
            PG8_WAIT_V(8); PG8_WAIT_L(0); PG8_BAR; PG8_MMA(1, 0, At, B0); PG8_MMA(1, 1, At, B1); PG8_BAR; PG8_SCHED;
            PG8_LDB(B0, 1, 0); PG8_LDB(B1, 1, 1); PG8_SCHED; PG8_LDA(At, 1, 0); PG8_STAGE(PG8_SA(0, 1), a2 + hstep, voffA);
            PG8_WAIT_V(8); PG8_WAIT_L(0); PG8_BAR; PG8_MMA(0, 0, At, B0); PG8_MMA(0, 1, At, B1); PG8_BAR; PG8_SCHED;
            PG8_LDA(At, 1, 1); PG8_STAGE(PG8_SB(1, 0), b3, voffB); PG8_STAGE(PG8_SB(1, 1), b3 + hstep, voffB); PG8_STAGE(PG8_SA(1, 0), a3, voffA);
            PG8_WAIT_V(8); PG8_WAIT_L(0); PG8_BAR; PG8_MMA(1, 0, At, B0); PG8_MMA(1, 1, At, B1); PG8_BAR; PG8_SCHED;
            } else {
            PG8_LDB(B0, 0, 0); PG8_SCHED; PG8_LDA(At, 0, 0); PG8_STAGE(PG8_SA(1, 1), a1 + hstep, voffA);
            PG8_WAIT_L(8); PG8_BAR; PG8_WAIT_L(0); PG8_MMA(0, 0, At, B0); PG8_BAR; PG8_SCHED;
            PG8_LDB(B1, 0, 1); PG8_STAGE(PG8_SB(0, 0), b2, voffB);
            PG8_BAR; PG8_WAIT_L(0); PG8_MMA(0, 1, At, B1); PG8_BAR;
            PG8_LDA(At, 0, 1); PG8_STAGE(PG8_SA(0, 0), a2, voffA);
            PG8_BAR; PG8_WAIT_L(0); PG8_MMA(1, 0, At, B0); PG8_BAR; PG8_SCHED;
            PG8_STAGE(PG8_SB(0, 1), b2 + hstep, voffB);
            PG8_WAIT_V(6); PG8_BAR; PG8_MMA(1, 1, At, B1); PG8_BAR;
            PG8_LDB(B0, 1, 0); PG8_SCHED; PG8_LDA(At, 1, 0); PG8_STAGE(PG8_SA(0, 1), a2 + hstep, voffA);
            PG8_WAIT_L(8); PG8_BAR; PG8_WAIT_L(0); PG8_MMA(0, 0, At, B0); PG8_BAR; PG8_SCHED;
            PG8_LDB(B1, 1, 1); PG8_STAGE(PG8_SB(1, 0), b3, voffB);
            PG8_BAR; PG8_WAIT_L(0); PG8_MMA(0, 1, At, B1); PG8_BAR;
            PG8_LDA(At, 1, 1); PG8_STAGE(PG8_SA(1, 0), a3, voffA);
            PG8_BAR; PG8_WAIT_L(0); PG8_MMA(1, 0, At, B0); PG8_BAR; PG8_SCHED;
            PG8_STAGE(PG8_SB(1, 1), b3 + hstep, voffB);
            PG8_WAIT_V(6); PG8_BAR; PG8_MMA(1, 1, At, B1); PG8_BAR;
            }
        }
        asm volatile("s_nop 15\n\ts_nop 15" ::: "memory");
        if constexpr (ALIGN_EPI) { if (wr == 0) PG8_BAR; }
        if constexpr (!Epi::AFTER_DRAIN) { E(acc, cur, wr, wc, fr, fq); S.done(cur); }
        if (!has_next) break;
#pragma unroll
        for (int a = 0; a < 2; ++a)
#pragma unroll
            for (int b = 0; b < 2; ++b)
#pragma unroll
                for (int m = 0; m < 4; ++m)
#pragma unroll
                    for (int n = 0; n < 2; ++n) acc[a][b][m][n] = (f32x4){0.f, 0.f, 0.f, 0.f};
        cur = nxt; cA = nA; cB = nB; ++ui;
        if constexpr (ALIGN_EPI) { if (wr == 1) PG8_BAR; }
    }
    PG8_WAIT_V(0);
    if constexpr (!ALIGN_EPI) { if (wr == 0) PG8_BAR; }
    PG8_BAR;
    if constexpr (Epi::AFTER_DRAIN) { E.fused(acc, cur, wr, wc, fr, fq, lds, wid, lane); S.done(cur); }
#undef PG8_SA
#undef PG8_SB
#undef PG8_STAGE
#undef PG8_LDA
#undef PG8_LDB
#undef PG8_MMA
#undef PG8_WAIT_V
#undef PG8_WAIT_L
#undef PG8_BAR
#undef PG8_SCHED
}
template <class Epi, class Sched>
__device__ __forceinline__ void gemm_phase_gather8(PG8_LAS unsigned char* lds, const Gemm g, const Sched& S, const Epi& E, const int wave_in) {
    unsigned z_ = 0u; asm volatile("" : "+v"(z_)); const int tid_ = (int)__builtin_amdgcn_mbcnt_hi(~0u, __builtin_amdgcn_mbcnt_lo(~0u, z_)) + 64 * wave_in;
    const int tid = tid_, wid = __builtin_amdgcn_readfirstlane(tid >> 6), lane = tid & 63, wr = wid >> 2, wc = wid & 3, fr = lane & 15, fq = lane >> 4;
    constexpr bool ALIGN_EPI = true, SP2 = true;
    const int K = g.K, nt = K / (2 * BK);
    unsigned voffB[2]; int RA0; unsigned CA0;
#pragma unroll
    for (int i = 0; i < 2; ++i) { int R, C; stage_rc(tid * 16 + i * 8192, R, C); const int Rb = Epi::PERM ? ((R & ~31) + perm32(R & 31)) : R;
        if (i == 0) { RA0 = R; CA0 = (unsigned)C * 2u; } voffB[i] = (unsigned)(Rb * K + C * 2); }
    unsigned ro[2], rn[2][2];
    const size_t kstep = (size_t)(BK * 2);
    const size_t hstep = (size_t)HALF * K;
    const size_t tstep = 2 * hstep;
    const unsigned ldsw = (unsigned)wid * 1024u;
    const int aoff = lds_byte(wr * 64 + fr, fq * 16), boff = lds_byte(wc * 32 + fr, fq * 16);
#define PG8_SA(b, h) (((b) * 2 + (h)) * HTB)
#define PG8_SB(b, h) ((4 + (b) * 2 + (h)) * HTB)
#define PG8_STAGE(bufoff, gbase, voff) do { _Pragma("unroll") for (int _i = 0; _i < 2; ++_i) \
        __builtin_amdgcn_global_load_lds((const unsigned*)((const char*)(gbase) + (voff)[_i]), (PG8_LAS unsigned*)(lds + (bufoff) + ldsw + _i * 8192), 16, 0, 0); } while (0)
#define PG8_STAGE_G(bufoff, kbyte, pk) do { _Pragma("unroll") for (int _i = 0; _i < 2; ++_i) { const unsigned _row = _i ? ((pk) >> 16) : ((pk) & 0xffffu); \
        __builtin_amdgcn_global_load_lds((const unsigned*)((const char*)g.A + (kbyte) + (_row * (unsigned)K + CA0)), (PG8_LAS unsigned*)(lds + (bufoff) + ldsw + _i * 8192), 16, 0, 0); } } while (0)
#define PG8_LDA(dst, b, h) do { _Pragma("unroll") for (int m = 0; m < 4; ++m) { const PG8_LAS u32x4* p_ = (const PG8_LAS u32x4*)(lds + PG8_SA(b, h) + aoff + m * 2048); const u32x4 lo_ = p_[0], hi_ = p_[1]; dst[m] = (v8i_t){(int)lo_.x, (int)lo_.y, (int)lo_.z, (int)lo_.w, (int)hi_.x, (int)hi_.y, (int)hi_.z, (int)hi_.w}; } } while (0)
#define PG8_LDB(dst, b, h) do { _Pragma("unroll") for (int n = 0; n < 2; ++n) { const PG8_LAS u32x4* p_ = (const PG8_LAS u32x4*)(lds + PG8_SB(b, h) + boff + n * 2048); const u32x4 lo_ = p_[0], hi_ = p_[1]; dst[n] = (v8i_t){(int)lo_.x, (int)lo_.y, (int)lo_.z, (int)lo_.w, (int)hi_.x, (int)hi_.y, (int)hi_.z, (int)hi_.w}; } } while (0)
#define PG8_MMA(ai, bj, At, Bt) do { __builtin_amdgcn_s_setprio(1); _Pragma("unroll") for (int m = 0; m < 4; ++m) _Pragma("unroll") for (int n = 0; n < 2; ++n) \
        asm volatile("v_mfma_f32_16x16x128_f8f6f4 %0, %1, %2, %0" : "+v"(acc[ai][bj][m][n]) : "v"(Bt[n]), "v"(At[m])); __builtin_amdgcn_s_setprio(0); } while (0)
#define PG8_WAIT_V(n) asm volatile("s_waitcnt vmcnt(" #n ")" ::: "memory")
#define PG8_WAIT_L(n) asm volatile("s_waitcnt lgkmcnt(" #n ")" ::: "memory")
#define PG8_BAR __builtin_amdgcn_s_barrier()
#define PG8_SCHED __builtin_amdgcn_sched_barrier(0)
    Unit cur, nxt; int ui = 0;
    if (!S.next(0, cur)) return;
    f32x4 acc[2][2][4][2];
#pragma unroll
    for (int a = 0; a < 2; ++a)
#pragma unroll
        for (int b = 0; b < 2; ++b)
#pragma unroll
            for (int m = 0; m < 4; ++m)
#pragma unroll
                for (int n = 0; n < 2; ++n) acc[a][b][m][n] = (f32x4){0.f, 0.f, 0.f, 0.f};
    v8i_t At[4], B0[2], B1[2];
    const char* cB = (const char*)g.Bt + (size_t)cur.pn * tstep;
    S.a_ready(cur);
    S.rows(cur, RA0, rn); ro[0] = rn[0][0] | (rn[0][1] << 16); ro[1] = rn[1][0] | (rn[1][1] << 16);
    if constexpr (SP2) {
        PG8_STAGE(PG8_SB(0, 0), cB, voffB); PG8_STAGE(PG8_SB(0, 1), cB + hstep, voffB); PG8_STAGE_G(PG8_SA(0, 0), 0, ro[0]); PG8_STAGE_G(PG8_SA(0, 1), 0, ro[1]);
        if (wr == 1) PG8_BAR;
        PG8_WAIT_V(2); PG8_BAR;
        PG8_STAGE(PG8_SB(1, 0), cB + kstep, voffB); PG8_STAGE_G(PG8_SA(1, 0), kstep, ro[0]); PG8_STAGE(PG8_SB(1, 1), cB + hstep + kstep, voffB);
        PG8_WAIT_V(6); PG8_BAR;
    }
    for (;;) {
        const bool has_next = S.next(ui + 1, nxt);
        const char* nB = has_next ? (const char*)g.Bt + (size_t)nxt.pn * tstep : cB;
#pragma nounroll
        for (int t = 0; t < nt; t += 2) {
            const bool last = (t == nt - 2);
            const size_t k1 = (size_t)(t + 1) * kstep, k2 = last ? (size_t)0 : (size_t)(t + 2) * kstep, k3 = k2 + kstep;
            const char* b2 = last ? nB : cB + (size_t)(t + 2) * kstep; const char* b3 = b2 + kstep;
            if (t == nt - 4 && has_next) S.rows(nxt, RA0, rn);
            const unsigned c1 = ro[1];
            unsigned s0 = ro[0], s1 = ro[1];
            if (last && has_next) { unsigned q0 = rn[0][0], q1 = rn[0][1], q2 = rn[1][0], q3 = rn[1][1]; asm volatile("" : "+v"(q0), "+v"(q1), "+v"(q2), "+v"(q3));
                s0 = q0 | (q1 << 16); s1 = q2 | (q3 << 16); ro[0] = s0; ro[1] = s1; }
            if (last && has_next) S.a_ready(nxt);
            if constexpr (SP2) {
            PG8_LDB(B0, 0, 0); PG8_LDB(B1, 0, 1); PG8_SCHED; PG8_LDA(At, 0, 0); PG8_STAGE_G(PG8_SA(1, 1), k1, c1);
            PG8_WAIT_V(8); PG8_WAIT_L(0); PG8_BAR; PG8_MMA(0, 0, At, B0); PG8_MMA(0, 1, At, B1); PG8_BAR; PG8_SCHED;
            PG8_LDA(At, 0, 1); PG8_STAGE(PG8_SB(0, 0), b2, voffB); PG8_STAGE(PG8_SB(0, 1), b2 + hstep, voffB); PG8_STAGE_G(PG8_SA(0, 0), k2, s0);
            PG8_WAIT_V(8); PG8_WAIT_L(0); PG8_BAR; PG8_MMA(1, 0, At, B0); PG8_MMA(1, 1, At, B1); PG8_BAR; PG8_SCHED;
            PG8_LDB(B0, 1, 0); PG8_LDB(B1, 1, 1); PG8_SCHED; PG8_LDA(At, 1, 0); PG8_STAGE_G(PG8_SA(0, 1), k2, s1);
            PG8_WAIT_V(8); PG8_WAIT_L(0); PG8_BAR; PG8_MMA(0, 0, At, B0); PG8_MMA(0, 1, At, B1); PG8_BAR; PG8_SCHED;
            PG8_LDA(At, 1, 1); PG8_STAGE(PG8_SB(1, 0), b3, voffB); PG8_STAGE(PG8_SB(1, 1), b3 + hstep, voffB); PG8_STAGE_G(PG8_SA(1, 0), k3, s0);
            PG8_WAIT_V(8); PG8_WAIT_L(0); PG8_BAR; PG8_MMA(1, 0, At, B0); PG8_MMA(1, 1, At, B1); PG8_BAR; PG8_SCHED;
            }
        }
        asm volatile("s_nop 15\n\ts_nop 15" ::: "memory");
        if constexpr (ALIGN_EPI) { if (wr == 0) PG8_BAR; }
        if constexpr (!Epi::AFTER_DRAIN) { E(acc, cur, wr, wc, fr, fq); S.done(cur); }
        if (!has_next) break;
#pragma unroll
        for (int a = 0; a < 2; ++a)
#pragma unroll
            for (int b = 0; b < 2; ++b)
#pragma unroll
                for (int m = 0; m < 4; ++m)
#pragma unroll
                    for (int n = 0; n < 2; ++n) acc[a][b][m][n] = (f32x4){0.f, 0.f, 0.f, 0.f};
        cur = nxt; cB = nB; ++ui;
        if constexpr (ALIGN_EPI) { if (wr == 1) PG8_BAR; }
    }
    PG8_WAIT_V(0);
    if constexpr (!ALIGN_EPI) { if (wr == 0) PG8_BAR; }
    PG8_BAR;
    if constexpr (Epi::AFTER_DRAIN) { E.fused(acc, cur, wr, wc, fr, fq, lds, wid, lane); S.done(cur); }
#undef PG8_SA
#undef PG8_SB
#undef PG8_STAGE
#undef PG8_STAGE_G
#undef PG8_LDA
#undef PG8_LDB
#undef PG8_MMA
#undef PG8_WAIT_V
#undef PG8_WAIT_L
#undef PG8_BAR
#undef PG8_SCHED
}
}

#ifndef PG8_SP2
#define PG8_SP2 true
#endif
#ifndef PG8_ALIGN
#define PG8_ALIGN true
#endif

constexpr int NTOK = 65536, DM = 1024, NCOL = 7680, SEQ = 4096, NBATCH = 16, HTOK = 32768, MEMLEN = 256;
constexpr int C_HQ = 0, C_HF = 1024, C_HI = 2048, C_HG = 3072, C_SQ = 4096, C_SK = 5120, C_SV = 5376, C_GA = 5632, C_GB = 6656;
constexpr int NEXP = 32, TOPK = 4, CAPH = HTOK * TOPK + NEXP * 256;
constexpr float RMS_EPS = 1e-5f;
constexpr size_t MiB = (size_t)1 << 20;
constexpr size_t WS_ZERO_BYTES = 2 * MiB;
constexpr size_t WS_GCNT = 1 * MiB;
constexpr int CW_TMO = 0, CW_BAR = 4096;
constexpr size_t WS_LB = 2 * MiB, WS_LUT = 2 * MiB + 4096, WS_BLKE = 2 * MiB + 16384, WS_NBT = 2 * MiB + 32768;
constexpr size_t WS_TOPE = 3 * MiB, WS_TOPG = 4 * MiB, WS_TOPR = 5 * MiB, WS_TOPP = 6 * MiB, WS_RGATE = 7 * MiB, WS_RRSTD = 8 * MiB, WS_D12 = 10 * MiB;
constexpr size_t WS_WIN = 16 * MiB, WS_WA = 31 * MiB, WS_WB = 33 * MiB, WS_WMIX = 35 * MiB, WS_WQ = 37 * MiB, WS_WK = 39 * MiB, WS_WV = 41 * MiB, WS_WO = 43 * MiB, WS_WR = 45 * MiB;
constexpr size_t WS_MEMBF = 46 * MiB, WS_KX = 54 * MiB, WS_VXT = 62 * MiB;
constexpr size_t WS_XBF = 72 * MiB;
constexpr size_t WS_PROJ = 200 * MiB, WS_OA = 680 * MiB, WS_OB = 744 * MiB, WS_TM = 808 * MiB;
constexpr size_t WS_Q = 664 * MiB, WS_O = 792 * MiB;
constexpr size_t WS_X2F8 = 296 * MiB;
constexpr size_t WS_WGU = 200 * MiB, WS_WD = 264 * MiB, WS_ACT = 392 * MiB, WS_Y = 664 * MiB, WS_SSQ1 = 936 * MiB, WS_SSQ2 = 940 * MiB, WS_RTOK = 944 * MiB, WS_RGATE2 = 952 * MiB, WS_RRSTD2 = 960 * MiB, WS_END = 968 * MiB;
constexpr size_t OUT_US = 128 * MiB;

#define GAS __attribute__((address_space(1)))
#define LAS __attribute__((address_space(3)))
typedef unsigned short bf16;
typedef unsigned v4u __attribute__((ext_vector_type(4)));
typedef unsigned v2u __attribute__((ext_vector_type(2)));
typedef float f32x4 __attribute__((ext_vector_type(4)));
typedef short bf16x8 __attribute__((ext_vector_type(8)));
typedef short s16x4 __attribute__((ext_vector_type(4)));
#define RLX_AGENT __ATOMIC_RELAXED, __HIP_MEMORY_SCOPE_AGENT
#define LDS_WAIT() asm volatile("s_waitcnt lgkmcnt(0)" ::: "memory")
#define CFENCE() asm volatile("" ::: "memory")
__device__ __forceinline__ unsigned f2bf(float f) { unsigned u = __builtin_bit_cast(unsigned, f); return (u + 0x7fffu + ((u >> 16) & 1u)) >> 16; }
typedef float f32x2_t __attribute__((ext_vector_type(2))); typedef __bf16 bf16x2_t __attribute__((ext_vector_type(2)));
__device__ __forceinline__ unsigned pk2(float lo, float hi) { f32x2_t v = {lo, hi}; bf16x2_t b = __builtin_convertvector(v, bf16x2_t); return __builtin_bit_cast(unsigned, b); }
__device__ __forceinline__ unsigned pk4f8(float a, float b, float c, float d) { int r = 0; r = __builtin_amdgcn_cvt_pk_fp8_f32(a, b, r, false); r = __builtin_amdgcn_cvt_pk_fp8_f32(c, d, r, true); return (unsigned)r; }
constexpr float F8_WSCALE = 64.f, F8_WINV = 1.f / 64.f;
__device__ __forceinline__ float bflo(unsigned w) { return __builtin_bit_cast(float, w << 16); }
__device__ __forceinline__ float bfhi(unsigned w) { return __builtin_bit_cast(float, w & 0xffff0000u); }
__device__ __forceinline__ float sigm(float x) { return 1.f / (1.f + __expf(-x)); }
__device__ __forceinline__ float shx(float v, int mask, int lane) { return __builtin_bit_cast(float, __builtin_amdgcn_ds_bpermute((lane ^ mask) << 2, __builtin_bit_cast(int, v))); }
__device__ __forceinline__ float wave_sum(float v, int lane) {
#pragma unroll
    for (int o = 1; o < 64; o <<= 1) v += shx(v, o, lane);
    return v;
}
__device__ __forceinline__ f32x4 mfma16(bf16x8 a, bf16x8 b, f32x4 c) { return __builtin_amdgcn_mfma_f32_16x16x32_bf16(a, b, c, 0, 0, 0); }
__device__ __forceinline__ s16x4 vtr(const LAS unsigned char* p) { return __builtin_bit_cast(s16x4, __builtin_amdgcn_ds_read_tr16_b64_v4i16((LAS s16x4*)p)); }
__device__ __forceinline__ bf16x8 cat8(s16x4 lo, s16x4 hi) { return __builtin_shufflevector(lo, hi, 0, 1, 2, 3, 4, 5, 6, 7); }
__device__ __forceinline__ bf16x8 pack8(f32x4 a, f32x4 b) { v4u w; w.x = pk2(a[0], a[1]); w.y = pk2(a[2], a[3]); w.z = pk2(b[0], b[1]); w.w = pk2(b[2], b[3]); return __builtin_bit_cast(bf16x8, w); }
__device__ __forceinline__ float rstd16(const float* ssqp, size_t row) { const f32x4* p = (const f32x4*)(ssqp + row * 16); const f32x4 a = p[0], b = p[1], c = p[2], d = p[3];
    const float s = ((a[0] + a[1]) + (a[2] + a[3])) + ((b[0] + b[1]) + (b[2] + b[3])) + ((c[0] + c[1]) + (c[2] + c[3])) + ((d[0] + d[1]) + (d[2] + d[3])); return rsqrtf(s * (1.f / 1024.f) + 1e-5f); }
__device__ __forceinline__ unsigned ld_agent(const unsigned* p) { return __hip_atomic_load(p, RLX_AGENT); }


#define XB_TMO      128
#define XB_XCNT(j)  (256  + 64 * (j))
#define XB_XSUB(j)  (1280 + 64 * (j))
#define XB_XGEN(j)  (2304 + 64 * (j))
#define XB_TOP      3328
#define XB_TOPGEN   3392
#define XCD_BAR_WORDS 3456
#define XB_SPIN_CAP (1u << 18)

__device__ __forceinline__ unsigned xb_ld(unsigned* p)              { return __hip_atomic_load(p, __ATOMIC_RELAXED, __HIP_MEMORY_SCOPE_AGENT); }
__device__ __forceinline__ unsigned xb_add(unsigned* p, unsigned v) { return __hip_atomic_fetch_add(p, v, __ATOMIC_RELAXED, __HIP_MEMORY_SCOPE_AGENT); }
__device__ __forceinline__ unsigned xb_xcc_id() { return (unsigned)__builtin_amdgcn_s_getreg((3 << 11) | 20) & 0xFu; }
#define XB_SPIN(cond, bar) do { unsigned _sp = 0; while (cond) { __builtin_amdgcn_s_sleep(1); \
    if ((++_sp & 255u) == 0u) { if (xb_ld(&(bar)[XB_TMO])) break; if (_sp > XB_SPIN_CAP) { atomicAdd(&(bar)[XB_TMO], 1u); break; } } } } while (0)

struct XcdBarrier {
    unsigned* bar; unsigned x; int t0;
    volatile LAS unsigned* st;
};

__device__ __forceinline__ bool xb_is_t0(int wave) { return wave == 0 && __builtin_amdgcn_mbcnt_hi(~0u, __builtin_amdgcn_mbcnt_lo(~0u, 0u)) == 0u; }
__device__ __forceinline__ XcdBarrier xcd_barrier_post(unsigned* bar, volatile LAS unsigned* st, int wave) {
    XcdBarrier b; b.bar = bar; b.x = xb_xcc_id(); b.st = st; b.t0 = wave;
    if (xb_is_t0(wave)) (void)xb_add(&bar[XB_XCNT(b.x)], 1u);
    return b;
}
__device__ __forceinline__ void xcd_barrier_complete(unsigned* bar, unsigned x, unsigned& nloc, unsigned& nx) {
    const unsigned G = gridDim.x * gridDim.y * gridDim.z;
    unsigned sum, cnt, mine, sp = 0u;
    for (;;) {
        sum = 0u; cnt = 0u; mine = 0u;
#pragma unroll
        for (unsigned j = 0; j < 16; ++j) { const unsigned c = xb_ld(&bar[XB_XCNT(j)]); sum += c; cnt += (c > 0u) ? 1u : 0u; mine = (j == x) ? c : mine; }
        if (sum == G) break;
        __builtin_amdgcn_s_sleep(1);
        if ((++sp & 255u) == 0u) { if (xb_ld(&bar[XB_TMO])) break; if (sp > XB_SPIN_CAP) { atomicAdd(&bar[XB_TMO], 1u); break; } }
    }
    nloc = mine > 0u ? mine : 1u; nx = cnt > 0u ? cnt : 1u;
}

__device__ __forceinline__ void xcd_barrier(const XcdBarrier& b) {
    asm volatile("s_waitcnt vmcnt(0)" ::: "memory");
    __syncthreads();
    if (xb_is_t0(b.t0)) {
        unsigned* bar = b.bar;
        __builtin_amdgcn_s_waitcnt(0);
        unsigned nloc = b.st[0], nx = b.st[1];
        if (nloc == 0u) { xcd_barrier_complete(bar, b.x, nloc, nx); b.st[0] = nloc; b.st[1] = nx; }
        const unsigned old = xb_add(&bar[XB_XSUB(b.x)], 1u);
        const unsigned gen = old / nloc;
        if (old + 1u == (gen + 1u) * nloc) {
            __builtin_amdgcn_fence(__ATOMIC_RELEASE, "agent");
            asm volatile("s_waitcnt vmcnt(0)" ::: "memory");
            const unsigned og = xb_add(&bar[XB_TOP], 1u);
            const unsigned tg = og / nx;
            if (og + 1u == (tg + 1u) * nx) xb_add(&bar[XB_TOPGEN], 1u);
            else XB_SPIN(xb_ld(&bar[XB_TOPGEN]) == tg, bar);
            __builtin_amdgcn_fence(__ATOMIC_ACQUIRE, "agent");
            xb_add(&bar[XB_XGEN(b.x)], 1u);
            asm volatile("s_waitcnt vmcnt(0)" ::: "memory");
        } else {
            XB_SPIN(xb_ld(&bar[XB_XGEN(b.x)]) == gen, bar);
            __builtin_amdgcn_fence(__ATOMIC_ACQUIRE, "agent");
            asm volatile("s_waitcnt vmcnt(0)" ::: "memory");
        }
    }
    __syncthreads();
}

struct Args {
    const float* in[25];
    float* out; unsigned char* ws;
    int ph_lo, ph_hi;
};

using pg8::Unit;
struct EpiStore {
    static constexpr bool PERM = true, AFTER_DRAIN = false;
    bf16* O; int ldc; const float* ssq;
    __device__ __forceinline__ void operator()(const f32x4 (&acc)[2][2][4][2], const Unit& u, int wr, int wc, int fr, int fq) const {
        const int row0 = u.pm * 256 + wr * 64 + fr, col0 = u.pn * 256 + wc * 32 + 8 * fq;
#pragma unroll
        for (int ai = 0; ai < 2; ++ai) { float sc[4];
#pragma unroll
            for (int m = 0; m < 4; ++m) sc[m] = ssq ? rstd16(ssq, (size_t)(row0 + ai * 128 + m * 16)) : 1.f;
#pragma unroll
            for (int m = 0; m < 4; ++m) { const int row = row0 + ai * 128 + m * 16; bf16* rowp = O + (size_t)row * ldc + col0;
#pragma unroll
                for (int bj = 0; bj < 2; ++bj) { const f32x4 v0 = acc[ai][bj][m][0] * sc[m], v1 = acc[ai][bj][m][1] * sc[m];
                    v4u w; w.x = pk2(v0[0], v0[1]); w.y = pk2(v0[2], v0[3]); w.z = pk2(v1[0], v1[1]); w.w = pk2(v1[2], v1[3]);
                    __builtin_nontemporal_store(w, (v4u*)(rowp + bj * 128)); } } }
    }
};
template <bool ADD> struct EpiGate {
    static constexpr bool PERM = true, AFTER_DRAIN = false;
    bf16* T; const bf16* proj; int gcol; const float* bias;
    __device__ __forceinline__ void operator()(const f32x4 (&acc)[2][2][4][2], const Unit& u, int wr, int wc, int fr, int fq) const {
        const int row0 = u.pm * 256 + wr * 64 + fr, col0 = u.pn * 256 + wc * 32 + 8 * fq;
        f32x4 bv[2][2];
#pragma unroll
        for (int bj = 0; bj < 2; ++bj)
#pragma unroll
            for (int n = 0; n < 2; ++n) bv[bj][n] = *(const f32x4*)(bias + col0 + bj * 128 + 4 * n);
#pragma unroll
        for (int am = 0; am < 4; ++am) { const int ai = am >> 1, mh = am & 1; v4u gw[2][2], tw[2][2];
#pragma unroll
            for (int mm = 0; mm < 2; ++mm)
#pragma unroll
                for (int bj = 0; bj < 2; ++bj) { const int row = row0 + ai * 128 + (2 * mh + mm) * 16; gw[mm][bj] = *(const v4u*)(proj + (size_t)row * NCOL + gcol + col0 + bj * 128);
                    if (ADD) tw[mm][bj] = *(const v4u*)(T + (size_t)row * DM + col0 + bj * 128); }
#pragma unroll
            for (int mm = 0; mm < 2; ++mm)
#pragma unroll
                for (int bj = 0; bj < 2; ++bj) { const int m = 2 * mh + mm; const int row = row0 + ai * 128 + m * 16; const v4u g4 = gw[mm][bj]; float r[8];
                    r[0] = sigm(bflo(g4.x) + bv[bj][0][0]) * acc[ai][bj][m][0][0]; r[1] = sigm(bfhi(g4.x) + bv[bj][0][1]) * acc[ai][bj][m][0][1];
                    r[2] = sigm(bflo(g4.y) + bv[bj][0][2]) * acc[ai][bj][m][0][2]; r[3] = sigm(bfhi(g4.y) + bv[bj][0][3]) * acc[ai][bj][m][0][3];
                    r[4] = sigm(bflo(g4.z) + bv[bj][1][0]) * acc[ai][bj][m][1][0]; r[5] = sigm(bfhi(g4.z) + bv[bj][1][1]) * acc[ai][bj][m][1][1];
                    r[6] = sigm(bflo(g4.w) + bv[bj][1][2]) * acc[ai][bj][m][1][2]; r[7] = sigm(bfhi(g4.w) + bv[bj][1][3]) * acc[ai][bj][m][1][3];
                    if (ADD) { const v4u t4 = tw[mm][bj];
                        r[0] += bflo(t4.x); r[1] += bfhi(t4.x); r[2] += bflo(t4.y); r[3] += bfhi(t4.y); r[4] += bflo(t4.z); r[5] += bfhi(t4.z); r[6] += bflo(t4.w); r[7] += bfhi(t4.w); }
                    v4u w; w.x = pk2(r[0], r[1]); w.y = pk2(r[2], r[3]); w.z = pk2(r[4], r[5]); w.w = pk2(r[6], r[7]);
                    *(v4u*)(T + (size_t)row * DM + col0 + bj * 128) = w; } }
    }
};
template <bool BF> struct EpiResid {
    static constexpr bool PERM = true, AFTER_DRAIN = false;
    const float* base; bf16* obf; float* ssq; unsigned char* f8;
    __device__ __forceinline__ void operator()(const f32x4 (&acc)[2][2][4][2], const Unit& u, int wr, int wc, int fr, int fq) const {
        const int row0 = u.pm * 256 + wr * 64 + fr, col0 = u.pn * 256 + wc * 32 + 8 * fq;
#pragma unroll
        for (int ai = 0; ai < 2; ++ai)
#pragma unroll
            for (int mh = 0; mh < 2; ++mh) { f32x4 b0[2][2], b1[2][2];
#pragma unroll
                for (int mm = 0; mm < 2; ++mm)
#pragma unroll
                    for (int bj = 0; bj < 2; ++bj) { const size_t off = (size_t)(row0 + ai * 128 + (2 * mh + mm) * 16) * DM + col0 + bj * 128;
                        if (BF) { const v4u bw = *(const v4u*)(obf + off); b0[mm][bj] = (f32x4){bflo(bw.x), bfhi(bw.x), bflo(bw.y), bfhi(bw.y)}; b1[mm][bj] = (f32x4){bflo(bw.z), bfhi(bw.z), bflo(bw.w), bfhi(bw.w)}; }
                        else { b0[mm][bj] = *(const f32x4*)(base + off); b1[mm][bj] = *(const f32x4*)(base + off + 4); } }
#pragma unroll
                for (int mm = 0; mm < 2; ++mm) { const int m = 2 * mh + mm; const int row = row0 + ai * 128 + m * 16; float ss = 0.f;
#pragma unroll
                    for (int bj = 0; bj < 2; ++bj) { const size_t off = (size_t)row * DM + col0 + bj * 128;
                        const f32x4 v0 = b0[mm][bj] + acc[ai][bj][m][0], v1 = b1[mm][bj] + acc[ai][bj][m][1];
                        v4u w; w.x = pk2(v0[0], v0[1]); w.y = pk2(v0[2], v0[3]); w.z = pk2(v1[0], v1[1]); w.w = pk2(v1[2], v1[3]);
                        *(v4u*)(obf + off) = w;
                        if (f8) { v2u q; q.x = pk4f8(v0[0], v0[1], v0[2], v0[3]); q.y = pk4f8(v1[0], v1[1], v1[2], v1[3]); *(v2u*)(f8 + off) = q; }
                        ss += ((v0[0] * v0[0] + v0[1] * v0[1]) + (v0[2] * v0[2] + v0[3] * v0[3])) + ((v1[0] * v1[0] + v1[1] * v1[1]) + (v1[2] * v1[2] + v1[3] * v1[3])); }
                    { const int ln_ = fr + 16 * fq; ss += shx(ss, 16, ln_); ss += shx(ss, 32, ln_); }
                    if (fq == 0) ssq[(size_t)row * 16 + (u.pn & 3) * 4 + wc] = ss; } }
    }
};
struct EpiSwiglu {
    static constexpr bool PERM = true, AFTER_DRAIN = false;
    unsigned char* act; const float* bgu; const float* row_rstd;
    __device__ __forceinline__ void operator()(const f32x4 (&acc)[2][2][4][2], const Unit& u, int wr, int wc, int fr, int fq) const {
        const int e = u.pn >> 3, pnl = u.pn & 7;
        const int rr0 = wr * 64 + fr, cl0 = pnl * 128 + wc * 32 + 8 * fq;
        f32x4 bg[2], bl[2]; float rs[2][4];
#pragma unroll
        for (int n = 0; n < 2; ++n) { bg[n] = *(const f32x4*)(bgu + e * 2048 + cl0 + 4 * n); bl[n] = *(const f32x4*)(bgu + e * 2048 + 1024 + cl0 + 4 * n); }
#pragma unroll
        for (int ai = 0; ai < 2; ++ai)
#pragma unroll
            for (int m = 0; m < 4; ++m) rs[ai][m] = row_rstd[u.aux + rr0 + ai * 128 + m * 16] * F8_WINV;
#pragma unroll
        for (int ai = 0; ai < 2; ++ai)
#pragma unroll
            for (int m = 0; m < 4; ++m) { const int row = u.pm * 256 + rr0 + ai * 128 + m * 16;
                float r[8];
#pragma unroll
                for (int n = 0; n < 2; ++n)
#pragma unroll
                    for (int j = 0; j < 4; ++j) { float gl = acc[ai][0][m][n][j] * rs[ai][m] + bg[n][j], li = acc[ai][1][m][n][j] * rs[ai][m] + bl[n][j];
                        gl = fminf(gl, 7.0f); li = fminf(fmaxf(li, -7.0f), 7.0f);
                        r[n * 4 + j] = gl * sigm(1.702f * gl) * (li + 1.0f); }
                v2u w; w.x = pk4f8(r[0], r[1], r[2], r[3]); w.y = pk4f8(r[4], r[5], r[6], r[7]);
                __builtin_nontemporal_store(w, (v2u*)(act + (size_t)row * DM + cl0)); }
    }
};
struct EpiDown {
    static constexpr bool PERM = true, AFTER_DRAIN = false;
    bf16* y; const float* bd; const float* row_gate;
    __device__ __forceinline__ void operator()(const f32x4 (&acc)[2][2][4][2], const Unit& u, int wr, int wc, int fr, int fq) const {
        const int e = u.pn >> 2, pnl = u.pn & 3;
        const int rr0 = wr * 64 + fr, col0 = pnl * 256 + wc * 32 + 8 * fq;
        f32x4 bv[2][2]; float gt[2][4];
#pragma unroll
        for (int bj = 0; bj < 2; ++bj)
#pragma unroll
            for (int n = 0; n < 2; ++n) bv[bj][n] = *(const f32x4*)(bd + e * 1024 + col0 + bj * 128 + 4 * n);
#pragma unroll
        for (int ai = 0; ai < 2; ++ai)
#pragma unroll
            for (int m = 0; m < 4; ++m) gt[ai][m] = row_gate[u.aux + rr0 + ai * 128 + m * 16];
#pragma unroll
        for (int ai = 0; ai < 2; ++ai)
#pragma unroll
            for (int m = 0; m < 4; ++m) { const int row = u.pm * 256 + rr0 + ai * 128 + m * 16;
#pragma unroll
                for (int bj = 0; bj < 2; ++bj) { const f32x4 v0 = (acc[ai][bj][m][0] * F8_WINV + bv[bj][0]) * gt[ai][m], v1 = (acc[ai][bj][m][1] * F8_WINV + bv[bj][1]) * gt[ai][m];
                    v4u w; w.x = pk2(v0[0], v0[1]); w.y = pk2(v0[2], v0[3]); w.z = pk2(v1[0], v1[1]); w.w = pk2(v1[2], v1[3]);
                    __builtin_nontemporal_store(w, (v4u*)(y + (size_t)row * DM + col0 + bj * 128)); } }
    }
};
struct GroupedOrder {
    int nunits, npn, G, c, half; const LAS unsigned* tab; const int* row_tok;
    __device__ __forceinline__ bool next(int i, Unit& u) const {
        const long L = (long)i * G + c; if (L >= nunits) return false;
        const int rb = (int)(L / npn), pn = (int)(L % npn);
        int e = 0;
#pragma unroll 4
        for (int k = 1; k < 32; ++k) e = (rb >= (int)tab[32 + k]) ? k : e;
        e = __builtin_amdgcn_readfirstlane(e);
        const int j = rb - (int)__builtin_amdgcn_readfirstlane(tab[32 + e]), cn = (int)__builtin_amdgcn_readfirstlane(tab[e]) - 256 * j;
        u.pm = rb; u.pn = e * npn + pn; u.aux = (half * 32 + e) * HTOK + 256 * j; u.cnt = cn < 256 ? cn : 256; return true;
    }
    __device__ __forceinline__ void rows(const Unit& u, int RA0, unsigned (&rn)[2][2]) const {
#pragma unroll
        for (int h = 0; h < 2; ++h) { const int r0 = h * 128 + RA0, r1 = r0 + 64, cm = u.cnt - 1;
            rn[h][0] = (unsigned)row_tok[u.aux + (r0 < cm ? r0 : cm)]; rn[h][1] = (unsigned)row_tok[u.aux + (r1 < cm ? r1 : cm)]; }
    }
    __device__ __forceinline__ void a_ready(const Unit&) const {}
    __device__ __forceinline__ void done(const Unit&) const {}
};
constexpr int MOE_TAB_OFF = 131072 + 1024;
__device__ __forceinline__ void moe_tables(const unsigned char* ws, int hb, LAS unsigned char* lds, int tid) {
    LAS unsigned* tab = (LAS unsigned*)(lds + MOE_TAB_OFF); const unsigned* gcnt = (const unsigned*)(ws + WS_GCNT);
    __syncthreads();
    if (tid < 32) tab[tid] = ld_agent(gcnt + (hb * 32 + tid) * 16);
    __syncthreads();
    if (tid == 0) { unsigned acc = 0; for (int e = 0; e < 32; ++e) { tab[32 + e] = acc; acc += (tab[e] + 255u) >> 8; } tab[64] = acc; }
    __syncthreads();
}

constexpr int RING_BYTES = 131072, MISC_OFF = RING_BYTES + 320, LDS_BYTES = 147456;

struct Ctx { LAS unsigned char* lds; int tid, lane, wave, G, gw, ngw; };

struct TItem { f32x4 v[8]; float gv[8]; };
__device__ __forceinline__ void titem_load(TItem& t, const float* W, int N, const float* gain, int k0, int n0, int lane) {
#pragma unroll
    for (int i = 0; i < 8; ++i) { const int kk = 8 * i + (lane >> 3); t.v[i] = *(const f32x4*)(W + (size_t)(k0 + kk) * N + n0 + (lane & 7) * 4); t.gv[i] = gain ? gain[k0 + kk] : 1.f; }
}
__device__ __forceinline__ void titem_to_lds(const TItem& t, LAS float* scr, int lane) {
#pragma unroll
    for (int i = 0; i < 8; ++i) { const int kk = 8 * i + (lane >> 3); LAS float* p = scr + kk * 33 + (lane & 7) * 4;
        p[0] = t.v[i][0] * t.gv[i]; p[1] = t.v[i][1] * t.gv[i]; p[2] = t.v[i][2] * t.gv[i]; p[3] = t.v[i][3] * t.gv[i]; }
    LDS_WAIT();
}
template <class RowMap>
__device__ __forceinline__ void titem_out(int K, bf16* WT, const LAS float* scr, int k0, int n0, int lane, RowMap rm) {
    const int c = lane & 7;
#pragma unroll
    for (int j = 0; j < 4; ++j) { const int n = (lane >> 3) + 8 * j; const LAS float* s = scr + (8 * c) * 33 + n;
        v4u o; o.x = pk2(s[0 * 33], s[1 * 33]); o.y = pk2(s[2 * 33], s[3 * 33]); o.z = pk2(s[4 * 33], s[5 * 33]); o.w = pk2(s[6 * 33], s[7 * 33]);
        *(v4u*)(WT + (size_t)rm(n0 + n) * K + k0 + 8 * c) = o; }
    LDS_WAIT();
}
template <class RowMap>
__device__ __forceinline__ void titem_out8(int K, unsigned char* WT, const LAS float* scr, int k0, int n0, int lane, RowMap rm) {
    const int c = lane & 7;
#pragma unroll
    for (int j = 0; j < 4; ++j) { const int n = (lane >> 3) + 8 * j; const LAS float* s = scr + (8 * c) * 33 + n;
        v2u o; o.x = pk4f8(s[0 * 33] * F8_WSCALE, s[1 * 33] * F8_WSCALE, s[2 * 33] * F8_WSCALE, s[3 * 33] * F8_WSCALE); o.y = pk4f8(s[4 * 33] * F8_WSCALE, s[5 * 33] * F8_WSCALE, s[6 * 33] * F8_WSCALE, s[7 * 33] * F8_WSCALE);
        *(v2u*)(WT + (size_t)rm(n0 + n) * K + k0 + 8 * c) = o; }
    LDS_WAIT();
}
template <class RowMap>
__device__ __forceinline__ void transpose_item(const float* W, int K, int N, bf16* WT, const float* gain, LAS float* scr, int item, int lane, RowMap rm) {
    const int nblk = N / 32, kb = item / nblk, nb = item % nblk, k0 = 64 * kb, n0 = 32 * nb;
    TItem t; titem_load(t, W, N, gain, k0, n0, lane); titem_to_lds(t, scr, lane); titem_out(K, WT, scr, k0, n0, lane, rm);
}
struct RowId { int off; __device__ __forceinline__ int operator()(int n) const { return off + n; } };
struct RowGU { int e; __device__ __forceinline__ int operator()(int n) const { const int j = n & 1023; return e * 2048 + (j >> 7) * 256 + (n >> 10) * 128 + (j & 127); } };

__device__ __forceinline__ void rms_row_to_bf16(const float* xrow, const float* gain, bf16* orow, int lane) {
    const f32x4* xr = (const f32x4*)xrow + lane; const f32x4* gr = (const f32x4*)gain + lane;
    f32x4 v[4]; float s = 0.f;
#pragma unroll
    for (int j = 0; j < 4; ++j) { v[j] = xr[64 * j]; s += (v[j][0] * v[j][0] + v[j][1] * v[j][1]) + (v[j][2] * v[j][2] + v[j][3] * v[j][3]); }
    const float rstd = rsqrtf(wave_sum(s, lane) * (1.f / DM) + RMS_EPS);
    unsigned long long* o8 = (unsigned long long*)orow + lane;
#pragma unroll
    for (int j = 0; j < 4; ++j) { const f32x4 g = gr[64 * j]; const f32x4 w = v[j] * rstd * g;
        o8[64 * j] = (unsigned long long)pk2(w[0], w[1]) | ((unsigned long long)pk2(w[2], w[3]) << 32); }
}

__device__ __forceinline__ void phase_prologue(const Args& a, const Ctx& c) {
    LAS float* scr = (LAS float*)(c.lds + c.wave * 16384);
    unsigned char* ws = a.ws;
    constexpr int I_IN = 16 * (NCOL / 32), I_SQ = 16 * 32, I_R = 16;
    constexpr int NIT = I_IN + 7 * I_SQ + I_R;
    for (int it = c.gw; it < NIT; it += c.ngw) {
        int r = it;
        if (r < I_IN) { transpose_item(a.in[5], DM, NCOL, (bf16*)(ws + WS_WIN), nullptr, scr, r, c.lane, RowId{0}); continue; } r -= I_IN;
        if (r < I_SQ) { transpose_item(a.in[9], DM, DM, (bf16*)(ws + WS_WA), nullptr, scr, r, c.lane, RowId{0}); continue; } r -= I_SQ;
        if (r < I_SQ) { transpose_item(a.in[10], DM, DM, (bf16*)(ws + WS_WB), nullptr, scr, r, c.lane, RowId{0}); continue; } r -= I_SQ;
        if (r < I_SQ) { transpose_item(a.in[11], DM, DM, (bf16*)(ws + WS_WMIX), nullptr, scr, r, c.lane, RowId{0}); continue; } r -= I_SQ;
        if (r < I_SQ) { transpose_item(a.in[13], DM, DM, (bf16*)(ws + WS_WQ), a.in[12], scr, r, c.lane, RowId{0}); continue; } r -= I_SQ;
        if (r < I_SQ) { transpose_item(a.in[14], DM, DM, (bf16*)(ws + WS_WK), nullptr, scr, r, c.lane, RowId{0}); continue; } r -= I_SQ;
        if (r < I_SQ) { transpose_item(a.in[15], DM, DM, (bf16*)(ws + WS_WV), nullptr, scr, r, c.lane, RowId{0}); continue; } r -= I_SQ;
        if (r < I_SQ) { transpose_item(a.in[16], DM, DM, (bf16*)(ws + WS_WO), nullptr, scr, r, c.lane, RowId{0}); continue; } r -= I_SQ;
        transpose_item(a.in[18], DM, NEXP, (bf16*)(ws + WS_WR), a.in[17], scr, r, c.lane, RowId{0});
    }
    { const size_t n8 = (size_t)NBATCH * MEMLEN * DM / 8; const float* mem = a.in[1]; bf16* mb = (bf16*)(ws + WS_MEMBF);
      for (size_t i = (size_t)c.gw * 64 + c.lane; i < n8; i += (size_t)c.ngw * 64) { const f32x4 v0 = *(const f32x4*)(mem + i * 8), v1 = *(const f32x4*)(mem + i * 8 + 4);
          v4u w; w.x = pk2(v0[0], v0[1]); w.y = pk2(v0[2], v0[3]); w.z = pk2(v1[0], v1[1]); w.w = pk2(v1[2], v1[3]); *(v4u*)(mb + i * 8) = w; } }
    if (c.gw == 0) {
        float* lb = (float*)(ws + WS_LB); const float* lbl = a.in[3];
        for (int k = c.lane; k < 1024; k += 64) lb[k] = 1.f / (1.f + expf(lbl[1024 + k] - lbl[k]));
    }
    if (c.gw == 1) {
        float* lut = (float*)(ws + WS_LUT); const float* t5 = a.in[2];
        for (int i = c.lane; i < 16 * 128; i += 64) { const int h = i >> 7, d = i & 127; int b = d;
            if (d >= 16) { b = 16 + (int)(logf((float)d * (1.f / 16.f)) / logf(8.f) * 16.f); b = b < 31 ? b : 31; }
            lut[i] = t5[b * 16 + h]; }
    }
}

__device__ __forceinline__ void phase_norm1(const Args& a, const Ctx& c, int hb) {
    const float* x = a.in[0] + (size_t)hb * HTOK * DM; bf16* xn = (bf16*)(a.ws + WS_TM);
    for (int m = c.gw; m < HTOK; m += c.ngw) rms_row_to_bf16(x + (size_t)m * DM, a.in[4], xn + (size_t)m * DM, c.lane);
}

constexpr int SWA_VB = 32 * 144;
constexpr int SWA_LUT_OFF = 8 * 2 * SWA_VB;
__device__ __forceinline__ void swa_unit(const bf16* proj, bf16* ob, int bl, int kvh, int tt, const LAS float* lut, LAS unsigned char* vbuf, const float* sinks, int lane) {
    const int l15 = lane & 15, g = lane >> 4, q4 = l15 >> 2, p4 = lane & 3;
    const int t0 = tt * 16; const size_t rowb = (size_t)bl * SEQ;
    bf16x8 qf[4][2];
#pragma unroll
    for (int gq = 0; gq < 4; ++gq)
#pragma unroll
        for (int ks = 0; ks < 2; ++ks) qf[gq][ks] = *(const bf16x8*)(proj + (rowb + t0 + l15) * NCOL + C_SQ + (kvh * 4 + gq) * 64 + ks * 32 + 8 * g);
    float mx[4], ls[4]; f32x4 o[4][4];
#pragma unroll
    for (int gq = 0; gq < 4; ++gq) { mx[gq] = sinks[kvh * 4 + gq]; ls[gq] = 1.f;
#pragma unroll
        for (int dt = 0; dt < 4; ++dt) o[gq][dt] = (f32x4){0.f, 0.f, 0.f, 0.f}; }
    for (int c = 0; c < 5; ++c) {
        const int kc = t0 - 144 + 32 * c;
        if (kc + 31 < 0) continue;
        LAS unsigned char* vb = vbuf + (c & 1) * SWA_VB;
#pragma unroll
        for (int i = 0; i < 4; ++i) { const int p = lane + 64 * i, key = p >> 3, d8 = p & 7; int kr = kc + key; kr = kr < 0 ? 0 : kr;
            const v4u vv = *(const v4u*)(proj + (rowb + kr) * NCOL + C_SV + kvh * 64 + d8 * 8);
            *(LAS v4u*)(vb + key * 144 + d8 * 16) = vv; }
        f32x4 s[4][2];
#pragma unroll
        for (int ksub = 0; ksub < 2; ++ksub) { int kr = kc + 16 * ksub + l15; kr = kr < 0 ? 0 : kr;
            const bf16* kp = proj + (rowb + kr) * NCOL + C_SK + kvh * 64 + 8 * g;
            const bf16x8 k0 = *(const bf16x8*)kp, k1 = *(const bf16x8*)(kp + 32);
#pragma unroll
            for (int gq = 0; gq < 4; ++gq) { f32x4 z = (f32x4){0.f, 0.f, 0.f, 0.f}; z = mfma16(k0, qf[gq][0], z); s[gq][ksub] = mfma16(k1, qf[gq][1], z); } }
        bf16x8 pf[4];
#pragma unroll
        for (int gq = 0; gq < 4; ++gq) { const int hq = kvh * 4 + gq; float cm = -1e30f;
#pragma unroll
            for (int ksub = 0; ksub < 2; ++ksub)
#pragma unroll
                for (int r = 0; r < 4; ++r) { const int key = kc + 16 * ksub + 4 * g + r, dist = t0 + l15 - key; const bool ok = (dist >= 0) && (dist < 128) && (key >= 0);
                    const int di = dist < 0 ? 0 : (dist > 127 ? 127 : dist);
                    float v = s[gq][ksub][r] * 0.125f + lut[hq * 128 + di]; v = ok ? v : -1e30f; s[gq][ksub][r] = v; cm = fmaxf(cm, v); }
            cm = fmaxf(cm, shx(cm, 16, lane)); cm = fmaxf(cm, shx(cm, 32, lane));
            const float mn = fmaxf(mx[gq], cm), alpha = __expf(mx[gq] - mn); mx[gq] = mn; float rs = 0.f;
#pragma unroll
            for (int ksub = 0; ksub < 2; ++ksub)
#pragma unroll
                for (int r = 0; r < 4; ++r) { const float p = __expf(s[gq][ksub][r] - mn); s[gq][ksub][r] = p; rs += p; }
            rs += shx(rs, 16, lane); rs += shx(rs, 32, lane);
            ls[gq] = ls[gq] * alpha + rs;
#pragma unroll
            for (int dt = 0; dt < 4; ++dt) o[gq][dt] = o[gq][dt] * alpha;
            pf[gq] = pack8(s[gq][0], s[gq][1]); }
        CFENCE();
#pragma unroll
        for (int dt = 0; dt < 4; ++dt) {
            const s16x4 lo = vtr(vb + (4 * g + q4) * 144 + (16 * dt + 4 * p4) * 2), hi = vtr(vb + (16 + 4 * g + q4) * 144 + (16 * dt + 4 * p4) * 2);
            const bf16x8 vf = cat8(lo, hi);
#pragma unroll
            for (int gq = 0; gq < 4; ++gq) o[gq][dt] = mfma16(vf, pf[gq], o[gq][dt]); }
        CFENCE();
    }
#pragma unroll
    for (int gq = 0; gq < 4; ++gq) { const float inv = 1.f / ls[gq];
#pragma unroll
        for (int dt = 0; dt < 4; ++dt) { const f32x4 v = o[gq][dt] * inv; v2u w; w.x = pk2(v[0], v[1]); w.y = pk2(v[2], v[3]);
            *(v2u*)(ob + (rowb + t0 + l15) * DM + (kvh * 4 + gq) * 64 + 16 * dt + 4 * g) = w; } }
}
constexpr int HGB_WAVES = 4;
__device__ __forceinline__ void hgB_work(const Args& a, const Ctx& c);
__device__ __forceinline__ void phase_swa_hgB(const Args& a, const Ctx& c) {
    const bf16* proj = (const bf16*)(a.ws + WS_PROJ); bf16* ob = (bf16*)(a.ws + WS_OB);
    LAS float* lut = (LAS float*)(c.lds + SWA_LUT_OFF); const float* glut = (const float*)(a.ws + WS_LUT);
    for (int i = c.tid; i < 16 * 128; i += 512) lut[i] = glut[i];
    __syncthreads();
    if (c.wave < HGB_WAVES) hgB_work(a, c);
    else {
        LAS unsigned char* vbuf = c.lds + c.wave * 2 * SWA_VB;
        constexpr int NU = 8 * 4 * 256;
        const int nsw = c.G * (8 - HGB_WAVES), sw = (int)blockIdx.x * (8 - HGB_WAVES) + (c.wave - HGB_WAVES);
        for (int u = sw; u < NU; u += nsw) { const int tt = u & 255, kvh = (u >> 8) & 3, bl = u >> 10; swa_unit(proj, ob, bl, kvh, tt, lut, vbuf, a.in[8], c.lane); }
    }
    __syncthreads();
}

constexpr int HG_LF = 0, HG_KP = 33792, HG_VT = 51200, HG_GT = 68608, HG_QP = 70656, HG_SSQ = 88064;
__device__ __forceinline__ void hg_scan(LAS unsigned char* lds, int tid, float (&loc)[16], float& pre, float& Gm, float& Gl) {
    const int ch = tid & 127, grp = tid >> 7;
    const LAS float* LF = (const LAS float*)(lds + HG_LF); LAS float* GT = (LAS float*)(lds + HG_GT);
    float run = 0.f;
#pragma unroll
    for (int i = 0; i < 16; ++i) { run += LF[(16 * grp + i) * 132 + ch]; loc[i] = run; }
    GT[grp * 128 + ch] = run;
    __syncthreads();
    const float g0 = GT[ch], g1 = GT[128 + ch], g2 = GT[256 + ch], g3 = GT[384 + ch];
    pre = (grp > 0 ? g0 : 0.f) + (grp > 1 ? g1 : 0.f) + (grp > 2 ? g2 : 0.f);
    Gm = g0 + g1; Gl = Gm + g2 + g3;
}
__device__ __forceinline__ void phase_hgA(const Args& a, const Ctx& c) {
    const bf16* proj = (const bf16*)(a.ws + WS_PROJ); bf16* US = (bf16*)((unsigned char*)a.out + OUT_US); float* D12 = (float*)(a.ws + WS_D12); const float* lb = (const float*)(a.ws + WS_LB);
    LAS unsigned char* lds = c.lds; const int tid = c.tid, lane = c.lane, w = c.wave;
    const int l15 = lane & 15, g = lane >> 4, q4 = l15 >> 2, p4 = lane & 3;
    constexpr int NU = 8 * 8 * 64;
    int u = blockIdx.x; if (u >= NU) return;
    v4u rf[2], rv[2];
#define HGA_LOAD(uu) do { const int cc_ = (uu) & 63, h_ = ((uu) >> 6) & 7, bl_ = (uu) >> 9; const size_t row0_ = (size_t)bl_ * SEQ + cc_ * 64; \
        _Pragma("unroll") for (int i = 0; i < 2; ++i) { const int p = tid + 512 * i, tok = p >> 4, c8 = p & 15; const bf16* rp = proj + (row0_ + tok) * NCOL + h_ * 128 + c8 * 8; \
            rf[i] = *(const v4u*)(rp + C_HF); rv[i] = *(const v4u*)(rp + C_HI); } } while (0)
    HGA_LOAD(u);
    for (;;) {
        const int h = (u >> 6) & 7;
#pragma unroll
        for (int i = 0; i < 2; ++i) { const int p = tid + 512 * i, tok = p >> 4, c8 = p & 15;
            const f32x4 lb0 = *(const f32x4*)(lb + h * 128 + c8 * 8), lb1 = *(const f32x4*)(lb + h * 128 + c8 * 8 + 4);
            const unsigned fw[4] = {rf[i].x, rf[i].y, rf[i].z, rf[i].w}; f32x4 o0, o1;
#pragma unroll
            for (int j = 0; j < 4; ++j) { const float lbl = j < 2 ? lb0[2 * j] : lb1[2 * j - 4], lbh = j < 2 ? lb0[2 * j + 1] : lb1[2 * j - 3];
                const float fl = lbl + (1.f - lbl) * sigm(bflo(fw[j])), fh = lbh + (1.f - lbh) * sigm(bfhi(fw[j]));
                if (j < 2) { o0[2 * j] = __logf(fl); o0[2 * j + 1] = __logf(fh); } else { o1[2 * j - 4] = __logf(fl); o1[2 * j - 3] = __logf(fh); } }
            LAS float* lfp = (LAS float*)(lds + HG_LF) + tok * 132 + c8 * 8; *(LAS f32x4*)lfp = o0; *(LAS f32x4*)(lfp + 4) = o1;
            *(LAS v4u*)(lds + HG_VT + tok * 272 + c8 * 16) = rv[i]; }
        const int ucur = u; const int un = u + gridDim.x; const bool has_next = un < NU;
        if (has_next) HGA_LOAD(un);
        __syncthreads();
        float loc[16], pre, Gm, Gl; hg_scan(lds, tid, loc, pre, Gm, Gl);
        { const int ch = tid & 127, grp = tid >> 7; LAS bf16* KP = (LAS bf16*)(lds + HG_KP);
#pragma unroll
          for (int i = 0; i < 16; ++i) { const float lfi = loc[i] - (i ? loc[i - 1] : 0.f), G = pre + loc[i];
              const float kp = (1.f - __expf(lfi)) * __expf(fminf(Gm - G, 80.f)); KP[(16 * grp + i) * 136 + ch] = (bf16)f2bf(kp); }
          if (grp == 0) { D12[(size_t)ucur * 256 + ch] = __expf(Gm); D12[(size_t)ucur * 256 + 128 + ch] = __expf(Gl - Gm); } }
        __syncthreads();
        { bf16x8 af[2];
#pragma unroll
          for (int ks = 0; ks < 2; ++ks) { const LAS unsigned char* bp = lds + HG_KP + (32 * ks + 8 * g + q4) * 272 + (16 * w + 4 * p4) * 2; af[ks] = cat8(vtr(bp), vtr(bp + 4 * 272)); }
#pragma unroll
          for (int vt = 0; vt < 8; ++vt) { f32x4 acc = (f32x4){0.f, 0.f, 0.f, 0.f};
#pragma unroll
              for (int ks = 0; ks < 2; ++ks) { const LAS unsigned char* bp = lds + HG_VT + (32 * ks + 8 * g + q4) * 272 + (16 * vt + 4 * p4) * 2; acc = mfma16(af[ks], cat8(vtr(bp), vtr(bp + 4 * 272)), acc); }
              v2u wv; wv.x = pk2(acc[0], acc[1]); wv.y = pk2(acc[2], acc[3]);
              *(v2u*)(US + ((size_t)ucur * 128 + 16 * vt + l15) * 128 + 16 * w + 4 * g) = wv; } }
        __syncthreads();
        if (!has_next) break;
        u = un;
    }
}
__device__ __forceinline__ void hgB_work(const Args& a, const Ctx& c) {
    bf16* US = (bf16*)((unsigned char*)a.out + OUT_US); const float* D12 = (const float*)(a.ws + WS_D12);
    const int nthr = c.G * HGB_WAVES * 64, gt = ((int)blockIdx.x * HGB_WAVES + c.wave) * 64 + c.lane;
    for (int e = gt; e < 64 * 2048; e += nthr) {
        const int bh = e >> 11, r = e & 2047, k8 = r & 15;
        float S[8];
#pragma unroll
        for (int j = 0; j < 8; ++j) S[j] = 0.f;
        for (int c0 = 0; c0 < 64; c0 += 8) {
            v4u uw[8];
#pragma unroll
            for (int cc = 0; cc < 8; ++cc) uw[cc] = *(const v4u*)(US + ((size_t)bh * 64 + c0 + cc) * 16384 + (size_t)r * 8);
#pragma unroll
            for (int cc = 0; cc < 8; ++cc) { const size_t un = (size_t)bh * 64 + c0 + cc;
                const f32x4 d1a = *(const f32x4*)(D12 + un * 256 + k8 * 8), d1b = *(const f32x4*)(D12 + un * 256 + k8 * 8 + 4);
                const f32x4 d2a = *(const f32x4*)(D12 + un * 256 + 128 + k8 * 8), d2b = *(const f32x4*)(D12 + un * 256 + 128 + k8 * 8 + 4);
                const unsigned ww[4] = {uw[cc].x, uw[cc].y, uw[cc].z, uw[cc].w}; float sp[8];
#pragma unroll
                for (int j = 0; j < 8; ++j) { const float d1v = j < 4 ? d1a[j & 3] : d1b[j & 3], d2v = j < 4 ? d2a[j & 3] : d2b[j & 3]; const float uv = (j & 1) ? bfhi(ww[j >> 1]) : bflo(ww[j >> 1]);
                    sp[j] = d1v * S[j]; S[j] = d2v * (sp[j] + uv); }
                v4u o; o.x = pk2(sp[0], sp[1]); o.y = pk2(sp[2], sp[3]); o.z = pk2(sp[4], sp[5]); o.w = pk2(sp[6], sp[7]);
                *(v4u*)(US + un * 16384 + (size_t)r * 8) = o; }
        }
    }
}
__device__ __forceinline__ void phase_hgC(const Args& a, const Ctx& c) {
    const bf16* proj = (const bf16*)(a.ws + WS_PROJ); const bf16* US = (const bf16*)((unsigned char*)a.out + OUT_US); bf16* oa = (bf16*)(a.ws + WS_OA);
    const float* lb = (const float*)(a.ws + WS_LB); const float* hgain = a.in[7];
    LAS unsigned char* lds = c.lds; const int tid = c.tid, lane = c.lane, w = c.wave;
    const int l15 = lane & 15, g = lane >> 4, q4 = l15 >> 2, p4 = lane & 3;
    constexpr int NU = 8 * 8 * 64;
    int u = blockIdx.x; if (u >= NU) return;
    v4u rq[2], rf[2], rv[2];
#define HGC_LOAD(uu) do { const int cc_ = (uu) & 63, h_ = ((uu) >> 6) & 7, bl_ = (uu) >> 9; const size_t row0_ = (size_t)bl_ * SEQ + cc_ * 64; \
        _Pragma("unroll") for (int i = 0; i < 2; ++i) { const int p = tid + 512 * i, tok = p >> 4, c8 = p & 15; const bf16* rp = proj + (row0_ + tok) * NCOL + h_ * 128 + c8 * 8; \
            rq[i] = *(const v4u*)(rp + C_HQ); rf[i] = *(const v4u*)(rp + C_HF); rv[i] = *(const v4u*)(rp + C_HI); } } while (0)
    HGC_LOAD(u);
    const f32x4 gn = *(const f32x4*)(hgain + 16 * w + 4 * g);
    for (;;) {
        const int cc = u & 63, h = (u >> 6) & 7, bl = u >> 9; const size_t row0 = (size_t)bl * SEQ + cc * 64;
#pragma unroll
        for (int i = 0; i < 2; ++i) { const int p = tid + 512 * i, tok = p >> 4, c8 = p & 15;
            const f32x4 lb0 = *(const f32x4*)(lb + h * 128 + c8 * 8), lb1 = *(const f32x4*)(lb + h * 128 + c8 * 8 + 4);
            const unsigned fw[4] = {rf[i].x, rf[i].y, rf[i].z, rf[i].w}; f32x4 o0, o1;
#pragma unroll
            for (int j = 0; j < 4; ++j) { const float lbl = j < 2 ? lb0[2 * j] : lb1[2 * j - 4], lbh = j < 2 ? lb0[2 * j + 1] : lb1[2 * j - 3];
                const float fl = lbl + (1.f - lbl) * sigm(bflo(fw[j])), fh = lbh + (1.f - lbh) * sigm(bfhi(fw[j]));
                if (j < 2) { o0[2 * j] = __logf(fl); o0[2 * j + 1] = __logf(fh); } else { o1[2 * j - 4] = __logf(fl); o1[2 * j - 3] = __logf(fh); } }
            LAS float* lfp = (LAS float*)(lds + HG_LF) + tok * 132 + c8 * 8; *(LAS f32x4*)lfp = o0; *(LAS f32x4*)(lfp + 4) = o1;
            *(LAS v4u*)(lds + HG_VT + tok * 272 + c8 * 16) = rv[i];
            *(LAS v4u*)(lds + HG_QP + tok * 272 + c8 * 16) = rq[i]; }
        const int ucur = u; const int un = u + gridDim.x; const bool has_next = un < NU;
        if (has_next) HGC_LOAD(un);
        bf16x8 sf[4]; v2u gwv[4];
#pragma unroll
        for (int ks = 0; ks < 4; ++ks) sf[ks] = *(const bf16x8*)(US + ((size_t)ucur * 128 + 16 * w + l15) * 128 + 32 * ks + 8 * g);
#pragma unroll
        for (int tt = 0; tt < 4; ++tt) gwv[tt] = *(const v2u*)(proj + (row0 + 16 * tt + l15) * NCOL + C_HG + h * 128 + 16 * w + 4 * g);
        __syncthreads();
        float loc[16], pre, Gm, Gl; hg_scan(lds, tid, loc, pre, Gm, Gl);
        { const int ch = tid & 127, grp = tid >> 7; LAS bf16* KP = (LAS bf16*)(lds + HG_KP); LAS bf16* QP = (LAS bf16*)(lds + HG_QP);
#pragma unroll
          for (int i = 0; i < 16; ++i) { const float lfi = loc[i] - (i ? loc[i - 1] : 0.f), G = pre + loc[i];
              const float kp = (1.f - __expf(lfi)) * __expf(fminf(Gm - G, 80.f)); KP[(16 * grp + i) * 136 + ch] = (bf16)f2bf(kp);
              const float qr = __builtin_bit_cast(float, (unsigned)QP[(16 * grp + i) * 136 + ch] << 16);
              const float qp = qr * sigm(qr) * __expf(fminf(G - Gm, 80.f)); QP[(16 * grp + i) * 136 + ch] = (bf16)f2bf(qp); } }
        __syncthreads();
        f32x4 o[4];
        {
            bf16x8 vf[2];
#pragma unroll
            for (int kk = 0; kk < 2; ++kk) { const LAS unsigned char* bp = lds + HG_VT + (32 * kk + 4 * g + q4) * 272 + (16 * w + 4 * p4) * 2; vf[kk] = cat8(vtr(bp), vtr(bp + 16 * 272)); }
#pragma unroll
            for (int tt = 0; tt < 4; ++tt) {
                bf16x8 qf[4];
#pragma unroll
                for (int ks = 0; ks < 4; ++ks) qf[ks] = *(const LAS bf16x8*)(lds + HG_QP + (16 * tt + l15) * 272 + (32 * ks + 8 * g) * 2);
                f32x4 acc = (f32x4){0.f, 0.f, 0.f, 0.f};
#pragma unroll
                for (int ks = 0; ks < 4; ++ks) acc = mfma16(sf[ks], qf[ks], acc);
                f32x4 at[4];
#pragma unroll
                for (int st = 0; st < 4; ++st) { at[st] = (f32x4){0.f, 0.f, 0.f, 0.f};
                    if (st <= tt) {
#pragma unroll
                        for (int ks = 0; ks < 4; ++ks) { const bf16x8 kf = *(const LAS bf16x8*)(lds + HG_KP + (16 * st + l15) * 272 + (32 * ks + 8 * g) * 2); at[st] = mfma16(kf, qf[ks], at[st]); }
                        if (st == tt) {
#pragma unroll
                            for (int r = 0; r < 4; ++r) at[st][r] = (4 * g + r <= l15) ? at[st][r] : 0.f; } } }
                acc = mfma16(vf[0], pack8(at[0], at[1]), acc);
                if (tt >= 2) acc = mfma16(vf[1], pack8(at[2], at[3]), acc);
                o[tt] = acc; }
        }
        { LAS float* SSQ = (LAS float*)(lds + HG_SSQ);
#pragma unroll
          for (int tt = 0; tt < 4; ++tt) { float s = (o[tt][0] * o[tt][0] + o[tt][1] * o[tt][1]) + (o[tt][2] * o[tt][2] + o[tt][3] * o[tt][3]);
              s += shx(s, 16, lane); s += shx(s, 32, lane); if (g == 0) SSQ[w * 64 + 16 * tt + l15] = s; }
          __syncthreads();
#pragma unroll
          for (int tt = 0; tt < 4; ++tt) { float s = 0.f;
#pragma unroll
              for (int ww = 0; ww < 8; ++ww) s += SSQ[ww * 64 + 16 * tt + l15];
              const float rstd = rsqrtf(s * (1.f / 128.f) + RMS_EPS);
              const size_t row = row0 + 16 * tt + l15;
              const v2u gw = gwv[tt];
              const float g0 = bflo(gw.x), g1 = bfhi(gw.x), g2 = bflo(gw.y), g3 = bfhi(gw.y);
              const float r0 = o[tt][0] * rstd * gn[0] * (g0 * sigm(g0)), r1 = o[tt][1] * rstd * gn[1] * (g1 * sigm(g1));
              const float r2 = o[tt][2] * rstd * gn[2] * (g2 * sigm(g2)), r3 = o[tt][3] * rstd * gn[3] * (g3 * sigm(g3));
              v2u wv; wv.x = pk2(r0, r1); wv.y = pk2(r2, r3);
              *(v2u*)(oa + row * DM + h * 128 + 16 * w + 4 * g) = wv; } }
        if (!has_next) break;
        u = un;
    }
    __syncthreads();
}

typedef float f32x16 __attribute__((ext_vector_type(16)));
constexpr int XA_KROW = 528, XA_VROW = 72, XA_KB = 32 * XA_KROW, XA_VB = 256 * XA_VROW, XA_STAGE = XA_KB + XA_VB;
__device__ __forceinline__ void phase_xa(const Args& a, const Ctx& c) {
    const bf16* qg = (const bf16*)(a.ws + WS_Q); bf16* og = (bf16*)(a.ws + WS_O); const bf16* kx = (const bf16*)(a.ws + WS_KX); const bf16* vxt = (const bf16*)(a.ws + WS_VXT);
    LAS unsigned char* lds = c.lds; const int tid = c.tid, lane = c.lane, w = c.wave;
    const int l31 = lane & 31, hh = lane >> 5, qt = w & 3, dh = w >> 2;
    constexpr int NU = NBATCH * 4 * (SEQ / 128);
    int u = blockIdx.x; if (u >= NU) return;
    v4u rk[2], rv[2];
#define XA_LOAD(uu, kc) do { const int b_ = (uu) >> 7, h_ = ((uu) >> 5) & 3; \
        _Pragma("unroll") for (int i = 0; i < 2; ++i) { const int p = tid + 512 * i; \
            rk[i] = *(const v4u*)(kx + (size_t)(b_ * MEMLEN + (kc) * 32 + (p >> 5)) * DM + h_ * 256 + (p & 31) * 8); \
            rv[i] = *(const v4u*)(vxt + (size_t)(h_ * 256 + (p >> 2)) * (NBATCH * MEMLEN) + b_ * MEMLEN + (kc) * 32 + (p & 3) * 8); } } while (0)
#define XA_STORE(buf) do { LAS unsigned char* sb = lds + (buf) * XA_STAGE; \
        _Pragma("unroll") for (int i = 0; i < 2; ++i) { const int p = tid + 512 * i; \
            *(LAS v4u*)(sb + (p >> 5) * XA_KROW + (p & 31) * 16) = rk[i]; \
            LAS v2u* vp = (LAS v2u*)(sb + XA_KB + (p >> 2) * XA_VROW + (p & 3) * 16); v2u lo; lo.x = rv[i].x; lo.y = rv[i].y; v2u hi; hi.x = rv[i].z; hi.y = rv[i].w; vp[0] = lo; vp[1] = hi; } } while (0)
    XA_LOAD(u, 0); XA_STORE(0);
    int par = 0;
    for (;;) {
        const int b = u >> 7, h = (u >> 5) & 3, qb = u & 31;
        const size_t row0 = (size_t)b * SEQ + qb * 128 + qt * 32;
        bf16x8 qf[16];
#pragma unroll
        for (int ks = 0; ks < 16; ++ks) qf[ks] = *(const bf16x8*)(qg + (row0 + l31) * DM + h * 256 + 16 * ks + 8 * hh);
        float mx = -1e30f, ls = 0.f; f32x16 o[4];
#pragma unroll
        for (int dt = 0; dt < 4; ++dt)
#pragma unroll
            for (int r = 0; r < 16; ++r) o[dt][r] = 0.f;
        const int un = u + gridDim.x; const bool has_next = un < NU;
        for (int kc = 0; kc < 8; ++kc) {
            __syncthreads();
            const bool more = (kc < 7) || has_next;
            if (more) { if (kc < 7) XA_LOAD(u, kc + 1); else XA_LOAD(un, 0); }
            const LAS unsigned char* kb = lds + par * XA_STAGE; const LAS unsigned char* vb = kb + XA_KB;
            f32x16 s;
#pragma unroll
            for (int r = 0; r < 16; ++r) s[r] = 0.f;
#pragma unroll
            for (int ks = 0; ks < 16; ++ks) { const bf16x8 kf = *(const LAS bf16x8*)(kb + l31 * XA_KROW + (16 * ks + 8 * hh) * 2); s = __builtin_amdgcn_mfma_f32_32x32x16_bf16(kf, qf[ks], s, 0, 0, 0); }
            float cm = -1e30f;
#pragma unroll
            for (int r = 0; r < 16; ++r) { s[r] *= 0.0625f; cm = fmaxf(cm, s[r]); }
            cm = fmaxf(cm, shx(cm, 32, lane));
            const float mn = fmaxf(mx, cm), alpha = __expf(mx - mn); mx = mn; float rs = 0.f;
#pragma unroll
            for (int r = 0; r < 16; ++r) { s[r] = __expf(s[r] - mn); rs += s[r]; }
            rs += shx(rs, 32, lane); ls = ls * alpha + rs;
#pragma unroll
            for (int dt = 0; dt < 4; ++dt)
#pragma unroll
                for (int r = 0; r < 16; ++r) o[dt][r] *= alpha;
            bf16x8 pf[2];
#pragma unroll
            for (int st = 0; st < 2; ++st) { v4u pw; pw.x = pk2(s[8 * st], s[8 * st + 1]); pw.y = pk2(s[8 * st + 2], s[8 * st + 3]); pw.z = pk2(s[8 * st + 4], s[8 * st + 5]); pw.w = pk2(s[8 * st + 6], s[8 * st + 7]); pf[st] = __builtin_bit_cast(bf16x8, pw); }
#pragma unroll
            for (int dt = 0; dt < 4; ++dt) { const LAS unsigned char* vrow = vb + (128 * dh + 32 * dt + l31) * XA_VROW + 8 * hh;
#pragma unroll
                for (int st = 0; st < 2; ++st) { const s16x4 lo = *(const LAS s16x4*)(vrow + 32 * st), hi = *(const LAS s16x4*)(vrow + 32 * st + 16);
                    o[dt] = __builtin_amdgcn_mfma_f32_32x32x16_bf16(cat8(lo, hi), pf[st], o[dt], 0, 0, 0); } }
            if (more) XA_STORE(par ^ 1);
            par ^= 1;
        }
        const float inv = 1.f / ls;
#pragma unroll
        for (int dt = 0; dt < 4; ++dt)
#pragma unroll
            for (int rg = 0; rg < 4; ++rg) { v2u wv; wv.x = pk2(o[dt][4 * rg] * inv, o[dt][4 * rg + 1] * inv); wv.y = pk2(o[dt][4 * rg + 2] * inv, o[dt][4 * rg + 3] * inv);
                *(v2u*)(og + (row0 + l31) * DM + h * 256 + 128 * dh + 32 * dt + 8 * rg + 4 * hh) = wv; }
        if (!has_next) break;
        u = un;
    }
    __syncthreads();
#undef XA_LOAD
#undef XA_STORE
}

__device__ __forceinline__ void phase_expert_weights(const Args& a, const Ctx& c) {
    LAS float* scr = (LAS float*)(c.lds + c.wave * 16384);
    constexpr int I_GU = 16 * 64, I_D = 16 * 32;
    constexpr int NGU = NEXP * I_GU, NIT = NEXP * (I_GU + I_D);
#define EW_GEO(it, W_, N_, k0_, n0_) const bool gu_##W_ = (it) < NGU; const int r_##W_ = gu_##W_ ? (it) : (it) - NGU; const int e_##W_ = gu_##W_ ? r_##W_ / I_GU : r_##W_ / I_D; \
        const int q_##W_ = gu_##W_ ? r_##W_ % I_GU : r_##W_ % I_D; const int N_ = gu_##W_ ? 2048 : 1024; const int nblk_##W_ = N_ / 32; const int k0_ = 64 * (q_##W_ / nblk_##W_), n0_ = 32 * (q_##W_ % nblk_##W_); \
        const float* W_ = gu_##W_ ? a.in[20] + (size_t)e_##W_ * DM * 2048 : a.in[22] + (size_t)e_##W_ * DM * DM
    int it = c.gw; if (it >= NIT) { __syncthreads(); return; }
    TItem t;
    { EW_GEO(it, W0, N0, k00, n00); titem_load(t, W0, N0, gu_W0 ? a.in[17] : nullptr, k00, n00, c.lane); }
    for (;;) {
        EW_GEO(it, Wc, Nc, k0c, n0c);
        titem_to_lds(t, scr, c.lane);
        const int itn = it + c.ngw; const bool more = itn < NIT;
        if (more) { EW_GEO(itn, Wn, Nn, k0n, n0n); titem_load(t, Wn, Nn, gu_Wn ? a.in[17] : nullptr, k0n, n0n, c.lane); }
        if (gu_Wc) titem_out8(DM, a.ws + WS_WGU, scr, k0c, n0c, c.lane, RowGU{e_Wc});
        else titem_out8(DM, a.ws + WS_WD, scr, k0c, n0c, c.lane, RowId{e_Wc * 1024});
        if (!more) break;
        it = itn;
    }
#undef EW_GEO
    __syncthreads();
}
__device__ __forceinline__ void phase_router(const Args& a, const Ctx& c) {
    const bf16* xb = (const bf16*)(a.ws + WS_XBF); const bf16* wr = (const bf16*)(a.ws + WS_WR); const float* ssq2 = (const float*)(a.ws + WS_SSQ2); const float* br = a.in[19];
    int* tope = (int*)(a.ws + WS_TOPE); float* topg = (float*)(a.ws + WS_TOPG); int* topr = (int*)(a.ws + WS_TOPR); unsigned* gcnt = (unsigned*)(a.ws + WS_GCNT);
    LAS unsigned char* lds = c.lds; const int lane = c.lane, w = c.wave, l15 = lane & 15, g = lane >> 4;
    LAS float* LG = (LAS float*)(lds + w * 4096);
    LAS int* LE = (LAS int*)(lds + w * 4096 + 2560); LAS float* LGT = (LAS float*)(lds + w * 4096 + 2816);
    int* rtok = (int*)(a.ws + WS_RTOK); float* rgate = (float*)(a.ws + WS_RGATE2); float* rrstd = (float*)(a.ws + WS_RRSTD2);
    LAS unsigned* CNT = (LAS unsigned*)(lds + 32768); LAS unsigned* BASE = CNT + 32;
    for (int it = blockIdx.x; it < NTOK / 128; it += gridDim.x) {
        const int tok0 = it * 128 + w * 16; const int half = tok0 >= HTOK;
        if (c.tid < 32) CNT[c.tid] = 0u;
        f32x4 acc[2] = {(f32x4){0.f, 0.f, 0.f, 0.f}, (f32x4){0.f, 0.f, 0.f, 0.f}};
        const bf16* ap = xb + (size_t)(tok0 + l15) * DM + 8 * g;
#pragma unroll 8
        for (int ks = 0; ks < 32; ++ks) { const bf16x8 af = *(const bf16x8*)(ap + 32 * ks);
#pragma unroll
            for (int nt = 0; nt < 2; ++nt) { const bf16x8 bf = *(const bf16x8*)(wr + (size_t)(16 * nt + l15) * DM + 32 * ks + 8 * g); acc[nt] = mfma16(af, bf, acc[nt]); } }
#pragma unroll
        for (int nt = 0; nt < 2; ++nt)
#pragma unroll
            for (int r = 0; r < 4; ++r) { const int t = 4 * g + r; const float rs = rstd16(ssq2, (size_t)(tok0 + t)); LG[t * 33 + 16 * nt + l15] = acc[nt][r] * rs + br[16 * nt + l15]; }
        LDS_WAIT();
        if (lane < 16) { float v[32];
#pragma unroll
            for (int e = 0; e < 32; ++e) v[e] = LG[lane * 33 + e];
            int se[4]; float sv[4];
#pragma unroll
            for (int k = 0; k < 4; ++k) { float best = -3e38f; int bi = 0;
#pragma unroll
                for (int e = 0; e < 32; ++e) { const bool bt = v[e] > best; best = bt ? v[e] : best; bi = bt ? e : bi; }
                se[k] = bi; sv[k] = best;
#pragma unroll
                for (int e = 0; e < 32; ++e) v[e] = (e == bi) ? -3e38f : v[e]; }
            const float e1 = __expf(sv[1] - sv[0]), e2 = __expf(sv[2] - sv[0]), e3 = __expf(sv[3] - sv[0]); const float inv = 1.f / (1.f + e1 + e2 + e3);
            const int tok = tok0 + lane;
            *(int4*)(tope + (size_t)tok * 4) = make_int4(se[0], se[1], se[2], se[3]);
            *(float4*)(topg + (size_t)tok * 4) = make_float4(inv, e1 * inv, e2 * inv, e3 * inv);
#pragma unroll
            for (int k = 0; k < 4; ++k) LE[lane * 4 + k] = se[k];
            LGT[lane * 4 + 0] = inv; LGT[lane * 4 + 1] = e1 * inv; LGT[lane * 4 + 2] = e2 * inv; LGT[lane * 4 + 3] = e3 * inv; }
        __syncthreads();
        const int myE = LE[lane];
        const unsigned lr = atomicAdd((unsigned*)&CNT[myE], 1u);
        __syncthreads();
        if (c.tid < 32) { const unsigned n = CNT[c.tid]; BASE[c.tid] = n ? atomicAdd(gcnt + (half * 32 + c.tid) * 16, n) : 0u; }
        __syncthreads();
        { const int rank = (int)(BASE[myE] + lr), tok = tok0 + (lane >> 2); topr[(size_t)tok * 4 + (lane & 3)] = rank;
          const size_t ri = (size_t)(half * 32 + myE) * HTOK + rank; rtok[ri] = tok; rgate[ri] = LGT[lane]; rrstd[ri] = rstd16(ssq2, (size_t)tok); }
        __syncthreads();
    }
}
__device__ __forceinline__ void add16(f32x4 (&v)[4], const v4u y0, const v4u y1) {
    v[0][0] += bflo(y0.x); v[0][1] += bfhi(y0.x); v[0][2] += bflo(y0.y); v[0][3] += bfhi(y0.y); v[1][0] += bflo(y0.z); v[1][1] += bfhi(y0.z); v[1][2] += bflo(y0.w); v[1][3] += bfhi(y0.w);
    v[2][0] += bflo(y1.x); v[2][1] += bfhi(y1.x); v[2][2] += bflo(y1.y); v[2][3] += bfhi(y1.y); v[3][0] += bflo(y1.z); v[3][1] += bfhi(y1.z); v[3][2] += bflo(y1.w); v[3][3] += bfhi(y1.w);
}
__device__ __forceinline__ void phase_combine(const Args& a, const Ctx& c, int hb) {
    const bf16* y = (const bf16*)(a.ws + WS_Y); const bf16* xb = (const bf16*)(a.ws + WS_XBF); const int* tope = (const int*)(a.ws + WS_TOPE); const int* topr = (const int*)(a.ws + WS_TOPR); const float* gf = a.in[24];
    moe_tables(a.ws, hb, c.lds, c.tid);
    const LAS unsigned* tab = (const LAS unsigned*)(c.lds + MOE_TAB_OFF);
    for (int i = c.gw; i < HTOK; i += c.ngw) { const int tok = hb * HTOK + i;
        const int4 ee = *(const int4*)(tope + (size_t)tok * 4), rr = *(const int4*)(topr + (size_t)tok * 4);
        const int ps[4] = {(int)tab[32 + ee.x] * 256 + rr.x, (int)tab[32 + ee.y] * 256 + rr.y, (int)tab[32 + ee.z] * 256 + rr.z, (int)tab[32 + ee.w] * 256 + rr.w};
        f32x4 v[4];
#pragma unroll
        for (int j = 0; j < 4; ++j) v[j] = (f32x4){0.f, 0.f, 0.f, 0.f};
        { const v4u* xp = (const v4u*)(xb + (size_t)tok * DM + c.lane * 16); add16(v, xp[0], xp[1]); }
#pragma unroll
        for (int k = 0; k < 4; ++k) { const v4u* yp = (const v4u*)(y + (size_t)ps[k] * DM + c.lane * 16); add16(v, yp[0], yp[1]); }
        float s = 0.f;
#pragma unroll
        for (int j = 0; j < 4; ++j) s += (v[j][0] * v[j][0] + v[j][1] * v[j][1]) + (v[j][2] * v[j][2] + v[j][3] * v[j][3]);
        const float rstd = rsqrtf(wave_sum(s, c.lane) * (1.f / DM) + RMS_EPS);
        float* xr = a.out + (size_t)tok * DM + c.lane * 16;
#pragma unroll
        for (int j = 0; j < 4; ++j) { const f32x4 gg = *(const f32x4*)(gf + c.lane * 16 + 4 * j); *(f32x4*)(xr + 4 * j) = v[j] * rstd * gg; } }
}

#ifndef MK_PER_PHASE_LAUNCH
#define MK_PER_PHASE_LAUNCH 0
#endif
constexpr int NPHASES = 27;
#ifndef MK_OFF
#define MK_OFF 0u
#endif
#define MKP(k) (((MK_OFF >> (k)) & 1u) == 0u)
#define GSCHED PG8_ALIGN, PG8_SP2
typedef const __attribute__((address_space(4))) Args* KArgP;
#if defined(__HIP_DEVICE_COMPILE__)
__device__ __forceinline__ Args ldargs() { KArgP kp = (KArgP)__builtin_amdgcn_kernarg_segment_ptr(); asm volatile("" : "+s"(kp)); Args r;
#pragma unroll
    for (int i = 0; i < 25; ++i) r.in[i] = kp->in[i];
    r.out = kp->out; r.ws = kp->ws; r.ph_lo = kp->ph_lo; r.ph_hi = kp->ph_hi; return r; }
#else
__device__ __forceinline__ Args ldargs() { return Args{}; }
#endif
__global__ void __launch_bounds__(512, 2) mk_fwd(Args a_) {
    extern __shared__ __attribute__((aligned(16))) unsigned char lds_raw[];
    Ctx c; c.lds = (LAS unsigned char*)lds_raw; c.tid = threadIdx.x; c.lane = c.tid & 63; c.wave = __builtin_amdgcn_readfirstlane(c.tid >> 6); const int wv = c.wave;
    c.G = gridDim.x; c.gw = blockIdx.x * 8 + c.wave; c.ngw = c.G * 8;
    volatile LAS unsigned* MISC = (volatile LAS unsigned*)(c.lds + MISC_OFF);
    for (int u = c.tid; u < (LDS_BYTES - RING_BYTES) / 4; u += 512) ((LAS unsigned*)(c.lds + RING_BYTES))[u] = 0u;
    __syncthreads();
    const int ph_lo = a_.ph_lo, ph_hi = a_.ph_hi;
    const bool fused = (ph_hi - ph_lo) > 1;
    unsigned* barw = (unsigned*)a_.ws + CW_BAR;
    XcdBarrier bar; bar.bar = barw; bar.x = 0; bar.st = MISC + 8; bar.t0 = wv;
    if (fused) bar = xcd_barrier_post(barw, MISC + 8, wv);
    int pc = 0;
#define PH_ON (pc >= ph_lo && pc < ph_hi)
#define PH_END do { if (PH_ON && pc + 1 < ph_hi) xcd_barrier(bar); ++pc; OPQ(c); } while (0)
    LAS unsigned char* ring = c.lds;
#define OPQ(cc) do { { unsigned z_ = 0u; asm volatile("" : "+v"(z_)); cc.lane = (int)__builtin_amdgcn_mbcnt_hi(~0u, __builtin_amdgcn_mbcnt_lo(~0u, z_)); } cc.wave = wv; cc.tid = wv * 64 + cc.lane; { int gw_ = (int)blockIdx.x * 8 + wv; asm volatile("" : "+s"(gw_)); cc.gw = gw_; } } while (0)

    if (MKP(0) && PH_ON) { const Args a = ldargs(); unsigned char* ws = a.ws; (void)ws;  phase_prologue(a, c); __syncthreads(); }
    PH_END;
#pragma unroll
    for (int hb = 0; hb < 2; ++hb) {
        const size_t toff = (size_t)hb * HTOK;
        if (MKP(1) && PH_ON) { const Args a = ldargs(); phase_norm1(a, c, hb); }
        PH_END;
        if (MKP(2) && PH_ON) { const Args a = ldargs(); unsigned char* ws = a.ws; (void)ws;  pg8::Gemm g{(const bf16*)(ws + WS_TM), (const bf16*)(ws + WS_WIN), HTOK, NCOL, DM}; pg8::StaticOrder S; S.init(HTOK, NCOL, c.G, (int)blockIdx.x);
            EpiStore E{(bf16*)(ws + WS_PROJ), NCOL, nullptr}; pg8::gemm_phase<EpiStore, pg8::StaticOrder, GSCHED>(ring, g, S, E, wv); }
        PH_END;
        if (MKP(3) && PH_ON) { const Args a = ldargs(); unsigned char* ws = a.ws; (void)ws;  phase_hgA(a, c); }
        PH_END;
        if (MKP(4) && PH_ON) { const Args a = ldargs(); phase_swa_hgB(a, c); }
        PH_END;
        if (MKP(5) && PH_ON) { const Args a = ldargs(); phase_hgC(a, c); }
        PH_END;
        if (MKP(6) && PH_ON) { const Args a = ldargs(); unsigned char* ws = a.ws; (void)ws;  pg8::Gemm g{(const bf16*)(ws + WS_OA), (const bf16*)(ws + WS_WA), HTOK, DM, DM}; pg8::StaticOrder S; S.init(HTOK, DM, c.G, (int)blockIdx.x);
            EpiGate<false> E{(bf16*)(ws + WS_TM), (const bf16*)(ws + WS_PROJ), C_GA, a.in[6]}; pg8::gemm_phase<EpiGate<false>, pg8::StaticOrder, GSCHED>(ring, g, S, E, wv); }
        PH_END;
        if (MKP(7) && PH_ON) { const Args a = ldargs(); unsigned char* ws = a.ws; (void)ws;  pg8::Gemm g{(const bf16*)(ws + WS_OB), (const bf16*)(ws + WS_WB), HTOK, DM, DM}; pg8::StaticOrder S; S.init(HTOK, DM, c.G, (int)blockIdx.x);
            EpiGate<true> E{(bf16*)(ws + WS_TM), (const bf16*)(ws + WS_PROJ), C_GB, a.in[6] + DM}; pg8::gemm_phase<EpiGate<true>, pg8::StaticOrder, GSCHED>(ring, g, S, E, wv); }
        PH_END;
        if (MKP(8) && PH_ON) { const Args a = ldargs(); unsigned char* ws = a.ws; (void)ws;  pg8::Gemm g{(const bf16*)(ws + WS_TM), (const bf16*)(ws + WS_WMIX), HTOK, DM, DM}; pg8::StaticOrder S; S.init(HTOK, DM, c.G, (int)blockIdx.x);
            EpiResid<false> E{a.in[0] + toff * DM, (bf16*)(ws + WS_XBF) + toff * DM, (float*)(ws + WS_SSQ1) + toff * 16, nullptr}; pg8::gemm_phase<EpiResid<false>, pg8::StaticOrder, GSCHED>(ring, g, S, E, wv); }
        PH_END;
    }
    if (MKP(9) && PH_ON) { const Args a = ldargs(); unsigned char* ws = a.ws; (void)ws;
        phase_expert_weights(a, c);
        { pg8::Gemm g{(const bf16*)(ws + WS_MEMBF), (const bf16*)(ws + WS_WK), NBATCH * MEMLEN, DM, DM}; pg8::StaticOrder S; S.init(NBATCH * MEMLEN, DM, c.G, (int)blockIdx.x);
          EpiStore E{(bf16*)(ws + WS_KX), DM, nullptr}; pg8::gemm_phase<EpiStore, pg8::StaticOrder, GSCHED>(ring, g, S, E, wv); }
        { pg8::Gemm g{(const bf16*)(ws + WS_WV), (const bf16*)(ws + WS_MEMBF), DM, NBATCH * MEMLEN, DM}; pg8::StaticOrder S; S.init(DM, NBATCH * MEMLEN, c.G, (int)((blockIdx.x + 64) % c.G));
          EpiStore E{(bf16*)(ws + WS_VXT), NBATCH * MEMLEN, nullptr}; pg8::gemm_phase<EpiStore, pg8::StaticOrder, GSCHED>(ring, g, S, E, wv); }
        { pg8::Gemm g{(const bf16*)(ws + WS_XBF), (const bf16*)(ws + WS_WQ), NTOK, DM, DM}; pg8::StaticOrder S; S.init(NTOK, DM, c.G, (int)blockIdx.x);
          EpiStore E{(bf16*)(ws + WS_Q), DM, (const float*)(ws + WS_SSQ1)}; pg8::gemm_phase<EpiStore, pg8::StaticOrder, GSCHED>(ring, g, S, E, wv); }
    }
    PH_END;
    if (MKP(10) && PH_ON) { const Args a = ldargs(); phase_xa(a, c); }
    PH_END;
    if (MKP(11) && PH_ON) { const Args a = ldargs(); unsigned char* ws = a.ws; (void)ws;  pg8::Gemm g{(const bf16*)(ws + WS_O), (const bf16*)(ws + WS_WO), NTOK, DM, DM}; pg8::StaticOrder S; S.init(NTOK, DM, c.G, (int)blockIdx.x);
        EpiResid<true> E{nullptr, (bf16*)(ws + WS_XBF), (float*)(ws + WS_SSQ2), ws + WS_X2F8}; pg8::gemm_phase<EpiResid<true>, pg8::StaticOrder, GSCHED>(ring, g, S, E, wv); }
    PH_END;
    if (MKP(12) && PH_ON) { const Args a = ldargs(); phase_router(a, c); }
    PH_END;
#pragma unroll
    for (int hb = 0; hb < 2; ++hb) {
        if (MKP(14) && PH_ON) { const Args a = ldargs(); unsigned char* ws = a.ws; moe_tables(ws, hb, c.lds, c.tid);
            const LAS unsigned* tab = (const LAS unsigned*)(c.lds + MOE_TAB_OFF); const int nb = (int)__builtin_amdgcn_readfirstlane(tab[64]);
            pg8::Gemm g{(const bf16*)(ws + WS_X2F8), (const bf16*)(ws + WS_WGU), NTOK, NEXP * 2048, DM};              GroupedOrder S{nb * 8, 8, c.G, (int)blockIdx.x, hb, tab, (const int*)(ws + WS_RTOK)};
            EpiSwiglu E{ws + WS_ACT, a.in[21], (const float*)(ws + WS_RRSTD2)}; pg8::gemm_phase_gather8<EpiSwiglu, GroupedOrder>(ring, g, S, E, wv); }
        PH_END;
        if (MKP(15) && PH_ON) { const Args a = ldargs(); unsigned char* ws = a.ws; moe_tables(ws, hb, c.lds, c.tid);
            const LAS unsigned* tab = (const LAS unsigned*)(c.lds + MOE_TAB_OFF); const int nb = (int)__builtin_amdgcn_readfirstlane(tab[64]);
            pg8::Gemm g{(const bf16*)(ws + WS_ACT), (const bf16*)(ws + WS_WD), CAPH, NEXP * 1024, DM}; GroupedOrder S{nb * 4, 4, c.G, (int)blockIdx.x, hb, tab, (const int*)(ws + WS_RTOK)};
            EpiDown E{(bf16*)(ws + WS_Y), a.in[23], (const float*)(ws + WS_RGATE2)}; pg8::gemm_phase8<EpiDown, GroupedOrder, GSCHED>(ring, g, S, E, wv); }
        PH_END;
        if (MKP(16) && PH_ON) { const Args a = ldargs(); phase_combine(a, c, hb); }
        PH_END;
    }
#undef PH_ON
#undef PH_END
}

#if defined(MK_DBG_STOP)
#ifndef MK_DBG_SRC_OUT
#define MK_DBG_SRC_OUT 0
#endif
#ifndef MK_DBG_F32
#define MK_DBG_F32 0
#endif
__global__ void dbg_dump(const unsigned short* src, float* out, size_t n, size_t N) {
    for (size_t i = (size_t)blockIdx.x * blockDim.x + threadIdx.x; i < N; i += (size_t)gridDim.x * blockDim.x) {
        if (i < n) { float v = MK_DBG_F32 ? ((const float*)src)[i] : __builtin_bit_cast(float, (unsigned)src[i] << 16); if (!(fabsf(v) < 1e30f)) v = 12345.f; out[i] = v; }
        else if (!MK_DBG_SRC_OUT) out[i] = 0.f;
    }
}
__global__ void dbg_zero_upper(float* out, size_t n0, size_t N) { for (size_t i = n0 + (size_t)blockIdx.x * blockDim.x + threadIdx.x; i < N; i += (size_t)gridDim.x * blockDim.x) out[i] = 0.f; }
#endif
extern "C" void kernel_launch(void* const* d_in, const int* in_sizes, int n_in, void* d_out, int out_size, void* d_ws, size_t ws_size, hipStream_t stream) {
    static int grid = 0;
    if (grid == 0) {
        if (n_in != 25 || out_size != NTOK * DM || ws_size < WS_END) { fprintf(stderr, "kernel_launch: unexpected problem shape (n_in %d, out %d, ws %zu); nothing launched\n", n_in, out_size, ws_size); grid = -1; return; }
        int dev = 0, cus = 0, per_cu = 0;
        if (hipGetDevice(&dev) != hipSuccess || hipDeviceGetAttribute(&cus, hipDeviceAttributeMultiprocessorCount, dev) != hipSuccess) { grid = -1; return; }
        if (hipFuncSetAttribute((const void*)mk_fwd, hipFuncAttributeMaxDynamicSharedMemorySize, LDS_BYTES) != hipSuccess) { fprintf(stderr, "kernel_launch: hipFuncSetAttribute failed\n"); grid = -1; return; }
        if (hipOccupancyMaxActiveBlocksPerMultiprocessor(&per_cu, (const void*)mk_fwd, 512, LDS_BYTES) != hipSuccess || per_cu < 1) { fprintf(stderr, "kernel_launch: occupancy query reports %d blocks per CU\n", per_cu); }
        (void)hipGetLastError();
        grid = cus;
    }
    if (grid < 0) return;
    (void)in_sizes;
    hipMemsetAsync(d_ws, 0, WS_ZERO_BYTES, stream);
    Args a{};
    for (int i = 0; i < 25; ++i) a.in[i] = (const float*)d_in[i];
    a.out = (float*)d_out; a.ws = (unsigned char*)d_ws;
#if defined(MK_DBG_STOP)
    for (int p = 0; p < MK_DBG_STOP; ++p) { a.ph_lo = p; a.ph_hi = p + 1; hipLaunchKernelGGL(mk_fwd, dim3(grid), dim3(512), LDS_BYTES, stream, a); }
    hipLaunchKernelGGL(dbg_dump, dim3(2048), dim3(256), 0, stream, (const unsigned short*)((const unsigned char*)(MK_DBG_SRC_OUT ? d_out : d_ws) + (size_t)MK_DBG_OFF_MIB * MiB), (float*)d_out, (size_t)MK_DBG_MIB * MiB / (MK_DBG_F32 ? 4 : 2), (size_t)NTOK * DM);
    if (MK_DBG_SRC_OUT) hipLaunchKernelGGL(dbg_zero_upper, dim3(2048), dim3(256), 0, stream, (float*)d_out, (size_t)MK_DBG_MIB * MiB / 2, (size_t)NTOK * DM);
#elif MK_PER_PHASE_LAUNCH
    for (int p = 0; p < NPHASES; ++p) { a.ph_lo = p; a.ph_hi = p + 1; hipLaunchKernelGGL(mk_fwd, dim3(grid), dim3(512), LDS_BYTES, stream, a);
#if defined(MK_REP_PC)
        if (p == MK_REP_PC) for (int r = 0; r < MK_REP_N; ++r) { if (p == 22 && false) (void)hipMemsetAsync((char*)d_ws + WS_GCNT, 0, 4096, stream); hipLaunchKernelGGL(mk_fwd, dim3(grid), dim3(512), LDS_BYTES, stream, a); }
#endif
    }
#else
    a.ph_lo = 0; a.ph_hi = NPHASES;
    hipLaunchKernelGGL(mk_fwd, dim3(grid), dim3(512), LDS_BYTES, stream, a);
#endif
}
```

```cpp
#include <hip/hip_runtime.h>
#include <cstdio>
#include <cstdint>
namespace pg8 {
#define PG8_LAS __attribute__((address_space(3)))
typedef unsigned short bf16_t;
typedef short bf16x8 __attribute__((ext_vector_type(8)));
typedef float f32x4 __attribute__((ext_vector_type(4)));
typedef unsigned u32x4 __attribute__((ext_vector_type(4)));
constexpr int BM = 256, BK = 64, HALF = 128, HTB = HALF * BK * 2  , STAGE_BYTES = 8 * HTB, NXCD = 8, WGM = 8;

__host__ __device__ __forceinline__ int lds_byte(int r, int c) { const int st = (r >> 4) * 2 + (c >> 5), rr = r & 15, cc = c & 31, ob = rr * 64 + cc * 2; return st * 1024 + (ob ^ (((ob >> 9) & 1) << 5)); }
__host__ __device__ __forceinline__ void stage_rc(int b, int& R, int& C) { const int st = b / 1024, sb = b % 1024, swz = sb ^ (((sb >> 9) & 1) << 5); R = (st >> 1) * 16 + swz / 64; C = (st & 1) * 32 + (swz % 64) / 2; }
__host__ __device__ __forceinline__ int perm32(int rho) { const int n = rho >> 4, i = rho & 15; return 8 * (i >> 2) + 4 * n + (i & 3); }

struct Unit { int pm, pn, aux, cnt; };
struct Gemm { const bf16_t* A; const bf16_t* Bt; int M, N, K; };

struct StaticOrder {
    int nM, nN, nwg, G, c;
    __host__ __device__ void init(int M, int N, int G_, int c_) { nM = M / BM; nN = N / BM; nwg = nM * nN; G = G_; c = c_; }
    __host__ __device__ bool next(int i, Unit& u) const {
        const long L = (long)i * G + c; if (L >= nwg) return false;
        int wgid = (int)L; { const int q = nwg / NXCD, r = nwg % NXCD, xcd = wgid % NXCD, off = wgid / NXCD; wgid = (xcd < r ? xcd * (q + 1) : r * (q + 1) + (xcd - r) * q) + off; }
        const int nig = WGM * nN, gid = wgid / nig, fm = gid * WGM, gsz = (nM - fm) < WGM ? (nM - fm) : WGM;
        u.pm = fm + ((wgid % nig) % gsz); u.pn = (wgid % nig) / gsz; return true;
    }
    __device__ __forceinline__ void a_ready(const Unit&) const {}
    __device__ __forceinline__ void done(const Unit&) const {}
};

__device__ __forceinline__ unsigned cvt_pk_bf16(float lo, float hi) { unsigned r; asm volatile("v_cvt_pk_bf16_f32 %0, %1, %2" : "=v"(r) : "v"(lo), "v"(hi)); return r; }
typedef float f32x2 __attribute__((ext_vector_type(2)));
template <class Epi, class Sched, bool ALIGN_EPI = false, bool SP2 = false>
__device__ __forceinline__ void gemm_phase(PG8_LAS unsigned char* lds, const Gemm g, const Sched& S, const Epi& E, const int wave_in) {
    unsigned z_ = 0u; asm volatile("" : "+v"(z_)); const int tid_ = (int)__builtin_amdgcn_mbcnt_hi(~0u, __builtin_amdgcn_mbcnt_lo(~0u, z_)) + 64 * wave_in;
    const int tid = tid_, wid = __builtin_amdgcn_readfirstlane(tid >> 6), lane = tid & 63, wr = wid >> 2, wc = wid & 3, fr = lane & 15, fq = lane >> 4;
    const int K = g.K, nt = K / BK;
    unsigned voffA[2], voffB[2];
#pragma unroll
    for (int i = 0; i < 2; ++i) { int R, C; stage_rc(tid * 16 + i * 8192, R, C); const int Rb = Epi::PERM ? ((R & ~31) + perm32(R & 31)) : R;
        voffA[i] = (unsigned)(R * K + C) * 2u; voffB[i] = (unsigned)(Rb * K + C) * 2u; }
    const size_t kstep = (size_t)(BK * 2);
    const size_t hstep = (size_t)HALF * K * 2;
    const size_t tstep = 2 * hstep;
    const unsigned ldsw = (unsigned)wid * 1024u;
    const int aoff = lds_byte(wr * 64 + fr, fq * 8), boff = lds_byte(wc * 32 + fr, fq * 8);
#define PG8_SA(b, h) (((b) * 2 + (h)) * HTB)
#define PG8_SB(b, h) ((4 + (b) * 2 + (h)) * HTB)
#define PG8_STAGE(bufoff, gbase, voff) do { _Pragma("unroll") for (int _i = 0; _i < 2; ++_i) \
        __builtin_amdgcn_global_load_lds((const unsigned*)((const char*)(gbase) + (voff)[_i]), (PG8_LAS unsigned*)(lds + (bufoff) + ldsw + _i * 8192), 16, 0, 0); } while (0)
#define PG8_LDA(dst, b, h) do { _Pragma("unroll") for (int m = 0; m < 4; ++m) _Pragma("unroll") for (int k = 0; k < 2; ++k) dst[m][k] = *(const PG8_LAS bf16x8*)(lds + PG8_SA(b, h) + aoff + m * 2048 + k * 1024); } while (0)
#define PG8_LDB(dst, b, h) do { _Pragma("unroll") for (int n = 0; n < 2; ++n) _Pragma("unroll") for (int k = 0; k < 2; ++k) dst[n][k] = *(const PG8_LAS bf16x8*)(lds + PG8_SB(b, h) + boff + n * 2048 + k * 1024); } while (0)
#define PG8_MMA(ai, bj, At, Bt) do { __builtin_amdgcn_s_setprio(1); _Pragma("unroll") for (int m = 0; m < 4; ++m) _Pragma("unroll") for (int n = 0; n < 2; ++n) _Pragma("unroll") for (int k = 0; k < 2; ++k) \
        acc[ai][bj][m][n] = __builtin_amdgcn_mfma_f32_16x16x32_bf16(Bt[n][k], At[m][k], acc[ai][bj][m][n], 0, 0, 0); __builtin_amdgcn_s_setprio(0); } while (0)
#define PG8_WAIT_V(n) asm volatile("s_waitcnt vmcnt(" #n ")" ::: "memory")
#define PG8_WAIT_L(n) asm volatile("s_waitcnt lgkmcnt(" #n ")" ::: "memory")
#define PG8_BAR __builtin_amdgcn_s_barrier()
#define PG8_SCHED __builtin_amdgcn_sched_barrier(0)
    Unit cur, nxt; int ui = 0;
    if (!S.next(0, cur)) return;
    f32x4 acc[2][2][4][2];
#pragma unroll
    for (int a = 0; a < 2; ++a)
#pragma unroll
        for (int b = 0; b < 2; ++b)
#pragma unroll
            for (int m = 0; m < 4; ++m)
#pragma unroll
                for (int n = 0; n < 2; ++n) acc[a][b][m][n] = (f32x4){0.f, 0.f, 0.f, 0.f};
    bf16x8 At[4][2], B0[2][2], B1[2][2];
    const char* cA = (const char*)g.A + (size_t)cur.pm * tstep; const char* cB = (const char*)g.Bt + (size_t)cur.pn * tstep;
    S.a_ready(cur);
    if constexpr (SP2) {
        PG8_STAGE(PG8_SB(0, 0), cB, voffB); PG8_STAGE(PG8_SB(0, 1), cB + hstep, voffB); PG8_STAGE(PG8_SA(0, 0), cA, voffA); PG8_STAGE(PG8_SA(0, 1), cA + hstep, voffA);
        if (wr == 1) PG8_BAR;
        PG8_WAIT_V(2); PG8_BAR;
        PG8_STAGE(PG8_SB(1, 0), cB + kstep, voffB); PG8_STAGE(PG8_SA(1, 0), cA + kstep, voffA); PG8_STAGE(PG8_SB(1, 1), cB + hstep + kstep, voffB);
        PG8_WAIT_V(6); PG8_BAR;
    } else {
        PG8_STAGE(PG8_SB(0, 0), cB, voffB); PG8_STAGE(PG8_SA(0, 0), cA, voffA); PG8_STAGE(PG8_SB(0, 1), cB + hstep, voffB); PG8_STAGE(PG8_SA(0, 1), cA + hstep, voffA);
        if (wr == 1) PG8_BAR;
        PG8_WAIT_V(4); PG8_BAR;
        PG8_STAGE(PG8_SB(1, 0), cB + kstep, voffB); PG8_STAGE(PG8_SA(1, 0), cA + kstep, voffA); PG8_STAGE(PG8_SB(1, 1), cB + hstep + kstep, voffB);
        PG8_WAIT_V(6); PG8_BAR;
    }
    for (;;) {
        const bool has_next = S.next(ui + 1, nxt);
        const char* nA = has_next ? (const char*)g.A + (size_t)nxt.pm * tstep : cA; const char* nB = has_next ? (const char*)g.Bt + (size_t)nxt.pn * tstep : cB;
        for (int t = 0; t < nt; t += 2) {
            const bool last = (t == nt - 2);
            const char* a1 = cA + (size_t)(t + 1) * kstep;
            const char* a2 = last ? nA : cA + (size_t)(t + 2) * kstep; const char* b2 = last ? nB : cB + (size_t)(t + 2) * kstep;
            const char* a3 = a2 + kstep; const char* b3 = b2 + kstep;
            if (last && has_next) S.a_ready(nxt);
            if constexpr (SP2) {
            PG8_LDB(B0, 0, 0); PG8_LDB(B1, 0, 1); PG8_SCHED; PG8_LDA(At, 0, 0); PG8_STAGE(PG8_SA(1, 1), a1 + hstep, voffA);
            PG8_WAIT_V(8); PG8_WAIT_L(0); PG8_BAR; PG8_MMA(0, 0, At, B0); PG8_MMA(0, 1, At, B1); PG8_BAR; PG8_SCHED;
            PG8_LDA(At, 0, 1); PG8_STAGE(PG8_SB(0, 0), b2, voffB); PG8_STAGE(PG8_SB(0, 1), b2 + hstep, voffB); PG8_STAGE(PG8_SA(0, 0), a2, voffA);
            PG8_WAIT_V(8); PG8_WAIT_L(0); PG8_BAR; PG8_MMA(1, 0, At, B0); PG8_MMA(1, 1, At, B1); PG8_BAR; PG8_SCHED;
            PG8_LDB(B0, 1, 0); PG8_LDB(B1, 1, 1); PG8_SCHED; PG8_LDA(At, 1, 0); PG8_STAGE(PG8_SA(0, 1), a2 + hstep, voffA);
            PG8_WAIT_V(8); PG8_WAIT_L(0); PG8_BAR; PG8_MMA(0, 0, At, B0); PG8_MMA(0, 1, At, B1); PG8_BAR; PG8_SCHED;
            PG8_LDA(At, 1, 1); PG8_STAGE(PG8_SB(1, 0), b3, voffB); PG8_STAGE(PG8_SB(1, 1), b3 + hstep, voffB); PG8_STAGE(PG8_SA(1, 0), a3, voffA);
            PG8_WAIT_V(8); PG8_WAIT_L(0); PG8_BAR; PG8_MMA(1, 0, At, B0); PG8_MMA(1, 1, At, B1); PG8_BAR; PG8_SCHED;
            } else {
            PG8_LDB(B0, 0, 0); PG8_SCHED; PG8_LDA(At, 0, 0); PG8_STAGE(PG8_SA(1, 1), a1 + hstep, voffA);
            PG8_WAIT_L(8); PG8_BAR; PG8_WAIT_L(0); PG8_MMA(0, 0, At, B0); PG8_BAR; PG8_SCHED;
            PG8_LDB(B1, 0, 1); PG8_STAGE(PG8_SB(0, 0), b2, voffB);
            PG8_BAR; PG8_WAIT_L(0); PG8_MMA(0, 1, At, B1); PG8_BAR;
            PG8_LDA(At, 0, 1); PG8_STAGE(PG8_SA(0, 0), a2, voffA);
            PG8_BAR; PG8_WAIT_L(0); PG8_MMA(1, 0, At, B0); PG8_BAR; PG8_SCHED;
            PG8_STAGE(PG8_SB(0, 1), b2 + hstep, voffB);
            PG8_WAIT_V(6); PG8_BAR; PG8_MMA(1, 1, At, B1); PG8_BAR;
            PG8_LDB(B0, 1, 0); PG8_SCHED; PG8_LDA(At, 1, 0); PG8_STAGE(PG8_SA(0, 1), a2 + hstep, voffA);
            PG8_WAIT_L(8); PG8_BAR; PG8_WAIT_L(0); PG8_MMA(0, 0, At, B0); PG8_BAR; PG8_SCHED;
            PG8_LDB(B1, 1, 1); PG8_STAGE(PG8_SB(1, 0), b3, voffB);
            PG8_BAR; PG8_WAIT_L(0); PG8_MMA(0, 1, At, B1); PG8_BAR;
            PG8_LDA(At, 1, 1); PG8_STAGE(PG8_SA(1, 0), a3, voffA);
            PG8_BAR; PG8_WAIT_L(0); PG8_MMA(1, 0, At, B0); PG8_BAR; PG8_SCHED;
            PG8_STAGE(PG8_SB(1, 1), b3 + hstep, voffB);
            PG8_WAIT_V(6); PG8_BAR; PG8_MMA(1, 1, At, B1); PG8_BAR;
            }
        }
        if constexpr (ALIGN_EPI) { if (wr == 0) PG8_BAR; }
        if constexpr (!Epi::AFTER_DRAIN) { E(acc, cur, wr, wc, fr, fq); S.done(cur); }
        if (!has_next) break;
#pragma unroll
        for (int a = 0; a < 2; ++a)
#pragma unroll
            for (int b = 0; b < 2; ++b)
#pragma unroll
                for (int m = 0; m < 4; ++m)
#pragma unroll
                    for (int n = 0; n < 2; ++n) acc[a][b][m][n] = (f32x4){0.f, 0.f, 0.f, 0.f};
        cur = nxt; cA = nA; cB = nB; ++ui;
        if constexpr (ALIGN_EPI) { if (wr == 1) PG8_BAR; }
    }
    PG8_WAIT_V(0);
    if constexpr (!ALIGN_EPI) { if (wr == 0) PG8_BAR; }
    PG8_BAR;
    if constexpr (Epi::AFTER_DRAIN) { E.fused(acc, cur, wr, wc, fr, fq, lds, wid, lane); S.done(cur); }
#undef PG8_SA
#undef PG8_SB
#undef PG8_STAGE
#undef PG8_LDA
#undef PG8_LDB
#undef PG8_MMA
#undef PG8_WAIT_V
#undef PG8_WAIT_L
#undef PG8_BAR
#undef PG8_SCHED
}
template <class Epi, class Sched>
__device__ __forceinline__ void gemm_phase_gather(PG8_LAS unsigned char* lds, const Gemm g, const Sched& S, const Epi& E, const int wave_in) {
    unsigned z_ = 0u; asm volatile("" : "+v"(z_)); const int tid_ = (int)__builtin_amdgcn_mbcnt_hi(~0u, __builtin_amdgcn_mbcnt_lo(~0u, z_)) + 64 * wave_in;
    const int tid = tid_, wid = __builtin_amdgcn_readfirstlane(tid >> 6), lane = tid & 63, wr = wid >> 2, wc = wid & 3, fr = lane & 15, fq = lane >> 4;
    constexpr bool ALIGN_EPI = true, SP2 = true;
    const int K = g.K, nt = K / BK;
    unsigned voffB[2]; int RA0; unsigned CA0;
#pragma unroll
    for (int i = 0; i < 2; ++i) { int R, C; stage_rc(tid * 16 + i * 8192, R, C); const int Rb = Epi::PERM ? ((R & ~31) + perm32(R & 31)) : R;
        if (i == 0) { RA0 = R; CA0 = (unsigned)C * 2u; } voffB[i] = (unsigned)(Rb * K + C) * 2u; }
    unsigned ro[2], rn[2][2];
    const size_t kstep = (size_t)(BK * 2);
    const size_t hstep = (size_t)HALF * K * 2;
    const size_t tstep = 2 * hstep;
    const unsigned ldsw = (unsigned)wid * 1024u;
    const int aoff = lds_byte(wr * 64 + fr, fq * 8), boff = lds_byte(wc * 32 + fr, fq * 8);
#define PG8_SA(b, h) (((b) * 2 + (h)) * HTB)
#define PG8_SB(b, h) ((4 + (b) * 2 + (h)) * HTB)
#define PG8_STAGE(bufoff, gbase, voff) do { _Pragma("unroll") for (int _i = 0; _i < 2; ++_i) \
        __builtin_amdgcn_global_load_lds((const unsigned*)((const char*)(gbase) + (voff)[_i]), (PG8_LAS unsigned*)(lds + (bufoff) + ldsw + _i * 8192), 16, 0, 0); } while (0)
#define PG8_STAGE_G(bufoff, kbyte, pk) do { _Pragma("unroll") for (int _i = 0; _i < 2; ++_i) { const unsigned _row = _i ? ((pk) >> 16) : ((pk) & 0xffffu); \
        __builtin_amdgcn_global_load_lds((const unsigned*)((const char*)g.A + (kbyte) + (_row * ((unsigned)K * 2u) + CA0)), (PG8_LAS unsigned*)(lds + (bufoff) + ldsw + _i * 8192), 16, 0, 0); } } while (0)
#define PG8_LDA(dst, b, h) do { _Pragma("unroll") for (int m = 0; m < 4; ++m) _Pragma("unroll") for (int k = 0; k < 2; ++k) dst[m][k] = *(const PG8_LAS bf16x8*)(lds + PG8_SA(b, h) + aoff + m * 2048 + k * 1024); } while (0)
#define PG8_LDB(dst, b, h) do { _Pragma("unroll") for (int n = 0; n < 2; ++n) _Pragma("unroll") for (int k = 0; k < 2; ++k) dst[n][k] = *(const PG8_LAS bf16x8*)(lds + PG8_SB(b, h) + boff + n * 2048 + k * 1024); } while (0)
#define PG8_MMA(ai, bj, At, Bt) do { __builtin_amdgcn_s_setprio(1); _Pragma("unroll") for (int m = 0; m < 4; ++m) _Pragma("unroll") for (int n = 0; n < 2; ++n) _Pragma("unroll") for (int k = 0; k < 2; ++k) \
        acc[ai][bj][m][n] = __builtin_amdgcn_mfma_f32_16x16x32_bf16(Bt[n][k], At[m][k], acc[ai][bj][m][n], 0, 0, 0); __builtin_amdgcn_s_setprio(0); } while (0)
#define PG8_WAIT_V(n) asm volatile("s_waitcnt vmcnt(" #n ")" ::: "memory")
#define PG8_WAIT_L(n) asm volatile("s_waitcnt lgkmcnt(" #n ")" ::: "memory")
#define PG8_BAR __builtin_amdgcn_s_barrier()
#define PG8_SCHED __builtin_amdgcn_sched_barrier(0)
    Unit cur, nxt; int ui = 0;
    if (!S.next(0, cur)) return;
    f32x4 acc[2][2][4][2];
#pragma unroll
    for (int a = 0; a < 2; ++a)
#pragma unroll
        for (int b = 0; b < 2; ++b)
#pragma unroll
            for (int m = 0; m < 4; ++m)
#pragma unroll
                for (int n = 0; n < 2; ++n) acc[a][b][m][n] = (f32x4){0.f, 0.f, 0.f, 0.f};
    bf16x8 At[4][2], B0[2][2], B1[2][2];
    const char* cB = (const char*)g.Bt + (size_t)cur.pn * tstep;
    S.a_ready(cur);
    S.rows(cur, RA0, rn); ro[0] = rn[0][0] | (rn[0][1] << 16); ro[1] = rn[1][0] | (rn[1][1] << 16);
    if constexpr (SP2) {
        PG8_STAGE(PG8_SB(0, 0), cB, voffB); PG8_STAGE(PG8_SB(0, 1), cB + hstep, voffB); PG8_STAGE_G(PG8_SA(0, 0), 0, ro[0]); PG8_STAGE_G(PG8_SA(0, 1), 0, ro[1]);
        if (wr == 1) PG8_BAR;
        PG8_WAIT_V(2); PG8_BAR;
        PG8_STAGE(PG8_SB(1, 0), cB + kstep, voffB); PG8_STAGE_G(PG8_SA(1, 0), kstep, ro[0]); PG8_STAGE(PG8_SB(1, 1), cB + hstep + kstep, voffB);
        PG8_WAIT_V(6); PG8_BAR;
    }
    for (;;) {
        const bool has_next = S.next(ui + 1, nxt);
        const char* nB = has_next ? (const char*)g.Bt + (size_t)nxt.pn * tstep : cB;
        for (int t = 0; t < nt; t += 2) {
            const bool last = (t == nt - 2);
            const size_t k1 = (size_t)(t + 1) * kstep, k2 = last ? (size_t)0 : (size_t)(t + 2) * kstep, k3 = k2 + kstep;
            const char* b2 = last ? nB : cB + (size_t)(t + 2) * kstep; const char* b3 = b2 + kstep;
            if (t == nt - 4 && has_next) S.rows(nxt, RA0, rn);
            const unsigned c1 = ro[1];
            unsigned s0 = ro[0], s1 = ro[1];
            if (last && has_next) { unsigned q0 = rn[0][0], q1 = rn[0][1], q2 = rn[1][0], q3 = rn[1][1]; asm volatile("" : "+v"(q0), "+v"(q1), "+v"(q2), "+v"(q3));
                s0 = q0 | (q1 << 16); s1 = q2 | (q3 << 16); ro[0] = s0; ro[1] = s1; }
            if (last && has_next) S.a_ready(nxt);
            if constexpr (SP2) {
            PG8_LDB(B0, 0, 0); PG8_LDB(B1, 0, 1); PG8_SCHED; PG8_LDA(At, 0, 0); PG8_STAGE_G(PG8_SA(1, 1), k1, c1);
            PG8_WAIT_V(8); PG8_WAIT_L(0); PG8_BAR; PG8_MMA(0, 0, At, B0); PG8_MMA(0, 1, At, B1); PG8_BAR; PG8_SCHED;
            PG8_LDA(At, 0, 1); PG8_STAGE(PG8_SB(0, 0), b2, voffB); PG8_STAGE(PG8_SB(0, 1), b2 + hstep, voffB); PG8_STAGE_G(PG8_SA(0, 0), k2, s0);
            PG8_WAIT_V(8); PG8_WAIT_L(0); PG8_BAR; PG8_MMA(1, 0, At, B0); PG8_MMA(1, 1, At, B1); PG8_BAR; PG8_SCHED;
            PG8_LDB(B0, 1, 0); PG8_LDB(B1, 1, 1); PG8_SCHED; PG8_LDA(At, 1, 0); PG8_STAGE_G(PG8_SA(0, 1), k2, s1);
            PG8_WAIT_V(8); PG8_WAIT_L(0); PG8_BAR; PG8_MMA(0, 0, At, B0); PG8_MMA(0, 1, At, B1); PG8_BAR; PG8_SCHED;
            PG8_LDA(At, 1, 1); PG8_STAGE(PG8_SB(1, 0), b3, voffB); PG8_STAGE(PG8_SB(1, 1), b3 + hstep, voffB); PG8_STAGE_G(PG8_SA(1, 0), k3, s0);
            PG8_WAIT_V(8); PG8_WAIT_L(0); PG8_BAR; PG8_MMA(1, 0, At, B0); PG8_MMA(1, 1, At, B1); PG8_BAR; PG8_SCHED;
            }
        }
        if constexpr (ALIGN_EPI) { if (wr == 0) PG8_BAR; }
        if constexpr (!Epi::AFTER_DRAIN) { E(acc, cur, wr, wc, fr, fq); S.done(cur); }
        if (!has_next) break;
#pragma unroll
        for (int a = 0; a < 2; ++a)
#pragma unroll
            for (int b = 0; b < 2; ++b)
#pragma unroll
                for (int m = 0; m < 4; ++m)
#pragma unroll
                    for (int n = 0; n < 2; ++n) acc[a][b][m][n] = (f32x4){0.f, 0.f, 0.f, 0.f};
        cur = nxt; cB = nB; ++ui;
        if constexpr (ALIGN_EPI) { if (wr == 1) PG8_BAR; }
    }
    PG8_WAIT_V(0);
    if constexpr (!ALIGN_EPI) { if (wr == 0) PG8_BAR; }
    PG8_BAR;
    if constexpr (Epi::AFTER_DRAIN) { E.fused(acc, cur, wr, wc, fr, fq, lds, wid, lane); S.done(cur); }
#undef PG8_SA
#undef PG8_SB
#undef PG8_STAGE
#undef PG8_STAGE_G
#undef PG8_LDA
#undef PG8_LDB
#undef PG8_MMA
#undef PG8_WAIT_V
#undef PG8_WAIT_L
#undef PG8_BAR
#undef PG8_SCHED
}
typedef int v8i_t __attribute__((ext_vector_type(8)));
template <class Epi, class Sched, bool ALIGN_EPI = false, bool SP2 = false>
__device__ __forceinline__ void gemm_phase8(PG8_LAS unsigned char* lds, const Gemm g, const Sched& S, const Epi& E, const int wave_in) {
    unsigned z_ = 0u; asm volatile("" : "+v"(z_)); const int tid_ = (int)__builtin_amdgcn_mbcnt_hi(~0u, __builtin_amdgcn_mbcnt_lo(~0u, z_)) + 64 * wave_in;
    const int tid = tid_, wid = __builtin_amdgcn_readfirstlane(tid >> 6), lane = tid & 63, wr = wid >> 2, wc = wid & 3, fr = lane & 15, fq = lane >> 4;
    const int K = g.K, nt = K / (2 * BK);
    unsigned voffA[2], voffB[2];
#pragma unroll
    for (int i = 0; i < 2; ++i) { int R, C; stage_rc(tid * 16 + i * 8192, R, C); const int Rb = Epi::PERM ? ((R & ~31) + perm32(R & 31)) : R;
        voffA[i] = (unsigned)(R * K + C * 2); voffB[i] = (unsigned)(Rb * K + C * 2); }
    const size_t kstep = (size_t)(BK * 2);
    const size_t hstep = (size_t)HALF * K;
    const size_t tstep = 2 * hstep;
    const unsigned ldsw = (unsigned)wid * 1024u;
    const int aoff = lds_byte(wr * 64 + fr, fq * 16), boff = lds_byte(wc * 32 + fr, fq * 16);
#define PG8_SA(b, h) (((b) * 2 + (h)) * HTB)
#define PG8_SB(b, h) ((4 + (b) * 2 + (h)) * HTB)
#define PG8_STAGE(bufoff, gbase, voff) do { _Pragma("unroll") for (int _i = 0; _i < 2; ++_i) \
        __builtin_amdgcn_global_load_lds((const unsigned*)((const char*)(gbase) + (voff)[_i]), (PG8_LAS unsigned*)(lds + (bufoff) + ldsw + _i * 8192), 16, 0, 0); } while (0)
#define PG8_LDA(dst, b, h) do { _Pragma("unroll") for (int m = 0; m < 4; ++m) { const PG8_LAS u32x4* p_ = (const PG8_LAS u32x4*)(lds + PG8_SA(b, h) + aoff + m * 2048); const u32x4 lo_ = p_[0], hi_ = p_[1]; dst[m] = (v8i_t){(int)lo_.x, (int)lo_.y, (int)lo_.z, (int)lo_.w, (int)hi_.x, (int)hi_.y, (int)hi_.z, (int)hi_.w}; } } while (0)
#define PG8_LDB(dst, b, h) do { _Pragma("unroll") for (int n = 0; n < 2; ++n) { const PG8_LAS u32x4* p_ = (const PG8_LAS u32x4*)(lds + PG8_SB(b, h) + boff + n * 2048); const u32x4 lo_ = p_[0], hi_ = p_[1]; dst[n] = (v8i_t){(int)lo_.x, (int)lo_.y, (int)lo_.z, (int)lo_.w, (int)hi_.x, (int)hi_.y, (int)hi_.z, (int)hi_.w}; } } while (0)
#define PG8_MMA(ai, bj, At, Bt) do { __builtin_amdgcn_s_setprio(1); _Pragma("unroll") for (int m = 0; m < 4; ++m) _Pragma("unroll") for (int n = 0; n < 2; ++n) \
        asm volatile("v_mfma_f32_16x16x128_f8f6f4 %0, %1, %2, %0" : "+v"(acc[ai][bj][m][n]) : "v"(Bt[n]), "v"(At[m])); __builtin_amdgcn_s_setprio(0); } while (0)
#define PG8_WAIT_V(n) asm volatile("s_waitcnt vmcnt(" #n ")" ::: "memory")
#define PG8_WAIT_L(n) asm volatile("s_waitcnt lgkmcnt(" #n ")" ::: "memory")
#define PG8_BAR __builtin_amdgcn_s_barrier()
#define PG8_SCHED __builtin_amdgcn_sched_barrier(0)
    Unit cur, nxt; int ui = 0;
    if (!S.next(0, cur)) return;
    f32x4 acc[2][2][4][2];
#pragma unroll
    for (int a = 0; a < 2; ++a)
#pragma unroll
        for (int b = 0; b < 2; ++b)
#pragma unroll
            for (int m = 0; m < 4; ++m)
#pragma unroll
                for (int n = 0; n < 2; ++n) acc[a][b][m][n] = (f32x4){0.f, 0.f, 0.f, 0.f};
    v8i_t At[4], B0[2], B1[2];
    const char* cA = (const char*)g.A + (size_t)cur.pm * tstep; const char* cB = (const char*)g.Bt + (size_t)cur.pn * tstep;
    S.a_ready(cur);
    if constexpr (SP2) {
        PG8_STAGE(PG8_SB(0, 0), cB, voffB); PG8_STAGE(PG8_SB(0, 1), cB + hstep, voffB); PG8_STAGE(PG8_SA(0, 0), cA, voffA); PG8_STAGE(PG8_SA(0, 1), cA + hstep, voffA);
        if (wr == 1) PG8_BAR;
        PG8_WAIT_V(2); PG8_BAR;
        PG8_STAGE(PG8_SB(1, 0), cB + kstep, voffB); PG8_STAGE(PG8_SA(1, 0), cA + kstep, voffA); PG8_STAGE(PG8_SB(1, 1), cB + hstep + kstep, voffB);
        PG8_WAIT_V(6); PG8_BAR;
    } else {
        PG8_STAGE(PG8_SB(0, 0), cB, voffB); PG8_STAGE(PG8_SA(0, 0), cA, voffA); PG8_STAGE(PG8_SB(0, 1), cB + hstep, voffB); PG8_STAGE(PG8_SA(0, 1), cA + hstep, voffA);
        if (wr == 1) PG8_BAR;
        PG8_WAIT_V(4); PG8_BAR;
        PG8_STAGE(PG8_SB(1, 0), cB + kstep, voffB); PG8_STAGE(PG8_SA(1, 0), cA + kstep, voffA); PG8_STAGE(PG8_SB(1, 1), cB + hstep + kstep, voffB);
        PG8_WAIT_V(6); PG8_BAR;
    }
    for (;;) {
        const bool has_next = S.next(ui + 1, nxt);
        const char* nA = has_next ? (const char*)g.A + (size_t)nxt.pm * tstep : cA; const char* nB = has_next ? (const char*)g.Bt + (size_t)nxt.pn * tstep : cB;
#pragma nounroll
        for (int t = 0; t < nt; t += 2) {
            const bool last = (t == nt - 2);
            const char* a1 = cA + (size_t)(t + 1) * kstep;
            const char* a2 = last ? nA : cA + (size_t)(t + 2) * kstep; const char* b2 = last ? nB : cB + (size_t)(t + 2) * kstep;
            const char* a3 = a2 + kstep; const char* b3 = b2 + kstep;
            if (last && has_next) S.a_ready(nxt);
            if constexpr (SP2) {
            PG8_LDB(B0, 0, 0); PG8_LDB(B1, 0, 1); PG8_SCHED; PG8_LDA(At, 0, 0); PG8_STAGE(PG8_SA(1, 1), a1 + hstep, voffA);
            PG8_WAIT_V(8); PG8_WAIT_L(0); PG8_BAR; PG8_MMA(0, 0, At, B0); PG8_MMA(0, 1, At, B1); PG8_BAR; PG8_SCHED;
            PG8_LDA(At, 0, 1); PG8_STAGE(PG8_SB(0, 0), b2, voffB); PG8_STAGE(PG8_SB(0, 1), b2 + hstep, voffB); PG8_STAGE(PG8_SA(0, 0), a2, voffA);
            PG8_WAIT_V(8); PG8_WAIT_L(0); PG8_BAR; PG8_MMA(1, 0, At, B0); PG8_MMA(1, 1, At, B1); PG8_BAR; PG8_SCHED;
            PG8_LDB(B0, 1, 0); PG8_LDB(B1, 1, 1); PG8_SCHED; PG8_LDA(At, 1, 0); PG8_STAGE(PG8_SA(0, 1), a2 + hstep, voffA);
            PG8_WAIT_V(8); PG8_WAIT_L(0); PG8_BAR; PG8_MMA(0, 0, At, B0); PG8_MMA(0, 1, At, B1); PG8_BAR; PG8_SCHED;
            PG8_LDA(At, 1, 1); PG8_STAGE(PG8_SB(1, 0), b3, voffB); PG8_STAGE(PG8_SB(1, 1), b3 + hstep, voffB); PG8_STAGE(PG8_SA(1, 0), a3, voffA);
            PG8_WAIT_V(8); PG8_WAIT_L(0); PG8_BAR; PG8_MMA(1, 0, At, B0); PG8_MMA(1, 1, At, B1); PG8_BAR; PG8_SCHED;
            } else {
            PG8_LDB(B0, 0, 0); PG8_SCHED; PG8_LDA(At, 0, 0); PG8_STAGE(PG8_SA(1, 1), a1 + hstep, voffA);
            PG8_WAIT_L(8); PG8_BAR; PG8_WAIT_L(0); PG8_MMA(0, 0, At, B0); PG8_BAR; PG8_SCHED;
            PG8_LDB(B1, 0, 1); PG8_STAGE(PG8_SB(0, 0), b2, voffB);
            PG8_BAR; PG8_WAIT_L(0); PG8_MMA(0, 1, At, B1); PG8_BAR;
            PG8_LDA(At, 0, 1); PG8_STAGE(PG8_SA(0, 0), a2, voffA);
            PG8_BAR; PG8_WAIT_L(0); PG8_MMA(1, 0, At, B0); PG8_BAR; PG8_SCHED;
            PG8_STAGE(PG8_SB(0, 1), b2 + hstep, voffB);
            PG8_WAIT_V(6); PG8_BAR; PG8_MMA(1, 1, At, B1); PG8_BAR;
            PG8_LDB(B0, 1, 0); PG8_SCHED; PG8_LDA(At, 1, 0); PG8_STAGE(PG8_SA(0, 1), a2 + hstep, voffA);
            PG8_WAIT_L(8); PG8_BAR; PG8_WAIT_L(0); PG8_MMA(0, 0, At, B0); PG8_BAR; PG8_SCHED;
            PG8_LDB(B1, 1, 1); PG8_STAGE(PG8_SB(1, 0), b3, voffB);
            PG8_BAR; PG8_WAIT_L(0); PG8_MMA(0, 1, At, B1); PG8_BAR;
            PG8_LDA(At, 1, 1); PG8_STAGE(PG8_SA(1, 0), a3, voffA);
            PG8_BAR; PG8_WAIT_L(0); PG8_MMA(1, 0, At, B0); PG8_BAR; PG8_SCHED;
            PG8_STAGE(PG8_SB(1, 1), b3 + hstep, voffB);
            PG8_WAIT_V(6); PG8_BAR; PG8_MMA(1, 1, At, B1); PG8_BAR;
            }
        }
        asm volatile("s_nop 15\n\ts_nop 15" ::: "memory");
        if constexpr (ALIGN_EPI) { if (wr == 0) PG8_BAR; }
        if constexpr (!Epi::AFTER_DRAIN) { E(acc, cur, wr, wc, fr, fq); S.done(cur); }
        if (!has_next) break;
#pragma unroll
        for (int a = 0; a < 2; ++a)
#pragma unroll
            for (int b = 0; b < 2; ++b)
#pragma unroll
                for (int m = 0; m < 4; ++m)
#pragma unroll
                    for (int n = 0; n < 2; ++n) acc[a][b][m][n] = (f32x4){0.f, 0.f, 0.f, 0.f};
        cur = nxt; cA = nA; cB = nB; ++ui;
        if constexpr (ALIGN_EPI) { if (wr == 1) PG8_BAR; }
    }
    PG8_WAIT_V(0);
    if constexpr (!ALIGN_EPI) { if (wr == 0) PG8_BAR; }
    PG8_BAR;
    if constexpr (Epi::AFTER_DRAIN) { E.fused(acc, cur, wr, wc, fr, fq, lds, wid, lane); S.done(cur); }
#undef PG8_SA
#undef PG8_SB
#undef PG8_STAGE
#undef PG8_LDA
#undef PG8_LDB
#undef PG8_MMA
#undef PG8_WAIT_V
#undef PG8_WAIT_L
#undef PG8_BAR
#undef PG8_SCHED
}
template <class Epi, class Sched>
__device__ __forceinline__ void gemm_phase_gather8(PG8_LAS unsigned char* lds, const Gemm g, const Sched& S, const Epi& E, const int wave_in) {
    unsigned z_ = 0u; asm volatile("" : "+v"(z_)); const int tid_ = (int)__builtin_amdgcn_mbcnt_hi(~0u, __builtin_amdgcn_mbcnt_lo(~0u, z_)) + 64 * wave_in;
    const int tid = tid_, wid = __builtin_amdgcn_readfirstlane(tid >> 6), lane = tid & 63, wr = wid >> 2, wc = wid & 3, fr = lane & 15, fq = lane >> 4;
    constexpr bool ALIGN_EPI = true, SP2 = true;
    const int K = g.K, nt = K / (2 * BK);
    unsigned voffB[2]; int RA0; unsigned CA0;
#pragma unroll
    for (int i = 0; i < 2; ++i) { int R, C; stage_rc(tid * 16 + i * 8192, R, C); const int Rb = Epi::PERM ? ((R & ~31) + perm32(R & 31)) : R;
        if (i == 0) { RA0 = R; CA0 = (unsigned)C * 2u; } voffB[i] = (unsigned)(Rb * K + C * 2); }
    unsigned ro[2], rn[2][2];
    const size_t kstep = (size_t)(BK * 2);
    const size_t hstep = (size_t)HALF * K;
    const size_t tstep = 2 * hstep;
    const unsigned ldsw = (unsigned)wid * 1024u;
    const int aoff = lds_byte(wr * 64 + fr, fq * 16), boff = lds_byte(wc * 32 + fr, fq * 16);
#define PG8_SA(b, h) (((b) * 2 + (h)) * HTB)
#define PG8_SB(b, h) ((4 + (b) * 2 + (h)) * HTB)
#define PG8_STAGE(bufoff, gbase, voff) do { _Pragma("unroll") for (int _i = 0; _i < 2; ++_i) \
        __builtin_amdgcn_global_load_lds((const unsigned*)((const char*)(gbase) + (voff)[_i]), (PG8_LAS unsigned*)(lds + (bufoff) + ldsw + _i * 8192), 16, 0, 0); } while (0)
#define PG8_STAGE_G(bufoff, kbyte, pk) do { _Pragma("unroll") for (int _i = 0; _i < 2; ++_i) { const unsigned _row = _i ? ((pk) >> 16) : ((pk) & 0xffffu); \
        __builtin_amdgcn_global_load_lds((const unsigned*)((const char*)g.A + (kbyte) + (_row * (unsigned)K + CA0)), (PG8_LAS unsigned*)(lds + (bufoff) + ldsw + _i * 8192), 16, 0, 0); } } while (0)
#define PG8_LDA(dst, b, h) do { _Pragma("unroll") for (int m = 0; m < 4; ++m) { const PG8_LAS u32x4* p_ = (const PG8_LAS u32x4*)(lds + PG8_SA(b, h) + aoff + m * 2048); const u32x4 lo_ = p_[0], hi_ = p_[1]; dst[m] = (v8i_t){(int)lo_.x, (int)lo_.y, (int)lo_.z, (int)lo_.w, (int)hi_.x, (int)hi_.y, (int)hi_.z, (int)hi_.w}; } } while (0)
#define PG8_LDB(dst, b, h) do { _Pragma("unroll") for (int n = 0; n < 2; ++n) { const PG8_LAS u32x4* p_ = (const PG8_LAS u32x4*)(lds + PG8_SB(b, h) + boff + n * 2048); const u32x4 lo_ = p_[0], hi_ = p_[1]; dst[n] = (v8i_t){(int)lo_.x, (int)lo_.y, (int)lo_.z, (int)lo_.w, (int)hi_.x, (int)hi_.y, (int)hi_.z, (int)hi_.w}; } } while (0)
#define PG8_MMA(ai, bj, At, Bt) do { __builtin_amdgcn_s_setprio(1); _Pragma("unroll") for (int m = 0; m < 4; ++m) _Pragma("unroll") for (int n = 0; n < 2; ++n) \
        asm volatile("v_mfma_f32_16x16x128_f8f6f4 %0, %1, %2, %0" : "+v"(acc[ai][bj][m][n]) : "v"(Bt[n]), "v"(At[m])); __builtin_amdgcn_s_setprio(0); } while (0)
#define PG8_WAIT_V(n) asm volatile("s_waitcnt vmcnt(" #n ")" ::: "memory")
#define PG8_WAIT_L(n) asm volatile("s_waitcnt lgkmcnt(" #n ")" ::: "memory")
#define PG8_BAR __builtin_amdgcn_s_barrier()
#define PG8_SCHED __builtin_amdgcn_sched_barrier(0)
    Unit cur, nxt; int ui = 0;
    if (!S.next(0, cur)) return;
    f32x4 acc[2][2][4][2];
#pragma unroll
    for (int a = 0; a < 2; ++a)
#pragma unroll
        for (int b = 0; b < 2; ++b)
#pragma unroll
            for (int m = 0; m < 4; ++m)
#pragma unroll
                for (int n = 0; n < 2; ++n) acc[a][b][m][n] = (f32x4){0.f, 0.f, 0.f, 0.f};
    v8i_t At[4], B0[2], B1[2];
    const char* cB = (const char*)g.Bt + (size_t)cur.pn * tstep;
    S.a_ready(cur);
    S.rows(cur, RA0, rn); ro[0] = rn[0][0] | (rn[0][1] << 16); ro[1] = rn[1][0] | (rn[1][1] << 16);
    if constexpr (SP2) {
        PG8_STAGE(PG8_SB(0, 0), cB, voffB); PG8_STAGE(PG8_SB(0, 1), cB + hstep, voffB); PG8_STAGE_G(PG8_SA(0, 0), 0, ro[0]); PG8_STAGE_G(PG8_SA(0, 1), 0, ro[1]);
        if (wr == 1) PG8_BAR;
        PG8_WAIT_V(2); PG8_BAR;
        PG8_STAGE(PG8_SB(1, 0), cB + kstep, voffB); PG8_STAGE_G(PG8_SA(1, 0), kstep, ro[0]); PG8_STAGE(PG8_SB(1, 1), cB + hstep + kstep, voffB);
        PG8_WAIT_V(6); PG8_BAR;
    }
    for (;;) {
        const bool has_next = S.next(ui + 1, nxt);
        const char* nB = has_next ? (const char*)g.Bt + (size_t)nxt.pn * tstep : cB;
#pragma nounroll
        for (int t = 0; t < nt; t += 2) {
            const bool last = (t == nt - 2);
            const size_t k1 = (size_t)(t + 1) * kstep, k2 = last ? (size_t)0 : (size_t)(t + 2) * kstep, k3 = k2 + kstep;
            const char* b2 = last ? nB : cB + (size_t)(t + 2) * kstep; const char* b3 = b2 + kstep;
            if (t == nt - 4 && has_next) S.rows(nxt, RA0, rn);
            const unsigned c1 = ro[1];
            unsigned s0 = ro[0], s1 = ro[1];
            if (last && has_next) { unsigned q0 = rn[0][0], q1 = rn[0][1], q2 = rn[1][0], q3 = rn[1][1]; asm volatile("" : "+v"(q0), "+v"(q1), "+v"(q2), "+v"(q3));
                s0 = q0 | (q1 << 16); s1 = q2 | (q3 << 16); ro[0] = s0; ro[1] = s1; }
            if (last && has_next) S.a_ready(nxt);
            if constexpr (SP2) {
            PG8_LDB(B0, 0, 0); PG8_LDB(B1, 0, 1); PG8_SCHED; PG8_LDA(At, 0, 0); PG8_STAGE_G(PG8_SA(1, 1), k1, c1);
            PG8_WAIT_V(8); PG8_WAIT_L(0); PG8_BAR; PG8_MMA(0, 0, At, B0); PG8_MMA(0, 1, At, B1); PG8_BAR; PG8_SCHED;
            PG8_LDA(At, 0, 1); PG8_STAGE(PG8_SB(0, 0), b2, voffB); PG8_STAGE(PG8_SB(0, 1), b2 + hstep, voffB); PG8_STAGE_G(PG8_SA(0, 0), k2, s0);
            PG8_WAIT_V(8); PG8_WAIT_L(0); PG8_BAR; PG8_MMA(1, 0, At, B0); PG8_MMA(1, 1, At, B1); PG8_BAR; PG8_SCHED;
            PG8_LDB(B0, 1, 0); PG8_LDB(B1, 1, 1); PG8_SCHED; PG8_LDA(At, 1, 0); PG8_STAGE_G(PG8_SA(0, 1), k2, s1);
            PG8_WAIT_V(8); PG8_WAIT_L(0); PG8_BAR; PG8_MMA(0, 0, At, B0); PG8_MMA(0, 1, At, B1); PG8_BAR; PG8_SCHED;
            PG8_LDA(At, 1, 1); PG8_STAGE(PG8_SB(1, 0), b3, voffB); PG8_STAGE(PG8_SB(1, 1), b3 + hstep, voffB); PG8_STAGE_G(PG8_SA(1, 0), k3, s0);
            PG8_WAIT_V(8); PG8_WAIT_L(0); PG8_BAR; PG8_MMA(1, 0, At, B0); PG8_MMA(1, 1, At, B1); PG8_BAR; PG8_SCHED;
            }
        }
        asm volatile("s_nop 15\n\ts_nop 15" ::: "memory");
        if constexpr (ALIGN_EPI) { if (wr == 0) PG8_BAR; }
        if constexpr (!Epi::AFTER_DRAIN) { E(acc, cur, wr, wc, fr, fq); S.done(cur); }
        if (!has_next) break;
#pragma unroll
        for (int a = 0; a < 2; ++a)
#pragma unroll
            for (int b = 0; b < 2; ++b)
#pragma unroll
                for (int m = 0; m < 4; ++m)
#pragma unroll
                    for (int n = 0; n < 2; ++n) acc[a][b][m][n] = (f32x4){0.f, 0.f, 0.f, 0.f};
        cur = nxt; cB = nB; ++ui;
        if constexpr (ALIGN_EPI) { if (wr == 1) PG8_BAR; }
    }
    PG8_WAIT_V(0);
    if constexpr (!ALIGN_EPI) { if (wr == 0) PG8_BAR; }
    PG8_BAR;
    if constexpr (Epi::AFTER_DRAIN) { E.fused(acc, cur, wr, wc, fr, fq, lds, wid, lane); S.done(cur); }
#undef PG8_SA
#undef PG8_SB
#undef PG8_STAGE
#undef PG8_STAGE_G
#undef PG8_LDA
#undef PG8_LDB
#undef PG8_MMA
#undef PG8_WAIT_V
#undef PG8_WAIT_L
#undef PG8_BAR
#undef PG8_SCHED
}
}

#ifndef PG8_SP2
#define PG8_SP2 true
#endif
#ifndef PG8_ALIGN
#define PG8_ALIGN true
#endif

constexpr int NTOK = 65536, DM = 1024, NCOL = 7680, SEQ = 4096, NBATCH = 16, HTOK = 32768, MEMLEN = 256;
constexpr int C_HQ = 0, C_HF = 1024, C_HI = 2048, C_HG = 3072, C_SQ = 4096, C_SK = 5120, C_SV = 5376, C_GA = 5632, C_GB = 6656;
constexpr size_t PJ_HQ = 0, PJ_HF = 64 * ((size_t)1 << 20), PJ_HI = 128 * ((size_t)1 << 20), PJ_HG = 192 * ((size_t)1 << 20), PJ_SQ = 256 * ((size_t)1 << 20), PJ_SK = 320 * ((size_t)1 << 20), PJ_SV = 336 * ((size_t)1 << 20), PJ_GA = 352 * ((size_t)1 << 20), PJ_GB = 416 * ((size_t)1 << 20);
constexpr int NEXP = 32, TOPK = 4, CAPH = HTOK * TOPK + NEXP * 256;
constexpr float RMS_EPS = 1e-5f;
constexpr size_t MiB = (size_t)1 << 20;
constexpr size_t WS_ZERO_BYTES = 2 * MiB;
constexpr size_t WS_GCNT = 1 * MiB;
constexpr int CW_TMO = 0, CW_BAR = 4096;
constexpr size_t WS_LB = 2 * MiB, WS_LUT = 2 * MiB + 4096, WS_BLKE = 2 * MiB + 16384, WS_NBT = 2 * MiB + 32768;
constexpr size_t WS_TOPE = 3 * MiB, WS_TOPG = 4 * MiB, WS_TOPR = 5 * MiB, WS_TOPP = 6 * MiB, WS_RGATE = 7 * MiB, WS_RRSTD = 8 * MiB, WS_D12 = 10 * MiB;
constexpr size_t WS_WIN = 16 * MiB, WS_WA = 31 * MiB, WS_WB = 33 * MiB, WS_WMIX = 35 * MiB, WS_WQ = 37 * MiB, WS_WK = 39 * MiB, WS_WV = 41 * MiB, WS_WO = 43 * MiB, WS_WR = 45 * MiB;
constexpr size_t WS_MEMBF = 46 * MiB, WS_KX = 54 * MiB, WS_VXT = 62 * MiB;
constexpr size_t WS_XBF = 72 * MiB;
constexpr size_t WS_PROJ = 200 * MiB, WS_OA = 680 * MiB, WS_OB = 744 * MiB, WS_TM = 808 * MiB;
constexpr size_t WS_Q = 664 * MiB, WS_O = 792 * MiB;
constexpr size_t WS_X1F8 = 872 * MiB;
constexpr size_t WS_X2F8 = 296 * MiB;
constexpr size_t WS_WGU = 200 * MiB, WS_WD = 264 * MiB, WS_ACT = 392 * MiB, WS_Y = 664 * MiB, WS_SSQ1 = 936 * MiB, WS_SSQ2 = 940 * MiB, WS_RTOK = 944 * MiB, WS_RGATE2 = 952 * MiB, WS_RRSTD2 = 960 * MiB, WS_END = 968 * MiB;
constexpr size_t OUT_US = 128 * MiB;

#define GAS __attribute__((address_space(1)))
#define LAS __attribute__((address_space(3)))
typedef unsigned short bf16;
typedef unsigned v4u __attribute__((ext_vector_type(4)));
typedef unsigned v2u __attribute__((ext_vector_type(2)));
typedef float f32x4 __attribute__((ext_vector_type(4)));
typedef short bf16x8 __attribute__((ext_vector_type(8)));
typedef short s16x4 __attribute__((ext_vector_type(4)));
#define RLX_AGENT __ATOMIC_RELAXED, __HIP_MEMORY_SCOPE_AGENT
#define LDS_WAIT() asm volatile("s_waitcnt lgkmcnt(0)" ::: "memory")
#define CFENCE() asm volatile("" ::: "memory")
__device__ __forceinline__ unsigned f2bf(float f) { unsigned u = __builtin_bit_cast(unsigned, f); return (u + 0x7fffu + ((u >> 16) & 1u)) >> 16; }
typedef float f32x2_t __attribute__((ext_vector_type(2))); typedef __bf16 bf16x2_t __attribute__((ext_vector_type(2)));
__device__ __forceinline__ unsigned pk2(float lo, float hi) { f32x2_t v = {lo, hi}; bf16x2_t b = __builtin_convertvector(v, bf16x2_t); return __builtin_bit_cast(unsigned, b); }
__device__ __forceinline__ unsigned pk4f8(float a, float b, float c, float d) { int r = 0; r = __builtin_amdgcn_cvt_pk_fp8_f32(a, b, r, false); r = __builtin_amdgcn_cvt_pk_fp8_f32(c, d, r, true); return (unsigned)r; }
constexpr float F8_WSCALE = 64.f, F8_WINV = 1.f / 64.f;
__device__ __forceinline__ float bflo(unsigned w) { return __builtin_bit_cast(float, w << 16); }
__device__ __forceinline__ float bfhi(unsigned w) { return __builtin_bit_cast(float, w & 0xffff0000u); }
__device__ __forceinline__ float fexp(float x) { return __builtin_amdgcn_exp2f(x * 1.4426950408889634f); }
__device__ __forceinline__ float flog(float x) { return __builtin_amdgcn_logf(x) * 0.6931471805599453f; }
__device__ __forceinline__ float sigm(float x) { return __builtin_amdgcn_rcpf(1.f + fexp(-x)); }
__device__ __forceinline__ float shx(float v, int mask, int lane) { return __builtin_bit_cast(float, __builtin_amdgcn_ds_bpermute((lane ^ mask) << 2, __builtin_bit_cast(int, v))); }
__device__ __forceinline__ float wave_sum(float v, int lane) {
#pragma unroll
    for (int o = 1; o < 64; o <<= 1) v += shx(v, o, lane);
    return v;
}
__device__ __forceinline__ f32x4 mfma16(bf16x8 a, bf16x8 b, f32x4 c) { return __builtin_amdgcn_mfma_f32_16x16x32_bf16(a, b, c, 0, 0, 0); }
__device__ __forceinline__ s16x4 vtr(const LAS unsigned char* p) { return __builtin_bit_cast(s16x4, __builtin_amdgcn_ds_read_tr16_b64_v4i16((LAS s16x4*)p)); }
__device__ __forceinline__ bf16x8 cat8(s16x4 lo, s16x4 hi) { return __builtin_shufflevector(lo, hi, 0, 1, 2, 3, 4, 5, 6, 7); }
__device__ __forceinline__ bf16x8 pack8(f32x4 a, f32x4 b) { v4u w; w.x = pk2(a[0], a[1]); w.y = pk2(a[2], a[3]); w.z = pk2(b[0], b[1]); w.w = pk2(b[2], b[3]); return __builtin_bit_cast(bf16x8, w); }
__device__ __forceinline__ float rstd16(const float* ssqp, size_t row) { const f32x4* p = (const f32x4*)(ssqp + row * 16); const f32x4 a = p[0], b = p[1], c = p[2], d = p[3];
    const float s = ((a[0] + a[1]) + (a[2] + a[3])) + ((b[0] + b[1]) + (b[2] + b[3])) + ((c[0] + c[1]) + (c[2] + c[3])) + ((d[0] + d[1]) + (d[2] + d[3])); return rsqrtf(s * (1.f / 1024.f) + 1e-5f); }
__device__ __forceinline__ unsigned ld_agent(const unsigned* p) { return __hip_atomic_load(p, RLX_AGENT); }


#define XB_TMO      128
#define XB_XCNT(j)  (256  + 64 * (j))
#define XB_XSUB(j)  (1280 + 64 * (j))
#define XB_XGEN(j)  (2304 + 64 * (j))
#define XB_TOP      3328
#define XB_TOPGEN   3392
#define XCD_BAR_WORDS 3456
#define XB_SPIN_CAP (1u << 18)

__device__ __forceinline__ unsigned xb_ld(unsigned* p)              { return __hip_atomic_load(p, __ATOMIC_RELAXED, __HIP_MEMORY_SCOPE_AGENT); }
__device__ __forceinline__ unsigned xb_add(unsigned* p, unsigned v) { return __hip_atomic_fetch_add(p, v, __ATOMIC_RELAXED, __HIP_MEMORY_SCOPE_AGENT); }
__device__ __forceinline__ unsigned xb_xcc_id() { return (unsigned)__builtin_amdgcn_s_getreg((3 << 11) | 20) & 0xFu; }
#define XB_SPIN(cond, bar) do { unsigned _sp = 0; while (cond) { __builtin_amdgcn_s_sleep(1); \
    if ((++_sp & 255u) == 0u) { if (xb_ld(&(bar)[XB_TMO])) break; if (_sp > XB_SPIN_CAP) { atomicAdd(&(bar)[XB_TMO], 1u); break; } } } } while (0)

struct XcdBarrier {
    unsigned* bar; unsigned x; int t0;
    volatile LAS unsigned* st;
};

__device__ __forceinline__ bool xb_is_t0(int wave) { return wave == 0 && __builtin_amdgcn_mbcnt_hi(~0u, __builtin_amdgcn_mbcnt_lo(~0u, 0u)) == 0u; }
__device__ __forceinline__ XcdBarrier xcd_barrier_post(unsigned* bar, volatile LAS unsigned* st, int wave) {
    XcdBarrier b; b.bar = bar; b.x = xb_xcc_id(); b.st = st; b.t0 = wave;
    if (xb_is_t0(wave)) (void)xb_add(&bar[XB_XCNT(b.x)], 1u);
    return b;
}
__device__ __forceinline__ void xcd_barrier_complete(unsigned* bar, unsigned x, unsigned& nloc, unsigned& nx) {
    const unsigned G = gridDim.x * gridDim.y * gridDim.z;
    unsigned sum, cnt, mine, sp = 0u;
    for (;;) {
        sum = 0u; cnt = 0u; mine = 0u;
#pragma unroll
        for (unsigned j = 0; j < 16; ++j) { const unsigned c = xb_ld(&bar[XB_XCNT(j)]); sum += c; cnt += (c > 0u) ? 1u : 0u; mine = (j == x) ? c : mine; }
        if (sum == G) break;
        __builtin_amdgcn_s_sleep(1);
        if ((++sp & 255u) == 0u) { if (xb_ld(&bar[XB_TMO])) break; if (sp > XB_SPIN_CAP) { atomicAdd(&bar[XB_TMO], 1u); break; } }
    }
    nloc = mine > 0u ? mine : 1u; nx = cnt > 0u ? cnt : 1u;
}

__device__ __forceinline__ void xcd_barrier(const XcdBarrier& b) {
    asm volatile("s_waitcnt vmcnt(0)" ::: "memory");
    __syncthreads();
    if (xb_is_t0(b.t0)) {
        unsigned* bar = b.bar;
        __builtin_amdgcn_s_waitcnt(0);
        unsigned nloc = b.st[0], nx = b.st[1];
        if (nloc == 0u) { xcd_barrier_complete(bar, b.x, nloc, nx); b.st[0] = nloc; b.st[1] = nx; }
        const unsigned old = xb_add(&bar[XB_XSUB(b.x)], 1u);
        const unsigned gen = old / nloc;
        if (old + 1u == (gen + 1u) * nloc) {
            __builtin_amdgcn_fence(__ATOMIC_RELEASE, "agent");
            asm volatile("s_waitcnt vmcnt(0)" ::: "memory");
            const unsigned og = xb_add(&bar[XB_TOP], 1u);
            const unsigned tg = og / nx;
            if (og + 1u == (tg + 1u) * nx) xb_add(&bar[XB_TOPGEN], 1u);
            else XB_SPIN(xb_ld(&bar[XB_TOPGEN]) == tg, bar);
            __builtin_amdgcn_fence(__ATOMIC_ACQUIRE, "agent");
            xb_add(&bar[XB_XGEN(b.x)], 1u);
            asm volatile("s_waitcnt vmcnt(0)" ::: "memory");
        } else {
            XB_SPIN(xb_ld(&bar[XB_XGEN(b.x)]) == gen, bar);
            __builtin_amdgcn_fence(__ATOMIC_ACQUIRE, "agent");
            asm volatile("s_waitcnt vmcnt(0)" ::: "memory");
        }
    }
    __syncthreads();
}

struct Args {
    const float* in[25];
    float* out; unsigned char* ws;
    int ph_lo, ph_hi;
};

using pg8::Unit;
struct EpiStore {
    static constexpr bool PERM = true, AFTER_DRAIN = false;
    bf16* O; int ldc; const float* ssq; float scl;
    __device__ __forceinline__ void operator()(const f32x4 (&acc)[2][2][4][2], const Unit& u, int wr, int wc, int fr, int fq) const {
        const int row0 = u.pm * 256 + wr * 64 + fr, col0 = u.pn * 256 + wc * 32 + 8 * fq;
#pragma unroll
        for (int ai = 0; ai < 2; ++ai) { float sc[4];
#pragma unroll
            for (int m = 0; m < 4; ++m) sc[m] = (ssq ? rstd16(ssq, (size_t)(row0 + ai * 128 + m * 16)) : 1.f) * scl;
#pragma unroll
            for (int m = 0; m < 4; ++m) { const int row = row0 + ai * 128 + m * 16; bf16* rowp = O + (size_t)row * ldc + col0;
#pragma unroll
                for (int bj = 0; bj < 2; ++bj) { const f32x4 v0 = acc[ai][bj][m][0] * sc[m], v1 = acc[ai][bj][m][1] * sc[m];
                    v4u w; w.x = pk2(v0[0], v0[1]); w.y = pk2(v0[2], v0[3]); w.z = pk2(v1[0], v1[1]); w.w = pk2(v1[2], v1[3]);
                    __builtin_nontemporal_store(w, (v4u*)(rowp + bj * 128)); } } }
    }
};
struct EpiProj {
    static constexpr bool PERM = true, AFTER_DRAIN = false;
    unsigned char* pj;
    __device__ __forceinline__ void operator()(const f32x4 (&acc)[2][2][4][2], const Unit& u, int wr, int wc, int fr, int fq) const {
        const int row0 = u.pm * 256 + wr * 64 + fr, pn = u.pn;
        bf16* base[2]; unsigned rowmul, blmul;
        if (pn < 16) { const int T = pn >> 2; rowmul = 256u; blmul = 8u * 4096u * 256u;
#pragma unroll
            for (int bj = 0; bj < 2; ++bj) base[bj] = (bf16*)(pj + (size_t)T * (64u << 20) + (size_t)(2 * (pn & 3) + bj) * (4096u * 256u)) + wc * 32 + 8 * fq; }
        else if (pn < 20) { rowmul = 128u; blmul = 16u * 4096u * 128u;
#pragma unroll
            for (int bj = 0; bj < 2; ++bj) base[bj] = (bf16*)(pj + PJ_SQ + (size_t)(4 * (pn - 16) + 2 * bj + (wc >> 1)) * (4096u * 128u)) + (wc & 1) * 32 + 8 * fq; }
        else if (pn < 22) { rowmul = 128u; blmul = 4u * 4096u * 128u;
#pragma unroll
            for (int bj = 0; bj < 2; ++bj) base[bj] = (bf16*)(pj + (pn == 20 ? PJ_SK : PJ_SV) + (size_t)(2 * bj + (wc >> 1)) * (4096u * 128u)) + (wc & 1) * 32 + 8 * fq; }
        else { rowmul = 2048u; blmul = 4096u * 2048u;
#pragma unroll
            for (int bj = 0; bj < 2; ++bj) base[bj] = (bf16*)(pj + (pn < 26 ? PJ_GA : PJ_GB)) + ((pn - 22) & 3) * 256 + bj * 128 + wc * 32 + 8 * fq; }
#pragma unroll
        for (int ai = 0; ai < 2; ++ai)
#pragma unroll
            for (int m = 0; m < 4; ++m) { const int row = row0 + ai * 128 + m * 16; const size_t ro = (size_t)(row >> 12) * blmul + (size_t)(row & 4095) * rowmul;
#pragma unroll
                for (int bj = 0; bj < 2; ++bj) { const f32x4 v0 = acc[ai][bj][m][0], v1 = acc[ai][bj][m][1];
                    v4u w; w.x = pk2(v0[0], v0[1]); w.y = pk2(v0[2], v0[3]); w.z = pk2(v1[0], v1[1]); w.w = pk2(v1[2], v1[3]);
                    __builtin_nontemporal_store(w, (v4u*)((unsigned char*)base[bj] + ro)); } }
    }
};
template <bool ADD> struct EpiGate {
    static constexpr bool PERM = true, AFTER_DRAIN = false;
    bf16* T; const bf16* gl; const float* bias;
    __device__ __forceinline__ void operator()(const f32x4 (&acc)[2][2][4][2], const Unit& u, int wr, int wc, int fr, int fq) const {
        const int row0 = u.pm * 256 + wr * 64 + fr, col0 = u.pn * 256 + wc * 32 + 8 * fq;
        f32x4 bv[2][2];
#pragma unroll
        for (int bj = 0; bj < 2; ++bj)
#pragma unroll
            for (int n = 0; n < 2; ++n) bv[bj][n] = *(const f32x4*)(bias + col0 + bj * 128 + 4 * n);
#pragma unroll
        for (int am = 0; am < 4; ++am) { const int ai = am >> 1, mh = am & 1; v4u gw[2][2], tw[2][2];
#pragma unroll
            for (int mm = 0; mm < 2; ++mm)
#pragma unroll
                for (int bj = 0; bj < 2; ++bj) { const int row = row0 + ai * 128 + (2 * mh + mm) * 16; gw[mm][bj] = *(const v4u*)(gl + (size_t)row * DM + col0 + bj * 128);
                    if (ADD) tw[mm][bj] = *(const v4u*)(T + (size_t)row * DM + col0 + bj * 128); }
#pragma unroll
            for (int mm = 0; mm < 2; ++mm)
#pragma unroll
                for (int bj = 0; bj < 2; ++bj) { const int m = 2 * mh + mm; const int row = row0 + ai * 128 + m * 16; const v4u g4 = gw[mm][bj]; float r[8];
                    r[0] = sigm(bflo(g4.x) + bv[bj][0][0]) * acc[ai][bj][m][0][0]; r[1] = sigm(bfhi(g4.x) + bv[bj][0][1]) * acc[ai][bj][m][0][1];
                    r[2] = sigm(bflo(g4.y) + bv[bj][0][2]) * acc[ai][bj][m][0][2]; r[3] = sigm(bfhi(g4.y) + bv[bj][0][3]) * acc[ai][bj][m][0][3];
                    r[4] = sigm(bflo(g4.z) + bv[bj][1][0]) * acc[ai][bj][m][1][0]; r[5] = sigm(bfhi(g4.z) + bv[bj][1][1]) * acc[ai][bj][m][1][1];
                    r[6] = sigm(bflo(g4.w) + bv[bj][1][2]) * acc[ai][bj][m][1][2]; r[7] = sigm(bfhi(g4.w) + bv[bj][1][3]) * acc[ai][bj][m][1][3];
                    if (ADD) { const v4u t4 = tw[mm][bj];
                        r[0] += bflo(t4.x); r[1] += bfhi(t4.x); r[2] += bflo(t4.y); r[3] += bfhi(t4.y); r[4] += bflo(t4.z); r[5] += bfhi(t4.z); r[6] += bflo(t4.w); r[7] += bfhi(t4.w); }
                    v4u w; w.x = pk2(r[0], r[1]); w.y = pk2(r[2], r[3]); w.z = pk2(r[4], r[5]); w.w = pk2(r[6], r[7]);
                    *(v4u*)(T + (size_t)row * DM + col0 + bj * 128) = w; } }
    }
};
template <bool BF> struct EpiResid {
    static constexpr bool PERM = true, AFTER_DRAIN = false;
    const float* base; bf16* obf; float* ssq; unsigned char* f8; float scl;
    __device__ __forceinline__ void operator()(const f32x4 (&acc)[2][2][4][2], const Unit& u, int wr, int wc, int fr, int fq) const {
        const int row0 = u.pm * 256 + wr * 64 + fr, col0 = u.pn * 256 + wc * 32 + 8 * fq;
#pragma unroll
        for (int ai = 0; ai < 2; ++ai)
#pragma unroll
            for (int mh = 0; mh < 2; ++mh) { f32x4 b0[2][2], b1[2][2];
#pragma unroll
                for (int mm = 0; mm < 2; ++mm)
#pragma unroll
                    for (int bj = 0; bj < 2; ++bj) { const size_t off = (size_t)(row0 + ai * 128 + (2 * mh + mm) * 16) * DM + col0 + bj * 128;
                        if (BF) { const v4u bw = *(const v4u*)(obf + off); b0[mm][bj] = (f32x4){bflo(bw.x), bfhi(bw.x), bflo(bw.y), bfhi(bw.y)}; b1[mm][bj] = (f32x4){bflo(bw.z), bfhi(bw.z), bflo(bw.w), bfhi(bw.w)}; }
                        else { b0[mm][bj] = *(const f32x4*)(base + off); b1[mm][bj] = *(const f32x4*)(base + off + 4); } }
#pragma unroll
                for (int mm = 0; mm < 2; ++mm) { const int m = 2 * mh + mm; const int row = row0 + ai * 128 + m * 16; float ss = 0.f;
#pragma unroll
                    for (int bj = 0; bj < 2; ++bj) { const size_t off = (size_t)row * DM + col0 + bj * 128;
                        const f32x4 v0 = b0[mm][bj] + acc[ai][bj][m][0] * scl, v1 = b1[mm][bj] + acc[ai][bj][m][1] * scl;
                        v4u w; w.x = pk2(v0[0], v0[1]); w.y = pk2(v0[2], v0[3]); w.z = pk2(v1[0], v1[1]); w.w = pk2(v1[2], v1[3]);
                        *(v4u*)(obf + off) = w;
                        if (f8) { v2u q; q.x = pk4f8(v0[0], v0[1], v0[2], v0[3]); q.y = pk4f8(v1[0], v1[1], v1[2], v1[3]); *(v2u*)(f8 + off) = q; }
                        ss += ((v0[0] * v0[0] + v0[1] * v0[1]) + (v0[2] * v0[2] + v0[3] * v0[3])) + ((v1[0] * v1[0] + v1[1] * v1[1]) + (v1[2] * v1[2] + v1[3] * v1[3])); }
                    { const int ln_ = fr + 16 * fq; ss += shx(ss, 16, ln_); ss += shx(ss, 32, ln_); }
                    if (fq == 0) ssq[(size_t)row * 16 + (u.pn & 3) * 4 + wc] = ss; } }
    }
};
struct EpiSwiglu {
    static constexpr bool PERM = true, AFTER_DRAIN = false;
    unsigned char* act; const float* bgu; const float* row_rstd;
    __device__ __forceinline__ void operator()(const f32x4 (&acc)[2][2][4][2], const Unit& u, int wr, int wc, int fr, int fq) const {
        const int e = u.pn >> 3, pnl = u.pn & 7;
        const int rr0 = wr * 64 + fr, cl0 = pnl * 128 + wc * 32 + 8 * fq;
        f32x4 bg[2], bl[2]; float rs[2][4];
#pragma unroll
        for (int n = 0; n < 2; ++n) { bg[n] = *(const f32x4*)(bgu + e * 2048 + cl0 + 4 * n); bl[n] = *(const f32x4*)(bgu + e * 2048 + 1024 + cl0 + 4 * n); }
#pragma unroll
        for (int ai = 0; ai < 2; ++ai)
#pragma unroll
            for (int m = 0; m < 4; ++m) rs[ai][m] = row_rstd[u.aux + rr0 + ai * 128 + m * 16] * F8_WINV;
#pragma unroll
        for (int ai = 0; ai < 2; ++ai)
#pragma unroll
            for (int m = 0; m < 4; ++m) { const int row = u.pm * 256 + rr0 + ai * 128 + m * 16;
                float r[8];
#pragma unroll
                for (int n = 0; n < 2; ++n)
#pragma unroll
                    for (int j = 0; j < 4; ++j) { float gl = acc[ai][0][m][n][j] * rs[ai][m] + bg[n][j], li = acc[ai][1][m][n][j] * rs[ai][m] + bl[n][j];
                        gl = fminf(gl, 7.0f); li = fminf(fmaxf(li, -7.0f), 7.0f);
                        r[n * 4 + j] = gl * sigm(1.702f * gl) * (li + 1.0f); }
                v2u w; w.x = pk4f8(r[0], r[1], r[2], r[3]); w.y = pk4f8(r[4], r[5], r[6], r[7]);
                __builtin_nontemporal_store(w, (v2u*)(act + (size_t)row * DM + cl0)); }
    }
};
struct EpiDown {
    static constexpr bool PERM = true, AFTER_DRAIN = false;
    bf16* y; const float* bd; const float* row_gate;
    __device__ __forceinline__ void operator()(const f32x4 (&acc)[2][2][4][2], const Unit& u, int wr, int wc, int fr, int fq) const {
        const int e = u.pn >> 2, pnl = u.pn & 3;
        const int rr0 = wr * 64 + fr, col0 = pnl * 256 + wc * 32 + 8 * fq;
        f32x4 bv[2][2]; float gt[2][4];
#pragma unroll
        for (int bj = 0; bj < 2; ++bj)
#pragma unroll
            for (int n = 0; n < 2; ++n) bv[bj][n] = *(const f32x4*)(bd + e * 1024 + col0 + bj * 128 + 4 * n);
#pragma unroll
        for (int ai = 0; ai < 2; ++ai)
#pragma unroll
            for (int m = 0; m < 4; ++m) gt[ai][m] = row_gate[u.aux + rr0 + ai * 128 + m * 16];
#pragma unroll
        for (int ai = 0; ai < 2; ++ai)
#pragma unroll
            for (int m = 0; m < 4; ++m) { const int row = u.pm * 256 + rr0 + ai * 128 + m * 16;
#pragma unroll
                for (int bj = 0; bj < 2; ++bj) { const f32x4 v0 = (acc[ai][bj][m][0] * F8_WINV + bv[bj][0]) * gt[ai][m], v1 = (acc[ai][bj][m][1] * F8_WINV + bv[bj][1]) * gt[ai][m];
                    v4u w; w.x = pk2(v0[0], v0[1]); w.y = pk2(v0[2], v0[3]); w.z = pk2(v1[0], v1[1]); w.w = pk2(v1[2], v1[3]);
                    __builtin_nontemporal_store(w, (v4u*)(y + (size_t)row * DM + col0 + bj * 128)); } }
    }
};
struct GroupedOrder {
    int nunits, npn, G, c, half; const LAS unsigned* tab; const int* row_tok;
    __device__ __forceinline__ bool next(int i, Unit& u) const {
        const long L = (long)i * G + c; if (L >= nunits) return false;
        const int rb = (int)(L / npn), pn = (int)(L % npn);
        int e = 0;
#pragma unroll 4
        for (int k = 1; k < 32; ++k) e = (rb >= (int)tab[32 + k]) ? k : e;
        e = __builtin_amdgcn_readfirstlane(e);
        const int j = rb - (int)__builtin_amdgcn_readfirstlane(tab[32 + e]), cn = (int)__builtin_amdgcn_readfirstlane(tab[e]) - 256 * j;
        u.pm = rb; u.pn = e * npn + pn; u.aux = (half * 32 + e) * HTOK + 256 * j; u.cnt = cn < 256 ? cn : 256; return true;
    }
    __device__ __forceinline__ void rows(const Unit& u, int RA0, unsigned (&rn)[2][2]) const {
#pragma unroll
        for (int h = 0; h < 2; ++h) { const int r0 = h * 128 + RA0, r1 = r0 + 64, cm = u.cnt - 1;
            rn[h][0] = (unsigned)row_tok[u.aux + (r0 < cm ? r0 : cm)]; rn[h][1] = (unsigned)row_tok[u.aux + (r1 < cm ? r1 : cm)]; }
    }
    __device__ __forceinline__ void a_ready(const Unit&) const {}
    __device__ __forceinline__ void done(const Unit&) const {}
};
constexpr int MOE_TAB_OFF = 131072 + 1024;
__device__ __forceinline__ void moe_tables(const unsigned char* ws, int hb, LAS unsigned char* lds, int tid) {
    LAS unsigned* tab = (LAS unsigned*)(lds + MOE_TAB_OFF); const unsigned* gcnt = (const unsigned*)(ws + WS_GCNT);
    __syncthreads();
    if (tid < 32) tab[tid] = ld_agent(gcnt + (hb * 32 + tid) * 16);
    __syncthreads();
    if (tid == 0) { unsigned acc = 0; for (int e = 0; e < 32; ++e) { tab[32 + e] = acc; acc += (tab[e] + 255u) >> 8; } tab[64] = acc; }
    __syncthreads();
}

constexpr int RING_BYTES = 131072, MISC_OFF = RING_BYTES + 320, LDS_BYTES = 147456;

struct Ctx { LAS unsigned char* lds; int tid, lane, wave, G, gw, ngw; };

struct TItem { f32x4 v[8]; float gv[8]; };
__device__ __forceinline__ void titem_load(TItem& t, const float* W, int N, const float* gain, int k0, int n0, int lane) {
#pragma unroll
    for (int i = 0; i < 8; ++i) { const int kk = 8 * i + (lane >> 3); t.v[i] = *(const f32x4*)(W + (size_t)(k0 + kk) * N + n0 + (lane & 7) * 4); t.gv[i] = gain ? gain[k0 + kk] : 1.f; }
}
__device__ __forceinline__ void titem_to_lds(const TItem& t, LAS float* scr, int lane) {
#pragma unroll
    for (int i = 0; i < 8; ++i) { const int kk = 8 * i + (lane >> 3); LAS float* p = scr + kk * 33 + (lane & 7) * 4;
        p[0] = t.v[i][0] * t.gv[i]; p[1] = t.v[i][1] * t.gv[i]; p[2] = t.v[i][2] * t.gv[i]; p[3] = t.v[i][3] * t.gv[i]; }
    LDS_WAIT();
}
template <class RowMap>
__device__ __forceinline__ void titem_out(int K, bf16* WT, const LAS float* scr, int k0, int n0, int lane, RowMap rm) {
    const int c = lane & 7;
#pragma unroll
    for (int j = 0; j < 4; ++j) { const int n = (lane >> 3) + 8 * j; const LAS float* s = scr + (8 * c) * 33 + n;
        v4u o; o.x = pk2(s[0 * 33], s[1 * 33]); o.y = pk2(s[2 * 33], s[3 * 33]); o.z = pk2(s[4 * 33], s[5 * 33]); o.w = pk2(s[6 * 33], s[7 * 33]);
        *(v4u*)(WT + (size_t)rm(n0 + n) * K + k0 + 8 * c) = o; }
    LDS_WAIT();
}
template <class RowMap>
__device__ __forceinline__ void titem_out8(int K, unsigned char* WT, const LAS float* scr, int k0, int n0, int lane, RowMap rm) {
    const int c = lane & 7;
#pragma unroll
    for (int j = 0; j < 4; ++j) { const int n = (lane >> 3) + 8 * j; const LAS float* s = scr + (8 * c) * 33 + n;
        v2u o; o.x = pk4f8(s[0 * 33] * F8_WSCALE, s[1 * 33] * F8_WSCALE, s[2 * 33] * F8_WSCALE, s[3 * 33] * F8_WSCALE); o.y = pk4f8(s[4 * 33] * F8_WSCALE, s[5 * 33] * F8_WSCALE, s[6 * 33] * F8_WSCALE, s[7 * 33] * F8_WSCALE);
        *(v2u*)(WT + (size_t)rm(n0 + n) * K + k0 + 8 * c) = o; }
    LDS_WAIT();
}
template <class RowMap>
__device__ __forceinline__ void transpose_item(const float* W, int K, int N, bf16* WT, const float* gain, LAS float* scr, int item, int lane, RowMap rm) {
    const int nblk = N / 32, kb = item / nblk, nb = item % nblk, k0 = 64 * kb, n0 = 32 * nb;
    TItem t; titem_load(t, W, N, gain, k0, n0, lane); titem_to_lds(t, scr, lane); titem_out(K, WT, scr, k0, n0, lane, rm);
}
template <class RowMap>
__device__ __forceinline__ void transpose_item8(const float* W, int K, int N, unsigned char* WT, const float* gain, LAS float* scr, int item, int lane, RowMap rm) {
    const int nblk = N / 32, kb = item / nblk, nb = item % nblk, k0 = 64 * kb, n0 = 32 * nb;
    TItem t; titem_load(t, W, N, gain, k0, n0, lane); titem_to_lds(t, scr, lane); titem_out8(K, WT, scr, k0, n0, lane, rm);
}
struct RowId { int off; __device__ __forceinline__ int operator()(int n) const { return off + n; } };
struct RowGU { int e; __device__ __forceinline__ int operator()(int n) const { const int j = n & 1023; return e * 2048 + (j >> 7) * 256 + (n >> 10) * 128 + (j & 127); } };

__device__ __forceinline__ void rms_row_to_bf16(const float* xrow, const float* gain, bf16* orow, int lane) {
    const f32x4* xr = (const f32x4*)xrow + lane; const f32x4* gr = (const f32x4*)gain + lane;
    f32x4 v[4]; float s = 0.f;
#pragma unroll
    for (int j = 0; j < 4; ++j) { v[j] = xr[64 * j]; s += (v[j][0] * v[j][0] + v[j][1] * v[j][1]) + (v[j][2] * v[j][2] + v[j][3] * v[j][3]); }
    const float rstd = rsqrtf(wave_sum(s, lane) * (1.f / DM) + RMS_EPS);
    unsigned long long* o8 = (unsigned long long*)orow + lane;
#pragma unroll
    for (int j = 0; j < 4; ++j) { const f32x4 g = gr[64 * j]; const f32x4 w = v[j] * rstd * g;
        o8[64 * j] = (unsigned long long)pk2(w[0], w[1]) | ((unsigned long long)pk2(w[2], w[3]) << 32); }
}

__device__ __forceinline__ void phase_prologue(const Args& a, const Ctx& c) {
    LAS float* scr = (LAS float*)(c.lds + c.wave * 16384);
    unsigned char* ws = a.ws;
    constexpr int I_IN = 16 * (NCOL / 32), I_SQ = 16 * 32, I_R = 16;
    constexpr int NIT = I_IN + 7 * I_SQ + I_R;
    for (int it = c.gw; it < NIT; it += c.ngw) {
        int r = it;
        if (r < I_IN) { transpose_item(a.in[5], DM, NCOL, (bf16*)(ws + WS_WIN), nullptr, scr, r, c.lane, RowId{0}); continue; } r -= I_IN;
        if (r < I_SQ) { transpose_item(a.in[9], DM, DM, (bf16*)(ws + WS_WA), nullptr, scr, r, c.lane, RowId{0}); continue; } r -= I_SQ;
        if (r < I_SQ) { transpose_item(a.in[10], DM, DM, (bf16*)(ws + WS_WB), nullptr, scr, r, c.lane, RowId{0}); continue; } r -= I_SQ;
        if (r < I_SQ) { transpose_item(a.in[11], DM, DM, (bf16*)(ws + WS_WMIX), nullptr, scr, r, c.lane, RowId{0}); continue; } r -= I_SQ;
        if (r < I_SQ) { transpose_item8(a.in[13], DM, DM, ws + WS_WQ, a.in[12], scr, r, c.lane, RowId{0}); continue; } r -= I_SQ;
        if (r < I_SQ) { transpose_item(a.in[14], DM, DM, (bf16*)(ws + WS_WK), nullptr, scr, r, c.lane, RowId{0}); continue; } r -= I_SQ;
        if (r < I_SQ) { transpose_item(a.in[15], DM, DM, (bf16*)(ws + WS_WV), nullptr, scr, r, c.lane, RowId{0}); continue; } r -= I_SQ;
        if (r < I_SQ) { transpose_item8(a.in[16], DM, DM, ws + WS_WO, nullptr, scr, r, c.lane, RowId{0}); continue; } r -= I_SQ;
        transpose_item(a.in[18], DM, NEXP, (bf16*)(ws + WS_WR), a.in[17], scr, r, c.lane, RowId{0});
    }
    { const size_t n8 = (size_t)NBATCH * MEMLEN * DM / 8; const float* mem = a.in[1]; bf16* mb = (bf16*)(ws + WS_MEMBF);
      for (size_t i = (size_t)c.gw * 64 + c.lane; i < n8; i += (size_t)c.ngw * 64) { const f32x4 v0 = *(const f32x4*)(mem + i * 8), v1 = *(const f32x4*)(mem + i * 8 + 4);
          v4u w; w.x = pk2(v0[0], v0[1]); w.y = pk2(v0[2], v0[3]); w.z = pk2(v1[0], v1[1]); w.w = pk2(v1[2], v1[3]); *(v4u*)(mb + i * 8) = w; } }
    if (c.gw == 0) {
        float* lb = (float*)(ws + WS_LB); const float* lbl = a.in[3];
        for (int k = c.lane; k < 1024; k += 64) lb[k] = 1.f / (1.f + expf(lbl[1024 + k] - lbl[k]));
    }
    if (c.gw == 1) {
        float* lut = (float*)(ws + WS_LUT); const float* t5 = a.in[2];
        for (int i = c.lane; i < 16 * 128; i += 64) { const int h = i >> 7, d = i & 127; int b = d;
            if (d >= 16) { b = 16 + (int)(logf((float)d * (1.f / 16.f)) / logf(8.f) * 16.f); b = b < 31 ? b : 31; }
            lut[i] = t5[b * 16 + h]; }
    }
}

__device__ __forceinline__ void phase_norm1(const Args& a, const Ctx& c, int hb) {
    const float* x = a.in[0] + (size_t)hb * HTOK * DM; bf16* xn = (bf16*)(a.ws + WS_TM);
    for (int m = c.gw; m < HTOK; m += c.ngw) rms_row_to_bf16(x + (size_t)m * DM, a.in[4], xn + (size_t)m * DM, c.lane);
}

constexpr int SWA_VB = 32 * 144;
constexpr int SWA_LUT_OFF = 8 * 2 * SWA_VB;
__device__ __forceinline__ void swa_unit(const bf16* proj, bf16* ob, int bl, int kvh, int tt, const LAS float* lut, LAS unsigned char* vbuf, const float* sinks, int lane) {
    const int l15 = lane & 15, g = lane >> 4, q4 = l15 >> 2, p4 = lane & 3;
    const int t0 = tt * 16; const size_t rowb = (size_t)bl * SEQ;
    const bf16* sq = (const bf16*)((const unsigned char*)proj + PJ_SQ) + (size_t)(bl * 16 + kvh * 4) * SEQ * 64;
    const bf16* sk = (const bf16*)((const unsigned char*)proj + PJ_SK) + (size_t)(bl * 4 + kvh) * SEQ * 64;
    const bf16* sv = (const bf16*)((const unsigned char*)proj + PJ_SV) + (size_t)(bl * 4 + kvh) * SEQ * 64;
    bf16x8 qf[4][2];
#pragma unroll
    for (int gq = 0; gq < 4; ++gq)
#pragma unroll
        for (int ks = 0; ks < 2; ++ks) qf[gq][ks] = *(const bf16x8*)(sq + ((size_t)gq * SEQ + t0 + l15) * 64 + ks * 32 + 8 * g);
    float mx[4], ls[4]; f32x4 o[4][4];
#pragma unroll
    for (int gq = 0; gq < 4; ++gq) { mx[gq] = sinks[kvh * 4 + gq]; ls[gq] = 1.f;
#pragma unroll
        for (int dt = 0; dt < 4; ++dt) o[gq][dt] = (f32x4){0.f, 0.f, 0.f, 0.f}; }
    for (int c = 0; c < 5; ++c) {
        const int kc = t0 - 144 + 32 * c;
        if (kc + 31 < 0) continue;
        LAS unsigned char* vb = vbuf + (c & 1) * SWA_VB;
#pragma unroll
        for (int i = 0; i < 4; ++i) { const int p = lane + 64 * i, key = p >> 3, d8 = p & 7; int kr = kc + key; kr = kr < 0 ? 0 : kr;
            const v4u vv = *(const v4u*)(sv + (size_t)kr * 64 + d8 * 8);
            *(LAS v4u*)(vb + key * 144 + d8 * 16) = vv; }
        f32x4 s[4][2];
#pragma unroll
        for (int ksub = 0; ksub < 2; ++ksub) { int kr = kc + 16 * ksub + l15; kr = kr < 0 ? 0 : kr;
            const bf16* kp = sk + (size_t)kr * 64 + 8 * g;
            const bf16x8 k0 = *(const bf16x8*)kp, k1 = *(const bf16x8*)(kp + 32);
#pragma unroll
            for (int gq = 0; gq < 4; ++gq) { f32x4 z = (f32x4){0.f, 0.f, 0.f, 0.f}; z = mfma16(k0, qf[gq][0], z); s[gq][ksub] = mfma16(k1, qf[gq][1], z); } }
        bf16x8 pf[4];
#pragma unroll
        for (int gq = 0; gq < 4; ++gq) { const int hq = kvh * 4 + gq; float cm = -1e30f;
#pragma unroll
            for (int ksub = 0; ksub < 2; ++ksub)
#pragma unroll
                for (int r = 0; r < 4; ++r) { const int key = kc + 16 * ksub + 4 * g + r, dist = t0 + l15 - key; const bool ok = (dist >= 0) && (dist < 128) && (key >= 0);
                    const int di = dist < 0 ? 0 : (dist > 127 ? 127 : dist);
                    float v = s[gq][ksub][r] * 0.125f + lut[hq * 128 + di]; v = ok ? v : -1e30f; s[gq][ksub][r] = v; cm = fmaxf(cm, v); }
            cm = fmaxf(cm, shx(cm, 16, lane)); cm = fmaxf(cm, shx(cm, 32, lane));
            const float mn = fmaxf(mx[gq], cm), alpha = fexp(mx[gq] - mn); mx[gq] = mn; float rs = 0.f;
#pragma unroll
            for (int ksub = 0; ksub < 2; ++ksub)
#pragma unroll
                for (int r = 0; r < 4; ++r) { const float p = fexp(s[gq][ksub][r] - mn); s[gq][ksub][r] = p; rs += p; }
            rs += shx(rs, 16, lane); rs += shx(rs, 32, lane);
            ls[gq] = ls[gq] * alpha + rs;
#pragma unroll
            for (int dt = 0; dt < 4; ++dt) o[gq][dt] = o[gq][dt] * alpha;
            pf[gq] = pack8(s[gq][0], s[gq][1]); }
        CFENCE();
#pragma unroll
        for (int dt = 0; dt < 4; ++dt) {
            const s16x4 lo = vtr(vb + (4 * g + q4) * 144 + (16 * dt + 4 * p4) * 2), hi = vtr(vb + (16 + 4 * g + q4) * 144 + (16 * dt + 4 * p4) * 2);
            const bf16x8 vf = cat8(lo, hi);
#pragma unroll
            for (int gq = 0; gq < 4; ++gq) o[gq][dt] = mfma16(vf, pf[gq], o[gq][dt]); }
        CFENCE();
    }
#pragma unroll
    for (int gq = 0; gq < 4; ++gq) { const float inv = __builtin_amdgcn_rcpf(ls[gq]);
#pragma unroll
        for (int dt = 0; dt < 4; ++dt) { const f32x4 v = o[gq][dt] * inv; v2u w; w.x = pk2(v[0], v[1]); w.y = pk2(v[2], v[3]);
            *(v2u*)(ob + (rowb + t0 + l15) * DM + (kvh * 4 + gq) * 64 + 16 * dt + 4 * g) = w; } }
}
constexpr int HGB_WAVES = 4;
__device__ __forceinline__ void hgB_work(const Args& a, const Ctx& c);
__device__ __forceinline__ void phase_swa_hgB(const Args& a, const Ctx& c) {
    const bf16* proj = (const bf16*)(a.ws + WS_PROJ); bf16* ob = (bf16*)(a.ws + WS_OB);
    LAS float* lut = (LAS float*)(c.lds + SWA_LUT_OFF); const float* glut = (const float*)(a.ws + WS_LUT);
    for (int i = c.tid; i < 16 * 128; i += 512) lut[i] = glut[i];
    __syncthreads();
    if (c.wave < HGB_WAVES) hgB_work(a, c);
    else {
        LAS unsigned char* vbuf = c.lds + c.wave * 2 * SWA_VB;
        constexpr int NU = 8 * 4 * 256;
        const int nsw = c.G * (8 - HGB_WAVES), sw = (int)blockIdx.x * (8 - HGB_WAVES) + (c.wave - HGB_WAVES);
        for (int u = sw; u < NU; u += nsw) { const int tt = u & 255, kvh = (u >> 8) & 3, bl = u >> 10; swa_unit(proj, ob, bl, kvh, tt, lut, vbuf, a.in[8], c.lane); }
    }
    __syncthreads();
}

constexpr int HG_LF = 0, HG_KP = 33792, HG_VT = 51200, HG_GT = 68608, HG_QP = 70656, HG_SSQ = 88064;
__device__ __forceinline__ void hg_scan(LAS unsigned char* lds, int tid, float (&loc)[16], float& pre, float& Gm, float& Gl) {
    const int ch = tid & 127, grp = tid >> 7;
    const LAS float* LF = (const LAS float*)(lds + HG_LF); LAS float* GT = (LAS float*)(lds + HG_GT);
    float run = 0.f;
#pragma unroll
    for (int i = 0; i < 16; ++i) { run += LF[(16 * grp + i) * 132 + ch]; loc[i] = run; }
    GT[grp * 128 + ch] = run;
    __syncthreads();
    const float g0 = GT[ch], g1 = GT[128 + ch], g2 = GT[256 + ch], g3 = GT[384 + ch];
    pre = (grp > 0 ? g0 : 0.f) + (grp > 1 ? g1 : 0.f) + (grp > 2 ? g2 : 0.f);
    Gm = g0 + g1; Gl = Gm + g2 + g3;
}
constexpr size_t OUT_KP = 0, OUT_QP = 64 * MiB;
constexpr int HS_FT = 0, HS_QT = 17408, HS_VT = 34816, HS_GT = 52224, HS_SLOT = 54272;
__device__ __forceinline__ void phase_hgA(const Args& a, const Ctx& c) {
    const bf16* proj = (const bf16*)(a.ws + WS_PROJ); bf16* US = (bf16*)((unsigned char*)a.out + OUT_US); float* D12 = (float*)(a.ws + WS_D12); const float* lb = (const float*)(a.ws + WS_LB);
    bf16* KPg = (bf16*)((unsigned char*)a.out + OUT_KP); bf16* QPg = (bf16*)((unsigned char*)a.out + OUT_QP);
    LAS unsigned char* lds = c.lds; const int tid = c.tid, lane = c.lane, w = c.wave;
    const int l15 = lane & 15, g = lane >> 4, q4 = l15 >> 2, p4 = lane & 3, ch = tid & 127, grp = tid >> 7;
    constexpr int NU = 8 * 8 * 64, NP = NU / 2;
    int pr = blockIdx.x; if (pr >= NP) return;
    v4u rq[2][2], rf[2][2], rv[2][2];
#define HGA_LOAD(pp) do { _Pragma("unroll") for (int s_ = 0; s_ < 2; ++s_) { const size_t uo = (size_t)(2 * (pp) + s_) * 8192;      \
        _Pragma("unroll") for (int i = 0; i < 2; ++i) { const size_t po = uo + (size_t)(tid + 512 * i) * 8; \
            rq[s_][i] = *(const v4u*)((const bf16*)((const unsigned char*)proj + PJ_HQ) + po); rf[s_][i] = *(const v4u*)((const bf16*)((const unsigned char*)proj + PJ_HF) + po); rv[s_][i] = *(const v4u*)((const bf16*)((const unsigned char*)proj + PJ_HI) + po); } } } while (0)
    HGA_LOAD(pr);
    for (;;) {
#pragma unroll
        for (int s = 0; s < 2; ++s)
#pragma unroll
            for (int i = 0; i < 2; ++i) { const int p = tid + 512 * i, tok = p >> 4, c8 = p & 15; LAS unsigned char* sb = lds + s * HS_SLOT + tok * 272 + c8 * 16;
                *(LAS v4u*)(sb + HS_FT) = rf[s][i]; *(LAS v4u*)(sb + HS_QT) = rq[s][i]; *(LAS v4u*)(sb + HS_VT) = rv[s][i]; }
        const int pcur = pr; const int pn = pr + gridDim.x; const bool has_next = pn < NP;
        if (has_next) HGA_LOAD(pn);
        __syncthreads();
        float loc[2][16];
#pragma unroll
        for (int s = 0; s < 2; ++s) { const int h = ((2 * pcur + s) >> 6) & 7; const float lbv = lb[h * 128 + ch]; const LAS bf16* FT = (const LAS bf16*)(lds + s * HS_SLOT + HS_FT);
            float ffv[16];
#pragma unroll
            for (int i = 0; i < 16; ++i) ffv[i] = __builtin_bit_cast(float, (unsigned)FT[(16 * grp + i) * 136 + ch] << 16);
            float run = 0.f;
#pragma unroll
            for (int i = 0; i < 16; ++i) { const float f = lbv + (1.f - lbv) * sigm(ffv[i]); run += flog(f); loc[s][i] = run; }
            ((LAS float*)(lds + s * HS_SLOT + HS_GT))[grp * 128 + ch] = run; }
        __syncthreads();
#pragma unroll
        for (int s = 0; s < 2; ++s) { const int ucur = 2 * pcur + s; const LAS float* GT = (const LAS float*)(lds + s * HS_SLOT + HS_GT);
            const float g0 = GT[ch], g1 = GT[128 + ch], g2 = GT[256 + ch], g3 = GT[384 + ch];
            const float pre = (grp > 0 ? g0 : 0.f) + (grp > 1 ? g1 : 0.f) + (grp > 2 ? g2 : 0.f), Gm = g0 + g1, Gl = Gm + g2 + g3;
            LAS bf16* KP = (LAS bf16*)(lds + s * HS_SLOT + HS_FT); LAS bf16* QP = (LAS bf16*)(lds + s * HS_SLOT + HS_QT);
            float qr[16];
#pragma unroll
            for (int i = 0; i < 16; ++i) qr[i] = __builtin_bit_cast(float, (unsigned)QP[(16 * grp + i) * 136 + ch] << 16);
#pragma unroll
            for (int i = 0; i < 16; ++i) { const float lfi = loc[s][i] - (i ? loc[s][i - 1] : 0.f), G = pre + loc[s][i];
                const float ed = fexp(fminf(Gm - G, 80.f));
                KP[(16 * grp + i) * 136 + ch] = (bf16)pk2((1.f - fexp(lfi)) * ed, 0.f);
                QP[(16 * grp + i) * 136 + ch] = (bf16)pk2(qr[i] * sigm(qr[i]) * __builtin_amdgcn_rcpf(ed), 0.f); }
            if (grp == 0) { D12[(size_t)ucur * 256 + ch] = fexp(Gm); D12[(size_t)ucur * 256 + 128 + ch] = fexp(Gl - Gm); } }
        __syncthreads();
#pragma unroll
        for (int s = 0; s < 2; ++s) { const int ucur = 2 * pcur + s; const int cc = ucur & 63, h = (ucur >> 6) & 7, bl = ucur >> 9; const size_t row0 = (size_t)bl * SEQ + cc * 64;
            const LAS unsigned char* sl = lds + s * HS_SLOT;
#pragma unroll
            for (int i = 0; i < 2; ++i) { const int p = tid + 512 * i, tok = p >> 4, c8 = p & 15; const size_t go = (size_t)ucur * 8192 + (size_t)p * 8;
                *(v4u*)(KPg + go) = *(const LAS v4u*)(sl + HS_FT + tok * 272 + c8 * 16); *(v4u*)(QPg + go) = *(const LAS v4u*)(sl + HS_QT + tok * 272 + c8 * 16); }
            bf16x8 af[2];
#pragma unroll
            for (int ks = 0; ks < 2; ++ks) { const LAS unsigned char* bp = sl + HS_FT + (32 * ks + 8 * g + q4) * 272 + (16 * w + 4 * p4) * 2; af[ks] = cat8(vtr(bp), vtr(bp + 4 * 272)); }
#pragma unroll
            for (int vt = 0; vt < 8; ++vt) { f32x4 acc = (f32x4){0.f, 0.f, 0.f, 0.f};
#pragma unroll
                for (int ks = 0; ks < 2; ++ks) { const LAS unsigned char* bp = sl + HS_VT + (32 * ks + 8 * g + q4) * 272 + (16 * vt + 4 * p4) * 2; acc = mfma16(af[ks], cat8(vtr(bp), vtr(bp + 4 * 272)), acc); }
                v2u wv; wv.x = pk2(acc[0], acc[1]); wv.y = pk2(acc[2], acc[3]);
                *(v2u*)(US + ((size_t)ucur * 128 + 16 * vt + l15) * 128 + 16 * w + 4 * g) = wv; } }
        __syncthreads();
        if (!has_next) break;
        pr = pn;
    }
#undef HGA_LOAD
}
__device__ __forceinline__ void hgB_work(const Args& a, const Ctx& c) {
    bf16* US = (bf16*)((unsigned char*)a.out + OUT_US); const float* D12 = (const float*)(a.ws + WS_D12);
    const int nthr = c.G * HGB_WAVES * 64, gt = ((int)blockIdx.x * HGB_WAVES + c.wave) * 64 + c.lane;
    for (int e = gt; e < 64 * 2048; e += nthr) {
        const int bh = e >> 11, r = e & 2047, k8 = r & 15;
        float S[8];
#pragma unroll
        for (int j = 0; j < 8; ++j) S[j] = 0.f;
        for (int c0 = 0; c0 < 64; c0 += 8) {
            v4u uw[8];
#pragma unroll
            for (int cc = 0; cc < 8; ++cc) uw[cc] = *(const v4u*)(US + ((size_t)bh * 64 + c0 + cc) * 16384 + (size_t)r * 8);
#pragma unroll
            for (int cc = 0; cc < 8; ++cc) { const size_t un = (size_t)bh * 64 + c0 + cc;
                const f32x4 d1a = *(const f32x4*)(D12 + un * 256 + k8 * 8), d1b = *(const f32x4*)(D12 + un * 256 + k8 * 8 + 4);
                const f32x4 d2a = *(const f32x4*)(D12 + un * 256 + 128 + k8 * 8), d2b = *(const f32x4*)(D12 + un * 256 + 128 + k8 * 8 + 4);
                const unsigned ww[4] = {uw[cc].x, uw[cc].y, uw[cc].z, uw[cc].w}; float sp[8];
#pragma unroll
                for (int j = 0; j < 8; ++j) { const float d1v = j < 4 ? d1a[j & 3] : d1b[j & 3], d2v = j < 4 ? d2a[j & 3] : d2b[j & 3]; const float uv = (j & 1) ? bfhi(ww[j >> 1]) : bflo(ww[j >> 1]);
                    sp[j] = d1v * S[j]; S[j] = d2v * (sp[j] + uv); }
                v4u o; o.x = pk2(sp[0], sp[1]); o.y = pk2(sp[2], sp[3]); o.z = pk2(sp[4], sp[5]); o.w = pk2(sp[6], sp[7]);
                *(v4u*)(US + un * 16384 + (size_t)r * 8) = o; }
        }
    }
}
__device__ __forceinline__ void phase_hgC(const Args& a, const Ctx& c) {
    const bf16* proj = (const bf16*)(a.ws + WS_PROJ); const bf16* US = (const bf16*)((unsigned char*)a.out + OUT_US); bf16* oa = (bf16*)(a.ws + WS_OA);
    const bf16* KPg = (const bf16*)((unsigned char*)a.out + OUT_KP); const bf16* QPg = (const bf16*)((unsigned char*)a.out + OUT_QP);
    const float* hgain = a.in[7];
    LAS unsigned char* lds = c.lds; const int tid = c.tid, lane = c.lane, w = c.wave;
    const int l15 = lane & 15, g = lane >> 4, q4 = l15 >> 2, p4 = lane & 3;
    constexpr int NU = 8 * 8 * 64, NP = NU / 2;
    int pr = blockIdx.x; if (pr >= NP) return;
    v4u rk[2][2], rq[2][2], rv[2][2];
#define HGC_LOAD(pp) do { _Pragma("unroll") for (int s_ = 0; s_ < 2; ++s_) { const size_t uo = (size_t)(2 * (pp) + s_) * 8192; \
        _Pragma("unroll") for (int i = 0; i < 2; ++i) { const size_t po = uo + (size_t)(tid + 512 * i) * 8; \
            rk[s_][i] = *(const v4u*)(KPg + po); rq[s_][i] = *(const v4u*)(QPg + po); rv[s_][i] = *(const v4u*)((const bf16*)((const unsigned char*)proj + PJ_HI) + po); } } } while (0)
    HGC_LOAD(pr);
    const f32x4 gn = *(const f32x4*)(hgain + 16 * w + 4 * g);
    for (;;) {
#pragma unroll
        for (int s = 0; s < 2; ++s)
#pragma unroll
            for (int i = 0; i < 2; ++i) { const int p = tid + 512 * i, tok = p >> 4, c8 = p & 15; LAS unsigned char* sb = lds + s * HS_SLOT + tok * 272 + c8 * 16;
                *(LAS v4u*)(sb + HS_FT) = rk[s][i]; *(LAS v4u*)(sb + HS_QT) = rq[s][i]; *(LAS v4u*)(sb + HS_VT) = rv[s][i]; }
        const int pcur = pr; const int pn = pr + gridDim.x; const bool has_next = pn < NP;
        bf16x8 sf[2][4]; v2u gwv[2][4];
#pragma unroll
        for (int s = 0; s < 2; ++s) { const int ucur = 2 * pcur + s; const int cc = ucur & 63, h = (ucur >> 6) & 7, bl = ucur >> 9; const size_t row0 = (size_t)bl * SEQ + cc * 64;
#pragma unroll
            for (int ks = 0; ks < 4; ++ks) sf[s][ks] = *(const bf16x8*)(US + ((size_t)ucur * 128 + 16 * w + l15) * 128 + 32 * ks + 8 * g);
#pragma unroll
            for (int tt = 0; tt < 4; ++tt) gwv[s][tt] = *(const v2u*)((const bf16*)((const unsigned char*)proj + PJ_HG) + (size_t)ucur * 8192 + (16 * tt + l15) * 128 + 16 * w + 4 * g); }
        if (has_next) HGC_LOAD(pn);
        __syncthreads();
        f32x4 o[2][4];
#pragma unroll
        for (int s = 0; s < 2; ++s) { const LAS unsigned char* sl = lds + s * HS_SLOT;
            bf16x8 vf[2];
#pragma unroll
            for (int kk = 0; kk < 2; ++kk) { const LAS unsigned char* bp = sl + HS_VT + (32 * kk + 4 * g + q4) * 272 + (16 * w + 4 * p4) * 2; vf[kk] = cat8(vtr(bp), vtr(bp + 16 * 272)); }
#pragma unroll
            for (int tt = 0; tt < 4; ++tt) {
                bf16x8 qf[4];
#pragma unroll
                for (int ks = 0; ks < 4; ++ks) qf[ks] = *(const LAS bf16x8*)(sl + HS_QT + (16 * tt + l15) * 272 + (32 * ks + 8 * g) * 2);
                f32x4 acc = (f32x4){0.f, 0.f, 0.f, 0.f};
#pragma unroll
                for (int ks = 0; ks < 4; ++ks) acc = mfma16(sf[s][ks], qf[ks], acc);
                f32x4 at[4];
#pragma unroll
                for (int st = 0; st < 4; ++st) { at[st] = (f32x4){0.f, 0.f, 0.f, 0.f};
                    if (st <= tt) {
#pragma unroll
                        for (int ks = 0; ks < 4; ++ks) { const bf16x8 kf = *(const LAS bf16x8*)(sl + HS_FT + (16 * st + l15) * 272 + (32 * ks + 8 * g) * 2); at[st] = mfma16(kf, qf[ks], at[st]); }
                        if (st == tt) {
#pragma unroll
                            for (int r = 0; r < 4; ++r) at[st][r] = (4 * g + r <= l15) ? at[st][r] : 0.f; } } }
                acc = mfma16(vf[0], pack8(at[0], at[1]), acc);
                if (tt >= 2) acc = mfma16(vf[1], pack8(at[2], at[3]), acc);
                o[s][tt] = acc; }
            LAS float* SSQ = (LAS float*)(lds + s * HS_SLOT + HS_GT);
#pragma unroll
            for (int tt = 0; tt < 4; ++tt) { float q = (o[s][tt][0] * o[s][tt][0] + o[s][tt][1] * o[s][tt][1]) + (o[s][tt][2] * o[s][tt][2] + o[s][tt][3] * o[s][tt][3]);
                q += shx(q, 16, lane); q += shx(q, 32, lane); if (g == 0) SSQ[w * 64 + 16 * tt + l15] = q; } }
        __syncthreads();
#pragma unroll
        for (int s = 0; s < 2; ++s) { const int ucur = 2 * pcur + s; const int cc = ucur & 63, h = (ucur >> 6) & 7, bl = ucur >> 9; const size_t row0 = (size_t)bl * SEQ + cc * 64;
            const LAS float* SSQ = (const LAS float*)(lds + s * HS_SLOT + HS_GT);
#pragma unroll
            for (int tt = 0; tt < 4; ++tt) { float q = 0.f;
#pragma unroll
                for (int ww = 0; ww < 8; ++ww) q += SSQ[ww * 64 + 16 * tt + l15];
                const float rstd = rsqrtf(q * (1.f / 128.f) + RMS_EPS);
                const size_t row = row0 + 16 * tt + l15;
                const v2u gw = gwv[s][tt];
                const float g0 = bflo(gw.x), g1 = bfhi(gw.x), g2 = bflo(gw.y), g3 = bfhi(gw.y);
                const float r0 = o[s][tt][0] * rstd * gn[0] * (g0 * sigm(g0)), r1 = o[s][tt][1] * rstd * gn[1] * (g1 * sigm(g1));
                const float r2 = o[s][tt][2] * rstd * gn[2] * (g2 * sigm(g2)), r3 = o[s][tt][3] * rstd * gn[3] * (g3 * sigm(g3));
                v2u wv; wv.x = pk2(r0, r1); wv.y = pk2(r2, r3);
                *(v2u*)(oa + row * DM + h * 128 + 16 * w + 4 * g) = wv; } }
        __syncthreads();
        if (!has_next) break;
        pr = pn;
    }
#undef HGC_LOAD
}

typedef float f32x16 __attribute__((ext_vector_type(16)));
constexpr int XA_KROW = 528, XA_VROW = 72, XA_KB = 32 * XA_KROW, XA_VB = 256 * XA_VROW, XA_STAGE = XA_KB + XA_VB;
__device__ __forceinline__ void phase_xa(const Args& a, const Ctx& c) {
    const bf16* qg = (const bf16*)(a.ws + WS_Q); unsigned char* og = a.ws + WS_O;     const bf16* kx = (const bf16*)(a.ws + WS_KX); const bf16* vxt = (const bf16*)(a.ws + WS_VXT);
    LAS unsigned char* lds = c.lds; const int tid = c.tid, lane = c.lane, w = c.wave;
    const int l31 = lane & 31, hh = lane >> 5, qt = w & 3, dh = w >> 2;
    constexpr int NU = NBATCH * 4 * (SEQ / 128);
    int u = blockIdx.x; if (u >= NU) return;
    v4u rk[2], rv[2];
#define XA_LOAD(uu, kc) do { const int b_ = (uu) >> 7, h_ = ((uu) >> 5) & 3; \
        _Pragma("unroll") for (int i = 0; i < 2; ++i) { const int p = tid + 512 * i; \
            rk[i] = *(const v4u*)(kx + (size_t)(b_ * MEMLEN + (kc) * 32 + (p >> 5)) * DM + h_ * 256 + (p & 31) * 8); \
            rv[i] = *(const v4u*)(vxt + (size_t)(h_ * 256 + (p >> 2)) * (NBATCH * MEMLEN) + b_ * MEMLEN + (kc) * 32 + (p & 3) * 8); } } while (0)
#define XA_STORE(buf) do { LAS unsigned char* sb = lds + (buf) * XA_STAGE; \
        _Pragma("unroll") for (int i = 0; i < 2; ++i) { const int p = tid + 512 * i; \
            *(LAS v4u*)(sb + (p >> 5) * XA_KROW + (p & 31) * 16) = rk[i]; \
            LAS v2u* vp = (LAS v2u*)(sb + XA_KB + (p >> 2) * XA_VROW + (p & 3) * 16); v2u lo; lo.x = rv[i].x; lo.y = rv[i].y; v2u hi; hi.x = rv[i].z; hi.y = rv[i].w; vp[0] = lo; vp[1] = hi; } } while (0)
    XA_LOAD(u, 0); XA_STORE(0);
    int par = 0;
    for (;;) {
        const int b = u >> 7, h = (u >> 5) & 3, qb = u & 31;
        const size_t row0 = (size_t)b * SEQ + qb * 128 + qt * 32;
        bf16x8 qf[16];
#pragma unroll
        for (int ks = 0; ks < 16; ++ks) qf[ks] = *(const bf16x8*)(qg + (row0 + l31) * DM + h * 256 + 16 * ks + 8 * hh);
        float mx = -1e30f, ls = 0.f; f32x16 o[4];
#pragma unroll
        for (int dt = 0; dt < 4; ++dt)
#pragma unroll
            for (int r = 0; r < 16; ++r) o[dt][r] = 0.f;
        const int un = u + gridDim.x; const bool has_next = un < NU;
        for (int kc = 0; kc < 8; ++kc) {
            __syncthreads();
            const bool more = (kc < 7) || has_next;
            if (more) { if (kc < 7) XA_LOAD(u, kc + 1); else XA_LOAD(un, 0); }
            const LAS unsigned char* kb = lds + par * XA_STAGE; const LAS unsigned char* vb = kb + XA_KB;
            f32x16 s;
#pragma unroll
            for (int r = 0; r < 16; ++r) s[r] = 0.f;
#pragma unroll
            for (int ks = 0; ks < 16; ++ks) { const bf16x8 kf = *(const LAS bf16x8*)(kb + l31 * XA_KROW + (16 * ks + 8 * hh) * 2); s = __builtin_amdgcn_mfma_f32_32x32x16_bf16(kf, qf[ks], s, 0, 0, 0); }
            float cm = -1e30f;
#pragma unroll
            for (int r = 0; r < 16; ++r) { s[r] *= 0.0625f; cm = fmaxf(cm, s[r]); }
            cm = fmaxf(cm, shx(cm, 32, lane));
            const float mn = fmaxf(mx, cm), alpha = fexp(mx - mn); mx = mn; float rs = 0.f;
#pragma unroll
            for (int r = 0; r < 16; ++r) { s[r] = fexp(s[r] - mn); rs += s[r]; }
            rs += shx(rs, 32, lane); ls = ls * alpha + rs;
#pragma unroll
            for (int dt = 0; dt < 4; ++dt)
#pragma unroll
                for (int r = 0; r < 16; ++r) o[dt][r] *= alpha;
            bf16x8 pf[2];
#pragma unroll
            for (int st = 0; st < 2; ++st) { v4u pw; pw.x = pk2(s[8 * st], s[8 * st + 1]); pw.y = pk2(s[8 * st + 2], s[8 * st + 3]); pw.z = pk2(s[8 * st + 4], s[8 * st + 5]); pw.w = pk2(s[8 * st + 6], s[8 * st + 7]); pf[st] = __builtin_bit_cast(bf16x8, pw); }
#pragma unroll
            for (int dt = 0; dt < 4; ++dt) { const LAS unsigned char* vrow = vb + (128 * dh + 32 * dt + l31) * XA_VROW + 8 * hh;
#pragma unroll
                for (int st = 0; st < 2; ++st) { const s16x4 lo = *(const LAS s16x4*)(vrow + 32 * st), hi = *(const LAS s16x4*)(vrow + 32 * st + 16);
                    o[dt] = __builtin_amdgcn_mfma_f32_32x32x16_bf16(cat8(lo, hi), pf[st], o[dt], 0, 0, 0); } }
            if (more) XA_STORE(par ^ 1);
            par ^= 1;
        }
        const float inv = __builtin_amdgcn_rcpf(ls);
#pragma unroll
        for (int dt = 0; dt < 4; ++dt)
#pragma unroll
            for (int rg = 0; rg < 4; ++rg)
                *(unsigned*)(og + (row0 + l31) * DM + h * 256 + 128 * dh + 32 * dt + 8 * rg + 4 * hh) = pk4f8(o[dt][4 * rg] * inv, o[dt][4 * rg + 1] * inv, o[dt][4 * rg + 2] * inv, o[dt][4 * rg + 3] * inv);
        if (!has_next) break;
        u = un;
    }
    __syncthreads();
#undef XA_LOAD
#undef XA_STORE
}

__device__ __forceinline__ void phase_expert_weights(const Args& a, const Ctx& c) {
    LAS float* scr = (LAS float*)(c.lds + c.wave * 16384);
    constexpr int I_GU = 16 * 64, I_D = 16 * 32;
    constexpr int NGU = NEXP * I_GU, NIT = NEXP * (I_GU + I_D);
#define EW_GEO(it, W_, N_, k0_, n0_) const bool gu_##W_ = (it) < NGU; const int r_##W_ = gu_##W_ ? (it) : (it) - NGU; const int e_##W_ = gu_##W_ ? r_##W_ / I_GU : r_##W_ / I_D; \
        const int q_##W_ = gu_##W_ ? r_##W_ % I_GU : r_##W_ % I_D; const int N_ = gu_##W_ ? 2048 : 1024; const int nblk_##W_ = N_ / 32; const int k0_ = 64 * (q_##W_ / nblk_##W_), n0_ = 32 * (q_##W_ % nblk_##W_); \
        const float* W_ = gu_##W_ ? a.in[20] + (size_t)e_##W_ * DM * 2048 : a.in[22] + (size_t)e_##W_ * DM * DM
    int it = c.gw; if (it >= NIT) { __syncthreads(); return; }
    TItem t;
    { EW_GEO(it, W0, N0, k00, n00); titem_load(t, W0, N0, gu_W0 ? a.in[17] : nullptr, k00, n00, c.lane); }
    for (;;) {
        EW_GEO(it, Wc, Nc, k0c, n0c);
        titem_to_lds(t, scr, c.lane);
        const int itn = it + c.ngw; const bool more = itn < NIT;
        if (more) { EW_GEO(itn, Wn, Nn, k0n, n0n); titem_load(t, Wn, Nn, gu_Wn ? a.in[17] : nullptr, k0n, n0n, c.lane); }
        if (gu_Wc) titem_out8(DM, a.ws + WS_WGU, scr, k0c, n0c, c.lane, RowGU{e_Wc});
        else titem_out8(DM, a.ws + WS_WD, scr, k0c, n0c, c.lane, RowId{e_Wc * 1024});
        if (!more) break;
        it = itn;
    }
#undef EW_GEO
    __syncthreads();
}
__device__ __forceinline__ void phase_router(const Args& a, const Ctx& c) {
    const bf16* xb = (const bf16*)(a.ws + WS_XBF); const bf16* wr = (const bf16*)(a.ws + WS_WR); const float* ssq2 = (const float*)(a.ws + WS_SSQ2); const float* br = a.in[19];
    int* tope = (int*)(a.ws + WS_TOPE); float* topg = (float*)(a.ws + WS_TOPG); int* topr = (int*)(a.ws + WS_TOPR); unsigned* gcnt = (unsigned*)(a.ws + WS_GCNT);
    LAS unsigned char* lds = c.lds; const int lane = c.lane, w = c.wave, l15 = lane & 15, g = lane >> 4;
    LAS float* LG = (LAS float*)(lds + w * 4096);
    LAS int* LE = (LAS int*)(lds + w * 4096 + 2560); LAS float* LGT = (LAS float*)(lds + w * 4096 + 2816);
    int* rtok = (int*)(a.ws + WS_RTOK); float* rgate = (float*)(a.ws + WS_RGATE2); float* rrstd = (float*)(a.ws + WS_RRSTD2);
    LAS unsigned* CNT = (LAS unsigned*)(lds + 32768); LAS unsigned* BASE = CNT + 32;
    for (int it = blockIdx.x; it < NTOK / 128; it += gridDim.x) {
        const int tok0 = it * 128 + w * 16; const int half = tok0 >= HTOK;
        if (c.tid < 32) CNT[c.tid] = 0u;
        f32x4 acc[2] = {(f32x4){0.f, 0.f, 0.f, 0.f}, (f32x4){0.f, 0.f, 0.f, 0.f}};
        const bf16* ap = xb + (size_t)(tok0 + l15) * DM + 8 * g;
#pragma unroll 8
        for (int ks = 0; ks < 32; ++ks) { const bf16x8 af = *(const bf16x8*)(ap + 32 * ks);
#pragma unroll
            for (int nt = 0; nt < 2; ++nt) { const bf16x8 bf = *(const bf16x8*)(wr + (size_t)(16 * nt + l15) * DM + 32 * ks + 8 * g); acc[nt] = mfma16(af, bf, acc[nt]); } }
#pragma unroll
        for (int nt = 0; nt < 2; ++nt)
#pragma unroll
            for (int r = 0; r < 4; ++r) { const int t = 4 * g + r; const float rs = rstd16(ssq2, (size_t)(tok0 + t)); LG[t * 33 + 16 * nt + l15] = acc[nt][r] * rs + br[16 * nt + l15]; }
        LDS_WAIT();
        if (lane < 16) { float v[32];
#pragma unroll
            for (int e = 0; e < 32; ++e) v[e] = LG[lane * 33 + e];
            int se[4]; float sv[4];
#pragma unroll
            for (int k = 0; k < 4; ++k) { float best = -3e38f; int bi = 0;
#pragma unroll
                for (int e = 0; e < 32; ++e) { const bool bt = v[e] > best; best = bt ? v[e] : best; bi = bt ? e : bi; }
                se[k] = bi; sv[k] = best;
#pragma unroll
                for (int e = 0; e < 32; ++e) v[e] = (e == bi) ? -3e38f : v[e]; }
            const float e1 = fexp(sv[1] - sv[0]), e2 = fexp(sv[2] - sv[0]), e3 = fexp(sv[3] - sv[0]); const float inv = 1.f / (1.f + e1 + e2 + e3);
            const int tok = tok0 + lane;
            *(int4*)(tope + (size_t)tok * 4) = make_int4(se[0], se[1], se[2], se[3]);
            *(float4*)(topg + (size_t)tok * 4) = make_float4(inv, e1 * inv, e2 * inv, e3 * inv);
#pragma unroll
            for (int k = 0; k < 4; ++k) LE[lane * 4 + k] = se[k];
            LGT[lane * 4 + 0] = inv; LGT[lane * 4 + 1] = e1 * inv; LGT[lane * 4 + 2] = e2 * inv; LGT[lane * 4 + 3] = e3 * inv; }
        __syncthreads();
        const int myE = LE[lane];
        const unsigned lr = atomicAdd((unsigned*)&CNT[myE], 1u);
        __syncthreads();
        if (c.tid < 32) { const unsigned n = CNT[c.tid]; BASE[c.tid] = n ? atomicAdd(gcnt + (half * 32 + c.tid) * 16, n) : 0u; }
        __syncthreads();
        { const int rank = (int)(BASE[myE] + lr), tok = tok0 + (lane >> 2); topr[(size_t)tok * 4 + (lane & 3)] = rank;
          const size_t ri = (size_t)(half * 32 + myE) * HTOK + rank; rtok[ri] = tok; rgate[ri] = LGT[lane]; rrstd[ri] = rstd16(ssq2, (size_t)tok); }
        __syncthreads();
    }
}
__device__ __forceinline__ void add16(f32x4 (&v)[4], const v4u y0, const v4u y1) {
    v[0][0] += bflo(y0.x); v[0][1] += bfhi(y0.x); v[0][2] += bflo(y0.y); v[0][3] += bfhi(y0.y); v[1][0] += bflo(y0.z); v[1][1] += bfhi(y0.z); v[1][2] += bflo(y0.w); v[1][3] += bfhi(y0.w);
    v[2][0] += bflo(y1.x); v[2][1] += bfhi(y1.x); v[2][2] += bflo(y1.y); v[2][3] += bfhi(y1.y); v[3][0] += bflo(y1.z); v[3][1] += bfhi(y1.z); v[3][2] += bflo(y1.w); v[3][3] += bfhi(y1.w);
}
__device__ __forceinline__ void phase_combine(const Args& a, const Ctx& c, int hb) {
    const bf16* y = (const bf16*)(a.ws + WS_Y); const bf16* xb = (const bf16*)(a.ws + WS_XBF); const int* tope = (const int*)(a.ws + WS_TOPE); const int* topr = (const int*)(a.ws + WS_TOPR); const float* gf = a.in[24];
    moe_tables(a.ws, hb, c.lds, c.tid);
    const LAS unsigned* tab = (const LAS unsigned*)(c.lds + MOE_TAB_OFF);
    for (int i = c.gw; i < HTOK; i += c.ngw) { const int tok = hb * HTOK + i;
        const int4 ee = *(const int4*)(tope + (size_t)tok * 4), rr = *(const int4*)(topr + (size_t)tok * 4);
        const int ps[4] = {(int)tab[32 + ee.x] * 256 + rr.x, (int)tab[32 + ee.y] * 256 + rr.y, (int)tab[32 + ee.z] * 256 + rr.z, (int)tab[32 + ee.w] * 256 + rr.w};
        f32x4 v[4];
#pragma unroll
        for (int j = 0; j < 4; ++j) v[j] = (f32x4){0.f, 0.f, 0.f, 0.f};
        { const v4u* xp = (const v4u*)(xb + (size_t)tok * DM + c.lane * 16); add16(v, xp[0], xp[1]); }
#pragma unroll
        for (int k = 0; k < 4; ++k) { const v4u* yp = (const v4u*)(y + (size_t)ps[k] * DM + c.lane * 16); add16(v, yp[0], yp[1]); }
        float s = 0.f;
#pragma unroll
        for (int j = 0; j < 4; ++j) s += (v[j][0] * v[j][0] + v[j][1] * v[j][1]) + (v[j][2] * v[j][2] + v[j][3] * v[j][3]);
        const float rstd = rsqrtf(wave_sum(s, c.lane) * (1.f / DM) + RMS_EPS);
        float* xr = a.out + (size_t)tok * DM + c.lane * 16;
#pragma unroll
        for (int j = 0; j < 4; ++j) { const f32x4 gg = *(const f32x4*)(gf + c.lane * 16 + 4 * j); *(f32x4*)(xr + 4 * j) = v[j] * rstd * gg; } }
}

#ifndef MK_PER_PHASE_LAUNCH
#define MK_PER_PHASE_LAUNCH 0
#endif
constexpr int NPHASES = 27;
#ifndef MK_OFF
#define MK_OFF 0u
#endif
#define MKP(k) (((MK_OFF >> (k)) & 1u) == 0u)
#define GSCHED PG8_ALIGN, PG8_SP2
typedef const __attribute__((address_space(4))) Args* KArgP;
#if defined(__HIP_DEVICE_COMPILE__)
__device__ __forceinline__ Args ldargs() { KArgP kp = (KArgP)__builtin_amdgcn_kernarg_segment_ptr(); asm volatile("" : "+s"(kp)); Args r;
#pragma unroll
    for (int i = 0; i < 25; ++i) r.in[i] = kp->in[i];
    r.out = kp->out; r.ws = kp->ws; r.ph_lo = kp->ph_lo; r.ph_hi = kp->ph_hi; return r; }
#else
__device__ __forceinline__ Args ldargs() { return Args{}; }
#endif
__global__ void __launch_bounds__(512, 2) mk_fwd(Args a_) {
    extern __shared__ __attribute__((aligned(16))) unsigned char lds_raw[];
    Ctx c; c.lds = (LAS unsigned char*)lds_raw; c.tid = threadIdx.x; c.lane = c.tid & 63; c.wave = __builtin_amdgcn_readfirstlane(c.tid >> 6); const int wv = c.wave;
    c.G = gridDim.x; c.gw = blockIdx.x * 8 + c.wave; c.ngw = c.G * 8;
    volatile LAS unsigned* MISC = (volatile LAS unsigned*)(c.lds + MISC_OFF);
    for (int u = c.tid; u < (LDS_BYTES - RING_BYTES) / 4; u += 512) ((LAS unsigned*)(c.lds + RING_BYTES))[u] = 0u;
    __syncthreads();
    const int ph_lo = a_.ph_lo, ph_hi = a_.ph_hi;
    const bool fused = (ph_hi - ph_lo) > 1;
    unsigned* barw = (unsigned*)a_.ws + CW_BAR;
    XcdBarrier bar; bar.bar = barw; bar.x = 0; bar.st = MISC + 8; bar.t0 = wv;
    if (fused) bar = xcd_barrier_post(barw, MISC + 8, wv);
    int pc = 0;
#define PH_ON (pc >= ph_lo && pc < ph_hi)
#define PH_END do { if (PH_ON && pc + 1 < ph_hi) xcd_barrier(bar); ++pc; OPQ(c); } while (0)
    LAS unsigned char* ring = c.lds;
#define OPQ(cc) do { { unsigned z_ = 0u; asm volatile("" : "+v"(z_)); cc.lane = (int)__builtin_amdgcn_mbcnt_hi(~0u, __builtin_amdgcn_mbcnt_lo(~0u, z_)); } cc.wave = wv; cc.tid = wv * 64 + cc.lane; { int gw_ = (int)blockIdx.x * 8 + wv; asm volatile("" : "+s"(gw_)); cc.gw = gw_; } } while (0)

    if (MKP(0) && PH_ON) { const Args a = ldargs(); unsigned char* ws = a.ws; (void)ws;  phase_prologue(a, c); __syncthreads(); }
    PH_END;
#pragma unroll
    for (int hb = 0; hb < 2; ++hb) {
        const size_t toff = (size_t)hb * HTOK;
        if (MKP(1) && PH_ON) { const Args a = ldargs(); phase_norm1(a, c, hb); }
        PH_END;
        if (MKP(2) && PH_ON) { const Args a = ldargs(); unsigned char* ws = a.ws; (void)ws;  pg8::Gemm g{(const bf16*)(ws + WS_TM), (const bf16*)(ws + WS_WIN), HTOK, NCOL, DM}; pg8::StaticOrder S; S.init(HTOK, NCOL, c.G, (int)blockIdx.x);
            EpiProj E{ws + WS_PROJ}; pg8::gemm_phase<EpiProj, pg8::StaticOrder, GSCHED>(ring, g, S, E, wv); }
        PH_END;
        if (MKP(3) && PH_ON) { const Args a = ldargs(); unsigned char* ws = a.ws; (void)ws;  phase_hgA(a, c); }
        PH_END;
        if (MKP(4) && PH_ON) { const Args a = ldargs(); phase_swa_hgB(a, c); }
        PH_END;
        if (MKP(5) && PH_ON) { const Args a = ldargs(); phase_hgC(a, c); }
        PH_END;
        if (MKP(6) && PH_ON) { const Args a = ldargs(); unsigned char* ws = a.ws; (void)ws;  pg8::Gemm g{(const bf16*)(ws + WS_OA), (const bf16*)(ws + WS_WA), HTOK, DM, DM}; pg8::StaticOrder S; S.init(HTOK, DM, c.G, (int)blockIdx.x);
            EpiGate<false> E{(bf16*)(ws + WS_TM), (const bf16*)(ws + WS_PROJ + PJ_GA), a.in[6]}; pg8::gemm_phase<EpiGate<false>, pg8::StaticOrder, GSCHED>(ring, g, S, E, wv); }
        PH_END;
        if (MKP(7) && PH_ON) { const Args a = ldargs(); unsigned char* ws = a.ws; (void)ws;  pg8::Gemm g{(const bf16*)(ws + WS_OB), (const bf16*)(ws + WS_WB), HTOK, DM, DM}; pg8::StaticOrder S; S.init(HTOK, DM, c.G, (int)blockIdx.x);
            EpiGate<true> E{(bf16*)(ws + WS_TM), (const bf16*)(ws + WS_PROJ + PJ_GB), a.in[6] + DM}; pg8::gemm_phase<EpiGate<true>, pg8::StaticOrder, GSCHED>(ring, g, S, E, wv); }
        PH_END;
        if (MKP(8) && PH_ON) { const Args a = ldargs(); unsigned char* ws = a.ws; (void)ws;  pg8::Gemm g{(const bf16*)(ws + WS_TM), (const bf16*)(ws + WS_WMIX), HTOK, DM, DM}; pg8::StaticOrder S; S.init(HTOK, DM, c.G, (int)blockIdx.x);
            EpiResid<false> E{a.in[0] + toff * DM, (bf16*)(ws + WS_XBF) + toff * DM, (float*)(ws + WS_SSQ1) + toff * 16, ws + WS_X1F8 + toff * DM, 1.f}; pg8::gemm_phase<EpiResid<false>, pg8::StaticOrder, GSCHED>(ring, g, S, E, wv); }
        PH_END;
    }
    if (MKP(9) && PH_ON) { const Args a = ldargs(); unsigned char* ws = a.ws; (void)ws;
        phase_expert_weights(a, c);
        { pg8::Gemm g{(const bf16*)(ws + WS_MEMBF), (const bf16*)(ws + WS_WK), NBATCH * MEMLEN, DM, DM}; pg8::StaticOrder S; S.init(NBATCH * MEMLEN, DM, c.G, (int)blockIdx.x);
          EpiStore E{(bf16*)(ws + WS_KX), DM, nullptr, 1.f}; pg8::gemm_phase<EpiStore, pg8::StaticOrder, GSCHED>(ring, g, S, E, wv); }
        { pg8::Gemm g{(const bf16*)(ws + WS_WV), (const bf16*)(ws + WS_MEMBF), DM, NBATCH * MEMLEN, DM}; pg8::StaticOrder S; S.init(DM, NBATCH * MEMLEN, c.G, (int)((blockIdx.x + 64) % c.G));
          EpiStore E{(bf16*)(ws + WS_VXT), NBATCH * MEMLEN, nullptr, 1.f}; pg8::gemm_phase<EpiStore, pg8::StaticOrder, GSCHED>(ring, g, S, E, wv); }
        { pg8::Gemm g{(const bf16*)(ws + WS_X1F8), (const bf16*)(ws + WS_WQ), NTOK, DM, DM}; pg8::StaticOrder S; S.init(NTOK, DM, c.G, (int)blockIdx.x);
          EpiStore E{(bf16*)(ws + WS_Q), DM, (const float*)(ws + WS_SSQ1), F8_WINV}; pg8::gemm_phase8<EpiStore, pg8::StaticOrder, GSCHED>(ring, g, S, E, wv); }
    }
    PH_END;
    if (MKP(10) && PH_ON) { const Args a = ldargs(); phase_xa(a, c); }
    PH_END;
    if (MKP(11) && PH_ON) { const Args a = ldargs(); unsigned char* ws = a.ws; (void)ws;  pg8::Gemm g{(const bf16*)(ws + WS_O), (const bf16*)(ws + WS_WO), NTOK, DM, DM}; pg8::StaticOrder S; S.init(NTOK, DM, c.G, (int)blockIdx.x);
        EpiResid<true> E{nullptr, (bf16*)(ws + WS_XBF), (float*)(ws + WS_SSQ2), ws + WS_X2F8, F8_WINV}; pg8::gemm_phase8<EpiResid<true>, pg8::StaticOrder, GSCHED>(ring, g, S, E, wv); }
    PH_END;
    if (MKP(12) && PH_ON) { const Args a = ldargs(); phase_router(a, c); }
    PH_END;
#pragma unroll
    for (int hb = 0; hb < 2; ++hb) {
        if (MKP(14) && PH_ON) { const Args a = ldargs(); unsigned char* ws = a.ws; moe_tables(ws, hb, c.lds, c.tid);
            const LAS unsigned* tab = (const LAS unsigned*)(c.lds + MOE_TAB_OFF); const int nb = (int)__builtin_amdgcn_readfirstlane(tab[64]);
            pg8::Gemm g{(const bf16*)(ws + WS_X2F8), (const bf16*)(ws + WS_WGU), NTOK, NEXP * 2048, DM};              GroupedOrder S{nb * 8, 8, c.G, (int)blockIdx.x, hb, tab, (const int*)(ws + WS_RTOK)};
            EpiSwiglu E{ws + WS_ACT, a.in[21], (const float*)(ws + WS_RRSTD2)}; pg8::gemm_phase_gather8<EpiSwiglu, GroupedOrder>(ring, g, S, E, wv); }
        PH_END;
        if (MKP(15) && PH_ON) { const Args a = ldargs(); unsigned char* ws = a.ws; moe_tables(ws, hb, c.lds, c.tid);
            const LAS unsigned* tab = (const LAS unsigned*)(c.lds + MOE_TAB_OFF); const int nb = (int)__builtin_amdgcn_readfirstlane(tab[64]);
            pg8::Gemm g{(const bf16*)(ws + WS_ACT), (const bf16*)(ws + WS_WD), CAPH, NEXP * 1024, DM}; GroupedOrder S{nb * 4, 4, c.G, (int)blockIdx.x, hb, tab, (const int*)(ws + WS_RTOK)};
            EpiDown E{(bf16*)(ws + WS_Y), a.in[23], (const float*)(ws + WS_RGATE2)}; pg8::gemm_phase8<EpiDown, GroupedOrder, GSCHED>(ring, g, S, E, wv); }
        PH_END;
        if (MKP(16) && PH_ON) { const Args a = ldargs(); phase_combine(a, c, hb); }
        PH_END;
    }
#undef PH_ON
#undef PH_END
}

#if defined(MK_DBG_STOP)
#ifndef MK_DBG_SRC_OUT
#define MK_DBG_SRC_OUT 0
#endif
#ifndef MK_DBG_F32
#define MK_DBG_F32 0
#endif
__global__ void dbg_dump(const unsigned short* src, float* out, size_t n, size_t N) {
    for (size_t i = (size_t)blockIdx.x * blockDim.x + threadIdx.x; i < N; i += (size_t)gridDim.x * blockDim.x) {
        if (i < n) { float v = MK_DBG_F32 ? ((const float*)src)[i] : __builtin_bit_cast(float, (unsigned)src[i] << 16); if (!(fabsf(v) < 1e30f)) v = 12345.f; out[i] = v; }
        else if (!MK_DBG_SRC_OUT) out[i] = 0.f;
    }
}
__global__ void dbg_zero_upper(float* out, size_t n0, size_t N) { for (size_t i = n0 + (size_t)blockIdx.x * blockDim.x + threadIdx.x; i < N; i += (size_t)gridDim.x * blockDim.x) out[i] = 0.f; }
#endif
extern "C" void kernel_launch(void* const* d_in, const int* in_sizes, int n_in, void* d_out, int out_size, void* d_ws, size_t ws_size, hipStream_t stream) {
    static int grid = 0;
    if (grid == 0) {
        if (n_in != 25 || out_size != NTOK * DM || ws_size < WS_END) { fprintf(stderr, "kernel_launch: unexpected problem shape (n_in %d, out %d, ws %zu); nothing launched\n", n_in, out_size, ws_size); grid = -1; return; }
        int dev = 0, cus = 0, per_cu = 0;
        if (hipGetDevice(&dev) != hipSuccess || hipDeviceGetAttribute(&cus, hipDeviceAttributeMultiprocessorCount, dev) != hipSuccess) { grid = -1; return; }
        if (hipFuncSetAttribute((const void*)mk_fwd, hipFuncAttributeMaxDynamicSharedMemorySize, LDS_BYTES) != hipSuccess) { fprintf(stderr, "kernel_launch: hipFuncSetAttribute failed\n"); grid = -1; return; }
        if (hipOccupancyMaxActiveBlocksPerMultiprocessor(&per_cu, (const void*)mk_fwd, 512, LDS_BYTES) != hipSuccess || per_cu < 1) { fprintf(stderr, "kernel_launch: occupancy query reports %d blocks per CU\n", per_cu); }
        (void)hipGetLastError();
        grid = cus;
    }
    if (grid < 0) return;
    (void)in_sizes;
    hipMemsetAsync(d_ws, 0, WS_ZERO_BYTES, stream);
    Args a{};
    for (int i = 0; i < 25; ++i) a.in[i] = (const float*)d_in[i];
    a.out = (float*)d_out; a.ws = (unsigned char*)d_ws;
#if defined(MK_DBG_STOP)
    for (int p = 0; p < MK_DBG_STOP; ++p) { a.ph_lo = p; a.ph_hi = p + 1; hipLaunchKernelGGL(mk_fwd, dim3(grid), dim3(512), LDS_BYTES, stream, a); }
    hipLaunchKernelGGL(dbg_dump, dim3(2048), dim3(256), 0, stream, (const unsigned short*)((const unsigned char*)(MK_DBG_SRC_OUT ? d_out : d_ws) + (size_t)MK_DBG_OFF_MIB * MiB), (float*)d_out, (size_t)MK_DBG_MIB * MiB / (MK_DBG_F32 ? 4 : 2), (size_t)NTOK * DM);
    if (MK_DBG_SRC_OUT) hipLaunchKernelGGL(dbg_zero_upper, dim3(2048), dim3(256), 0, stream, (float*)d_out, (size_t)MK_DBG_MIB * MiB / 2, (size_t)NTOK * DM);
#elif MK_PER_PHASE_LAUNCH
    for (int p = 0; p < NPHASES; ++p) { a.ph_lo = p; a.ph_hi = p + 1; hipLaunchKernelGGL(mk_fwd, dim3(grid), dim3(512), LDS_BYTES, stream, a);
#if defined(MK_REP_PC)
        if (p == MK_REP_PC) for (int r = 0; r < MK_REP_N; ++r) { if (p == 22 && false) (void)hipMemsetAsync((char*)d_ws + WS_GCNT, 0, 4096, stream); hipLaunchKernelGGL(mk_fwd, dim3(grid), dim3(512), LDS_BYTES, stream, a); }
#endif
    }
#else
    a.ph_lo = 0; a.ph_hi = NPHASES;
    hipLaunchKernelGGL(mk_fwd, dim3(grid), dim3(512), LDS_BYTES, stream, a);
#endif
}
```

```cpp
#include <hip/hip_runtime.h>
#include <cstdio>
#include <cstdint>
namespace pg8 {
#define PG8_LAS __attribute__((address_space(3)))
typedef unsigned short bf16_t;
typedef short bf16x8 __attribute__((ext_vector_type(8)));
typedef float f32x4 __attribute__((ext_vector_type(4)));
typedef unsigned u32x4 __attribute__((ext_vector_type(4)));
constexpr int BM = 256, BK = 64, HALF = 128, HTB = HALF * BK * 2  , STAGE_BYTES = 8 * HTB, NXCD = 8, WGM = 8;

__host__ __device__ __forceinline__ int lds_byte(int r, int c) { const int st = (r >> 4) * 2 + (c >> 5), rr = r & 15, cc = c & 31, ob = rr * 64 + cc * 2; return st * 1024 + (ob ^ (((ob >> 9) & 1) << 5)); }
__host__ __device__ __forceinline__ void stage_rc(int b, int& R, int& C) { const int st = b / 1024, sb = b % 1024, swz = sb ^ (((sb >> 9) & 1) << 5); R = (st >> 1) * 16 + swz / 64; C = (st & 1) * 32 + (swz % 64) / 2; }
__host__ __device__ __forceinline__ int perm32(int rho) { const int n = rho >> 4, i = rho & 15; return 8 * (i >> 2) + 4 * n + (i & 3); }

struct Unit { int pm, pn, aux, cnt; };
struct Gemm { const bf16_t* A; const bf16_t* Bt; int M, N, K; };

struct StaticOrder {
    int nM, nN, nwg, G, c;
    __host__ __device__ void init(int M, int N, int G_, int c_) { nM = M / BM; nN = N / BM; nwg = nM * nN; G = G_; c = c_; }
    __host__ __device__ bool next(int i, Unit& u) const {
        const long L = (long)i * G + c; if (L >= nwg) return false;
        int wgid = (int)L; { const int q = nwg / NXCD, r = nwg % NXCD, xcd = wgid % NXCD, off = wgid / NXCD; wgid = (xcd < r ? xcd * (q + 1) : r * (q + 1) + (xcd - r) * q) + off; }
        const int nig = WGM * nN, gid = wgid / nig, fm = gid * WGM, gsz = (nM - fm) < WGM ? (nM - fm) : WGM;
        u.pm = fm + ((wgid % nig) % gsz); u.pn = (wgid % nig) / gsz; return true;
    }
    __device__ __forceinline__ void a_ready(const Unit&) const {}
    __device__ __forceinline__ void done(const Unit&) const {}
};

__device__ __forceinline__ unsigned cvt_pk_bf16(float lo, float hi) { unsigned r; asm volatile("v_cvt_pk_bf16_f32 %0, %1, %2" : "=v"(r) : "v"(lo), "v"(hi)); return r; }
typedef float f32x2 __attribute__((ext_vector_type(2)));
template <class Epi, class Sched, bool ALIGN_EPI = false, bool SP2 = false>
__device__ __forceinline__ void gemm_phase(PG8_LAS unsigned char* lds, const Gemm g, const Sched& S, const Epi& E, const int wave_in) {
    unsigned z_ = 0u; asm volatile("" : "+v"(z_)); const int tid_ = (int)__builtin_amdgcn_mbcnt_hi(~0u, __builtin_amdgcn_mbcnt_lo(~0u, z_)) + 64 * wave_in;
    const int tid = tid_, wid = __builtin_amdgcn_readfirstlane(tid >> 6), lane = tid & 63, wr = wid >> 2, wc = wid & 3, fr = lane & 15, fq = lane >> 4;
    const int K = g.K, nt = K / BK;
    unsigned voffA[2], voffB[2];
#pragma unroll
    for (int i = 0; i < 2; ++i) { int R, C; stage_rc(tid * 16 + i * 8192, R, C); const int Rb = Epi::PERM ? ((R & ~31) + perm32(R & 31)) : R;
        voffA[i] = (unsigned)(R * K + C) * 2u; voffB[i] = (unsigned)(Rb * K + C) * 2u; }
    const size_t kstep = (size_t)(BK * 2);
    const size_t hstep = (size_t)HALF * K * 2;
    const size_t tstep = 2 * hstep;
    const unsigned ldsw = (unsigned)wid * 1024u;
    const int aoff = lds_byte(wr * 64 + fr, fq * 8), boff = lds_byte(wc * 32 + fr, fq * 8);
#define PG8_SA(b, h) (((b) * 2 + (h)) * HTB)
#define PG8_SB(b, h) ((4 + (b) * 2 + (h)) * HTB)
#define PG8_STAGE(bufoff, gbase, voff) do { _Pragma("unroll") for (int _i = 0; _i < 2; ++_i) \
        __builtin_amdgcn_global_load_lds((const unsigned*)((const char*)(gbase) + (voff)[_i]), (PG8_LAS unsigned*)(lds + (bufoff) + ldsw + _i * 8192), 16, 0, 0); } while (0)
#define PG8_LDA(dst, b, h) do { _Pragma("unroll") for (int m = 0; m < 4; ++m) _Pragma("unroll") for (int k = 0; k < 2; ++k) dst[m][k] = *(const PG8_LAS bf16x8*)(lds + PG8_SA(b, h) + aoff + m * 2048 + k * 1024); } while (0)
#define PG8_LDB(dst, b, h) do { _Pragma("unroll") for (int n = 0; n < 2; ++n) _Pragma("unroll") for (int k = 0; k < 2; ++k) dst[n][k] = *(const PG8_LAS bf16x8*)(lds + PG8_SB(b, h) + boff + n * 2048 + k * 1024); } while (0)
#define PG8_MMA(ai, bj, At, Bt) do { __builtin_amdgcn_s_setprio(1); _Pragma("unroll") for (int m = 0; m < 4; ++m) _Pragma("unroll") for (int n = 0; n < 2; ++n) _Pragma("unroll") for (int k = 0; k < 2; ++k) \
        acc[ai][bj][m][n] = __builtin_amdgcn_mfma_f32_16x16x32_bf16(Bt[n][k], At[m][k], acc[ai][bj][m][n], 0, 0, 0); __builtin_amdgcn_s_setprio(0); } while (0)
#define PG8_WAIT_V(n) asm volatile("s_waitcnt vmcnt(" #n ")" ::: "memory")
#define PG8_WAIT_L(n) asm volatile("s_waitcnt lgkmcnt(" #n ")" ::: "memory")
#define PG8_BAR __builtin_amdgcn_s_barrier()
#define PG8_SCHED __builtin_amdgcn_sched_barrier(0)
    Unit cur, nxt; int ui = 0;
    if (!S.next(0, cur)) return;
    f32x4 acc[2][2][4][2];
#pragma unroll
    for (int a = 0; a < 2; ++a)
#pragma unroll
        for (int b = 0; b < 2; ++b)
#pragma unroll
            for (int m = 0; m < 4; ++m)
#pragma unroll
                for (int n = 0; n < 2; ++n) acc[a][b][m][n] = (f32x4){0.f, 0.f, 0.f, 0.f};
    bf16x8 At[4][2], B0[2][2], B1[2][2];
    const char* cA = (const char*)g.A + (size_t)cur.pm * tstep; const char* cB = (const char*)g.Bt + (size_t)cur.pn * tstep;
    S.a_ready(cur);
    if constexpr (SP2) {
        PG8_STAGE(PG8_SB(0, 0), cB, voffB); PG8_STAGE(PG8_SB(0, 1), cB + hstep, voffB); PG8_STAGE(PG8_SA(0, 0), cA, voffA); PG8_STAGE(PG8_SA(0, 1), cA + hstep, voffA);
        if (wr == 1) PG8_BAR;
        PG8_WAIT_V(2); PG8_BAR;
        PG8_STAGE(PG8_SB(1, 0), cB + kstep, voffB); PG8_STAGE(PG8_SA(1, 0), cA + kstep, voffA); PG8_STAGE(PG8_SB(1, 1), cB + hstep + kstep, voffB);
        PG8_WAIT_V(6); PG8_BAR;
    } else {
        PG8_STAGE(PG8_SB(0, 0), cB, voffB); PG8_STAGE(PG8_SA(0, 0), cA, voffA); PG8_STAGE(PG8_SB(0, 1), cB + hstep, voffB); PG8_STAGE(PG8_SA(0, 1), cA + hstep, voffA);
        if (wr == 1) PG8_BAR;
        PG8_WAIT_V(4); PG8_BAR;
        PG8_STAGE(PG8_SB(1, 0), cB + kstep, voffB); PG8_STAGE(PG8_SA(1, 0), cA + kstep, voffA); PG8_STAGE(PG8_SB(1, 1), cB + hstep + kstep, voffB);
        PG8_WAIT_V(6); PG8_BAR;
    }
    for (;;) {
        const bool has_next = S.next(ui + 1, nxt);
        const char* nA = has_next ? (const char*)g.A + (size_t)nxt.pm * tstep : cA; const char* nB = has_next ? (const char*)g.Bt + (size_t)nxt.pn * tstep : cB;
        for (int t = 0; t < nt; t += 2) {
            const bool last = (t == nt - 2);
            const char* a1 = cA + (size_t)(t + 1) * kstep;
            const char* a2 = last ? nA : cA + (size_t)(t + 2) * kstep; const char* b2 = last ? nB : cB + (size_t)(t + 2) * kstep;
            const char* a3 = a2 + kstep; const char* b3 = b2 + kstep;
            if (last && has_next) S.a_ready(nxt);
            if constexpr (SP2) {
            PG8_LDB(B0, 0, 0); PG8_LDB(B1, 0, 1); PG8_SCHED; PG8_LDA(At, 0, 0); PG8_STAGE(PG8_SA(1, 1), a1 + hstep, voffA);
            PG8_WAIT_V(8); PG8_WAIT_L(0); PG8_BAR; PG8_MMA(0, 0, At, B0); PG8_MMA(0, 1, At, B1); PG8_BAR; PG8_SCHED;
            PG8_LDA(At, 0, 1); PG8_STAGE(PG8_SB(0, 0), b2, voffB); PG8_STAGE(PG8_SB(0, 1), b2 + hstep, voffB); PG8_STAGE(PG8_SA(0, 0), a2, voffA);
            PG8_WAIT_V(8); PG8_WAIT_L(0); PG8_BAR; PG8_MMA(1, 0, At, B0); PG8_MMA(1, 1, At, B1); PG8_BAR; PG8_SCHED;
            PG8_LDB(B0, 1, 0); PG8_LDB(B1, 1, 1); PG8_SCHED; PG8_LDA(At, 1, 0); PG8_STAGE(PG8_SA(0, 1), a2 + hstep, voffA);
            PG8_WAIT_V(8); PG8_WAIT_L(0); PG8_BAR; PG8_MMA(0, 0, At, B0); PG8_MMA(0, 1, At, B1); PG8_BAR; PG8_SCHED;
            PG8_LDA(At, 1, 1); PG8_STAGE(PG8_SB(1, 0), b3, voffB); PG8_STAGE(PG8_SB(1, 1), b3 + hstep, voffB); PG8_STAGE(PG8_SA(1, 0), a3, voffA);
            PG8_WAIT_V(8); PG8_WAIT_L(0); PG8_BAR; PG8_MMA(1, 0, At, B0); PG8_MMA(1, 1, At, B1); PG8_BAR; PG8_SCHED;
            } else {
            PG8_LDB(B0, 0, 0); PG8_SCHED; PG8_LDA(At, 0, 0); PG8_STAGE(PG8_SA(1, 1), a1 + hstep, voffA);
            PG8_WAIT_L(8); PG8_BAR; PG8_WAIT_L(0); PG8_MMA(0, 0, At, B0); PG8_BAR; PG8_SCHED;
            PG8_LDB(B1, 0, 1); PG8_STAGE(PG8_SB(0, 0), b2, voffB);
            PG8_BAR; PG8_WAIT_L(0); PG8_MMA(0, 1, At, B1); PG8_BAR;
            PG8_LDA(At, 0, 1); PG8_STAGE(PG8_SA(0, 0), a2, voffA);
            PG8_BAR; PG8_WAIT_L(0); PG8_MMA(1, 0, At, B0); PG8_BAR; PG8_SCHED;
            PG8_STAGE(PG8_SB(0, 1), b2 + hstep, voffB);
            PG8_WAIT_V(6); PG8_BAR; PG8_MMA(1, 1, At, B1); PG8_BAR;
            PG8_LDB(B0, 1, 0); PG8_SCHED; PG8_LDA(At, 1, 0); PG8_STAGE(PG8_SA(0, 1), a2 + hstep, voffA);
            PG8_WAIT_L(8); PG8_BAR; PG8_WAIT_L(0); PG8_MMA(0, 0, At, B0); PG8_BAR; PG8_SCHED;
            PG8_LDB(B1, 1, 1); PG8_STAGE(PG8_SB(1, 0), b3, voffB);
            PG8_BAR; PG8_WAIT_L(0); PG8_MMA(0, 1, At, B1); PG8_BAR;
            PG8_LDA(At, 1, 1); PG8_STAGE(PG8_SA(1, 0), a3, voffA);
            PG8_BAR; PG8_WAIT_L(0); PG8_MMA(1, 0, At, B0); PG8_BAR; PG8_SCHED;
            PG8_STAGE(PG8_SB(1, 1), b3 + hstep, voffB);
            PG8_WAIT_V(6); PG8_BAR; PG8_MMA(1, 1, At, B1); PG8_BAR;
            }
        }
        if constexpr (ALIGN_EPI) { if (wr == 0) PG8_BAR; }
        if constexpr (!Epi::AFTER_DRAIN) { E(acc, cur, wr, wc, fr, fq); S.done(cur); }
        if (!has_next) break;
#pragma unroll
        for (int a = 0; a < 2; ++a)
#pragma unroll
            for (int b = 0; b < 2; ++b)
#pragma unroll
                for (int m = 0; m < 4; ++m)
#pragma unroll
                    for (int n = 0; n < 2; ++n) acc[a][b][m][n] = (f32x4){0.f, 0.f, 0.f, 0.f};
        cur = nxt; cA = nA; cB = nB; ++ui;
        if constexpr (ALIGN_EPI) { if (wr == 1) PG8_BAR; }
    }
    PG8_WAIT_V(0);
    if constexpr (!ALIGN_EPI) { if (wr == 0) PG8_BAR; }
    PG8_BAR;
    if constexpr (Epi::AFTER_DRAIN) { E.fused(acc, cur, wr, wc, fr, fq, lds, wid, lane); S.done(cur); }
#undef PG8_SA
#undef PG8_SB
#undef PG8_STAGE
#undef PG8_LDA
#undef PG8_LDB
#undef PG8_MMA
#undef PG8_WAIT_V
#undef PG8_WAIT_L
#undef PG8_BAR
#undef PG8_SCHED
}
template <class Epi, class Sched>
__device__ __forceinline__ void gemm_phase_gather(PG8_LAS unsigned char* lds, const Gemm g, const Sched& S, const Epi& E, const int wave_in) {
    unsigned z_ = 0u; asm volatile("" : "+v"(z_)); const int tid_ = (int)__builtin_amdgcn_mbcnt_hi(~0u, __builtin_amdgcn_mbcnt_lo(~0u, z_)) + 64 * wave_in;
    const int tid = tid_, wid = __builtin_amdgcn_readfirstlane(tid >> 6), lane = tid & 63, wr = wid >> 2, wc = wid & 3, fr = lane & 15, fq = lane >> 4;
    constexpr bool ALIGN_EPI = true, SP2 = true;
    const int K = g.K, nt = K / BK;
    unsigned voffB[2]; int RA0; unsigned CA0;
#pragma unroll
    for (int i = 0; i < 2; ++i) { int R, C; stage_rc(tid * 16 + i * 8192, R, C); const int Rb = Epi::PERM ? ((R & ~31) + perm32(R & 31)) : R;
        if (i == 0) { RA0 = R; CA0 = (unsigned)C * 2u; } voffB[i] = (unsigned)(Rb * K + C) * 2u; }
    unsigned ro[2], rn[2][2];
    const size_t kstep = (size_t)(BK * 2);
    const size_t hstep = (size_t)HALF * K * 2;
    const size_t tstep = 2 * hstep;
    const unsigned ldsw = (unsigned)wid * 1024u;
    const int aoff = lds_byte(wr * 64 + fr, fq * 8), boff = lds_byte(wc * 32 + fr, fq * 8);
#define PG8_SA(b, h) (((b) * 2 + (h)) * HTB)
#define PG8_SB(b, h) ((4 + (b) * 2 + (h)) * HTB)
#define PG8_STAGE(bufoff, gbase, voff) do { _Pragma("unroll") for (int _i = 0; _i < 2; ++_i) \
        __builtin_amdgcn_global_load_lds((const unsigned*)((const char*)(gbase) + (voff)[_i]), (PG8_LAS unsigned*)(lds + (bufoff) + ldsw + _i * 8192), 16, 0, 0); } while (0)
#define PG8_STAGE_G(bufoff, kbyte, pk) do { _Pragma("unroll") for (int _i = 0; _i < 2; ++_i) { const unsigned _row = _i ? ((pk) >> 16) : ((pk) & 0xffffu); \
        __builtin_amdgcn_global_load_lds((const unsigned*)((const char*)g.A + (kbyte) + (_row * ((unsigned)K * 2u) + CA0)), (PG8_LAS unsigned*)(lds + (bufoff) + ldsw + _i * 8192), 16, 0, 0); } } while (0)
#define PG8_LDA(dst, b, h) do { _Pragma("unroll") for (int m = 0; m < 4; ++m) _Pragma("unroll") for (int k = 0; k < 2; ++k) dst[m][k] = *(const PG8_LAS bf16x8*)(lds + PG8_SA(b, h) + aoff + m * 2048 + k * 1024); } while (0)
#define PG8_LDB(dst, b, h) do { _Pragma("unroll") for (int n = 0; n < 2; ++n) _Pragma("unroll") for (int k = 0; k < 2; ++k) dst[n][k] = *(const PG8_LAS bf16x8*)(lds + PG8_SB(b, h) + boff + n * 2048 + k * 1024); } while (0)
#define PG8_MMA(ai, bj, At, Bt) do { __builtin_amdgcn_s_setprio(1); _Pragma("unroll") for (int m = 0; m < 4; ++m) _Pragma("unroll") for (int n = 0; n < 2; ++n) _Pragma("unroll") for (int k = 0; k < 2; ++k) \
        acc[ai][bj][m][n] = __builtin_amdgcn_mfma_f32_16x16x32_bf16(Bt[n][k], At[m][k], acc[ai][bj][m][n], 0, 0, 0); __builtin_amdgcn_s_setprio(0); } while (0)
#define PG8_WAIT_V(n) asm volatile("s_waitcnt vmcnt(" #n ")" ::: "memory")
#define PG8_WAIT_L(n) asm volatile("s_waitcnt lgkmcnt(" #n ")" ::: "memory")
#define PG8_BAR __builtin_amdgcn_s_barrier()
#define PG8_SCHED __builtin_amdgcn_sched_barrier(0)
    Unit cur, nxt; int ui = 0;
    if (!S.next(0, cur)) return;
    f32x4 acc[2][2][4][2];
#pragma unroll
    for (int a = 0; a < 2; ++a)
#pragma unroll
        for (int b = 0; b < 2; ++b)
#pragma unroll
            for (int m = 0; m < 4; ++m)
#pragma unroll
                for (int n = 0; n < 2; ++n) acc[a][b][m][n] = (f32x4){0.f, 0.f, 0.f, 0.f};
    bf16x8 At[4][2], B0[2][2], B1[2][2];
    const char* cB = (const char*)g.Bt + (size_t)cur.pn * tstep;
    S.a_ready(cur);
    S.rows(cur, RA0, rn); ro[0] = rn[0][0] | (rn[0][1] << 16); ro[1] = rn[1][0] | (rn[1][1] << 16);
    if constexpr (SP2) {
        PG8_STAGE(PG8_SB(0, 0), cB, voffB); PG8_STAGE(PG8_SB(0, 1), cB + hstep, voffB); PG8_STAGE_G(PG8_SA(0, 0), 0, ro[0]); PG8_STAGE_G(PG8_SA(0, 1), 0, ro[1]);
        if (wr == 1) PG8_BAR;
        PG8_WAIT_V(2); PG8_BAR;
        PG8_STAGE(PG8_SB(1, 0), cB + kstep, voffB); PG8_STAGE_G(PG8_SA(1, 0), kstep, ro[0]); PG8_STAGE(PG8_SB(1, 1), cB + hstep + kstep, voffB);
        PG8_WAIT_V(6); PG8_BAR;
    }
    for (;;) {
        const bool has_next = S.next(ui + 1, nxt);
        const char* nB = has_next ? (const char*)g.Bt + (size_t)nxt.pn * tstep : cB;
        for (int t = 0; t < nt; t += 2) {
            const bool last = (t == nt - 2);
            const size_t k1 = (size_t)(t + 1) * kstep, k2 = last ? (size_t)0 : (size_t)(t + 2) * kstep, k3 = k2 + kstep;
            const char* b2 = last ? nB : cB + (size_t)(t + 2) * kstep; const char* b3 = b2 + kstep;
            if (t == nt - 4 && has_next) S.rows(nxt, RA0, rn);
            const unsigned c1 = ro[1];
            unsigned s0 = ro[0], s1 = ro[1];
            if (last && has_next) { unsigned q0 = rn[0][0], q1 = rn[0][1], q2 = rn[1][0], q3 = rn[1][1]; asm volatile("" : "+v"(q0), "+v"(q1), "+v"(q2), "+v"(q3));
                s0 = q0 | (q1 << 16); s1 = q2 | (q3 << 16); ro[0] = s0; ro[1] = s1; }
            if (last && has_next) S.a_ready(nxt);
            if constexpr (SP2) {
            PG8_LDB(B0, 0, 0); PG8_LDB(B1, 0, 1); PG8_SCHED; PG8_LDA(At, 0, 0); PG8_STAGE_G(PG8_SA(1, 1), k1, c1);
            PG8_WAIT_V(8); PG8_WAIT_L(0); PG8_BAR; PG8_MMA(0, 0, At, B0); PG8_MMA(0, 1, At, B1); PG8_BAR; PG8_SCHED;
            PG8_LDA(At, 0, 1); PG8_STAGE(PG8_SB(0, 0), b2, voffB); PG8_STAGE(PG8_SB(0, 1), b2 + hstep, voffB); PG8_STAGE_G(PG8_SA(0, 0), k2, s0);
            PG8_WAIT_V(8); PG8_WAIT_L(0); PG8_BAR; PG8_MMA(1, 0, At, B0); PG8_MMA(1, 1, At, B1); PG8_BAR; PG8_SCHED;
            PG8_LDB(B0, 1, 0); PG8_LDB(B1, 1, 1); PG8_SCHED; PG8_LDA(At, 1, 0); PG8_STAGE_G(PG8_SA(0, 1), k2, s1);
            PG8_WAIT_V(8); PG8_WAIT_L(0); PG8_BAR; PG8_MMA(0, 0, At, B0); PG8_MMA(0, 1, At, B1); PG8_BAR; PG8_SCHED;
            PG8_LDA(At, 1, 1); PG8_STAGE(PG8_SB(1, 0), b3, voffB); PG8_STAGE(PG8_SB(1, 1), b3 + hstep, voffB); PG8_STAGE_G(PG8_SA(1, 0), k3, s0);
            PG8_WAIT_V(8); PG8_WAIT_L(0); PG8_BAR; PG8_MMA(1, 0, At, B0); PG8_MMA(1, 1, At, B1); PG8_BAR; PG8_SCHED;
            }
        }
        if constexpr (ALIGN_EPI) { if (wr == 0) PG8_BAR; }
        if constexpr (!Epi::AFTER_DRAIN) { E(acc, cur, wr, wc, fr, fq); S.done(cur); }
        if (!has_next) break;
#pragma unroll
        for (int a = 0; a < 2; ++a)
#pragma unroll
            for (int b = 0; b < 2; ++b)
#pragma unroll
                for (int m = 0; m < 4; ++m)
#pragma unroll
                    for (int n = 0; n < 2; ++n) acc[a][b][m][n] = (f32x4){0.f, 0.f, 0.f, 0.f};
        cur = nxt; cB = nB; ++ui;
        if constexpr (ALIGN_EPI) { if (wr == 1) PG8_BAR; }
    }
    PG8_WAIT_V(0);
    if constexpr (!ALIGN_EPI) { if (wr == 0) PG8_BAR; }
    PG8_BAR;
    if constexpr (Epi::AFTER_DRAIN) { E.fused(acc, cur, wr, wc, fr, fq, lds, wid, lane); S.done(cur); }
#undef PG8_SA
#undef PG8_SB
#undef PG8_STAGE
#undef PG8_STAGE_G
#undef PG8_LDA
#undef PG8_LDB
#undef PG8_MMA
#undef PG8_WAIT_V
#undef PG8_WAIT_L
#undef PG8_BAR
#undef PG8_SCHED
}
typedef int v8i_t __attribute__((ext_vector_type(8)));
template <class Epi, class Sched, bool ALIGN_EPI = false, bool SP2 = false>
__device__ __forceinline__ void gemm_phase8(PG8_LAS unsigned char* lds, const Gemm g, const Sched& S, const Epi& E, const int wave_in) {
    unsigned z_ = 0u; asm volatile("" : "+v"(z_)); const int tid_ = (int)__builtin_amdgcn_mbcnt_hi(~0u, __builtin_amdgcn_mbcnt_lo(~0u, z_)) + 64 * wave_in;
    const int tid = tid_, wid = __builtin_amdgcn_readfirstlane(tid >> 6), lane = tid & 63, wr = wid >> 2, wc = wid & 3, fr = lane & 15, fq = lane >> 4;
    const int K = g.K, nt = K / (2 * BK);
    unsigned voffA[2], voffB[2];
#pragma unroll
    for (int i = 0; i < 2; ++i) { int R, C; stage_rc(tid * 16 + i * 8192, R, C); const int Rb = Epi::PERM ? ((R & ~31) + perm32(R & 31)) : R;
        voffA[i] = (unsigned)(R * K + C * 2); voffB[i] = (unsigned)(Rb * K + C * 2); }
    const size_t kstep = (size_t)(BK * 2);
    const size_t hstep = (size_t)HALF * K;
    const size_t tstep = 2 * hstep;
    const unsigned ldsw = (unsigned)wid * 1024u;
    const int aoff = lds_byte(wr * 64 + fr, fq * 16), boff = lds_byte(wc * 32 + fr, fq * 16);
#define PG8_SA(b, h) (((b) * 2 + (h)) * HTB)
#define PG8_SB(b, h) ((4 + (b) * 2 + (h)) * HTB)
#define PG8_STAGE(bufoff, gbase, voff) do { _Pragma("unroll") for (int _i = 0; _i < 2; ++_i) \
        __builtin_amdgcn_global_load_lds((const unsigned*)((const char*)(gbase) + (voff)[_i]), (PG8_LAS unsigned*)(lds + (bufoff) + ldsw + _i * 8192), 16, 0, 0); } while (0)
#define PG8_LDA(dst, b, h) do { _Pragma("unroll") for (int m = 0; m < 4; ++m) { const PG8_LAS u32x4* p_ = (const PG8_LAS u32x4*)(lds + PG8_SA(b, h) + aoff + m * 2048); const u32x4 lo_ = p_[0], hi_ = p_[1]; dst[m] = (v8i_t){(int)lo_.x, (int)lo_.y, (int)lo_.z, (int)lo_.w, (int)hi_.x, (int)hi_.y, (int)hi_.z, (int)hi_.w}; } } while (0)
#define PG8_LDB(dst, b, h) do { _Pragma("unroll") for (int n = 0; n < 2; ++n) { const PG8_LAS u32x4* p_ = (const PG8_LAS u32x4*)(lds + PG8_SB(b, h) + boff + n * 2048); const u32x4 lo_ = p_[0], hi_ = p_[1]; dst[n] = (v8i_t){(int)lo_.x, (int)lo_.y, (int)lo_.z, (int)lo_.w, (int)hi_.x, (int)hi_.y, (int)hi_.z, (int)hi_.w}; } } while (0)
#define PG8_MMA(ai, bj, At, Bt) do { __builtin_amdgcn_s_setprio(1); _Pragma("unroll") for (int m = 0; m < 4; ++m) _Pragma("unroll") for (int n = 0; n < 2; ++n) \
        asm volatile("v_mfma_f32_16x16x128_f8f6f4 %0, %1, %2, %0" : "+v"(acc[ai][bj][m][n]) : "v"(Bt[n]), "v"(At[m])); __builtin_amdgcn_s_setprio(0); } while (0)
#define PG8_WAIT_V(n) asm volatile("s_waitcnt vmcnt(" #n ")" ::: "memory")
#define PG8_WAIT_L(n) asm volatile("s_waitcnt lgkmcnt(" #n ")" ::: "memory")
#define PG8_BAR __builtin_amdgcn_s_barrier()
#define PG8_SCHED __builtin_amdgcn_sched_barrier(0)
    Unit cur, nxt; int ui = 0;
    if (!S.next(0, cur)) return;
    f32x4 acc[2][2][4][2];
#pragma unroll
    for (int a = 0; a < 2; ++a)
#pragma unroll
        for (int b = 0; b < 2; ++b)
#pragma unroll
            for (int m = 0; m < 4; ++m)
#pragma unroll
                for (int n = 0; n < 2; ++n) acc[a][b][m][n] = (f32x4){0.f, 0.f, 0.f, 0.f};
    v8i_t At[4], B0[2], B1[2];
    const char* cA = (const char*)g.A + (size_t)cur.pm * tstep; const char* cB = (const char*)g.Bt + (size_t)cur.pn * tstep;
    S.a_ready(cur);
    if constexpr (SP2) {
        PG8_STAGE(PG8_SB(0, 0), cB, voffB); PG8_STAGE(PG8_SB(0, 1), cB + hstep, voffB); PG8_STAGE(PG8_SA(0, 0), cA, voffA); PG8_STAGE(PG8_SA(0, 1), cA + hstep, voffA);
        if (wr == 1) PG8_BAR;
        PG8_WAIT_V(2); PG8_BAR;
        PG8_STAGE(PG8_SB(1, 0), cB + kstep, voffB); PG8_STAGE(PG8_SA(1, 0), cA + kstep, voffA); PG8_STAGE(PG8_SB(1, 1), cB + hstep + kstep, voffB);
        PG8_WAIT_V(6); PG8_BAR;
    } else {
        PG8_STAGE(PG8_SB(0, 0), cB, voffB); PG8_STAGE(PG8_SA(0, 0), cA, voffA); PG8_STAGE(PG8_SB(0, 1), cB + hstep, voffB); PG8_STAGE(PG8_SA(0, 1), cA + hstep, voffA);
        if (wr == 1) PG8_BAR;
        PG8_WAIT_V(4); PG8_BAR;
        PG8_STAGE(PG8_SB(1, 0), cB + kstep, voffB); PG8_STAGE(PG8_SA(1, 0), cA + kstep, voffA); PG8_STAGE(PG8_SB(1, 1), cB + hstep + kstep, voffB);
        PG8_WAIT_V(6); PG8_BAR;
    }
    for (;;) {
        const bool has_next = S.next(ui + 1, nxt);
        const char* nA = has_next ? (const char*)g.A + (size_t)nxt.pm * tstep : cA; const char* nB = has_next ? (const char*)g.Bt + (size_t)nxt.pn * tstep : cB;
#pragma nounroll
        for (int t = 0; t < nt; t += 2) {
            const bool last = (t == nt - 2);
            const char* a1 = cA + (size_t)(t + 1) * kstep;
            const char* a2 = last ? nA : cA + (size_t)(t + 2) * kstep; const char* b2 = last ? nB : cB + (size_t)(t + 2) * kstep;
            const char* a3 = a2 + kstep; const char* b3 = b2 + kstep;
            if (last && has_next) S.a_ready(nxt);
            if constexpr (SP2) {
            PG8_LDB(B0, 0, 0); PG8_LDB(B1, 0, 1); PG8_SCHED; PG8_LDA(At, 0, 0); PG8_STAGE(PG8_SA(1, 1), a1 + hstep, voffA);
            PG8_WAIT_V(8); PG8_WAIT_L(0); PG8_BAR; PG8_MMA(0, 0, At, B0); PG8_MMA(0, 1, At, B1); PG8_BAR; PG8_SCHED;
            PG8_LDA(At, 0, 1); PG8_STAGE(PG8_SB(0, 0), b2, voffB); PG8_STAGE(PG8_SB(0, 1), b2 + hstep, voffB); PG8_STAGE(PG8_SA(0, 0), a2, voffA);
            PG8_WAIT_V(8); PG8_WAIT_L(0); PG8_BAR; PG8_MMA(1, 0, At, B0); PG8_MMA(1, 1, At, B1); PG8_BAR; PG8_SCHED;
            PG8_LDB(B0, 1, 0); PG8_LDB(B1, 1, 1); PG8_SCHED; PG8_LDA(At, 1, 0); PG8_STAGE(PG8_SA(0, 1), a2 + hstep, voffA);
            PG8_WAIT_V(8); PG8_WAIT_L(0); PG8_BAR; PG8_MMA(0, 0, At, B0); PG8_MMA(0, 1, At, B1); PG8_BAR; PG8_SCHED;
            PG8_LDA(At, 1, 1); PG8_STAGE(PG8_SB(1, 0), b3, voffB); PG8_STAGE(PG8_SB(1, 1), b3 + hstep, voffB); PG8_STAGE(PG8_SA(1, 0), a3, voffA);
            PG8_WAIT_V(8); PG8_WAIT_L(0); PG8_BAR; PG8_MMA(1, 0, At, B0); PG8_MMA(1, 1, At, B1); PG8_BAR; PG8_SCHED;
            } else {
            PG8_LDB(B0, 0, 0); PG8_SCHED; PG8_LDA(At, 0, 0); PG8_STAGE(PG8_SA(1, 1), a1 + hstep, voffA);
            PG8_WAIT_L(8); PG8_BAR; PG8_WAIT_L(0); PG8_MMA(0, 0, At, B0); PG8_BAR; PG8_SCHED;
            PG8_LDB(B1, 0, 1); PG8_STAGE(PG8_SB(0, 0), b2, voffB);
            PG8_BAR; PG8_WAIT_L(0); PG8_MMA(0, 1, At, B1); PG8_BAR;
            PG8_LDA(At, 0, 1); PG8_STAGE(PG8_SA(0, 0), a2, voffA);
            PG8_BAR; PG8_WAIT_L(0); PG8_MMA(1, 0, At, B0); PG8_BAR; PG8_SCHED;
            PG8_STAGE(PG8_SB(0, 1), b2 + hstep, voffB);
            PG8_WAIT_V(6); PG8_BAR; PG8_MMA(1, 1, At, B1); PG8_BAR;
            PG8_LDB(B0, 1, 0); PG8_SCHED; PG8_LDA(At, 1, 0); PG8_STAGE(PG8_SA(0, 1), a2 + hstep, voffA);
            PG8_WAIT_L(8); PG8_BAR; PG8_WAIT_L(0); PG8_MMA(0, 0, At, B0); PG8_BAR; PG8_SCHED;
            PG8_LDB(B1, 1, 1); PG8_STAGE(PG8_SB(1, 0), b3, voffB);
            PG8_BAR; PG8_WAIT_L(0); PG8_MMA(0, 1, At, B1); PG8_BAR;
            PG8_LDA(At, 1, 1); PG8_STAGE(PG8_SA(1, 0), a3, voffA);
            PG8_BAR; PG8_WAIT_L(0); PG8_MMA(1, 0, At, B0); PG8_BAR; PG8_SCHED;
            PG8_STAGE(PG8_SB(1, 1), b3 + hstep, voffB);
            PG8_WAIT_V(6); PG8_BAR; PG8_MMA(1, 1, At, B1); PG8_BAR;
            }
        }
        asm volatile("s_nop 15\n\ts_nop 15" ::: "memory");
        if constexpr (ALIGN_EPI) { if (wr == 0) PG8_BAR; }
        if constexpr (!Epi::AFTER_DRAIN) { E(acc, cur, wr, wc, fr, fq); S.done(cur); }
        if (!has_next) break;
#pragma unroll
        for (int a = 0; a < 2; ++a)
#pragma unroll
            for (int b = 0; b < 2; ++b)
#pragma unroll
                for (int m = 0; m < 4; ++m)
#pragma unroll
                    for (int n = 0; n < 2; ++n) acc[a][b][m][n] = (f32x4){0.f, 0.f, 0.f, 0.f};
        cur = nxt; cA = nA; cB = nB; ++ui;
        if constexpr (ALIGN_EPI) { if (wr == 1) PG8_BAR; }
    }
    PG8_WAIT_V(0);
    if constexpr (!ALIGN_EPI) { if (wr == 0) PG8_BAR; }
    PG8_BAR;
    if constexpr (Epi::AFTER_DRAIN) { E.fused(acc, cur, wr, wc, fr, fq, lds, wid, lane); S.done(cur); }
#undef PG8_SA
#undef PG8_SB
#undef PG8_STAGE
#undef PG8_LDA
#undef PG8_LDB
#undef PG8_MMA
#undef PG8_WAIT_V
#undef PG8_WAIT_L
#undef PG8_BAR
#undef PG8_SCHED
}
template <class Epi, class Sched>
__device__ __forceinline__ void gemm_phase_gather8(PG8_LAS unsigned char* lds, const Gemm g, const Sched& S, const Epi& E, const int wave_in) {
    unsigned z_ = 0u; asm volatile("" : "+v"(z_)); const int tid_ = (int)__builtin_amdgcn_mbcnt_hi(~0u, __builtin_amdgcn_mbcnt_lo(~0u, z_)) + 64 * wave_in;
    const int tid = tid_, wid = __builtin_amdgcn_readfirstlane(tid >> 6), lane = tid & 63, wr = wid >> 2, wc = wid & 3, fr = lane & 15, fq = lane >> 4;
    constexpr bool ALIGN_EPI = true, SP2 = true;
    const int K = g.K, nt = K / (2 * BK);
    unsigned voffB[2]; int RA0; unsigned CA0;
#pragma unroll
    for (int i = 0; i < 2; ++i) { int R, C; stage_rc(tid * 16 + i * 8192, R, C); const int Rb = Epi::PERM ? ((R & ~31) + perm32(R & 31)) : R;
        if (i == 0) { RA0 = R; CA0 = (unsigned)C * 2u; } voffB[i] = (unsigned)(Rb * K + C * 2); }
    unsigned ro[2], rn[2][2];
    const size_t kstep = (size_t)(BK * 2);
    const size_t hstep = (size_t)HALF * K;
    const size_t tstep = 2 * hstep;
    const unsigned ldsw = (unsigned)wid * 1024u;
    const int aoff = lds_byte(wr * 64 + fr, fq * 16), boff = lds_byte(wc * 32 + fr, fq * 16);
#define PG8_SA(b, h) (((b) * 2 + (h)) * HTB)
#define PG8_SB(b, h) ((4 + (b) * 2 + (h)) * HTB)
#define PG8_STAGE(bufoff, gbase, voff) do { _Pragma("unroll") for (int _i = 0; _i < 2; ++_i) \
        __builtin_amdgcn_global_load_lds((const unsigned*)((const char*)(gbase) + (voff)[_i]), (PG8_LAS unsigned*)(lds + (bufoff) + ldsw + _i * 8192), 16, 0, 0); } while (0)
#define PG8_STAGE_G(bufoff, kbyte, pk) do { _Pragma("unroll") for (int _i = 0; _i < 2; ++_i) { const unsigned _row = _i ? ((pk) >> 16) : ((pk) & 0xffffu); \
        __builtin_amdgcn_global_load_lds((const unsigned*)((const char*)g.A + (kbyte) + (_row * (unsigned)K + CA0)), (PG8_LAS unsigned*)(lds + (bufoff) + ldsw + _i * 8192), 16, 0, 0); } } while (0)
#define PG8_LDA(dst, b, h) do { _Pragma("unroll") for (int m = 0; m < 4; ++m) { const PG8_LAS u32x4* p_ = (const PG8_LAS u32x4*)(lds + PG8_SA(b, h) + aoff + m * 2048); const u32x4 lo_ = p_[0], hi_ = p_[1]; dst[m] = (v8i_t){(int)lo_.x, (int)lo_.y, (int)lo_.z, (int)lo_.w, (int)hi_.x, (int)hi_.y, (int)hi_.z, (int)hi_.w}; } } while (0)
#define PG8_LDB(dst, b, h) do { _Pragma("unroll") for (int n = 0; n < 2; ++n) { const PG8_LAS u32x4* p_ = (const PG8_LAS u32x4*)(lds + PG8_SB(b, h) + boff + n * 2048); const u32x4 lo_ = p_[0], hi_ = p_[1]; dst[n] = (v8i_t){(int)lo_.x, (int)lo_.y, (int)lo_.z, (int)lo_.w, (int)hi_.x, (int)hi_.y, (int)hi_.z, (int)hi_.w}; } } while (0)
#define PG8_MMA(ai, bj, At, Bt) do { __builtin_amdgcn_s_setprio(1); _Pragma("unroll") for (int m = 0; m < 4; ++m) _Pragma("unroll") for (int n = 0; n < 2; ++n) \
        asm volatile("v_mfma_f32_16x16x128_f8f6f4 %0, %1, %2, %0" : "+v"(acc[ai][bj][m][n]) : "v"(Bt[n]), "v"(At[m])); __builtin_amdgcn_s_setprio(0); } while (0)
#define PG8_WAIT_V(n) asm volatile("s_waitcnt vmcnt(" #n ")" ::: "memory")
#define PG8_WAIT_L(n) asm volatile("s_waitcnt lgkmcnt(" #n ")" ::: "memory")
#define PG8_BAR __builtin_amdgcn_s_barrier()
#define PG8_SCHED __builtin_amdgcn_sched_barrier(0)
    Unit cur, nxt; int ui = 0;
    if (!S.next(0, cur)) return;
    f32x4 acc[2][2][4][2];
#pragma unroll
    for (int a = 0; a < 2; ++a)
#pragma unroll
        for (int b = 0; b < 2; ++b)
#pragma unroll
            for (int m = 0; m < 4; ++m)
#pragma unroll
                for (int n = 0; n < 2; ++n) acc[a][b][m][n] = (f32x4){0.f, 0.f, 0.f, 0.f};
    v8i_t At[4], B0[2], B1[2];
    const char* cB = (const char*)g.Bt + (size_t)cur.pn * tstep;
    S.a_ready(cur);
    S.rows(cur, RA0, rn); ro[0] = rn[0][0] | (rn[0][1] << 16); ro[1] = rn[1][0] | (rn[1][1] << 16);
    if constexpr (SP2) {
        PG8_STAGE(PG8_SB(0, 0), cB, voffB); PG8_STAGE(PG8_SB(0, 1), cB + hstep, voffB); PG8_STAGE_G(PG8_SA(0, 0), 0, ro[0]); PG8_STAGE_G(PG8_SA(0, 1), 0, ro[1]);
        if (wr == 1) PG8_BAR;
        PG8_WAIT_V(2); PG8_BAR;
        PG8_STAGE(PG8_SB(1, 0), cB + kstep, voffB); PG8_STAGE_G(PG8_SA(1, 0), kstep, ro[0]); PG8_STAGE(PG8_SB(1, 1), cB + hstep + kstep, voffB);
        PG8_WAIT_V(6); PG8_BAR;
    }
    for (;;) {
        const bool has_next = S.next(ui + 1, nxt);
        const char* nB = has_next ? (const char*)g.Bt + (size_t)nxt.pn * tstep : cB;
#pragma nounroll
        for (int t = 0; t < nt; t += 2) {
            const bool last = (t == nt - 2);
            const size_t k1 = (size_t)(t + 1) * kstep, k2 = last ? (size_t)0 : (size_t)(t + 2) * kstep, k3 = k2 + kstep;
            const char* b2 = last ? nB : cB + (size_t)(t + 2) * kstep; const char* b3 = b2 + kstep;
            if (t == nt - 4 && has_next) S.rows(nxt, RA0, rn);
            const unsigned c1 = ro[1];
            unsigned s0 = ro[0], s1 = ro[1];
            if (last && has_next) { unsigned q0 = rn[0][0], q1 = rn[0][1], q2 = rn[1][0], q3 = rn[1][1]; asm volatile("" : "+v"(q0), "+v"(q1), "+v"(q2), "+v"(q3));
                s0 = q0 | (q1 << 16); s1 = q2 | (q3 << 16); ro[0] = s0; ro[1] = s1; }
            if (last && has_next) S.a_ready(nxt);
            if constexpr (SP2) {
            PG8_LDB(B0, 0, 0); PG8_LDB(B1, 0, 1); PG8_SCHED; PG8_LDA(At, 0, 0); PG8_STAGE_G(PG8_SA(1, 1), k1, c1);
            PG8_WAIT_V(8); PG8_WAIT_L(0); PG8_BAR; PG8_MMA(0, 0, At, B0); PG8_MMA(0, 1, At, B1); PG8_BAR; PG8_SCHED;
            PG8_LDA(At, 0, 1); PG8_STAGE(PG8_SB(0, 0), b2, voffB); PG8_STAGE(PG8_SB(0, 1), b2 + hstep, voffB); PG8_STAGE_G(PG8_SA(0, 0), k2, s0);
            PG8_WAIT_V(8); PG8_WAIT_L(0); PG8_BAR; PG8_MMA(1, 0, At, B0); PG8_MMA(1, 1, At, B1); PG8_BAR; PG8_SCHED;
            PG8_LDB(B0, 1, 0); PG8_LDB(B1, 1, 1); PG8_SCHED; PG8_LDA(At, 1, 0); PG8_STAGE_G(PG8_SA(0, 1), k2, s1);
            PG8_WAIT_V(8); PG8_WAIT_L(0); PG8_BAR; PG8_MMA(0, 0, At, B0); PG8_MMA(0, 1, At, B1); PG8_BAR; PG8_SCHED;
            PG8_LDA(At, 1, 1); PG8_STAGE(PG8_SB(1, 0), b3, voffB); PG8_STAGE(PG8_SB(1, 1), b3 + hstep, voffB); PG8_STAGE_G(PG8_SA(1, 0), k3, s0);
            PG8_WAIT_V(8); PG8_WAIT_L(0); PG8_BAR; PG8_MMA(1, 0, At, B0); PG8_MMA(1, 1, At, B1); PG8_BAR; PG8_SCHED;
            }
        }
        asm volatile("s_nop 15\n\ts_nop 15" ::: "memory");
        if constexpr (ALIGN_EPI) { if (wr == 0) PG8_BAR; }
        if constexpr (!Epi::AFTER_DRAIN) { E(acc, cur, wr, wc, fr, fq); S.done(cur); }
        if (!has_next) break;
#pragma unroll
        for (int a = 0; a < 2; ++a)
#pragma unroll
            for (int b = 0; b < 2; ++b)
#pragma unroll
                for (int m = 0; m < 4; ++m)
#pragma unroll
                    for (int n = 0; n < 2; ++n) acc[a][b][m][n] = (f32x4){0.f, 0.f, 0.f, 0.f};
        cur = nxt; cB = nB; ++ui;
        if constexpr (ALIGN_EPI) { if (wr == 1) PG8_BAR; }
    }
    PG8_WAIT_V(0);
    if constexpr (!ALIGN_EPI) { if (wr == 0) PG8_BAR; }
    PG8_BAR;
    if constexpr (Epi::AFTER_DRAIN) { E.fused(acc, cur, wr, wc, fr, fq, lds, wid, lane); S.done(cur); }
#undef PG8_SA
#undef PG8_SB
#undef PG8_STAGE
#undef PG8_STAGE_G
#undef PG8_LDA
#undef PG8_LDB
#undef PG8_MMA
#undef PG8_WAIT_V
#undef PG8_WAIT_L
#undef PG8_BAR
#undef PG8_SCHED
}
}

#ifndef PG8_SP2
#define PG8_SP2 true
#endif
#ifndef PG8_ALIGN
#define PG8_ALIGN true
#endif

constexpr int NTOK = 65536, DM = 1024, NCOL = 7680, SEQ = 4096, NBATCH = 16, HTOK = 32768, MEMLEN = 256;
constexpr int C_HQ = 0, C_HF = 1024, C_HI = 2048, C_HG = 3072, C_SQ = 4096, C_SK = 5120, C_SV = 5376, C_GA = 5632, C_GB = 6656;
constexpr size_t PJ_HQ = 0, PJ_HF = 64 * ((size_t)1 << 20), PJ_HI = 128 * ((size_t)1 << 20), PJ_HG = 192 * ((size_t)1 << 20), PJ_SQ = 256 * ((size_t)1 << 20), PJ_SK = 320 * ((size_t)1 << 20), PJ_SV = 336 * ((size_t)1 << 20), PJ_GA = 352 * ((size_t)1 << 20), PJ_GB = 416 * ((size_t)1 << 20);
constexpr int NEXP = 32, TOPK = 4, CAPH = HTOK * TOPK + NEXP * 256;
constexpr float RMS_EPS = 1e-5f;
constexpr size_t MiB = (size_t)1 << 20;
constexpr size_t WS_ZERO_BYTES = 2 * MiB;
constexpr size_t WS_GCNT = 1 * MiB;
constexpr int CW_TMO = 0, CW_BAR = 4096;
constexpr size_t WS_LB = 2 * MiB, WS_LUT = 2 * MiB + 4096, WS_BLKE = 2 * MiB + 16384, WS_NBT = 2 * MiB + 32768;
constexpr size_t WS_TOPE = 3 * MiB, WS_TOPG = 4 * MiB, WS_TOPR = 5 * MiB, WS_TOPP = 6 * MiB, WS_RGATE = 7 * MiB, WS_RRSTD = 8 * MiB, WS_D12 = 10 * MiB;
constexpr size_t WS_WIN = 16 * MiB, WS_WA = 31 * MiB, WS_WB = 33 * MiB, WS_WMIX = 35 * MiB, WS_WQ = 37 * MiB, WS_WK = 39 * MiB, WS_WV = 41 * MiB, WS_WO = 43 * MiB, WS_WR = 45 * MiB;
constexpr size_t WS_MEMBF = 46 * MiB, WS_KX = 54 * MiB, WS_VXT = 62 * MiB;
constexpr size_t WS_XBF = 72 * MiB;
constexpr size_t WS_PROJ = 200 * MiB, WS_OA = 680 * MiB, WS_OB = 744 * MiB, WS_TM = 808 * MiB;
constexpr size_t WS_Q = 664 * MiB, WS_O = 792 * MiB;
constexpr size_t WS_X1F8 = 872 * MiB;
constexpr size_t WS_X2F8 = 296 * MiB;
constexpr size_t WS_WGU = 200 * MiB, WS_WD = 264 * MiB, WS_ACT = 392 * MiB, WS_Y = 664 * MiB, WS_SSQ1 = 936 * MiB, WS_SSQ2 = 940 * MiB, WS_RTOK = 944 * MiB, WS_RGATE2 = 952 * MiB, WS_RRSTD2 = 960 * MiB, WS_END = 968 * MiB;
constexpr size_t OUT_US = 128 * MiB;

#define GAS __attribute__((address_space(1)))
#define LAS __attribute__((address_space(3)))
typedef unsigned short bf16;
typedef unsigned v4u __attribute__((ext_vector_type(4)));
typedef unsigned v2u __attribute__((ext_vector_type(2)));
typedef float f32x4 __attribute__((ext_vector_type(4)));
typedef short bf16x8 __attribute__((ext_vector_type(8)));
typedef short s16x4 __attribute__((ext_vector_type(4)));
#define RLX_AGENT __ATOMIC_RELAXED, __HIP_MEMORY_SCOPE_AGENT
#define LDS_WAIT() asm volatile("s_waitcnt lgkmcnt(0)" ::: "memory")
#define CFENCE() asm volatile("" ::: "memory")
__device__ __forceinline__ unsigned f2bf(float f) { unsigned u = __builtin_bit_cast(unsigned, f); return (u + 0x7fffu + ((u >> 16) & 1u)) >> 16; }
typedef float f32x2_t __attribute__((ext_vector_type(2))); typedef __bf16 bf16x2_t __attribute__((ext_vector_type(2)));
__device__ __forceinline__ unsigned pk2(float lo, float hi) { f32x2_t v = {lo, hi}; bf16x2_t b = __builtin_convertvector(v, bf16x2_t); return __builtin_bit_cast(unsigned, b); }
__device__ __forceinline__ unsigned pk4f8(float a, float b, float c, float d) { int r = 0; r = __builtin_amdgcn_cvt_pk_fp8_f32(a, b, r, false); r = __builtin_amdgcn_cvt_pk_fp8_f32(c, d, r, true); return (unsigned)r; }
constexpr float F8_WSCALE = 64.f, F8_WINV = 1.f / 64.f;
__device__ __forceinline__ float bflo(unsigned w) { return __builtin_bit_cast(float, w << 16); }
__device__ __forceinline__ float bfhi(unsigned w) { return __builtin_bit_cast(float, w & 0xffff0000u); }
__device__ __forceinline__ float fexp(float x) { return __builtin_amdgcn_exp2f(x * 1.4426950408889634f); }
__device__ __forceinline__ float flog(float x) { return __builtin_amdgcn_logf(x) * 0.6931471805599453f; }
__device__ __forceinline__ float sigm(float x) { return __builtin_amdgcn_rcpf(1.f + fexp(-x)); }
__device__ __forceinline__ float shx(float v, int mask, int lane) { return __builtin_bit_cast(float, __builtin_amdgcn_ds_bpermute((lane ^ mask) << 2, __builtin_bit_cast(int, v))); }
__device__ __forceinline__ float wave_sum(float v, int lane) {
#pragma unroll
    for (int o = 1; o < 64; o <<= 1) v += shx(v, o, lane);
    return v;
}
__device__ __forceinline__ f32x4 mfma16(bf16x8 a, bf16x8 b, f32x4 c) { return __builtin_amdgcn_mfma_f32_16x16x32_bf16(a, b, c, 0, 0, 0); }
__device__ __forceinline__ s16x4 vtr(const LAS unsigned char* p) { return __builtin_bit_cast(s16x4, __builtin_amdgcn_ds_read_tr16_b64_v4i16((LAS s16x4*)p)); }
__device__ __forceinline__ bf16x8 cat8(s16x4 lo, s16x4 hi) { return __builtin_shufflevector(lo, hi, 0, 1, 2, 3, 4, 5, 6, 7); }
__device__ __forceinline__ bf16x8 pack8(f32x4 a, f32x4 b) { v4u w; w.x = pk2(a[0], a[1]); w.y = pk2(a[2], a[3]); w.z = pk2(b[0], b[1]); w.w = pk2(b[2], b[3]); return __builtin_bit_cast(bf16x8, w); }
__device__ __forceinline__ float rstd16(const float* ssqp, size_t row) { const f32x4* p = (const f32x4*)(ssqp + row * 16); const f32x4 a = p[0], b = p[1], c = p[2], d = p[3];
    const float s = ((a[0] + a[1]) + (a[2] + a[3])) + ((b[0] + b[1]) + (b[2] + b[3])) + ((c[0] + c[1]) + (c[2] + c[3])) + ((d[0] + d[1]) + (d[2] + d[3])); return rsqrtf(s * (1.f / 1024.f) + 1e-5f); }
__device__ __forceinline__ unsigned ld_agent(const unsigned* p) { return __hip_atomic_load(p, RLX_AGENT); }


#define XB_TMO      128
#define XB_XCNT(j)  (256  + 64 * (j))
#define XB_XSUB(j)  (1280 + 64 * (j))
#define XB_XGEN(j)  (2304 + 64 * (j))
#define XB_TOP      3328
#define XB_TOPGEN   3392
#define XCD_BAR_WORDS 3456
#define XB_SPIN_CAP (1u << 18)

__device__ __forceinline__ unsigned xb_ld(unsigned* p)              { return __hip_atomic_load(p, __ATOMIC_RELAXED, __HIP_MEMORY_SCOPE_AGENT); }
__device__ __forceinline__ unsigned xb_add(unsigned* p, unsigned v) { return __hip_atomic_fetch_add(p, v, __ATOMIC_RELAXED, __HIP_MEMORY_SCOPE_AGENT); }
__device__ __forceinline__ unsigned xb_xcc_id() { return (unsigned)__builtin_amdgcn_s_getreg((3 << 11) | 20) & 0xFu; }
#define XB_SPIN(cond, bar) do { unsigned _sp = 0; while (cond) { __builtin_amdgcn_s_sleep(1); \
    if ((++_sp & 255u) == 0u) { if (xb_ld(&(bar)[XB_TMO])) break; if (_sp > XB_SPIN_CAP) { atomicAdd(&(bar)[XB_TMO], 1u); break; } } } } while (0)

struct XcdBarrier {
    unsigned* bar; unsigned x; int t0;
    volatile LAS unsigned* st;
};

__device__ __forceinline__ bool xb_is_t0(int wave) { return wave == 0 && __builtin_amdgcn_mbcnt_hi(~0u, __builtin_amdgcn_mbcnt_lo(~0u, 0u)) == 0u; }
__device__ __forceinline__ XcdBarrier xcd_barrier_post(unsigned* bar, volatile LAS unsigned* st, int wave) {
    XcdBarrier b; b.bar = bar; b.x = xb_xcc_id(); b.st = st; b.t0 = wave;
    if (xb_is_t0(wave)) (void)xb_add(&bar[XB_XCNT(b.x)], 1u);
    return b;
}
__device__ __forceinline__ void xcd_barrier_complete(unsigned* bar, unsigned x, unsigned& nloc, unsigned& nx) {
    const unsigned G = gridDim.x * gridDim.y * gridDim.z;
    unsigned sum, cnt, mine, sp = 0u;
    for (;;) {
        sum = 0u; cnt = 0u; mine = 0u;
#pragma unroll
        for (unsigned j = 0; j < 16; ++j) { const unsigned c = xb_ld(&bar[XB_XCNT(j)]); sum += c; cnt += (c > 0u) ? 1u : 0u; mine = (j == x) ? c : mine; }
        if (sum == G) break;
        __builtin_amdgcn_s_sleep(1);
        if ((++sp & 255u) == 0u) { if (xb_ld(&bar[XB_TMO])) break; if (sp > XB_SPIN_CAP) { atomicAdd(&bar[XB_TMO], 1u); break; } }
    }
    nloc = mine > 0u ? mine : 1u; nx = cnt > 0u ? cnt : 1u;
}

__device__ __forceinline__ void xcd_barrier(const XcdBarrier& b) {
    asm volatile("s_waitcnt vmcnt(0)" ::: "memory");
    __syncthreads();
    if (xb_is_t0(b.t0)) {
        unsigned* bar = b.bar;
        __builtin_amdgcn_s_waitcnt(0);
        unsigned nloc = b.st[0], nx = b.st[1];
        if (nloc == 0u) { xcd_barrier_complete(bar, b.x, nloc, nx); b.st[0] = nloc; b.st[1] = nx; }
        const unsigned old = xb_add(&bar[XB_XSUB(b.x)], 1u);
        const unsigned gen = old / nloc;
        if (old + 1u == (gen + 1u) * nloc) {
            __builtin_amdgcn_fence(__ATOMIC_RELEASE, "agent");
            asm volatile("s_waitcnt vmcnt(0)" ::: "memory");
            const unsigned og = xb_add(&bar[XB_TOP], 1u);
            const unsigned tg = og / nx;
            if (og + 1u == (tg + 1u) * nx) xb_add(&bar[XB_TOPGEN], 1u);
            else XB_SPIN(xb_ld(&bar[XB_TOPGEN]) == tg, bar);
            __builtin_amdgcn_fence(__ATOMIC_ACQUIRE, "agent");
            xb_add(&bar[XB_XGEN(b.x)], 1u);
            asm volatile("s_waitcnt vmcnt(0)" ::: "memory");
        } else {
            XB_SPIN(xb_ld(&bar[XB_XGEN(b.x)]) == gen, bar);
            __builtin_amdgcn_fence(__ATOMIC_ACQUIRE, "agent");
            asm volatile("s_waitcnt vmcnt(0)" ::: "memory");
        }
    }
    __syncthreads();
}

struct Args {
    const float* in[25];
    float* out; unsigned char* ws;
    int ph_lo, ph_hi;
};

using pg8::Unit;
struct EpiStore {
    static constexpr bool PERM = true, AFTER_DRAIN = false;
    bf16* O; int ldc; const float* ssq; float scl;
    __device__ __forceinline__ void operator()(const f32x4 (&acc)[2][2][4][2], const Unit& u, int wr, int wc, int fr, int fq) const {
        const int row0 = u.pm * 256 + wr * 64 + fr, col0 = u.pn * 256 + wc * 32 + 8 * fq;
#pragma unroll
        for (int ai = 0; ai < 2; ++ai) { float sc[4];
#pragma unroll
            for (int m = 0; m < 4; ++m) sc[m] = (ssq ? rstd16(ssq, (size_t)(row0 + ai * 128 + m * 16)) : 1.f) * scl;
#pragma unroll
            for (int m = 0; m < 4; ++m) { const int row = row0 + ai * 128 + m * 16; bf16* rowp = O + (size_t)row * ldc + col0;
#pragma unroll
                for (int bj = 0; bj < 2; ++bj) { const f32x4 v0 = acc[ai][bj][m][0] * sc[m], v1 = acc[ai][bj][m][1] * sc[m];
                    v4u w; w.x = pk2(v0[0], v0[1]); w.y = pk2(v0[2], v0[3]); w.z = pk2(v1[0], v1[1]); w.w = pk2(v1[2], v1[3]);
                    __builtin_nontemporal_store(w, (v4u*)(rowp + bj * 128)); } } }
    }
};
struct EpiProj {
    static constexpr bool PERM = true, AFTER_DRAIN = false;
    unsigned char* pj; const float* lb;
    __device__ __forceinline__ void operator()(const f32x4 (&acc)[2][2][4][2], const Unit& u, int wr, int wc, int fr, int fq) const {
        const int row0 = u.pm * 256 + wr * 64 + fr, pn = u.pn;
        bf16* base[2]; unsigned rowmul, blmul;
        if (pn < 16) { const int T = pn >> 2; rowmul = 256u; blmul = 8u * 4096u * 256u;
#pragma unroll
            for (int bj = 0; bj < 2; ++bj) base[bj] = (bf16*)(pj + (size_t)T * (64u << 20) + (size_t)(2 * (pn & 3) + bj) * (4096u * 256u)) + wc * 32 + 8 * fq; }
        else if (pn < 20) { rowmul = 128u; blmul = 16u * 4096u * 128u;
#pragma unroll
            for (int bj = 0; bj < 2; ++bj) base[bj] = (bf16*)(pj + PJ_SQ + (size_t)(4 * (pn - 16) + 2 * bj + (wc >> 1)) * (4096u * 128u)) + (wc & 1) * 32 + 8 * fq; }
        else if (pn < 22) { rowmul = 128u; blmul = 4u * 4096u * 128u;
#pragma unroll
            for (int bj = 0; bj < 2; ++bj) base[bj] = (bf16*)(pj + (pn == 20 ? PJ_SK : PJ_SV) + (size_t)(2 * bj + (wc >> 1)) * (4096u * 128u)) + (wc & 1) * 32 + 8 * fq; }
        else { rowmul = 2048u; blmul = 4096u * 2048u;
#pragma unroll
            for (int bj = 0; bj < 2; ++bj) base[bj] = (bf16*)(pj + (pn < 26 ? PJ_GA : PJ_GB)) + ((pn - 22) & 3) * 256 + bj * 128 + wc * 32 + 8 * fq; }
        const int kind = pn < 16 ? (pn >> 2) : 2;
        f32x4 lbv[2][2];
        if (kind == 1) {
#pragma unroll
            for (int bj = 0; bj < 2; ++bj)
#pragma unroll
                for (int n = 0; n < 2; ++n) lbv[bj][n] = *(const f32x4*)(lb + (2 * (pn & 3) + bj) * 128 + wc * 32 + 8 * fq + 4 * n); }
#pragma unroll
        for (int ai = 0; ai < 2; ++ai)
#pragma unroll
            for (int m = 0; m < 4; ++m) { const int row = row0 + ai * 128 + m * 16; const size_t ro = (size_t)(row >> 12) * blmul + (size_t)(row & 4095) * rowmul;
#pragma unroll
                for (int bj = 0; bj < 2; ++bj) { f32x4 v[2] = {acc[ai][bj][m][0], acc[ai][bj][m][1]};
                    if (kind == 0 || kind == 3) {
#pragma unroll
                        for (int n = 0; n < 2; ++n)
#pragma unroll
                            for (int j = 0; j < 4; ++j) v[n][j] = v[n][j] * sigm(v[n][j]); }
                    else if (kind == 1) {
#pragma unroll
                        for (int n = 0; n < 2; ++n)
#pragma unroll
                            for (int j = 0; j < 4; ++j) v[n][j] = lbv[bj][n][j] + (1.f - lbv[bj][n][j]) * sigm(v[n][j]); }
                    v4u w; w.x = pk2(v[0][0], v[0][1]); w.y = pk2(v[0][2], v[0][3]); w.z = pk2(v[1][0], v[1][1]); w.w = pk2(v[1][2], v[1][3]);
                    __builtin_nontemporal_store(w, (v4u*)((unsigned char*)base[bj] + ro)); } }
    }
};
template <bool ADD> struct EpiGate {
    static constexpr bool PERM = true, AFTER_DRAIN = false;
    bf16* T; const bf16* gl; const float* bias;
    __device__ __forceinline__ void operator()(const f32x4 (&acc)[2][2][4][2], const Unit& u, int wr, int wc, int fr, int fq) const {
        const int row0 = u.pm * 256 + wr * 64 + fr, col0 = u.pn * 256 + wc * 32 + 8 * fq;
        f32x4 bv[2][2];
#pragma unroll
        for (int bj = 0; bj < 2; ++bj)
#pragma unroll
            for (int n = 0; n < 2; ++n) bv[bj][n] = *(const f32x4*)(bias + col0 + bj * 128 + 4 * n);
#pragma unroll
        for (int am = 0; am < 4; ++am) { const int ai = am >> 1, mh = am & 1; v4u gw[2][2], tw[2][2];
#pragma unroll
            for (int mm = 0; mm < 2; ++mm)
#pragma unroll
                for (int bj = 0; bj < 2; ++bj) { const int row = row0 + ai * 128 + (2 * mh + mm) * 16; gw[mm][bj] = *(const v4u*)(gl + (size_t)row * DM + col0 + bj * 128);
                    if (ADD) tw[mm][bj] = *(const v4u*)(T + (size_t)row * DM + col0 + bj * 128); }
#pragma unroll
            for (int mm = 0; mm < 2; ++mm)
#pragma unroll
                for (int bj = 0; bj < 2; ++bj) { const int m = 2 * mh + mm; const int row = row0 + ai * 128 + m * 16; const v4u g4 = gw[mm][bj]; float r[8];
                    r[0] = sigm(bflo(g4.x) + bv[bj][0][0]) * acc[ai][bj][m][0][0]; r[1] = sigm(bfhi(g4.x) + bv[bj][0][1]) * acc[ai][bj][m][0][1];
                    r[2] = sigm(bflo(g4.y) + bv[bj][0][2]) * acc[ai][bj][m][0][2]; r[3] = sigm(bfhi(g4.y) + bv[bj][0][3]) * acc[ai][bj][m][0][3];
                    r[4] = sigm(bflo(g4.z) + bv[bj][1][0]) * acc[ai][bj][m][1][0]; r[5] = sigm(bfhi(g4.z) + bv[bj][1][1]) * acc[ai][bj][m][1][1];
                    r[6] = sigm(bflo(g4.w) + bv[bj][1][2]) * acc[ai][bj][m][1][2]; r[7] = sigm(bfhi(g4.w) + bv[bj][1][3]) * acc[ai][bj][m][1][3];
                    if (ADD) { const v4u t4 = tw[mm][bj];
                        r[0] += bflo(t4.x); r[1] += bfhi(t4.x); r[2] += bflo(t4.y); r[3] += bfhi(t4.y); r[4] += bflo(t4.z); r[5] += bfhi(t4.z); r[6] += bflo(t4.w); r[7] += bfhi(t4.w); }
                    v4u w; w.x = pk2(r[0], r[1]); w.y = pk2(r[2], r[3]); w.z = pk2(r[4], r[5]); w.w = pk2(r[6], r[7]);
                    *(v4u*)(T + (size_t)row * DM + col0 + bj * 128) = w; } }
    }
};
template <bool BF> struct EpiResid {
    static constexpr bool PERM = true, AFTER_DRAIN = false;
    const float* base; bf16* obf; float* ssq; unsigned char* f8; float scl;
    __device__ __forceinline__ void operator()(const f32x4 (&acc)[2][2][4][2], const Unit& u, int wr, int wc, int fr, int fq) const {
        const int row0 = u.pm * 256 + wr * 64 + fr, col0 = u.pn * 256 + wc * 32 + 8 * fq;
#pragma unroll
        for (int ai = 0; ai < 2; ++ai)
#pragma unroll
            for (int mh = 0; mh < 2; ++mh) { f32x4 b0[2][2], b1[2][2];
#pragma unroll
                for (int mm = 0; mm < 2; ++mm)
#pragma unroll
                    for (int bj = 0; bj < 2; ++bj) { const size_t off = (size_t)(row0 + ai * 128 + (2 * mh + mm) * 16) * DM + col0 + bj * 128;
                        if (BF) { const v4u bw = *(const v4u*)(obf + off); b0[mm][bj] = (f32x4){bflo(bw.x), bfhi(bw.x), bflo(bw.y), bfhi(bw.y)}; b1[mm][bj] = (f32x4){bflo(bw.z), bfhi(bw.z), bflo(bw.w), bfhi(bw.w)}; }
                        else { b0[mm][bj] = *(const f32x4*)(base + off); b1[mm][bj] = *(const f32x4*)(base + off + 4); } }
#pragma unroll
                for (int mm = 0; mm < 2; ++mm) { const int m = 2 * mh + mm; const int row = row0 + ai * 128 + m * 16; float ss = 0.f;
#pragma unroll
                    for (int bj = 0; bj < 2; ++bj) { const size_t off = (size_t)row * DM + col0 + bj * 128;
                        const f32x4 v0 = b0[mm][bj] + acc[ai][bj][m][0] * scl, v1 = b1[mm][bj] + acc[ai][bj][m][1] * scl;
                        v4u w; w.x = pk2(v0[0], v0[1]); w.y = pk2(v0[2], v0[3]); w.z = pk2(v1[0], v1[1]); w.w = pk2(v1[2], v1[3]);
                        *(v4u*)(obf + off) = w;
                        if (f8) { v2u q; q.x = pk4f8(v0[0], v0[1], v0[2], v0[3]); q.y = pk4f8(v1[0], v1[1], v1[2], v1[3]); *(v2u*)(f8 + off) = q; }
                        ss += ((v0[0] * v0[0] + v0[1] * v0[1]) + (v0[2] * v0[2] + v0[3] * v0[3])) + ((v1[0] * v1[0] + v1[1] * v1[1]) + (v1[2] * v1[2] + v1[3] * v1[3])); }
                    { const int ln_ = fr + 16 * fq; ss += shx(ss, 16, ln_); ss += shx(ss, 32, ln_); }
                    if (fq == 0) ssq[(size_t)row * 16 + (u.pn & 3) * 4 + wc] = ss; } }
    }
};
struct EpiSwiglu {
    static constexpr bool PERM = true, AFTER_DRAIN = false;
    unsigned char* act; const float* bgu; const float* row_rstd;
    __device__ __forceinline__ void operator()(const f32x4 (&acc)[2][2][4][2], const Unit& u, int wr, int wc, int fr, int fq) const {
        const int e = u.pn >> 3, pnl = u.pn & 7;
        const int rr0 = wr * 64 + fr, cl0 = pnl * 128 + wc * 32 + 8 * fq;
        f32x4 bg[2], bl[2]; float rs[2][4];
#pragma unroll
        for (int n = 0; n < 2; ++n) { bg[n] = *(const f32x4*)(bgu + e * 2048 + cl0 + 4 * n); bl[n] = *(const f32x4*)(bgu + e * 2048 + 1024 + cl0 + 4 * n); }
#pragma unroll
        for (int ai = 0; ai < 2; ++ai)
#pragma unroll
            for (int m = 0; m < 4; ++m) rs[ai][m] = row_rstd[u.aux + rr0 + ai * 128 + m * 16] * F8_WINV;
#pragma unroll
        for (int ai = 0; ai < 2; ++ai)
#pragma unroll
            for (int m = 0; m < 4; ++m) { const int row = u.pm * 256 + rr0 + ai * 128 + m * 16;
                float r[8];
#pragma unroll
                for (int n = 0; n < 2; ++n)
#pragma unroll
                    for (int j = 0; j < 4; ++j) { float gl = acc[ai][0][m][n][j] * rs[ai][m] + bg[n][j], li = acc[ai][1][m][n][j] * rs[ai][m] + bl[n][j];
                        gl = fminf(gl, 7.0f); li = fminf(fmaxf(li, -7.0f), 7.0f);
                        r[n * 4 + j] = gl * sigm(1.702f * gl) * (li + 1.0f); }
                v2u w; w.x = pk4f8(r[0], r[1], r[2], r[3]); w.y = pk4f8(r[4], r[5], r[6], r[7]);
                __builtin_nontemporal_store(w, (v2u*)(act + (size_t)row * DM + cl0)); }
    }
};
struct EpiDown {
    static constexpr bool PERM = true, AFTER_DRAIN = false;
    bf16* y; const float* bd; const float* row_gate;
    __device__ __forceinline__ void operator()(const f32x4 (&acc)[2][2][4][2], const Unit& u, int wr, int wc, int fr, int fq) const {
        const int e = u.pn >> 2, pnl = u.pn & 3;
        const int rr0 = wr * 64 + fr, col0 = pnl * 256 + wc * 32 + 8 * fq;
        f32x4 bv[2][2]; float gt[2][4];
#pragma unroll
        for (int bj = 0; bj < 2; ++bj)
#pragma unroll
            for (int n = 0; n < 2; ++n) bv[bj][n] = *(const f32x4*)(bd + e * 1024 + col0 + bj * 128 + 4 * n);
#pragma unroll
        for (int ai = 0; ai < 2; ++ai)
#pragma unroll
            for (int m = 0; m < 4; ++m) gt[ai][m] = row_gate[u.aux + rr0 + ai * 128 + m * 16];
#pragma unroll
        for (int ai = 0; ai < 2; ++ai)
#pragma unroll
            for (int m = 0; m < 4; ++m) { const int row = u.pm * 256 + rr0 + ai * 128 + m * 16;
#pragma unroll
                for (int bj = 0; bj < 2; ++bj) { const f32x4 v0 = (acc[ai][bj][m][0] * F8_WINV + bv[bj][0]) * gt[ai][m], v1 = (acc[ai][bj][m][1] * F8_WINV + bv[bj][1]) * gt[ai][m];
                    v4u w; w.x = pk2(v0[0], v0[1]); w.y = pk2(v0[2], v0[3]); w.z = pk2(v1[0], v1[1]); w.w = pk2(v1[2], v1[3]);
                    __builtin_nontemporal_store(w, (v4u*)(y + (size_t)row * DM + col0 + bj * 128)); } }
    }
};
struct GroupedOrder {
    int nunits, npn, G, c, half; const LAS unsigned* tab; const int* row_tok;
    __device__ __forceinline__ bool next(int i, Unit& u) const {
        const long L = (long)i * G + c; if (L >= nunits) return false;
        const int rb = (int)(L / npn), pn = (int)(L % npn);
        int e = 0;
#pragma unroll 4
        for (int k = 1; k < 32; ++k) e = (rb >= (int)tab[32 + k]) ? k : e;
        e = __builtin_amdgcn_readfirstlane(e);
        const int j = rb - (int)__builtin_amdgcn_readfirstlane(tab[32 + e]), cn = (int)__builtin_amdgcn_readfirstlane(tab[e]) - 256 * j;
        u.pm = rb; u.pn = e * npn + pn; u.aux = (half * 32 + e) * HTOK + 256 * j; u.cnt = cn < 256 ? cn : 256; return true;
    }
    __device__ __forceinline__ void rows(const Unit& u, int RA0, unsigned (&rn)[2][2]) const {
#pragma unroll
        for (int h = 0; h < 2; ++h) { const int r0 = h * 128 + RA0, r1 = r0 + 64, cm = u.cnt - 1;
            rn[h][0] = (unsigned)row_tok[u.aux + (r0 < cm ? r0 : cm)]; rn[h][1] = (unsigned)row_tok[u.aux + (r1 < cm ? r1 : cm)]; }
    }
    __device__ __forceinline__ void a_ready(const Unit&) const {}
    __device__ __forceinline__ void done(const Unit&) const {}
};
constexpr int MOE_TAB_OFF = 131072 + 1024;
__device__ __forceinline__ void moe_tables(const unsigned char* ws, int hb, LAS unsigned char* lds, int tid) {
    LAS unsigned* tab = (LAS unsigned*)(lds + MOE_TAB_OFF); const unsigned* gcnt = (const unsigned*)(ws + WS_GCNT);
    __syncthreads();
    if (tid < 32) tab[tid] = ld_agent(gcnt + (hb * 32 + tid) * 16);
    __syncthreads();
    if (tid == 0) { unsigned acc = 0; for (int e = 0; e < 32; ++e) { tab[32 + e] = acc; acc += (tab[e] + 255u) >> 8; } tab[64] = acc; }
    __syncthreads();
}

constexpr int RING_BYTES = 131072, MISC_OFF = RING_BYTES + 320, LDS_BYTES = 147456;

struct Ctx { LAS unsigned char* lds; int tid, lane, wave, G, gw, ngw; };

struct TItem { f32x4 v[8]; float gv[8]; };
__device__ __forceinline__ void titem_load(TItem& t, const float* W, int N, const float* gain, int k0, int n0, int lane) {
#pragma unroll
    for (int i = 0; i < 8; ++i) { const int kk = 8 * i + (lane >> 3); t.v[i] = *(const f32x4*)(W + (size_t)(k0 + kk) * N + n0 + (lane & 7) * 4); t.gv[i] = gain ? gain[k0 + kk] : 1.f; }
}
__device__ __forceinline__ void titem_to_lds(const TItem& t, LAS float* scr, int lane) {
#pragma unroll
    for (int i = 0; i < 8; ++i) { const int kk = 8 * i + (lane >> 3); LAS float* p = scr + kk * 33 + (lane & 7) * 4;
        p[0] = t.v[i][0] * t.gv[i]; p[1] = t.v[i][1] * t.gv[i]; p[2] = t.v[i][2] * t.gv[i]; p[3] = t.v[i][3] * t.gv[i]; }
    LDS_WAIT();
}
template <class RowMap>
__device__ __forceinline__ void titem_out(int K, bf16* WT, const LAS float* scr, int k0, int n0, int lane, RowMap rm) {
    const int c = lane & 7;
#pragma unroll
    for (int j = 0; j < 4; ++j) { const int n = (lane >> 3) + 8 * j; const LAS float* s = scr + (8 * c) * 33 + n;
        v4u o; o.x = pk2(s[0 * 33], s[1 * 33]); o.y = pk2(s[2 * 33], s[3 * 33]); o.z = pk2(s[4 * 33], s[5 * 33]); o.w = pk2(s[6 * 33], s[7 * 33]);
        *(v4u*)(WT + (size_t)rm(n0 + n) * K + k0 + 8 * c) = o; }
    LDS_WAIT();
}
template <class RowMap>
__device__ __forceinline__ void titem_out8(int K, unsigned char* WT, const LAS float* scr, int k0, int n0, int lane, RowMap rm) {
    const int c = lane & 7;
#pragma unroll
    for (int j = 0; j < 4; ++j) { const int n = (lane >> 3) + 8 * j; const LAS float* s = scr + (8 * c) * 33 + n;
        v2u o; o.x = pk4f8(s[0 * 33] * F8_WSCALE, s[1 * 33] * F8_WSCALE, s[2 * 33] * F8_WSCALE, s[3 * 33] * F8_WSCALE); o.y = pk4f8(s[4 * 33] * F8_WSCALE, s[5 * 33] * F8_WSCALE, s[6 * 33] * F8_WSCALE, s[7 * 33] * F8_WSCALE);
        *(v2u*)(WT + (size_t)rm(n0 + n) * K + k0 + 8 * c) = o; }
    LDS_WAIT();
}
template <class RowMap>
__device__ __forceinline__ void transpose_item(const float* W, int K, int N, bf16* WT, const float* gain, LAS float* scr, int item, int lane, RowMap rm) {
    const int nblk = N / 32, kb = item / nblk, nb = item % nblk, k0 = 64 * kb, n0 = 32 * nb;
    TItem t; titem_load(t, W, N, gain, k0, n0, lane); titem_to_lds(t, scr, lane); titem_out(K, WT, scr, k0, n0, lane, rm);
}
template <class RowMap>
__device__ __forceinline__ void transpose_item8(const float* W, int K, int N, unsigned char* WT, const float* gain, LAS float* scr, int item, int lane, RowMap rm) {
    const int nblk = N / 32, kb = item / nblk, nb = item % nblk, k0 = 64 * kb, n0 = 32 * nb;
    TItem t; titem_load(t, W, N, gain, k0, n0, lane); titem_to_lds(t, scr, lane); titem_out8(K, WT, scr, k0, n0, lane, rm);
}
struct RowId { int off; __device__ __forceinline__ int operator()(int n) const { return off + n; } };
struct RowGU { int e; __device__ __forceinline__ int operator()(int n) const { const int j = n & 1023; return e * 2048 + (j >> 7) * 256 + (n >> 10) * 128 + (j & 127); } };

__device__ __forceinline__ void rms_row_to_bf16(const float* xrow, const float* gain, bf16* orow, int lane) {
    const f32x4* xr = (const f32x4*)xrow + lane; const f32x4* gr = (const f32x4*)gain + lane;
    f32x4 v[4]; float s = 0.f;
#pragma unroll
    for (int j = 0; j < 4; ++j) { v[j] = xr[64 * j]; s += (v[j][0] * v[j][0] + v[j][1] * v[j][1]) + (v[j][2] * v[j][2] + v[j][3] * v[j][3]); }
    const float rstd = rsqrtf(wave_sum(s, lane) * (1.f / DM) + RMS_EPS);
    unsigned long long* o8 = (unsigned long long*)orow + lane;
#pragma unroll
    for (int j = 0; j < 4; ++j) { const f32x4 g = gr[64 * j]; const f32x4 w = v[j] * rstd * g;
        o8[64 * j] = (unsigned long long)pk2(w[0], w[1]) | ((unsigned long long)pk2(w[2], w[3]) << 32); }
}

__device__ __forceinline__ void phase_prologue(const Args& a, const Ctx& c) {
    LAS float* scr = (LAS float*)(c.lds + c.wave * 16384);
    unsigned char* ws = a.ws;
    constexpr int I_IN = 16 * (NCOL / 32), I_SQ = 16 * 32, I_R = 16;
    constexpr int NIT = I_IN + 7 * I_SQ + I_R;
    for (int it = c.gw; it < NIT; it += c.ngw) {
        int r = it;
        if (r < I_IN) { transpose_item(a.in[5], DM, NCOL, (bf16*)(ws + WS_WIN), nullptr, scr, r, c.lane, RowId{0}); continue; } r -= I_IN;
        if (r < I_SQ) { transpose_item(a.in[9], DM, DM, (bf16*)(ws + WS_WA), nullptr, scr, r, c.lane, RowId{0}); continue; } r -= I_SQ;
        if (r < I_SQ) { transpose_item(a.in[10], DM, DM, (bf16*)(ws + WS_WB), nullptr, scr, r, c.lane, RowId{0}); continue; } r -= I_SQ;
        if (r < I_SQ) { transpose_item(a.in[11], DM, DM, (bf16*)(ws + WS_WMIX), nullptr, scr, r, c.lane, RowId{0}); continue; } r -= I_SQ;
        if (r < I_SQ) { transpose_item8(a.in[13], DM, DM, ws + WS_WQ, a.in[12], scr, r, c.lane, RowId{0}); continue; } r -= I_SQ;
        if (r < I_SQ) { transpose_item(a.in[14], DM, DM, (bf16*)(ws + WS_WK), nullptr, scr, r, c.lane, RowId{0}); continue; } r -= I_SQ;
        if (r < I_SQ) { transpose_item(a.in[15], DM, DM, (bf16*)(ws + WS_WV), nullptr, scr, r, c.lane, RowId{0}); continue; } r -= I_SQ;
        if (r < I_SQ) { transpose_item8(a.in[16], DM, DM, ws + WS_WO, nullptr, scr, r, c.lane, RowId{0}); continue; } r -= I_SQ;
        transpose_item(a.in[18], DM, NEXP, (bf16*)(ws + WS_WR), a.in[17], scr, r, c.lane, RowId{0});
    }
    { const size_t n8 = (size_t)NBATCH * MEMLEN * DM / 8; const float* mem = a.in[1]; bf16* mb = (bf16*)(ws + WS_MEMBF);
      for (size_t i = (size_t)c.gw * 64 + c.lane; i < n8; i += (size_t)c.ngw * 64) { const f32x4 v0 = *(const f32x4*)(mem + i * 8), v1 = *(const f32x4*)(mem + i * 8 + 4);
          v4u w; w.x = pk2(v0[0], v0[1]); w.y = pk2(v0[2], v0[3]); w.z = pk2(v1[0], v1[1]); w.w = pk2(v1[2], v1[3]); *(v4u*)(mb + i * 8) = w; } }
    if (c.gw == 0) {
        float* lb = (float*)(ws + WS_LB); const float* lbl = a.in[3];
        for (int k = c.lane; k < 1024; k += 64) lb[k] = 1.f / (1.f + expf(lbl[1024 + k] - lbl[k]));
    }
    if (c.gw == 1) {
        float* lut = (float*)(ws + WS_LUT); const float* t5 = a.in[2];
        for (int i = c.lane; i < 16 * 128; i += 64) { const int h = i >> 7, d = i & 127; int b = d;
            if (d >= 16) { b = 16 + (int)(logf((float)d * (1.f / 16.f)) / logf(8.f) * 16.f); b = b < 31 ? b : 31; }
            lut[i] = t5[b * 16 + h]; }
    }
}

__device__ __forceinline__ void phase_norm1(const Args& a, const Ctx& c, int hb) {
    const float* x = a.in[0] + (size_t)hb * HTOK * DM; bf16* xn = (bf16*)(a.ws + WS_TM);
    for (int m = c.gw; m < HTOK; m += c.ngw) rms_row_to_bf16(x + (size_t)m * DM, a.in[4], xn + (size_t)m * DM, c.lane);
}

constexpr int SWA_VB = 32 * 144;
constexpr int SWA_LUT_OFF = 8 * 2 * SWA_VB;
__device__ __forceinline__ void swa_unit(const bf16* proj, bf16* ob, int bl, int kvh, int tt, const LAS float* lut, LAS unsigned char* vbuf, const float* sinks, int lane) {
    const int l15 = lane & 15, g = lane >> 4, q4 = l15 >> 2, p4 = lane & 3;
    const int t0 = tt * 16; const size_t rowb = (size_t)bl * SEQ;
    const bf16* sq = (const bf16*)((const unsigned char*)proj + PJ_SQ) + (size_t)(bl * 16 + kvh * 4) * SEQ * 64;
    const bf16* sk = (const bf16*)((const unsigned char*)proj + PJ_SK) + (size_t)(bl * 4 + kvh) * SEQ * 64;
    const bf16* sv = (const bf16*)((const unsigned char*)proj + PJ_SV) + (size_t)(bl * 4 + kvh) * SEQ * 64;
    bf16x8 qf[4][2];
#pragma unroll
    for (int gq = 0; gq < 4; ++gq)
#pragma unroll
        for (int ks = 0; ks < 2; ++ks) qf[gq][ks] = *(const bf16x8*)(sq + ((size_t)gq * SEQ + t0 + l15) * 64 + ks * 32 + 8 * g);
    float mx[4], ls[4]; f32x4 o[4][4];
#pragma unroll
    for (int gq = 0; gq < 4; ++gq) { mx[gq] = sinks[kvh * 4 + gq]; ls[gq] = 1.f;
#pragma unroll
        for (int dt = 0; dt < 4; ++dt) o[gq][dt] = (f32x4){0.f, 0.f, 0.f, 0.f}; }
    for (int c = 0; c < 5; ++c) {
        const int kc = t0 - 144 + 32 * c;
        if (kc + 31 < 0) continue;
        LAS unsigned char* vb = vbuf + (c & 1) * SWA_VB;
#pragma unroll
        for (int i = 0; i < 4; ++i) { const int p = lane + 64 * i, key = p >> 3, d8 = p & 7; int kr = kc + key; kr = kr < 0 ? 0 : kr;
            const v4u vv = *(const v4u*)(sv + (size_t)kr * 64 + d8 * 8);
            *(LAS v4u*)(vb + key * 144 + d8 * 16) = vv; }
        f32x4 s[4][2];
#pragma unroll
        for (int ksub = 0; ksub < 2; ++ksub) { int kr = kc + 16 * ksub + l15; kr = kr < 0 ? 0 : kr;
            const bf16* kp = sk + (size_t)kr * 64 + 8 * g;
            const bf16x8 k0 = *(const bf16x8*)kp, k1 = *(const bf16x8*)(kp + 32);
#pragma unroll
            for (int gq = 0; gq < 4; ++gq) { f32x4 z = (f32x4){0.f, 0.f, 0.f, 0.f}; z = mfma16(k0, qf[gq][0], z); s[gq][ksub] = mfma16(k1, qf[gq][1], z); } }
        bf16x8 pf[4];
#pragma unroll
        for (int gq = 0; gq < 4; ++gq) { const int hq = kvh * 4 + gq; float cm = -1e30f;
#pragma unroll
            for (int ksub = 0; ksub < 2; ++ksub)
#pragma unroll
                for (int r = 0; r < 4; ++r) { const int key = kc + 16 * ksub + 4 * g + r, dist = t0 + l15 - key; const bool ok = (dist >= 0) && (dist < 128) && (key >= 0);
                    const int di = dist < 0 ? 0 : (dist > 127 ? 127 : dist);
                    float v = s[gq][ksub][r] * 0.125f + lut[hq * 128 + di]; v = ok ? v : -1e30f; s[gq][ksub][r] = v; cm = fmaxf(cm, v); }
            cm = fmaxf(cm, shx(cm, 16, lane)); cm = fmaxf(cm, shx(cm, 32, lane));
            const float mn = fmaxf(mx[gq], cm), alpha = fexp(mx[gq] - mn); mx[gq] = mn; float rs = 0.f;
#pragma unroll
            for (int ksub = 0; ksub < 2; ++ksub)
#pragma unroll
                for (int r = 0; r < 4; ++r) { const float p = fexp(s[gq][ksub][r] - mn); s[gq][ksub][r] = p; rs += p; }
            rs += shx(rs, 16, lane); rs += shx(rs, 32, lane);
            ls[gq] = ls[gq] * alpha + rs;
#pragma unroll
            for (int dt = 0; dt < 4; ++dt) o[gq][dt] = o[gq][dt] * alpha;
            pf[gq] = pack8(s[gq][0], s[gq][1]); }
        CFENCE();
#pragma unroll
        for (int dt = 0; dt < 4; ++dt) {
            const s16x4 lo = vtr(vb + (4 * g + q4) * 144 + (16 * dt + 4 * p4) * 2), hi = vtr(vb + (16 + 4 * g + q4) * 144 + (16 * dt + 4 * p4) * 2);
            const bf16x8 vf = cat8(lo, hi);
#pragma unroll
            for (int gq = 0; gq < 4; ++gq) o[gq][dt] = mfma16(vf, pf[gq], o[gq][dt]); }
        CFENCE();
    }
#pragma unroll
    for (int gq = 0; gq < 4; ++gq) { const float inv = __builtin_amdgcn_rcpf(ls[gq]);
#pragma unroll
        for (int dt = 0; dt < 4; ++dt) { const f32x4 v = o[gq][dt] * inv; v2u w; w.x = pk2(v[0], v[1]); w.y = pk2(v[2], v[3]);
            *(v2u*)(ob + (rowb + t0 + l15) * DM + (kvh * 4 + gq) * 64 + 16 * dt + 4 * g) = w; } }
}
constexpr int HGB_WAVES = 4;
__device__ __forceinline__ void hgB_work(const Args& a, const Ctx& c);
__device__ __forceinline__ void phase_swa_hgB(const Args& a, const Ctx& c) {
    const bf16* proj = (const bf16*)(a.ws + WS_PROJ); bf16* ob = (bf16*)(a.ws + WS_OB);
    LAS float* lut = (LAS float*)(c.lds + SWA_LUT_OFF); const float* glut = (const float*)(a.ws + WS_LUT);
    for (int i = c.tid; i < 16 * 128; i += 512) lut[i] = glut[i];
    __syncthreads();
    if (c.wave < HGB_WAVES) hgB_work(a, c);
    else {
        LAS unsigned char* vbuf = c.lds + c.wave * 2 * SWA_VB;
        constexpr int NU = 8 * 4 * 256;
        const int nsw = c.G * (8 - HGB_WAVES), sw = (int)blockIdx.x * (8 - HGB_WAVES) + (c.wave - HGB_WAVES);
        for (int u = sw; u < NU; u += nsw) { const int tt = u & 255, kvh = (u >> 8) & 3, bl = u >> 10; swa_unit(proj, ob, bl, kvh, tt, lut, vbuf, a.in[8], c.lane); }
    }
    __syncthreads();
}

constexpr int HG_LF = 0, HG_KP = 33792, HG_VT = 51200, HG_GT = 68608, HG_QP = 70656, HG_SSQ = 88064;
__device__ __forceinline__ void hg_scan(LAS unsigned char* lds, int tid, float (&loc)[16], float& pre, float& Gm, float& Gl) {
    const int ch = tid & 127, grp = tid >> 7;
    const LAS float* LF = (const LAS float*)(lds + HG_LF); LAS float* GT = (LAS float*)(lds + HG_GT);
    float run = 0.f;
#pragma unroll
    for (int i = 0; i < 16; ++i) { run += LF[(16 * grp + i) * 132 + ch]; loc[i] = run; }
    GT[grp * 128 + ch] = run;
    __syncthreads();
    const float g0 = GT[ch], g1 = GT[128 + ch], g2 = GT[256 + ch], g3 = GT[384 + ch];
    pre = (grp > 0 ? g0 : 0.f) + (grp > 1 ? g1 : 0.f) + (grp > 2 ? g2 : 0.f);
    Gm = g0 + g1; Gl = Gm + g2 + g3;
}
constexpr size_t OUT_KP = 0, OUT_QP = 64 * MiB;
constexpr int HS_FT = 0, HS_QT = 17408, HS_VT = 34816, HS_GT = 52224, HS_SLOT = 54272;
__device__ __forceinline__ void phase_hgA(const Args& a, const Ctx& c) {
    const bf16* proj = (const bf16*)(a.ws + WS_PROJ); bf16* US = (bf16*)((unsigned char*)a.out + OUT_US); float* D12 = (float*)(a.ws + WS_D12); const float* lb = (const float*)(a.ws + WS_LB);
    bf16* KPg = (bf16*)((unsigned char*)a.out + OUT_KP); bf16* QPg = (bf16*)((unsigned char*)a.out + OUT_QP);
    LAS unsigned char* lds = c.lds; const int tid = c.tid, lane = c.lane, w = c.wave;
    const int l15 = lane & 15, g = lane >> 4, q4 = l15 >> 2, p4 = lane & 3, ch = tid & 127, grp = tid >> 7;
    constexpr int NU = 8 * 8 * 64, NP = NU / 2;
    int pr = blockIdx.x; if (pr >= NP) return;
    v4u rq[2][2], rf[2][2], rv[2][2];
#define HGA_LOAD(pp) do { _Pragma("unroll") for (int s_ = 0; s_ < 2; ++s_) { const size_t uo = (size_t)(2 * (pp) + s_) * 8192;      \
        _Pragma("unroll") for (int i = 0; i < 2; ++i) { const size_t po = uo + (size_t)(tid + 512 * i) * 8; \
            rq[s_][i] = *(const v4u*)((const bf16*)((const unsigned char*)proj + PJ_HQ) + po); rf[s_][i] = *(const v4u*)((const bf16*)((const unsigned char*)proj + PJ_HF) + po); rv[s_][i] = *(const v4u*)((const bf16*)((const unsigned char*)proj + PJ_HI) + po); } } } while (0)
    HGA_LOAD(pr);
    for (;;) {
#pragma unroll
        for (int s = 0; s < 2; ++s)
#pragma unroll
            for (int i = 0; i < 2; ++i) { const int p = tid + 512 * i, tok = p >> 4, c8 = p & 15; LAS unsigned char* sb = lds + s * HS_SLOT + tok * 272 + c8 * 16;
                *(LAS v4u*)(sb + HS_FT) = rf[s][i]; *(LAS v4u*)(sb + HS_QT) = rq[s][i]; *(LAS v4u*)(sb + HS_VT) = rv[s][i]; }
        const int pcur = pr; const int pn = pr + gridDim.x; const bool has_next = pn < NP;
        if (has_next) HGA_LOAD(pn);
        __syncthreads();
        float loc[2][16], kt[2][16];
#pragma unroll
        for (int s = 0; s < 2; ++s) { const LAS bf16* FT = (const LAS bf16*)(lds + s * HS_SLOT + HS_FT);
            float ffv[16];
#pragma unroll
            for (int i = 0; i < 16; ++i) ffv[i] = __builtin_bit_cast(float, (unsigned)FT[(16 * grp + i) * 136 + ch] << 16);
            float run = 0.f;
#pragma unroll
            for (int i = 0; i < 16; ++i) { kt[s][i] = 1.f - ffv[i]; run += flog(ffv[i]); loc[s][i] = run; }
            ((LAS float*)(lds + s * HS_SLOT + HS_GT))[grp * 128 + ch] = run; }
        __syncthreads();
#pragma unroll
        for (int s = 0; s < 2; ++s) { const int ucur = 2 * pcur + s; const LAS float* GT = (const LAS float*)(lds + s * HS_SLOT + HS_GT);
            const float g0 = GT[ch], g1 = GT[128 + ch], g2 = GT[256 + ch], g3 = GT[384 + ch];
            const float pre = (grp > 0 ? g0 : 0.f) + (grp > 1 ? g1 : 0.f) + (grp > 2 ? g2 : 0.f), Gm = g0 + g1, Gl = Gm + g2 + g3;
            LAS bf16* KP = (LAS bf16*)(lds + s * HS_SLOT + HS_FT); LAS bf16* QP = (LAS bf16*)(lds + s * HS_SLOT + HS_QT);
            float qr[16];
#pragma unroll
            for (int i = 0; i < 16; ++i) qr[i] = __builtin_bit_cast(float, (unsigned)QP[(16 * grp + i) * 136 + ch] << 16);
#pragma unroll
            for (int i = 0; i < 16; ++i) { const float G = pre + loc[s][i];
                const float ed = fexp(fminf(Gm - G, 80.f));
                KP[(16 * grp + i) * 136 + ch] = (bf16)pk2(kt[s][i] * ed, 0.f);
                QP[(16 * grp + i) * 136 + ch] = (bf16)pk2(qr[i] * __builtin_amdgcn_rcpf(ed), 0.f); }
            if (grp == 0) { D12[(size_t)ucur * 256 + ch] = fexp(Gm); D12[(size_t)ucur * 256 + 128 + ch] = fexp(Gl - Gm); } }
        __syncthreads();
#pragma unroll
        for (int s = 0; s < 2; ++s) { const int ucur = 2 * pcur + s; const int cc = ucur & 63, h = (ucur >> 6) & 7, bl = ucur >> 9; const size_t row0 = (size_t)bl * SEQ + cc * 64;
            const LAS unsigned char* sl = lds + s * HS_SLOT;
#pragma unroll
            for (int i = 0; i < 2; ++i) { const int p = tid + 512 * i, tok = p >> 4, c8 = p & 15; const size_t go = (size_t)ucur * 8192 + (size_t)p * 8;
                *(v4u*)(KPg + go) = *(const LAS v4u*)(sl + HS_FT + tok * 272 + c8 * 16); *(v4u*)(QPg + go) = *(const LAS v4u*)(sl + HS_QT + tok * 272 + c8 * 16); }
            bf16x8 af[2];
#pragma unroll
            for (int ks = 0; ks < 2; ++ks) { const LAS unsigned char* bp = sl + HS_FT + (32 * ks + 8 * g + q4) * 272 + (16 * w + 4 * p4) * 2; af[ks] = cat8(vtr(bp), vtr(bp + 4 * 272)); }
#pragma unroll
            for (int vt = 0; vt < 8; ++vt) { f32x4 acc = (f32x4){0.f, 0.f, 0.f, 0.f};
#pragma unroll
                for (int ks = 0; ks < 2; ++ks) { const LAS unsigned char* bp = sl + HS_VT + (32 * ks + 8 * g + q4) * 272 + (16 * vt + 4 * p4) * 2; acc = mfma16(af[ks], cat8(vtr(bp), vtr(bp + 4 * 272)), acc); }
                v2u wv; wv.x = pk2(acc[0], acc[1]); wv.y = pk2(acc[2], acc[3]);
                *(v2u*)(US + ((size_t)ucur * 128 + 16 * vt + l15) * 128 + 16 * w + 4 * g) = wv; } }
        __syncthreads();
        if (!has_next) break;
        pr = pn;
    }
#undef HGA_LOAD
}
__device__ __forceinline__ void hgB_work(const Args& a, const Ctx& c) {
    bf16* US = (bf16*)((unsigned char*)a.out + OUT_US); const float* D12 = (const float*)(a.ws + WS_D12);
    const int nthr = c.G * HGB_WAVES * 64, gt = ((int)blockIdx.x * HGB_WAVES + c.wave) * 64 + c.lane;
    for (int e = gt; e < 64 * 2048; e += nthr) {
        const int bh = e >> 11, r = e & 2047, k8 = r & 15;
        float S[8];
#pragma unroll
        for (int j = 0; j < 8; ++j) S[j] = 0.f;
        for (int c0 = 0; c0 < 64; c0 += 8) {
            v4u uw[8];
#pragma unroll
            for (int cc = 0; cc < 8; ++cc) uw[cc] = *(const v4u*)(US + ((size_t)bh * 64 + c0 + cc) * 16384 + (size_t)r * 8);
#pragma unroll
            for (int cc = 0; cc < 8; ++cc) { const size_t un = (size_t)bh * 64 + c0 + cc;
                const f32x4 d1a = *(const f32x4*)(D12 + un * 256 + k8 * 8), d1b = *(const f32x4*)(D12 + un * 256 + k8 * 8 + 4);
                const f32x4 d2a = *(const f32x4*)(D12 + un * 256 + 128 + k8 * 8), d2b = *(const f32x4*)(D12 + un * 256 + 128 + k8 * 8 + 4);
                const unsigned ww[4] = {uw[cc].x, uw[cc].y, uw[cc].z, uw[cc].w}; float sp[8];
#pragma unroll
                for (int j = 0; j < 8; ++j) { const float d1v = j < 4 ? d1a[j & 3] : d1b[j & 3], d2v = j < 4 ? d2a[j & 3] : d2b[j & 3]; const float uv = (j & 1) ? bfhi(ww[j >> 1]) : bflo(ww[j >> 1]);
                    sp[j] = d1v * S[j]; S[j] = d2v * (sp[j] + uv); }
                v4u o; o.x = pk2(sp[0], sp[1]); o.y = pk2(sp[2], sp[3]); o.z = pk2(sp[4], sp[5]); o.w = pk2(sp[6], sp[7]);
                *(v4u*)(US + un * 16384 + (size_t)r * 8) = o; }
        }
    }
}
__device__ __forceinline__ void phase_hgC(const Args& a, const Ctx& c) {
    const bf16* proj = (const bf16*)(a.ws + WS_PROJ); const bf16* US = (const bf16*)((unsigned char*)a.out + OUT_US); bf16* oa = (bf16*)(a.ws + WS_OA);
    const bf16* KPg = (const bf16*)((unsigned char*)a.out + OUT_KP); const bf16* QPg = (const bf16*)((unsigned char*)a.out + OUT_QP);
    const float* hgain = a.in[7];
    LAS unsigned char* lds = c.lds; const int tid = c.tid, lane = c.lane, w = c.wave;
    const int l15 = lane & 15, g = lane >> 4, q4 = l15 >> 2, p4 = lane & 3;
    constexpr int NU = 8 * 8 * 64, NP = NU / 2;
    int pr = blockIdx.x; if (pr >= NP) return;
    v4u rk[2][2], rq[2][2], rv[2][2];
#define HGC_LOAD(pp) do { _Pragma("unroll") for (int s_ = 0; s_ < 2; ++s_) { const size_t uo = (size_t)(2 * (pp) + s_) * 8192; \
        _Pragma("unroll") for (int i = 0; i < 2; ++i) { const size_t po = uo + (size_t)(tid + 512 * i) * 8; \
            rk[s_][i] = *(const v4u*)(KPg + po); rq[s_][i] = *(const v4u*)(QPg + po); rv[s_][i] = *(const v4u*)((const bf16*)((const unsigned char*)proj + PJ_HI) + po); } } } while (0)
    HGC_LOAD(pr);
    const f32x4 gn = *(const f32x4*)(hgain + 16 * w + 4 * g);
    for (;;) {
#pragma unroll
        for (int s = 0; s < 2; ++s)
#pragma unroll
            for (int i = 0; i < 2; ++i) { const int p = tid + 512 * i, tok = p >> 4, c8 = p & 15; LAS unsigned char* sb = lds + s * HS_SLOT + tok * 272 + c8 * 16;
                *(LAS v4u*)(sb + HS_FT) = rk[s][i]; *(LAS v4u*)(sb + HS_QT) = rq[s][i]; *(LAS v4u*)(sb + HS_VT) = rv[s][i]; }
        const int pcur = pr; const int pn = pr + gridDim.x; const bool has_next = pn < NP;
        bf16x8 sf[2][4]; v2u gwv[2][4];
#pragma unroll
        for (int s = 0; s < 2; ++s) { const int ucur = 2 * pcur + s; const int cc = ucur & 63, h = (ucur >> 6) & 7, bl = ucur >> 9; const size_t row0 = (size_t)bl * SEQ + cc * 64;
#pragma unroll
            for (int ks = 0; ks < 4; ++ks) sf[s][ks] = *(const bf16x8*)(US + ((size_t)ucur * 128 + 16 * w + l15) * 128 + 32 * ks + 8 * g);
#pragma unroll
            for (int tt = 0; tt < 4; ++tt) gwv[s][tt] = *(const v2u*)((const bf16*)((const unsigned char*)proj + PJ_HG) + (size_t)ucur * 8192 + (16 * tt + l15) * 128 + 16 * w + 4 * g); }
        if (has_next) HGC_LOAD(pn);
        __syncthreads();
        f32x4 o[2][4];
#pragma unroll
        for (int s = 0; s < 2; ++s) { const LAS unsigned char* sl = lds + s * HS_SLOT;
            bf16x8 vf[2];
#pragma unroll
            for (int kk = 0; kk < 2; ++kk) { const LAS unsigned char* bp = sl + HS_VT + (32 * kk + 4 * g + q4) * 272 + (16 * w + 4 * p4) * 2; vf[kk] = cat8(vtr(bp), vtr(bp + 16 * 272)); }
#pragma unroll
            for (int tt = 0; tt < 4; ++tt) {
                bf16x8 qf[4];
#pragma unroll
                for (int ks = 0; ks < 4; ++ks) qf[ks] = *(const LAS bf16x8*)(sl + HS_QT + (16 * tt + l15) * 272 + (32 * ks + 8 * g) * 2);
                f32x4 acc = (f32x4){0.f, 0.f, 0.f, 0.f};
#pragma unroll
                for (int ks = 0; ks < 4; ++ks) acc = mfma16(sf[s][ks], qf[ks], acc);
                f32x4 at[4];
#pragma unroll
                for (int st = 0; st < 4; ++st) { at[st] = (f32x4){0.f, 0.f, 0.f, 0.f};
                    if (st <= tt) {
#pragma unroll
                        for (int ks = 0; ks < 4; ++ks) { const bf16x8 kf = *(const LAS bf16x8*)(sl + HS_FT + (16 * st + l15) * 272 + (32 * ks + 8 * g) * 2); at[st] = mfma16(kf, qf[ks], at[st]); }
                        if (st == tt) {
#pragma unroll
                            for (int r = 0; r < 4; ++r) at[st][r] = (4 * g + r <= l15) ? at[st][r] : 0.f; } } }
                acc = mfma16(vf[0], pack8(at[0], at[1]), acc);
                if (tt >= 2) acc = mfma16(vf[1], pack8(at[2], at[3]), acc);
                o[s][tt] = acc; }
            LAS float* SSQ = (LAS float*)(lds + s * HS_SLOT + HS_GT);
#pragma unroll
            for (int tt = 0; tt < 4; ++tt) { float q = (o[s][tt][0] * o[s][tt][0] + o[s][tt][1] * o[s][tt][1]) + (o[s][tt][2] * o[s][tt][2] + o[s][tt][3] * o[s][tt][3]);
                q += shx(q, 16, lane); q += shx(q, 32, lane); if (g == 0) SSQ[w * 64 + 16 * tt + l15] = q; } }
        __syncthreads();
#pragma unroll
        for (int s = 0; s < 2; ++s) { const int ucur = 2 * pcur + s; const int cc = ucur & 63, h = (ucur >> 6) & 7, bl = ucur >> 9; const size_t row0 = (size_t)bl * SEQ + cc * 64;
            const LAS float* SSQ = (const LAS float*)(lds + s * HS_SLOT + HS_GT);
#pragma unroll
            for (int tt = 0; tt < 4; ++tt) { float q = 0.f;
#pragma unroll
                for (int ww = 0; ww < 8; ++ww) q += SSQ[ww * 64 + 16 * tt + l15];
                const float rstd = rsqrtf(q * (1.f / 128.f) + RMS_EPS);
                const size_t row = row0 + 16 * tt + l15;
                const v2u gw = gwv[s][tt];
                const float g0 = bflo(gw.x), g1 = bfhi(gw.x), g2 = bflo(gw.y), g3 = bfhi(gw.y);
                const float r0 = o[s][tt][0] * rstd * gn[0] * g0, r1 = o[s][tt][1] * rstd * gn[1] * g1;
                const float r2 = o[s][tt][2] * rstd * gn[2] * g2, r3 = o[s][tt][3] * rstd * gn[3] * g3;
                v2u wv; wv.x = pk2(r0, r1); wv.y = pk2(r2, r3);
                *(v2u*)(oa + row * DM + h * 128 + 16 * w + 4 * g) = wv; } }
        __syncthreads();
        if (!has_next) break;
        pr = pn;
    }
#undef HGC_LOAD
}

typedef float f32x16 __attribute__((ext_vector_type(16)));
constexpr int XA_KROW = 528, XA_VROW = 72, XA_KB = 32 * XA_KROW, XA_VB = 256 * XA_VROW, XA_STAGE = XA_KB + XA_VB;
__device__ __forceinline__ void phase_xa(const Args& a, const Ctx& c) {
    const bf16* qg = (const bf16*)(a.ws + WS_Q); unsigned char* og = a.ws + WS_O;     const bf16* kx = (const bf16*)(a.ws + WS_KX); const bf16* vxt = (const bf16*)(a.ws + WS_VXT);
    LAS unsigned char* lds = c.lds; const int tid = c.tid, lane = c.lane, w = c.wave;
    const int l31 = lane & 31, hh = lane >> 5, qt = w & 3, dh = w >> 2;
    constexpr int NU = NBATCH * 4 * (SEQ / 128);
    int u = blockIdx.x; if (u >= NU) return;
    v4u rk[2], rv[2];
#define XA_LOAD(uu, kc) do { const int b_ = (uu) >> 7, h_ = ((uu) >> 5) & 3; \
        _Pragma("unroll") for (int i = 0; i < 2; ++i) { const int p = tid + 512 * i; \
            rk[i] = *(const v4u*)(kx + (size_t)(b_ * MEMLEN + (kc) * 32 + (p >> 5)) * DM + h_ * 256 + (p & 31) * 8); \
            rv[i] = *(const v4u*)(vxt + (size_t)(h_ * 256 + (p >> 2)) * (NBATCH * MEMLEN) + b_ * MEMLEN + (kc) * 32 + (p & 3) * 8); } } while (0)
#define XA_STORE(buf) do { LAS unsigned char* sb = lds + (buf) * XA_STAGE; \
        _Pragma("unroll") for (int i = 0; i < 2; ++i) { const int p = tid + 512 * i; \
            *(LAS v4u*)(sb + (p >> 5) * XA_KROW + (p & 31) * 16) = rk[i]; \
            LAS v2u* vp = (LAS v2u*)(sb + XA_KB + (p >> 2) * XA_VROW + (p & 3) * 16); v2u lo; lo.x = rv[i].x; lo.y = rv[i].y; v2u hi; hi.x = rv[i].z; hi.y = rv[i].w; vp[0] = lo; vp[1] = hi; } } while (0)
    XA_LOAD(u, 0); XA_STORE(0);
    int par = 0;
    for (;;) {
        const int b = u >> 7, h = (u >> 5) & 3, qb = u & 31;
        const size_t row0 = (size_t)b * SEQ + qb * 128 + qt * 32;
        bf16x8 qf[16];
#pragma unroll
        for (int ks = 0; ks < 16; ++ks) qf[ks] = *(const bf16x8*)(qg + (row0 + l31) * DM + h * 256 + 16 * ks + 8 * hh);
        float mx = -1e30f, ls = 0.f; f32x16 o[4];
#pragma unroll
        for (int dt = 0; dt < 4; ++dt)
#pragma unroll
            for (int r = 0; r < 16; ++r) o[dt][r] = 0.f;
        const int un = u + gridDim.x; const bool has_next = un < NU;
        for (int kc = 0; kc < 8; ++kc) {
            __syncthreads();
            const bool more = (kc < 7) || has_next;
            if (more) { if (kc < 7) XA_LOAD(u, kc + 1); else XA_LOAD(un, 0); }
            const LAS unsigned char* kb = lds + par * XA_STAGE; const LAS unsigned char* vb = kb + XA_KB;
            f32x16 s;
#pragma unroll
            for (int r = 0; r < 16; ++r) s[r] = 0.f;
#pragma unroll
            for (int ks = 0; ks < 16; ++ks) { const bf16x8 kf = *(const LAS bf16x8*)(kb + l31 * XA_KROW + (16 * ks + 8 * hh) * 2); s = __builtin_amdgcn_mfma_f32_32x32x16_bf16(kf, qf[ks], s, 0, 0, 0); }
            float cm = -1e30f;
#pragma unroll
            for (int r = 0; r < 16; ++r) { s[r] *= 0.0625f; cm = fmaxf(cm, s[r]); }
            cm = fmaxf(cm, shx(cm, 32, lane));
            const float mn = fmaxf(mx, cm), alpha = fexp(mx - mn); mx = mn; float rs = 0.f;
#pragma unroll
            for (int r = 0; r < 16; ++r) { s[r] = fexp(s[r] - mn); rs += s[r]; }
            rs += shx(rs, 32, lane); ls = ls * alpha + rs;
#pragma unroll
            for (int dt = 0; dt < 4; ++dt)
#pragma unroll
                for (int r = 0; r < 16; ++r) o[dt][r] *= alpha;
            bf16x8 pf[2];
#pragma unroll
            for (int st = 0; st < 2; ++st) { v4u pw; pw.x = pk2(s[8 * st], s[8 * st + 1]); pw.y = pk2(s[8 * st + 2], s[8 * st + 3]); pw.z = pk2(s[8 * st + 4], s[8 * st + 5]); pw.w = pk2(s[8 * st + 6], s[8 * st + 7]); pf[st] = __builtin_bit_cast(bf16x8, pw); }
#pragma unroll
            for (int dt = 0; dt < 4; ++dt) { const LAS unsigned char* vrow = vb + (128 * dh + 32 * dt + l31) * XA_VROW + 8 * hh;
#pragma unroll
                for (int st = 0; st < 2; ++st) { const s16x4 lo = *(const LAS s16x4*)(vrow + 32 * st), hi = *(const LAS s16x4*)(vrow + 32 * st + 16);
                    o[dt] = __builtin_amdgcn_mfma_f32_32x32x16_bf16(cat8(lo, hi), pf[st], o[dt], 0, 0, 0); } }
            if (more) XA_STORE(par ^ 1);
            par ^= 1;
        }
        const float inv = __builtin_amdgcn_rcpf(ls);
#pragma unroll
        for (int dt = 0; dt < 4; ++dt)
#pragma unroll
            for (int rg = 0; rg < 4; ++rg)
                *(unsigned*)(og + (row0 + l31) * DM + h * 256 + 128 * dh + 32 * dt + 8 * rg + 4 * hh) = pk4f8(o[dt][4 * rg] * inv, o[dt][4 * rg + 1] * inv, o[dt][4 * rg + 2] * inv, o[dt][4 * rg + 3] * inv);
        if (!has_next) break;
        u = un;
    }
    __syncthreads();
#undef XA_LOAD
#undef XA_STORE
}

__device__ __forceinline__ void phase_expert_weights(const Args& a, const Ctx& c) {
    LAS float* scr = (LAS float*)(c.lds + c.wave * 16384);
    constexpr int I_GU = 16 * 64, I_D = 16 * 32;
    constexpr int NGU = NEXP * I_GU, NIT = NEXP * (I_GU + I_D);
#define EW_GEO(it, W_, N_, k0_, n0_) const bool gu_##W_ = (it) < NGU; const int r_##W_ = gu_##W_ ? (it) : (it) - NGU; const int e_##W_ = gu_##W_ ? r_##W_ / I_GU : r_##W_ / I_D; \
        const int q_##W_ = gu_##W_ ? r_##W_ % I_GU : r_##W_ % I_D; const int N_ = gu_##W_ ? 2048 : 1024; const int nblk_##W_ = N_ / 32; const int k0_ = 64 * (q_##W_ / nblk_##W_), n0_ = 32 * (q_##W_ % nblk_##W_); \
        const float* W_ = gu_##W_ ? a.in[20] + (size_t)e_##W_ * DM * 2048 : a.in[22] + (size_t)e_##W_ * DM * DM
    int it = c.gw; if (it >= NIT) { __syncthreads(); return; }
    TItem t;
    { EW_GEO(it, W0, N0, k00, n00); titem_load(t, W0, N0, gu_W0 ? a.in[17] : nullptr, k00, n00, c.lane); }
    for (;;) {
        EW_GEO(it, Wc, Nc, k0c, n0c);
        titem_to_lds(t, scr, c.lane);
        const int itn = it + c.ngw; const bool more = itn < NIT;
        if (more) { EW_GEO(itn, Wn, Nn, k0n, n0n); titem_load(t, Wn, Nn, gu_Wn ? a.in[17] : nullptr, k0n, n0n, c.lane); }
        if (gu_Wc) titem_out8(DM, a.ws + WS_WGU, scr, k0c, n0c, c.lane, RowGU{e_Wc});
        else titem_out8(DM, a.ws + WS_WD, scr, k0c, n0c, c.lane, RowId{e_Wc * 1024});
        if (!more) break;
        it = itn;
    }
#undef EW_GEO
    __syncthreads();
}
__device__ __forceinline__ void phase_router(const Args& a, const Ctx& c) {
    const bf16* xb = (const bf16*)(a.ws + WS_XBF); const bf16* wr = (const bf16*)(a.ws + WS_WR); const float* ssq2 = (const float*)(a.ws + WS_SSQ2); const float* br = a.in[19];
    int* tope = (int*)(a.ws + WS_TOPE); float* topg = (float*)(a.ws + WS_TOPG); int* topr = (int*)(a.ws + WS_TOPR); unsigned* gcnt = (unsigned*)(a.ws + WS_GCNT);
    LAS unsigned char* lds = c.lds; const int lane = c.lane, w = c.wave, l15 = lane & 15, g = lane >> 4;
    LAS float* LG = (LAS float*)(lds + w * 4096);
    LAS int* LE = (LAS int*)(lds + w * 4096 + 2560); LAS float* LGT = (LAS float*)(lds + w * 4096 + 2816);
    int* rtok = (int*)(a.ws + WS_RTOK); float* rgate = (float*)(a.ws + WS_RGATE2); float* rrstd = (float*)(a.ws + WS_RRSTD2);
    LAS unsigned* CNT = (LAS unsigned*)(lds + 32768); LAS unsigned* BASE = CNT + 32;
    for (int it = blockIdx.x; it < NTOK / 128; it += gridDim.x) {
        const int tok0 = it * 128 + w * 16; const int half = tok0 >= HTOK;
        if (c.tid < 32) CNT[c.tid] = 0u;
        f32x4 acc[2] = {(f32x4){0.f, 0.f, 0.f, 0.f}, (f32x4){0.f, 0.f, 0.f, 0.f}};
        const bf16* ap = xb + (size_t)(tok0 + l15) * DM + 8 * g;
#pragma unroll 8
        for (int ks = 0; ks < 32; ++ks) { const bf16x8 af = *(const bf16x8*)(ap + 32 * ks);
#pragma unroll
            for (int nt = 0; nt < 2; ++nt) { const bf16x8 bf = *(const bf16x8*)(wr + (size_t)(16 * nt + l15) * DM + 32 * ks + 8 * g); acc[nt] = mfma16(af, bf, acc[nt]); } }
#pragma unroll
        for (int nt = 0; nt < 2; ++nt)
#pragma unroll
            for (int r = 0; r < 4; ++r) { const int t = 4 * g + r; const float rs = rstd16(ssq2, (size_t)(tok0 + t)); LG[t * 33 + 16 * nt + l15] = acc[nt][r] * rs + br[16 * nt + l15]; }
        LDS_WAIT();
        if (lane < 16) { float v[32];
#pragma unroll
            for (int e = 0; e < 32; ++e) v[e] = LG[lane * 33 + e];
            int se[4]; float sv[4];
#pragma unroll
            for (int k = 0; k < 4; ++k) { float best = -3e38f; int bi = 0;
#pragma unroll
                for (int e = 0; e < 32; ++e) { const bool bt = v[e] > best; best = bt ? v[e] : best; bi = bt ? e : bi; }
                se[k] = bi; sv[k] = best;
#pragma unroll
                for (int e = 0; e < 32; ++e) v[e] = (e == bi) ? -3e38f : v[e]; }
            const float e1 = fexp(sv[1] - sv[0]), e2 = fexp(sv[2] - sv[0]), e3 = fexp(sv[3] - sv[0]); const float inv = 1.f / (1.f + e1 + e2 + e3);
            const int tok = tok0 + lane;
            *(int4*)(tope + (size_t)tok * 4) = make_int4(se[0], se[1], se[2], se[3]);
            *(float4*)(topg + (size_t)tok * 4) = make_float4(inv, e1 * inv, e2 * inv, e3 * inv);
#pragma unroll
            for (int k = 0; k < 4; ++k) LE[lane * 4 + k] = se[k];
            LGT[lane * 4 + 0] = inv; LGT[lane * 4 + 1] = e1 * inv; LGT[lane * 4 + 2] = e2 * inv; LGT[lane * 4 + 3] = e3 * inv; }
        __syncthreads();
        const int myE = LE[lane];
        const unsigned lr = atomicAdd((unsigned*)&CNT[myE], 1u);
        __syncthreads();
        if (c.tid < 32) { const unsigned n = CNT[c.tid]; BASE[c.tid] = n ? atomicAdd(gcnt + (half * 32 + c.tid) * 16, n) : 0u; }
        __syncthreads();
        { const int rank = (int)(BASE[myE] + lr), tok = tok0 + (lane >> 2); topr[(size_t)tok * 4 + (lane & 3)] = rank;
          const size_t ri = (size_t)(half * 32 + myE) * HTOK + rank; rtok[ri] = tok; rgate[ri] = LGT[lane]; rrstd[ri] = rstd16(ssq2, (size_t)tok); }
        __syncthreads();
    }
}
__device__ __forceinline__ void add16(f32x4 (&v)[4], const v4u y0, const v4u y1) {
    v[0][0] += bflo(y0.x); v[0][1] += bfhi(y0.x); v[0][2] += bflo(y0.y); v[0][3] += bfhi(y0.y); v[1][0] += bflo(y0.z); v[1][1] += bfhi(y0.z); v[1][2] += bflo(y0.w); v[1][3] += bfhi(y0.w);
    v[2][0] += bflo(y1.x); v[2][1] += bfhi(y1.x); v[2][2] += bflo(y1.y); v[2][3] += bfhi(y1.y); v[3][0] += bflo(y1.z); v[3][1] += bfhi(y1.z); v[3][2] += bflo(y1.w); v[3][3] += bfhi(y1.w);
}
__device__ __forceinline__ void phase_combine(const Args& a, const Ctx& c, int hb) {
    const bf16* y = (const bf16*)(a.ws + WS_Y); const bf16* xb = (const bf16*)(a.ws + WS_XBF); const int* tope = (const int*)(a.ws + WS_TOPE); const int* topr = (const int*)(a.ws + WS_TOPR); const float* gf = a.in[24];
    moe_tables(a.ws, hb, c.lds, c.tid);
    const LAS unsigned* tab = (const LAS unsigned*)(c.lds + MOE_TAB_OFF);
    for (int i = c.gw; i < HTOK; i += c.ngw) { const int tok = hb * HTOK + i;
        const int4 ee = *(const int4*)(tope + (size_t)tok * 4), rr = *(const int4*)(topr + (size_t)tok * 4);
        const int ps[4] = {(int)tab[32 + ee.x] * 256 + rr.x, (int)tab[32 + ee.y] * 256 + rr.y, (int)tab[32 + ee.z] * 256 + rr.z, (int)tab[32 + ee.w] * 256 + rr.w};
        f32x4 v[4];
#pragma unroll
        for (int j = 0; j < 4; ++j) v[j] = (f32x4){0.f, 0.f, 0.f, 0.f};
        { const v4u* xp = (const v4u*)(xb + (size_t)tok * DM + c.lane * 16); add16(v, xp[0], xp[1]); }
#pragma unroll
        for (int k = 0; k < 4; ++k) { const v4u* yp = (const v4u*)(y + (size_t)ps[k] * DM + c.lane * 16); add16(v, yp[0], yp[1]); }
        float s = 0.f;
#pragma unroll
        for (int j = 0; j < 4; ++j) s += (v[j][0] * v[j][0] + v[j][1] * v[j][1]) + (v[j][2] * v[j][2] + v[j][3] * v[j][3]);
        const float rstd = rsqrtf(wave_sum(s, c.lane) * (1.f / DM) + RMS_EPS);
        float* xr = a.out + (size_t)tok * DM + c.lane * 16;
#pragma unroll
        for (int j = 0; j < 4; ++j) { const f32x4 gg = *(const f32x4*)(gf + c.lane * 16 + 4 * j); *(f32x4*)(xr + 4 * j) = v[j] * rstd * gg; } }
}

#ifndef MK_PER_PHASE_LAUNCH
#define MK_PER_PHASE_LAUNCH 0
#endif
constexpr int NPHASES = 27;
#ifndef MK_OFF
#define MK_OFF 0u
#endif
#define MKP(k) (((MK_OFF >> (k)) & 1u) == 0u)
#define GSCHED PG8_ALIGN, PG8_SP2
typedef const __attribute__((address_space(4))) Args* KArgP;
#if defined(__HIP_DEVICE_COMPILE__)
__device__ __forceinline__ Args ldargs() { KArgP kp = (KArgP)__builtin_amdgcn_kernarg_segment_ptr(); asm volatile("" : "+s"(kp)); Args r;
#pragma unroll
    for (int i = 0; i < 25; ++i) r.in[i] = kp->in[i];
    r.out = kp->out; r.ws = kp->ws; r.ph_lo = kp->ph_lo; r.ph_hi = kp->ph_hi; return r; }
#else
__device__ __forceinline__ Args ldargs() { return Args{}; }
#endif
__global__ void __launch_bounds__(512, 2) mk_fwd(Args a_) {
    extern __shared__ __attribute__((aligned(16))) unsigned char lds_raw[];
    Ctx c; c.lds = (LAS unsigned char*)lds_raw; c.tid = threadIdx.x; c.lane = c.tid & 63; c.wave = __builtin_amdgcn_readfirstlane(c.tid >> 6); const int wv = c.wave;
    c.G = gridDim.x; c.gw = blockIdx.x * 8 + c.wave; c.ngw = c.G * 8;
    volatile LAS unsigned* MISC = (volatile LAS unsigned*)(c.lds + MISC_OFF);
    for (int u = c.tid; u < (LDS_BYTES - RING_BYTES) / 4; u += 512) ((LAS unsigned*)(c.lds + RING_BYTES))[u] = 0u;
    __syncthreads();
    const int ph_lo = a_.ph_lo, ph_hi = a_.ph_hi;
    const bool fused = (ph_hi - ph_lo) > 1;
    unsigned* barw = (unsigned*)a_.ws + CW_BAR;
    XcdBarrier bar; bar.bar = barw; bar.x = 0; bar.st = MISC + 8; bar.t0 = wv;
    if (fused) bar = xcd_barrier_post(barw, MISC + 8, wv);
    int pc = 0;
#define PH_ON (pc >= ph_lo && pc < ph_hi)
#define PH_END do { if (PH_ON && pc + 1 < ph_hi) xcd_barrier(bar); ++pc; OPQ(c); } while (0)
    LAS unsigned char* ring = c.lds;
#define OPQ(cc) do { { unsigned z_ = 0u; asm volatile("" : "+v"(z_)); cc.lane = (int)__builtin_amdgcn_mbcnt_hi(~0u, __builtin_amdgcn_mbcnt_lo(~0u, z_)); } cc.wave = wv; cc.tid = wv * 64 + cc.lane; { int gw_ = (int)blockIdx.x * 8 + wv; asm volatile("" : "+s"(gw_)); cc.gw = gw_; } } while (0)

    if (MKP(0) && PH_ON) { const Args a = ldargs(); unsigned char* ws = a.ws; (void)ws;  phase_prologue(a, c); __syncthreads(); }
    PH_END;
#pragma unroll
    for (int hb = 0; hb < 2; ++hb) {
        const size_t toff = (size_t)hb * HTOK;
        if (MKP(1) && PH_ON) { const Args a = ldargs(); phase_norm1(a, c, hb); }
        PH_END;
        if (MKP(2) && PH_ON) { const Args a = ldargs(); unsigned char* ws = a.ws; (void)ws;  pg8::Gemm g{(const bf16*)(ws + WS_TM), (const bf16*)(ws + WS_WIN), HTOK, NCOL, DM}; pg8::StaticOrder S; S.init(HTOK, NCOL, c.G, (int)blockIdx.x);
            EpiProj E{ws + WS_PROJ, (const float*)(ws + WS_LB)}; pg8::gemm_phase<EpiProj, pg8::StaticOrder, GSCHED>(ring, g, S, E, wv); }
        PH_END;
        if (MKP(3) && PH_ON) { const Args a = ldargs(); unsigned char* ws = a.ws; (void)ws;  phase_hgA(a, c); }
        PH_END;
        if (MKP(4) && PH_ON) { const Args a = ldargs(); phase_swa_hgB(a, c); }
        PH_END;
        if (MKP(5) && PH_ON) { const Args a = ldargs(); phase_hgC(a, c); }
        PH_END;
        if (MKP(6) && PH_ON) { const Args a = ldargs(); unsigned char* ws = a.ws; (void)ws;  pg8::Gemm g{(const bf16*)(ws + WS_OA), (const bf16*)(ws + WS_WA), HTOK, DM, DM}; pg8::StaticOrder S; S.init(HTOK, DM, c.G, (int)blockIdx.x);
            EpiGate<false> E{(bf16*)(ws + WS_TM), (const bf16*)(ws + WS_PROJ + PJ_GA), a.in[6]}; pg8::gemm_phase<EpiGate<false>, pg8::StaticOrder, GSCHED>(ring, g, S, E, wv); }
        PH_END;
        if (MKP(7) && PH_ON) { const Args a = ldargs(); unsigned char* ws = a.ws; (void)ws;  pg8::Gemm g{(const bf16*)(ws + WS_OB), (const bf16*)(ws + WS_WB), HTOK, DM, DM}; pg8::StaticOrder S; S.init(HTOK, DM, c.G, (int)blockIdx.x);
            EpiGate<true> E{(bf16*)(ws + WS_TM), (const bf16*)(ws + WS_PROJ + PJ_GB), a.in[6] + DM}; pg8::gemm_phase<EpiGate<true>, pg8::StaticOrder, GSCHED>(ring, g, S, E, wv); }
        PH_END;
        if (MKP(8) && PH_ON) { const Args a = ldargs(); unsigned char* ws = a.ws; (void)ws;  pg8::Gemm g{(const bf16*)(ws + WS_TM), (const bf16*)(ws + WS_WMIX), HTOK, DM, DM}; pg8::StaticOrder S; S.init(HTOK, DM, c.G, (int)blockIdx.x);
            EpiResid<false> E{a.in[0] + toff * DM, (bf16*)(ws + WS_XBF) + toff * DM, (float*)(ws + WS_SSQ1) + toff * 16, ws + WS_X1F8 + toff * DM, 1.f}; pg8::gemm_phase<EpiResid<false>, pg8::StaticOrder, GSCHED>(ring, g, S, E, wv); }
        PH_END;
    }
    if (MKP(9) && PH_ON) { const Args a = ldargs(); unsigned char* ws = a.ws; (void)ws;
        phase_expert_weights(a, c);
        { pg8::Gemm g{(const bf16*)(ws + WS_MEMBF), (const bf16*)(ws + WS_WK), NBATCH * MEMLEN, DM, DM}; pg8::StaticOrder S; S.init(NBATCH * MEMLEN, DM, c.G, (int)blockIdx.x);
          EpiStore E{(bf16*)(ws + WS_KX), DM, nullptr, 1.f}; pg8::gemm_phase<EpiStore, pg8::StaticOrder, GSCHED>(ring, g, S, E, wv); }
        { pg8::Gemm g{(const bf16*)(ws + WS_WV), (const bf16*)(ws + WS_MEMBF), DM, NBATCH * MEMLEN, DM}; pg8::StaticOrder S; S.init(DM, NBATCH * MEMLEN, c.G, (int)((blockIdx.x + 64) % c.G));
          EpiStore E{(bf16*)(ws + WS_VXT), NBATCH * MEMLEN, nullptr, 1.f}; pg8::gemm_phase<EpiStore, pg8::StaticOrder, GSCHED>(ring, g, S, E, wv); }
        { pg8::Gemm g{(const bf16*)(ws + WS_X1F8), (const bf16*)(ws + WS_WQ), NTOK, DM, DM}; pg8::StaticOrder S; S.init(NTOK, DM, c.G, (int)blockIdx.x);
          EpiStore E{(bf16*)(ws + WS_Q), DM, (const float*)(ws + WS_SSQ1), F8_WINV}; pg8::gemm_phase8<EpiStore, pg8::StaticOrder, GSCHED>(ring, g, S, E, wv); }
    }
    PH_END;
    if (MKP(10) && PH_ON) { const Args a = ldargs(); phase_xa(a, c); }
    PH_END;
    if (MKP(11) && PH_ON) { const Args a = ldargs(); unsigned char* ws = a.ws; (void)ws;  pg8::Gemm g{(const bf16*)(ws + WS_O), (const bf16*)(ws + WS_WO), NTOK, DM, DM}; pg8::StaticOrder S; S.init(NTOK, DM, c.G, (int)blockIdx.x);
        EpiResid<true> E{nullptr, (bf16*)(ws + WS_XBF), (float*)(ws + WS_SSQ2), ws + WS_X2F8, F8_WINV}; pg8::gemm_phase8<EpiResid<true>, pg8::StaticOrder, GSCHED>(ring, g, S, E, wv); }
    PH_END;
    if (MKP(12) && PH_ON) { const Args a = ldargs(); phase_router(a, c); }
    PH_END;
#pragma unroll
    for (int hb = 0; hb < 2; ++hb) {
        if (MKP(14) && PH_ON) { const Args a = ldargs(); unsigned char* ws = a.ws; moe_tables(ws, hb, c.lds, c.tid);
            const LAS unsigned* tab = (const LAS unsigned*)(c.lds + MOE_TAB_OFF); const int nb = (int)__builtin_amdgcn_readfirstlane(tab[64]);
            pg8::Gemm g{(const bf16*)(ws + WS_X2F8), (const bf16*)(ws + WS_WGU), NTOK, NEXP * 2048, DM};              GroupedOrder S{nb * 8, 8, c.G, (int)blockIdx.x, hb, tab, (const int*)(ws + WS_RTOK)};
            EpiSwiglu E{ws + WS_ACT, a.in[21], (const float*)(ws + WS_RRSTD2)}; pg8::gemm_phase_gather8<EpiSwiglu, GroupedOrder>(ring, g, S, E, wv); }
        PH_END;
        if (MKP(15) && PH_ON) { const Args a = ldargs(); unsigned char* ws = a.ws; moe_tables(ws, hb, c.lds, c.tid);
            const LAS unsigned* tab = (const LAS unsigned*)(c.lds + MOE_TAB_OFF); const int nb = (int)__builtin_amdgcn_readfirstlane(tab[64]);
            pg8::Gemm g{(const bf16*)(ws + WS_ACT), (const bf16*)(ws + WS_WD), CAPH, NEXP * 1024, DM}; GroupedOrder S{nb * 4, 4, c.G, (int)blockIdx.x, hb, tab, (const int*)(ws + WS_RTOK)};
            EpiDown E{(bf16*)(ws + WS_Y), a.in[23], (const float*)(ws + WS_RGATE2)}; pg8::gemm_phase8<EpiDown, GroupedOrder, GSCHED>(ring, g, S, E, wv); }
        PH_END;
        if (MKP(16) && PH_ON) { const Args a = ldargs(); phase_combine(a, c, hb); }
        PH_END;
    }
#undef PH_ON
#undef PH_END
}

#if defined(MK_DBG_STOP)
#ifndef MK_DBG_SRC_OUT
#define MK_DBG_SRC_OUT 0
#endif
#ifndef MK_DBG_F32
#define MK_DBG_F32 0
#endif
__global__ void dbg_dump(const unsigned short* src, float* out, size_t n, size_t N) {
    for (size_t i = (size_t)blockIdx.x * blockDim.x + threadIdx.x; i < N; i += (size_t)gridDim.x * blockDim.x) {
        if (i < n) { float v = MK_DBG_F32 ? ((const float*)src)[i] : __builtin_bit_cast(float, (unsigned)src[i] << 16); if (!(fabsf(v) < 1e30f)) v = 12345.f; out[i] = v; }
        else if (!MK_DBG_SRC_OUT) out[i] = 0.f;
    }
}
__global__ void dbg_zero_upper(float* out, size_t n0, size_t N) { for (size_t i = n0 + (size_t)blockIdx.x * blockDim.x + threadIdx.x; i < N; i += (size_t)gridDim.x * blockDim.x) out[i] = 0.f; }
#endif
#if defined(MK_REP_THRASH)
__global__ void dbg_thrash(const f32x4* a, size_t na, const f32x4* b, size_t nb, float* sink) {
    f32x4 acc = (f32x4){0.f, 0.f, 0.f, 0.f};
    for (size_t i = (size_t)blockIdx.x * blockDim.x + threadIdx.x; i < na; i += (size_t)gridDim.x * blockDim.x) acc += a[i];
    for (size_t i = (size_t)blockIdx.x * blockDim.x + threadIdx.x; i < nb; i += (size_t)gridDim.x * blockDim.x) acc += b[i];
    if (acc[0] + acc[1] + acc[2] + acc[3] == 12345.678f) sink[0] = 1.f;
}
#endif
extern "C" void kernel_launch(void* const* d_in, const int* in_sizes, int n_in, void* d_out, int out_size, void* d_ws, size_t ws_size, hipStream_t stream) {
    static int grid = 0;
    if (grid == 0) {
        if (n_in != 25 || out_size != NTOK * DM || ws_size < WS_END) { fprintf(stderr, "kernel_launch: unexpected problem shape (n_in %d, out %d, ws %zu); nothing launched\n", n_in, out_size, ws_size); grid = -1; return; }
        int dev = 0, cus = 0, per_cu = 0;
        if (hipGetDevice(&dev) != hipSuccess || hipDeviceGetAttribute(&cus, hipDeviceAttributeMultiprocessorCount, dev) != hipSuccess) { grid = -1; return; }
        if (hipFuncSetAttribute((const void*)mk_fwd, hipFuncAttributeMaxDynamicSharedMemorySize, LDS_BYTES) != hipSuccess) { fprintf(stderr, "kernel_launch: hipFuncSetAttribute failed\n"); grid = -1; return; }
        if (hipOccupancyMaxActiveBlocksPerMultiprocessor(&per_cu, (const void*)mk_fwd, 512, LDS_BYTES) != hipSuccess || per_cu < 1) { fprintf(stderr, "kernel_launch: occupancy query reports %d blocks per CU\n", per_cu); }
        (void)hipGetLastError();
        grid = cus;
    }
    if (grid < 0) return;
    (void)in_sizes;
    hipMemsetAsync(d_ws, 0, WS_ZERO_BYTES, stream);
    Args a{};
    for (int i = 0; i < 25; ++i) a.in[i] = (const float*)d_in[i];
    a.out = (float*)d_out; a.ws = (unsigned char*)d_ws;
#if defined(MK_DBG_STOP)
    for (int p = 0; p < MK_DBG_STOP; ++p) { a.ph_lo = p; a.ph_hi = p + 1; hipLaunchKernelGGL(mk_fwd, dim3(grid), dim3(512), LDS_BYTES, stream, a); }
    hipLaunchKernelGGL(dbg_dump, dim3(2048), dim3(256), 0, stream, (const unsigned short*)((const unsigned char*)(MK_DBG_SRC_OUT ? d_out : d_ws) + (size_t)MK_DBG_OFF_MIB * MiB), (float*)d_out, (size_t)MK_DBG_MIB * MiB / (MK_DBG_F32 ? 4 : 2), (size_t)NTOK * DM);
    if (MK_DBG_SRC_OUT) hipLaunchKernelGGL(dbg_zero_upper, dim3(2048), dim3(256), 0, stream, (float*)d_out, (size_t)MK_DBG_MIB * MiB / 2, (size_t)NTOK * DM);
#elif MK_PER_PHASE_LAUNCH
#if defined(MK_REP_THRASH) && defined(MK_REP_PC)
    if (MK_REP_PC < 0) for (int r = 0; r < MK_REP_N; ++r) hipLaunchKernelGGL(dbg_thrash, dim3(2048), dim3(256), 0, stream, (const f32x4*)d_in[20], (size_t)NEXP * DM * 2048 / 4, (const f32x4*)d_in[22], (size_t)NEXP * DM * DM / 4, (float*)((char*)d_ws + WS_LB + 8192));
#endif
    for (int p = 0; p < NPHASES; ++p) { a.ph_lo = p; a.ph_hi = p + 1; hipLaunchKernelGGL(mk_fwd, dim3(grid), dim3(512), LDS_BYTES, stream, a);
#if defined(MK_REP_PC)
        if (p == MK_REP_PC) for (int r = 0; r < MK_REP_N; ++r) {
#if defined(MK_REP_THRASH)
            hipLaunchKernelGGL(dbg_thrash, dim3(2048), dim3(256), 0, stream, (const f32x4*)d_in[20], (size_t)NEXP * DM * 2048 / 4, (const f32x4*)d_in[22], (size_t)NEXP * DM * DM / 4, (float*)((char*)d_ws + WS_LB + 8192));
#endif
 if (p == 22 && false) (void)hipMemsetAsync((char*)d_ws + WS_GCNT, 0, 4096, stream); hipLaunchKernelGGL(mk_fwd, dim3(grid), dim3(512), LDS_BYTES, stream, a); }
#endif
    }
#else
    a.ph_lo = 0; a.ph_hi = NPHASES;
    hipLaunchKernelGGL(mk_fwd, dim3(grid), dim3(512), LDS_BYTES, stream, a);
#endif
}
```

```cpp
#include <hip/hip_runtime.h>
#include <cstdio>
#include <cstdint>
#ifndef PG8_RELAX_A
#define PG8_RELAX_A 0
#endif
#ifndef PG8_RELAX_B
#define PG8_RELAX_B 1
#endif
#ifndef PG8_RELAX_C
#define PG8_RELAX_C 1
#endif
#if defined(MK_KLOOP_PROBE) || defined(MK_TL_PROBE) || defined(MK_K8_PROBE)
__device__ float mk_probe[32]; __device__ int mk_probe_site = -1;
#endif
namespace pg8 {
#define PG8_LAS __attribute__((address_space(3)))
typedef unsigned short bf16_t;
typedef short bf16x8 __attribute__((ext_vector_type(8)));
typedef float f32x4 __attribute__((ext_vector_type(4)));
typedef unsigned u32x4 __attribute__((ext_vector_type(4)));
constexpr int BM = 256, BK = 64, HALF = 128, HTB = HALF * BK * 2  , STAGE_BYTES = 8 * HTB, NXCD = 8, WGM = 4;

__host__ __device__ __forceinline__ int lds_byte(int r, int c) { const int st = (r >> 4) * 2 + (c >> 5), rr = r & 15, cc = c & 31, ob = rr * 64 + cc * 2; return st * 1024 + (ob ^ (((ob >> 9) & 1) << 5)); }
__host__ __device__ __forceinline__ void stage_rc(int b, int& R, int& C) { const int st = b / 1024, sb = b % 1024, swz = sb ^ (((sb >> 9) & 1) << 5); R = (st >> 1) * 16 + swz / 64; C = (st & 1) * 32 + (swz % 64) / 2; }
__host__ __device__ __forceinline__ int perm32(int rho) { const int n = rho >> 4, i = rho & 15; return 8 * (i >> 2) + 4 * n + (i & 3); }

struct Unit { int pm, pn, aux, cnt; };
struct Gemm { const bf16_t* A; const bf16_t* Bt; int M, N, K; };

struct StaticOrder {
    int nM, nN, nwg, G, c;
    __host__ __device__ void init(int M, int N, int G_, int c_) { nM = M / BM; nN = N / BM; nwg = nM * nN; G = G_; c = c_; }
    __host__ __device__ bool next(int i, Unit& u) const {
        const long L = (long)i * G + c; if (L >= nwg) return false;
        int wgid = (int)L; { const int q = nwg / NXCD, r = nwg % NXCD, xcd = wgid % NXCD, off = wgid / NXCD; wgid = (xcd < r ? xcd * (q + 1) : r * (q + 1) + (xcd - r) * q) + off; }
        const int nig = WGM * nN, gid = wgid / nig, fm = gid * WGM, gsz = (nM - fm) < WGM ? (nM - fm) : WGM;
        u.pm = fm + ((wgid % nig) % gsz); u.pn = (wgid % nig) / gsz; return true;
    }
    __device__ __forceinline__ void a_ready(const Unit&) const {}
    __device__ __forceinline__ void done(const Unit&) const {}
};

__device__ __forceinline__ unsigned cvt_pk_bf16(float lo, float hi) { unsigned r; asm volatile("v_cvt_pk_bf16_f32 %0, %1, %2" : "=v"(r) : "v"(lo), "v"(hi)); return r; }
typedef float f32x2 __attribute__((ext_vector_type(2)));
template <class Epi, class Sched, bool ALIGN_EPI = false, bool SP2 = false>
__device__ __forceinline__ void gemm_phase(PG8_LAS unsigned char* lds, const Gemm g, const Sched& S, const Epi& E, const int wave_in) {
    unsigned z_ = 0u; asm volatile("" : "+v"(z_)); const int tid_ = (int)__builtin_amdgcn_mbcnt_hi(~0u, __builtin_amdgcn_mbcnt_lo(~0u, z_)) + 64 * wave_in;
    const int tid = tid_, wid = __builtin_amdgcn_readfirstlane(tid >> 6), lane = tid & 63, wr = wid >> 2, wc = wid & 3, fr = lane & 15, fq = lane >> 4;
    const int K = g.K, nt = K / BK;
#if defined(MK_KLOOP_PROBE)
    long long kp_f0 = 0; if (blockIdx.x == MK_KLOOP_WG && tid == 0) { mk_probe_site = mk_probe_site + 1; kp_f0 = clock64(); }
#endif
    unsigned voffA[2], voffB[2];
#pragma unroll
    for (int i = 0; i < 2; ++i) { int R, C; stage_rc(tid * 16 + i * 8192, R, C); const int Rb = Epi::PERM ? ((R & ~31) + perm32(R & 31)) : R;
        voffA[i] = (unsigned)(R * K + C) * 2u; voffB[i] = (unsigned)(Rb * K + C) * 2u; }
    const size_t kstep = (size_t)(BK * 2);
    const size_t hstep = (size_t)HALF * K * 2;
    const size_t tstep = 2 * hstep;
    const unsigned ldsw = (unsigned)wid * 1024u;
    const int aoff = lds_byte(wr * 64 + fr, fq * 8), boff = lds_byte(wc * 32 + fr, fq * 8);
#define PG8_SA(b, h) (((b) * 2 + (h)) * HTB)
#define PG8_SB(b, h) ((4 + (b) * 2 + (h)) * HTB)
#define PG8_STAGE(bufoff, gbase, voff) do { _Pragma("unroll") for (int _i = 0; _i < 2; ++_i) \
        __builtin_amdgcn_global_load_lds((const unsigned*)((const char*)(gbase) + (voff)[_i]), (PG8_LAS unsigned*)(lds + (bufoff) + ldsw + _i * 8192), 16, 0, 0); } while (0)
#define PG8_LDA(dst, b, h) do { _Pragma("unroll") for (int m = 0; m < 4; ++m) _Pragma("unroll") for (int k = 0; k < 2; ++k) dst[m][k] = *(const PG8_LAS bf16x8*)(lds + PG8_SA(b, h) + aoff + m * 2048 + k * 1024); } while (0)
#define PG8_LDB(dst, b, h) do { _Pragma("unroll") for (int n = 0; n < 2; ++n) _Pragma("unroll") for (int k = 0; k < 2; ++k) dst[n][k] = *(const PG8_LAS bf16x8*)(lds + PG8_SB(b, h) + boff + n * 2048 + k * 1024); } while (0)
#define PG8_MMA(ai, bj, At, Bt) do { __builtin_amdgcn_s_setprio(1); _Pragma("unroll") for (int m = 0; m < 4; ++m) _Pragma("unroll") for (int n = 0; n < 2; ++n) _Pragma("unroll") for (int k = 0; k < 2; ++k) \
        acc[ai][bj][m][n] = __builtin_amdgcn_mfma_f32_16x16x32_bf16(Bt[n][k], At[m][k], acc[ai][bj][m][n], 0, 0, 0); __builtin_amdgcn_s_setprio(0); } while (0)
#define PG8_WAIT_V(n) asm volatile("s_waitcnt vmcnt(" #n ")" ::: "memory")
#define PG8_WAIT_VN(n) asm volatile("s_waitcnt vmcnt(%0)" :: "n"(n) : "memory")
#define PG8_WAIT_V8R(flag, n) asm volatile("s_waitcnt vmcnt(%1)\n\ts_cmp_lg_u32 %0, 0\n\ts_cbranch_scc1 .Lrw_%=\n\ts_waitcnt vmcnt(8)\n.Lrw_%=:" :: "s"(flag), "n"(n) : "scc", "memory")
#define PG8_WAIT_L(n) asm volatile("s_waitcnt lgkmcnt(" #n ")" ::: "memory")
#define PG8_BAR __builtin_amdgcn_s_barrier()
#define PG8_SCHED __builtin_amdgcn_sched_barrier(0)
    Unit cur, nxt; int ui = 0;
    if (!S.next(0, cur)) return;
    f32x4 acc[2][2][4][2];
#pragma unroll
    for (int a = 0; a < 2; ++a)
#pragma unroll
        for (int b = 0; b < 2; ++b)
#pragma unroll
            for (int m = 0; m < 4; ++m)
#pragma unroll
                for (int n = 0; n < 2; ++n) acc[a][b][m][n] = (f32x4){0.f, 0.f, 0.f, 0.f};
    bf16x8 At[4][2], B0[2][2], B1[2][2];
    const char* cA = (const char*)g.A + (size_t)cur.pm * tstep; const char* cB = (const char*)g.Bt + (size_t)cur.pn * tstep;
    S.a_ready(cur);
    if constexpr (SP2) {
        PG8_STAGE(PG8_SB(0, 0), cB, voffB); PG8_STAGE(PG8_SB(0, 1), cB + hstep, voffB); PG8_STAGE(PG8_SA(0, 0), cA, voffA); PG8_STAGE(PG8_SA(0, 1), cA + hstep, voffA);
        if (wr == 1) PG8_BAR;
        PG8_WAIT_V(2); PG8_BAR;
        PG8_STAGE(PG8_SB(1, 0), cB + kstep, voffB); PG8_STAGE(PG8_SA(1, 0), cA + kstep, voffA); PG8_STAGE(PG8_SB(1, 1), cB + hstep + kstep, voffB);
        PG8_WAIT_V(6); PG8_BAR;
    } else {
        PG8_STAGE(PG8_SB(0, 0), cB, voffB); PG8_STAGE(PG8_SA(0, 0), cA, voffA); PG8_STAGE(PG8_SB(0, 1), cB + hstep, voffB); PG8_STAGE(PG8_SA(0, 1), cA + hstep, voffA);
        if (wr == 1) PG8_BAR;
        PG8_WAIT_V(4); PG8_BAR;
        PG8_STAGE(PG8_SB(1, 0), cB + kstep, voffB); PG8_STAGE(PG8_SA(1, 0), cA + kstep, voffA); PG8_STAGE(PG8_SB(1, 1), cB + hstep + kstep, voffB);
        PG8_WAIT_V(6); PG8_BAR;
    }
    for (;;) {
        const bool has_next = S.next(ui + 1, nxt);
        const char* nA = has_next ? (const char*)g.A + (size_t)nxt.pm * tstep : cA; const char* nB = has_next ? (const char*)g.Bt + (size_t)nxt.pn * tstep : cB;
#if defined(MK_KLOOP_PROBE)
        long long kp_t0 = 0; const bool kp_on = (blockIdx.x == MK_KLOOP_WG) && (ui == MK_KLOOP_UNIT) && (tid == 0); if (kp_on) kp_t0 = clock64();
#endif
        for (int t = 0; t < nt; t += 2) {
            const bool last = (t == nt - 2);
            const char* a1 = cA + (size_t)(t + 1) * kstep;
            const char* a2 = last ? nA : cA + (size_t)(t + 2) * kstep; const char* b2 = last ? nB : cB + (size_t)(t + 2) * kstep;
            const char* a3 = a2 + kstep; const char* b3 = b2 + kstep;
            if (last && has_next) S.a_ready(nxt);
            if constexpr (SP2) {
            PG8_LDB(B0, 0, 0); PG8_LDB(B1, 0, 1); PG8_SCHED; PG8_LDA(At, 0, 0); PG8_STAGE(PG8_SA(1, 1), a1 + hstep, voffA);
            PG8_WAIT_V8R(__builtin_amdgcn_readfirstlane((t == 0 && ui > 0) ? 1 : 0), 8 + Epi::NST); PG8_WAIT_L(0); PG8_BAR; PG8_MMA(0, 0, At, B0); PG8_MMA(0, 1, At, B1); PG8_BAR; PG8_SCHED;
            PG8_LDA(At, 0, 1); PG8_STAGE(PG8_SB(0, 0), b2, voffB); PG8_STAGE(PG8_SB(0, 1), b2 + hstep, voffB); PG8_STAGE(PG8_SA(0, 0), a2, voffA);
            PG8_WAIT_V8R(__builtin_amdgcn_readfirstlane((t == 0 && ui > 0) ? 1 : 0), 8 + Epi::NST); PG8_WAIT_L(0); PG8_BAR; PG8_MMA(1, 0, At, B0); PG8_MMA(1, 1, At, B1); PG8_BAR; PG8_SCHED;
            PG8_LDB(B0, 1, 0); PG8_LDB(B1, 1, 1); PG8_SCHED; PG8_LDA(At, 1, 0); PG8_STAGE(PG8_SA(0, 1), a2 + hstep, voffA);
            PG8_WAIT_V(8); PG8_WAIT_L(0); PG8_BAR; PG8_MMA(0, 0, At, B0); PG8_MMA(0, 1, At, B1); PG8_BAR; PG8_SCHED;
            PG8_LDA(At, 1, 1); PG8_STAGE(PG8_SB(1, 0), b3, voffB); PG8_STAGE(PG8_SB(1, 1), b3 + hstep, voffB); PG8_STAGE(PG8_SA(1, 0), a3, voffA);
            PG8_WAIT_V(8); PG8_WAIT_L(0); PG8_BAR; PG8_MMA(1, 0, At, B0); PG8_MMA(1, 1, At, B1); PG8_BAR; PG8_SCHED;
            } else {
            PG8_LDB(B0, 0, 0); PG8_SCHED; PG8_LDA(At, 0, 0); PG8_STAGE(PG8_SA(1, 1), a1 + hstep, voffA);
            PG8_WAIT_L(8); PG8_BAR; PG8_WAIT_L(0); PG8_MMA(0, 0, At, B0); PG8_BAR; PG8_SCHED;
            PG8_LDB(B1, 0, 1); PG8_STAGE(PG8_SB(0, 0), b2, voffB);
            PG8_BAR; PG8_WAIT_L(0); PG8_MMA(0, 1, At, B1); PG8_BAR;
            PG8_LDA(At, 0, 1); PG8_STAGE(PG8_SA(0, 0), a2, voffA);
            PG8_BAR; PG8_WAIT_L(0); PG8_MMA(1, 0, At, B0); PG8_BAR; PG8_SCHED;
            PG8_STAGE(PG8_SB(0, 1), b2 + hstep, voffB);
            PG8_WAIT_V(6); PG8_BAR; PG8_MMA(1, 1, At, B1); PG8_BAR;
            PG8_LDB(B0, 1, 0); PG8_SCHED; PG8_LDA(At, 1, 0); PG8_STAGE(PG8_SA(0, 1), a2 + hstep, voffA);
            PG8_WAIT_L(8); PG8_BAR; PG8_WAIT_L(0); PG8_MMA(0, 0, At, B0); PG8_BAR; PG8_SCHED;
            PG8_LDB(B1, 1, 1); PG8_STAGE(PG8_SB(1, 0), b3, voffB);
            PG8_BAR; PG8_WAIT_L(0); PG8_MMA(0, 1, At, B1); PG8_BAR;
            PG8_LDA(At, 1, 1); PG8_STAGE(PG8_SA(1, 0), a3, voffA);
            PG8_BAR; PG8_WAIT_L(0); PG8_MMA(1, 0, At, B0); PG8_BAR; PG8_SCHED;
            PG8_STAGE(PG8_SB(1, 1), b3 + hstep, voffB);
            PG8_WAIT_V(6); PG8_BAR; PG8_MMA(1, 1, At, B1); PG8_BAR;
            }
        }
#if defined(MK_KLOOP_PROBE)
        long long kp_t1 = 0; if (kp_on) kp_t1 = clock64();
#endif
        if constexpr (ALIGN_EPI) { if (wr == 0) PG8_BAR; }
        if constexpr (!Epi::AFTER_DRAIN) { E(acc, cur, wr, wc, fr, fq); S.done(cur); }
#if defined(MK_KLOOP_PROBE)
        if (kp_on) { const long long kp_t2 = clock64(); const int site = mk_probe_site; if (site < 16) { mk_probe[2 * site] = (float)(kp_t1 - kp_t0); mk_probe[2 * site + 1] = (float)(kp_t2 - kp_t1); } }
#endif
        if (!has_next) break;
#pragma unroll
        for (int a = 0; a < 2; ++a)
#pragma unroll
            for (int b = 0; b < 2; ++b)
#pragma unroll
                for (int m = 0; m < 4; ++m)
#pragma unroll
                    for (int n = 0; n < 2; ++n) acc[a][b][m][n] = (f32x4){0.f, 0.f, 0.f, 0.f};
        cur = nxt; cA = nA; cB = nB; ++ui;
        if constexpr (ALIGN_EPI) { if (wr == 1) PG8_BAR; }
    }
#if defined(MK_KLOOP_PROBE)
    if (blockIdx.x == MK_KLOOP_WG && tid == 0) { const int site = mk_probe_site; if (site < 8) mk_probe[16 + site] = (float)(clock64() - kp_f0); }
#endif
    PG8_WAIT_V(0);
    if constexpr (!ALIGN_EPI) { if (wr == 0) PG8_BAR; }
    PG8_BAR;
    if constexpr (Epi::AFTER_DRAIN) { E.fused(acc, cur, wr, wc, fr, fq, lds, wid, lane); S.done(cur); }
#undef PG8_SA
#undef PG8_SB
#undef PG8_STAGE
#undef PG8_LDA
#undef PG8_LDB
#undef PG8_MMA
#undef PG8_WAIT_V
#undef PG8_WAIT_VN
#undef PG8_WAIT_V8R
#undef PG8_WAIT_L
#undef PG8_BAR
#undef PG8_SCHED
}
template <class Epi, class Sched>
__device__ __forceinline__ void gemm_phase_gather(PG8_LAS unsigned char* lds, const Gemm g, const Sched& S, const Epi& E, const int wave_in) {
    unsigned z_ = 0u; asm volatile("" : "+v"(z_)); const int tid_ = (int)__builtin_amdgcn_mbcnt_hi(~0u, __builtin_amdgcn_mbcnt_lo(~0u, z_)) + 64 * wave_in;
    const int tid = tid_, wid = __builtin_amdgcn_readfirstlane(tid >> 6), lane = tid & 63, wr = wid >> 2, wc = wid & 3, fr = lane & 15, fq = lane >> 4;
    constexpr bool ALIGN_EPI = true, SP2 = true;
    const int K = g.K, nt = K / BK;
    unsigned voffB[2]; int RA0; unsigned CA0;
#pragma unroll
    for (int i = 0; i < 2; ++i) { int R, C; stage_rc(tid * 16 + i * 8192, R, C); const int Rb = Epi::PERM ? ((R & ~31) + perm32(R & 31)) : R;
        if (i == 0) { RA0 = R; CA0 = (unsigned)C * 2u; } voffB[i] = (unsigned)(Rb * K + C) * 2u; }
    unsigned ro[2], rn[2][2];
    const size_t kstep = (size_t)(BK * 2);
    const size_t hstep = (size_t)HALF * K * 2;
    const size_t tstep = 2 * hstep;
    const unsigned ldsw = (unsigned)wid * 1024u;
    const int aoff = lds_byte(wr * 64 + fr, fq * 8), boff = lds_byte(wc * 32 + fr, fq * 8);
#define PG8_SA(b, h) (((b) * 2 + (h)) * HTB)
#define PG8_SB(b, h) ((4 + (b) * 2 + (h)) * HTB)
#define PG8_STAGE(bufoff, gbase, voff) do { _Pragma("unroll") for (int _i = 0; _i < 2; ++_i) \
        __builtin_amdgcn_global_load_lds((const unsigned*)((const char*)(gbase) + (voff)[_i]), (PG8_LAS unsigned*)(lds + (bufoff) + ldsw + _i * 8192), 16, 0, 0); } while (0)
#define PG8_STAGE_G(bufoff, kbyte, pk) do { _Pragma("unroll") for (int _i = 0; _i < 2; ++_i) { const unsigned _row = _i ? ((pk) >> 16) : ((pk) & 0xffffu); \
        __builtin_amdgcn_global_load_lds((const unsigned*)((const char*)g.A + (kbyte) + (_row * ((unsigned)K * 2u) + CA0)), (PG8_LAS unsigned*)(lds + (bufoff) + ldsw + _i * 8192), 16, 0, 0); } } while (0)
#define PG8_LDA(dst, b, h) do { _Pragma("unroll") for (int m = 0; m < 4; ++m) _Pragma("unroll") for (int k = 0; k < 2; ++k) dst[m][k] = *(const PG8_LAS bf16x8*)(lds + PG8_SA(b, h) + aoff + m * 2048 + k * 1024); } while (0)
#define PG8_LDB(dst, b, h) do { _Pragma("unroll") for (int n = 0; n < 2; ++n) _Pragma("unroll") for (int k = 0; k < 2; ++k) dst[n][k] = *(const PG8_LAS bf16x8*)(lds + PG8_SB(b, h) + boff + n * 2048 + k * 1024); } while (0)
#define PG8_MMA(ai, bj, At, Bt) do { __builtin_amdgcn_s_setprio(1); _Pragma("unroll") for (int m = 0; m < 4; ++m) _Pragma("unroll") for (int n = 0; n < 2; ++n) _Pragma("unroll") for (int k = 0; k < 2; ++k) \
        acc[ai][bj][m][n] = __builtin_amdgcn_mfma_f32_16x16x32_bf16(Bt[n][k], At[m][k], acc[ai][bj][m][n], 0, 0, 0); __builtin_amdgcn_s_setprio(0); } while (0)
#define PG8_WAIT_V(n) asm volatile("s_waitcnt vmcnt(" #n ")" ::: "memory")
#define PG8_WAIT_VN(n) asm volatile("s_waitcnt vmcnt(%0)" :: "n"(n) : "memory")
#define PG8_WAIT_L(n) asm volatile("s_waitcnt lgkmcnt(" #n ")" ::: "memory")
#define PG8_BAR __builtin_amdgcn_s_barrier()
#define PG8_SCHED __builtin_amdgcn_sched_barrier(0)
    Unit cur, nxt; int ui = 0;
    if (!S.next(0, cur)) return;
    f32x4 acc[2][2][4][2];
#pragma unroll
    for (int a = 0; a < 2; ++a)
#pragma unroll
        for (int b = 0; b < 2; ++b)
#pragma unroll
            for (int m = 0; m < 4; ++m)
#pragma unroll
                for (int n = 0; n < 2; ++n) acc[a][b][m][n] = (f32x4){0.f, 0.f, 0.f, 0.f};
    bf16x8 At[4][2], B0[2][2], B1[2][2];
    const char* cB = (const char*)g.Bt + (size_t)cur.pn * tstep;
    S.a_ready(cur);
    S.rows(cur, RA0, rn); ro[0] = rn[0][0] | (rn[0][1] << 16); ro[1] = rn[1][0] | (rn[1][1] << 16);
    if constexpr (SP2) {
        PG8_STAGE(PG8_SB(0, 0), cB, voffB); PG8_STAGE(PG8_SB(0, 1), cB + hstep, voffB); PG8_STAGE_G(PG8_SA(0, 0), 0, ro[0]); PG8_STAGE_G(PG8_SA(0, 1), 0, ro[1]);
        if (wr == 1) PG8_BAR;
        PG8_WAIT_V(2); PG8_BAR;
        PG8_STAGE(PG8_SB(1, 0), cB + kstep, voffB); PG8_STAGE_G(PG8_SA(1, 0), kstep, ro[0]); PG8_STAGE(PG8_SB(1, 1), cB + hstep + kstep, voffB);
        PG8_WAIT_V(6); PG8_BAR;
    }
    for (;;) {
        const bool has_next = S.next(ui + 1, nxt);
        const char* nB = has_next ? (const char*)g.Bt + (size_t)nxt.pn * tstep : cB;
        for (int t = 0; t < nt; t += 2) {
            const bool last = (t == nt - 2);
            const size_t k1 = (size_t)(t + 1) * kstep, k2 = last ? (size_t)0 : (size_t)(t + 2) * kstep, k3 = k2 + kstep;
            const char* b2 = last ? nB : cB + (size_t)(t + 2) * kstep; const char* b3 = b2 + kstep;
            if (t == nt - 4 && has_next) S.rows(nxt, RA0, rn);
            const unsigned c1 = ro[1];
            unsigned s0 = ro[0], s1 = ro[1];
            if (last && has_next) { unsigned q0 = rn[0][0], q1 = rn[0][1], q2 = rn[1][0], q3 = rn[1][1]; asm volatile("" : "+v"(q0), "+v"(q1), "+v"(q2), "+v"(q3));
                s0 = q0 | (q1 << 16); s1 = q2 | (q3 << 16); ro[0] = s0; ro[1] = s1; }
            if (last && has_next) S.a_ready(nxt);
            if constexpr (SP2) {
            PG8_LDB(B0, 0, 0); PG8_LDB(B1, 0, 1); PG8_SCHED; PG8_LDA(At, 0, 0); PG8_STAGE_G(PG8_SA(1, 1), k1, c1);
            PG8_WAIT_V(8); PG8_WAIT_L(0); PG8_BAR; PG8_MMA(0, 0, At, B0); PG8_MMA(0, 1, At, B1); PG8_BAR; PG8_SCHED;
            PG8_LDA(At, 0, 1); PG8_STAGE(PG8_SB(0, 0), b2, voffB); PG8_STAGE(PG8_SB(0, 1), b2 + hstep, voffB); PG8_STAGE_G(PG8_SA(0, 0), k2, s0);
            PG8_WAIT_V(8); PG8_WAIT_L(0); PG8_BAR; PG8_MMA(1, 0, At, B0); PG8_MMA(1, 1, At, B1); PG8_BAR; PG8_SCHED;
            PG8_LDB(B0, 1, 0); PG8_LDB(B1, 1, 1); PG8_SCHED; PG8_LDA(At, 1, 0); PG8_STAGE_G(PG8_SA(0, 1), k2, s1);
            PG8_WAIT_V(8); PG8_WAIT_L(0); PG8_BAR; PG8_MMA(0, 0, At, B0); PG8_MMA(0, 1, At, B1); PG8_BAR; PG8_SCHED;
            PG8_LDA(At, 1, 1); PG8_STAGE(PG8_SB(1, 0), b3, voffB); PG8_STAGE(PG8_SB(1, 1), b3 + hstep, voffB); PG8_STAGE_G(PG8_SA(1, 0), k3, s0);
            PG8_WAIT_V(8); PG8_WAIT_L(0); PG8_BAR; PG8_MMA(1, 0, At, B0); PG8_MMA(1, 1, At, B1); PG8_BAR; PG8_SCHED;
            }
        }
        if constexpr (ALIGN_EPI) { if (wr == 0) PG8_BAR; }
        if constexpr (!Epi::AFTER_DRAIN) { E(acc, cur, wr, wc, fr, fq); S.done(cur); }
        if (!has_next) break;
#pragma unroll
        for (int a = 0; a < 2; ++a)
#pragma unroll
            for (int b = 0; b < 2; ++b)
#pragma unroll
                for (int m = 0; m < 4; ++m)
#pragma unroll
                    for (int n = 0; n < 2; ++n) acc[a][b][m][n] = (f32x4){0.f, 0.f, 0.f, 0.f};
        cur = nxt; cB = nB; ++ui;
        if constexpr (ALIGN_EPI) { if (wr == 1) PG8_BAR; }
    }
    PG8_WAIT_V(0);
    if constexpr (!ALIGN_EPI) { if (wr == 0) PG8_BAR; }
    PG8_BAR;
    if constexpr (Epi::AFTER_DRAIN) { E.fused(acc, cur, wr, wc, fr, fq, lds, wid, lane); S.done(cur); }
#undef PG8_SA
#undef PG8_SB
#undef PG8_STAGE
#undef PG8_STAGE_G
#undef PG8_LDA
#undef PG8_LDB
#undef PG8_MMA
#undef PG8_WAIT_V
#undef PG8_WAIT_VN
#undef PG8_WAIT_L
#undef PG8_BAR
#undef PG8_SCHED
}
typedef int v8i_t __attribute__((ext_vector_type(8)));
template <class Epi, class Sched, bool ALIGN_EPI = false, bool SP2 = false>
__device__ __forceinline__ void gemm_phase8(PG8_LAS unsigned char* lds, const Gemm g, const Sched& S, const Epi& E, const int wave_in) {
    unsigned z_ = 0u; asm volatile("" : "+v"(z_)); const int tid_ = (int)__builtin_amdgcn_mbcnt_hi(~0u, __builtin_amdgcn_mbcnt_lo(~0u, z_)) + 64 * wave_in;
    const int tid = tid_, wid = __builtin_amdgcn_readfirstlane(tid >> 6), lane = tid & 63, wr = wid >> 2, wc = wid & 3, fr = lane & 15, fq = lane >> 4;
    const int K = g.K, nt = K / (2 * BK);
    unsigned voffA[2], voffB[2];
#pragma unroll
    for (int i = 0; i < 2; ++i) { int R, C; stage_rc(tid * 16 + i * 8192, R, C); const int Rb = Epi::PERM ? ((R & ~31) + perm32(R & 31)) : R;
        voffA[i] = (unsigned)(R * K + C * 2); voffB[i] = (unsigned)(Rb * K + C * 2); }
    const size_t kstep = (size_t)(BK * 2);
    const size_t hstep = (size_t)HALF * K;
    const size_t tstep = 2 * hstep;
    const unsigned ldsw = (unsigned)wid * 1024u;
    const int aoff = lds_byte(wr * 64 + fr, fq * 8), boff = lds_byte(wc * 32 + fr, fq * 8);
#define PG8_SA(b, h) (((b) * 2 + (h)) * HTB)
#define PG8_SB(b, h) ((4 + (b) * 2 + (h)) * HTB)
#define PG8_STAGE(bufoff, gbase, voff) do { _Pragma("unroll") for (int _i = 0; _i < 2; ++_i) \
        __builtin_amdgcn_global_load_lds((const unsigned*)((const char*)(gbase) + (voff)[_i]), (PG8_LAS unsigned*)(lds + (bufoff) + ldsw + _i * 8192), 16, 0, 0); } while (0)
#define PG8_LDA(dst, b, h) do { _Pragma("unroll") for (int m = 0; m < 4; ++m) { const u32x4 lo_ = *(const PG8_LAS u32x4*)(lds + PG8_SA(b, h) + aoff + m * 2048), hi_ = *(const PG8_LAS u32x4*)(lds + PG8_SA(b, h) + aoff + m * 2048 + 1024); dst[m] = (v8i_t){(int)lo_.x, (int)lo_.y, (int)lo_.z, (int)lo_.w, (int)hi_.x, (int)hi_.y, (int)hi_.z, (int)hi_.w}; } } while (0)
#define PG8_LDB(dst, b, h) do { _Pragma("unroll") for (int n = 0; n < 2; ++n) { const u32x4 lo_ = *(const PG8_LAS u32x4*)(lds + PG8_SB(b, h) + boff + n * 2048), hi_ = *(const PG8_LAS u32x4*)(lds + PG8_SB(b, h) + boff + n * 2048 + 1024); dst[n] = (v8i_t){(int)lo_.x, (int)lo_.y, (int)lo_.z, (int)lo_.w, (int)hi_.x, (int)hi_.y, (int)hi_.z, (int)hi_.w}; } } while (0)
#define PG8_MMA(ai, bj, At, Bt) do { __builtin_amdgcn_s_setprio(1); _Pragma("unroll") for (int m = 0; m < 4; ++m) _Pragma("unroll") for (int n = 0; n < 2; ++n) \
        asm volatile("v_mfma_f32_16x16x128_f8f6f4 %0, %1, %2, %0" : "+v"(acc[ai][bj][m][n]) : "v"(Bt[n]), "v"(At[m])); __builtin_amdgcn_s_setprio(0); } while (0)
#define PG8_MMAZ(ai, bj, At, Bt) do { __builtin_amdgcn_s_setprio(1); _Pragma("unroll") for (int m = 0; m < 4; ++m) _Pragma("unroll") for (int n = 0; n < 2; ++n) \
        asm volatile("v_mfma_f32_16x16x128_f8f6f4 %0, %1, %2, 0" : "=v"(acc[ai][bj][m][n]) : "v"(Bt[n]), "v"(At[m])); __builtin_amdgcn_s_setprio(0); } while (0)
#define PG8_WAIT_V(n) asm volatile("s_waitcnt vmcnt(" #n ")" ::: "memory")
#define PG8_WAIT_VN(n) asm volatile("s_waitcnt vmcnt(%0)" :: "n"(n) : "memory")
#define PG8_WAIT_L(n) asm volatile("s_waitcnt lgkmcnt(" #n ")" ::: "memory")
#define PG8_BAR __builtin_amdgcn_s_barrier()
#define PG8_SCHED __builtin_amdgcn_sched_barrier(0)
    Unit cur, nxt; int ui = 0;
    if (!S.next(0, cur)) return;
    f32x4 acc[2][2][4][2];
#pragma unroll
    for (int a = 0; a < 2; ++a)
#pragma unroll
        for (int b = 0; b < 2; ++b)
#pragma unroll
            for (int m = 0; m < 4; ++m)
#pragma unroll
                for (int n = 0; n < 2; ++n) (void)0;
    v8i_t At[4], B0[2], B1[2];
    typename Epi::Pre pre;
    const char* cA = (const char*)g.A + (size_t)cur.pm * tstep; const char* cB = (const char*)g.Bt + (size_t)cur.pn * tstep;
    S.a_ready(cur);
    if constexpr (SP2) {
        PG8_STAGE(PG8_SB(0, 0), cB, voffB); PG8_STAGE(PG8_SB(0, 1), cB + hstep, voffB); PG8_STAGE(PG8_SA(0, 0), cA, voffA); PG8_STAGE(PG8_SA(0, 1), cA + hstep, voffA);
        if (wr == 1) PG8_BAR;
        PG8_WAIT_V(2); PG8_BAR;
        PG8_STAGE(PG8_SB(1, 0), cB + kstep, voffB); PG8_STAGE(PG8_SA(1, 0), cA + kstep, voffA); PG8_STAGE(PG8_SB(1, 1), cB + hstep + kstep, voffB);
        PG8_WAIT_V(6); PG8_BAR;
    } else {
        PG8_STAGE(PG8_SB(0, 0), cB, voffB); PG8_STAGE(PG8_SA(0, 0), cA, voffA); PG8_STAGE(PG8_SB(0, 1), cB + hstep, voffB); PG8_STAGE(PG8_SA(0, 1), cA + hstep, voffA);
        if (wr == 1) PG8_BAR;
        PG8_WAIT_V(4); PG8_BAR;
        PG8_STAGE(PG8_SB(1, 0), cB + kstep, voffB); PG8_STAGE(PG8_SA(1, 0), cA + kstep, voffA); PG8_STAGE(PG8_SB(1, 1), cB + hstep + kstep, voffB);
        PG8_WAIT_V(6); PG8_BAR;
    }
    for (;;) {
        const bool has_next = S.next(ui + 1, nxt);
        const char* nA = has_next ? (const char*)g.A + (size_t)nxt.pm * tstep : cA; const char* nB = has_next ? (const char*)g.Bt + (size_t)nxt.pn * tstep : cB;
#pragma nounroll
        for (int t = 0; t < nt; t += 2) {
            const bool last = (t == nt - 2);
            const char* a1 = cA + (size_t)(t + 1) * kstep;
            const char* a2 = last ? nA : cA + (size_t)(t + 2) * kstep; const char* b2 = last ? nB : cB + (size_t)(t + 2) * kstep;
            const char* a3 = a2 + kstep; const char* b3 = b2 + kstep;
            if (last && has_next) S.a_ready(nxt);
            if (last) E.prefetch(pre, cur, wr, wc, fr, fq);
            if constexpr (SP2) {
            PG8_LDB(B0, 0, 0); PG8_LDB(B1, 0, 1); PG8_SCHED; PG8_LDA(At, 0, 0); PG8_STAGE(PG8_SA(1, 1), a1 + hstep, voffA);
            if (PG8_RELAX_B && t == 0 && ui > 0) PG8_WAIT_VN(8 + Epi::NST); else PG8_WAIT_V(8); PG8_WAIT_L(0); PG8_BAR; if (t == 0) { PG8_MMAZ(0, 0, At, B0); PG8_MMAZ(0, 1, At, B1); } else { PG8_MMA(0, 0, At, B0); PG8_MMA(0, 1, At, B1); } PG8_BAR; PG8_SCHED;
            PG8_LDA(At, 0, 1); PG8_STAGE(PG8_SB(0, 0), b2, voffB); PG8_STAGE(PG8_SB(0, 1), b2 + hstep, voffB); PG8_STAGE(PG8_SA(0, 0), a2, voffA);
            if (PG8_RELAX_B && t == 0 && ui > 0) PG8_WAIT_VN(8 + Epi::NST); else PG8_WAIT_V(8); PG8_WAIT_L(0); PG8_BAR; if (t == 0) { PG8_MMAZ(1, 0, At, B0); PG8_MMAZ(1, 1, At, B1); } else { PG8_MMA(1, 0, At, B0); PG8_MMA(1, 1, At, B1); } PG8_BAR; PG8_SCHED;
            PG8_LDB(B0, 1, 0); PG8_LDB(B1, 1, 1); PG8_SCHED; PG8_LDA(At, 1, 0); PG8_STAGE(PG8_SA(0, 1), a2 + hstep, voffA);
            PG8_WAIT_V(8); PG8_WAIT_L(0); PG8_BAR; PG8_MMA(0, 0, At, B0); PG8_MMA(0, 1, At, B1); PG8_BAR; PG8_SCHED;
            PG8_LDA(At, 1, 1); PG8_STAGE(PG8_SB(1, 0), b3, voffB); PG8_STAGE(PG8_SB(1, 1), b3 + hstep, voffB); PG8_STAGE(PG8_SA(1, 0), a3, voffA);
            PG8_WAIT_V(8); PG8_WAIT_L(0); PG8_BAR; PG8_MMA(1, 0, At, B0); PG8_MMA(1, 1, At, B1); PG8_BAR; PG8_SCHED;
            } else {
            PG8_LDB(B0, 0, 0); PG8_SCHED; PG8_LDA(At, 0, 0); PG8_STAGE(PG8_SA(1, 1), a1 + hstep, voffA);
            PG8_WAIT_L(8); PG8_BAR; PG8_WAIT_L(0); PG8_MMA(0, 0, At, B0); PG8_BAR; PG8_SCHED;
            PG8_LDB(B1, 0, 1); PG8_STAGE(PG8_SB(0, 0), b2, voffB);
            PG8_BAR; PG8_WAIT_L(0); PG8_MMA(0, 1, At, B1); PG8_BAR;
            PG8_LDA(At, 0, 1); PG8_STAGE(PG8_SA(0, 0), a2, voffA);
            PG8_BAR; PG8_WAIT_L(0); PG8_MMA(1, 0, At, B0); PG8_BAR; PG8_SCHED;
            PG8_STAGE(PG8_SB(0, 1), b2 + hstep, voffB);
            PG8_WAIT_V(6); PG8_BAR; PG8_MMA(1, 1, At, B1); PG8_BAR;
            PG8_LDB(B0, 1, 0); PG8_SCHED; PG8_LDA(At, 1, 0); PG8_STAGE(PG8_SA(0, 1), a2 + hstep, voffA);
            PG8_WAIT_L(8); PG8_BAR; PG8_WAIT_L(0); PG8_MMA(0, 0, At, B0); PG8_BAR; PG8_SCHED;
            PG8_LDB(B1, 1, 1); PG8_STAGE(PG8_SB(1, 0), b3, voffB);
            PG8_BAR; PG8_WAIT_L(0); PG8_MMA(0, 1, At, B1); PG8_BAR;
            PG8_LDA(At, 1, 1); PG8_STAGE(PG8_SA(1, 0), a3, voffA);
            PG8_BAR; PG8_WAIT_L(0); PG8_MMA(1, 0, At, B0); PG8_BAR; PG8_SCHED;
            PG8_STAGE(PG8_SB(1, 1), b3 + hstep, voffB);
            PG8_WAIT_V(6); PG8_BAR; PG8_MMA(1, 1, At, B1); PG8_BAR;
            }
        }
        E.preload(pre, cur, wr, wc, fr, fq);
        asm volatile("s_nop 15\n\ts_nop 15" ::: "memory");
        if constexpr (ALIGN_EPI) { if (wr == 0) PG8_BAR; }
        if constexpr (!Epi::AFTER_DRAIN) { E(acc, cur, wr, wc, fr, fq, pre); S.done(cur); }
        if (!has_next) break;
#pragma unroll
        for (int a = 0; a < 2; ++a)
#pragma unroll
            for (int b = 0; b < 2; ++b)
#pragma unroll
                for (int m = 0; m < 4; ++m)
#pragma unroll
                    for (int n = 0; n < 2; ++n) (void)0;
        cur = nxt; cA = nA; cB = nB; ++ui;
        if constexpr (ALIGN_EPI) { if (wr == 1) PG8_BAR; }
    }
    PG8_WAIT_V(0);
    if constexpr (!ALIGN_EPI) { if (wr == 0) PG8_BAR; }
    PG8_BAR;
    if constexpr (Epi::AFTER_DRAIN) { E.fused(acc, cur, wr, wc, fr, fq, lds, wid, lane); S.done(cur); }
#undef PG8_SA
#undef PG8_SB
#undef PG8_STAGE
#undef PG8_LDA
#undef PG8_LDB
#undef PG8_MMA
#undef PG8_MMAZ
#undef PG8_WAIT_V
#undef PG8_WAIT_VN
#undef PG8_WAIT_L
#undef PG8_BAR
#undef PG8_SCHED
}
template <class Epi, class Sched>
__device__ __forceinline__ void gemm_phase_gather8(PG8_LAS unsigned char* lds, const Gemm g, const Sched& S, const Epi& E, const int wave_in) {
    unsigned z_ = 0u; asm volatile("" : "+v"(z_)); const int tid_ = (int)__builtin_amdgcn_mbcnt_hi(~0u, __builtin_amdgcn_mbcnt_lo(~0u, z_)) + 64 * wave_in;
    const int tid = tid_, wid = __builtin_amdgcn_readfirstlane(tid >> 6), lane = tid & 63, wr = wid >> 2, wc = wid & 3, fr = lane & 15, fq = lane >> 4;
    constexpr bool ALIGN_EPI = true, SP2 = true;
    const int K = g.K, nt = K / (2 * BK);
    unsigned voffB[2]; int RA0; unsigned CA0;
#pragma unroll
    for (int i = 0; i < 2; ++i) { int R, C; stage_rc(tid * 16 + i * 8192, R, C); const int Rb = Epi::PERM ? ((R & ~31) + perm32(R & 31)) : R;
        if (i == 0) { RA0 = R; CA0 = (unsigned)C * 2u; } voffB[i] = (unsigned)(Rb * K + C * 2); }
    unsigned ro[2], rn[2][2];
    const size_t kstep = (size_t)(BK * 2);
    const size_t hstep = (size_t)HALF * K;
    const size_t tstep = 2 * hstep;
    const unsigned ldsw = (unsigned)wid * 1024u;
    const int aoff = lds_byte(wr * 64 + fr, fq * 8), boff = lds_byte(wc * 32 + fr, fq * 8);
#define PG8_SA(b, h) (((b) * 2 + (h)) * HTB)
#define PG8_SB(b, h) ((4 + (b) * 2 + (h)) * HTB)
#define PG8_STAGE(bufoff, gbase, voff) do { _Pragma("unroll") for (int _i = 0; _i < 2; ++_i) \
        __builtin_amdgcn_global_load_lds((const unsigned*)((const char*)(gbase) + (voff)[_i]), (PG8_LAS unsigned*)(lds + (bufoff) + ldsw + _i * 8192), 16, 0, 0); } while (0)
#define PG8_STAGE_G(bufoff, kbyte, pk) do { _Pragma("unroll") for (int _i = 0; _i < 2; ++_i) { const unsigned _row = _i ? ((pk) >> 16) : ((pk) & 0xffffu); \
        __builtin_amdgcn_global_load_lds((const unsigned*)((const char*)g.A + (kbyte) + (_row * (unsigned)K + CA0)), (PG8_LAS unsigned*)(lds + (bufoff) + ldsw + _i * 8192), 16, 0, 0); } } while (0)
#define PG8_LDA(dst, b, h) do { _Pragma("unroll") for (int m = 0; m < 4; ++m) { const u32x4 lo_ = *(const PG8_LAS u32x4*)(lds + PG8_SA(b, h) + aoff + m * 2048), hi_ = *(const PG8_LAS u32x4*)(lds + PG8_SA(b, h) + aoff + m * 2048 + 1024); dst[m] = (v8i_t){(int)lo_.x, (int)lo_.y, (int)lo_.z, (int)lo_.w, (int)hi_.x, (int)hi_.y, (int)hi_.z, (int)hi_.w}; } } while (0)
#define PG8_LDB(dst, b, h) do { _Pragma("unroll") for (int n = 0; n < 2; ++n) { const u32x4 lo_ = *(const PG8_LAS u32x4*)(lds + PG8_SB(b, h) + boff + n * 2048), hi_ = *(const PG8_LAS u32x4*)(lds + PG8_SB(b, h) + boff + n * 2048 + 1024); dst[n] = (v8i_t){(int)lo_.x, (int)lo_.y, (int)lo_.z, (int)lo_.w, (int)hi_.x, (int)hi_.y, (int)hi_.z, (int)hi_.w}; } } while (0)
#define PG8_MMA(ai, bj, At, Bt) do { __builtin_amdgcn_s_setprio(1); _Pragma("unroll") for (int m = 0; m < 4; ++m) _Pragma("unroll") for (int n = 0; n < 2; ++n) \
        asm volatile("v_mfma_f32_16x16x128_f8f6f4 %0, %1, %2, %0" : "+v"(acc[ai][bj][m][n]) : "v"(Bt[n]), "v"(At[m])); __builtin_amdgcn_s_setprio(0); } while (0)
#define PG8_MMAZ(ai, bj, At, Bt) do { __builtin_amdgcn_s_setprio(1); _Pragma("unroll") for (int m = 0; m < 4; ++m) _Pragma("unroll") for (int n = 0; n < 2; ++n) \
        asm volatile("v_mfma_f32_16x16x128_f8f6f4 %0, %1, %2, 0" : "=v"(acc[ai][bj][m][n]) : "v"(Bt[n]), "v"(At[m])); __builtin_amdgcn_s_setprio(0); } while (0)
#define PG8_WAIT_V(n) asm volatile("s_waitcnt vmcnt(" #n ")" ::: "memory")
#define PG8_WAIT_VN(n) asm volatile("s_waitcnt vmcnt(%0)" :: "n"(n) : "memory")
#define PG8_WAIT_L(n) asm volatile("s_waitcnt lgkmcnt(" #n ")" ::: "memory")
#define PG8_BAR __builtin_amdgcn_s_barrier()
#define PG8_SCHED __builtin_amdgcn_sched_barrier(0)
#if defined(MK_K8_PROBE)
    long long k8_f0 = 0; bool k8_w = false; if (blockIdx.x == MK_K8_WG && tid == 0) { mk_probe_site = mk_probe_site + 1; k8_w = (mk_probe_site == MK_K8_SITE); k8_f0 = clock64(); }
    long long k8_prev = 0;
#endif
#if defined(MK_K8_PROBE)
    unsigned k8_a = 0u; bool k8_u = false;
#define K8_CK() ((unsigned)__builtin_readcyclecounter())
#if MK_K8_FINE == 1
#define K8_SPH(m0, m1) do { if (k8_u) { const unsigned t0_ = K8_CK(); PG8_WAIT_V(8); k8_a += K8_CK() - t0_; } else PG8_WAIT_V(8); PG8_WAIT_L(0); PG8_BAR; m0; m1; PG8_BAR; PG8_SCHED; } while (0)
#elif MK_K8_FINE == 2
#define K8_SPH(m0, m1) do { PG8_WAIT_V(8); PG8_WAIT_L(0); if (k8_u) { const unsigned t0_ = K8_CK(); PG8_BAR; k8_a += K8_CK() - t0_; } else PG8_BAR; m0; m1; PG8_BAR; PG8_SCHED; } while (0)
#elif MK_K8_FINE == 3
#define K8_SPH(m0, m1) do { PG8_WAIT_V(8); PG8_WAIT_L(0); PG8_BAR; const unsigned t0_ = k8_u ? K8_CK() : 0u; m0; m1; if (k8_u) k8_a += K8_CK() - t0_; PG8_BAR; PG8_SCHED; } while (0)
#elif MK_K8_FINE == 4
#define K8_SPH(m0, m1) do { PG8_WAIT_V(8); PG8_WAIT_L(0); PG8_BAR; m0; m1; if (k8_u) { const unsigned t0_ = K8_CK(); PG8_BAR; k8_a += K8_CK() - t0_; } else PG8_BAR; PG8_SCHED; } while (0)
#else
#define K8_SPH(m0, m1) do { PG8_WAIT_V(8); PG8_WAIT_L(0); PG8_BAR; m0; m1; PG8_BAR; PG8_SCHED; } while (0)
#endif
#else
#define K8_SPH(m0, m1) do { PG8_WAIT_V(8); PG8_WAIT_L(0); PG8_BAR; m0; m1; PG8_BAR; PG8_SCHED; } while (0)
#endif
#define K8_SPH0(m0, m1) do { if (PG8_RELAX_C && ui > 0) PG8_WAIT_VN(8 + Epi::NST); else PG8_WAIT_V(8); PG8_WAIT_L(0); PG8_BAR; m0; m1; PG8_BAR; PG8_SCHED; } while (0)
    Unit cur, nxt; int ui = 0;
    if (!S.next(0, cur)) return;
    f32x4 acc[2][2][4][2];
#pragma unroll
    for (int a = 0; a < 2; ++a)
#pragma unroll
        for (int b = 0; b < 2; ++b)
#pragma unroll
            for (int m = 0; m < 4; ++m)
#pragma unroll
                for (int n = 0; n < 2; ++n) (void)0;
    v8i_t At[4], B0[2], B1[2];
    typename Epi::Pre pre;
    const char* cB = (const char*)g.Bt + (size_t)cur.pn * tstep;
    S.a_ready(cur);
    S.rows(cur, RA0, rn); ro[0] = rn[0][0] | (rn[0][1] << 16); ro[1] = rn[1][0] | (rn[1][1] << 16);
    if constexpr (SP2) {
        PG8_STAGE(PG8_SB(0, 0), cB, voffB); PG8_STAGE(PG8_SB(0, 1), cB + hstep, voffB); PG8_STAGE_G(PG8_SA(0, 0), 0, ro[0]); PG8_STAGE_G(PG8_SA(0, 1), 0, ro[1]);
        if (wr == 1) PG8_BAR;
        PG8_WAIT_V(2); PG8_BAR;
        PG8_STAGE(PG8_SB(1, 0), cB + kstep, voffB); PG8_STAGE_G(PG8_SA(1, 0), kstep, ro[0]); PG8_STAGE(PG8_SB(1, 1), cB + hstep + kstep, voffB);
        PG8_WAIT_V(6); PG8_BAR;
    }
    for (;;) {
        const bool has_next = S.next(ui + 1, nxt);
        const char* nB = has_next ? (const char*)g.Bt + (size_t)nxt.pn * tstep : cB;
#if defined(MK_K8_PROBE)
        k8_u = (blockIdx.x == MK_K8_WG) && (ui == MK_K8_UNIT) && (MK_K8_FINE != 0); long long k8_t0 = 0; const bool k8_on = k8_w && (ui == MK_K8_UNIT); if (k8_on) { k8_t0 = clock64(); mk_probe[27] = (float)(k8_t0 - k8_prev); } const bool k8_on1 = k8_w && (ui == MK_K8_UNIT - 1);
#endif
#pragma nounroll
        for (int t = 0; t < nt; t += 2) {
            const bool last = (t == nt - 2);
            const size_t k1 = (size_t)(t + 1) * kstep, k2 = last ? (size_t)0 : (size_t)(t + 2) * kstep, k3 = k2 + kstep;
            const char* b2 = last ? nB : cB + (size_t)(t + 2) * kstep; const char* b3 = b2 + kstep;
            if (t == nt - 4 && has_next) S.rows(nxt, RA0, rn);
            const unsigned c1 = ro[1];
            unsigned s0 = ro[0], s1 = ro[1];
            if (last && has_next) { unsigned q0 = rn[0][0], q1 = rn[0][1], q2 = rn[1][0], q3 = rn[1][1]; asm volatile("" : "+v"(q0), "+v"(q1), "+v"(q2), "+v"(q3));
                s0 = q0 | (q1 << 16); s1 = q2 | (q3 << 16); ro[0] = s0; ro[1] = s1; }
            if (last && has_next) S.a_ready(nxt);
            if (last) E.prefetch(pre, cur, wr, wc, fr, fq);
            if constexpr (SP2) {
            PG8_LDB(B0, 0, 0); PG8_LDB(B1, 0, 1); PG8_SCHED; PG8_LDA(At, 0, 0); PG8_STAGE_G(PG8_SA(1, 1), k1, c1);
            if (t == 0) K8_SPH0(PG8_MMAZ(0, 0, At, B0), PG8_MMAZ(0, 1, At, B1)); else K8_SPH(PG8_MMA(0, 0, At, B0), PG8_MMA(0, 1, At, B1));
            PG8_LDA(At, 0, 1); PG8_STAGE(PG8_SB(0, 0), b2, voffB); PG8_STAGE(PG8_SB(0, 1), b2 + hstep, voffB); PG8_STAGE_G(PG8_SA(0, 0), k2, s0);
            if (t == 0) K8_SPH0(PG8_MMAZ(1, 0, At, B0), PG8_MMAZ(1, 1, At, B1)); else K8_SPH(PG8_MMA(1, 0, At, B0), PG8_MMA(1, 1, At, B1));
            PG8_LDB(B0, 1, 0); PG8_LDB(B1, 1, 1); PG8_SCHED; PG8_LDA(At, 1, 0); PG8_STAGE_G(PG8_SA(0, 1), k2, s1);
            K8_SPH(PG8_MMA(0, 0, At, B0), PG8_MMA(0, 1, At, B1));
            PG8_LDA(At, 1, 1); PG8_STAGE(PG8_SB(1, 0), b3, voffB); PG8_STAGE(PG8_SB(1, 1), b3 + hstep, voffB); PG8_STAGE_G(PG8_SA(1, 0), k3, s0);
            K8_SPH(PG8_MMA(1, 0, At, B0), PG8_MMA(1, 1, At, B1));
            }
        }
        E.preload(pre, cur, wr, wc, fr, fq);
        asm volatile("s_nop 15\n\ts_nop 15" ::: "memory");
#if defined(MK_K8_PROBE)
        long long k8_t1 = 0; if (k8_on) k8_t1 = clock64();
#endif
        if constexpr (ALIGN_EPI) { if (wr == 0) PG8_BAR; }
        if constexpr (!Epi::AFTER_DRAIN) { E(acc, cur, wr, wc, fr, fq, pre); S.done(cur); }
#if defined(MK_K8_PROBE)
        if (k8_on) { const long long k8_t2 = clock64(); mk_probe[24] = (float)(k8_t1 - k8_t0); mk_probe[25] = (float)(k8_t2 - k8_t1);  mk_probe[20] = (float)k8_a; }
        if (k8_on1) k8_prev = clock64();
#endif
        if (!has_next) break;
#pragma unroll
        for (int a = 0; a < 2; ++a)
#pragma unroll
            for (int b = 0; b < 2; ++b)
#pragma unroll
                for (int m = 0; m < 4; ++m)
#pragma unroll
                    for (int n = 0; n < 2; ++n) (void)0;
        cur = nxt; cB = nB; ++ui;
        if constexpr (ALIGN_EPI) { if (wr == 1) PG8_BAR; }
    }
#if defined(MK_K8_PROBE)
    if (k8_w) { mk_probe[26] = (float)(clock64() - k8_f0); mk_probe[28] = (float)(ui + 1); }
#endif
    PG8_WAIT_V(0);
    if constexpr (!ALIGN_EPI) { if (wr == 0) PG8_BAR; }
    PG8_BAR;
    if constexpr (Epi::AFTER_DRAIN) { E.fused(acc, cur, wr, wc, fr, fq, lds, wid, lane); S.done(cur); }
#undef PG8_SA
#undef PG8_SB
#undef PG8_STAGE
#undef PG8_STAGE_G
#undef PG8_LDA
#undef PG8_LDB
#undef PG8_MMA
#undef PG8_MMAZ
#undef PG8_WAIT_V
#undef PG8_WAIT_VN
#undef PG8_WAIT_L
#undef PG8_BAR
#undef PG8_SCHED
#undef K8_SPH
#undef K8_SPH0
}
}

#ifndef PG8_SP2
#define PG8_SP2 true
#endif
#ifndef PG8_ALIGN
#define PG8_ALIGN true
#endif

constexpr int NTOK = 65536, DM = 1024, NCOL = 7680, SEQ = 4096, NBATCH = 16, HTOK = 32768, MEMLEN = 256;
constexpr int C_HQ = 0, C_HF = 1024, C_HI = 2048, C_HG = 3072, C_SQ = 4096, C_SK = 5120, C_SV = 5376, C_GA = 5632, C_GB = 6656;
constexpr size_t PJ_HQ = 0, PJ_HF = 64 * ((size_t)1 << 20), PJ_HI = 128 * ((size_t)1 << 20), PJ_HG = 192 * ((size_t)1 << 20), PJ_SQ = 256 * ((size_t)1 << 20), PJ_SK = 320 * ((size_t)1 << 20), PJ_SV = 336 * ((size_t)1 << 20), PJ_GA = 352 * ((size_t)1 << 20), PJ_GB = 416 * ((size_t)1 << 20);
constexpr int NEXP = 32, TOPK = 4, CAPH = HTOK * TOPK + NEXP * 256;
constexpr float RMS_EPS = 1e-5f;
constexpr size_t MiB = (size_t)1 << 20;
constexpr size_t WS_ZERO_BYTES = 2 * MiB;
constexpr size_t WS_GCNT = 1 * MiB;
constexpr int CW_TMO = 0, CW_BAR = 4096;
constexpr size_t WS_LB = 2 * MiB, WS_LUT = 2 * MiB + 4096, WS_BLKE = 2 * MiB + 16384, WS_NBT = 2 * MiB + 32768;
constexpr size_t WS_TOPE = 3 * MiB, WS_TOPG = 4 * MiB, WS_TOPR = 5 * MiB, WS_TOPP = 6 * MiB, WS_RGATE = 7 * MiB, WS_RRSTD = 8 * MiB, WS_D12 = 10 * MiB;
constexpr size_t WS_WIN = 16 * MiB, WS_WA = 31 * MiB, WS_WB = 33 * MiB, WS_WMIX = 35 * MiB, WS_WQ = 37 * MiB, WS_WK = 39 * MiB, WS_WV = 41 * MiB, WS_WO = 43 * MiB, WS_WR = 45 * MiB;
constexpr size_t WS_MEMBF = 46 * MiB, WS_KX = 54 * MiB, WS_VXT = 62 * MiB;
constexpr size_t WS_XBF = 72 * MiB;
constexpr size_t WS_PROJ = 200 * MiB, WS_OA = 680 * MiB, WS_OB = 744 * MiB, WS_TM = 808 * MiB;
constexpr size_t WS_Q = 664 * MiB, WS_O = 792 * MiB;
constexpr size_t WS_X1F8 = 872 * MiB;
constexpr size_t WS_X2F8 = 296 * MiB;
constexpr size_t WS_WD = 200 * MiB, WS_WGU = 232 * MiB, WS_Y1 = 232 * MiB, WS_ACT = 392 * MiB, WS_Y = 664 * MiB,     WS_SSQ1 = 936 * MiB, WS_SSQ2 = 940 * MiB, WS_RTOK = 944 * MiB, WS_RGATE2 = 952 * MiB, WS_RRSTD2 = 960 * MiB, WS_END = 968 * MiB;
constexpr size_t ACT_HALF = (size_t)CAPH * 1024;
constexpr size_t OUT_US = 128 * MiB;

#define GAS __attribute__((address_space(1)))
#define LAS __attribute__((address_space(3)))
typedef unsigned short bf16;
typedef unsigned v4u __attribute__((ext_vector_type(4)));
typedef unsigned v2u __attribute__((ext_vector_type(2)));
typedef float f32x4 __attribute__((ext_vector_type(4)));
typedef short bf16x8 __attribute__((ext_vector_type(8)));
typedef short s16x4 __attribute__((ext_vector_type(4)));
#define RLX_AGENT __ATOMIC_RELAXED, __HIP_MEMORY_SCOPE_AGENT
#define LDS_WAIT() asm volatile("s_waitcnt lgkmcnt(0)" ::: "memory")
#define CFENCE() asm volatile("" ::: "memory")
__device__ __forceinline__ unsigned f2bf(float f) { unsigned u = __builtin_bit_cast(unsigned, f); return (u + 0x7fffu + ((u >> 16) & 1u)) >> 16; }
typedef float f32x2_t __attribute__((ext_vector_type(2))); typedef __bf16 bf16x2_t __attribute__((ext_vector_type(2)));
__device__ __forceinline__ unsigned pk2(float lo, float hi) { f32x2_t v = {lo, hi}; bf16x2_t b = __builtin_convertvector(v, bf16x2_t); return __builtin_bit_cast(unsigned, b); }
__device__ __forceinline__ unsigned pk4f8(float a, float b, float c, float d) { int r = 0; r = __builtin_amdgcn_cvt_pk_fp8_f32(a, b, r, false); r = __builtin_amdgcn_cvt_pk_fp8_f32(c, d, r, true); return (unsigned)r; }
constexpr float F8_WSCALE = 64.f, F8_WINV = 1.f / 64.f;
__device__ __forceinline__ float bflo(unsigned w) { return __builtin_bit_cast(float, w << 16); }
__device__ __forceinline__ float bfhi(unsigned w) { return __builtin_bit_cast(float, w & 0xffff0000u); }
__device__ __forceinline__ float fexp(float x) { return __builtin_amdgcn_exp2f(x * 1.4426950408889634f); }
__device__ __forceinline__ float flog(float x) { return __builtin_amdgcn_logf(x) * 0.6931471805599453f; }
__device__ __forceinline__ float sigm(float x) { return __builtin_amdgcn_rcpf(1.f + fexp(-x)); }
__device__ __forceinline__ float shx(float v, int mask, int lane) { return __builtin_bit_cast(float, __builtin_amdgcn_ds_bpermute((lane ^ mask) << 2, __builtin_bit_cast(int, v))); }
__device__ __forceinline__ float wave_sum(float v, int lane) {
#pragma unroll
    for (int o = 1; o < 64; o <<= 1) v += shx(v, o, lane);
    return v;
}
__device__ __forceinline__ f32x4 mfma16(bf16x8 a, bf16x8 b, f32x4 c) { return __builtin_amdgcn_mfma_f32_16x16x32_bf16(a, b, c, 0, 0, 0); }
__device__ __forceinline__ s16x4 vtr(const LAS unsigned char* p) { return __builtin_bit_cast(s16x4, __builtin_amdgcn_ds_read_tr16_b64_v4i16((LAS s16x4*)p)); }
__device__ __forceinline__ bf16x8 cat8(s16x4 lo, s16x4 hi) { return __builtin_shufflevector(lo, hi, 0, 1, 2, 3, 4, 5, 6, 7); }
__device__ __forceinline__ bf16x8 pack8(f32x4 a, f32x4 b) { v4u w; w.x = pk2(a[0], a[1]); w.y = pk2(a[2], a[3]); w.z = pk2(b[0], b[1]); w.w = pk2(b[2], b[3]); return __builtin_bit_cast(bf16x8, w); }
__device__ __forceinline__ float rstd16(const float* ssqp, size_t row) { const f32x4* p = (const f32x4*)(ssqp + row * 16); const f32x4 a = p[0], b = p[1], c = p[2], d = p[3];
    const float s = ((a[0] + a[1]) + (a[2] + a[3])) + ((b[0] + b[1]) + (b[2] + b[3])) + ((c[0] + c[1]) + (c[2] + c[3])) + ((d[0] + d[1]) + (d[2] + d[3])); return rsqrtf(s * (1.f / 1024.f) + 1e-5f); }
__device__ __forceinline__ unsigned ld_agent(const unsigned* p) { return __hip_atomic_load(p, RLX_AGENT); }


#define XB_TMO      128
#define XB_XCNT(j)  (256  + 64 * (j))
#define XB_XSUB(j)  (1280 + 64 * (j))
#define XB_XGEN(j)  (2304 + 64 * (j))
#define XB_TOP      3328
#define XB_TOPGEN   3392
#define XCD_BAR_WORDS 3456
#define XB_SPIN_CAP (1u << 18)

__device__ __forceinline__ unsigned xb_ld(unsigned* p)              { return __hip_atomic_load(p, __ATOMIC_RELAXED, __HIP_MEMORY_SCOPE_AGENT); }
__device__ __forceinline__ unsigned xb_add(unsigned* p, unsigned v) { return __hip_atomic_fetch_add(p, v, __ATOMIC_RELAXED, __HIP_MEMORY_SCOPE_AGENT); }
__device__ __forceinline__ unsigned xb_xcc_id() { return (unsigned)__builtin_amdgcn_s_getreg((3 << 11) | 20) & 0xFu; }
#define XB_SPIN(cond, bar) do { unsigned _sp = 0; while (cond) { __builtin_amdgcn_s_sleep(1); \
    if ((++_sp & 255u) == 0u) { if (xb_ld(&(bar)[XB_TMO])) break; if (_sp > XB_SPIN_CAP) { atomicAdd(&(bar)[XB_TMO], 1u); break; } } } } while (0)

struct XcdBarrier {
    unsigned* bar; unsigned x; int t0;
    volatile LAS unsigned* st;
};

__device__ __forceinline__ bool xb_is_t0(int wave) { return wave == 0 && __builtin_amdgcn_mbcnt_hi(~0u, __builtin_amdgcn_mbcnt_lo(~0u, 0u)) == 0u; }
__device__ __forceinline__ XcdBarrier xcd_barrier_post(unsigned* bar, volatile LAS unsigned* st, int wave) {
    XcdBarrier b; b.bar = bar; b.x = xb_xcc_id(); b.st = st; b.t0 = wave;
    if (xb_is_t0(wave)) (void)xb_add(&bar[XB_XCNT(b.x)], 1u);
    return b;
}
__device__ __forceinline__ void xcd_barrier_complete(unsigned* bar, unsigned x, unsigned& nloc, unsigned& nx) {
    const unsigned G = gridDim.x * gridDim.y * gridDim.z;
    unsigned sum, cnt, mine, sp = 0u;
    for (;;) {
        sum = 0u; cnt = 0u; mine = 0u;
#pragma unroll
        for (unsigned j = 0; j < 16; ++j) { const unsigned c = xb_ld(&bar[XB_XCNT(j)]); sum += c; cnt += (c > 0u) ? 1u : 0u; mine = (j == x) ? c : mine; }
        if (sum == G) break;
        __builtin_amdgcn_s_sleep(1);
        if ((++sp & 255u) == 0u) { if (xb_ld(&bar[XB_TMO])) break; if (sp > XB_SPIN_CAP) { atomicAdd(&bar[XB_TMO], 1u); break; } }
    }
    nloc = mine > 0u ? mine : 1u; nx = cnt > 0u ? cnt : 1u;
}

__device__ __forceinline__ void xcd_barrier(const XcdBarrier& b) {
    asm volatile("s_waitcnt vmcnt(0)" ::: "memory");
    __syncthreads();
    if (xb_is_t0(b.t0)) {
        unsigned* bar = b.bar;
        __builtin_amdgcn_s_waitcnt(0);
        unsigned nloc = b.st[0], nx = b.st[1];
        if (nloc == 0u) { xcd_barrier_complete(bar, b.x, nloc, nx); b.st[0] = nloc; b.st[1] = nx; }
        const unsigned old = xb_add(&bar[XB_XSUB(b.x)], 1u);
        const unsigned gen = old / nloc;
        if (old + 1u == (gen + 1u) * nloc) {
            __builtin_amdgcn_fence(__ATOMIC_RELEASE, "agent");
            asm volatile("s_waitcnt vmcnt(0)" ::: "memory");
            const unsigned og = xb_add(&bar[XB_TOP], 1u);
            const unsigned tg = og / nx;
            if (og + 1u == (tg + 1u) * nx) xb_add(&bar[XB_TOPGEN], 1u);
            else XB_SPIN(xb_ld(&bar[XB_TOPGEN]) == tg, bar);
            __builtin_amdgcn_fence(__ATOMIC_ACQUIRE, "agent");
            xb_add(&bar[XB_XGEN(b.x)], 1u);
            asm volatile("s_waitcnt vmcnt(0)" ::: "memory");
        } else {
            XB_SPIN(xb_ld(&bar[XB_XGEN(b.x)]) == gen, bar);
            __builtin_amdgcn_fence(__ATOMIC_ACQUIRE, "agent");
            asm volatile("s_waitcnt vmcnt(0)" ::: "memory");
        }
    }
    __syncthreads();
}

struct Args {
    const float* in[25];
    float* out; unsigned char* ws;
    int ph_lo, ph_hi;
};

using pg8::Unit;
struct NoPre {};
struct EpiStore {
    static constexpr int NST = 16; static constexpr bool PERM = true, AFTER_DRAIN = false; typedef NoPre Pre;
    __device__ __forceinline__ void prefetch(Pre&, const Unit&, int, int, int, int) const {}
    __device__ __forceinline__ void preload(Pre&, const Unit&, int, int, int, int) const {}
    __device__ __forceinline__ void operator()(const f32x4 (&acc)[2][2][4][2], const Unit& u, int wr, int wc, int fr, int fq, const Pre&) const { (*this)(acc, u, wr, wc, fr, fq); }
    bf16* O; int ldc; const float* ssq; float scl;
    __device__ __forceinline__ void operator()(const f32x4 (&acc)[2][2][4][2], const Unit& u, int wr, int wc, int fr, int fq) const {
        const int row0 = u.pm * 256 + wr * 64 + fr, col0 = u.pn * 256 + wc * 32 + 8 * fq;
#pragma unroll
        for (int ai = 0; ai < 2; ++ai) { float sc[4];
#pragma unroll
            for (int m = 0; m < 4; ++m) sc[m] = (ssq ? rstd16(ssq, (size_t)(row0 + ai * 128 + m * 16)) : 1.f) * scl;
#pragma unroll
            for (int m = 0; m < 4; ++m) { const int row = row0 + ai * 128 + m * 16; bf16* rowp = O + (size_t)row * ldc + col0;
#pragma unroll
                for (int bj = 0; bj < 2; ++bj) { const f32x4 v0 = acc[ai][bj][m][0] * sc[m], v1 = acc[ai][bj][m][1] * sc[m];
                    v4u w; w.x = pk2(v0[0], v0[1]); w.y = pk2(v0[2], v0[3]); w.z = pk2(v1[0], v1[1]); w.w = pk2(v1[2], v1[3]);
                    __builtin_nontemporal_store(w, (v4u*)(rowp + bj * 128)); } } }
    }
};
struct EpiProj {
    static constexpr int NST = 16; static constexpr bool PERM = true, AFTER_DRAIN = false;
    unsigned char* pj; const float* lb;
    __device__ __forceinline__ void operator()(const f32x4 (&acc)[2][2][4][2], const Unit& u, int wr, int wc, int fr, int fq) const {
        const int row0 = u.pm * 256 + wr * 64 + fr, pn = u.pn;
        bf16* base[2]; unsigned rowmul, blmul;
        if (pn < 16) { const int T = pn >> 2; rowmul = 256u; blmul = 8u * 4096u * 256u;
#pragma unroll
            for (int bj = 0; bj < 2; ++bj) base[bj] = (bf16*)(pj + (size_t)T * (64u << 20) + (size_t)(2 * (pn & 3) + bj) * (4096u * 256u)) + wc * 32 + 8 * fq; }
        else if (pn < 20) { rowmul = 128u; blmul = 16u * 4096u * 128u;
#pragma unroll
            for (int bj = 0; bj < 2; ++bj) base[bj] = (bf16*)(pj + PJ_SQ + (size_t)(4 * (pn - 16) + 2 * bj + (wc >> 1)) * (4096u * 128u)) + (wc & 1) * 32 + 8 * fq; }
        else if (pn < 22) { rowmul = 128u; blmul = 4u * 4096u * 128u;
#pragma unroll
            for (int bj = 0; bj < 2; ++bj) base[bj] = (bf16*)(pj + (pn == 20 ? PJ_SK : PJ_SV) + (size_t)(2 * bj + (wc >> 1)) * (4096u * 128u)) + (wc & 1) * 32 + 8 * fq; }
        else { rowmul = 2048u; blmul = 4096u * 2048u;
#pragma unroll
            for (int bj = 0; bj < 2; ++bj) base[bj] = (bf16*)(pj + (pn < 26 ? PJ_GA : PJ_GB)) + ((pn - 22) & 3) * 256 + bj * 128 + wc * 32 + 8 * fq; }
        const int kind = pn < 16 ? (pn >> 2) : 2;
        f32x4 lbv[2][2];
        if (kind == 1) {
#pragma unroll
            for (int bj = 0; bj < 2; ++bj)
#pragma unroll
                for (int n = 0; n < 2; ++n) lbv[bj][n] = *(const f32x4*)(lb + (2 * (pn & 3) + bj) * 128 + wc * 32 + 8 * fq + 4 * n); }
#pragma unroll
        for (int ai = 0; ai < 2; ++ai)
#pragma unroll
            for (int m = 0; m < 4; ++m) { const int row = row0 + ai * 128 + m * 16; const size_t ro = (size_t)(row >> 12) * blmul + (size_t)(row & 4095) * rowmul;
#pragma unroll
                for (int bj = 0; bj < 2; ++bj) { f32x4 v[2] = {acc[ai][bj][m][0], acc[ai][bj][m][1]};
                    if (kind == 0 || kind == 3) {
#pragma unroll
                        for (int n = 0; n < 2; ++n)
#pragma unroll
                            for (int j = 0; j < 4; ++j) v[n][j] = v[n][j] * sigm(v[n][j]); }
                    else if (kind == 1) {
#pragma unroll
                        for (int n = 0; n < 2; ++n)
#pragma unroll
                            for (int j = 0; j < 4; ++j) v[n][j] = lbv[bj][n][j] + (1.f - lbv[bj][n][j]) * sigm(v[n][j]); }
                    v4u w; w.x = pk2(v[0][0], v[0][1]); w.y = pk2(v[0][2], v[0][3]); w.z = pk2(v[1][0], v[1][1]); w.w = pk2(v[1][2], v[1][3]);
                    *(v4u*)((unsigned char*)base[bj] + ro) = w; } }
    }
};
template <bool ADD> struct EpiGate {
    static constexpr int NST = 16; static constexpr bool PERM = true, AFTER_DRAIN = false;
    bf16* T; const bf16* gl; const float* bias;
    __device__ __forceinline__ void operator()(const f32x4 (&acc)[2][2][4][2], const Unit& u, int wr, int wc, int fr, int fq) const {
        const int row0 = u.pm * 256 + wr * 64 + fr, col0 = u.pn * 256 + wc * 32 + 8 * fq;
        f32x4 bv[2][2];
#pragma unroll
        for (int bj = 0; bj < 2; ++bj)
#pragma unroll
            for (int n = 0; n < 2; ++n) bv[bj][n] = *(const f32x4*)(bias + col0 + bj * 128 + 4 * n);
#pragma unroll
        for (int am = 0; am < 4; ++am) { const int ai = am >> 1, mh = am & 1; v4u gw[2][2], tw[2][2];
#pragma unroll
            for (int mm = 0; mm < 2; ++mm)
#pragma unroll
                for (int bj = 0; bj < 2; ++bj) { const int row = row0 + ai * 128 + (2 * mh + mm) * 16; gw[mm][bj] = *(const v4u*)(gl + (size_t)row * DM + col0 + bj * 128);
                    if (ADD) tw[mm][bj] = *(const v4u*)(T + (size_t)row * DM + col0 + bj * 128); }
#pragma unroll
            for (int mm = 0; mm < 2; ++mm)
#pragma unroll
                for (int bj = 0; bj < 2; ++bj) { const int m = 2 * mh + mm; const int row = row0 + ai * 128 + m * 16; const v4u g4 = gw[mm][bj]; float r[8];
                    r[0] = sigm(bflo(g4.x) + bv[bj][0][0]) * acc[ai][bj][m][0][0]; r[1] = sigm(bfhi(g4.x) + bv[bj][0][1]) * acc[ai][bj][m][0][1];
                    r[2] = sigm(bflo(g4.y) + bv[bj][0][2]) * acc[ai][bj][m][0][2]; r[3] = sigm(bfhi(g4.y) + bv[bj][0][3]) * acc[ai][bj][m][0][3];
                    r[4] = sigm(bflo(g4.z) + bv[bj][1][0]) * acc[ai][bj][m][1][0]; r[5] = sigm(bfhi(g4.z) + bv[bj][1][1]) * acc[ai][bj][m][1][1];
                    r[6] = sigm(bflo(g4.w) + bv[bj][1][2]) * acc[ai][bj][m][1][2]; r[7] = sigm(bfhi(g4.w) + bv[bj][1][3]) * acc[ai][bj][m][1][3];
                    if (ADD) { const v4u t4 = tw[mm][bj];
                        r[0] += bflo(t4.x); r[1] += bfhi(t4.x); r[2] += bflo(t4.y); r[3] += bfhi(t4.y); r[4] += bflo(t4.z); r[5] += bfhi(t4.z); r[6] += bflo(t4.w); r[7] += bfhi(t4.w); }
                    v4u w; w.x = pk2(r[0], r[1]); w.y = pk2(r[2], r[3]); w.z = pk2(r[4], r[5]); w.w = pk2(r[6], r[7]);
                    *(v4u*)(T + (size_t)row * DM + col0 + bj * 128) = w; } }
    }
};
template <bool BF> struct EpiResid {
    static constexpr int NST = 16; static constexpr bool PERM = true, AFTER_DRAIN = false; typedef NoPre Pre;
    __device__ __forceinline__ void prefetch(Pre&, const Unit&, int, int, int, int) const {}
    __device__ __forceinline__ void preload(Pre&, const Unit&, int, int, int, int) const {}
    __device__ __forceinline__ void operator()(const f32x4 (&acc)[2][2][4][2], const Unit& u, int wr, int wc, int fr, int fq, const Pre&) const { (*this)(acc, u, wr, wc, fr, fq); }
    const float* base; bf16* obf; float* ssq; unsigned char* f8; float scl;
    __device__ __forceinline__ void operator()(const f32x4 (&acc)[2][2][4][2], const Unit& u, int wr, int wc, int fr, int fq) const {
        const int row0 = u.pm * 256 + wr * 64 + fr, col0 = u.pn * 256 + wc * 32 + 8 * fq;
#pragma unroll
        for (int ai = 0; ai < 2; ++ai)
#pragma unroll
            for (int mh = 0; mh < 2; ++mh) { f32x4 b0[2][2], b1[2][2];
#pragma unroll
                for (int mm = 0; mm < 2; ++mm)
#pragma unroll
                    for (int bj = 0; bj < 2; ++bj) { const size_t off = (size_t)(row0 + ai * 128 + (2 * mh + mm) * 16) * DM + col0 + bj * 128;
                        if (BF) { const v4u bw = *(const v4u*)(obf + off); b0[mm][bj] = (f32x4){bflo(bw.x), bfhi(bw.x), bflo(bw.y), bfhi(bw.y)}; b1[mm][bj] = (f32x4){bflo(bw.z), bfhi(bw.z), bflo(bw.w), bfhi(bw.w)}; }
                        else { b0[mm][bj] = *(const f32x4*)(base + off); b1[mm][bj] = *(const f32x4*)(base + off + 4); } }
#pragma unroll
                for (int mm = 0; mm < 2; ++mm) { const int m = 2 * mh + mm; const int row = row0 + ai * 128 + m * 16; float ss = 0.f;
#pragma unroll
                    for (int bj = 0; bj < 2; ++bj) { const size_t off = (size_t)row * DM + col0 + bj * 128;
                        const f32x4 v0 = b0[mm][bj] + acc[ai][bj][m][0] * scl, v1 = b1[mm][bj] + acc[ai][bj][m][1] * scl;
                        v4u w; w.x = pk2(v0[0], v0[1]); w.y = pk2(v0[2], v0[3]); w.z = pk2(v1[0], v1[1]); w.w = pk2(v1[2], v1[3]);
                        *(v4u*)(obf + off) = w;
                        if (f8) { v2u q; q.x = pk4f8(v0[0], v0[1], v0[2], v0[3]); q.y = pk4f8(v1[0], v1[1], v1[2], v1[3]); *(v2u*)(f8 + off) = q; }
                        ss += ((v0[0] * v0[0] + v0[1] * v0[1]) + (v0[2] * v0[2] + v0[3] * v0[3])) + ((v1[0] * v1[0] + v1[1] * v1[1]) + (v1[2] * v1[2] + v1[3] * v1[3])); }
                    { const int ln_ = fr + 16 * fq; ss += shx(ss, 16, ln_); ss += shx(ss, 32, ln_); }
                    if (fq == 0) ssq[(size_t)row * 16 + (u.pn & 3) * 4 + wc] = ss; } }
    }
};
struct EpiSwiglu {
    static constexpr int NST = 8; static constexpr bool PERM = true, AFTER_DRAIN = false;
    unsigned char* act; const float* bgu; const float* row_rstd;
    struct Pre { float rs[2][4]; f32x4 bg[2], bl[2]; };
    __device__ __forceinline__ void prefetch(Pre& p, const Unit& u, int wr, int wc, int fr, int fq) const {
        const int e = u.pn >> 3, pnl = u.pn & 7, rr0 = wr * 64 + fr, cl0 = pnl * 128 + wc * 32 + 8 * fq;
#pragma unroll
        for (int ai = 0; ai < 2; ++ai)
#pragma unroll
            for (int m = 0; m < 4; ++m) p.rs[ai][m] = row_rstd[u.aux + rr0 + ai * 128 + m * 16];
        (void)e; (void)cl0;
    }
    __device__ __forceinline__ void preload(Pre& p, const Unit& u, int wr, int wc, int fr, int fq) const {
        const int e = u.pn >> 3, pnl = u.pn & 7, cl0 = pnl * 128 + wc * 32 + 8 * fq; (void)wr; (void)fr;
#pragma unroll
        for (int n = 0; n < 2; ++n) { p.bg[n] = *(const f32x4*)(bgu + e * 2048 + cl0 + 4 * n); p.bl[n] = *(const f32x4*)(bgu + e * 2048 + 1024 + cl0 + 4 * n); }
    }
    __device__ __forceinline__ void operator()(const f32x4 (&acc)[2][2][4][2], const Unit& u, int wr, int wc, int fr, int fq, const Pre& p) const {
        const int pnl = u.pn & 7;
        const int rr0 = wr * 64 + fr, cl0 = pnl * 128 + wc * 32 + 8 * fq;
        typedef float f32x2 __attribute__((ext_vector_type(2)));
        f32x4 bg[2], bl[2];
#pragma unroll
        for (int n = 0; n < 2; ++n) { bg[n] = p.bg[n]; bl[n] = p.bl[n] + 1.0f; }
#pragma unroll
        for (int ai = 0; ai < 2; ++ai)
#pragma unroll
            for (int m = 0; m < 4; ++m) { const int row = u.pm * 256 + rr0 + ai * 128 + m * 16; const float rs1 = p.rs[ai][m] * F8_WINV; const f32x2 rs = {rs1, rs1};
                float r[8];
#pragma unroll
                for (int n = 0; n < 2; ++n)
#pragma unroll
                    for (int jp = 0; jp < 2; ++jp) {
                        f32x2 gl = (f32x2){acc[ai][0][m][n][2 * jp], acc[ai][0][m][n][2 * jp + 1]} * rs + (f32x2){bg[n][2 * jp], bg[n][2 * jp + 1]};
                        f32x2 li = (f32x2){acc[ai][1][m][n][2 * jp], acc[ai][1][m][n][2 * jp + 1]} * rs + (f32x2){bl[n][2 * jp], bl[n][2 * jp + 1]};
                        gl = (f32x2){fminf(gl[0], 7.0f), fminf(gl[1], 7.0f)}; li = (f32x2){__builtin_amdgcn_fmed3f(li[0], -6.0f, 8.0f), __builtin_amdgcn_fmed3f(li[1], -6.0f, 8.0f)};
                        const f32x2 t = gl * (-1.702f * 1.4426950408889634f);
                        const f32x2 d = (f32x2){__builtin_amdgcn_exp2f(t[0]), __builtin_amdgcn_exp2f(t[1])} + 1.0f;
                        const f32x2 o = gl * (f32x2){__builtin_amdgcn_rcpf(d[0]), __builtin_amdgcn_rcpf(d[1])} * li;
                        r[n * 4 + 2 * jp] = o[0]; r[n * 4 + 2 * jp + 1] = o[1]; }
                v2u w; w.x = pk4f8(r[0], r[1], r[2], r[3]); w.y = pk4f8(r[4], r[5], r[6], r[7]);
                *(v2u*)(act + (size_t)row * DM + cl0) = w; }
    }
};
struct EpiDown {
    static constexpr int NST = 16; static constexpr bool PERM = true, AFTER_DRAIN = false;
    bf16* y; const float* bd; const float* row_gate;
    struct Pre { float gt[2][4]; f32x4 bv[2][2]; };
    __device__ __forceinline__ void prefetch(Pre& p, const Unit& u, int wr, int wc, int fr, int fq) const {
        const int e = u.pn >> 2, pnl = u.pn & 3, rr0 = wr * 64 + fr, col0 = pnl * 256 + wc * 32 + 8 * fq;
#pragma unroll
        for (int ai = 0; ai < 2; ++ai)
#pragma unroll
            for (int m = 0; m < 4; ++m) p.gt[ai][m] = row_gate[u.aux + rr0 + ai * 128 + m * 16];
        (void)e; (void)col0;
    }
    __device__ __forceinline__ void preload(Pre& p, const Unit& u, int wr, int wc, int fr, int fq) const {
        const int e = u.pn >> 2, pnl = u.pn & 3, col0 = pnl * 256 + wc * 32 + 8 * fq; (void)wr; (void)fr;
#pragma unroll
        for (int bj = 0; bj < 2; ++bj)
#pragma unroll
            for (int n = 0; n < 2; ++n) p.bv[bj][n] = *(const f32x4*)(bd + e * 1024 + col0 + bj * 128 + 4 * n);
    }
    __device__ __forceinline__ void operator()(const f32x4 (&acc)[2][2][4][2], const Unit& u, int wr, int wc, int fr, int fq, const Pre& p) const {
        const int pnl = u.pn & 3;
        const int rr0 = wr * 64 + fr, col0 = pnl * 256 + wc * 32 + 8 * fq;
        f32x4 bv[2][2];
#pragma unroll
        for (int bj = 0; bj < 2; ++bj)
#pragma unroll
            for (int n = 0; n < 2; ++n) bv[bj][n] = p.bv[bj][n];
#pragma unroll
        for (int ai = 0; ai < 2; ++ai)
#pragma unroll
            for (int m = 0; m < 4; ++m) { const int row = u.pm * 256 + rr0 + ai * 128 + m * 16;
#pragma unroll
                for (int bj = 0; bj < 2; ++bj) { const f32x4 v0 = (acc[ai][bj][m][0] * F8_WINV + bv[bj][0]) * p.gt[ai][m], v1 = (acc[ai][bj][m][1] * F8_WINV + bv[bj][1]) * p.gt[ai][m];
                    v4u w; w.x = pk2(v0[0], v0[1]); w.y = pk2(v0[2], v0[3]); w.z = pk2(v1[0], v1[1]); w.w = pk2(v1[2], v1[3]);
                    *(v4u*)(y + (size_t)row * DM + col0 + bj * 128) = w; } }
    }
};
struct GroupedOrder {
    int nunits, npn, G, c, half; const LAS unsigned* tab; const int* row_tok; int i0 = 0, i1 = 0x7fffffff;
    __device__ __forceinline__ bool next(int i, Unit& u) const {
        i += i0; if (i >= i1) return false;
        const int spx = G >> 3, xcd = c & 7, slot = c >> 3;
        const long L = ((long)i * 8 + xcd) * spx + slot; if (L >= nunits) return false;
        const int rb = (int)(L / npn), pn = (int)(L % npn);
        unsigned z_ = 0u; asm volatile("" : "+v"(z_)); const int l31 = (int)__builtin_amdgcn_mbcnt_hi(~0u, __builtin_amdgcn_mbcnt_lo(~0u, z_)) & 31;
        const unsigned st = tab[32 + l31], ct = tab[l31];
        const int e = __builtin_popcount((unsigned)__builtin_amdgcn_ballot_w64((unsigned)rb >= st)) - 1;
        const int j = rb - __builtin_amdgcn_readlane((int)st, e), cn = __builtin_amdgcn_readlane((int)ct, e) - 256 * j;
        u.pm = rb; u.pn = e * npn + pn; u.aux = (half * 32 + e) * HTOK + 256 * j; u.cnt = cn < 256 ? cn : 256; return true;
    }
    __device__ __forceinline__ void rows(const Unit& u, int RA0, unsigned (&rn)[2][2]) const {
#pragma unroll
        for (int h = 0; h < 2; ++h) { const int r0 = h * 128 + RA0, r1 = r0 + 64, cm = u.cnt - 1;
            rn[h][0] = (unsigned)row_tok[u.aux + (r0 < cm ? r0 : cm)]; rn[h][1] = (unsigned)row_tok[u.aux + (r1 < cm ? r1 : cm)]; }
    }
    __device__ __forceinline__ void a_ready(const Unit&) const {}
    __device__ __forceinline__ void done(const Unit&) const {}
};
constexpr int MOE_TAB_OFF = 131072 + 1024;
__device__ __forceinline__ void moe_tables(const unsigned char* ws, int hb, LAS unsigned char* lds, int tid, int off = MOE_TAB_OFF) {
    LAS unsigned* tab = (LAS unsigned*)(lds + off); const unsigned* gcnt = (const unsigned*)(ws + WS_GCNT);
    __syncthreads();
    if (tid < 32) tab[tid] = ld_agent(gcnt + (hb * 32 + tid) * 16);
    __syncthreads();
    if (tid < 32) { unsigned acc = 0, tot = 0;
        for (int e = 0; e < 32; ++e) { const unsigned nb = (tab[e] + 255u) >> 8; acc += e < tid ? nb : 0u; tot += nb; }
        tab[32 + tid] = acc; if (tid == 0) tab[64] = tot; }
    __syncthreads();
}

constexpr int RING_BYTES = 131072, MISC_OFF = RING_BYTES + 320, LDS_BYTES = 147456;

struct Ctx { LAS unsigned char* lds; int tid, lane, wave, G, gw, ngw; };

struct TItem { f32x4 v[8]; float gv[8]; };
__device__ __forceinline__ void titem_load(TItem& t, const float* W, int N, const float* gain, int k0, int n0, int lane) {
#pragma unroll
    for (int i = 0; i < 8; ++i) { const int kk = 8 * i + (lane >> 3); t.v[i] = *(const f32x4*)(W + (size_t)(k0 + kk) * N + n0 + (lane & 7) * 4); t.gv[i] = gain ? gain[k0 + kk] : 1.f; }
}
__device__ __forceinline__ void titem_to_lds(const TItem& t, LAS float* scr, int lane) {
#pragma unroll
    for (int i = 0; i < 8; ++i) { const int kk = 8 * i + (lane >> 3); LAS float* p = scr + kk * 33 + (lane & 7) * 4;
        p[0] = t.v[i][0] * t.gv[i]; p[1] = t.v[i][1] * t.gv[i]; p[2] = t.v[i][2] * t.gv[i]; p[3] = t.v[i][3] * t.gv[i]; }
    LDS_WAIT();
}
template <class RowMap>
__device__ __forceinline__ void titem_out(int K, bf16* WT, const LAS float* scr, int k0, int n0, int lane, RowMap rm) {
    const int c = lane & 7;
#pragma unroll
    for (int j = 0; j < 4; ++j) { const int n = (lane >> 3) + 8 * j; const LAS float* s = scr + (8 * c) * 33 + n;
        v4u o; o.x = pk2(s[0 * 33], s[1 * 33]); o.y = pk2(s[2 * 33], s[3 * 33]); o.z = pk2(s[4 * 33], s[5 * 33]); o.w = pk2(s[6 * 33], s[7 * 33]);
        *(v4u*)(WT + (size_t)rm(n0 + n) * K + k0 + 8 * c) = o; }
    LDS_WAIT();
}
template <class RowMap>
__device__ __forceinline__ void titem_out8(int K, unsigned char* WT, const LAS float* scr, int k0, int n0, int lane, RowMap rm) {
    const int c = lane & 7;
#pragma unroll
    for (int j = 0; j < 4; ++j) { const int n = (lane >> 3) + 8 * j; const LAS float* s = scr + (8 * c) * 33 + n;
        v2u o; o.x = pk4f8(s[0 * 33] * F8_WSCALE, s[1 * 33] * F8_WSCALE, s[2 * 33] * F8_WSCALE, s[3 * 33] * F8_WSCALE); o.y = pk4f8(s[4 * 33] * F8_WSCALE, s[5 * 33] * F8_WSCALE, s[6 * 33] * F8_WSCALE, s[7 * 33] * F8_WSCALE);
        *(v2u*)(WT + (size_t)rm(n0 + n) * K + k0 + 8 * c) = o; }
    LDS_WAIT();
}
template <class RowMap>
__device__ __forceinline__ void transpose_item(const float* W, int K, int N, bf16* WT, const float* gain, LAS float* scr, int item, int lane, RowMap rm) {
    const int nblk = N / 32, kb = item / nblk, nb = item % nblk, k0 = 64 * kb, n0 = 32 * nb;
    TItem t; titem_load(t, W, N, gain, k0, n0, lane); titem_to_lds(t, scr, lane); titem_out(K, WT, scr, k0, n0, lane, rm);
}
template <class RowMap>
__device__ __forceinline__ void transpose_item8(const float* W, int K, int N, unsigned char* WT, const float* gain, LAS float* scr, int item, int lane, RowMap rm) {
    const int nblk = N / 32, kb = item / nblk, nb = item % nblk, k0 = 64 * kb, n0 = 32 * nb;
    TItem t; titem_load(t, W, N, gain, k0, n0, lane); titem_to_lds(t, scr, lane); titem_out8(K, WT, scr, k0, n0, lane, rm);
}
struct RowId { int off; __device__ __forceinline__ int operator()(int n) const { return off + n; } };
struct RowGU { int e; __device__ __forceinline__ int operator()(int n) const { const int j = n & 1023; return e * 2048 + (j >> 7) * 256 + (n >> 10) * 128 + (j & 127); } };

__device__ __forceinline__ void rms_row_to_bf16(const float* xrow, const float* gain, bf16* orow, int lane) {
    const f32x4* xr = (const f32x4*)xrow + lane; const f32x4* gr = (const f32x4*)gain + lane;
    f32x4 v[4]; float s = 0.f;
#pragma unroll
    for (int j = 0; j < 4; ++j) { v[j] = xr[64 * j]; s += (v[j][0] * v[j][0] + v[j][1] * v[j][1]) + (v[j][2] * v[j][2] + v[j][3] * v[j][3]); }
    const float rstd = rsqrtf(wave_sum(s, lane) * (1.f / DM) + RMS_EPS);
    unsigned long long* o8 = (unsigned long long*)orow + lane;
#pragma unroll
    for (int j = 0; j < 4; ++j) { const f32x4 g = gr[64 * j]; const f32x4 w = v[j] * rstd * g;
        o8[64 * j] = (unsigned long long)pk2(w[0], w[1]) | ((unsigned long long)pk2(w[2], w[3]) << 32); }
}

__device__ __forceinline__ void phase_prologue(const Args& a, const Ctx& c) {
    LAS float* scr = (LAS float*)(c.lds + c.wave * 16384);
    unsigned char* ws = a.ws;
    constexpr int I_IN = 16 * (NCOL / 32), I_SQ = 16 * 32, I_R = 16;
    constexpr int NIT = I_IN + 7 * I_SQ + I_R;
    for (int it = c.gw; it < NIT; it += c.ngw) {
        int r = it;
        if (r < I_IN) { transpose_item(a.in[5], DM, NCOL, (bf16*)(ws + WS_WIN), nullptr, scr, r, c.lane, RowId{0}); continue; } r -= I_IN;
        if (r < I_SQ) { transpose_item(a.in[9], DM, DM, (bf16*)(ws + WS_WA), nullptr, scr, r, c.lane, RowId{0}); continue; } r -= I_SQ;
        if (r < I_SQ) { transpose_item(a.in[10], DM, DM, (bf16*)(ws + WS_WB), nullptr, scr, r, c.lane, RowId{0}); continue; } r -= I_SQ;
        if (r < I_SQ) { transpose_item(a.in[11], DM, DM, (bf16*)(ws + WS_WMIX), nullptr, scr, r, c.lane, RowId{0}); continue; } r -= I_SQ;
        if (r < I_SQ) { transpose_item8(a.in[13], DM, DM, ws + WS_WQ, a.in[12], scr, r, c.lane, RowId{0}); continue; } r -= I_SQ;
        if (r < I_SQ) { transpose_item(a.in[14], DM, DM, (bf16*)(ws + WS_WK), nullptr, scr, r, c.lane, RowId{0}); continue; } r -= I_SQ;
        if (r < I_SQ) { transpose_item(a.in[15], DM, DM, (bf16*)(ws + WS_WV), nullptr, scr, r, c.lane, RowId{0}); continue; } r -= I_SQ;
        if (r < I_SQ) { transpose_item8(a.in[16], DM, DM, ws + WS_WO, nullptr, scr, r, c.lane, RowId{0}); continue; } r -= I_SQ;
        transpose_item(a.in[18], DM, NEXP, (bf16*)(ws + WS_WR), a.in[17], scr, r, c.lane, RowId{0});
    }
    { const size_t n8 = (size_t)NBATCH * MEMLEN * DM / 8; const float* mem = a.in[1]; bf16* mb = (bf16*)(ws + WS_MEMBF);
      for (size_t i = (size_t)c.gw * 64 + c.lane; i < n8; i += (size_t)c.ngw * 64) { const f32x4 v0 = *(const f32x4*)(mem + i * 8), v1 = *(const f32x4*)(mem + i * 8 + 4);
          v4u w; w.x = pk2(v0[0], v0[1]); w.y = pk2(v0[2], v0[3]); w.z = pk2(v1[0], v1[1]); w.w = pk2(v1[2], v1[3]); *(v4u*)(mb + i * 8) = w; } }
    if (c.gw == 0) {
        float* lb = (float*)(ws + WS_LB); const float* lbl = a.in[3];
        for (int k = c.lane; k < 1024; k += 64) lb[k] = 1.f / (1.f + expf(lbl[1024 + k] - lbl[k]));
    }
    if (c.gw == 1) {
        float* lut = (float*)(ws + WS_LUT); const float* t5 = a.in[2];
        for (int i = c.lane; i < 16 * 128; i += 64) { const int h = i >> 7, d = i & 127; int b = d;
            if (d >= 16) { b = 16 + (int)(logf((float)d * (1.f / 16.f)) / logf(8.f) * 16.f); b = b < 31 ? b : 31; }
            lut[i] = t5[b * 16 + h]; }
    }
}

__device__ __forceinline__ void phase_norm1(const Args& a, const Ctx& c, int hb) {
    const float* x = a.in[0] + (size_t)hb * HTOK * DM; bf16* xn = (bf16*)(a.ws + (hb ? WS_OA : WS_TM));
    for (int m = c.gw; m < HTOK; m += c.ngw) rms_row_to_bf16(x + (size_t)m * DM, a.in[4], xn + (size_t)m * DM, c.lane);
}

constexpr int SWA_VB = 32 * 144;
constexpr int SWA_LUT_OFF = 8 * 2 * SWA_VB;
__device__ __forceinline__ void swa_unit(const bf16* proj, bf16* ob, int bl, int kvh, int tt, const LAS float* lut, LAS unsigned char* vbuf, const float* sinks, int lane) {
    const int l15 = lane & 15, g = lane >> 4, q4 = l15 >> 2, p4 = lane & 3;
    const int t0 = tt * 16; const size_t rowb = (size_t)bl * SEQ;
    const bf16* sq = (const bf16*)((const unsigned char*)proj + PJ_SQ) + (size_t)(bl * 16 + kvh * 4) * SEQ * 64;
    const bf16* sk = (const bf16*)((const unsigned char*)proj + PJ_SK) + (size_t)(bl * 4 + kvh) * SEQ * 64;
    const bf16* sv = (const bf16*)((const unsigned char*)proj + PJ_SV) + (size_t)(bl * 4 + kvh) * SEQ * 64;
    bf16x8 qf[4][2];
#pragma unroll
    for (int gq = 0; gq < 4; ++gq)
#pragma unroll
        for (int ks = 0; ks < 2; ++ks) qf[gq][ks] = *(const bf16x8*)(sq + ((size_t)gq * SEQ + t0 + l15) * 64 + ks * 32 + 8 * g);
    float mx[4], ls[4]; f32x4 o[4][4];
#pragma unroll
    for (int gq = 0; gq < 4; ++gq) { mx[gq] = sinks[kvh * 4 + gq]; ls[gq] = 1.f;
#pragma unroll
        for (int dt = 0; dt < 4; ++dt) o[gq][dt] = (f32x4){0.f, 0.f, 0.f, 0.f}; }
    for (int c = 0; c < 5; ++c) {
        const int kc = t0 - 144 + 32 * c;
        if (kc + 31 < 0) continue;
        LAS unsigned char* vb = vbuf + (c & 1) * SWA_VB;
#pragma unroll
        for (int i = 0; i < 4; ++i) { const int p = lane + 64 * i, key = p >> 3, d8 = p & 7; int kr = kc + key; kr = kr < 0 ? 0 : kr;
            const v4u vv = *(const v4u*)(sv + (size_t)kr * 64 + d8 * 8);
            *(LAS v4u*)(vb + key * 144 + d8 * 16) = vv; }
        f32x4 s[4][2];
#pragma unroll
        for (int ksub = 0; ksub < 2; ++ksub) { int kr = kc + 16 * ksub + l15; kr = kr < 0 ? 0 : kr;
            const bf16* kp = sk + (size_t)kr * 64 + 8 * g;
            const bf16x8 k0 = *(const bf16x8*)kp, k1 = *(const bf16x8*)(kp + 32);
#pragma unroll
            for (int gq = 0; gq < 4; ++gq) { f32x4 z = (f32x4){0.f, 0.f, 0.f, 0.f}; z = mfma16(k0, qf[gq][0], z); s[gq][ksub] = mfma16(k1, qf[gq][1], z); } }
        bf16x8 pf[4];
#pragma unroll
        for (int gq = 0; gq < 4; ++gq) { const int hq = kvh * 4 + gq; float cm = -1e30f;
#pragma unroll
            for (int ksub = 0; ksub < 2; ++ksub)
#pragma unroll
                for (int r = 0; r < 4; ++r) { const int key = kc + 16 * ksub + 4 * g + r, dist = t0 + l15 - key; const bool ok = (dist >= 0) && (dist < 128) && (key >= 0);
                    const int di = dist < 0 ? 0 : (dist > 127 ? 127 : dist);
                    float v = s[gq][ksub][r] * 0.125f + lut[hq * 128 + di]; v = ok ? v : -1e30f; s[gq][ksub][r] = v; cm = fmaxf(cm, v); }
            cm = fmaxf(cm, shx(cm, 16, lane)); cm = fmaxf(cm, shx(cm, 32, lane));
            const float mn = fmaxf(mx[gq], cm), alpha = fexp(mx[gq] - mn); mx[gq] = mn; float rs = 0.f;
#pragma unroll
            for (int ksub = 0; ksub < 2; ++ksub)
#pragma unroll
                for (int r = 0; r < 4; ++r) { const float p = fexp(s[gq][ksub][r] - mn); s[gq][ksub][r] = p; rs += p; }
            rs += shx(rs, 16, lane); rs += shx(rs, 32, lane);
            ls[gq] = ls[gq] * alpha + rs;
#pragma unroll
            for (int dt = 0; dt < 4; ++dt) o[gq][dt] = o[gq][dt] * alpha;
            pf[gq] = pack8(s[gq][0], s[gq][1]); }
        CFENCE();
#pragma unroll
        for (int dt = 0; dt < 4; ++dt) {
            const s16x4 lo = vtr(vb + (4 * g + q4) * 144 + (16 * dt + 4 * p4) * 2), hi = vtr(vb + (16 + 4 * g + q4) * 144 + (16 * dt + 4 * p4) * 2);
            const bf16x8 vf = cat8(lo, hi);
#pragma unroll
            for (int gq = 0; gq < 4; ++gq) o[gq][dt] = mfma16(vf, pf[gq], o[gq][dt]); }
        CFENCE();
    }
#pragma unroll
    for (int gq = 0; gq < 4; ++gq) { const float inv = __builtin_amdgcn_rcpf(ls[gq]);
#pragma unroll
        for (int dt = 0; dt < 4; ++dt) { const f32x4 v = o[gq][dt] * inv; v2u w; w.x = pk2(v[0], v[1]); w.y = pk2(v[2], v[3]);
            *(v2u*)(ob + (rowb + t0 + l15) * DM + (kvh * 4 + gq) * 64 + 16 * dt + 4 * g) = w; } }
}
constexpr int HGB_WAVES = 4;
template <int NW> __device__ __forceinline__ void hgB_work(const Args& a, const Ctx& c);
template <int HW  > __device__ __forceinline__ void phase_swa_hgB(const Args& a, const Ctx& c) {
    const bf16* proj = (const bf16*)(a.ws + WS_PROJ); bf16* ob = (bf16*)(a.ws + WS_OB);
    LAS float* lut = (LAS float*)(c.lds + SWA_LUT_OFF); const float* glut = (const float*)(a.ws + WS_LUT);
    for (int i = c.tid; i < 16 * 128; i += 512) lut[i] = glut[i];
    __syncthreads();
    if (c.wave < HW) hgB_work<HW>(a, c);
    else {
        LAS unsigned char* vbuf = c.lds + c.wave * 2 * SWA_VB;
        constexpr int NU = 8 * 4 * 256;
        const int nsw = c.G * (8 - HW), sw = (int)blockIdx.x * (8 - HW) + (c.wave - HW);
        for (int u = sw; u < NU; u += nsw) { const int tt = u & 255, kvh = (u >> 8) & 3, bl = u >> 10; swa_unit(proj, ob, bl, kvh, tt, lut, vbuf, a.in[8], c.lane); }
    }
    __syncthreads();
}

constexpr int HG_LF = 0, HG_KP = 33792, HG_VT = 51200, HG_GT = 68608, HG_QP = 70656, HG_SSQ = 88064;
__device__ __forceinline__ void hg_scan(LAS unsigned char* lds, int tid, float (&loc)[16], float& pre, float& Gm, float& Gl) {
    const int ch = tid & 127, grp = tid >> 7;
    const LAS float* LF = (const LAS float*)(lds + HG_LF); LAS float* GT = (LAS float*)(lds + HG_GT);
    float run = 0.f;
#pragma unroll
    for (int i = 0; i < 16; ++i) { run += LF[(16 * grp + i) * 132 + ch]; loc[i] = run; }
    GT[grp * 128 + ch] = run;
    __syncthreads();
    const float g0 = GT[ch], g1 = GT[128 + ch], g2 = GT[256 + ch], g3 = GT[384 + ch];
    pre = (grp > 0 ? g0 : 0.f) + (grp > 1 ? g1 : 0.f) + (grp > 2 ? g2 : 0.f);
    Gm = g0 + g1; Gl = Gm + g2 + g3;
}
constexpr size_t OUT_KP = 0, OUT_QP = 64 * MiB;
constexpr int HCH = 128, HNCH = SEQ / HCH, HNU = 8 * 8 * HNCH;
constexpr int HS_FT = 0, HS_QT = 34816, HS_VT = 69632, HS_GT = 104448, HS_SSQ = 106496;
__device__ __forceinline__ void phase_hgA(const Args& a, const Ctx& c) {
    const bf16* proj = (const bf16*)(a.ws + WS_PROJ); bf16* US = (bf16*)((unsigned char*)a.out + OUT_US); float* D12 = (float*)(a.ws + WS_D12);
    bf16* KPg = (bf16*)((unsigned char*)a.out + OUT_KP); bf16* QPg = (bf16*)((unsigned char*)a.out + OUT_QP);
    LAS unsigned char* lds = c.lds; const int tid = c.tid, lane = c.lane, w = c.wave;
    const int l15 = lane & 15, g = lane >> 4, q4 = l15 >> 2, p4 = lane & 3, ch = tid & 127, grp = tid >> 7;
    int u = blockIdx.x; if (u >= HNU) return;
    v4u rq[4], rf[4], rv[4];
#define HGA_LOAD(uu) do { const size_t uo = (size_t)(uu) * (HCH * 128);      \
        _Pragma("unroll") for (int i = 0; i < 4; ++i) { const size_t po = uo + (size_t)(tid + 512 * i) * 8; \
            rq[i] = *(const v4u*)((const bf16*)((const unsigned char*)proj + PJ_HQ) + po); rf[i] = *(const v4u*)((const bf16*)((const unsigned char*)proj + PJ_HF) + po); rv[i] = *(const v4u*)((const bf16*)((const unsigned char*)proj + PJ_HI) + po); } } while (0)
    HGA_LOAD(u);
    for (;;) {
#pragma unroll
        for (int i = 0; i < 4; ++i) { const int p = tid + 512 * i, tok = p >> 4, c8 = p & 15; LAS unsigned char* sb = lds + tok * 272 + c8 * 16;
            *(LAS v4u*)(sb + HS_FT) = rf[i]; *(LAS v4u*)(sb + HS_QT) = rq[i]; *(LAS v4u*)(sb + HS_VT) = rv[i]; }
        const int ucur = u; const int un = u + gridDim.x; const bool has_next = un < HNU;
        LDS_WAIT();
        if (has_next) HGA_LOAD(un);
        __syncthreads();
        float loc[32], kt[32];
        { const LAS bf16* FT = (const LAS bf16*)(lds + HS_FT); float run = 0.f;
#pragma unroll
          for (int i = 0; i < 32; ++i) { const float f = __builtin_bit_cast(float, (unsigned)FT[(32 * grp + i) * 136 + ch] << 16); kt[i] = 1.f - f; run += flog(f); loc[i] = run; }
          ((LAS float*)(lds + HS_GT))[grp * 128 + ch] = run; }
        __syncthreads();
        { const LAS float* GT = (const LAS float*)(lds + HS_GT);
          const float g0 = GT[ch], g1 = GT[128 + ch], g2 = GT[256 + ch], g3 = GT[384 + ch];
          const float pre = (grp > 0 ? g0 : 0.f) + (grp > 1 ? g1 : 0.f) + (grp > 2 ? g2 : 0.f), Gm = g0 + g1, Gl = Gm + g2 + g3;
          LAS bf16* KP = (LAS bf16*)(lds + HS_FT); LAS bf16* QP = (LAS bf16*)(lds + HS_QT);
#pragma unroll
          for (int hf = 0; hf < 2; ++hf) { float qr[16];
#pragma unroll
              for (int i = 0; i < 16; ++i) qr[i] = __builtin_bit_cast(float, (unsigned)QP[(32 * grp + 16 * hf + i) * 136 + ch] << 16);
#pragma unroll
              for (int i = 0; i < 16; ++i) { const int ii = 16 * hf + i; const float G = pre + loc[ii];
                  const float ed = fexp(fminf(Gm - G, 80.f));
                  KP[(32 * grp + ii) * 136 + ch] = (bf16)pk2(kt[ii] * ed, 0.f);
                  QP[(32 * grp + ii) * 136 + ch] = (bf16)pk2(qr[i] * __builtin_amdgcn_rcpf(ed), 0.f); } }
          if (grp == 0) { D12[(size_t)ucur * 256 + ch] = fexp(Gm); D12[(size_t)ucur * 256 + 128 + ch] = fexp(Gl - Gm); } }
        __syncthreads();
#pragma unroll
        for (int i = 0; i < 4; ++i) { const int p = tid + 512 * i, tok = p >> 4, c8 = p & 15; const size_t go = (size_t)ucur * (HCH * 128) + (size_t)p * 8;
            *(v4u*)(KPg + go) = *(const LAS v4u*)(lds + HS_FT + tok * 272 + c8 * 16); *(v4u*)(QPg + go) = *(const LAS v4u*)(lds + HS_QT + tok * 272 + c8 * 16); }
        { bf16x8 af[4];
#pragma unroll
          for (int ks = 0; ks < 4; ++ks) { const LAS unsigned char* bp = lds + HS_FT + (32 * ks + 8 * g + q4) * 272 + (16 * w + 4 * p4) * 2; af[ks] = cat8(vtr(bp), vtr(bp + 4 * 272)); }
#pragma unroll
          for (int vt = 0; vt < 8; ++vt) { f32x4 acc = (f32x4){0.f, 0.f, 0.f, 0.f};
#pragma unroll
              for (int ks = 0; ks < 4; ++ks) { const LAS unsigned char* bp = lds + HS_VT + (32 * ks + 8 * g + q4) * 272 + (16 * vt + 4 * p4) * 2; acc = mfma16(af[ks], cat8(vtr(bp), vtr(bp + 4 * 272)), acc); }
              v2u wv; wv.x = pk2(acc[0], acc[1]); wv.y = pk2(acc[2], acc[3]);
              *(v2u*)(US + ((size_t)ucur * 128 + 16 * vt + l15) * 128 + 16 * w + 4 * g) = wv; } }
        __syncthreads();
        if (!has_next) break;
        u = un;
    }
#undef HGA_LOAD
}
template <int NW> __device__ __forceinline__ void hgB_work(const Args& a, const Ctx& c) {
    bf16* US = (bf16*)((unsigned char*)a.out + OUT_US); const float* D12 = (const float*)(a.ws + WS_D12);
    const int nthr = c.G * NW * 64, gt = ((int)blockIdx.x * NW + c.wave) * 64 + c.lane;
    for (int e = gt; e < 64 * 2048; e += nthr) {
        const int bh = e >> 11, r = e & 2047, k8 = r & 15;
        float S[8];
#pragma unroll
        for (int j = 0; j < 8; ++j) S[j] = 0.f;
        for (int c0 = 0; c0 < HNCH; c0 += 8) {
            v4u uw[8];
#pragma unroll
            for (int cc = 0; cc < 8; ++cc) uw[cc] = *(const v4u*)(US + ((size_t)bh * HNCH + c0 + cc) * 16384 + (size_t)r * 8);
#pragma unroll
            for (int cc = 0; cc < 8; ++cc) { const size_t un = (size_t)bh * HNCH + c0 + cc;
                const f32x4 d1a = *(const f32x4*)(D12 + un * 256 + k8 * 8), d1b = *(const f32x4*)(D12 + un * 256 + k8 * 8 + 4);
                const f32x4 d2a = *(const f32x4*)(D12 + un * 256 + 128 + k8 * 8), d2b = *(const f32x4*)(D12 + un * 256 + 128 + k8 * 8 + 4);
                const unsigned ww[4] = {uw[cc].x, uw[cc].y, uw[cc].z, uw[cc].w}; float sp[8];
#pragma unroll
                for (int j = 0; j < 8; ++j) { const float d1v = j < 4 ? d1a[j & 3] : d1b[j & 3], d2v = j < 4 ? d2a[j & 3] : d2b[j & 3]; const float uv = (j & 1) ? bfhi(ww[j >> 1]) : bflo(ww[j >> 1]);
                    sp[j] = d1v * S[j]; S[j] = d2v * (sp[j] + uv); }
                v4u o; o.x = pk2(sp[0], sp[1]); o.y = pk2(sp[2], sp[3]); o.z = pk2(sp[4], sp[5]); o.w = pk2(sp[6], sp[7]);
                *(v4u*)(US + un * 16384 + (size_t)r * 8) = o; }
        }
    }
}
__device__ __forceinline__ void phase_hgC(const Args& a, const Ctx& c) {
    const bf16* proj = (const bf16*)(a.ws + WS_PROJ); const bf16* US = (const bf16*)((unsigned char*)a.out + OUT_US); bf16* oa = (bf16*)(a.ws + WS_OA);
    const bf16* KPg = (const bf16*)((unsigned char*)a.out + OUT_KP); const bf16* QPg = (const bf16*)((unsigned char*)a.out + OUT_QP);
    const float* hgain = a.in[7];
    LAS unsigned char* lds = c.lds; const int tid = c.tid, lane = c.lane, w = c.wave;
    const int l15 = lane & 15, g = lane >> 4, q4 = l15 >> 2, p4 = lane & 3;
    int u = blockIdx.x; if (u >= HNU) return;
    v4u rk[4], rq[4], rv[4];
#define HGC_LOAD(uu) do { const size_t uo = (size_t)(uu) * (HCH * 128); \
        _Pragma("unroll") for (int i = 0; i < 4; ++i) { const size_t po = uo + (size_t)(tid + 512 * i) * 8; \
            rk[i] = *(const v4u*)(KPg + po); rq[i] = *(const v4u*)(QPg + po); rv[i] = *(const v4u*)((const bf16*)((const unsigned char*)proj + PJ_HI) + po); } } while (0)
    HGC_LOAD(u);
    const f32x4 gn = *(const f32x4*)(hgain + 16 * w + 4 * g);
    for (;;) {
#pragma unroll
        for (int i = 0; i < 4; ++i) { const int p = tid + 512 * i, tok = p >> 4, c8 = p & 15; LAS unsigned char* sb = lds + tok * 272 + c8 * 16;
            *(LAS v4u*)(sb + HS_FT) = rk[i]; *(LAS v4u*)(sb + HS_QT) = rq[i]; *(LAS v4u*)(sb + HS_VT) = rv[i]; }
        const int ucur = u; const int un = u + gridDim.x; const bool has_next = un < HNU;
        const int cc = ucur % HNCH, h = (ucur / HNCH) & 7, bl = ucur / (HNCH * 8); const size_t row0 = (size_t)bl * SEQ + cc * HCH;
        bf16x8 sf[4]; v2u gwv[8];
#pragma unroll
        for (int ks = 0; ks < 4; ++ks) sf[ks] = *(const bf16x8*)(US + ((size_t)ucur * 128 + 16 * w + l15) * 128 + 32 * ks + 8 * g);
        LDS_WAIT();
        if (has_next) HGC_LOAD(un);
        __syncthreads();
        f32x4 o[8];
        {
            bf16x8 vf[4];
#pragma unroll
            for (int kk = 0; kk < 4; ++kk) { const LAS unsigned char* bp = lds + HS_VT + (32 * kk + 4 * g + q4) * 272 + (16 * w + 4 * p4) * 2; vf[kk] = cat8(vtr(bp), vtr(bp + 16 * 272)); }
#pragma unroll
            for (int tt = 0; tt < 8; ++tt) {
                bf16x8 qf[4];
#pragma unroll
                for (int ks = 0; ks < 4; ++ks) qf[ks] = *(const LAS bf16x8*)(lds + HS_QT + (16 * tt + l15) * 272 + (32 * ks + 8 * g) * 2);
                f32x4 acc = (f32x4){0.f, 0.f, 0.f, 0.f};
#pragma unroll
                for (int ks = 0; ks < 4; ++ks) acc = mfma16(sf[ks], qf[ks], acc);
#pragma unroll
                for (int kk = 0; kk < 4; ++kk) {
                    if (2 * kk <= tt) { f32x4 at[2];
#pragma unroll
                        for (int e = 0; e < 2; ++e) { const int st = 2 * kk + e; at[e] = (f32x4){0.f, 0.f, 0.f, 0.f};
                            if (st <= tt) {
#pragma unroll
                                for (int ks = 0; ks < 4; ++ks) { const bf16x8 kf = *(const LAS bf16x8*)(lds + HS_FT + (16 * st + l15) * 272 + (32 * ks + 8 * g) * 2); at[e] = mfma16(kf, qf[ks], at[e]); }
                                if (st == tt) {
#pragma unroll
                                    for (int r = 0; r < 4; ++r) at[e][r] = (4 * g + r <= l15) ? at[e][r] : 0.f; } } }
                        acc = mfma16(vf[kk], pack8(at[0], at[1]), acc); } }
                o[tt] = acc; CFENCE(); }
        }
#pragma unroll
        for (int tt = 0; tt < 8; ++tt) gwv[tt] = *(const v2u*)((const bf16*)((const unsigned char*)proj + PJ_HG) + (size_t)ucur * (HCH * 128) + (16 * tt + l15) * 128 + 16 * w + 4 * g);
        { LAS float* SSQ = (LAS float*)(lds + HS_SSQ);
#pragma unroll
          for (int tt = 0; tt < 8; ++tt) { float q = (o[tt][0] * o[tt][0] + o[tt][1] * o[tt][1]) + (o[tt][2] * o[tt][2] + o[tt][3] * o[tt][3]);
              q += shx(q, 16, lane); q += shx(q, 32, lane); if (g == 0) SSQ[w * 128 + 16 * tt + l15] = q; } }
        __syncthreads();
        { const LAS float* SSQ = (const LAS float*)(lds + HS_SSQ);
#pragma unroll
          for (int tt = 0; tt < 8; ++tt) { float q = 0.f;
#pragma unroll
              for (int ww = 0; ww < 8; ++ww) q += SSQ[ww * 128 + 16 * tt + l15];
              const float rstd = rsqrtf(q * (1.f / 128.f) + RMS_EPS);
              const size_t row = row0 + 16 * tt + l15;
              const v2u gw = gwv[tt];
              const float g0 = bflo(gw.x), g1 = bfhi(gw.x), g2 = bflo(gw.y), g3 = bfhi(gw.y);
              const float r0 = o[tt][0] * rstd * gn[0] * g0, r1 = o[tt][1] * rstd * gn[1] * g1;
              const float r2 = o[tt][2] * rstd * gn[2] * g2, r3 = o[tt][3] * rstd * gn[3] * g3;
              v2u wv; wv.x = pk2(r0, r1); wv.y = pk2(r2, r3);
              *(v2u*)(oa + row * DM + h * 128 + 16 * w + 4 * g) = wv; } }
        __syncthreads();
        if (!has_next) break;
        u = un;
    }
#undef HGC_LOAD
}

typedef float f32x16 __attribute__((ext_vector_type(16)));
constexpr int XA_KROW = 528, XA_VROW = 72, XA_KB = 32 * XA_KROW, XA_VB = 256 * XA_VROW, XA_STAGE = XA_KB + XA_VB;
__device__ __forceinline__ void phase_xa(const Args& a, const Ctx& c) {
    const bf16* qg = (const bf16*)(a.ws + WS_Q); unsigned char* og = a.ws + WS_O;     const bf16* kx = (const bf16*)(a.ws + WS_KX); const bf16* vxt = (const bf16*)(a.ws + WS_VXT);
    LAS unsigned char* lds = c.lds; const int tid = c.tid, lane = c.lane, w = c.wave;
    const int l31 = lane & 31, hh = lane >> 5, qt = w & 3, dh = w >> 2;
    constexpr int NU = NBATCH * 4 * (SEQ / 128);
    int u = blockIdx.x; if (u >= NU) return;
    v4u rk[2], rv[2];
#define XA_LOAD(uu, kc) do { const int b_ = (uu) >> 7, h_ = ((uu) >> 5) & 3; \
        _Pragma("unroll") for (int i = 0; i < 2; ++i) { const int p = tid + 512 * i; \
            rk[i] = *(const v4u*)(kx + (size_t)(b_ * MEMLEN + (kc) * 32 + (p >> 5)) * DM + h_ * 256 + (p & 31) * 8); \
            rv[i] = *(const v4u*)(vxt + (size_t)(h_ * 256 + (p >> 2)) * (NBATCH * MEMLEN) + b_ * MEMLEN + (kc) * 32 + (p & 3) * 8); } } while (0)
#define XA_STORE(buf) do { LAS unsigned char* sb = lds + (buf) * XA_STAGE; \
        _Pragma("unroll") for (int i = 0; i < 2; ++i) { const int p = tid + 512 * i; \
            *(LAS v4u*)(sb + (p >> 5) * XA_KROW + (p & 31) * 16) = rk[i]; \
            LAS v2u* vp = (LAS v2u*)(sb + XA_KB + (p >> 2) * XA_VROW + (p & 3) * 16); v2u lo; lo.x = rv[i].x; lo.y = rv[i].y; v2u hi; hi.x = rv[i].z; hi.y = rv[i].w; vp[0] = lo; vp[1] = hi; } } while (0)
    XA_LOAD(u, 0); XA_STORE(0);
    int par = 0;
    bf16x8 qf[16];
#define XA_QLOAD(uu) do { const int b_ = (uu) >> 7, h_ = ((uu) >> 5) & 3, qb_ = (uu) & 31; const size_t r_ = (size_t)b_ * SEQ + qb_ * 128 + qt * 32 + l31; \
        _Pragma("unroll") for (int ks = 0; ks < 16; ++ks) qf[ks] = *(const bf16x8*)(qg + r_ * DM + h_ * 256 + 16 * ks + 8 * hh); } while (0)
    XA_QLOAD(u);
    for (;;) {
        const int b = u >> 7, h = (u >> 5) & 3, qb = u & 31;
        const size_t row0 = (size_t)b * SEQ + qb * 128 + qt * 32;
        float mx = -1e30f, ls = 0.f; f32x16 o[4];
#pragma unroll
        for (int dt = 0; dt < 4; ++dt)
#pragma unroll
            for (int r = 0; r < 16; ++r) o[dt][r] = 0.f;
        const int un = u + gridDim.x; const bool has_next = un < NU;
        for (int kc = 0; kc < 8; ++kc) {
            __syncthreads();
            const bool more = (kc < 7) || has_next;
            if (more) { if (kc < 7) XA_LOAD(u, kc + 1); else XA_LOAD(un, 0); }
            const LAS unsigned char* kb = lds + par * XA_STAGE; const LAS unsigned char* vb = kb + XA_KB;
            f32x16 s, s2;
#pragma unroll
            for (int r = 0; r < 16; ++r) { s[r] = 0.f; s2[r] = 0.f; }
#pragma unroll
            for (int ks = 0; ks < 16; ks += 2) { const bf16x8 kf = *(const LAS bf16x8*)(kb + l31 * XA_KROW + (16 * ks + 8 * hh) * 2), kf2 = *(const LAS bf16x8*)(kb + l31 * XA_KROW + (16 * ks + 16 + 8 * hh) * 2);
                s = __builtin_amdgcn_mfma_f32_32x32x16_bf16(kf, qf[ks], s, 0, 0, 0); s2 = __builtin_amdgcn_mfma_f32_32x32x16_bf16(kf2, qf[ks + 1], s2, 0, 0, 0); }
            if (kc == 7 && has_next) XA_QLOAD(un);
#pragma unroll
            for (int r = 0; r < 16; ++r) s[r] += s2[r];
            float cm = -1e30f;
#pragma unroll
            for (int r = 0; r < 16; ++r) { s[r] *= 0.0625f; cm = fmaxf(cm, s[r]); }
            cm = fmaxf(cm, shx(cm, 32, lane));
            const float mn = fmaxf(mx, cm), alpha = fexp(mx - mn); mx = mn; float rs = 0.f;
#pragma unroll
            for (int r = 0; r < 16; ++r) { s[r] = fexp(s[r] - mn); rs += s[r]; }
            rs += shx(rs, 32, lane); ls = ls * alpha + rs;
#pragma unroll
            for (int dt = 0; dt < 4; ++dt)
#pragma unroll
                for (int r = 0; r < 16; ++r) o[dt][r] *= alpha;
            bf16x8 pf[2];
#pragma unroll
            for (int st = 0; st < 2; ++st) { v4u pw; pw.x = pk2(s[8 * st], s[8 * st + 1]); pw.y = pk2(s[8 * st + 2], s[8 * st + 3]); pw.z = pk2(s[8 * st + 4], s[8 * st + 5]); pw.w = pk2(s[8 * st + 6], s[8 * st + 7]); pf[st] = __builtin_bit_cast(bf16x8, pw); }
#pragma unroll
            for (int dt = 0; dt < 4; ++dt) { const LAS unsigned char* vrow = vb + (128 * dh + 32 * dt + l31) * XA_VROW + 8 * hh;
#pragma unroll
                for (int st = 0; st < 2; ++st) { const s16x4 lo = *(const LAS s16x4*)(vrow + 32 * st), hi = *(const LAS s16x4*)(vrow + 32 * st + 16);
                    o[dt] = __builtin_amdgcn_mfma_f32_32x32x16_bf16(cat8(lo, hi), pf[st], o[dt], 0, 0, 0); } }
            if (more) XA_STORE(par ^ 1);
            par ^= 1;
        }
        const float inv = __builtin_amdgcn_rcpf(ls);
#pragma unroll
        for (int dt = 0; dt < 4; ++dt)
#pragma unroll
            for (int rg = 0; rg < 4; ++rg)
                *(unsigned*)(og + (row0 + l31) * DM + h * 256 + 128 * dh + 32 * dt + 8 * rg + 4 * hh) = pk4f8(o[dt][4 * rg] * inv, o[dt][4 * rg + 1] * inv, o[dt][4 * rg + 2] * inv, o[dt][4 * rg + 3] * inv);
        if (!has_next) break;
        u = un;
    }
    __syncthreads();
#undef XA_LOAD
#undef XA_STORE
#undef XA_QLOAD
}

__device__ __forceinline__ void phase_expert_weights(const Args& a, const Ctx& c) {
    LAS float* scr = (LAS float*)(c.lds + c.wave * 16384);
    constexpr int I_GU = 16 * 64, I_D = 16 * 32;
    constexpr int NGU = NEXP * I_GU, NIT = NEXP * (I_GU + I_D);
#define EW_GEO(it, W_, N_, k0_, n0_) const bool gu_##W_ = (it) < NGU; const int r_##W_ = gu_##W_ ? (it) : (it) - NGU; const int e_##W_ = gu_##W_ ? r_##W_ / I_GU : r_##W_ / I_D; \
        const int q_##W_ = gu_##W_ ? r_##W_ % I_GU : r_##W_ % I_D; const int N_ = gu_##W_ ? 2048 : 1024; const int nblk_##W_ = N_ / 32; const int k0_ = 64 * (q_##W_ / nblk_##W_), n0_ = 32 * (q_##W_ % nblk_##W_); \
        const float* W_ = gu_##W_ ? a.in[20] + (size_t)e_##W_ * DM * 2048 : a.in[22] + (size_t)e_##W_ * DM * DM
    int it = c.gw; if (it >= NIT) { __syncthreads(); return; }
    TItem t;
    { EW_GEO(it, W0, N0, k00, n00); titem_load(t, W0, N0, gu_W0 ? a.in[17] : nullptr, k00, n00, c.lane); }
    for (;;) {
        EW_GEO(it, Wc, Nc, k0c, n0c);
        titem_to_lds(t, scr, c.lane);
        const int itn = it + c.ngw; const bool more = itn < NIT;
        if (more) { EW_GEO(itn, Wn, Nn, k0n, n0n); titem_load(t, Wn, Nn, gu_Wn ? a.in[17] : nullptr, k0n, n0n, c.lane); }
        if (gu_Wc) titem_out8(DM, a.ws + WS_WGU, scr, k0c, n0c, c.lane, RowGU{e_Wc});
        else titem_out8(DM, a.ws + WS_WD, scr, k0c, n0c, c.lane, RowId{e_Wc * 1024});
        if (!more) break;
        it = itn;
    }
#undef EW_GEO
    __syncthreads();
}
__device__ __forceinline__ void phase_router(const Args& a, const Ctx& c) {
    const bf16* xb = (const bf16*)(a.ws + WS_XBF); const bf16* wr = (const bf16*)(a.ws + WS_WR); const float* ssq2 = (const float*)(a.ws + WS_SSQ2); const float* br = a.in[19];
    int* tope = (int*)(a.ws + WS_TOPE); float* topg = (float*)(a.ws + WS_TOPG); int* topr = (int*)(a.ws + WS_TOPR); unsigned* gcnt = (unsigned*)(a.ws + WS_GCNT);
    LAS unsigned char* lds = c.lds; const int lane = c.lane, w = c.wave, l15 = lane & 15, g = lane >> 4;
    LAS float* LG = (LAS float*)(lds + w * 4096);
    LAS int* LE = (LAS int*)(lds + w * 4096 + 2560); LAS float* LGT = (LAS float*)(lds + w * 4096 + 2816);
    int* rtok = (int*)(a.ws + WS_RTOK); float* rgate = (float*)(a.ws + WS_RGATE2); float* rrstd = (float*)(a.ws + WS_RRSTD2);
    LAS unsigned* CNT = (LAS unsigned*)(lds + 32768); LAS unsigned* BASE = CNT + 32;
    for (int it = blockIdx.x; it < NTOK / 128; it += gridDim.x) {
        const int tok0 = it * 128 + w * 16; const int half = tok0 >= HTOK;
        if (c.tid < 32) CNT[c.tid] = 0u;
        f32x4 acc[2] = {(f32x4){0.f, 0.f, 0.f, 0.f}, (f32x4){0.f, 0.f, 0.f, 0.f}};
        const bf16* ap = xb + (size_t)(tok0 + l15) * DM + 8 * g;
#pragma unroll 16
        for (int ks = 0; ks < 32; ++ks) { const bf16x8 af = *(const bf16x8*)(ap + 32 * ks);
#pragma unroll
            for (int nt = 0; nt < 2; ++nt) { const bf16x8 bf = *(const bf16x8*)(wr + (size_t)(16 * nt + l15) * DM + 32 * ks + 8 * g); acc[nt] = mfma16(af, bf, acc[nt]); } }
#pragma unroll
        for (int nt = 0; nt < 2; ++nt)
#pragma unroll
            for (int r = 0; r < 4; ++r) { const int t = 4 * g + r; const float rs = rstd16(ssq2, (size_t)(tok0 + t)); LG[t * 33 + 16 * nt + l15] = acc[nt][r] * rs + br[16 * nt + l15]; }
        LDS_WAIT();
        if (lane < 16) { float v[32];
#pragma unroll
            for (int e = 0; e < 32; ++e) v[e] = LG[lane * 33 + e];
            int se[4]; float sv[4];
#pragma unroll
            for (int k = 0; k < 4; ++k) { float best = -3e38f; int bi = 0;
#pragma unroll
                for (int e = 0; e < 32; ++e) { const bool bt = v[e] > best; best = bt ? v[e] : best; bi = bt ? e : bi; }
                se[k] = bi; sv[k] = best;
#pragma unroll
                for (int e = 0; e < 32; ++e) v[e] = (e == bi) ? -3e38f : v[e]; }
            const float e1 = fexp(sv[1] - sv[0]), e2 = fexp(sv[2] - sv[0]), e3 = fexp(sv[3] - sv[0]); const float inv = 1.f / (1.f + e1 + e2 + e3);
            const int tok = tok0 + lane;
            *(int4*)(tope + (size_t)tok * 4) = make_int4(se[0], se[1], se[2], se[3]);
            *(float4*)(topg + (size_t)tok * 4) = make_float4(inv, e1 * inv, e2 * inv, e3 * inv);
#pragma unroll
            for (int k = 0; k < 4; ++k) LE[lane * 4 + k] = se[k];
            LGT[lane * 4 + 0] = inv; LGT[lane * 4 + 1] = e1 * inv; LGT[lane * 4 + 2] = e2 * inv; LGT[lane * 4 + 3] = e3 * inv; }
        __syncthreads();
        const int myE = LE[lane];
        const unsigned lr = atomicAdd((unsigned*)&CNT[myE], 1u);
        __syncthreads();
        if (c.tid < 32) { const unsigned n = CNT[c.tid]; BASE[c.tid] = n ? atomicAdd(gcnt + (half * 32 + c.tid) * 16, n) : 0u; }
        __syncthreads();
        { const int rank = (int)(BASE[myE] + lr), tok = tok0 + (lane >> 2); topr[(size_t)tok * 4 + (lane & 3)] = rank;
          const size_t ri = (size_t)(half * 32 + myE) * HTOK + rank; rtok[ri] = tok; rgate[ri] = LGT[lane]; rrstd[ri] = rstd16(ssq2, (size_t)tok); }
        __syncthreads();
    }
}
__device__ __forceinline__ void add16(f32x4 (&v)[4], const v4u y0, const v4u y1) {
    v[0][0] += bflo(y0.x); v[0][1] += bfhi(y0.x); v[0][2] += bflo(y0.y); v[0][3] += bfhi(y0.y); v[1][0] += bflo(y0.z); v[1][1] += bfhi(y0.z); v[1][2] += bflo(y0.w); v[1][3] += bfhi(y0.w);
    v[2][0] += bflo(y1.x); v[2][1] += bfhi(y1.x); v[2][2] += bflo(y1.y); v[2][3] += bfhi(y1.y); v[3][0] += bflo(y1.z); v[3][1] += bfhi(y1.z); v[3][2] += bflo(y1.w); v[3][3] += bfhi(y1.w);
}
__device__ __forceinline__ void comb_issue(const bf16* y, const bf16* xb, const LAS unsigned* tab, int tok, const int4 ee, const int4 rr, int lane, v2u (&R)[20]) {
    const int ps[4] = {(int)tab[32 + ee.x] * 256 + rr.x, (int)tab[32 + ee.y] * 256 + rr.y, (int)tab[32 + ee.z] * 256 + rr.z, (int)tab[32 + ee.w] * 256 + rr.w};
    { const bf16* xp = xb + (size_t)tok * DM + lane * 4;
#pragma unroll
      for (int j = 0; j < 4; ++j) R[j] = *(const v2u*)(xp + j * 256); }
#pragma unroll
    for (int k = 0; k < 4; ++k) { const bf16* yp = y + (size_t)ps[k] * DM + lane * 4;
#pragma unroll
        for (int j = 0; j < 4; ++j) R[4 + 4 * k + j] = *(const v2u*)(yp + j * 256); }
}
__device__ __forceinline__ void comb_sum(f32x4 (&v)[4], const v2u (&R)[20]) {
#pragma unroll
    for (int j = 0; j < 4; ++j) v[j] = (f32x4){0.f, 0.f, 0.f, 0.f};
#pragma unroll
    for (int k = 0; k < 5; ++k)
#pragma unroll
        for (int j = 0; j < 4; ++j) { const v2u w = R[4 * k + j]; v[j][0] += bflo(w.x); v[j][1] += bfhi(w.x); v[j][2] += bflo(w.y); v[j][3] += bfhi(w.y); }
}
__device__ __forceinline__ void comb_store(float* out, const f32x4 (&gg)[4], int tok, int lane, const f32x4 (&v)[4]) {
    float s = 0.f;
#pragma unroll
    for (int j = 0; j < 4; ++j) s += (v[j][0] * v[j][0] + v[j][1] * v[j][1]) + (v[j][2] * v[j][2] + v[j][3] * v[j][3]);
    const float rstd = rsqrtf(wave_sum(s, lane) * (1.f / DM) + RMS_EPS);
    float* xr = out + (size_t)tok * DM + lane * 4;
#if defined(MK_COMB_NOSTORE)
    if (rstd == 12345.f)
#endif
#pragma unroll
    for (int j = 0; j < 4; ++j) *(f32x4*)(xr + j * 256) = v[j] * rstd * gg[j];
}
__device__ __forceinline__ void phase_combine(const Args& a, const Ctx& c, int hb, size_t yoff, int taboff) {
    const bf16* y = (const bf16*)(a.ws + yoff); const bf16* xb = (const bf16*)(a.ws + WS_XBF); const int* tope = (const int*)(a.ws + WS_TOPE); const int* topr = (const int*)(a.ws + WS_TOPR); const float* gf = a.in[24];
    moe_tables(a.ws, hb, c.lds, c.tid, taboff);
    const LAS unsigned* tab = (const LAS unsigned*)(c.lds + taboff);
    const int base = hb * HTOK, st = c.ngw, i0 = c.gw;
    if (i0 >= HTOK) return;
    int4 e0, r0, e1, r1; v2u R0[20], R1[20];
    f32x4 gg[4];
#pragma unroll
    for (int j = 0; j < 4; ++j) gg[j] = *(const f32x4*)(gf + j * 256 + c.lane * 4);
    e0 = *(const int4*)(tope + (size_t)(base + i0) * 4); r0 = *(const int4*)(topr + (size_t)(base + i0) * 4);
    e1 = e0; r1 = r0; if (i0 + st < HTOK) { e1 = *(const int4*)(tope + (size_t)(base + i0 + st) * 4); r1 = *(const int4*)(topr + (size_t)(base + i0 + st) * 4); }
    comb_issue(y, xb, tab, base + i0, e0, r0, c.lane, R0);
    if (i0 + st < HTOK) comb_issue(y, xb, tab, base + i0 + st, e1, r1, c.lane, R1);
    if (i0 + 2 * st < HTOK) { e0 = *(const int4*)(tope + (size_t)(base + i0 + 2 * st) * 4); r0 = *(const int4*)(topr + (size_t)(base + i0 + 2 * st) * 4); }
    if (i0 + 3 * st < HTOK) { e1 = *(const int4*)(tope + (size_t)(base + i0 + 3 * st) * 4); r1 = *(const int4*)(topr + (size_t)(base + i0 + 3 * st) * 4); }
#pragma nounroll
    for (int i = i0; i < HTOK; i += 2 * st) {
        f32x4 v[4];
        comb_sum(v, R0);
        if (i + 2 * st < HTOK) { comb_issue(y, xb, tab, base + i + 2 * st, e0, r0, c.lane, R0);
            if (i + 4 * st < HTOK) { e0 = *(const int4*)(tope + (size_t)(base + i + 4 * st) * 4); r0 = *(const int4*)(topr + (size_t)(base + i + 4 * st) * 4); } }
        comb_store(a.out, gg, base + i, c.lane, v);
        if (i + st < HTOK) {
            comb_sum(v, R1);
            if (i + 3 * st < HTOK) { comb_issue(y, xb, tab, base + i + 3 * st, e1, r1, c.lane, R1);
                if (i + 5 * st < HTOK) { e1 = *(const int4*)(tope + (size_t)(base + i + 5 * st) * 4); r1 = *(const int4*)(topr + (size_t)(base + i + 5 * st) * 4); } }
            comb_store(a.out, gg, base + i + st, c.lane, v); }
    }
}

#ifndef MK_PER_PHASE_LAUNCH
#define MK_PER_PHASE_LAUNCH 0
#endif
#if defined(MK_SPLIT_SWA)
constexpr int NPHASES = 24;
#else
constexpr int NPHASES = 21;
#endif
#ifndef MK_OFF
#define MK_OFF 0u
#endif
#define MKP(k) (((MK_OFF >> (k)) & 1u) == 0u)
#define GSCHED PG8_ALIGN, PG8_SP2
typedef const __attribute__((address_space(4))) Args* KArgP;
#if defined(__HIP_DEVICE_COMPILE__)
__device__ __forceinline__ Args ldargs() { KArgP kp = (KArgP)__builtin_amdgcn_kernarg_segment_ptr(); asm volatile("" : "+s"(kp)); Args r;
#pragma unroll
    for (int i = 0; i < 25; ++i) r.in[i] = kp->in[i];
    r.out = kp->out; r.ws = kp->ws; r.ph_lo = kp->ph_lo; r.ph_hi = kp->ph_hi; return r; }
#else
__device__ __forceinline__ Args ldargs() { return Args{}; }
#endif
__global__ void __launch_bounds__(512, 2) mk_fwd(Args a_) {
    extern __shared__ __attribute__((aligned(16))) unsigned char lds_raw[];
    Ctx c; c.lds = (LAS unsigned char*)lds_raw; c.tid = threadIdx.x; c.lane = c.tid & 63; c.wave = __builtin_amdgcn_readfirstlane(c.tid >> 6); const int wv = c.wave;
    c.G = gridDim.x; c.gw = blockIdx.x * 8 + c.wave; c.ngw = c.G * 8;
    volatile LAS unsigned* MISC = (volatile LAS unsigned*)(c.lds + MISC_OFF);
    for (int u = c.tid; u < (LDS_BYTES - RING_BYTES) / 4; u += 512) ((LAS unsigned*)(c.lds + RING_BYTES))[u] = 0u;
    __syncthreads();
    const int ph_lo = a_.ph_lo, ph_hi = a_.ph_hi;
    const bool fused = (ph_hi - ph_lo) > 1;
    unsigned* barw = (unsigned*)a_.ws + CW_BAR;
    XcdBarrier bar; bar.bar = barw; bar.x = 0; bar.st = MISC + 8; bar.t0 = wv;
    if (fused) bar = xcd_barrier_post(barw, MISC + 8, wv);
    int pc = 0;
#define PH_ON (pc >= ph_lo && pc < ph_hi)
#if defined(MK_TL_PROBE)
    const long long tl0 = wall_clock64();
#define PH_END do { xcd_barrier(bar); if (blockIdx.x == 0 && c.tid == 0) mk_probe[pc] = (float)(wall_clock64() - tl0); ++pc; OPQ(c); } while (0)
#else
#define PH_END do { if (PH_ON && pc + 1 < ph_hi) xcd_barrier(bar); ++pc; OPQ(c); } while (0)
#endif
    LAS unsigned char* ring = c.lds;
#define OPQ(cc) do { { unsigned z_ = 0u; asm volatile("" : "+v"(z_)); cc.lane = (int)__builtin_amdgcn_mbcnt_hi(~0u, __builtin_amdgcn_mbcnt_lo(~0u, z_)); } cc.wave = wv; cc.tid = wv * 64 + cc.lane; { int gw_ = (int)blockIdx.x * 8 + wv; asm volatile("" : "+s"(gw_)); cc.gw = gw_; } } while (0)

    if (MKP(0) && PH_ON) { const Args a = ldargs(); unsigned char* ws = a.ws; (void)ws;  phase_prologue(a, c); __syncthreads(); phase_norm1(a, c, 0); }
    PH_END;
#pragma unroll
    for (int hb = 0; hb < 2; ++hb) {
        const size_t toff = (size_t)hb * HTOK;

#if defined(MK_CLK_PROBE)
        long long ck0 = 0, wk0 = 0; if (PH_ON && pc == MK_CLK_PROBE) { ck0 = clock64(); wk0 = wall_clock64(); }
#endif
        if (MKP(2) && PH_ON) { const Args a = ldargs(); unsigned char* ws = a.ws; (void)ws;  pg8::Gemm g{(const bf16*)(ws + (hb ? WS_OA : WS_TM)), (const bf16*)(ws + WS_WIN), HTOK, NCOL, DM};        pg8::StaticOrder S; S.init(HTOK, NCOL, c.G, (int)blockIdx.x);
            EpiProj E{ws + WS_PROJ, (const float*)(ws + WS_LB)}; pg8::gemm_phase<EpiProj, pg8::StaticOrder, GSCHED>(ring, g, S, E, wv); }
#if defined(MK_CLK_PROBE)
        if (PH_ON && pc == MK_CLK_PROBE && blockIdx.x == 0 && c.tid == 0) { const long long dc = clock64() - ck0, dw = wall_clock64() - wk0; const Args a = ldargs(); ((float*)(a.ws + WS_LB + 12288))[0] = (float)dc / (float)dw * 100.f; ((float*)(a.ws + WS_LB + 12288))[1] = (float)dw * 0.01f; }
#endif
        PH_END;
        if (MKP(3) && PH_ON) { const Args a = ldargs(); unsigned char* ws = a.ws; (void)ws;  phase_hgA(a, c); }
        PH_END;
#if defined(MK_SPLIT_SWA)
        if (MKP(4) && PH_ON) { const Args a = ldargs(); phase_swa_hgB<8>(a, c); }
        PH_END;
        if (MKP(4) && PH_ON) { const Args a = ldargs(); phase_swa_hgB<0>(a, c); }
        PH_END;
#else
        if (MKP(4) && PH_ON) { const Args a = ldargs(); phase_swa_hgB<HGB_WAVES>(a, c); }
        PH_END;
#endif
        if (MKP(5) && PH_ON) { const Args a = ldargs(); phase_hgC(a, c); }
        PH_END;
        if (MKP(6) && PH_ON) { const Args a = ldargs(); unsigned char* ws = a.ws; (void)ws;  pg8::Gemm g{(const bf16*)(ws + WS_OA), (const bf16*)(ws + WS_WA), HTOK, DM, DM}; pg8::StaticOrder S; S.init(HTOK, DM, c.G, (int)blockIdx.x);
            EpiGate<false> E{(bf16*)(ws + WS_TM), (const bf16*)(ws + WS_PROJ + PJ_GA), a.in[6]}; pg8::gemm_phase<EpiGate<false>, pg8::StaticOrder, GSCHED>(ring, g, S, E, wv); }
        if (MKP(7) && PH_ON) { const Args a = ldargs(); unsigned char* ws = a.ws; (void)ws;  pg8::Gemm g{(const bf16*)(ws + WS_OB), (const bf16*)(ws + WS_WB), HTOK, DM, DM}; pg8::StaticOrder S; S.init(HTOK, DM, c.G, (int)blockIdx.x);
            EpiGate<true> E{(bf16*)(ws + WS_TM), (const bf16*)(ws + WS_PROJ + PJ_GB), a.in[6] + DM}; pg8::gemm_phase<EpiGate<true>, pg8::StaticOrder, GSCHED>(ring, g, S, E, wv); }
        PH_END;
        if (MKP(8) && PH_ON) { const Args a = ldargs(); unsigned char* ws = a.ws; (void)ws;  pg8::Gemm g{(const bf16*)(ws + WS_TM), (const bf16*)(ws + WS_WMIX), HTOK, DM, DM}; pg8::StaticOrder S; S.init(HTOK, DM, c.G, (int)blockIdx.x);
            EpiResid<false> E{a.in[0] + toff * DM, (bf16*)(ws + WS_XBF) + toff * DM, (float*)(ws + WS_SSQ1) + toff * 16, ws + WS_X1F8 + toff * DM, 1.f}; pg8::gemm_phase<EpiResid<false>, pg8::StaticOrder, GSCHED>(ring, g, S, E, wv);
            if (hb == 0) phase_norm1(a, c, 1); }
        PH_END;
    }
    if (MKP(9) && PH_ON) { const Args a = ldargs(); unsigned char* ws = a.ws; (void)ws;
        phase_expert_weights(a, c);
        { pg8::Gemm g{(const bf16*)(ws + WS_MEMBF), (const bf16*)(ws + WS_WK), NBATCH * MEMLEN, DM, DM}; pg8::StaticOrder S; S.init(NBATCH * MEMLEN, DM, c.G, (int)blockIdx.x);
          EpiStore E{(bf16*)(ws + WS_KX), DM, nullptr, 1.f}; pg8::gemm_phase<EpiStore, pg8::StaticOrder, GSCHED>(ring, g, S, E, wv); }
        { pg8::Gemm g{(const bf16*)(ws + WS_WV), (const bf16*)(ws + WS_MEMBF), DM, NBATCH * MEMLEN, DM}; pg8::StaticOrder S; S.init(DM, NBATCH * MEMLEN, c.G, (int)((blockIdx.x + 64) % c.G));
          EpiStore E{(bf16*)(ws + WS_VXT), NBATCH * MEMLEN, nullptr, 1.f}; pg8::gemm_phase<EpiStore, pg8::StaticOrder, GSCHED>(ring, g, S, E, wv); }
        { pg8::Gemm g{(const bf16*)(ws + WS_X1F8), (const bf16*)(ws + WS_WQ), NTOK, DM, DM}; pg8::StaticOrder S; S.init(NTOK, DM, c.G, (int)blockIdx.x);
          EpiStore E{(bf16*)(ws + WS_Q), DM, (const float*)(ws + WS_SSQ1), F8_WINV}; pg8::gemm_phase8<EpiStore, pg8::StaticOrder, GSCHED>(ring, g, S, E, wv); }
    }
    PH_END;
    if (MKP(10) && PH_ON) { const Args a = ldargs(); phase_xa(a, c); }
    PH_END;
    if (MKP(11) && PH_ON) { const Args a = ldargs(); unsigned char* ws = a.ws; (void)ws;  pg8::Gemm g{(const bf16*)(ws + WS_O), (const bf16*)(ws + WS_WO), NTOK, DM, DM}; pg8::StaticOrder S; S.init(NTOK, DM, c.G, (int)blockIdx.x);
        EpiResid<true> E{nullptr, (bf16*)(ws + WS_XBF), (float*)(ws + WS_SSQ2), ws + WS_X2F8, F8_WINV}; pg8::gemm_phase8<EpiResid<true>, pg8::StaticOrder, GSCHED>(ring, g, S, E, wv); }
    PH_END;
    if (MKP(12) && PH_ON) { const Args a = ldargs(); phase_router(a, c); }
    PH_END;
#define MOE_GEMM1(hb_) do { const Args a = ldargs(); unsigned char* ws = a.ws; moe_tables(ws, (hb_), c.lds, c.tid); \
        const LAS unsigned* tab = (const LAS unsigned*)(c.lds + MOE_TAB_OFF); const int nb = (int)__builtin_amdgcn_readfirstlane(tab[64]); \
        pg8::Gemm g{(const bf16*)(ws + WS_X2F8), (const bf16*)(ws + WS_WGU), NTOK, NEXP * 2048, DM}; GroupedOrder S{nb * 8, 8, c.G, (int)blockIdx.x, (hb_), tab, (const int*)(ws + WS_RTOK)}; \
        EpiSwiglu E{ws + WS_ACT + (size_t)(hb_) * ACT_HALF, a.in[21], (const float*)(ws + WS_RRSTD2)}; pg8::gemm_phase_gather8<EpiSwiglu, GroupedOrder>(ring, g, S, E, wv); } while (0)
#define MOE_GEMM2(hb_, yoff_, i0_, i1_) do { const Args a = ldargs(); unsigned char* ws = a.ws; moe_tables(ws, (hb_), c.lds, c.tid); \
        const LAS unsigned* tab = (const LAS unsigned*)(c.lds + MOE_TAB_OFF); const int nb = (int)__builtin_amdgcn_readfirstlane(tab[64]); \
        pg8::Gemm g{(const bf16*)(ws + WS_ACT + (size_t)(hb_) * ACT_HALF), (const bf16*)(ws + WS_WD), CAPH, NEXP * 1024, DM}; GroupedOrder S{nb * 4, 4, c.G, (int)blockIdx.x, (hb_), tab, (const int*)(ws + WS_RTOK), (i0_), (i1_)}; \
        EpiDown E{(bf16*)(ws + (yoff_)), a.in[23], (const float*)(ws + WS_RGATE2)}; pg8::gemm_phase8<EpiDown, GroupedOrder, GSCHED>(ring, g, S, E, wv); } while (0)
    if (MKP(14) && PH_ON) { MOE_GEMM1(0); }
    PH_END;
    if (MKP(15) && PH_ON) { MOE_GEMM2(0, WS_Y, 0, 0x7fffffff); MOE_GEMM1(1); }
    PH_END;
    if (MKP(15) && PH_ON) { int kq = ((int)blockIdx.x >> 3) % 9; asm volatile("" : "+s"(kq));
#pragma nounroll
        for (int part = 0; part < 2; ++part) { MOE_GEMM2(1, WS_Y1, part ? kq : 0, part ? 0x7fffffff : kq); OPQ(c);
#if defined(MK_COMB_ONLY_K)
            if (part == 0 && kq == MK_COMB_ONLY_K) { const Args a = ldargs(); phase_combine(a, c, 0, WS_Y, MOE_TAB_OFF + 512); OPQ(c); } } }
#else
            if (part == 0) { const Args a = ldargs(); phase_combine(a, c, 0, WS_Y, MOE_TAB_OFF + 512); OPQ(c); } } }
#endif
    PH_END;
    if (MKP(16) && PH_ON) { const Args a = ldargs(); phase_combine(a, c, 1, WS_Y1, MOE_TAB_OFF); }
    PH_END;
#undef MOE_GEMM1
#undef MOE_GEMM2
#if defined(MK_K8_PROBE)
    { const Args a = ldargs(); xcd_barrier(bar); const float v = (float)MK_K8_SCALE * mk_probe[MK_K8_WHICH]; for (size_t i = (size_t)blockIdx.x * 512 + c.tid; i < (size_t)NTOK * DM; i += (size_t)c.G * 512) a.out[i] = (i == 12345) ? v : (float)MK_K8_C; }
#endif
#if defined(MK_TL_PROBE)
    { const Args a = ldargs(); xcd_barrier(bar); const float v = 0.01f * (mk_probe[MK_TL_WHICH] - (MK_TL_WHICH > 0 ? mk_probe[MK_TL_WHICH > 0 ? MK_TL_WHICH - 1 : 0] : 0.f)); for (size_t i = (size_t)blockIdx.x * 512 + c.tid; i < (size_t)NTOK * DM; i += (size_t)c.G * 512) a.out[i] = (i == 12345) ? v : (float)MK_TL_C; }
#endif
#if defined(MK_KLOOP_PROBE)
    { const Args a = ldargs(); xcd_barrier(bar); const float v = (float)MK_KLOOP_Q * floorf(mk_probe[MK_KLOOP_WHICH] * (1.f / (float)MK_KLOOP_Q)); for (size_t i = (size_t)blockIdx.x * 512 + c.tid; i < (size_t)NTOK * DM; i += (size_t)c.G * 512) a.out[i] = v; }
#endif
#if defined(MK_CLK_PROBE)
    { const Args a = ldargs(); xcd_barrier(bar); const float v = ((const float*)(a.ws + WS_LB + 12288))[MK_CLK_WHICH]; for (size_t i = (size_t)blockIdx.x * 512 + c.tid; i < (size_t)NTOK * DM; i += (size_t)c.G * 512) a.out[i] = v; }
#endif
#undef PH_ON
#undef PH_END
}

#if defined(MK_DBG_STOP)
#ifndef MK_DBG_SRC_OUT
#define MK_DBG_SRC_OUT 0
#endif
#ifndef MK_DBG_F32
#define MK_DBG_F32 0
#endif
__global__ void dbg_dump(const unsigned short* src, float* out, size_t n, size_t N) {
    for (size_t i = (size_t)blockIdx.x * blockDim.x + threadIdx.x; i < N; i += (size_t)gridDim.x * blockDim.x) {
        if (i < n) { float v = MK_DBG_F32 ? ((const float*)src)[i] : __builtin_bit_cast(float, (unsigned)src[i] << 16); if (!(fabsf(v) < 1e30f)) v = 12345.f; out[i] = v; }
        else if (!MK_DBG_SRC_OUT) out[i] = 0.f;
    }
}
__global__ void dbg_zero_upper(float* out, size_t n0, size_t N) { for (size_t i = n0 + (size_t)blockIdx.x * blockDim.x + threadIdx.x; i < N; i += (size_t)gridDim.x * blockDim.x) out[i] = 0.f; }
#endif
#if defined(MK_REP_THRASH)
__global__ void dbg_thrash(const f32x4* a, size_t na, const f32x4* b, size_t nb, float* sink) {
    f32x4 acc = (f32x4){0.f, 0.f, 0.f, 0.f};
    for (size_t i = (size_t)blockIdx.x * blockDim.x + threadIdx.x; i < na; i += (size_t)gridDim.x * blockDim.x) acc += a[i];
    for (size_t i = (size_t)blockIdx.x * blockDim.x + threadIdx.x; i < nb; i += (size_t)gridDim.x * blockDim.x) acc += b[i];
    if (acc[0] + acc[1] + acc[2] + acc[3] == 12345.678f) sink[0] = 1.f;
}
#endif
extern "C" void kernel_launch(void* const* d_in, const int* in_sizes, int n_in, void* d_out, int out_size, void* d_ws, size_t ws_size, hipStream_t stream) {
    static int grid = 0;
    if (grid == 0) {
        if (n_in != 25 || out_size != NTOK * DM || ws_size < WS_END) { fprintf(stderr, "kernel_launch: unexpected problem shape (n_in %d, out %d, ws %zu); nothing launched\n", n_in, out_size, ws_size); grid = -1; return; }
        int dev = 0, cus = 0, per_cu = 0;
        if (hipGetDevice(&dev) != hipSuccess || hipDeviceGetAttribute(&cus, hipDeviceAttributeMultiprocessorCount, dev) != hipSuccess) { grid = -1; return; }
        if (hipFuncSetAttribute((const void*)mk_fwd, hipFuncAttributeMaxDynamicSharedMemorySize, LDS_BYTES) != hipSuccess) { fprintf(stderr, "kernel_launch: hipFuncSetAttribute failed\n"); grid = -1; return; }
        if (hipOccupancyMaxActiveBlocksPerMultiprocessor(&per_cu, (const void*)mk_fwd, 512, LDS_BYTES) != hipSuccess || per_cu < 1) { fprintf(stderr, "kernel_launch: occupancy query reports %d blocks per CU\n", per_cu); }
        (void)hipGetLastError();
        grid = cus;
    }
    if (grid < 0) return;
    (void)in_sizes;
    hipMemsetAsync(d_ws, 0, WS_ZERO_BYTES, stream);
    Args a{};
    for (int i = 0; i < 25; ++i) a.in[i] = (const float*)d_in[i];
    a.out = (float*)d_out; a.ws = (unsigned char*)d_ws;
#if defined(MK_DBG_STOP)
    for (int p = 0; p < MK_DBG_STOP; ++p) { a.ph_lo = p; a.ph_hi = p + 1; hipLaunchKernelGGL(mk_fwd, dim3(grid), dim3(512), LDS_BYTES, stream, a); }
    hipLaunchKernelGGL(dbg_dump, dim3(2048), dim3(256), 0, stream, (const unsigned short*)((const unsigned char*)(MK_DBG_SRC_OUT ? d_out : d_ws) + (size_t)MK_DBG_OFF_MIB * MiB), (float*)d_out, (size_t)MK_DBG_MIB * MiB / (MK_DBG_F32 ? 4 : 2), (size_t)NTOK * DM);
    if (MK_DBG_SRC_OUT) hipLaunchKernelGGL(dbg_zero_upper, dim3(2048), dim3(256), 0, stream, (float*)d_out, (size_t)MK_DBG_MIB * MiB / 2, (size_t)NTOK * DM);
#elif MK_PER_PHASE_LAUNCH
#if defined(MK_REP_THRASH) && defined(MK_REP_PC)
    if (MK_REP_PC < 0) for (int r = 0; r < MK_REP_N; ++r) hipLaunchKernelGGL(dbg_thrash, dim3(2048), dim3(256), 0, stream, (const f32x4*)d_in[20], (size_t)NEXP * DM * 2048 / 4, (const f32x4*)d_in[22], (size_t)NEXP * DM * DM / 4, (float*)((char*)d_ws + WS_LB + 8192));
#endif
    for (int p = 0; p < NPHASES; ++p) { a.ph_lo = p; a.ph_hi = p + 1; hipLaunchKernelGGL(mk_fwd, dim3(grid), dim3(512), LDS_BYTES, stream, a);
#if defined(MK_REP_PC)
        if (p == MK_REP_PC) for (int r = 0; r < MK_REP_N; ++r) {
#if defined(MK_REP_THRASH)
            hipLaunchKernelGGL(dbg_thrash, dim3(2048), dim3(256), 0, stream, (const f32x4*)d_in[20], (size_t)NEXP * DM * 2048 / 4, (const f32x4*)d_in[22], (size_t)NEXP * DM * DM / 4, (float*)((char*)d_ws + WS_LB + 8192));
#endif
 if (p == 22 && false) (void)hipMemsetAsync((char*)d_ws + WS_GCNT, 0, 4096, stream); hipLaunchKernelGGL(mk_fwd, dim3(grid), dim3(512), LDS_BYTES, stream, a); }
#endif
    }
#else
    a.ph_lo = 0; a.ph_hi = NPHASES;
    hipLaunchKernelGGL(mk_fwd, dim3(grid), dim3(512), LDS_BYTES, stream, a);
#endif
}
```

```cpp
#include <hip/hip_runtime.h>
#include <cstdio>
#include <cstdint>
#ifndef PG8_RELAX_A
#define PG8_RELAX_A 0
#endif
#ifndef PG8_RELAX_B
#define PG8_RELAX_B 1
#endif
#ifndef PG8_RELAX_C
#define PG8_RELAX_C 1
#endif
namespace pg8 {
#define PG8_LAS __attribute__((address_space(3)))
typedef unsigned short bf16_t;
typedef short bf16x8 __attribute__((ext_vector_type(8)));
typedef float f32x4 __attribute__((ext_vector_type(4)));
typedef unsigned u32x4 __attribute__((ext_vector_type(4)));
constexpr int BM = 256, BK = 64, HALF = 128, HTB = HALF * BK * 2  , STAGE_BYTES = 8 * HTB, NXCD = 8, WGM = 4;

__host__ __device__ __forceinline__ int lds_byte(int r, int c) { const int st = (r >> 4) * 2 + (c >> 5), rr = r & 15, cc = c & 31, ob = rr * 64 + cc * 2; return st * 1024 + (ob ^ (((ob >> 9) & 1) << 5)); }
__host__ __device__ __forceinline__ void stage_rc(int b, int& R, int& C) { const int st = b / 1024, sb = b % 1024, swz = sb ^ (((sb >> 9) & 1) << 5); R = (st >> 1) * 16 + swz / 64; C = (st & 1) * 32 + (swz % 64) / 2; }
__host__ __device__ __forceinline__ int perm32(int rho) { const int n = rho >> 4, i = rho & 15; return 8 * (i >> 2) + 4 * n + (i & 3); }

struct Unit { int pm, pn, aux, cnt; };
struct Gemm { const bf16_t* A; const bf16_t* Bt; int M, N, K; };

struct StaticOrder {
    int nM, nN, nwg, G, c;
    __host__ __device__ void init(int M, int N, int G_, int c_) { nM = M / BM; nN = N / BM; nwg = nM * nN; G = G_; c = c_; }
    __host__ __device__ bool next(int i, Unit& u) const {
        const long L = (long)i * G + c; if (L >= nwg) return false;
        int wgid = (int)L; { const int q = nwg / NXCD, r = nwg % NXCD, xcd = wgid % NXCD, off = wgid / NXCD; wgid = (xcd < r ? xcd * (q + 1) : r * (q + 1) + (xcd - r) * q) + off; }
        const int nig = WGM * nN, gid = wgid / nig, fm = gid * WGM, gsz = (nM - fm) < WGM ? (nM - fm) : WGM;
        u.pm = fm + ((wgid % nig) % gsz); u.pn = (wgid % nig) / gsz; return true;
    }
    __device__ __forceinline__ void a_ready(const Unit&) const {}
    __device__ __forceinline__ void done(const Unit&) const {}
};

__device__ __forceinline__ unsigned cvt_pk_bf16(float lo, float hi) { unsigned r; asm volatile("v_cvt_pk_bf16_f32 %0, %1, %2" : "=v"(r) : "v"(lo), "v"(hi)); return r; }
typedef float f32x2 __attribute__((ext_vector_type(2)));
template <class Epi, class Sched, bool ALIGN_EPI = false, bool SP2 = false>
__device__ __forceinline__ void gemm_phase(PG8_LAS unsigned char* lds, const Gemm g, const Sched& S, const Epi& E, const int wave_in) {
    unsigned z_ = 0u; asm volatile("" : "+v"(z_)); const int tid_ = (int)__builtin_amdgcn_mbcnt_hi(~0u, __builtin_amdgcn_mbcnt_lo(~0u, z_)) + 64 * wave_in;
    const int tid = tid_, wid = __builtin_amdgcn_readfirstlane(tid >> 6), lane = tid & 63, wr = wid >> 2, wc = wid & 3, fr = lane & 15, fq = lane >> 4;
    const int K = g.K, nt = K / BK;
    unsigned voffA[2], voffB[2];
#pragma unroll
    for (int i = 0; i < 2; ++i) { int R, C; stage_rc(tid * 16 + i * 8192, R, C); const int Rb = Epi::PERM ? ((R & ~31) + perm32(R & 31)) : R;
        voffA[i] = (unsigned)(R * K + C) * 2u; voffB[i] = (unsigned)(Rb * K + C) * 2u; }
    const size_t kstep = (size_t)(BK * 2);
    const size_t hstep = (size_t)HALF * K * 2;
    const size_t tstep = 2 * hstep;
    const unsigned ldsw = (unsigned)wid * 1024u;
    const int aoff = lds_byte(wr * 64 + fr, fq * 8), boff = lds_byte(wc * 32 + fr, fq * 8);
#define PG8_SA(b, h) (((b) * 2 + (h)) * HTB)
#define PG8_SB(b, h) ((4 + (b) * 2 + (h)) * HTB)
#define PG8_STAGE(bufoff, gbase, voff) do { _Pragma("unroll") for (int _i = 0; _i < 2; ++_i) \
        __builtin_amdgcn_global_load_lds((const unsigned*)((const char*)(gbase) + (voff)[_i]), (PG8_LAS unsigned*)(lds + (bufoff) + ldsw + _i * 8192), 16, 0, 0); } while (0)
#define PG8_LDA(dst, b, h) do { _Pragma("unroll") for (int m = 0; m < 4; ++m) _Pragma("unroll") for (int k = 0; k < 2; ++k) dst[m][k] = *(const PG8_LAS bf16x8*)(lds + PG8_SA(b, h) + aoff + m * 2048 + k * 1024); } while (0)
#define PG8_LDB(dst, b, h) do { _Pragma("unroll") for (int n = 0; n < 2; ++n) _Pragma("unroll") for (int k = 0; k < 2; ++k) dst[n][k] = *(const PG8_LAS bf16x8*)(lds + PG8_SB(b, h) + boff + n * 2048 + k * 1024); } while (0)
#define PG8_MMA(ai, bj, At, Bt) do { __builtin_amdgcn_s_setprio(1); _Pragma("unroll") for (int m = 0; m < 4; ++m) _Pragma("unroll") for (int n = 0; n < 2; ++n) _Pragma("unroll") for (int k = 0; k < 2; ++k) \
        acc[ai][bj][m][n] = __builtin_amdgcn_mfma_f32_16x16x32_bf16(Bt[n][k], At[m][k], acc[ai][bj][m][n], 0, 0, 0); __builtin_amdgcn_s_setprio(0); } while (0)
#define PG8_WAIT_V(n) asm volatile("s_waitcnt vmcnt(" #n ")" ::: "memory")
#define PG8_WAIT_VN(n) asm volatile("s_waitcnt vmcnt(%0)" :: "n"(n) : "memory")
#define PG8_WAIT_V8R(flag, n) asm volatile("s_waitcnt vmcnt(%1)\n\ts_cmp_lg_u32 %0, 0\n\ts_cbranch_scc1 .Lrw_%=\n\ts_waitcnt vmcnt(8)\n.Lrw_%=:" :: "s"(flag), "n"(n) : "scc", "memory")
#define PG8_WAIT_L(n) asm volatile("s_waitcnt lgkmcnt(" #n ")" ::: "memory")
#define PG8_BAR __builtin_amdgcn_s_barrier()
#define PG8_SCHED __builtin_amdgcn_sched_barrier(0)
    Unit cur, nxt; int ui = 0;
    if (!S.next(0, cur)) return;
    f32x4 acc[2][2][4][2];
#pragma unroll
    for (int a = 0; a < 2; ++a)
#pragma unroll
        for (int b = 0; b < 2; ++b)
#pragma unroll
            for (int m = 0; m < 4; ++m)
#pragma unroll
                for (int n = 0; n < 2; ++n) acc[a][b][m][n] = (f32x4){0.f, 0.f, 0.f, 0.f};
    bf16x8 At[4][2], B0[2][2], B1[2][2];
    const char* cA = (const char*)g.A + (size_t)cur.pm * tstep; const char* cB = (const char*)g.Bt + (size_t)cur.pn * tstep;
    S.a_ready(cur);
    if constexpr (SP2) {
        PG8_STAGE(PG8_SB(0, 0), cB, voffB); PG8_STAGE(PG8_SB(0, 1), cB + hstep, voffB); PG8_STAGE(PG8_SA(0, 0), cA, voffA); PG8_STAGE(PG8_SA(0, 1), cA + hstep, voffA);
        if (wr == 1) PG8_BAR;
        PG8_WAIT_V(2); PG8_BAR;
        PG8_STAGE(PG8_SB(1, 0), cB + kstep, voffB); PG8_STAGE(PG8_SA(1, 0), cA + kstep, voffA); PG8_STAGE(PG8_SB(1, 1), cB + hstep + kstep, voffB);
        PG8_WAIT_V(6); PG8_BAR;
    } else {
        PG8_STAGE(PG8_SB(0, 0), cB, voffB); PG8_STAGE(PG8_SA(0, 0), cA, voffA); PG8_STAGE(PG8_SB(0, 1), cB + hstep, voffB); PG8_STAGE(PG8_SA(0, 1), cA + hstep, voffA);
        if (wr == 1) PG8_BAR;
        PG8_WAIT_V(4); PG8_BAR;
        PG8_STAGE(PG8_SB(1, 0), cB + kstep, voffB); PG8_STAGE(PG8_SA(1, 0), cA + kstep, voffA); PG8_STAGE(PG8_SB(1, 1), cB + hstep + kstep, voffB);
        PG8_WAIT_V(6); PG8_BAR;
    }
    for (;;) {
        const bool has_next = S.next(ui + 1, nxt);
        const char* nA = has_next ? (const char*)g.A + (size_t)nxt.pm * tstep : cA; const char* nB = has_next ? (const char*)g.Bt + (size_t)nxt.pn * tstep : cB;
        for (int t = 0; t < nt; t += 2) {
            const bool last = (t == nt - 2);
            const char* a1 = cA + (size_t)(t + 1) * kstep;
            const char* a2 = last ? nA : cA + (size_t)(t + 2) * kstep; const char* b2 = last ? nB : cB + (size_t)(t + 2) * kstep;
            const char* a3 = a2 + kstep; const char* b3 = b2 + kstep;
            if (last && has_next) S.a_ready(nxt);
            if constexpr (SP2) {
            PG8_LDB(B0, 0, 0); PG8_LDB(B1, 0, 1); PG8_SCHED; PG8_LDA(At, 0, 0); PG8_STAGE(PG8_SA(1, 1), a1 + hstep, voffA);
            PG8_WAIT_V8R(__builtin_amdgcn_readfirstlane((t == 0 && ui > 0) ? 1 : 0), 8 + Epi::NST); PG8_WAIT_L(0); PG8_BAR; PG8_MMA(0, 0, At, B0); PG8_MMA(0, 1, At, B1); PG8_BAR; PG8_SCHED;
            PG8_LDA(At, 0, 1); PG8_STAGE(PG8_SB(0, 0), b2, voffB); PG8_STAGE(PG8_SB(0, 1), b2 + hstep, voffB); PG8_STAGE(PG8_SA(0, 0), a2, voffA);
            PG8_WAIT_V8R(__builtin_amdgcn_readfirstlane((t == 0 && ui > 0) ? 1 : 0), 8 + Epi::NST); PG8_WAIT_L(0); PG8_BAR; PG8_MMA(1, 0, At, B0); PG8_MMA(1, 1, At, B1); PG8_BAR; PG8_SCHED;
            PG8_LDB(B0, 1, 0); PG8_LDB(B1, 1, 1); PG8_SCHED; PG8_LDA(At, 1, 0); PG8_STAGE(PG8_SA(0, 1), a2 + hstep, voffA);
            PG8_WAIT_V(8); PG8_WAIT_L(0); PG8_BAR; PG8_MMA(0, 0, At, B0); PG8_MMA(0, 1, At, B1); PG8_BAR; PG8_SCHED;
            PG8_LDA(At, 1, 1); PG8_STAGE(PG8_SB(1, 0), b3, voffB); PG8_STAGE(PG8_SB(1, 1), b3 + hstep, voffB); PG8_STAGE(PG8_SA(1, 0), a3, voffA);
            PG8_WAIT_V(8); PG8_WAIT_L(0); PG8_BAR; PG8_MMA(1, 0, At, B0); PG8_MMA(1, 1, At, B1); PG8_BAR; PG8_SCHED;
            } else {
            PG8_LDB(B0, 0, 0); PG8_SCHED; PG8_LDA(At, 0, 0); PG8_STAGE(PG8_SA(1, 1), a1 + hstep, voffA);
            PG8_WAIT_L(8); PG8_BAR; PG8_WAIT_L(0); PG8_MMA(0, 0, At, B0); PG8_BAR; PG8_SCHED;
            PG8_LDB(B1, 0, 1); PG8_STAGE(PG8_SB(0, 0), b2, voffB);
            PG8_BAR; PG8_WAIT_L(0); PG8_MMA(0, 1, At, B1); PG8_BAR;
            PG8_LDA(At, 0, 1); PG8_STAGE(PG8_SA(0, 0), a2, voffA);
            PG8_BAR; PG8_WAIT_L(0); PG8_MMA(1, 0, At, B0); PG8_BAR; PG8_SCHED;
            PG8_STAGE(PG8_SB(0, 1), b2 + hstep, voffB);
            PG8_WAIT_V(6); PG8_BAR; PG8_MMA(1, 1, At, B1); PG8_BAR;
            PG8_LDB(B0, 1, 0); PG8_SCHED; PG8_LDA(At, 1, 0); PG8_STAGE(PG8_SA(0, 1), a2 + hstep, voffA);
            PG8_WAIT_L(8); PG8_BAR; PG8_WAIT_L(0); PG8_MMA(0, 0, At, B0); PG8_BAR; PG8_SCHED;
            PG8_LDB(B1, 1, 1); PG8_STAGE(PG8_SB(1, 0), b3, voffB);
            PG8_BAR; PG8_WAIT_L(0); PG8_MMA(0, 1, At, B1); PG8_BAR;
            PG8_LDA(At, 1, 1); PG8_STAGE(PG8_SA(1, 0), a3, voffA);
            PG8_BAR; PG8_WAIT_L(0); PG8_MMA(1, 0, At, B0); PG8_BAR; PG8_SCHED;
            PG8_STAGE(PG8_SB(1, 1), b3 + hstep, voffB);
            PG8_WAIT_V(6); PG8_BAR; PG8_MMA(1, 1, At, B1); PG8_BAR;
            }
        }
        if constexpr (ALIGN_EPI) { if (wr == 0) PG8_BAR; }
        if constexpr (!Epi::AFTER_DRAIN) { E(acc, cur, wr, wc, fr, fq); S.done(cur); }
        if (!has_next) break;
#pragma unroll
        for (int a = 0; a < 2; ++a)
#pragma unroll
            for (int b = 0; b < 2; ++b)
#pragma unroll
                for (int m = 0; m < 4; ++m)
#pragma unroll
                    for (int n = 0; n < 2; ++n) acc[a][b][m][n] = (f32x4){0.f, 0.f, 0.f, 0.f};
        cur = nxt; cA = nA; cB = nB; ++ui;
        if constexpr (ALIGN_EPI) { if (wr == 1) PG8_BAR; }
    }
    PG8_WAIT_V(0);
    if constexpr (!ALIGN_EPI) { if (wr == 0) PG8_BAR; }
    PG8_BAR;
    if constexpr (Epi::AFTER_DRAIN) { E.fused(acc, cur, wr, wc, fr, fq, lds, wid, lane); S.done(cur); }
#undef PG8_SA
#undef PG8_SB
#undef PG8_STAGE
#undef PG8_LDA
#undef PG8_LDB
#undef PG8_MMA
#undef PG8_WAIT_V
#undef PG8_WAIT_VN
#undef PG8_WAIT_V8R
#undef PG8_WAIT_L
#undef PG8_BAR
#undef PG8_SCHED
}
template <class Epi, class Sched>
__device__ __forceinline__ void gemm_phase_gather(PG8_LAS unsigned char* lds, const Gemm g, const Sched& S, const Epi& E, const int wave_in) {
    unsigned z_ = 0u; asm volatile("" : "+v"(z_)); const int tid_ = (int)__builtin_amdgcn_mbcnt_hi(~0u, __builtin_amdgcn_mbcnt_lo(~0u, z_)) + 64 * wave_in;
    const int tid = tid_, wid = __builtin_amdgcn_readfirstlane(tid >> 6), lane = tid & 63, wr = wid >> 2, wc = wid & 3, fr = lane & 15, fq = lane >> 4;
    constexpr bool ALIGN_EPI = true, SP2 = true;
    const int K = g.K, nt = K / BK;
    unsigned voffB[2]; int RA0; unsigned CA0;
#pragma unroll
    for (int i = 0; i < 2; ++i) { int R, C; stage_rc(tid * 16 + i * 8192, R, C); const int Rb = Epi::PERM ? ((R & ~31) + perm32(R & 31)) : R;
        if (i == 0) { RA0 = R; CA0 = (unsigned)C * 2u; } voffB[i] = (unsigned)(Rb * K + C) * 2u; }
    unsigned ro[2], rn[2][2];
    const size_t kstep = (size_t)(BK * 2);
    const size_t hstep = (size_t)HALF * K * 2;
    const size_t tstep = 2 * hstep;
    const unsigned ldsw = (unsigned)wid * 1024u;
    const int aoff = lds_byte(wr * 64 + fr, fq * 8), boff = lds_byte(wc * 32 + fr, fq * 8);
#define PG8_SA(b, h) (((b) * 2 + (h)) * HTB)
#define PG8_SB(b, h) ((4 + (b) * 2 + (h)) * HTB)
#define PG8_STAGE(bufoff, gbase, voff) do { _Pragma("unroll") for (int _i = 0; _i < 2; ++_i) \
        __builtin_amdgcn_global_load_lds((const unsigned*)((const char*)(gbase) + (voff)[_i]), (PG8_LAS unsigned*)(lds + (bufoff) + ldsw + _i * 8192), 16, 0, 0); } while (0)
#define PG8_STAGE_G(bufoff, kbyte, pk) do { _Pragma("unroll") for (int _i = 0; _i < 2; ++_i) { const unsigned _row = _i ? ((pk) >> 16) : ((pk) & 0xffffu); \
        __builtin_amdgcn_global_load_lds((const unsigned*)((const char*)g.A + (kbyte) + (_row * ((unsigned)K * 2u) + CA0)), (PG8_LAS unsigned*)(lds + (bufoff) + ldsw + _i * 8192), 16, 0, 0); } } while (0)
#define PG8_LDA(dst, b, h) do { _Pragma("unroll") for (int m = 0; m < 4; ++m) _Pragma("unroll") for (int k = 0; k < 2; ++k) dst[m][k] = *(const PG8_LAS bf16x8*)(lds + PG8_SA(b, h) + aoff + m * 2048 + k * 1024); } while (0)
#define PG8_LDB(dst, b, h) do { _Pragma("unroll") for (int n = 0; n < 2; ++n) _Pragma("unroll") for (int k = 0; k < 2; ++k) dst[n][k] = *(const PG8_LAS bf16x8*)(lds + PG8_SB(b, h) + boff + n * 2048 + k * 1024); } while (0)
#define PG8_MMA(ai, bj, At, Bt) do { __builtin_amdgcn_s_setprio(1); _Pragma("unroll") for (int m = 0; m < 4; ++m) _Pragma("unroll") for (int n = 0; n < 2; ++n) _Pragma("unroll") for (int k = 0; k < 2; ++k) \
        acc[ai][bj][m][n] = __builtin_amdgcn_mfma_f32_16x16x32_bf16(Bt[n][k], At[m][k], acc[ai][bj][m][n], 0, 0, 0); __builtin_amdgcn_s_setprio(0); } while (0)
#define PG8_WAIT_V(n) asm volatile("s_waitcnt vmcnt(" #n ")" ::: "memory")
#define PG8_WAIT_VN(n) asm volatile("s_waitcnt vmcnt(%0)" :: "n"(n) : "memory")
#define PG8_WAIT_L(n) asm volatile("s_waitcnt lgkmcnt(" #n ")" ::: "memory")
#define PG8_BAR __builtin_amdgcn_s_barrier()
#define PG8_SCHED __builtin_amdgcn_sched_barrier(0)
    Unit cur, nxt; int ui = 0;
    if (!S.next(0, cur)) return;
    f32x4 acc[2][2][4][2];
#pragma unroll
    for (int a = 0; a < 2; ++a)
#pragma unroll
        for (int b = 0; b < 2; ++b)
#pragma unroll
            for (int m = 0; m < 4; ++m)
#pragma unroll
                for (int n = 0; n < 2; ++n) acc[a][b][m][n] = (f32x4){0.f, 0.f, 0.f, 0.f};
    bf16x8 At[4][2], B0[2][2], B1[2][2];
    const char* cB = (const char*)g.Bt + (size_t)cur.pn * tstep;
    S.a_ready(cur);
    S.rows(cur, RA0, rn); ro[0] = rn[0][0] | (rn[0][1] << 16); ro[1] = rn[1][0] | (rn[1][1] << 16);
    if constexpr (SP2) {
        PG8_STAGE(PG8_SB(0, 0), cB, voffB); PG8_STAGE(PG8_SB(0, 1), cB + hstep, voffB); PG8_STAGE_G(PG8_SA(0, 0), 0, ro[0]); PG8_STAGE_G(PG8_SA(0, 1), 0, ro[1]);
        if (wr == 1) PG8_BAR;
        PG8_WAIT_V(2); PG8_BAR;
        PG8_STAGE(PG8_SB(1, 0), cB + kstep, voffB); PG8_STAGE_G(PG8_SA(1, 0), kstep, ro[0]); PG8_STAGE(PG8_SB(1, 1), cB + hstep + kstep, voffB);
        PG8_WAIT_V(6); PG8_BAR;
    }
    for (;;) {
        const bool has_next = S.next(ui + 1, nxt);
        const char* nB = has_next ? (const char*)g.Bt + (size_t)nxt.pn * tstep : cB;
        for (int t = 0; t < nt; t += 2) {
            const bool last = (t == nt - 2);
            const size_t k1 = (size_t)(t + 1) * kstep, k2 = last ? (size_t)0 : (size_t)(t + 2) * kstep, k3 = k2 + kstep;
            const char* b2 = last ? nB : cB + (size_t)(t + 2) * kstep; const char* b3 = b2 + kstep;
            if (t == nt - 4 && has_next) S.rows(nxt, RA0, rn);
            const unsigned c1 = ro[1];
            unsigned s0 = ro[0], s1 = ro[1];
            if (last && has_next) { unsigned q0 = rn[0][0], q1 = rn[0][1], q2 = rn[1][0], q3 = rn[1][1]; asm volatile("" : "+v"(q0), "+v"(q1), "+v"(q2), "+v"(q3));
                s0 = q0 | (q1 << 16); s1 = q2 | (q3 << 16); ro[0] = s0; ro[1] = s1; }
            if (last && has_next) S.a_ready(nxt);
            if constexpr (SP2) {
            PG8_LDB(B0, 0, 0); PG8_LDB(B1, 0, 1); PG8_SCHED; PG8_LDA(At, 0, 0); PG8_STAGE_G(PG8_SA(1, 1), k1, c1);
            PG8_WAIT_V(8); PG8_WAIT_L(0); PG8_BAR; PG8_MMA(0, 0, At, B0); PG8_MMA(0, 1, At, B1); PG8_BAR; PG8_SCHED;
            PG8_LDA(At, 0, 1); PG8_STAGE(PG8_SB(0, 0), b2, voffB); PG8_STAGE(PG8_SB(0, 1), b2 + hstep, voffB); PG8_STAGE_G(PG8_SA(0, 0), k2, s0);
            PG8_WAIT_V(8); PG8_WAIT_L(0); PG8_BAR; PG8_MMA(1, 0, At, B0); PG8_MMA(1, 1, At, B1); PG8_BAR; PG8_SCHED;
            PG8_LDB(B0, 1, 0); PG8_LDB(B1, 1, 1); PG8_SCHED; PG8_LDA(At, 1, 0); PG8_STAGE_G(PG8_SA(0, 1), k2, s1);
            PG8_WAIT_V(8); PG8_WAIT_L(0); PG8_BAR; PG8_MMA(0, 0, At, B0); PG8_MMA(0, 1, At, B1); PG8_BAR; PG8_SCHED;
            PG8_LDA(At, 1, 1); PG8_STAGE(PG8_SB(1, 0), b3, voffB); PG8_STAGE(PG8_SB(1, 1), b3 + hstep, voffB); PG8_STAGE_G(PG8_SA(1, 0), k3, s0);
            PG8_WAIT_V(8); PG8_WAIT_L(0); PG8_BAR; PG8_MMA(1, 0, At, B0); PG8_MMA(1, 1, At, B1); PG8_BAR; PG8_SCHED;
            }
        }
        if constexpr (ALIGN_EPI) { if (wr == 0) PG8_BAR; }
        if constexpr (!Epi::AFTER_DRAIN) { E(acc, cur, wr, wc, fr, fq); S.done(cur); }
        if (!has_next) break;
#pragma unroll
        for (int a = 0; a < 2; ++a)
#pragma unroll
            for (int b = 0; b < 2; ++b)
#pragma unroll
                for (int m = 0; m < 4; ++m)
#pragma unroll
                    for (int n = 0; n < 2; ++n) acc[a][b][m][n] = (f32x4){0.f, 0.f, 0.f, 0.f};
        cur = nxt; cB = nB; ++ui;
        if constexpr (ALIGN_EPI) { if (wr == 1) PG8_BAR; }
    }
    PG8_WAIT_V(0);
    if constexpr (!ALIGN_EPI) { if (wr == 0) PG8_BAR; }
    PG8_BAR;
    if constexpr (Epi::AFTER_DRAIN) { E.fused(acc, cur, wr, wc, fr, fq, lds, wid, lane); S.done(cur); }
#undef PG8_SA
#undef PG8_SB
#undef PG8_STAGE
#undef PG8_STAGE_G
#undef PG8_LDA
#undef PG8_LDB
#undef PG8_MMA
#undef PG8_WAIT_V
#undef PG8_WAIT_VN
#undef PG8_WAIT_L
#undef PG8_BAR
#undef PG8_SCHED
}
typedef int v8i_t __attribute__((ext_vector_type(8)));
template <class Epi, class Sched, bool ALIGN_EPI = false, bool SP2 = false>
__device__ __forceinline__ void gemm_phase8(PG8_LAS unsigned char* lds, const Gemm g, const Sched& S, const Epi& E, const int wave_in) {
    unsigned z_ = 0u; asm volatile("" : "+v"(z_)); const int tid_ = (int)__builtin_amdgcn_mbcnt_hi(~0u, __builtin_amdgcn_mbcnt_lo(~0u, z_)) + 64 * wave_in;
    const int tid = tid_, wid = __builtin_amdgcn_readfirstlane(tid >> 6), lane = tid & 63, wr = wid >> 2, wc = wid & 3, fr = lane & 15, fq = lane >> 4;
    const int K = g.K, nt = K / (2 * BK);
    unsigned voffA[2], voffB[2];
#pragma unroll
    for (int i = 0; i < 2; ++i) { int R, C; stage_rc(tid * 16 + i * 8192, R, C); const int Rb = Epi::PERM ? ((R & ~31) + perm32(R & 31)) : R;
        voffA[i] = (unsigned)(R * K + C * 2); voffB[i] = (unsigned)(Rb * K + C * 2); }
    const size_t kstep = (size_t)(BK * 2);
    const size_t hstep = (size_t)HALF * K;
    const size_t tstep = 2 * hstep;
    const unsigned ldsw = (unsigned)wid * 1024u;
    const int aoff = lds_byte(wr * 64 + fr, fq * 8), boff = lds_byte(wc * 32 + fr, fq * 8);
#define PG8_SA(b, h) (((b) * 2 + (h)) * HTB)
#define PG8_SB(b, h) ((4 + (b) * 2 + (h)) * HTB)
#define PG8_STAGE(bufoff, gbase, voff) do { _Pragma("unroll") for (int _i = 0; _i < 2; ++_i) \
        __builtin_amdgcn_global_load_lds((const unsigned*)((const char*)(gbase) + (voff)[_i]), (PG8_LAS unsigned*)(lds + (bufoff) + ldsw + _i * 8192), 16, 0, 0); } while (0)
#define PG8_LDA(dst, b, h) do { _Pragma("unroll") for (int m = 0; m < 4; ++m) { const u32x4 lo_ = *(const PG8_LAS u32x4*)(lds + PG8_SA(b, h) + aoff + m * 2048), hi_ = *(const PG8_LAS u32x4*)(lds + PG8_SA(b, h) + aoff + m * 2048 + 1024); dst[m] = (v8i_t){(int)lo_.x, (int)lo_.y, (int)lo_.z, (int)lo_.w, (int)hi_.x, (int)hi_.y, (int)hi_.z, (int)hi_.w}; } } while (0)
#define PG8_LDB(dst, b, h) do { _Pragma("unroll") for (int n = 0; n < 2; ++n) { const u32x4 lo_ = *(const PG8_LAS u32x4*)(lds + PG8_SB(b, h) + boff + n * 2048), hi_ = *(const PG8_LAS u32x4*)(lds + PG8_SB(b, h) + boff + n * 2048 + 1024); dst[n] = (v8i_t){(int)lo_.x, (int)lo_.y, (int)lo_.z, (int)lo_.w, (int)hi_.x, (int)hi_.y, (int)hi_.z, (int)hi_.w}; } } while (0)
#define PG8_MMA(ai, bj, At, Bt) do { __builtin_amdgcn_s_setprio(1); _Pragma("unroll") for (int m = 0; m < 4; ++m) _Pragma("unroll") for (int n = 0; n < 2; ++n) \
        asm volatile("v_mfma_f32_16x16x128_f8f6f4 %0, %1, %2, %0" : "+v"(acc[ai][bj][m][n]) : "v"(Bt[n]), "v"(At[m])); __builtin_amdgcn_s_setprio(0); } while (0)
#define PG8_MMAZ(ai, bj, At, Bt) do { __builtin_amdgcn_s_setprio(1); _Pragma("unroll") for (int m = 0; m < 4; ++m) _Pragma("unroll") for (int n = 0; n < 2; ++n) \
        asm volatile("v_mfma_f32_16x16x128_f8f6f4 %0, %1, %2, 0" : "=v"(acc[ai][bj][m][n]) : "v"(Bt[n]), "v"(At[m])); __builtin_amdgcn_s_setprio(0); } while (0)
#define PG8_WAIT_V(n) asm volatile("s_waitcnt vmcnt(" #n ")" ::: "memory")
#define PG8_WAIT_VN(n) asm volatile("s_waitcnt vmcnt(%0)" :: "n"(n) : "memory")
#define PG8_WAIT_L(n) asm volatile("s_waitcnt lgkmcnt(" #n ")" ::: "memory")
#define PG8_BAR __builtin_amdgcn_s_barrier()
#define PG8_SCHED __builtin_amdgcn_sched_barrier(0)
    Unit cur, nxt; int ui = 0;
    if (!S.next(0, cur)) return;
    f32x4 acc[2][2][4][2];
#pragma unroll
    for (int a = 0; a < 2; ++a)
#pragma unroll
        for (int b = 0; b < 2; ++b)
#pragma unroll
            for (int m = 0; m < 4; ++m)
#pragma unroll
                for (int n = 0; n < 2; ++n) (void)0;
    v8i_t At[4], B0[2], B1[2];
    typename Epi::Pre pre;
    const char* cA = (const char*)g.A + (size_t)cur.pm * tstep; const char* cB = (const char*)g.Bt + (size_t)cur.pn * tstep;
    S.a_ready(cur);
    if constexpr (SP2) {
        PG8_STAGE(PG8_SB(0, 0), cB, voffB); PG8_STAGE(PG8_SB(0, 1), cB + hstep, voffB); PG8_STAGE(PG8_SA(0, 0), cA, voffA); PG8_STAGE(PG8_SA(0, 1), cA + hstep, voffA);
        if (wr == 1) PG8_BAR;
        PG8_WAIT_V(2); PG8_BAR;
        PG8_STAGE(PG8_SB(1, 0), cB + kstep, voffB); PG8_STAGE(PG8_SA(1, 0), cA + kstep, voffA); PG8_STAGE(PG8_SB(1, 1), cB + hstep + kstep, voffB);
        PG8_WAIT_V(6); PG8_BAR;
    } else {
        PG8_STAGE(PG8_SB(0, 0), cB, voffB); PG8_STAGE(PG8_SA(0, 0), cA, voffA); PG8_STAGE(PG8_SB(0, 1), cB + hstep, voffB); PG8_STAGE(PG8_SA(0, 1), cA + hstep, voffA);
        if (wr == 1) PG8_BAR;
        PG8_WAIT_V(4); PG8_BAR;
        PG8_STAGE(PG8_SB(1, 0), cB + kstep, voffB); PG8_STAGE(PG8_SA(1, 0), cA + kstep, voffA); PG8_STAGE(PG8_SB(1, 1), cB + hstep + kstep, voffB);
        PG8_WAIT_V(6); PG8_BAR;
    }
    for (;;) {
        const bool has_next = S.next(ui + 1, nxt);
        const char* nA = has_next ? (const char*)g.A + (size_t)nxt.pm * tstep : cA; const char* nB = has_next ? (const char*)g.Bt + (size_t)nxt.pn * tstep : cB;
#pragma nounroll
        for (int t = 0; t < nt; t += 2) {
            const bool last = (t == nt - 2);
            const char* a1 = cA + (size_t)(t + 1) * kstep;
            const char* a2 = last ? nA : cA + (size_t)(t + 2) * kstep; const char* b2 = last ? nB : cB + (size_t)(t + 2) * kstep;
            const char* a3 = a2 + kstep; const char* b3 = b2 + kstep;
            if (last && has_next) S.a_ready(nxt);
            if (last) E.prefetch(pre, cur, wr, wc, fr, fq);
            if constexpr (SP2) {
            PG8_LDB(B0, 0, 0); PG8_LDB(B1, 0, 1); PG8_SCHED; PG8_LDA(At, 0, 0); PG8_STAGE(PG8_SA(1, 1), a1 + hstep, voffA);
            if (PG8_RELAX_B && t == 0 && ui > 0) PG8_WAIT_VN(8 + Epi::NST); else PG8_WAIT_V(8); PG8_WAIT_L(0); PG8_BAR; if (t == 0) { PG8_MMAZ(0, 0, At, B0); PG8_MMAZ(0, 1, At, B1); } else { PG8_MMA(0, 0, At, B0); PG8_MMA(0, 1, At, B1); } PG8_BAR; PG8_SCHED;
            PG8_LDA(At, 0, 1); PG8_STAGE(PG8_SB(0, 0), b2, voffB); PG8_STAGE(PG8_SB(0, 1), b2 + hstep, voffB); PG8_STAGE(PG8_SA(0, 0), a2, voffA);
            if (PG8_RELAX_B && t == 0 && ui > 0) PG8_WAIT_VN(8 + Epi::NST); else PG8_WAIT_V(8); PG8_WAIT_L(0); PG8_BAR; if (t == 0) { PG8_MMAZ(1, 0, At, B0); PG8_MMAZ(1, 1, At, B1); } else { PG8_MMA(1, 0, At, B0); PG8_MMA(1, 1, At, B1); } PG8_BAR; PG8_SCHED;
            PG8_LDB(B0, 1, 0); PG8_LDB(B1, 1, 1); PG8_SCHED; PG8_LDA(At, 1, 0); PG8_STAGE(PG8_SA(0, 1), a2 + hstep, voffA);
            PG8_WAIT_V(8); PG8_WAIT_L(0); PG8_BAR; PG8_MMA(0, 0, At, B0); PG8_MMA(0, 1, At, B1); PG8_BAR; PG8_SCHED;
            PG8_LDA(At, 1, 1); PG8_STAGE(PG8_SB(1, 0), b3, voffB); PG8_STAGE(PG8_SB(1, 1), b3 + hstep, voffB); PG8_STAGE(PG8_SA(1, 0), a3, voffA);
            PG8_WAIT_V(8); PG8_WAIT_L(0); PG8_BAR; PG8_MMA(1, 0, At, B0); PG8_MMA(1, 1, At, B1); PG8_BAR; PG8_SCHED;
            } else {
            PG8_LDB(B0, 0, 0); PG8_SCHED; PG8_LDA(At, 0, 0); PG8_STAGE(PG8_SA(1, 1), a1 + hstep, voffA);
            PG8_WAIT_L(8); PG8_BAR; PG8_WAIT_L(0); PG8_MMA(0, 0, At, B0); PG8_BAR; PG8_SCHED;
            PG8_LDB(B1, 0, 1); PG8_STAGE(PG8_SB(0, 0), b2, voffB);
            PG8_BAR; PG8_WAIT_L(0); PG8_MMA(0, 1, At, B1); PG8_BAR;
            PG8_LDA(At, 0, 1); PG8_STAGE(PG8_SA(0, 0), a2, voffA);
            PG8_BAR; PG8_WAIT_L(0); PG8_MMA(1, 0, At, B0); PG8_BAR; PG8_SCHED;
            PG8_STAGE(PG8_SB(0, 1), b2 + hstep, voffB);
            PG8_WAIT_V(6); PG8_BAR; PG8_MMA(1, 1, At, B1); PG8_BAR;
            PG8_LDB(B0, 1, 0); PG8_SCHED; PG8_LDA(At, 1, 0); PG8_STAGE(PG8_SA(0, 1), a2 + hstep, voffA);
            PG8_WAIT_L(8); PG8_BAR; PG8_WAIT_L(0); PG8_MMA(0, 0, At, B0); PG8_BAR; PG8_SCHED;
            PG8_LDB(B1, 1, 1); PG8_STAGE(PG8_SB(1, 0), b3, voffB);
            PG8_BAR; PG8_WAIT_L(0); PG8_MMA(0, 1, At, B1); PG8_BAR;
            PG8_LDA(At, 1, 1); PG8_STAGE(PG8_SA(1, 0), a3, voffA);
            PG8_BAR; PG8_WAIT_L(0); PG8_MMA(1, 0, At, B0); PG8_BAR; PG8_SCHED;
            PG8_STAGE(PG8_SB(1, 1), b3 + hstep, voffB);
            PG8_WAIT_V(6); PG8_BAR; PG8_MMA(1, 1, At, B1); PG8_BAR;
            }
        }
        E.preload(pre, cur, wr, wc, fr, fq);
        asm volatile("s_nop 15\n\ts_nop 15" ::: "memory");
        if constexpr (ALIGN_EPI) { if (wr == 0) PG8_BAR; }
        if constexpr (!Epi::AFTER_DRAIN) { E(acc, cur, wr, wc, fr, fq, pre); S.done(cur); }
        if (!has_next) break;
#pragma unroll
        for (int a = 0; a < 2; ++a)
#pragma unroll
            for (int b = 0; b < 2; ++b)
#pragma unroll
                for (int m = 0; m < 4; ++m)
#pragma unroll
                    for (int n = 0; n < 2; ++n) (void)0;
        cur = nxt; cA = nA; cB = nB; ++ui;
        if constexpr (ALIGN_EPI) { if (wr == 1) PG8_BAR; }
    }
    PG8_WAIT_V(0);
    if constexpr (!ALIGN_EPI) { if (wr == 0) PG8_BAR; }
    PG8_BAR;
    if constexpr (Epi::AFTER_DRAIN) { E.fused(acc, cur, wr, wc, fr, fq, lds, wid, lane); S.done(cur); }
#undef PG8_SA
#undef PG8_SB
#undef PG8_STAGE
#undef PG8_LDA
#undef PG8_LDB
#undef PG8_MMA
#undef PG8_MMAZ
#undef PG8_WAIT_V
#undef PG8_WAIT_VN
#undef PG8_WAIT_L
#undef PG8_BAR
#undef PG8_SCHED
}
template <class Epi, class Sched>
__device__ __forceinline__ void gemm_phase_gather8(PG8_LAS unsigned char* lds, const Gemm g, const Sched& S, const Epi& E, const int wave_in) {
    unsigned z_ = 0u; asm volatile("" : "+v"(z_)); const int tid_ = (int)__builtin_amdgcn_mbcnt_hi(~0u, __builtin_amdgcn_mbcnt_lo(~0u, z_)) + 64 * wave_in;
    const int tid = tid_, wid = __builtin_amdgcn_readfirstlane(tid >> 6), lane = tid & 63, wr = wid >> 2, wc = wid & 3, fr = lane & 15, fq = lane >> 4;
    constexpr bool ALIGN_EPI = true, SP2 = true;
    const int K = g.K, nt = K / (2 * BK);
    unsigned voffB[2]; int RA0; unsigned CA0;
#pragma unroll
    for (int i = 0; i < 2; ++i) { int R, C; stage_rc(tid * 16 + i * 8192, R, C); const int Rb = Epi::PERM ? ((R & ~31) + perm32(R & 31)) : R;
        if (i == 0) { RA0 = R; CA0 = (unsigned)C * 2u; } voffB[i] = (unsigned)(Rb * K + C * 2); }
    unsigned ro[2], rn[2][2];
    const size_t kstep = (size_t)(BK * 2);
    const size_t hstep = (size_t)HALF * K;
    const size_t tstep = 2 * hstep;
    const unsigned ldsw = (unsigned)wid * 1024u;
    const int aoff = lds_byte(wr * 64 + fr, fq * 8), boff = lds_byte(wc * 32 + fr, fq * 8);
#define PG8_SA(b, h) (((b) * 2 + (h)) * HTB)
#define PG8_SB(b, h) ((4 + (b) * 2 + (h)) * HTB)
#define PG8_STAGE(bufoff, gbase, voff) do { _Pragma("unroll") for (int _i = 0; _i < 2; ++_i) \
        __builtin_amdgcn_global_load_lds((const unsigned*)((const char*)(gbase) + (voff)[_i]), (PG8_LAS unsigned*)(lds + (bufoff) + ldsw + _i * 8192), 16, 0, 0); } while (0)
#define PG8_STAGE_G(bufoff, kbyte, pk) do { _Pragma("unroll") for (int _i = 0; _i < 2; ++_i) { const unsigned _row = _i ? ((pk) >> 16) : ((pk) & 0xffffu); \
        __builtin_amdgcn_global_load_lds((const unsigned*)((const char*)g.A + (kbyte) + (_row * (unsigned)K + CA0)), (PG8_LAS unsigned*)(lds + (bufoff) + ldsw + _i * 8192), 16, 0, 0); } } while (0)
#define PG8_LDA(dst, b, h) do { _Pragma("unroll") for (int m = 0; m < 4; ++m) { const u32x4 lo_ = *(const PG8_LAS u32x4*)(lds + PG8_SA(b, h) + aoff + m * 2048), hi_ = *(const PG8_LAS u32x4*)(lds + PG8_SA(b, h) + aoff + m * 2048 + 1024); dst[m] = (v8i_t){(int)lo_.x, (int)lo_.y, (int)lo_.z, (int)lo_.w, (int)hi_.x, (int)hi_.y, (int)hi_.z, (int)hi_.w}; } } while (0)
#define PG8_LDB(dst, b, h) do { _Pragma("unroll") for (int n = 0; n < 2; ++n) { const u32x4 lo_ = *(const PG8_LAS u32x4*)(lds + PG8_SB(b, h) + boff + n * 2048), hi_ = *(const PG8_LAS u32x4*)(lds + PG8_SB(b, h) + boff + n * 2048 + 1024); dst[n] = (v8i_t){(int)lo_.x, (int)lo_.y, (int)lo_.z, (int)lo_.w, (int)hi_.x, (int)hi_.y, (int)hi_.z, (int)hi_.w}; } } while (0)
#define PG8_MMA(ai, bj, At, Bt) do { __builtin_amdgcn_s_setprio(1); _Pragma("unroll") for (int m = 0; m < 4; ++m) _Pragma("unroll") for (int n = 0; n < 2; ++n) \
        asm volatile("v_mfma_f32_16x16x128_f8f6f4 %0, %1, %2, %0" : "+v"(acc[ai][bj][m][n]) : "v"(Bt[n]), "v"(At[m])); __builtin_amdgcn_s_setprio(0); } while (0)
#define PG8_MMAZ(ai, bj, At, Bt) do { __builtin_amdgcn_s_setprio(1); _Pragma("unroll") for (int m = 0; m < 4; ++m) _Pragma("unroll") for (int n = 0; n < 2; ++n) \
        asm volatile("v_mfma_f32_16x16x128_f8f6f4 %0, %1, %2, 0" : "=v"(acc[ai][bj][m][n]) : "v"(Bt[n]), "v"(At[m])); __builtin_amdgcn_s_setprio(0); } while (0)
#define PG8_WAIT_V(n) asm volatile("s_waitcnt vmcnt(" #n ")" ::: "memory")
#define PG8_WAIT_VN(n) asm volatile("s_waitcnt vmcnt(%0)" :: "n"(n) : "memory")
#define PG8_WAIT_L(n) asm volatile("s_waitcnt lgkmcnt(" #n ")" ::: "memory")
#define PG8_BAR __builtin_amdgcn_s_barrier()
#define PG8_SCHED __builtin_amdgcn_sched_barrier(0)
#define PG8_SPH(m0, m1) do { PG8_WAIT_V(8); PG8_WAIT_L(0); PG8_BAR; m0; m1; PG8_BAR; PG8_SCHED; } while (0)
#define PG8_SPH0(m0, m1) do { if (PG8_RELAX_C && ui > 0) PG8_WAIT_VN(8 + Epi::NST); else PG8_WAIT_V(8); PG8_WAIT_L(0); PG8_BAR; m0; m1; PG8_BAR; PG8_SCHED; } while (0)
    Unit cur, nxt; int ui = 0;
    if (!S.next(0, cur)) return;
    f32x4 acc[2][2][4][2];
#pragma unroll
    for (int a = 0; a < 2; ++a)
#pragma unroll
        for (int b = 0; b < 2; ++b)
#pragma unroll
            for (int m = 0; m < 4; ++m)
#pragma unroll
                for (int n = 0; n < 2; ++n) (void)0;
    v8i_t At[4], B0[2], B1[2];
    typename Epi::Pre pre;
    const char* cB = (const char*)g.Bt + (size_t)cur.pn * tstep;
    S.a_ready(cur);
    S.rows(cur, RA0, rn); ro[0] = rn[0][0] | (rn[0][1] << 16); ro[1] = rn[1][0] | (rn[1][1] << 16);
    if constexpr (SP2) {
        PG8_STAGE(PG8_SB(0, 0), cB, voffB); PG8_STAGE(PG8_SB(0, 1), cB + hstep, voffB); PG8_STAGE_G(PG8_SA(0, 0), 0, ro[0]); PG8_STAGE_G(PG8_SA(0, 1), 0, ro[1]);
        if (wr == 1) PG8_BAR;
        PG8_WAIT_V(2); PG8_BAR;
        PG8_STAGE(PG8_SB(1, 0), cB + kstep, voffB); PG8_STAGE_G(PG8_SA(1, 0), kstep, ro[0]); PG8_STAGE(PG8_SB(1, 1), cB + hstep + kstep, voffB);
        PG8_WAIT_V(6); PG8_BAR;
    }
    for (;;) {
        const bool has_next = S.next(ui + 1, nxt);
        const char* nB = has_next ? (const char*)g.Bt + (size_t)nxt.pn * tstep : cB;
#pragma nounroll
        for (int t = 0; t < nt; t += 2) {
            const bool last = (t == nt - 2);
            const size_t k1 = (size_t)(t + 1) * kstep, k2 = last ? (size_t)0 : (size_t)(t + 2) * kstep, k3 = k2 + kstep;
            const char* b2 = last ? nB : cB + (size_t)(t + 2) * kstep; const char* b3 = b2 + kstep;
            if (t == nt - 4 && has_next) S.rows(nxt, RA0, rn);
            const unsigned c1 = ro[1];
            unsigned s0 = ro[0], s1 = ro[1];
            if (last && has_next) { unsigned q0 = rn[0][0], q1 = rn[0][1], q2 = rn[1][0], q3 = rn[1][1]; asm volatile("" : "+v"(q0), "+v"(q1), "+v"(q2), "+v"(q3));
                s0 = q0 | (q1 << 16); s1 = q2 | (q3 << 16); ro[0] = s0; ro[1] = s1; }
            if (last && has_next) S.a_ready(nxt);
            if (last) E.prefetch(pre, cur, wr, wc, fr, fq);
            if constexpr (SP2) {
            PG8_LDB(B0, 0, 0); PG8_LDB(B1, 0, 1); PG8_SCHED; PG8_LDA(At, 0, 0); PG8_STAGE_G(PG8_SA(1, 1), k1, c1);
            if (t == 0) PG8_SPH0(PG8_MMAZ(0, 0, At, B0), PG8_MMAZ(0, 1, At, B1)); else PG8_SPH(PG8_MMA(0, 0, At, B0), PG8_MMA(0, 1, At, B1));
            PG8_LDA(At, 0, 1); PG8_STAGE(PG8_SB(0, 0), b2, voffB); PG8_STAGE(PG8_SB(0, 1), b2 + hstep, voffB); PG8_STAGE_G(PG8_SA(0, 0), k2, s0);
            if (t == 0) PG8_SPH0(PG8_MMAZ(1, 0, At, B0), PG8_MMAZ(1, 1, At, B1)); else PG8_SPH(PG8_MMA(1, 0, At, B0), PG8_MMA(1, 1, At, B1));
            PG8_LDB(B0, 1, 0); PG8_LDB(B1, 1, 1); PG8_SCHED; PG8_LDA(At, 1, 0); PG8_STAGE_G(PG8_SA(0, 1), k2, s1);
            PG8_SPH(PG8_MMA(0, 0, At, B0), PG8_MMA(0, 1, At, B1));
            PG8_LDA(At, 1, 1); PG8_STAGE(PG8_SB(1, 0), b3, voffB); PG8_STAGE(PG8_SB(1, 1), b3 + hstep, voffB); PG8_STAGE_G(PG8_SA(1, 0), k3, s0);
            PG8_SPH(PG8_MMA(1, 0, At, B0), PG8_MMA(1, 1, At, B1));
            }
        }
        E.preload(pre, cur, wr, wc, fr, fq);
        asm volatile("s_nop 15\n\ts_nop 15" ::: "memory");
        if constexpr (ALIGN_EPI) { if (wr == 0) PG8_BAR; }
        if constexpr (!Epi::AFTER_DRAIN) { E(acc, cur, wr, wc, fr, fq, pre); S.done(cur); }
        if (!has_next) break;
#pragma unroll
        for (int a = 0; a < 2; ++a)
#pragma unroll
            for (int b = 0; b < 2; ++b)
#pragma unroll
                for (int m = 0; m < 4; ++m)
#pragma unroll
                    for (int n = 0; n < 2; ++n) (void)0;
        cur = nxt; cB = nB; ++ui;
        if constexpr (ALIGN_EPI) { if (wr == 1) PG8_BAR; }
    }
    PG8_WAIT_V(0);
    if constexpr (!ALIGN_EPI) { if (wr == 0) PG8_BAR; }
    PG8_BAR;
    if constexpr (Epi::AFTER_DRAIN) { E.fused(acc, cur, wr, wc, fr, fq, lds, wid, lane); S.done(cur); }
#undef PG8_SA
#undef PG8_SB
#undef PG8_STAGE
#undef PG8_STAGE_G
#undef PG8_LDA
#undef PG8_LDB
#undef PG8_MMA
#undef PG8_MMAZ
#undef PG8_WAIT_V
#undef PG8_WAIT_VN
#undef PG8_WAIT_L
#undef PG8_BAR
#undef PG8_SCHED
#undef PG8_SPH
#undef PG8_SPH0
}
}

#ifndef PG8_SP2
#define PG8_SP2 true
#endif
#ifndef PG8_ALIGN
#define PG8_ALIGN true
#endif

constexpr int NTOK = 65536, DM = 1024, NCOL = 7680, SEQ = 4096, NBATCH = 16, HTOK = 32768, MEMLEN = 256;
constexpr int C_HQ = 0, C_HF = 1024, C_HI = 2048, C_HG = 3072, C_SQ = 4096, C_SK = 5120, C_SV = 5376, C_GA = 5632, C_GB = 6656;
constexpr size_t PJ_HQ = 0, PJ_HF = 64 * ((size_t)1 << 20), PJ_HI = 128 * ((size_t)1 << 20), PJ_HG = 192 * ((size_t)1 << 20), PJ_SQ = 256 * ((size_t)1 << 20), PJ_SK = 320 * ((size_t)1 << 20), PJ_SV = 336 * ((size_t)1 << 20), PJ_GA = 352 * ((size_t)1 << 20), PJ_GB = 416 * ((size_t)1 << 20);
constexpr int NEXP = 32, TOPK = 4, CAPH = HTOK * TOPK + NEXP * 256;
constexpr float RMS_EPS = 1e-5f;
constexpr size_t MiB = (size_t)1 << 20;
constexpr size_t WS_ZERO_BYTES = 2 * MiB;
constexpr size_t WS_GCNT = 1 * MiB;
constexpr int CW_TMO = 0, CW_BAR = 4096;
constexpr size_t WS_LB = 2 * MiB, WS_LUT = 2 * MiB + 4096, WS_BLKE = 2 * MiB + 16384, WS_NBT = 2 * MiB + 32768;
constexpr size_t WS_TOPE = 3 * MiB, WS_TOPG = 4 * MiB, WS_TOPR = 5 * MiB, WS_TOPP = 6 * MiB, WS_RGATE = 7 * MiB, WS_RRSTD = 8 * MiB, WS_D12 = 10 * MiB;
constexpr size_t WS_WIN = 16 * MiB, WS_WA = 31 * MiB, WS_WB = 33 * MiB, WS_WMIX = 35 * MiB, WS_WQ = 37 * MiB, WS_WK = 39 * MiB, WS_WV = 41 * MiB, WS_WO = 43 * MiB, WS_WR = 45 * MiB;
constexpr size_t WS_MEMBF = 46 * MiB, WS_KX = 54 * MiB, WS_VXT = 62 * MiB;
constexpr size_t WS_XBF = 72 * MiB;
constexpr size_t WS_PROJ = 200 * MiB, WS_OA = 680 * MiB, WS_OB = 744 * MiB, WS_TM = 808 * MiB;
constexpr size_t WS_Q = 664 * MiB, WS_O = 792 * MiB;
constexpr size_t WS_X1F8 = 872 * MiB;
constexpr size_t WS_X2F8 = 296 * MiB;
constexpr size_t WS_WD = 200 * MiB, WS_WGU = 232 * MiB, WS_Y1 = 232 * MiB, WS_ACT = 392 * MiB, WS_Y = 664 * MiB,     WS_SSQ1 = 936 * MiB, WS_SSQ2 = 940 * MiB, WS_RTOK = 944 * MiB, WS_RGATE2 = 952 * MiB, WS_RRSTD2 = 960 * MiB, WS_END = 968 * MiB;
constexpr size_t ACT_HALF = (size_t)CAPH * 1024;
constexpr size_t OUT_US = 128 * MiB;

#define GAS __attribute__((address_space(1)))
#define LAS __attribute__((address_space(3)))
typedef unsigned short bf16;
typedef unsigned v4u __attribute__((ext_vector_type(4)));
typedef unsigned v2u __attribute__((ext_vector_type(2)));
typedef float f32x4 __attribute__((ext_vector_type(4)));
typedef short bf16x8 __attribute__((ext_vector_type(8)));
typedef short s16x4 __attribute__((ext_vector_type(4)));
#define RLX_AGENT __ATOMIC_RELAXED, __HIP_MEMORY_SCOPE_AGENT
#define LDS_WAIT() asm volatile("s_waitcnt lgkmcnt(0)" ::: "memory")
#define CFENCE() asm volatile("" ::: "memory")
__device__ __forceinline__ unsigned f2bf(float f) { unsigned u = __builtin_bit_cast(unsigned, f); return (u + 0x7fffu + ((u >> 16) & 1u)) >> 16; }
typedef float f32x2_t __attribute__((ext_vector_type(2))); typedef __bf16 bf16x2_t __attribute__((ext_vector_type(2)));
__device__ __forceinline__ unsigned pk2(float lo, float hi) { f32x2_t v = {lo, hi}; bf16x2_t b = __builtin_convertvector(v, bf16x2_t); return __builtin_bit_cast(unsigned, b); }
__device__ __forceinline__ unsigned pk4f8(float a, float b, float c, float d) { int r = 0; r = __builtin_amdgcn_cvt_pk_fp8_f32(a, b, r, false); r = __builtin_amdgcn_cvt_pk_fp8_f32(c, d, r, true); return (unsigned)r; }
constexpr float F8_WSCALE = 64.f, F8_WINV = 1.f / 64.f;
__device__ __forceinline__ float bflo(unsigned w) { return __builtin_bit_cast(float, w << 16); }
__device__ __forceinline__ float bfhi(unsigned w) { return __builtin_bit_cast(float, w & 0xffff0000u); }
__device__ __forceinline__ float fexp(float x) { return __builtin_amdgcn_exp2f(x * 1.4426950408889634f); }
__device__ __forceinline__ float flog(float x) { return __builtin_amdgcn_logf(x) * 0.6931471805599453f; }
__device__ __forceinline__ float sigm(float x) { return __builtin_amdgcn_rcpf(1.f + fexp(-x)); }
__device__ __forceinline__ float shx(float v, int mask, int lane) { return __builtin_bit_cast(float, __builtin_amdgcn_ds_bpermute((lane ^ mask) << 2, __builtin_bit_cast(int, v))); }
__device__ __forceinline__ float wave_sum(float v, int lane) {
#pragma unroll
    for (int o = 1; o < 64; o <<= 1) v += shx(v, o, lane);
    return v;
}
__device__ __forceinline__ f32x4 mfma16(bf16x8 a, bf16x8 b, f32x4 c) { return __builtin_amdgcn_mfma_f32_16x16x32_bf16(a, b, c, 0, 0, 0); }
__device__ __forceinline__ s16x4 vtr(const LAS unsigned char* p) { return __builtin_bit_cast(s16x4, __builtin_amdgcn_ds_read_tr16_b64_v4i16((LAS s16x4*)p)); }
__device__ __forceinline__ bf16x8 cat8(s16x4 lo, s16x4 hi) { return __builtin_shufflevector(lo, hi, 0, 1, 2, 3, 4, 5, 6, 7); }
__device__ __forceinline__ bf16x8 pack8(f32x4 a, f32x4 b) { v4u w; w.x = pk2(a[0], a[1]); w.y = pk2(a[2], a[3]); w.z = pk2(b[0], b[1]); w.w = pk2(b[2], b[3]); return __builtin_bit_cast(bf16x8, w); }
__device__ __forceinline__ float rstd16(const float* ssqp, size_t row) { const f32x4* p = (const f32x4*)(ssqp + row * 16); const f32x4 a = p[0], b = p[1], c = p[2], d = p[3];
    const float s = ((a[0] + a[1]) + (a[2] + a[3])) + ((b[0] + b[1]) + (b[2] + b[3])) + ((c[0] + c[1]) + (c[2] + c[3])) + ((d[0] + d[1]) + (d[2] + d[3])); return rsqrtf(s * (1.f / 1024.f) + 1e-5f); }
__device__ __forceinline__ unsigned ld_agent(const unsigned* p) { return __hip_atomic_load(p, RLX_AGENT); }


#define XB_TMO      128
#define XB_XCNT(j)  (256  + 64 * (j))
#define XB_XSUB(j)  (1280 + 64 * (j))
#define XB_XGEN(j)  (2304 + 64 * (j))
#define XB_TOP      3328
#define XB_TOPGEN   3392
#define XCD_BAR_WORDS 3456
#define XB_SPIN_CAP (1u << 18)

__device__ __forceinline__ unsigned xb_ld(unsigned* p)              { return __hip_atomic_load(p, __ATOMIC_RELAXED, __HIP_MEMORY_SCOPE_AGENT); }
__device__ __forceinline__ unsigned xb_add(unsigned* p, unsigned v) { return __hip_atomic_fetch_add(p, v, __ATOMIC_RELAXED, __HIP_MEMORY_SCOPE_AGENT); }
__device__ __forceinline__ unsigned xb_xcc_id() { return (unsigned)__builtin_amdgcn_s_getreg((3 << 11) | 20) & 0xFu; }
#define XB_SPIN(cond, bar) do { unsigned _sp = 0; while (cond) { __builtin_amdgcn_s_sleep(1); \
    if ((++_sp & 255u) == 0u) { if (xb_ld(&(bar)[XB_TMO])) break; if (_sp > XB_SPIN_CAP) { atomicAdd(&(bar)[XB_TMO], 1u); break; } } } } while (0)

struct XcdBarrier {
    unsigned* bar; unsigned x; int t0;
    volatile LAS unsigned* st;
};

__device__ __forceinline__ bool xb_is_t0(int wave) { return wave == 0 && __builtin_amdgcn_mbcnt_hi(~0u, __builtin_amdgcn_mbcnt_lo(~0u, 0u)) == 0u; }
__device__ __forceinline__ XcdBarrier xcd_barrier_post(unsigned* bar, volatile LAS unsigned* st, int wave) {
    XcdBarrier b; b.bar = bar; b.x = xb_xcc_id(); b.st = st; b.t0 = wave;
    if (xb_is_t0(wave)) (void)xb_add(&bar[XB_XCNT(b.x)], 1u);
    return b;
}
__device__ __forceinline__ void xcd_barrier_complete(unsigned* bar, unsigned x, unsigned& nloc, unsigned& nx) {
    const unsigned G = gridDim.x * gridDim.y * gridDim.z;
    unsigned sum, cnt, mine, sp = 0u;
    for (;;) {
        sum = 0u; cnt = 0u; mine = 0u;
#pragma unroll
        for (unsigned j = 0; j < 16; ++j) { const unsigned c = xb_ld(&bar[XB_XCNT(j)]); sum += c; cnt += (c > 0u) ? 1u : 0u; mine = (j == x) ? c : mine; }
        if (sum == G) break;
        __builtin_amdgcn_s_sleep(1);
        if ((++sp & 255u) == 0u) { if (xb_ld(&bar[XB_TMO])) break; if (sp > XB_SPIN_CAP) { atomicAdd(&bar[XB_TMO], 1u); break; } }
    }
    nloc = mine > 0u ? mine : 1u; nx = cnt > 0u ? cnt : 1u;
}

__device__ __forceinline__ void xcd_barrier(const XcdBarrier& b) {
    asm volatile("s_waitcnt vmcnt(0)" ::: "memory");
    __syncthreads();
    if (xb_is_t0(b.t0)) {
        unsigned* bar = b.bar;
        __builtin_amdgcn_s_waitcnt(0);
        unsigned nloc = b.st[0], nx = b.st[1];
        if (nloc == 0u) { xcd_barrier_complete(bar, b.x, nloc, nx); b.st[0] = nloc; b.st[1] = nx; }
        const unsigned old = xb_add(&bar[XB_XSUB(b.x)], 1u);
        const unsigned gen = old / nloc;
        if (old + 1u == (gen + 1u) * nloc) {
            __builtin_amdgcn_fence(__ATOMIC_RELEASE, "agent");
            asm volatile("s_waitcnt vmcnt(0)" ::: "memory");
            const unsigned og = xb_add(&bar[XB_TOP], 1u);
            const unsigned tg = og / nx;
            if (og + 1u == (tg + 1u) * nx) xb_add(&bar[XB_TOPGEN], 1u);
            else XB_SPIN(xb_ld(&bar[XB_TOPGEN]) == tg, bar);
            __builtin_amdgcn_fence(__ATOMIC_ACQUIRE, "agent");
            xb_add(&bar[XB_XGEN(b.x)], 1u);
            asm volatile("s_waitcnt vmcnt(0)" ::: "memory");
        } else {
            XB_SPIN(xb_ld(&bar[XB_XGEN(b.x)]) == gen, bar);
            __builtin_amdgcn_fence(__ATOMIC_ACQUIRE, "agent");
            asm volatile("s_waitcnt vmcnt(0)" ::: "memory");
        }
    }
    __syncthreads();
}

struct Args {
    const float* in[25];
    float* out; unsigned char* ws;
    int ph_lo, ph_hi;
};

using pg8::Unit;
struct NoPre {};
struct EpiStore {
    static constexpr int NST = 16; static constexpr bool PERM = true, AFTER_DRAIN = false; typedef NoPre Pre;
    __device__ __forceinline__ void prefetch(Pre&, const Unit&, int, int, int, int) const {}
    __device__ __forceinline__ void preload(Pre&, const Unit&, int, int, int, int) const {}
    __device__ __forceinline__ void operator()(const f32x4 (&acc)[2][2][4][2], const Unit& u, int wr, int wc, int fr, int fq, const Pre&) const { (*this)(acc, u, wr, wc, fr, fq); }
    bf16* O; int ldc; const float* ssq; float scl;
    __device__ __forceinline__ void operator()(const f32x4 (&acc)[2][2][4][2], const Unit& u, int wr, int wc, int fr, int fq) const {
        const int row0 = u.pm * 256 + wr * 64 + fr, col0 = u.pn * 256 + wc * 32 + 8 * fq;
#pragma unroll
        for (int ai = 0; ai < 2; ++ai) { float sc[4];
#pragma unroll
            for (int m = 0; m < 4; ++m) sc[m] = (ssq ? rstd16(ssq, (size_t)(row0 + ai * 128 + m * 16)) : 1.f) * scl;
#pragma unroll
            for (int m = 0; m < 4; ++m) { const int row = row0 + ai * 128 + m * 16; bf16* rowp = O + (size_t)row * ldc + col0;
#pragma unroll
                for (int bj = 0; bj < 2; ++bj) { const f32x4 v0 = acc[ai][bj][m][0] * sc[m], v1 = acc[ai][bj][m][1] * sc[m];
                    v4u w; w.x = pk2(v0[0], v0[1]); w.y = pk2(v0[2], v0[3]); w.z = pk2(v1[0], v1[1]); w.w = pk2(v1[2], v1[3]);
                    __builtin_nontemporal_store(w, (v4u*)(rowp + bj * 128)); } } }
    }
};
struct EpiProj {
    static constexpr int NST = 16; static constexpr bool PERM = true, AFTER_DRAIN = false;
    unsigned char* pj; const float* lb;
    __device__ __forceinline__ void operator()(const f32x4 (&acc)[2][2][4][2], const Unit& u, int wr, int wc, int fr, int fq) const {
        const int row0 = u.pm * 256 + wr * 64 + fr, pn = u.pn;
        bf16* base[2]; unsigned rowmul, blmul;
        if (pn < 16) { const int T = pn >> 2; rowmul = 256u; blmul = 8u * 4096u * 256u;
#pragma unroll
            for (int bj = 0; bj < 2; ++bj) base[bj] = (bf16*)(pj + (size_t)T * (64u << 20) + (size_t)(2 * (pn & 3) + bj) * (4096u * 256u)) + wc * 32 + 8 * fq; }
        else if (pn < 20) { rowmul = 128u; blmul = 16u * 4096u * 128u;
#pragma unroll
            for (int bj = 0; bj < 2; ++bj) base[bj] = (bf16*)(pj + PJ_SQ + (size_t)(4 * (pn - 16) + 2 * bj + (wc >> 1)) * (4096u * 128u)) + (wc & 1) * 32 + 8 * fq; }
        else if (pn < 22) { rowmul = 128u; blmul = 4u * 4096u * 128u;
#pragma unroll
            for (int bj = 0; bj < 2; ++bj) base[bj] = (bf16*)(pj + (pn == 20 ? PJ_SK : PJ_SV) + (size_t)(2 * bj + (wc >> 1)) * (4096u * 128u)) + (wc & 1) * 32 + 8 * fq; }
        else { rowmul = 2048u; blmul = 4096u * 2048u;
#pragma unroll
            for (int bj = 0; bj < 2; ++bj) base[bj] = (bf16*)(pj + (pn < 26 ? PJ_GA : PJ_GB)) + ((pn - 22) & 3) * 256 + bj * 128 + wc * 32 + 8 * fq; }
        const int kind = pn < 16 ? (pn >> 2) : 2;
        f32x4 lbv[2][2];
        if (kind == 1) {
#pragma unroll
            for (int bj = 0; bj < 2; ++bj)
#pragma unroll
                for (int n = 0; n < 2; ++n) lbv[bj][n] = *(const f32x4*)(lb + (2 * (pn & 3) + bj) * 128 + wc * 32 + 8 * fq + 4 * n); }
#pragma unroll
        for (int ai = 0; ai < 2; ++ai)
#pragma unroll
            for (int m = 0; m < 4; ++m) { const int row = row0 + ai * 128 + m * 16; const size_t ro = (size_t)(row >> 12) * blmul + (size_t)(row & 4095) * rowmul;
#pragma unroll
                for (int bj = 0; bj < 2; ++bj) { f32x4 v[2] = {acc[ai][bj][m][0], acc[ai][bj][m][1]};
                    if (kind == 0 || kind == 3) {
#pragma unroll
                        for (int n = 0; n < 2; ++n)
#pragma unroll
                            for (int j = 0; j < 4; ++j) v[n][j] = v[n][j] * sigm(v[n][j]); }
                    else if (kind == 1) {
#pragma unroll
                        for (int n = 0; n < 2; ++n)
#pragma unroll
                            for (int j = 0; j < 4; ++j) v[n][j] = lbv[bj][n][j] + (1.f - lbv[bj][n][j]) * sigm(v[n][j]); }
                    v4u w; w.x = pk2(v[0][0], v[0][1]); w.y = pk2(v[0][2], v[0][3]); w.z = pk2(v[1][0], v[1][1]); w.w = pk2(v[1][2], v[1][3]);
                    *(v4u*)((unsigned char*)base[bj] + ro) = w; } }
    }
};
template <bool ADD> struct EpiGate {
    static constexpr int NST = 16; static constexpr bool PERM = true, AFTER_DRAIN = false;
    bf16* T; const bf16* gl; const float* bias;
    __device__ __forceinline__ void operator()(const f32x4 (&acc)[2][2][4][2], const Unit& u, int wr, int wc, int fr, int fq) const {
        const int row0 = u.pm * 256 + wr * 64 + fr, col0 = u.pn * 256 + wc * 32 + 8 * fq;
        f32x4 bv[2][2];
#pragma unroll
        for (int bj = 0; bj < 2; ++bj)
#pragma unroll
            for (int n = 0; n < 2; ++n) bv[bj][n] = *(const f32x4*)(bias + col0 + bj * 128 + 4 * n);
#pragma unroll
        for (int am = 0; am < 4; ++am) { const int ai = am >> 1, mh = am & 1; v4u gw[2][2], tw[2][2];
#pragma unroll
            for (int mm = 0; mm < 2; ++mm)
#pragma unroll
                for (int bj = 0; bj < 2; ++bj) { const int row = row0 + ai * 128 + (2 * mh + mm) * 16; gw[mm][bj] = *(const v4u*)(gl + (size_t)row * DM + col0 + bj * 128);
                    if (ADD) tw[mm][bj] = *(const v4u*)(T + (size_t)row * DM + col0 + bj * 128); }
#pragma unroll
            for (int mm = 0; mm < 2; ++mm)
#pragma unroll
                for (int bj = 0; bj < 2; ++bj) { const int m = 2 * mh + mm; const int row = row0 + ai * 128 + m * 16; const v4u g4 = gw[mm][bj]; float r[8];
                    r[0] = sigm(bflo(g4.x) + bv[bj][0][0]) * acc[ai][bj][m][0][0]; r[1] = sigm(bfhi(g4.x) + bv[bj][0][1]) * acc[ai][bj][m][0][1];
                    r[2] = sigm(bflo(g4.y) + bv[bj][0][2]) * acc[ai][bj][m][0][2]; r[3] = sigm(bfhi(g4.y) + bv[bj][0][3]) * acc[ai][bj][m][0][3];
                    r[4] = sigm(bflo(g4.z) + bv[bj][1][0]) * acc[ai][bj][m][1][0]; r[5] = sigm(bfhi(g4.z) + bv[bj][1][1]) * acc[ai][bj][m][1][1];
                    r[6] = sigm(bflo(g4.w) + bv[bj][1][2]) * acc[ai][bj][m][1][2]; r[7] = sigm(bfhi(g4.w) + bv[bj][1][3]) * acc[ai][bj][m][1][3];
                    if (ADD) { const v4u t4 = tw[mm][bj];
                        r[0] += bflo(t4.x); r[1] += bfhi(t4.x); r[2] += bflo(t4.y); r[3] += bfhi(t4.y); r[4] += bflo(t4.z); r[5] += bfhi(t4.z); r[6] += bflo(t4.w); r[7] += bfhi(t4.w); }
                    v4u w; w.x = pk2(r[0], r[1]); w.y = pk2(r[2], r[3]); w.z = pk2(r[4], r[5]); w.w = pk2(r[6], r[7]);
                    *(v4u*)(T + (size_t)row * DM + col0 + bj * 128) = w; } }
    }
};
template <bool BF> struct EpiResid {
    static constexpr int NST = 16; static constexpr bool PERM = true, AFTER_DRAIN = false; typedef NoPre Pre;
    __device__ __forceinline__ void prefetch(Pre&, const Unit&, int, int, int, int) const {}
    __device__ __forceinline__ void preload(Pre&, const Unit&, int, int, int, int) const {}
    __device__ __forceinline__ void operator()(const f32x4 (&acc)[2][2][4][2], const Unit& u, int wr, int wc, int fr, int fq, const Pre&) const { (*this)(acc, u, wr, wc, fr, fq); }
    const float* base; bf16* obf; float* ssq; unsigned char* f8; float scl;
    __device__ __forceinline__ void operator()(const f32x4 (&acc)[2][2][4][2], const Unit& u, int wr, int wc, int fr, int fq) const {
        const int row0 = u.pm * 256 + wr * 64 + fr, col0 = u.pn * 256 + wc * 32 + 8 * fq;
#pragma unroll
        for (int ai = 0; ai < 2; ++ai)
#pragma unroll
            for (int mh = 0; mh < 2; ++mh) { f32x4 b0[2][2], b1[2][2];
#pragma unroll
                for (int mm = 0; mm < 2; ++mm)
#pragma unroll
                    for (int bj = 0; bj < 2; ++bj) { const size_t off = (size_t)(row0 + ai * 128 + (2 * mh + mm) * 16) * DM + col0 + bj * 128;
                        if (BF) { const v4u bw = *(const v4u*)(obf + off); b0[mm][bj] = (f32x4){bflo(bw.x), bfhi(bw.x), bflo(bw.y), bfhi(bw.y)}; b1[mm][bj] = (f32x4){bflo(bw.z), bfhi(bw.z), bflo(bw.w), bfhi(bw.w)}; }
                        else { b0[mm][bj] = *(const f32x4*)(base + off); b1[mm][bj] = *(const f32x4*)(base + off + 4); } }
#pragma unroll
                for (int mm = 0; mm < 2; ++mm) { const int m = 2 * mh + mm; const int row = row0 + ai * 128 + m * 16; float ss = 0.f;
#pragma unroll
                    for (int bj = 0; bj < 2; ++bj) { const size_t off = (size_t)row * DM + col0 + bj * 128;
                        const f32x4 v0 = b0[mm][bj] + acc[ai][bj][m][0] * scl, v1 = b1[mm][bj] + acc[ai][bj][m][1] * scl;
                        v4u w; w.x = pk2(v0[0], v0[1]); w.y = pk2(v0[2], v0[3]); w.z = pk2(v1[0], v1[1]); w.w = pk2(v1[2], v1[3]);
                        *(v4u*)(obf + off) = w;
                        if (f8) { v2u q; q.x = pk4f8(v0[0], v0[1], v0[2], v0[3]); q.y = pk4f8(v1[0], v1[1], v1[2], v1[3]); *(v2u*)(f8 + off) = q; }
                        ss += ((v0[0] * v0[0] + v0[1] * v0[1]) + (v0[2] * v0[2] + v0[3] * v0[3])) + ((v1[0] * v1[0] + v1[1] * v1[1]) + (v1[2] * v1[2] + v1[3] * v1[3])); }
                    { const int ln_ = fr + 16 * fq; ss += shx(ss, 16, ln_); ss += shx(ss, 32, ln_); }
                    if (fq == 0) ssq[(size_t)row * 16 + (u.pn & 3) * 4 + wc] = ss; } }
    }
};
struct EpiSwiglu {
    static constexpr int NST = 8; static constexpr bool PERM = true, AFTER_DRAIN = false;
    unsigned char* act; const float* bgu; const float* row_rstd;
    struct Pre { float rs[2][4]; f32x4 bg[2], bl[2]; };
    __device__ __forceinline__ void prefetch(Pre& p, const Unit& u, int wr, int wc, int fr, int fq) const {
        const int e = u.pn >> 3, pnl = u.pn & 7, rr0 = wr * 64 + fr, cl0 = pnl * 128 + wc * 32 + 8 * fq;
#pragma unroll
        for (int ai = 0; ai < 2; ++ai)
#pragma unroll
            for (int m = 0; m < 4; ++m) p.rs[ai][m] = row_rstd[u.aux + rr0 + ai * 128 + m * 16];
        (void)e; (void)cl0;
    }
    __device__ __forceinline__ void preload(Pre& p, const Unit& u, int wr, int wc, int fr, int fq) const {
        const int e = u.pn >> 3, pnl = u.pn & 7, cl0 = pnl * 128 + wc * 32 + 8 * fq; (void)wr; (void)fr;
#pragma unroll
        for (int n = 0; n < 2; ++n) { p.bg[n] = *(const f32x4*)(bgu + e * 2048 + cl0 + 4 * n); p.bl[n] = *(const f32x4*)(bgu + e * 2048 + 1024 + cl0 + 4 * n); }
    }
    __device__ __forceinline__ void operator()(const f32x4 (&acc)[2][2][4][2], const Unit& u, int wr, int wc, int fr, int fq, const Pre& p) const {
        const int pnl = u.pn & 7;
        const int rr0 = wr * 64 + fr, cl0 = pnl * 128 + wc * 32 + 8 * fq;
        typedef float f32x2 __attribute__((ext_vector_type(2)));
        f32x4 bg[2], bl[2];
#pragma unroll
        for (int n = 0; n < 2; ++n) { bg[n] = p.bg[n]; bl[n] = p.bl[n] + 1.0f; }
#pragma unroll
        for (int ai = 0; ai < 2; ++ai)
#pragma unroll
            for (int m = 0; m < 4; ++m) { const int row = u.pm * 256 + rr0 + ai * 128 + m * 16; const float rs1 = p.rs[ai][m] * F8_WINV; const f32x2 rs = {rs1, rs1};
                float r[8];
#pragma unroll
                for (int n = 0; n < 2; ++n)
#pragma unroll
                    for (int jp = 0; jp < 2; ++jp) {
                        f32x2 gl = (f32x2){acc[ai][0][m][n][2 * jp], acc[ai][0][m][n][2 * jp + 1]} * rs + (f32x2){bg[n][2 * jp], bg[n][2 * jp + 1]};
                        f32x2 li = (f32x2){acc[ai][1][m][n][2 * jp], acc[ai][1][m][n][2 * jp + 1]} * rs + (f32x2){bl[n][2 * jp], bl[n][2 * jp + 1]};
                        gl = (f32x2){fminf(gl[0], 7.0f), fminf(gl[1], 7.0f)}; li = (f32x2){__builtin_amdgcn_fmed3f(li[0], -6.0f, 8.0f), __builtin_amdgcn_fmed3f(li[1], -6.0f, 8.0f)};
                        const f32x2 t = gl * (-1.702f * 1.4426950408889634f);
                        const f32x2 d = (f32x2){__builtin_amdgcn_exp2f(t[0]), __builtin_amdgcn_exp2f(t[1])} + 1.0f;
                        const f32x2 o = gl * (f32x2){__builtin_amdgcn_rcpf(d[0]), __builtin_amdgcn_rcpf(d[1])} * li;
                        r[n * 4 + 2 * jp] = o[0]; r[n * 4 + 2 * jp + 1] = o[1]; }
                v2u w; w.x = pk4f8(r[0], r[1], r[2], r[3]); w.y = pk4f8(r[4], r[5], r[6], r[7]);
                *(v2u*)(act + (size_t)row * DM + cl0) = w; }
    }
};
struct EpiDown {
    static constexpr int NST = 16; static constexpr bool PERM = true, AFTER_DRAIN = false;
    bf16* y; const float* bd; const float* row_gate;
    struct Pre { float gt[2][4]; f32x4 bv[2][2]; };
    __device__ __forceinline__ void prefetch(Pre& p, const Unit& u, int wr, int wc, int fr, int fq) const {
        const int e = u.pn >> 2, pnl = u.pn & 3, rr0 = wr * 64 + fr, col0 = pnl * 256 + wc * 32 + 8 * fq;
#pragma unroll
        for (int ai = 0; ai < 2; ++ai)
#pragma unroll
            for (int m = 0; m < 4; ++m) p.gt[ai][m] = row_gate[u.aux + rr0 + ai * 128 + m * 16];
        (void)e; (void)col0;
    }
    __device__ __forceinline__ void preload(Pre& p, const Unit& u, int wr, int wc, int fr, int fq) const {
        const int e = u.pn >> 2, pnl = u.pn & 3, col0 = pnl * 256 + wc * 32 + 8 * fq; (void)wr; (void)fr;
#pragma unroll
        for (int bj = 0; bj < 2; ++bj)
#pragma unroll
            for (int n = 0; n < 2; ++n) p.bv[bj][n] = *(const f32x4*)(bd + e * 1024 + col0 + bj * 128 + 4 * n);
    }
    __device__ __forceinline__ void operator()(const f32x4 (&acc)[2][2][4][2], const Unit& u, int wr, int wc, int fr, int fq, const Pre& p) const {
        const int pnl = u.pn & 3;
        const int rr0 = wr * 64 + fr, col0 = pnl * 256 + wc * 32 + 8 * fq;
        f32x4 bv[2][2];
#pragma unroll
        for (int bj = 0; bj < 2; ++bj)
#pragma unroll
            for (int n = 0; n < 2; ++n) bv[bj][n] = p.bv[bj][n];
#pragma unroll
        for (int ai = 0; ai < 2; ++ai)
#pragma unroll
            for (int m = 0; m < 4; ++m) { const int row = u.pm * 256 + rr0 + ai * 128 + m * 16;
#pragma unroll
                for (int bj = 0; bj < 2; ++bj) { const f32x4 v0 = (acc[ai][bj][m][0] * F8_WINV + bv[bj][0]) * p.gt[ai][m], v1 = (acc[ai][bj][m][1] * F8_WINV + bv[bj][1]) * p.gt[ai][m];
                    v4u w; w.x = pk2(v0[0], v0[1]); w.y = pk2(v0[2], v0[3]); w.z = pk2(v1[0], v1[1]); w.w = pk2(v1[2], v1[3]);
                    *(v4u*)(y + (size_t)row * DM + col0 + bj * 128) = w; } }
    }
};
struct GroupedOrder {
    int nunits, npn, G, c, half; const LAS unsigned* tab; const int* row_tok; int i0 = 0, i1 = 0x7fffffff;
    __device__ __forceinline__ bool next(int i, Unit& u) const {
        i += i0; if (i >= i1) return false;
        const int spx = G >> 3, xcd = c & 7, slot = c >> 3;
        const long L = ((long)i * 8 + xcd) * spx + slot; if (L >= nunits) return false;
        const int rb = (int)(L / npn), pn = (int)(L % npn);
        unsigned z_ = 0u; asm volatile("" : "+v"(z_)); const int l31 = (int)__builtin_amdgcn_mbcnt_hi(~0u, __builtin_amdgcn_mbcnt_lo(~0u, z_)) & 31;
        const unsigned st = tab[32 + l31], ct = tab[l31];
        const int e = __builtin_popcount((unsigned)__builtin_amdgcn_ballot_w64((unsigned)rb >= st)) - 1;
        const int j = rb - __builtin_amdgcn_readlane((int)st, e), cn = __builtin_amdgcn_readlane((int)ct, e) - 256 * j;
        u.pm = rb; u.pn = e * npn + pn; u.aux = (half * 32 + e) * HTOK + 256 * j; u.cnt = cn < 256 ? cn : 256; return true;
    }
    __device__ __forceinline__ void rows(const Unit& u, int RA0, unsigned (&rn)[2][2]) const {
#pragma unroll
        for (int h = 0; h < 2; ++h) { const int r0 = h * 128 + RA0, r1 = r0 + 64, cm = u.cnt - 1;
            rn[h][0] = (unsigned)row_tok[u.aux + (r0 < cm ? r0 : cm)]; rn[h][1] = (unsigned)row_tok[u.aux + (r1 < cm ? r1 : cm)]; }
    }
    __device__ __forceinline__ void a_ready(const Unit&) const {}
    __device__ __forceinline__ void done(const Unit&) const {}
};
constexpr int MOE_TAB_OFF = 131072 + 1024;
__device__ __forceinline__ void moe_tables(const unsigned char* ws, int hb, LAS unsigned char* lds, int tid, int off = MOE_TAB_OFF) {
    LAS unsigned* tab = (LAS unsigned*)(lds + off); const unsigned* gcnt = (const unsigned*)(ws + WS_GCNT);
    __syncthreads();
    if (tid < 32) tab[tid] = ld_agent(gcnt + (hb * 32 + tid) * 16);
    __syncthreads();
    if (tid < 32) { unsigned acc = 0, tot = 0;
        for (int e = 0; e < 32; ++e) { const unsigned nb = (tab[e] + 255u) >> 8; acc += e < tid ? nb : 0u; tot += nb; }
        tab[32 + tid] = acc; if (tid == 0) tab[64] = tot; }
    __syncthreads();
}

constexpr int RING_BYTES = 131072, MISC_OFF = RING_BYTES + 320, LDS_BYTES = 147456;

struct Ctx { LAS unsigned char* lds; int tid, lane, wave, G, gw, ngw; };

struct TItem { f32x4 v[8]; float gv[8]; };
__device__ __forceinline__ void titem_load(TItem& t, const float* W, int N, const float* gain, int k0, int n0, int lane) {
#pragma unroll
    for (int i = 0; i < 8; ++i) { const int kk = 8 * i + (lane >> 3); t.v[i] = *(const f32x4*)(W + (size_t)(k0 + kk) * N + n0 + (lane & 7) * 4); t.gv[i] = gain ? gain[k0 + kk] : 1.f; }
}
__device__ __forceinline__ void titem_to_lds(const TItem& t, LAS float* scr, int lane) {
#pragma unroll
    for (int i = 0; i < 8; ++i) { const int kk = 8 * i + (lane >> 3); LAS float* p = scr + kk * 33 + (lane & 7) * 4;
        p[0] = t.v[i][0] * t.gv[i]; p[1] = t.v[i][1] * t.gv[i]; p[2] = t.v[i][2] * t.gv[i]; p[3] = t.v[i][3] * t.gv[i]; }
    LDS_WAIT();
}
template <class RowMap>
__device__ __forceinline__ void titem_out(int K, bf16* WT, const LAS float* scr, int k0, int n0, int lane, RowMap rm) {
    const int c = lane & 7;
#pragma unroll
    for (int j = 0; j < 4; ++j) { const int n = (lane >> 3) + 8 * j; const LAS float* s = scr + (8 * c) * 33 + n;
        v4u o; o.x = pk2(s[0 * 33], s[1 * 33]); o.y = pk2(s[2 * 33], s[3 * 33]); o.z = pk2(s[4 * 33], s[5 * 33]); o.w = pk2(s[6 * 33], s[7 * 33]);
        *(v4u*)(WT + (size_t)rm(n0 + n) * K + k0 + 8 * c) = o; }
    LDS_WAIT();
}
template <class RowMap>
__device__ __forceinline__ void titem_out8(int K, unsigned char* WT, const LAS float* scr, int k0, int n0, int lane, RowMap rm) {
    const int c = lane & 7;
#pragma unroll
    for (int j = 0; j < 4; ++j) { const int n = (lane >> 3) + 8 * j; const LAS float* s = scr + (8 * c) * 33 + n;
        v2u o; o.x = pk4f8(s[0 * 33] * F8_WSCALE, s[1 * 33] * F8_WSCALE, s[2 * 33] * F8_WSCALE, s[3 * 33] * F8_WSCALE); o.y = pk4f8(s[4 * 33] * F8_WSCALE, s[5 * 33] * F8_WSCALE, s[6 * 33] * F8_WSCALE, s[7 * 33] * F8_WSCALE);
        *(v2u*)(WT + (size_t)rm(n0 + n) * K + k0 + 8 * c) = o; }
    LDS_WAIT();
}
template <class RowMap>
__device__ __forceinline__ void transpose_item(const float* W, int K, int N, bf16* WT, const float* gain, LAS float* scr, int item, int lane, RowMap rm) {
    const int nblk = N / 32, kb = item / nblk, nb = item % nblk, k0 = 64 * kb, n0 = 32 * nb;
    TItem t; titem_load(t, W, N, gain, k0, n0, lane); titem_to_lds(t, scr, lane); titem_out(K, WT, scr, k0, n0, lane, rm);
}
template <class RowMap>
__device__ __forceinline__ void transpose_item8(const float* W, int K, int N, unsigned char* WT, const float* gain, LAS float* scr, int item, int lane, RowMap rm) {
    const int nblk = N / 32, kb = item / nblk, nb = item % nblk, k0 = 64 * kb, n0 = 32 * nb;
    TItem t; titem_load(t, W, N, gain, k0, n0, lane); titem_to_lds(t, scr, lane); titem_out8(K, WT, scr, k0, n0, lane, rm);
}
struct RowId { int off; __device__ __forceinline__ int operator()(int n) const { return off + n; } };
struct RowGU { int e; __device__ __forceinline__ int operator()(int n) const { const int j = n & 1023; return e * 2048 + (j >> 7) * 256 + (n >> 10) * 128 + (j & 127); } };

__device__ __forceinline__ void rms_row_to_bf16(const float* xrow, const float* gain, bf16* orow, int lane) {
    const f32x4* xr = (const f32x4*)xrow + lane; const f32x4* gr = (const f32x4*)gain + lane;
    f32x4 v[4]; float s = 0.f;
#pragma unroll
    for (int j = 0; j < 4; ++j) { v[j] = xr[64 * j]; s += (v[j][0] * v[j][0] + v[j][1] * v[j][1]) + (v[j][2] * v[j][2] + v[j][3] * v[j][3]); }
    const float rstd = rsqrtf(wave_sum(s, lane) * (1.f / DM) + RMS_EPS);
    unsigned long long* o8 = (unsigned long long*)orow + lane;
#pragma unroll
    for (int j = 0; j < 4; ++j) { const f32x4 g = gr[64 * j]; const f32x4 w = v[j] * rstd * g;
        o8[64 * j] = (unsigned long long)pk2(w[0], w[1]) | ((unsigned long long)pk2(w[2], w[3]) << 32); }
}

__device__ __forceinline__ void phase_prologue(const Args& a, const Ctx& c) {
    LAS float* scr = (LAS float*)(c.lds + c.wave * 16384);
    unsigned char* ws = a.ws;
    constexpr int I_IN = 16 * (NCOL / 32), I_SQ = 16 * 32, I_R = 16;
    constexpr int NIT = I_IN + 7 * I_SQ + I_R;
    for (int it = c.gw; it < NIT; it += c.ngw) {
        int r = it;
        if (r < I_IN) { transpose_item(a.in[5], DM, NCOL, (bf16*)(ws + WS_WIN), nullptr, scr, r, c.lane, RowId{0}); continue; } r -= I_IN;
        if (r < I_SQ) { transpose_item(a.in[9], DM, DM, (bf16*)(ws + WS_WA), nullptr, scr, r, c.lane, RowId{0}); continue; } r -= I_SQ;
        if (r < I_SQ) { transpose_item(a.in[10], DM, DM, (bf16*)(ws + WS_WB), nullptr, scr, r, c.lane, RowId{0}); continue; } r -= I_SQ;
        if (r < I_SQ) { transpose_item(a.in[11], DM, DM, (bf16*)(ws + WS_WMIX), nullptr, scr, r, c.lane, RowId{0}); continue; } r -= I_SQ;
        if (r < I_SQ) { transpose_item8(a.in[13], DM, DM, ws + WS_WQ, a.in[12], scr, r, c.lane, RowId{0}); continue; } r -= I_SQ;
        if (r < I_SQ) { transpose_item(a.in[14], DM, DM, (bf16*)(ws + WS_WK), nullptr, scr, r, c.lane, RowId{0}); continue; } r -= I_SQ;
        if (r < I_SQ) { transpose_item(a.in[15], DM, DM, (bf16*)(ws + WS_WV), nullptr, scr, r, c.lane, RowId{0}); continue; } r -= I_SQ;
        if (r < I_SQ) { transpose_item8(a.in[16], DM, DM, ws + WS_WO, nullptr, scr, r, c.lane, RowId{0}); continue; } r -= I_SQ;
        transpose_item(a.in[18], DM, NEXP, (bf16*)(ws + WS_WR), a.in[17], scr, r, c.lane, RowId{0});
    }
    { const size_t n8 = (size_t)NBATCH * MEMLEN * DM / 8; const float* mem = a.in[1]; bf16* mb = (bf16*)(ws + WS_MEMBF);
      for (size_t i = (size_t)c.gw * 64 + c.lane; i < n8; i += (size_t)c.ngw * 64) { const f32x4 v0 = *(const f32x4*)(mem + i * 8), v1 = *(const f32x4*)(mem + i * 8 + 4);
          v4u w; w.x = pk2(v0[0], v0[1]); w.y = pk2(v0[2], v0[3]); w.z = pk2(v1[0], v1[1]); w.w = pk2(v1[2], v1[3]); *(v4u*)(mb + i * 8) = w; } }
    if (c.gw == 0) {
        float* lb = (float*)(ws + WS_LB); const float* lbl = a.in[3];
        for (int k = c.lane; k < 1024; k += 64) lb[k] = 1.f / (1.f + expf(lbl[1024 + k] - lbl[k]));
    }
    if (c.gw == 1) {
        float* lut = (float*)(ws + WS_LUT); const float* t5 = a.in[2];
        for (int i = c.lane; i < 16 * 128; i += 64) { const int h = i >> 7, d = i & 127; int b = d;
            if (d >= 16) { b = 16 + (int)(logf((float)d * (1.f / 16.f)) / logf(8.f) * 16.f); b = b < 31 ? b : 31; }
            lut[i] = t5[b * 16 + h]; }
    }
}

__device__ __forceinline__ void phase_norm1(const Args& a, const Ctx& c, int hb) {
    const float* x = a.in[0] + (size_t)hb * HTOK * DM; bf16* xn = (bf16*)(a.ws + (hb ? WS_OA : WS_TM));
    for (int m = c.gw; m < HTOK; m += c.ngw) rms_row_to_bf16(x + (size_t)m * DM, a.in[4], xn + (size_t)m * DM, c.lane);
}

constexpr int SWA_VB = 32 * 144;
constexpr int SWA_LUT_OFF = 8 * 2 * SWA_VB;
__device__ __forceinline__ void swa_unit(const bf16* proj, bf16* ob, int bl, int kvh, int tt, const LAS float* lut, LAS unsigned char* vbuf, const float* sinks, int lane) {
    const int l15 = lane & 15, g = lane >> 4, q4 = l15 >> 2, p4 = lane & 3;
    const int t0 = tt * 16; const size_t rowb = (size_t)bl * SEQ;
    const bf16* sq = (const bf16*)((const unsigned char*)proj + PJ_SQ) + (size_t)(bl * 16 + kvh * 4) * SEQ * 64;
    const bf16* sk = (const bf16*)((const unsigned char*)proj + PJ_SK) + (size_t)(bl * 4 + kvh) * SEQ * 64;
    const bf16* sv = (const bf16*)((const unsigned char*)proj + PJ_SV) + (size_t)(bl * 4 + kvh) * SEQ * 64;
    bf16x8 qf[4][2];
#pragma unroll
    for (int gq = 0; gq < 4; ++gq)
#pragma unroll
        for (int ks = 0; ks < 2; ++ks) qf[gq][ks] = *(const bf16x8*)(sq + ((size_t)gq * SEQ + t0 + l15) * 64 + ks * 32 + 8 * g);
    float mx[4], ls[4]; f32x4 o[4][4];
#pragma unroll
    for (int gq = 0; gq < 4; ++gq) { mx[gq] = sinks[kvh * 4 + gq]; ls[gq] = 1.f;
#pragma unroll
        for (int dt = 0; dt < 4; ++dt) o[gq][dt] = (f32x4){0.f, 0.f, 0.f, 0.f}; }
    for (int c = 0; c < 5; ++c) {
        const int kc = t0 - 144 + 32 * c;
        if (kc + 31 < 0) continue;
        LAS unsigned char* vb = vbuf + (c & 1) * SWA_VB;
#pragma unroll
        for (int i = 0; i < 4; ++i) { const int p = lane + 64 * i, key = p >> 3, d8 = p & 7; int kr = kc + key; kr = kr < 0 ? 0 : kr;
            const v4u vv = *(const v4u*)(sv + (size_t)kr * 64 + d8 * 8);
            *(LAS v4u*)(vb + key * 144 + d8 * 16) = vv; }
        f32x4 s[4][2];
#pragma unroll
        for (int ksub = 0; ksub < 2; ++ksub) { int kr = kc + 16 * ksub + l15; kr = kr < 0 ? 0 : kr;
            const bf16* kp = sk + (size_t)kr * 64 + 8 * g;
            const bf16x8 k0 = *(const bf16x8*)kp, k1 = *(const bf16x8*)(kp + 32);
#pragma unroll
            for (int gq = 0; gq < 4; ++gq) { f32x4 z = (f32x4){0.f, 0.f, 0.f, 0.f}; z = mfma16(k0, qf[gq][0], z); s[gq][ksub] = mfma16(k1, qf[gq][1], z); } }
        bf16x8 pf[4];
#pragma unroll
        for (int gq = 0; gq < 4; ++gq) { const int hq = kvh * 4 + gq; float cm = -1e30f;
#pragma unroll
            for (int ksub = 0; ksub < 2; ++ksub)
#pragma unroll
                for (int r = 0; r < 4; ++r) { const int key = kc + 16 * ksub + 4 * g + r, dist = t0 + l15 - key; const bool ok = (dist >= 0) && (dist < 128) && (key >= 0);
                    const int di = dist < 0 ? 0 : (dist > 127 ? 127 : dist);
                    float v = s[gq][ksub][r] * 0.125f + lut[hq * 128 + di]; v = ok ? v : -1e30f; s[gq][ksub][r] = v; cm = fmaxf(cm, v); }
            cm = fmaxf(cm, shx(cm, 16, lane)); cm = fmaxf(cm, shx(cm, 32, lane));
            const float mn = fmaxf(mx[gq], cm), alpha = fexp(mx[gq] - mn); mx[gq] = mn; float rs = 0.f;
#pragma unroll
            for (int ksub = 0; ksub < 2; ++ksub)
#pragma unroll
                for (int r = 0; r < 4; ++r) { const float p = fexp(s[gq][ksub][r] - mn); s[gq][ksub][r] = p; rs += p; }
            rs += shx(rs, 16, lane); rs += shx(rs, 32, lane);
            ls[gq] = ls[gq] * alpha + rs;
#pragma unroll
            for (int dt = 0; dt < 4; ++dt) o[gq][dt] = o[gq][dt] * alpha;
            pf[gq] = pack8(s[gq][0], s[gq][1]); }
        CFENCE();
#pragma unroll
        for (int dt = 0; dt < 4; ++dt) {
            const s16x4 lo = vtr(vb + (4 * g + q4) * 144 + (16 * dt + 4 * p4) * 2), hi = vtr(vb + (16 + 4 * g + q4) * 144 + (16 * dt + 4 * p4) * 2);
            const bf16x8 vf = cat8(lo, hi);
#pragma unroll
            for (int gq = 0; gq < 4; ++gq) o[gq][dt] = mfma16(vf, pf[gq], o[gq][dt]); }
        CFENCE();
    }
#pragma unroll
    for (int gq = 0; gq < 4; ++gq) { const float inv = __builtin_amdgcn_rcpf(ls[gq]);
#pragma unroll
        for (int dt = 0; dt < 4; ++dt) { const f32x4 v = o[gq][dt] * inv; v2u w; w.x = pk2(v[0], v[1]); w.y = pk2(v[2], v[3]);
            *(v2u*)(ob + (rowb + t0 + l15) * DM + (kvh * 4 + gq) * 64 + 16 * dt + 4 * g) = w; } }
}
constexpr int HGB_WAVES = 4;
template <int NW> __device__ __forceinline__ void hgB_work(const Args& a, const Ctx& c);
template <int HW  > __device__ __forceinline__ void phase_swa_hgB(const Args& a, const Ctx& c) {
    const bf16* proj = (const bf16*)(a.ws + WS_PROJ); bf16* ob = (bf16*)(a.ws + WS_OB);
    LAS float* lut = (LAS float*)(c.lds + SWA_LUT_OFF); const float* glut = (const float*)(a.ws + WS_LUT);
    for (int i = c.tid; i < 16 * 128; i += 512) lut[i] = glut[i];
    __syncthreads();
    if (c.wave < HW) hgB_work<HW>(a, c);
    else {
        LAS unsigned char* vbuf = c.lds + c.wave * 2 * SWA_VB;
        constexpr int NU = 8 * 4 * 256;
        const int nsw = c.G * (8 - HW), sw = (int)blockIdx.x * (8 - HW) + (c.wave - HW);
        for (int u = sw; u < NU; u += nsw) { const int tt = u & 255, kvh = (u >> 8) & 3, bl = u >> 10; swa_unit(proj, ob, bl, kvh, tt, lut, vbuf, a.in[8], c.lane); }
    }
    __syncthreads();
}

constexpr int HG_LF = 0, HG_KP = 33792, HG_VT = 51200, HG_GT = 68608, HG_QP = 70656, HG_SSQ = 88064;
__device__ __forceinline__ void hg_scan(LAS unsigned char* lds, int tid, float (&loc)[16], float& pre, float& Gm, float& Gl) {
    const int ch = tid & 127, grp = tid >> 7;
    const LAS float* LF = (const LAS float*)(lds + HG_LF); LAS float* GT = (LAS float*)(lds + HG_GT);
    float run = 0.f;
#pragma unroll
    for (int i = 0; i < 16; ++i) { run += LF[(16 * grp + i) * 132 + ch]; loc[i] = run; }
    GT[grp * 128 + ch] = run;
    __syncthreads();
    const float g0 = GT[ch], g1 = GT[128 + ch], g2 = GT[256 + ch], g3 = GT[384 + ch];
    pre = (grp > 0 ? g0 : 0.f) + (grp > 1 ? g1 : 0.f) + (grp > 2 ? g2 : 0.f);
    Gm = g0 + g1; Gl = Gm + g2 + g3;
}
constexpr size_t OUT_KP = 0, OUT_QP = 64 * MiB;
constexpr int HCH = 128, HNCH = SEQ / HCH, HNU = 8 * 8 * HNCH;
constexpr int HS_FT = 0, HS_QT = 34816, HS_VT = 69632, HS_GT = 104448, HS_SSQ = 106496;
__device__ __forceinline__ void phase_hgA(const Args& a, const Ctx& c) {
    const bf16* proj = (const bf16*)(a.ws + WS_PROJ); bf16* US = (bf16*)((unsigned char*)a.out + OUT_US); float* D12 = (float*)(a.ws + WS_D12);
    bf16* KPg = (bf16*)((unsigned char*)a.out + OUT_KP); bf16* QPg = (bf16*)((unsigned char*)a.out + OUT_QP);
    LAS unsigned char* lds = c.lds; const int tid = c.tid, lane = c.lane, w = c.wave;
    const int l15 = lane & 15, g = lane >> 4, q4 = l15 >> 2, p4 = lane & 3, ch = tid & 127, grp = tid >> 7;
    int u = blockIdx.x; if (u >= HNU) return;
    v4u rq[4], rf[4], rv[4];
#define HGA_LOAD(uu) do { const size_t uo = (size_t)(uu) * (HCH * 128);      \
        _Pragma("unroll") for (int i = 0; i < 4; ++i) { const size_t po = uo + (size_t)(tid + 512 * i) * 8; \
            rq[i] = *(const v4u*)((const bf16*)((const unsigned char*)proj + PJ_HQ) + po); rf[i] = *(const v4u*)((const bf16*)((const unsigned char*)proj + PJ_HF) + po); rv[i] = *(const v4u*)((const bf16*)((const unsigned char*)proj + PJ_HI) + po); } } while (0)
    HGA_LOAD(u);
    for (;;) {
#pragma unroll
        for (int i = 0; i < 4; ++i) { const int p = tid + 512 * i, tok = p >> 4, c8 = p & 15; LAS unsigned char* sb = lds + tok * 272 + c8 * 16;
            *(LAS v4u*)(sb + HS_FT) = rf[i]; *(LAS v4u*)(sb + HS_QT) = rq[i]; *(LAS v4u*)(sb + HS_VT) = rv[i]; }
        const int ucur = u; const int un = u + gridDim.x; const bool has_next = un < HNU;
        LDS_WAIT();
        if (has_next) HGA_LOAD(un);
        __syncthreads();
        float loc[32], kt[32];
        { const LAS bf16* FT = (const LAS bf16*)(lds + HS_FT); float run = 0.f;
#pragma unroll
          for (int i = 0; i < 32; ++i) { const float f = __builtin_bit_cast(float, (unsigned)FT[(32 * grp + i) * 136 + ch] << 16); kt[i] = 1.f - f; run += flog(f); loc[i] = run; }
          ((LAS float*)(lds + HS_GT))[grp * 128 + ch] = run; }
        __syncthreads();
        { const LAS float* GT = (const LAS float*)(lds + HS_GT);
          const float g0 = GT[ch], g1 = GT[128 + ch], g2 = GT[256 + ch], g3 = GT[384 + ch];
          const float pre = (grp > 0 ? g0 : 0.f) + (grp > 1 ? g1 : 0.f) + (grp > 2 ? g2 : 0.f), Gm = g0 + g1, Gl = Gm + g2 + g3;
          LAS bf16* KP = (LAS bf16*)(lds + HS_FT); LAS bf16* QP = (LAS bf16*)(lds + HS_QT);
#pragma unroll
          for (int hf = 0; hf < 2; ++hf) { float qr[16];
#pragma unroll
              for (int i = 0; i < 16; ++i) qr[i] = __builtin_bit_cast(float, (unsigned)QP[(32 * grp + 16 * hf + i) * 136 + ch] << 16);
#pragma unroll
              for (int i = 0; i < 16; ++i) { const int ii = 16 * hf + i; const float G = pre + loc[ii];
                  const float ed = fexp(fminf(Gm - G, 80.f));
                  KP[(32 * grp + ii) * 136 + ch] = (bf16)pk2(kt[ii] * ed, 0.f);
                  QP[(32 * grp + ii) * 136 + ch] = (bf16)pk2(qr[i] * __builtin_amdgcn_rcpf(ed), 0.f); } }
          if (grp == 0) { D12[(size_t)ucur * 256 + ch] = fexp(Gm); D12[(size_t)ucur * 256 + 128 + ch] = fexp(Gl - Gm); } }
        __syncthreads();
#pragma unroll
        for (int i = 0; i < 4; ++i) { const int p = tid + 512 * i, tok = p >> 4, c8 = p & 15; const size_t go = (size_t)ucur * (HCH * 128) + (size_t)p * 8;
            *(v4u*)(KPg + go) = *(const LAS v4u*)(lds + HS_FT + tok * 272 + c8 * 16); *(v4u*)(QPg + go) = *(const LAS v4u*)(lds + HS_QT + tok * 272 + c8 * 16); }
        { bf16x8 af[4];
#pragma unroll
          for (int ks = 0; ks < 4; ++ks) { const LAS unsigned char* bp = lds + HS_FT + (32 * ks + 8 * g + q4) * 272 + (16 * w + 4 * p4) * 2; af[ks] = cat8(vtr(bp), vtr(bp + 4 * 272)); }
#pragma unroll
          for (int vt = 0; vt < 8; ++vt) { f32x4 acc = (f32x4){0.f, 0.f, 0.f, 0.f};
#pragma unroll
              for (int ks = 0; ks < 4; ++ks) { const LAS unsigned char* bp = lds + HS_VT + (32 * ks + 8 * g + q4) * 272 + (16 * vt + 4 * p4) * 2; acc = mfma16(af[ks], cat8(vtr(bp), vtr(bp + 4 * 272)), acc); }
              v2u wv; wv.x = pk2(acc[0], acc[1]); wv.y = pk2(acc[2], acc[3]);
              *(v2u*)(US + ((size_t)ucur * 128 + 16 * vt + l15) * 128 + 16 * w + 4 * g) = wv; } }
        __syncthreads();
        if (!has_next) break;
        u = un;
    }
#undef HGA_LOAD
}
template <int NW> __device__ __forceinline__ void hgB_work(const Args& a, const Ctx& c) {
    bf16* US = (bf16*)((unsigned char*)a.out + OUT_US); const float* D12 = (const float*)(a.ws + WS_D12);
    const int nthr = c.G * NW * 64, gt = ((int)blockIdx.x * NW + c.wave) * 64 + c.lane;
    for (int e = gt; e < 64 * 2048; e += nthr) {
        const int bh = e >> 11, r = e & 2047, k8 = r & 15;
        float S[8];
#pragma unroll
        for (int j = 0; j < 8; ++j) S[j] = 0.f;
        for (int c0 = 0; c0 < HNCH; c0 += 8) {
            v4u uw[8];
#pragma unroll
            for (int cc = 0; cc < 8; ++cc) uw[cc] = *(const v4u*)(US + ((size_t)bh * HNCH + c0 + cc) * 16384 + (size_t)r * 8);
#pragma unroll
            for (int cc = 0; cc < 8; ++cc) { const size_t un = (size_t)bh * HNCH + c0 + cc;
                const f32x4 d1a = *(const f32x4*)(D12 + un * 256 + k8 * 8), d1b = *(const f32x4*)(D12 + un * 256 + k8 * 8 + 4);
                const f32x4 d2a = *(const f32x4*)(D12 + un * 256 + 128 + k8 * 8), d2b = *(const f32x4*)(D12 + un * 256 + 128 + k8 * 8 + 4);
                const unsigned ww[4] = {uw[cc].x, uw[cc].y, uw[cc].z, uw[cc].w}; float sp[8];
#pragma unroll
                for (int j = 0; j < 8; ++j) { const float d1v = j < 4 ? d1a[j & 3] : d1b[j & 3], d2v = j < 4 ? d2a[j & 3] : d2b[j & 3]; const float uv = (j & 1) ? bfhi(ww[j >> 1]) : bflo(ww[j >> 1]);
                    sp[j] = d1v * S[j]; S[j] = d2v * (sp[j] + uv); }
                v4u o; o.x = pk2(sp[0], sp[1]); o.y = pk2(sp[2], sp[3]); o.z = pk2(sp[4], sp[5]); o.w = pk2(sp[6], sp[7]);
                *(v4u*)(US + un * 16384 + (size_t)r * 8) = o; }
        }
    }
}
__device__ __forceinline__ void phase_hgC(const Args& a, const Ctx& c) {
    const bf16* proj = (const bf16*)(a.ws + WS_PROJ); const bf16* US = (const bf16*)((unsigned char*)a.out + OUT_US); bf16* oa = (bf16*)(a.ws + WS_OA);
    const bf16* KPg = (const bf16*)((unsigned char*)a.out + OUT_KP); const bf16* QPg = (const bf16*)((unsigned char*)a.out + OUT_QP);
    const float* hgain = a.in[7];
    LAS unsigned char* lds = c.lds; const int tid = c.tid, lane = c.lane, w = c.wave;
    const int l15 = lane & 15, g = lane >> 4, q4 = l15 >> 2, p4 = lane & 3;
    int u = blockIdx.x; if (u >= HNU) return;
    v4u rk[4], rq[4], rv[4];
#define HGC_LOAD(uu) do { const size_t uo = (size_t)(uu) * (HCH * 128); \
        _Pragma("unroll") for (int i = 0; i < 4; ++i) { const size_t po = uo + (size_t)(tid + 512 * i) * 8; \
            rk[i] = *(const v4u*)(KPg + po); rq[i] = *(const v4u*)(QPg + po); rv[i] = *(const v4u*)((const bf16*)((const unsigned char*)proj + PJ_HI) + po); } } while (0)
    HGC_LOAD(u);
    const f32x4 gn = *(const f32x4*)(hgain + 16 * w + 4 * g);
    for (;;) {
#pragma unroll
        for (int i = 0; i < 4; ++i) { const int p = tid + 512 * i, tok = p >> 4, c8 = p & 15; LAS unsigned char* sb = lds + tok * 272 + c8 * 16;
            *(LAS v4u*)(sb + HS_FT) = rk[i]; *(LAS v4u*)(sb + HS_QT) = rq[i]; *(LAS v4u*)(sb + HS_VT) = rv[i]; }
        const int ucur = u; const int un = u + gridDim.x; const bool has_next = un < HNU;
        const int cc = ucur % HNCH, h = (ucur / HNCH) & 7, bl = ucur / (HNCH * 8); const size_t row0 = (size_t)bl * SEQ + cc * HCH;
        bf16x8 sf[4]; v2u gwv[8];
#pragma unroll
        for (int ks = 0; ks < 4; ++ks) sf[ks] = *(const bf16x8*)(US + ((size_t)ucur * 128 + 16 * w + l15) * 128 + 32 * ks + 8 * g);
        LDS_WAIT();
        if (has_next) HGC_LOAD(un);
        __syncthreads();
        f32x4 o[8];
        {
            bf16x8 vf[4];
#pragma unroll
            for (int kk = 0; kk < 4; ++kk) { const LAS unsigned char* bp = lds + HS_VT + (32 * kk + 4 * g + q4) * 272 + (16 * w + 4 * p4) * 2; vf[kk] = cat8(vtr(bp), vtr(bp + 16 * 272)); }
#pragma unroll
            for (int tt = 0; tt < 8; ++tt) {
                bf16x8 qf[4];
#pragma unroll
                for (int ks = 0; ks < 4; ++ks) qf[ks] = *(const LAS bf16x8*)(lds + HS_QT + (16 * tt + l15) * 272 + (32 * ks + 8 * g) * 2);
                f32x4 acc = (f32x4){0.f, 0.f, 0.f, 0.f};
#pragma unroll
                for (int ks = 0; ks < 4; ++ks) acc = mfma16(sf[ks], qf[ks], acc);
#pragma unroll
                for (int kk = 0; kk < 4; ++kk) {
                    if (2 * kk <= tt) { f32x4 at[2];
#pragma unroll
                        for (int e = 0; e < 2; ++e) { const int st = 2 * kk + e; at[e] = (f32x4){0.f, 0.f, 0.f, 0.f};
                            if (st <= tt) {
#pragma unroll
                                for (int ks = 0; ks < 4; ++ks) { const bf16x8 kf = *(const LAS bf16x8*)(lds + HS_FT + (16 * st + l15) * 272 + (32 * ks + 8 * g) * 2); at[e] = mfma16(kf, qf[ks], at[e]); }
                                if (st == tt) {
#pragma unroll
                                    for (int r = 0; r < 4; ++r) at[e][r] = (4 * g + r <= l15) ? at[e][r] : 0.f; } } }
                        acc = mfma16(vf[kk], pack8(at[0], at[1]), acc); } }
                o[tt] = acc; CFENCE(); }
        }
#pragma unroll
        for (int tt = 0; tt < 8; ++tt) gwv[tt] = *(const v2u*)((const bf16*)((const unsigned char*)proj + PJ_HG) + (size_t)ucur * (HCH * 128) + (16 * tt + l15) * 128 + 16 * w + 4 * g);
        { LAS float* SSQ = (LAS float*)(lds + HS_SSQ);
#pragma unroll
          for (int tt = 0; tt < 8; ++tt) { float q = (o[tt][0] * o[tt][0] + o[tt][1] * o[tt][1]) + (o[tt][2] * o[tt][2] + o[tt][3] * o[tt][3]);
              q += shx(q, 16, lane); q += shx(q, 32, lane); if (g == 0) SSQ[w * 128 + 16 * tt + l15] = q; } }
        __syncthreads();
        { const LAS float* SSQ = (const LAS float*)(lds + HS_SSQ);
#pragma unroll
          for (int tt = 0; tt < 8; ++tt) { float q = 0.f;
#pragma unroll
              for (int ww = 0; ww < 8; ++ww) q += SSQ[ww * 128 + 16 * tt + l15];
              const float rstd = rsqrtf(q * (1.f / 128.f) + RMS_EPS);
              const size_t row = row0 + 16 * tt + l15;
              const v2u gw = gwv[tt];
              const float g0 = bflo(gw.x), g1 = bfhi(gw.x), g2 = bflo(gw.y), g3 = bfhi(gw.y);
              const float r0 = o[tt][0] * rstd * gn[0] * g0, r1 = o[tt][1] * rstd * gn[1] * g1;
              const float r2 = o[tt][2] * rstd * gn[2] * g2, r3 = o[tt][3] * rstd * gn[3] * g3;
              v2u wv; wv.x = pk2(r0, r1); wv.y = pk2(r2, r3);
              *(v2u*)(oa + row * DM + h * 128 + 16 * w + 4 * g) = wv; } }
        __syncthreads();
        if (!has_next) break;
        u = un;
    }
#undef HGC_LOAD
}

typedef float f32x16 __attribute__((ext_vector_type(16)));
constexpr int XA_KROW = 528, XA_VROW = 72, XA_KB = 32 * XA_KROW, XA_VB = 256 * XA_VROW, XA_STAGE = XA_KB + XA_VB;
__device__ __forceinline__ void phase_xa(const Args& a, const Ctx& c) {
    const bf16* qg = (const bf16*)(a.ws + WS_Q); unsigned char* og = a.ws + WS_O;     const bf16* kx = (const bf16*)(a.ws + WS_KX); const bf16* vxt = (const bf16*)(a.ws + WS_VXT);
    LAS unsigned char* lds = c.lds; const int tid = c.tid, lane = c.lane, w = c.wave;
    const int l31 = lane & 31, hh = lane >> 5, qt = w & 3, dh = w >> 2;
    constexpr int NU = NBATCH * 4 * (SEQ / 128);
    int u = blockIdx.x; if (u >= NU) return;
    v4u rk[2], rv[2];
#define XA_LOAD(uu, kc) do { const int b_ = (uu) >> 7, h_ = ((uu) >> 5) & 3; \
        _Pragma("unroll") for (int i = 0; i < 2; ++i) { const int p = tid + 512 * i; \
            rk[i] = *(const v4u*)(kx + (size_t)(b_ * MEMLEN + (kc) * 32 + (p >> 5)) * DM + h_ * 256 + (p & 31) * 8); \
            rv[i] = *(const v4u*)(vxt + (size_t)(h_ * 256 + (p >> 2)) * (NBATCH * MEMLEN) + b_ * MEMLEN + (kc) * 32 + (p & 3) * 8); } } while (0)
#define XA_STORE(buf) do { LAS unsigned char* sb = lds + (buf) * XA_STAGE; \
        _Pragma("unroll") for (int i = 0; i < 2; ++i) { const int p = tid + 512 * i; \
            *(LAS v4u*)(sb + (p >> 5) * XA_KROW + (p & 31) * 16) = rk[i]; \
            LAS v2u* vp = (LAS v2u*)(sb + XA_KB + (p >> 2) * XA_VROW + (p & 3) * 16); v2u lo; lo.x = rv[i].x; lo.y = rv[i].y; v2u hi; hi.x = rv[i].z; hi.y = rv[i].w; vp[0] = lo; vp[1] = hi; } } while (0)
    XA_LOAD(u, 0); XA_STORE(0);
    int par = 0;
    bf16x8 qf[16];
#define XA_QLOAD(uu) do { const int b_ = (uu) >> 7, h_ = ((uu) >> 5) & 3, qb_ = (uu) & 31; const size_t r_ = (size_t)b_ * SEQ + qb_ * 128 + qt * 32 + l31; \
        _Pragma("unroll") for (int ks = 0; ks < 16; ++ks) qf[ks] = *(const bf16x8*)(qg + r_ * DM + h_ * 256 + 16 * ks + 8 * hh); } while (0)
    XA_QLOAD(u);
    for (;;) {
        const int b = u >> 7, h = (u >> 5) & 3, qb = u & 31;
        const size_t row0 = (size_t)b * SEQ + qb * 128 + qt * 32;
        float mx = -1e30f, ls = 0.f; f32x16 o[4];
#pragma unroll
        for (int dt = 0; dt < 4; ++dt)
#pragma unroll
            for (int r = 0; r < 16; ++r) o[dt][r] = 0.f;
        const int un = u + gridDim.x; const bool has_next = un < NU;
        for (int kc = 0; kc < 8; ++kc) {
            __syncthreads();
            const bool more = (kc < 7) || has_next;
            if (more) { if (kc < 7) XA_LOAD(u, kc + 1); else XA_LOAD(un, 0); }
            const LAS unsigned char* kb = lds + par * XA_STAGE; const LAS unsigned char* vb = kb + XA_KB;
            f32x16 s, s2;
#pragma unroll
            for (int r = 0; r < 16; ++r) { s[r] = 0.f; s2[r] = 0.f; }
#pragma unroll
            for (int ks = 0; ks < 16; ks += 2) { const bf16x8 kf = *(const LAS bf16x8*)(kb + l31 * XA_KROW + (16 * ks + 8 * hh) * 2), kf2 = *(const LAS bf16x8*)(kb + l31 * XA_KROW + (16 * ks + 16 + 8 * hh) * 2);
                s = __builtin_amdgcn_mfma_f32_32x32x16_bf16(kf, qf[ks], s, 0, 0, 0); s2 = __builtin_amdgcn_mfma_f32_32x32x16_bf16(kf2, qf[ks + 1], s2, 0, 0, 0); }
            if (kc == 7 && has_next) XA_QLOAD(un);
#pragma unroll
            for (int r = 0; r < 16; ++r) s[r] += s2[r];
            float cm = -1e30f;
#pragma unroll
            for (int r = 0; r < 16; ++r) { s[r] *= 0.0625f; cm = fmaxf(cm, s[r]); }
            cm = fmaxf(cm, shx(cm, 32, lane));
            const float mn = fmaxf(mx, cm), alpha = fexp(mx - mn); mx = mn; float rs = 0.f;
#pragma unroll
            for (int r = 0; r < 16; ++r) { s[r] = fexp(s[r] - mn); rs += s[r]; }
            rs += shx(rs, 32, lane); ls = ls * alpha + rs;
#pragma unroll
            for (int dt = 0; dt < 4; ++dt)
#pragma unroll
                for (int r = 0; r < 16; ++r) o[dt][r] *= alpha;
            bf16x8 pf[2];
#pragma unroll
            for (int st = 0; st < 2; ++st) { v4u pw; pw.x = pk2(s[8 * st], s[8 * st + 1]); pw.y = pk2(s[8 * st + 2], s[8 * st + 3]); pw.z = pk2(s[8 * st + 4], s[8 * st + 5]); pw.w = pk2(s[8 * st + 6], s[8 * st + 7]); pf[st] = __builtin_bit_cast(bf16x8, pw); }
#pragma unroll
            for (int dt = 0; dt < 4; ++dt) { const LAS unsigned char* vrow = vb + (128 * dh + 32 * dt + l31) * XA_VROW + 8 * hh;
#pragma unroll
                for (int st = 0; st < 2; ++st) { const s16x4 lo = *(const LAS s16x4*)(vrow + 32 * st), hi = *(const LAS s16x4*)(vrow + 32 * st + 16);
                    o[dt] = __builtin_amdgcn_mfma_f32_32x32x16_bf16(cat8(lo, hi), pf[st], o[dt], 0, 0, 0); } }
            if (more) XA_STORE(par ^ 1);
            par ^= 1;
        }
        const float inv = __builtin_amdgcn_rcpf(ls);
#pragma unroll
        for (int dt = 0; dt < 4; ++dt)
#pragma unroll
            for (int rg = 0; rg < 4; ++rg)
                *(unsigned*)(og + (row0 + l31) * DM + h * 256 + 128 * dh + 32 * dt + 8 * rg + 4 * hh) = pk4f8(o[dt][4 * rg] * inv, o[dt][4 * rg + 1] * inv, o[dt][4 * rg + 2] * inv, o[dt][4 * rg + 3] * inv);
        if (!has_next) break;
        u = un;
    }
    __syncthreads();
#undef XA_LOAD
#undef XA_STORE
#undef XA_QLOAD
}

__device__ __forceinline__ void phase_expert_weights(const Args& a, const Ctx& c) {
    LAS float* scr = (LAS float*)(c.lds + c.wave * 16384);
    constexpr int I_GU = 16 * 64, I_D = 16 * 32;
    constexpr int NGU = NEXP * I_GU, NIT = NEXP * (I_GU + I_D);
#define EW_GEO(it, W_, N_, k0_, n0_) const bool gu_##W_ = (it) < NGU; const int r_##W_ = gu_##W_ ? (it) : (it) - NGU; const int e_##W_ = gu_##W_ ? r_##W_ / I_GU : r_##W_ / I_D; \
        const int q_##W_ = gu_##W_ ? r_##W_ % I_GU : r_##W_ % I_D; const int N_ = gu_##W_ ? 2048 : 1024; const int nblk_##W_ = N_ / 32; const int k0_ = 64 * (q_##W_ / nblk_##W_), n0_ = 32 * (q_##W_ % nblk_##W_); \
        const float* W_ = gu_##W_ ? a.in[20] + (size_t)e_##W_ * DM * 2048 : a.in[22] + (size_t)e_##W_ * DM * DM
    int it = c.gw; if (it >= NIT) { __syncthreads(); return; }
    TItem t;
    { EW_GEO(it, W0, N0, k00, n00); titem_load(t, W0, N0, gu_W0 ? a.in[17] : nullptr, k00, n00, c.lane); }
    for (;;) {
        EW_GEO(it, Wc, Nc, k0c, n0c);
        titem_to_lds(t, scr, c.lane);
        const int itn = it + c.ngw; const bool more = itn < NIT;
        if (more) { EW_GEO(itn, Wn, Nn, k0n, n0n); titem_load(t, Wn, Nn, gu_Wn ? a.in[17] : nullptr, k0n, n0n, c.lane); }
        if (gu_Wc) titem_out8(DM, a.ws + WS_WGU, scr, k0c, n0c, c.lane, RowGU{e_Wc});
        else titem_out8(DM, a.ws + WS_WD, scr, k0c, n0c, c.lane, RowId{e_Wc * 1024});
        if (!more) break;
        it = itn;
    }
#undef EW_GEO
    __syncthreads();
}
__device__ __forceinline__ void phase_router(const Args& a, const Ctx& c) {
    const bf16* xb = (const bf16*)(a.ws + WS_XBF); const bf16* wr = (const bf16*)(a.ws + WS_WR); const float* ssq2 = (const float*)(a.ws + WS_SSQ2); const float* br = a.in[19];
    int* tope = (int*)(a.ws + WS_TOPE); float* topg = (float*)(a.ws + WS_TOPG); int* topr = (int*)(a.ws + WS_TOPR); unsigned* gcnt = (unsigned*)(a.ws + WS_GCNT);
    LAS unsigned char* lds = c.lds; const int lane = c.lane, w = c.wave, l15 = lane & 15, g = lane >> 4;
    LAS float* LG = (LAS float*)(lds + w * 4096);
    LAS int* LE = (LAS int*)(lds + w * 4096 + 2560); LAS float* LGT = (LAS float*)(lds + w * 4096 + 2816);
    int* rtok = (int*)(a.ws + WS_RTOK); float* rgate = (float*)(a.ws + WS_RGATE2); float* rrstd = (float*)(a.ws + WS_RRSTD2);
    LAS unsigned* CNT = (LAS unsigned*)(lds + 32768); LAS unsigned* BASE = CNT + 32;
    for (int it = blockIdx.x; it < NTOK / 128; it += gridDim.x) {
        const int tok0 = it * 128 + w * 16; const int half = tok0 >= HTOK;
        if (c.tid < 32) CNT[c.tid] = 0u;
        f32x4 acc[2] = {(f32x4){0.f, 0.f, 0.f, 0.f}, (f32x4){0.f, 0.f, 0.f, 0.f}};
        const bf16* ap = xb + (size_t)(tok0 + l15) * DM + 8 * g;
#pragma unroll 16
        for (int ks = 0; ks < 32; ++ks) { const bf16x8 af = *(const bf16x8*)(ap + 32 * ks);
#pragma unroll
            for (int nt = 0; nt < 2; ++nt) { const bf16x8 bf = *(const bf16x8*)(wr + (size_t)(16 * nt + l15) * DM + 32 * ks + 8 * g); acc[nt] = mfma16(af, bf, acc[nt]); } }
#pragma unroll
        for (int nt = 0; nt < 2; ++nt)
#pragma unroll
            for (int r = 0; r < 4; ++r) { const int t = 4 * g + r; const float rs = rstd16(ssq2, (size_t)(tok0 + t)); LG[t * 33 + 16 * nt + l15] = acc[nt][r] * rs + br[16 * nt + l15]; }
        LDS_WAIT();
        if (lane < 16) { float v[32];
#pragma unroll
            for (int e = 0; e < 32; ++e) v[e] = LG[lane * 33 + e];
            int se[4]; float sv[4];
#pragma unroll
            for (int k = 0; k < 4; ++k) { float best = -3e38f; int bi = 0;
#pragma unroll
                for (int e = 0; e < 32; ++e) { const bool bt = v[e] > best; best = bt ? v[e] : best; bi = bt ? e : bi; }
                se[k] = bi; sv[k] = best;
#pragma unroll
                for (int e = 0; e < 32; ++e) v[e] = (e == bi) ? -3e38f : v[e]; }
            const float e1 = fexp(sv[1] - sv[0]), e2 = fexp(sv[2] - sv[0]), e3 = fexp(sv[3] - sv[0]); const float inv = 1.f / (1.f + e1 + e2 + e3);
            const int tok = tok0 + lane;
            *(int4*)(tope + (size_t)tok * 4) = make_int4(se[0], se[1], se[2], se[3]);
            *(float4*)(topg + (size_t)tok * 4) = make_float4(inv, e1 * inv, e2 * inv, e3 * inv);
#pragma unroll
            for (int k = 0; k < 4; ++k) LE[lane * 4 + k] = se[k];
            LGT[lane * 4 + 0] = inv; LGT[lane * 4 + 1] = e1 * inv; LGT[lane * 4 + 2] = e2 * inv; LGT[lane * 4 + 3] = e3 * inv; }
        __syncthreads();
        const int myE = LE[lane];
        const unsigned lr = atomicAdd((unsigned*)&CNT[myE], 1u);
        __syncthreads();
        if (c.tid < 32) { const unsigned n = CNT[c.tid]; BASE[c.tid] = n ? atomicAdd(gcnt + (half * 32 + c.tid) * 16, n) : 0u; }
        __syncthreads();
        { const int rank = (int)(BASE[myE] + lr), tok = tok0 + (lane >> 2); topr[(size_t)tok * 4 + (lane & 3)] = rank;
          const size_t ri = (size_t)(half * 32 + myE) * HTOK + rank; rtok[ri] = tok; rgate[ri] = LGT[lane]; rrstd[ri] = rstd16(ssq2, (size_t)tok); }
        __syncthreads();
    }
}
__device__ __forceinline__ void add16(f32x4 (&v)[4], const v4u y0, const v4u y1) {
    v[0][0] += bflo(y0.x); v[0][1] += bfhi(y0.x); v[0][2] += bflo(y0.y); v[0][3] += bfhi(y0.y); v[1][0] += bflo(y0.z); v[1][1] += bfhi(y0.z); v[1][2] += bflo(y0.w); v[1][3] += bfhi(y0.w);
    v[2][0] += bflo(y1.x); v[2][1] += bfhi(y1.x); v[2][2] += bflo(y1.y); v[2][3] += bfhi(y1.y); v[3][0] += bflo(y1.z); v[3][1] += bfhi(y1.z); v[3][2] += bflo(y1.w); v[3][3] += bfhi(y1.w);
}
__device__ __forceinline__ void comb_issue(const bf16* y, const bf16* xb, const LAS unsigned* tab, int tok, const int4 ee, const int4 rr, int lane, v2u (&R)[20]) {
    const int ps[4] = {(int)tab[32 + ee.x] * 256 + rr.x, (int)tab[32 + ee.y] * 256 + rr.y, (int)tab[32 + ee.z] * 256 + rr.z, (int)tab[32 + ee.w] * 256 + rr.w};
    { const bf16* xp = xb + (size_t)tok * DM + lane * 4;
#pragma unroll
      for (int j = 0; j < 4; ++j) R[j] = *(const v2u*)(xp + j * 256); }
#pragma unroll
    for (int k = 0; k < 4; ++k) { const bf16* yp = y + (size_t)ps[k] * DM + lane * 4;
#pragma unroll
        for (int j = 0; j < 4; ++j) R[4 + 4 * k + j] = *(const v2u*)(yp + j * 256); }
}
__device__ __forceinline__ void comb_sum(f32x4 (&v)[4], const v2u (&R)[20]) {
#pragma unroll
    for (int j = 0; j < 4; ++j) v[j] = (f32x4){0.f, 0.f, 0.f, 0.f};
#pragma unroll
    for (int k = 0; k < 5; ++k)
#pragma unroll
        for (int j = 0; j < 4; ++j) { const v2u w = R[4 * k + j]; v[j][0] += bflo(w.x); v[j][1] += bfhi(w.x); v[j][2] += bflo(w.y); v[j][3] += bfhi(w.y); }
}
__device__ __forceinline__ void comb_store(float* out, const f32x4 (&gg)[4], int tok, int lane, const f32x4 (&v)[4]) {
    float s = 0.f;
#pragma unroll
    for (int j = 0; j < 4; ++j) s += (v[j][0] * v[j][0] + v[j][1] * v[j][1]) + (v[j][2] * v[j][2] + v[j][3] * v[j][3]);
    const float rstd = rsqrtf(wave_sum(s, lane) * (1.f / DM) + RMS_EPS);
    float* xr = out + (size_t)tok * DM + lane * 4;
#pragma unroll
    for (int j = 0; j < 4; ++j) *(f32x4*)(xr + j * 256) = v[j] * rstd * gg[j];
}
__device__ __forceinline__ void phase_combine(const Args& a, const Ctx& c, int hb, size_t yoff, int taboff) {
    const bf16* y = (const bf16*)(a.ws + yoff); const bf16* xb = (const bf16*)(a.ws + WS_XBF); const int* tope = (const int*)(a.ws + WS_TOPE); const int* topr = (const int*)(a.ws + WS_TOPR); const float* gf = a.in[24];
    moe_tables(a.ws, hb, c.lds, c.tid, taboff);
    const LAS unsigned* tab = (const LAS unsigned*)(c.lds + taboff);
    const int base = hb * HTOK, st = c.ngw, i0 = c.gw;
    if (i0 >= HTOK) return;
    int4 e0, r0, e1, r1; v2u R0[20], R1[20];
    f32x4 gg[4];
#pragma unroll
    for (int j = 0; j < 4; ++j) gg[j] = *(const f32x4*)(gf + j * 256 + c.lane * 4);
    e0 = *(const int4*)(tope + (size_t)(base + i0) * 4); r0 = *(const int4*)(topr + (size_t)(base + i0) * 4);
    e1 = e0; r1 = r0; if (i0 + st < HTOK) { e1 = *(const int4*)(tope + (size_t)(base + i0 + st) * 4); r1 = *(const int4*)(topr + (size_t)(base + i0 + st) * 4); }
    comb_issue(y, xb, tab, base + i0, e0, r0, c.lane, R0);
    if (i0 + st < HTOK) comb_issue(y, xb, tab, base + i0 + st, e1, r1, c.lane, R1);
    if (i0 + 2 * st < HTOK) { e0 = *(const int4*)(tope + (size_t)(base + i0 + 2 * st) * 4); r0 = *(const int4*)(topr + (size_t)(base + i0 + 2 * st) * 4); }
    if (i0 + 3 * st < HTOK) { e1 = *(const int4*)(tope + (size_t)(base + i0 + 3 * st) * 4); r1 = *(const int4*)(topr + (size_t)(base + i0 + 3 * st) * 4); }
#pragma nounroll
    for (int i = i0; i < HTOK; i += 2 * st) {
        f32x4 v[4];
        comb_sum(v, R0);
        if (i + 2 * st < HTOK) { comb_issue(y, xb, tab, base + i + 2 * st, e0, r0, c.lane, R0);
            if (i + 4 * st < HTOK) { e0 = *(const int4*)(tope + (size_t)(base + i + 4 * st) * 4); r0 = *(const int4*)(topr + (size_t)(base + i + 4 * st) * 4); } }
        comb_store(a.out, gg, base + i, c.lane, v);
        if (i + st < HTOK) {
            comb_sum(v, R1);
            if (i + 3 * st < HTOK) { comb_issue(y, xb, tab, base + i + 3 * st, e1, r1, c.lane, R1);
                if (i + 5 * st < HTOK) { e1 = *(const int4*)(tope + (size_t)(base + i + 5 * st) * 4); r1 = *(const int4*)(topr + (size_t)(base + i + 5 * st) * 4); } }
            comb_store(a.out, gg, base + i + st, c.lane, v); }
    }
}

#ifndef MK_PER_PHASE_LAUNCH
#define MK_PER_PHASE_LAUNCH 0
#endif
#if defined(MK_SPLIT_SWA)
constexpr int NPHASES = 24;
#else
constexpr int NPHASES = 21;
#endif
#ifndef MK_OFF
#define MK_OFF 0u
#endif
#define MKP(k) (((MK_OFF >> (k)) & 1u) == 0u)
#define GSCHED PG8_ALIGN, PG8_SP2
typedef const __attribute__((address_space(4))) Args* KArgP;
#if defined(__HIP_DEVICE_COMPILE__)
__device__ __forceinline__ Args ldargs() { KArgP kp = (KArgP)__builtin_amdgcn_kernarg_segment_ptr(); asm volatile("" : "+s"(kp)); Args r;
#pragma unroll
    for (int i = 0; i < 25; ++i) r.in[i] = kp->in[i];
    r.out = kp->out; r.ws = kp->ws; r.ph_lo = kp->ph_lo; r.ph_hi = kp->ph_hi; return r; }
#else
__device__ __forceinline__ Args ldargs() { return Args{}; }
#endif
__global__ void __launch_bounds__(512, 2) mk_fwd(Args a_) {
    extern __shared__ __attribute__((aligned(16))) unsigned char lds_raw[];
    Ctx c; c.lds = (LAS unsigned char*)lds_raw; c.tid = threadIdx.x; c.lane = c.tid & 63; c.wave = __builtin_amdgcn_readfirstlane(c.tid >> 6); const int wv = c.wave;
    c.G = gridDim.x; c.gw = blockIdx.x * 8 + c.wave; c.ngw = c.G * 8;
    volatile LAS unsigned* MISC = (volatile LAS unsigned*)(c.lds + MISC_OFF);
    for (int u = c.tid; u < (LDS_BYTES - RING_BYTES) / 4; u += 512) ((LAS unsigned*)(c.lds + RING_BYTES))[u] = 0u;
    __syncthreads();
    const int ph_lo = a_.ph_lo, ph_hi = a_.ph_hi;
    const bool fused = (ph_hi - ph_lo) > 1;
    unsigned* barw = (unsigned*)a_.ws + CW_BAR;
    XcdBarrier bar; bar.bar = barw; bar.x = 0; bar.st = MISC + 8; bar.t0 = wv;
    if (fused) bar = xcd_barrier_post(barw, MISC + 8, wv);
    int pc = 0;
#define PH_ON (pc >= ph_lo && pc < ph_hi)
#define PH_END do { if (PH_ON && pc + 1 < ph_hi) xcd_barrier(bar); ++pc; OPQ(c); } while (0)
    LAS unsigned char* ring = c.lds;
#define OPQ(cc) do { { unsigned z_ = 0u; asm volatile("" : "+v"(z_)); cc.lane = (int)__builtin_amdgcn_mbcnt_hi(~0u, __builtin_amdgcn_mbcnt_lo(~0u, z_)); } cc.wave = wv; cc.tid = wv * 64 + cc.lane; { int gw_ = (int)blockIdx.x * 8 + wv; asm volatile("" : "+s"(gw_)); cc.gw = gw_; } } while (0)

    if (MKP(0) && PH_ON) { const Args a = ldargs(); unsigned char* ws = a.ws; (void)ws;  phase_prologue(a, c); __syncthreads(); phase_norm1(a, c, 0); }
    PH_END;
#pragma unroll
    for (int hb = 0; hb < 2; ++hb) {
        const size_t toff = (size_t)hb * HTOK;

        if (MKP(2) && PH_ON) { const Args a = ldargs(); unsigned char* ws = a.ws; (void)ws;  pg8::Gemm g{(const bf16*)(ws + (hb ? WS_OA : WS_TM)), (const bf16*)(ws + WS_WIN), HTOK, NCOL, DM};        pg8::StaticOrder S; S.init(HTOK, NCOL, c.G, (int)blockIdx.x);
            EpiProj E{ws + WS_PROJ, (const float*)(ws + WS_LB)}; pg8::gemm_phase<EpiProj, pg8::StaticOrder, GSCHED>(ring, g, S, E, wv); }
        PH_END;
        if (MKP(3) && PH_ON) { const Args a = ldargs(); unsigned char* ws = a.ws; (void)ws;  phase_hgA(a, c); }
        PH_END;
#if defined(MK_SPLIT_SWA)
        if (MKP(4) && PH_ON) { const Args a = ldargs(); phase_swa_hgB<8>(a, c); }
        PH_END;
        if (MKP(4) && PH_ON) { const Args a = ldargs(); phase_swa_hgB<0>(a, c); }
        PH_END;
#else
        if (MKP(4) && PH_ON) { const Args a = ldargs(); phase_swa_hgB<HGB_WAVES>(a, c); }
        PH_END;
#endif
        if (MKP(5) && PH_ON) { const Args a = ldargs(); phase_hgC(a, c); }
        PH_END;
        if (MKP(6) && PH_ON) { const Args a = ldargs(); unsigned char* ws = a.ws; (void)ws;  pg8::Gemm g{(const bf16*)(ws + WS_OA), (const bf16*)(ws + WS_WA), HTOK, DM, DM}; pg8::StaticOrder S; S.init(HTOK, DM, c.G, (int)blockIdx.x);
            EpiGate<false> E{(bf16*)(ws + WS_TM), (const bf16*)(ws + WS_PROJ + PJ_GA), a.in[6]}; pg8::gemm_phase<EpiGate<false>, pg8::StaticOrder, GSCHED>(ring, g, S, E, wv); }
        if (MKP(7) && PH_ON) { const Args a = ldargs(); unsigned char* ws = a.ws; (void)ws;  pg8::Gemm g{(const bf16*)(ws + WS_OB), (const bf16*)(ws + WS_WB), HTOK, DM, DM}; pg8::StaticOrder S; S.init(HTOK, DM, c.G, (int)blockIdx.x);
            EpiGate<true> E{(bf16*)(ws + WS_TM), (const bf16*)(ws + WS_PROJ + PJ_GB), a.in[6] + DM}; pg8::gemm_phase<EpiGate<true>, pg8::StaticOrder, GSCHED>(ring, g, S, E, wv); }
        PH_END;
        if (MKP(8) && PH_ON) { const Args a = ldargs(); unsigned char* ws = a.ws; (void)ws;  pg8::Gemm g{(const bf16*)(ws + WS_TM), (const bf16*)(ws + WS_WMIX), HTOK, DM, DM}; pg8::StaticOrder S; S.init(HTOK, DM, c.G, (int)blockIdx.x);
            EpiResid<false> E{a.in[0] + toff * DM, (bf16*)(ws + WS_XBF) + toff * DM, (float*)(ws + WS_SSQ1) + toff * 16, ws + WS_X1F8 + toff * DM, 1.f}; pg8::gemm_phase<EpiResid<false>, pg8::StaticOrder, GSCHED>(ring, g, S, E, wv);
            if (hb == 0) phase_norm1(a, c, 1); }
        PH_END;
    }
    if (MKP(9) && PH_ON) { const Args a = ldargs(); unsigned char* ws = a.ws; (void)ws;
        phase_expert_weights(a, c);
        { pg8::Gemm g{(const bf16*)(ws + WS_MEMBF), (const bf16*)(ws + WS_WK), NBATCH * MEMLEN, DM, DM}; pg8::StaticOrder S; S.init(NBATCH * MEMLEN, DM, c.G, (int)blockIdx.x);
          EpiStore E{(bf16*)(ws + WS_KX), DM, nullptr, 1.f}; pg8::gemm_phase<EpiStore, pg8::StaticOrder, GSCHED>(ring, g, S, E, wv); }
        { pg8::Gemm g{(const bf16*)(ws + WS_WV), (const bf16*)(ws + WS_MEMBF), DM, NBATCH * MEMLEN, DM}; pg8::StaticOrder S; S.init(DM, NBATCH * MEMLEN, c.G, (int)((blockIdx.x + 64) % c.G));
          EpiStore E{(bf16*)(ws + WS_VXT), NBATCH * MEMLEN, nullptr, 1.f}; pg8::gemm_phase<EpiStore, pg8::StaticOrder, GSCHED>(ring, g, S, E, wv); }
        { pg8::Gemm g{(const bf16*)(ws + WS_X1F8), (const bf16*)(ws + WS_WQ), NTOK, DM, DM}; pg8::StaticOrder S; S.init(NTOK, DM, c.G, (int)blockIdx.x);
          EpiStore E{(bf16*)(ws + WS_Q), DM, (const float*)(ws + WS_SSQ1), F8_WINV}; pg8::gemm_phase8<EpiStore, pg8::StaticOrder, GSCHED>(ring, g, S, E, wv); }
    }
    PH_END;
    if (MKP(10) && PH_ON) { const Args a = ldargs(); phase_xa(a, c); }
    PH_END;
    if (MKP(11) && PH_ON) { const Args a = ldargs(); unsigned char* ws = a.ws; (void)ws;  pg8::Gemm g{(const bf16*)(ws + WS_O), (const bf16*)(ws + WS_WO), NTOK, DM, DM}; pg8::StaticOrder S; S.init(NTOK, DM, c.G, (int)blockIdx.x);
        EpiResid<true> E{nullptr, (bf16*)(ws + WS_XBF), (float*)(ws + WS_SSQ2), ws + WS_X2F8, F8_WINV}; pg8::gemm_phase8<EpiResid<true>, pg8::StaticOrder, GSCHED>(ring, g, S, E, wv); }
    PH_END;
    if (MKP(12) && PH_ON) { const Args a = ldargs(); phase_router(a, c); }
    PH_END;
#define MOE_GEMM1(hb_) do { const Args a = ldargs(); unsigned char* ws = a.ws; moe_tables(ws, (hb_), c.lds, c.tid); \
        const LAS unsigned* tab = (const LAS unsigned*)(c.lds + MOE_TAB_OFF); const int nb = (int)__builtin_amdgcn_readfirstlane(tab[64]); \
        pg8::Gemm g{(const bf16*)(ws + WS_X2F8), (const bf16*)(ws + WS_WGU), NTOK, NEXP * 2048, DM}; GroupedOrder S{nb * 8, 8, c.G, (int)blockIdx.x, (hb_), tab, (const int*)(ws + WS_RTOK)}; \
        EpiSwiglu E{ws + WS_ACT + (size_t)(hb_) * ACT_HALF, a.in[21], (const float*)(ws + WS_RRSTD2)}; pg8::gemm_phase_gather8<EpiSwiglu, GroupedOrder>(ring, g, S, E, wv); } while (0)
#define MOE_GEMM2(hb_, yoff_, i0_, i1_) do { const Args a = ldargs(); unsigned char* ws = a.ws; moe_tables(ws, (hb_), c.lds, c.tid); \
        const LAS unsigned* tab = (const LAS unsigned*)(c.lds + MOE_TAB_OFF); const int nb = (int)__builtin_amdgcn_readfirstlane(tab[64]); \
        pg8::Gemm g{(const bf16*)(ws + WS_ACT + (size_t)(hb_) * ACT_HALF), (const bf16*)(ws + WS_WD), CAPH, NEXP * 1024, DM}; GroupedOrder S{nb * 4, 4, c.G, (int)blockIdx.x, (hb_), tab, (const int*)(ws + WS_RTOK), (i0_), (i1_)}; \
        EpiDown E{(bf16*)(ws + (yoff_)), a.in[23], (const float*)(ws + WS_RGATE2)}; pg8::gemm_phase8<EpiDown, GroupedOrder, GSCHED>(ring, g, S, E, wv); } while (0)
    if (MKP(14) && PH_ON) { MOE_GEMM1(0); }
    PH_END;
    if (MKP(15) && PH_ON) { MOE_GEMM2(0, WS_Y, 0, 0x7fffffff); MOE_GEMM1(1); }
    PH_END;
    if (MKP(15) && PH_ON) { int kq = ((int)blockIdx.x >> 3) % 9; asm volatile("" : "+s"(kq));
#pragma nounroll
        for (int part = 0; part < 2; ++part) { MOE_GEMM2(1, WS_Y1, part ? kq : 0, part ? 0x7fffffff : kq); OPQ(c);
            if (part == 0) { const Args a = ldargs(); phase_combine(a, c, 0, WS_Y, MOE_TAB_OFF + 512); OPQ(c); } } }
    PH_END;
    if (MKP(16) && PH_ON) { const Args a = ldargs(); phase_combine(a, c, 1, WS_Y1, MOE_TAB_OFF); }
    PH_END;
#undef MOE_GEMM1
#undef MOE_GEMM2
#undef PH_ON
#undef PH_END
}

#if defined(MK_DBG_STOP)
#ifndef MK_DBG_SRC_OUT
#define MK_DBG_SRC_OUT 0
#endif
#ifndef MK_DBG_F32
#define MK_DBG_F32 0
#endif
__global__ void dbg_dump(const unsigned short* src, float* out, size_t n, size_t N) {
    for (size_t i = (size_t)blockIdx.x * blockDim.x + threadIdx.x; i < N; i += (size_t)gridDim.x * blockDim.x) {
        if (i < n) { float v = MK_DBG_F32 ? ((const float*)src)[i] : __builtin_bit_cast(float, (unsigned)src[i] << 16); if (!(fabsf(v) < 1e30f)) v = 12345.f; out[i] = v; }
        else if (!MK_DBG_SRC_OUT) out[i] = 0.f;
    }
}
__global__ void dbg_zero_upper(float* out, size_t n0, size_t N) { for (size_t i = n0 + (size_t)blockIdx.x * blockDim.x + threadIdx.x; i < N; i += (size_t)gridDim.x * blockDim.x) out[i] = 0.f; }
#endif
#if defined(MK_REP_THRASH)
__global__ void dbg_thrash(const f32x4* a, size_t na, const f32x4* b, size_t nb, float* sink) {
    f32x4 acc = (f32x4){0.f, 0.f, 0.f, 0.f};
    for (size_t i = (size_t)blockIdx.x * blockDim.x + threadIdx.x; i < na; i += (size_t)gridDim.x * blockDim.x) acc += a[i];
    for (size_t i = (size_t)blockIdx.x * blockDim.x + threadIdx.x; i < nb; i += (size_t)gridDim.x * blockDim.x) acc += b[i];
    if (acc[0] + acc[1] + acc[2] + acc[3] == 12345.678f) sink[0] = 1.f;
}
#endif
extern "C" void kernel_launch(void* const* d_in, const int* in_sizes, int n_in, void* d_out, int out_size, void* d_ws, size_t ws_size, hipStream_t stream) {
    static int grid = 0;
    if (grid == 0) {
        if (n_in != 25 || out_size != NTOK * DM || ws_size < WS_END) { fprintf(stderr, "kernel_launch: unexpected problem shape (n_in %d, out %d, ws %zu); nothing launched\n", n_in, out_size, ws_size); grid = -1; return; }
        int dev = 0, cus = 0, per_cu = 0;
        if (hipGetDevice(&dev) != hipSuccess || hipDeviceGetAttribute(&cus, hipDeviceAttributeMultiprocessorCount, dev) != hipSuccess) { grid = -1; return; }
        if (hipFuncSetAttribute((const void*)mk_fwd, hipFuncAttributeMaxDynamicSharedMemorySize, LDS_BYTES) != hipSuccess) { fprintf(stderr, "kernel_launch: hipFuncSetAttribute failed\n"); grid = -1; return; }
        if (hipOccupancyMaxActiveBlocksPerMultiprocessor(&per_cu, (const void*)mk_fwd, 512, LDS_BYTES) != hipSuccess || per_cu < 1) { fprintf(stderr, "kernel_launch: occupancy query reports %d blocks per CU\n", per_cu); }
        (void)hipGetLastError();
        grid = cus;
    }
    if (grid < 0) return;
    (void)in_sizes;
    hipMemsetAsync(d_ws, 0, WS_ZERO_BYTES, stream);
    Args a{};
    for (int i = 0; i < 25; ++i) a.in[i] = (const float*)d_in[i];
    a.out = (float*)d_out; a.ws = (unsigned char*)d_ws;
#if defined(MK_DBG_STOP)
    for (int p = 0; p < MK_DBG_STOP; ++p) { a.ph_lo = p; a.ph_hi = p + 1; hipLaunchKernelGGL(mk_fwd, dim3(grid), dim3(512), LDS_BYTES, stream, a); }
    hipLaunchKernelGGL(dbg_dump, dim3(2048), dim3(256), 0, stream, (const unsigned short*)((const unsigned char*)(MK_DBG_SRC_OUT ? d_out : d_ws) + (size_t)MK_DBG_OFF_MIB * MiB), (float*)d_out, (size_t)MK_DBG_MIB * MiB / (MK_DBG_F32 ? 4 : 2), (size_t)NTOK * DM);
    if (MK_DBG_SRC_OUT) hipLaunchKernelGGL(dbg_zero_upper, dim3(2048), dim3(256), 0, stream, (float*)d_out, (size_t)MK_DBG_MIB * MiB / 2, (size_t)NTOK * DM);
#elif MK_PER_PHASE_LAUNCH
#if defined(MK_REP_THRASH) && defined(MK_REP_PC)
    if (MK_REP_PC < 0) for (int r = 0; r < MK_REP_N; ++r) hipLaunchKernelGGL(dbg_thrash, dim3(2048), dim3(256), 0, stream, (const f32x4*)d_in[20], (size_t)NEXP * DM * 2048 / 4, (const f32x4*)d_in[22], (size_t)NEXP * DM * DM / 4, (float*)((char*)d_ws + WS_LB + 8192));
#endif
    for (int p = 0; p < NPHASES; ++p) { a.ph_lo = p; a.ph_hi = p + 1; hipLaunchKernelGGL(mk_fwd, dim3(grid), dim3(512), LDS_BYTES, stream, a);
#if defined(MK_REP_PC)
        if (p == MK_REP_PC) for (int r = 0; r < MK_REP_N; ++r) {
#if defined(MK_REP_THRASH)
            hipLaunchKernelGGL(dbg_thrash, dim3(2048), dim3(256), 0, stream, (const f32x4*)d_in[20], (size_t)NEXP * DM * 2048 / 4, (const f32x4*)d_in[22], (size_t)NEXP * DM * DM / 4, (float*)((char*)d_ws + WS_LB + 8192));
#endif
 if (p == 22 && false) (void)hipMemsetAsync((char*)d_ws + WS_GCNT, 0, 4096, stream); hipLaunchKernelGGL(mk_fwd, dim3(grid), dim3(512), LDS_BYTES, stream, a); }
#endif
    }
#else
    a.ph_lo = 0; a.ph_hi = NPHASES;
    hipLaunchKernelGGL(mk_fwd, dim3(grid), dim3(512), LDS_BYTES, stream, a);
#endif
}
```

```cpp
#include <hip/hip_runtime.h>
#include <cstdio>
#include <cstdint>
#ifndef PG8_RELAX_A
#define PG8_RELAX_A 0
#endif
#ifndef PG8_RELAX_B
#define PG8_RELAX_B 1
#endif
#ifndef PG8_RELAX_C
#define PG8_RELAX_C 1
#endif
namespace pg8 {
#define PG8_LAS __attribute__((address_space(3)))
typedef unsigned short bf16_t;
typedef short bf16x8 __attribute__((ext_vector_type(8)));
typedef float f32x4 __attribute__((ext_vector_type(4)));
typedef unsigned u32x4 __attribute__((ext_vector_type(4)));
constexpr int BM = 256, BK = 64, HALF = 128, HTB = HALF * BK * 2  , STAGE_BYTES = 8 * HTB, NXCD = 8, WGM = 4;

__host__ __device__ __forceinline__ int lds_byte(int r, int c) { const int st = (r >> 4) * 2 + (c >> 5), rr = r & 15, cc = c & 31, ob = rr * 64 + cc * 2; return st * 1024 + (ob ^ (((ob >> 9) & 1) << 5)); }
__host__ __device__ __forceinline__ void stage_rc(int b, int& R, int& C) { const int st = b / 1024, sb = b % 1024, swz = sb ^ (((sb >> 9) & 1) << 5); R = (st >> 1) * 16 + swz / 64; C = (st & 1) * 32 + (swz % 64) / 2; }
__host__ __device__ __forceinline__ int perm32(int rho) { const int n = rho >> 4, i = rho & 15; return 8 * (i >> 2) + 4 * n + (i & 3); }

struct Unit { int pm, pn, aux, cnt; };
struct Gemm { const bf16_t* A; const bf16_t* Bt; int M, N, K; };

struct StaticOrder {
    int nM, nN, nwg, G, c;
    __host__ __device__ void init(int M, int N, int G_, int c_) { nM = M / BM; nN = N / BM; nwg = nM * nN; G = G_; c = c_; }
    __host__ __device__ bool next(int i, Unit& u) const {
        const long L = (long)i * G + c; if (L >= nwg) return false;
        int wgid = (int)L; { const int q = nwg / NXCD, r = nwg % NXCD, xcd = wgid % NXCD, off = wgid / NXCD; wgid = (xcd < r ? xcd * (q + 1) : r * (q + 1) + (xcd - r) * q) + off; }
        const int nig = WGM * nN, gid = wgid / nig, fm = gid * WGM, gsz = (nM - fm) < WGM ? (nM - fm) : WGM;
        u.pm = fm + ((wgid % nig) % gsz); u.pn = (wgid % nig) / gsz; return true;
    }
    __device__ __forceinline__ void a_ready(const Unit&) const {}
    __device__ __forceinline__ void done(const Unit&) const {}
};

__device__ __forceinline__ unsigned cvt_pk_bf16(float lo, float hi) { unsigned r; asm volatile("v_cvt_pk_bf16_f32 %0, %1, %2" : "=v"(r) : "v"(lo), "v"(hi)); return r; }
typedef float f32x2 __attribute__((ext_vector_type(2)));
template <class Epi, class Sched, bool ALIGN_EPI = false, bool SP2 = false>
__device__ __forceinline__ void gemm_phase(PG8_LAS unsigned char* lds, const Gemm g, const Sched& S, const Epi& E, const int wave_in) {
    unsigned z_ = 0u; asm volatile("" : "+v"(z_)); const int tid_ = (int)__builtin_amdgcn_mbcnt_hi(~0u, __builtin_amdgcn_mbcnt_lo(~0u, z_)) + 64 * wave_in;
    const int tid = tid_, wid = __builtin_amdgcn_readfirstlane(tid >> 6), lane = tid & 63, wr = wid >> 2, wc = wid & 3, fr = lane & 15, fq = lane >> 4;
    const int K = g.K, nt = K / BK;
    unsigned voffA[2], voffB[2];
#pragma unroll
    for (int i = 0; i < 2; ++i) { int R, C; stage_rc(tid * 16 + i * 8192, R, C); const int Rb = Epi::PERM ? ((R & ~31) + perm32(R & 31)) : R;
        voffA[i] = (unsigned)(R * K + C) * 2u; voffB[i] = (unsigned)(Rb * K + C) * 2u; }
    const size_t kstep = (size_t)(BK * 2);
    const size_t hstep = (size_t)HALF * K * 2;
    const size_t tstep = 2 * hstep;
    const unsigned ldsw = (unsigned)wid * 1024u;
    const int aoff = lds_byte(wr * 64 + fr, fq * 8), boff = lds_byte(wc * 32 + fr, fq * 8);
#define PG8_SA(b, h) (((b) * 2 + (h)) * HTB)
#define PG8_SB(b, h) ((4 + (b) * 2 + (h)) * HTB)
#define PG8_STAGE(bufoff, gbase, voff) do { _Pragma("unroll") for (int _i = 0; _i < 2; ++_i) \
        __builtin_amdgcn_global_load_lds((const unsigned*)((const char*)(gbase) + (voff)[_i]), (PG8_LAS unsigned*)(lds + (bufoff) + ldsw + _i * 8192), 16, 0, 0); } while (0)
#define PG8_LDA(dst, b, h) do { _Pragma("unroll") for (int m = 0; m < 4; ++m) _Pragma("unroll") for (int k = 0; k < 2; ++k) dst[m][k] = *(const PG8_LAS bf16x8*)(lds + PG8_SA(b, h) + aoff + m * 2048 + k * 1024); } while (0)
#define PG8_LDB(dst, b, h) do { _Pragma("unroll") for (int n = 0; n < 2; ++n) _Pragma("unroll") for (int k = 0; k < 2; ++k) dst[n][k] = *(const PG8_LAS bf16x8*)(lds + PG8_SB(b, h) + boff + n * 2048 + k * 1024); } while (0)
#define PG8_MMA(ai, bj, At, Bt) do { __builtin_amdgcn_s_setprio(1); _Pragma("unroll") for (int m = 0; m < 4; ++m) _Pragma("unroll") for (int n = 0; n < 2; ++n) _Pragma("unroll") for (int k = 0; k < 2; ++k) \
        acc[ai][bj][m][n] = __builtin_amdgcn_mfma_f32_16x16x32_bf16(Bt[n][k], At[m][k], acc[ai][bj][m][n], 0, 0, 0); __builtin_amdgcn_s_setprio(0); } while (0)
#define PG8_WAIT_V(n) asm volatile("s_waitcnt vmcnt(" #n ")" ::: "memory")
#define PG8_WAIT_VN(n) asm volatile("s_waitcnt vmcnt(%0)" :: "n"(n) : "memory")
#define PG8_WAIT_V8R(flag, n) asm volatile("s_waitcnt vmcnt(%1)\n\ts_cmp_lg_u32 %0, 0\n\ts_cbranch_scc1 .Lrw_%=\n\ts_waitcnt vmcnt(8)\n.Lrw_%=:" :: "s"(flag), "n"(n) : "scc", "memory")
#define PG8_WAIT_L(n) asm volatile("s_waitcnt lgkmcnt(" #n ")" ::: "memory")
#define PG8_BAR __builtin_amdgcn_s_barrier()
#define PG8_SCHED __builtin_amdgcn_sched_barrier(0)
    Unit cur, nxt; int ui = 0;
    if (!S.next(0, cur)) return;
    f32x4 acc[2][2][4][2];
#pragma unroll
    for (int a = 0; a < 2; ++a)
#pragma unroll
        for (int b = 0; b < 2; ++b)
#pragma unroll
            for (int m = 0; m < 4; ++m)
#pragma unroll
                for (int n = 0; n < 2; ++n) acc[a][b][m][n] = (f32x4){0.f, 0.f, 0.f, 0.f};
    bf16x8 At[4][2], B0[2][2], B1[2][2];
    const char* cA = (const char*)g.A + (size_t)cur.pm * tstep; const char* cB = (const char*)g.Bt + (size_t)cur.pn * tstep;
    S.a_ready(cur);
    if constexpr (SP2) {
        PG8_STAGE(PG8_SB(0, 0), cB, voffB); PG8_STAGE(PG8_SB(0, 1), cB + hstep, voffB); PG8_STAGE(PG8_SA(0, 0), cA, voffA); PG8_STAGE(PG8_SA(0, 1), cA + hstep, voffA);
        if (wr == 1) PG8_BAR;
        PG8_WAIT_V(2); PG8_BAR;
        PG8_STAGE(PG8_SB(1, 0), cB + kstep, voffB); PG8_STAGE(PG8_SA(1, 0), cA + kstep, voffA); PG8_STAGE(PG8_SB(1, 1), cB + hstep + kstep, voffB);
        PG8_WAIT_V(6); PG8_BAR;
    } else {
        PG8_STAGE(PG8_SB(0, 0), cB, voffB); PG8_STAGE(PG8_SA(0, 0), cA, voffA); PG8_STAGE(PG8_SB(0, 1), cB + hstep, voffB); PG8_STAGE(PG8_SA(0, 1), cA + hstep, voffA);
        if (wr == 1) PG8_BAR;
        PG8_WAIT_V(4); PG8_BAR;
        PG8_STAGE(PG8_SB(1, 0), cB + kstep, voffB); PG8_STAGE(PG8_SA(1, 0), cA + kstep, voffA); PG8_STAGE(PG8_SB(1, 1), cB + hstep + kstep, voffB);
        PG8_WAIT_V(6); PG8_BAR;
    }
    for (;;) {
        const bool has_next = S.next(ui + 1, nxt);
        const char* nA = has_next ? (const char*)g.A + (size_t)nxt.pm * tstep : cA; const char* nB = has_next ? (const char*)g.Bt + (size_t)nxt.pn * tstep : cB;
        for (int t = 0; t < nt; t += 2) {
            const bool last = (t == nt - 2);
            const char* a1 = cA + (size_t)(t + 1) * kstep;
            const char* a2 = last ? nA : cA + (size_t)(t + 2) * kstep; const char* b2 = last ? nB : cB + (size_t)(t + 2) * kstep;
            const char* a3 = a2 + kstep; const char* b3 = b2 + kstep;
            if (last && has_next) S.a_ready(nxt);
            if constexpr (SP2) {
            PG8_LDB(B0, 0, 0); PG8_LDB(B1, 0, 1); PG8_SCHED; PG8_LDA(At, 0, 0); PG8_STAGE(PG8_SA(1, 1), a1 + hstep, voffA);
            PG8_WAIT_V8R(__builtin_amdgcn_readfirstlane((t == 0 && ui > 0) ? 1 : 0), 8 + Epi::NST); PG8_WAIT_L(0); PG8_BAR; PG8_MMA(0, 0, At, B0); PG8_MMA(0, 1, At, B1); PG8_BAR; PG8_SCHED;
            PG8_LDA(At, 0, 1); PG8_STAGE(PG8_SB(0, 0), b2, voffB); PG8_STAGE(PG8_SB(0, 1), b2 + hstep, voffB); PG8_STAGE(PG8_SA(0, 0), a2, voffA);
            PG8_WAIT_V8R(__builtin_amdgcn_readfirstlane((t == 0 && ui > 0) ? 1 : 0), 8 + Epi::NST); PG8_WAIT_L(0); PG8_BAR; PG8_MMA(1, 0, At, B0); PG8_MMA(1, 1, At, B1); PG8_BAR; PG8_SCHED;
            PG8_LDB(B0, 1, 0); PG8_LDB(B1, 1, 1); PG8_SCHED; PG8_LDA(At, 1, 0); PG8_STAGE(PG8_SA(0, 1), a2 + hstep, voffA);
            PG8_WAIT_V(8); PG8_WAIT_L(0); PG8_BAR; PG8_MMA(0, 0, At, B0); PG8_MMA(0, 1, At, B1); PG8_BAR; PG8_SCHED;
            PG8_LDA(At, 1, 1); PG8_STAGE(PG8_SB(1, 0), b3, voffB); PG8_STAGE(PG8_SB(1, 1), b3 + hstep, voffB); PG8_STAGE(PG8_SA(1, 0), a3, voffA);
            PG8_WAIT_V(8); PG8_WAIT_L(0); PG8_BAR; PG8_MMA(1, 0, At, B0); PG8_MMA(1, 1, At, B1); PG8_BAR; PG8_SCHED;
            } else {
            PG8_LDB(B0, 0, 0); PG8_SCHED; PG8_LDA(At, 0, 0); PG8_STAGE(PG8_SA(1, 1), a1 + hstep, voffA);
            PG8_WAIT_L(8); PG8_BAR; PG8_WAIT_L(0); PG8_MMA(0, 0, At, B0); PG8_BAR; PG8_SCHED;
            PG8_LDB(B1, 0, 1); PG8_STAGE(PG8_SB(0, 0), b2, voffB);
            PG8_BAR; PG8_WAIT_L(0); PG8_MMA(0, 1, At, B1); PG8_BAR;
            PG8_LDA(At, 0, 1); PG8_STAGE(PG8_SA(0, 0), a2, voffA);
            PG8_BAR; PG8_WAIT_L(0); PG8_MMA(1, 0, At, B0); PG8_BAR; PG8_SCHED;
            PG8_STAGE(PG8_SB(0, 1), b2 + hstep, voffB);
            PG8_WAIT_V(6); PG8_BAR; PG8_MMA(1, 1, At, B1); PG8_BAR;
            PG8_LDB(B0, 1, 0); PG8_SCHED; PG8_LDA(At, 1, 0); PG8_STAGE(PG8_SA(0, 1), a2 + hstep, voffA);
            PG8_WAIT_L(8); PG8_BAR; PG8_WAIT_L(0); PG8_MMA(0, 0, At, B0); PG8_BAR; PG8_SCHED;
            PG8_LDB(B1, 1, 1); PG8_STAGE(PG8_SB(1, 0), b3, voffB);
            PG8_BAR; PG8_WAIT_L(0); PG8_MMA(0, 1, At, B1); PG8_BAR;
            PG8_LDA(At, 1, 1); PG8_STAGE(PG8_SA(1, 0), a3, voffA);
            PG8_BAR; PG8_WAIT_L(0); PG8_MMA(1, 0, At, B0); PG8_BAR; PG8_SCHED;
            PG8_STAGE(PG8_SB(1, 1), b3 + hstep, voffB);
            PG8_WAIT_V(6); PG8_BAR; PG8_MMA(1, 1, At, B1); PG8_BAR;
            }
        }
        if constexpr (ALIGN_EPI) { if (wr == 0) PG8_BAR; }
        if constexpr (!Epi::AFTER_DRAIN) { E(acc, cur, wr, wc, fr, fq); S.done(cur); }
        if (!has_next) break;
#pragma unroll
        for (int a = 0; a < 2; ++a)
#pragma unroll
            for (int b = 0; b < 2; ++b)
#pragma unroll
                for (int m = 0; m < 4; ++m)
#pragma unroll
                    for (int n = 0; n < 2; ++n) acc[a][b][m][n] = (f32x4){0.f, 0.f, 0.f, 0.f};
        cur = nxt; cA = nA; cB = nB; ++ui;
        if constexpr (ALIGN_EPI) { if (wr == 1) PG8_BAR; }
    }
    PG8_WAIT_V(0);
    if constexpr (!ALIGN_EPI) { if (wr == 0) PG8_BAR; }
    PG8_BAR;
    if constexpr (Epi::AFTER_DRAIN) { E.fused(acc, cur, wr, wc, fr, fq, lds, wid, lane); S.done(cur); }
#undef PG8_SA
#undef PG8_SB
#undef PG8_STAGE
#undef PG8_LDA
#undef PG8_LDB
#undef PG8_MMA
#undef PG8_WAIT_V
#undef PG8_WAIT_VN
#undef PG8_WAIT_V8R
#undef PG8_WAIT_L
#undef PG8_BAR
#undef PG8_SCHED
}
template <class Epi, class Sched>
__device__ __forceinline__ void gemm_phase_gather(PG8_LAS unsigned char* lds, const Gemm g, const Sched& S, const Epi& E, const int wave_in) {
    unsigned z_ = 0u; asm volatile("" : "+v"(z_)); const int tid_ = (int)__builtin_amdgcn_mbcnt_hi(~0u, __builtin_amdgcn_mbcnt_lo(~0u, z_)) + 64 * wave_in;
    const int tid = tid_, wid = __builtin_amdgcn_readfirstlane(tid >> 6), lane = tid & 63, wr = wid >> 2, wc = wid & 3, fr = lane & 15, fq = lane >> 4;
    constexpr bool ALIGN_EPI = true, SP2 = true;
    const int K = g.K, nt = K / BK;
    unsigned voffB[2]; int RA0; unsigned CA0;
#pragma unroll
    for (int i = 0; i < 2; ++i) { int R, C; stage_rc(tid * 16 + i * 8192, R, C); const int Rb = Epi::PERM ? ((R & ~31) + perm32(R & 31)) : R;
        if (i == 0) { RA0 = R; CA0 = (unsigned)C * 2u; } voffB[i] = (unsigned)(Rb * K + C) * 2u; }
    unsigned ro[2], rn[2][2];
    const size_t kstep = (size_t)(BK * 2);
    const size_t hstep = (size_t)HALF * K * 2;
    const size_t tstep = 2 * hstep;
    const unsigned ldsw = (unsigned)wid * 1024u;
    const int aoff = lds_byte(wr * 64 + fr, fq * 8), boff = lds_byte(wc * 32 + fr, fq * 8);
#define PG8_SA(b, h) (((b) * 2 + (h)) * HTB)
#define PG8_SB(b, h) ((4 + (b) * 2 + (h)) * HTB)
#define PG8_STAGE(bufoff, gbase, voff) do { _Pragma("unroll") for (int _i = 0; _i < 2; ++_i) \
        __builtin_amdgcn_global_load_lds((const unsigned*)((const char*)(gbase) + (voff)[_i]), (PG8_LAS unsigned*)(lds + (bufoff) + ldsw + _i * 8192), 16, 0, 0); } while (0)
#define PG8_STAGE_G(bufoff, kbyte, pk) do { _Pragma("unroll") for (int _i = 0; _i < 2; ++_i) { const unsigned _row = _i ? ((pk) >> 16) : ((pk) & 0xffffu); \
        __builtin_amdgcn_global_load_lds((const unsigned*)((const char*)g.A + (kbyte) + (_row * ((unsigned)K * 2u) + CA0)), (PG8_LAS unsigned*)(lds + (bufoff) + ldsw + _i * 8192), 16, 0, 0); } } while (0)
#define PG8_LDA(dst, b, h) do { _Pragma("unroll") for (int m = 0; m < 4; ++m) _Pragma("unroll") for (int k = 0; k < 2; ++k) dst[m][k] = *(const PG8_LAS bf16x8*)(lds + PG8_SA(b, h) + aoff + m * 2048 + k * 1024); } while (0)
#define PG8_LDB(dst, b, h) do { _Pragma("unroll") for (int n = 0; n < 2; ++n) _Pragma("unroll") for (int k = 0; k < 2; ++k) dst[n][k] = *(const PG8_LAS bf16x8*)(lds + PG8_SB(b, h) + boff + n * 2048 + k * 1024); } while (0)
#define PG8_MMA(ai, bj, At, Bt) do { __builtin_amdgcn_s_setprio(1); _Pragma("unroll") for (int m = 0; m < 4; ++m) _Pragma("unroll") for (int n = 0; n < 2; ++n) _Pragma("unroll") for (int k = 0; k < 2; ++k) \
        acc[ai][bj][m][n] = __builtin_amdgcn_mfma_f32_16x16x32_bf16(Bt[n][k], At[m][k], acc[ai][bj][m][n], 0, 0, 0); __builtin_amdgcn_s_setprio(0); } while (0)
#define PG8_WAIT_V(n) asm volatile("s_waitcnt vmcnt(" #n ")" ::: "memory")
#define PG8_WAIT_VN(n) asm volatile("s_waitcnt vmcnt(%0)" :: "n"(n) : "memory")
#define PG8_WAIT_L(n) asm volatile("s_waitcnt lgkmcnt(" #n ")" ::: "memory")
#define PG8_BAR __builtin_amdgcn_s_barrier()
#define PG8_SCHED __builtin_amdgcn_sched_barrier(0)
    Unit cur, nxt; int ui = 0;
    if (!S.next(0, cur)) return;
    f32x4 acc[2][2][4][2];
#pragma unroll
    for (int a = 0; a < 2; ++a)
#pragma unroll
        for (int b = 0; b < 2; ++b)
#pragma unroll
            for (int m = 0; m < 4; ++m)
#pragma unroll
                for (int n = 0; n < 2; ++n) acc[a][b][m][n] = (f32x4){0.f, 0.f, 0.f, 0.f};
    bf16x8 At[4][2], B0[2][2], B1[2][2];
    const char* cB = (const char*)g.Bt + (size_t)cur.pn * tstep;
    S.a_ready(cur);
    S.rows(cur, RA0, rn); ro[0] = rn[0][0] | (rn[0][1] << 16); ro[1] = rn[1][0] | (rn[1][1] << 16);
    if constexpr (SP2) {
        PG8_STAGE(PG8_SB(0, 0), cB, voffB); PG8_STAGE(PG8_SB(0, 1), cB + hstep, voffB); PG8_STAGE_G(PG8_SA(0, 0), 0, ro[0]); PG8_STAGE_G(PG8_SA(0, 1), 0, ro[1]);
        if (wr == 1) PG8_BAR;
        PG8_WAIT_V(2); PG8_BAR;
        PG8_STAGE(PG8_SB(1, 0), cB + kstep, voffB); PG8_STAGE_G(PG8_SA(1, 0), kstep, ro[0]); PG8_STAGE(PG8_SB(1, 1), cB + hstep + kstep, voffB);
        PG8_WAIT_V(6); PG8_BAR;
    }
    for (;;) {
        const bool has_next = S.next(ui + 1, nxt);
        const char* nB = has_next ? (const char*)g.Bt + (size_t)nxt.pn * tstep : cB;
        for (int t = 0; t < nt; t += 2) {
            const bool last = (t == nt - 2);
            const size_t k1 = (size_t)(t + 1) * kstep, k2 = last ? (size_t)0 : (size_t)(t + 2) * kstep, k3 = k2 + kstep;
            const char* b2 = last ? nB : cB + (size_t)(t + 2) * kstep; const char* b3 = b2 + kstep;
            if (t == nt - 4 && has_next) S.rows(nxt, RA0, rn);
            const unsigned c1 = ro[1];
            unsigned s0 = ro[0], s1 = ro[1];
            if (last && has_next) { unsigned q0 = rn[0][0], q1 = rn[0][1], q2 = rn[1][0], q3 = rn[1][1]; asm volatile("" : "+v"(q0), "+v"(q1), "+v"(q2), "+v"(q3));
                s0 = q0 | (q1 << 16); s1 = q2 | (q3 << 16); ro[0] = s0; ro[1] = s1; }
            if (last && has_next) S.a_ready(nxt);
            if constexpr (SP2) {
            PG8_LDB(B0, 0, 0); PG8_LDB(B1, 0, 1); PG8_SCHED; PG8_LDA(At, 0, 0); PG8_STAGE_G(PG8_SA(1, 1), k1, c1);
            PG8_WAIT_V(8); PG8_WAIT_L(0); PG8_BAR; PG8_MMA(0, 0, At, B0); PG8_MMA(0, 1, At, B1); PG8_BAR; PG8_SCHED;
            PG8_LDA(At, 0, 1); PG8_STAGE(PG8_SB(0, 0), b2, voffB); PG8_STAGE(PG8_SB(0, 1), b2 + hstep, voffB); PG8_STAGE_G(PG8_SA(0, 0), k2, s0);
            PG8_WAIT_V(8); PG8_WAIT_L(0); PG8_BAR; PG8_MMA(1, 0, At, B0); PG8_MMA(1, 1, At, B1); PG8_BAR; PG8_SCHED;
            PG8_LDB(B0, 1, 0); PG8_LDB(B1, 1, 1); PG8_SCHED; PG8_LDA(At, 1, 0); PG8_STAGE_G(PG8_SA(0, 1), k2, s1);
            PG8_WAIT_V(8); PG8_WAIT_L(0); PG8_BAR; PG8_MMA(0, 0, At, B0); PG8_MMA(0, 1, At, B1); PG8_BAR; PG8_SCHED;
            PG8_LDA(At, 1, 1); PG8_STAGE(PG8_SB(1, 0), b3, voffB); PG8_STAGE(PG8_SB(1, 1), b3 + hstep, voffB); PG8_STAGE_G(PG8_SA(1, 0), k3, s0);
            PG8_WAIT_V(8); PG8_WAIT_L(0); PG8_BAR; PG8_MMA(1, 0, At, B0); PG8_MMA(1, 1, At, B1); PG8_BAR; PG8_SCHED;
            }
        }
        if constexpr (ALIGN_EPI) { if (wr == 0) PG8_BAR; }
        if constexpr (!Epi::AFTER_DRAIN) { E(acc, cur, wr, wc, fr, fq); S.done(cur); }
        if (!has_next) break;
#pragma unroll
        for (int a = 0; a < 2; ++a)
#pragma unroll
            for (int b = 0; b < 2; ++b)
#pragma unroll
                for (int m = 0; m < 4; ++m)
#pragma unroll
                    for (int n = 0; n < 2; ++n) acc[a][b][m][n] = (f32x4){0.f, 0.f, 0.f, 0.f};
        cur = nxt; cB = nB; ++ui;
        if constexpr (ALIGN_EPI) { if (wr == 1) PG8_BAR; }
    }
    PG8_WAIT_V(0);
    if constexpr (!ALIGN_EPI) { if (wr == 0) PG8_BAR; }
    PG8_BAR;
    if constexpr (Epi::AFTER_DRAIN) { E.fused(acc, cur, wr, wc, fr, fq, lds, wid, lane); S.done(cur); }
#undef PG8_SA
#undef PG8_SB
#undef PG8_STAGE
#undef PG8_STAGE_G
#undef PG8_LDA
#undef PG8_LDB
#undef PG8_MMA
#undef PG8_WAIT_V
#undef PG8_WAIT_VN
#undef PG8_WAIT_L
#undef PG8_BAR
#undef PG8_SCHED
}
typedef int v8i_t __attribute__((ext_vector_type(8)));
template <class Epi, class Sched, bool ALIGN_EPI = false, bool SP2 = false>
__device__ __forceinline__ void gemm_phase8(PG8_LAS unsigned char* lds, const Gemm g, const Sched& S, const Epi& E, const int wave_in) {
    unsigned z_ = 0u; asm volatile("" : "+v"(z_)); const int tid_ = (int)__builtin_amdgcn_mbcnt_hi(~0u, __builtin_amdgcn_mbcnt_lo(~0u, z_)) + 64 * wave_in;
    const int tid = tid_, wid = __builtin_amdgcn_readfirstlane(tid >> 6), lane = tid & 63, wr = wid >> 2, wc = wid & 3, fr = lane & 15, fq = lane >> 4;
    const int K = g.K, nt = K / (2 * BK);
    unsigned voffA[2], voffB[2];
#pragma unroll
    for (int i = 0; i < 2; ++i) { int R, C; stage_rc(tid * 16 + i * 8192, R, C); const int Rb = Epi::PERM ? ((R & ~31) + perm32(R & 31)) : R;
        voffA[i] = (unsigned)(R * K + C * 2); voffB[i] = (unsigned)(Rb * K + C * 2); }
    const size_t kstep = (size_t)(BK * 2);
    const size_t hstep = (size_t)HALF * K;
    const size_t tstep = 2 * hstep;
    const unsigned ldsw = (unsigned)wid * 1024u;
    const int aoff = lds_byte(wr * 64 + fr, fq * 8), boff = lds_byte(wc * 32 + fr, fq * 8);
#define PG8_SA(b, h) (((b) * 2 + (h)) * HTB)
#define PG8_SB(b, h) ((4 + (b) * 2 + (h)) * HTB)
#define PG8_STAGE(bufoff, gbase, voff) do { _Pragma("unroll") for (int _i = 0; _i < 2; ++_i) \
        __builtin_amdgcn_global_load_lds((const unsigned*)((const char*)(gbase) + (voff)[_i]), (PG8_LAS unsigned*)(lds + (bufoff) + ldsw + _i * 8192), 16, 0, 0); } while (0)
#define PG8_LDA(dst, b, h) do { _Pragma("unroll") for (int m = 0; m < 4; ++m) { const u32x4 lo_ = *(const PG8_LAS u32x4*)(lds + PG8_SA(b, h) + aoff + m * 2048), hi_ = *(const PG8_LAS u32x4*)(lds + PG8_SA(b, h) + aoff + m * 2048 + 1024); dst[m] = (v8i_t){(int)lo_.x, (int)lo_.y, (int)lo_.z, (int)lo_.w, (int)hi_.x, (int)hi_.y, (int)hi_.z, (int)hi_.w}; } } while (0)
#define PG8_LDB(dst, b, h) do { _Pragma("unroll") for (int n = 0; n < 2; ++n) { const u32x4 lo_ = *(const PG8_LAS u32x4*)(lds + PG8_SB(b, h) + boff + n * 2048), hi_ = *(const PG8_LAS u32x4*)(lds + PG8_SB(b, h) + boff + n * 2048 + 1024); dst[n] = (v8i_t){(int)lo_.x, (int)lo_.y, (int)lo_.z, (int)lo_.w, (int)hi_.x, (int)hi_.y, (int)hi_.z, (int)hi_.w}; } } while (0)
#define PG8_MMA(ai, bj, At, Bt) do { __builtin_amdgcn_s_setprio(1); _Pragma("unroll") for (int m = 0; m < 4; ++m) _Pragma("unroll") for (int n = 0; n < 2; ++n) \
        asm volatile("v_mfma_f32_16x16x128_f8f6f4 %0, %1, %2, %0" : "+v"(acc[ai][bj][m][n]) : "v"(Bt[n]), "v"(At[m])); __builtin_amdgcn_s_setprio(0); } while (0)
#define PG8_MMAZ(ai, bj, At, Bt) do { __builtin_amdgcn_s_setprio(1); _Pragma("unroll") for (int m = 0; m < 4; ++m) _Pragma("unroll") for (int n = 0; n < 2; ++n) \
        asm volatile("v_mfma_f32_16x16x128_f8f6f4 %0, %1, %2, 0" : "=v"(acc[ai][bj][m][n]) : "v"(Bt[n]), "v"(At[m])); __builtin_amdgcn_s_setprio(0); } while (0)
#define PG8_WAIT_V(n) asm volatile("s_waitcnt vmcnt(" #n ")" ::: "memory")
#define PG8_WAIT_VN(n) asm volatile("s_waitcnt vmcnt(%0)" :: "n"(n) : "memory")
#define PG8_WAIT_L(n) asm volatile("s_waitcnt lgkmcnt(" #n ")" ::: "memory")
#define PG8_BAR __builtin_amdgcn_s_barrier()
#define PG8_SCHED __builtin_amdgcn_sched_barrier(0)
    Unit cur, nxt; int ui = 0;
    if (!S.next(0, cur)) return;
    f32x4 acc[2][2][4][2];
#pragma unroll
    for (int a = 0; a < 2; ++a)
#pragma unroll
        for (int b = 0; b < 2; ++b)
#pragma unroll
            for (int m = 0; m < 4; ++m)
#pragma unroll
                for (int n = 0; n < 2; ++n) (void)0;
    v8i_t At[4], B0[2], B1[2];
    typename Epi::Pre pre;
    const char* cA = (const char*)g.A + (size_t)cur.pm * tstep; const char* cB = (const char*)g.Bt + (size_t)cur.pn * tstep;
    S.a_ready(cur);
    if constexpr (SP2) {
        PG8_STAGE(PG8_SB(0, 0), cB, voffB); PG8_STAGE(PG8_SB(0, 1), cB + hstep, voffB); PG8_STAGE(PG8_SA(0, 0), cA, voffA); PG8_STAGE(PG8_SA(0, 1), cA + hstep, voffA);
        if (wr == 1) PG8_BAR;
        PG8_WAIT_V(2); PG8_BAR;
        PG8_STAGE(PG8_SB(1, 0), cB + kstep, voffB); PG8_STAGE(PG8_SA(1, 0), cA + kstep, voffA); PG8_STAGE(PG8_SB(1, 1), cB + hstep + kstep, voffB);
        PG8_WAIT_V(6); PG8_BAR;
    } else {
        PG8_STAGE(PG8_SB(0, 0), cB, voffB); PG8_STAGE(PG8_SA(0, 0), cA, voffA); PG8_STAGE(PG8_SB(0, 1), cB + hstep, voffB); PG8_STAGE(PG8_SA(0, 1), cA + hstep, voffA);
        if (wr == 1) PG8_BAR;
        PG8_WAIT_V(4); PG8_BAR;
        PG8_STAGE(PG8_SB(1, 0), cB + kstep, voffB); PG8_STAGE(PG8_SA(1, 0), cA + kstep, voffA); PG8_STAGE(PG8_SB(1, 1), cB + hstep + kstep, voffB);
        PG8_WAIT_V(6); PG8_BAR;
    }
    for (;;) {
        const bool has_next = S.next(ui + 1, nxt);
        const char* nA = has_next ? (const char*)g.A + (size_t)nxt.pm * tstep : cA; const char* nB = has_next ? (const char*)g.Bt + (size_t)nxt.pn * tstep : cB;
#pragma nounroll
        for (int t = 0; t < nt; t += 2) {
            const bool last = (t == nt - 2);
            const char* a1 = cA + (size_t)(t + 1) * kstep;
            const char* a2 = last ? nA : cA + (size_t)(t + 2) * kstep; const char* b2 = last ? nB : cB + (size_t)(t + 2) * kstep;
            const char* a3 = a2 + kstep; const char* b3 = b2 + kstep;
            if (last && has_next) S.a_ready(nxt);
            if (last) E.prefetch(pre, cur, wr, wc, fr, fq);
            if constexpr (SP2) {
            PG8_LDB(B0, 0, 0); PG8_LDB(B1, 0, 1); PG8_SCHED; PG8_LDA(At, 0, 0); PG8_STAGE(PG8_SA(1, 1), a1 + hstep, voffA);
            if (PG8_RELAX_B && t == 0 && ui > 0) PG8_WAIT_VN(8 + Epi::NST); else PG8_WAIT_V(8); PG8_WAIT_L(0); PG8_BAR; if (t == 0) { PG8_MMAZ(0, 0, At, B0); PG8_MMAZ(0, 1, At, B1); } else { PG8_MMA(0, 0, At, B0); PG8_MMA(0, 1, At, B1); } PG8_BAR; PG8_SCHED;
            PG8_LDA(At, 0, 1); PG8_STAGE(PG8_SB(0, 0), b2, voffB); PG8_STAGE(PG8_SB(0, 1), b2 + hstep, voffB); PG8_STAGE(PG8_SA(0, 0), a2, voffA);
            if (PG8_RELAX_B && t == 0 && ui > 0) PG8_WAIT_VN(8 + Epi::NST); else PG8_WAIT_V(8); PG8_WAIT_L(0); PG8_BAR; if (t == 0) { PG8_MMAZ(1, 0, At, B0); PG8_MMAZ(1, 1, At, B1); } else { PG8_MMA(1, 0, At, B0); PG8_MMA(1, 1, At, B1); } PG8_BAR; PG8_SCHED;
            PG8_LDB(B0, 1, 0); PG8_LDB(B1, 1, 1); PG8_SCHED; PG8_LDA(At, 1, 0); PG8_STAGE(PG8_SA(0, 1), a2 + hstep, voffA);
            PG8_WAIT_V(8); PG8_WAIT_L(0); PG8_BAR; PG8_MMA(0, 0, At, B0); PG8_MMA(0, 1, At, B1); PG8_BAR; PG8_SCHED;
            PG8_LDA(At, 1, 1); PG8_STAGE(PG8_SB(1, 0), b3, voffB); PG8_STAGE(PG8_SB(1, 1), b3 + hstep, voffB); PG8_STAGE(PG8_SA(1, 0), a3, voffA);
            PG8_WAIT_V(8); PG8_WAIT_L(0); PG8_BAR; PG8_MMA(1, 0, At, B0); PG8_MMA(1, 1, At, B1); PG8_BAR; PG8_SCHED;
            } else {
            PG8_LDB(B0, 0, 0); PG8_SCHED; PG8_LDA(At, 0, 0); PG8_STAGE(PG8_SA(1, 1), a1 + hstep, voffA);
            PG8_WAIT_L(8); PG8_BAR; PG8_WAIT_L(0); PG8_MMA(0, 0, At, B0); PG8_BAR; PG8_SCHED;
            PG8_LDB(B1, 0, 1); PG8_STAGE(PG8_SB(0, 0), b2, voffB);
            PG8_BAR; PG8_WAIT_L(0); PG8_MMA(0, 1, At, B1); PG8_BAR;
            PG8_LDA(At, 0, 1); PG8_STAGE(PG8_SA(0, 0), a2, voffA);
            PG8_BAR; PG8_WAIT_L(0); PG8_MMA(1, 0, At, B0); PG8_BAR; PG8_SCHED;
            PG8_STAGE(PG8_SB(0, 1), b2 + hstep, voffB);
            PG8_WAIT_V(6); PG8_BAR; PG8_MMA(1, 1, At, B1); PG8_BAR;
            PG8_LDB(B0, 1, 0); PG8_SCHED; PG8_LDA(At, 1, 0); PG8_STAGE(PG8_SA(0, 1), a2 + hstep, voffA);
            PG8_WAIT_L(8); PG8_BAR; PG8_WAIT_L(0); PG8_MMA(0, 0, At, B0); PG8_BAR; PG8_SCHED;
            PG8_LDB(B1, 1, 1); PG8_STAGE(PG8_SB(1, 0), b3, voffB);
            PG8_BAR; PG8_WAIT_L(0); PG8_MMA(0, 1, At, B1); PG8_BAR;
            PG8_LDA(At, 1, 1); PG8_STAGE(PG8_SA(1, 0), a3, voffA);
            PG8_BAR; PG8_WAIT_L(0); PG8_MMA(1, 0, At, B0); PG8_BAR; PG8_SCHED;
            PG8_STAGE(PG8_SB(1, 1), b3 + hstep, voffB);
            PG8_WAIT_V(6); PG8_BAR; PG8_MMA(1, 1, At, B1); PG8_BAR;
            }
        }
        E.preload(pre, cur, wr, wc, fr, fq);
        asm volatile("s_nop 15\n\ts_nop 15" ::: "memory");
        if constexpr (ALIGN_EPI) { if (wr == 0) PG8_BAR; }
        if constexpr (!Epi::AFTER_DRAIN) { E(acc, cur, wr, wc, fr, fq, pre); S.done(cur); }
        if (!has_next) break;
#pragma unroll
        for (int a = 0; a < 2; ++a)
#pragma unroll
            for (int b = 0; b < 2; ++b)
#pragma unroll
                for (int m = 0; m < 4; ++m)
#pragma unroll
                    for (int n = 0; n < 2; ++n) (void)0;
        cur = nxt; cA = nA; cB = nB; ++ui;
        if constexpr (ALIGN_EPI) { if (wr == 1) PG8_BAR; }
    }
    PG8_WAIT_V(0);
    if constexpr (!ALIGN_EPI) { if (wr == 0) PG8_BAR; }
    PG8_BAR;
    if constexpr (Epi::AFTER_DRAIN) { E.fused(acc, cur, wr, wc, fr, fq, lds, wid, lane); S.done(cur); }
#undef PG8_SA
#undef PG8_SB
#undef PG8_STAGE
#undef PG8_LDA
#undef PG8_LDB
#undef PG8_MMA
#undef PG8_MMAZ
#undef PG8_WAIT_V
#undef PG8_WAIT_VN
#undef PG8_WAIT_L
#undef PG8_BAR
#undef PG8_SCHED
}
template <class Epi, class Sched>
__device__ __forceinline__ void gemm_phase_gather8(PG8_LAS unsigned char* lds, const Gemm g, const Sched& S, const Epi& E, const int wave_in) {
    unsigned z_ = 0u; asm volatile("" : "+v"(z_)); const int tid_ = (int)__builtin_amdgcn_mbcnt_hi(~0u, __builtin_amdgcn_mbcnt_lo(~0u, z_)) + 64 * wave_in;
    const int tid = tid_, wid = __builtin_amdgcn_readfirstlane(tid >> 6), lane = tid & 63, wr = wid >> 2, wc = wid & 3, fr = lane & 15, fq = lane >> 4;
    constexpr bool ALIGN_EPI = true, SP2 = true;
    const int K = g.K, nt = K / (2 * BK);
    unsigned voffB[2]; int RA0; unsigned CA0;
#pragma unroll
    for (int i = 0; i < 2; ++i) { int R, C; stage_rc(tid * 16 + i * 8192, R, C); const int Rb = Epi::PERM ? ((R & ~31) + perm32(R & 31)) : R;
        if (i == 0) { RA0 = R; CA0 = (unsigned)C * 2u; } voffB[i] = (unsigned)(Rb * K + C * 2); }
    unsigned ro[2], rn[2][2];
    const size_t kstep = (size_t)(BK * 2);
    const size_t hstep = (size_t)HALF * K;
    const size_t tstep = 2 * hstep;
    const unsigned ldsw = (unsigned)wid * 1024u;
    const int aoff = lds_byte(wr * 64 + fr, fq * 8), boff = lds_byte(wc * 32 + fr, fq * 8);
#define PG8_SA(b, h) (((b) * 2 + (h)) * HTB)
#define PG8_SB(b, h) ((4 + (b) * 2 + (h)) * HTB)
#define PG8_STAGE(bufoff, gbase, voff) do { _Pragma("unroll") for (int _i = 0; _i < 2; ++_i) \
        __builtin_amdgcn_global_load_lds((const unsigned*)((const char*)(gbase) + (voff)[_i]), (PG8_LAS unsigned*)(lds + (bufoff) + ldsw + _i * 8192), 16, 0, 0); } while (0)
#define PG8_STAGE_G(bufoff, kbyte, pk) do { _Pragma("unroll") for (int _i = 0; _i < 2; ++_i) { const unsigned _row = _i ? ((pk) >> 16) : ((pk) & 0xffffu); \
        __builtin_amdgcn_global_load_lds((const unsigned*)((const char*)g.A + (kbyte) + (_row * (unsigned)K + CA0)), (PG8_LAS unsigned*)(lds + (bufoff) + ldsw + _i * 8192), 16, 0, 0); } } while (0)
#define PG8_LDA(dst, b, h) do { _Pragma("unroll") for (int m = 0; m < 4; ++m) { const u32x4 lo_ = *(const PG8_LAS u32x4*)(lds + PG8_SA(b, h) + aoff + m * 2048), hi_ = *(const PG8_LAS u32x4*)(lds + PG8_SA(b, h) + aoff + m * 2048 + 1024); dst[m] = (v8i_t){(int)lo_.x, (int)lo_.y, (int)lo_.z, (int)lo_.w, (int)hi_.x, (int)hi_.y, (int)hi_.z, (int)hi_.w}; } } while (0)
#define PG8_LDB(dst, b, h) do { _Pragma("unroll") for (int n = 0; n < 2; ++n) { const u32x4 lo_ = *(const PG8_LAS u32x4*)(lds + PG8_SB(b, h) + boff + n * 2048), hi_ = *(const PG8_LAS u32x4*)(lds + PG8_SB(b, h) + boff + n * 2048 + 1024); dst[n] = (v8i_t){(int)lo_.x, (int)lo_.y, (int)lo_.z, (int)lo_.w, (int)hi_.x, (int)hi_.y, (int)hi_.z, (int)hi_.w}; } } while (0)
#define PG8_MMA(ai, bj, At, Bt) do { __builtin_amdgcn_s_setprio(1); _Pragma("unroll") for (int m = 0; m < 4; ++m) _Pragma("unroll") for (int n = 0; n < 2; ++n) \
        asm volatile("v_mfma_f32_16x16x128_f8f6f4 %0, %1, %2, %0" : "+v"(acc[ai][bj][m][n]) : "v"(Bt[n]), "v"(At[m])); __builtin_amdgcn_s_setprio(0); } while (0)
#define PG8_MMAZ(ai, bj, At, Bt) do { __builtin_amdgcn_s_setprio(1); _Pragma("unroll") for (int m = 0; m < 4; ++m) _Pragma("unroll") for (int n = 0; n < 2; ++n) \
        asm volatile("v_mfma_f32_16x16x128_f8f6f4 %0, %1, %2, 0" : "=v"(acc[ai][bj][m][n]) : "v"(Bt[n]), "v"(At[m])); __builtin_amdgcn_s_setprio(0); } while (0)
#define PG8_WAIT_V(n) asm volatile("s_waitcnt vmcnt(" #n ")" ::: "memory")
#define PG8_WAIT_VN(n) asm volatile("s_waitcnt vmcnt(%0)" :: "n"(n) : "memory")
#define PG8_WAIT_L(n) asm volatile("s_waitcnt lgkmcnt(" #n ")" ::: "memory")
#define PG8_BAR __builtin_amdgcn_s_barrier()
#define PG8_SCHED __builtin_amdgcn_sched_barrier(0)
#define PG8_SPH(m0, m1) do { PG8_WAIT_V(8); PG8_WAIT_L(0); PG8_BAR; m0; m1; PG8_BAR; PG8_SCHED; } while (0)
#define PG8_SPH0(m0, m1) do { if (PG8_RELAX_C && ui > 0) PG8_WAIT_VN(8 + Epi::NST); else PG8_WAIT_V(8); PG8_WAIT_L(0); PG8_BAR; m0; m1; PG8_BAR; PG8_SCHED; } while (0)
    Unit cur, nxt; int ui = 0;
    if (!S.next(0, cur)) return;
    f32x4 acc[2][2][4][2];
#pragma unroll
    for (int a = 0; a < 2; ++a)
#pragma unroll
        for (int b = 0; b < 2; ++b)
#pragma unroll
            for (int m = 0; m < 4; ++m)
#pragma unroll
                for (int n = 0; n < 2; ++n) (void)0;
    v8i_t At[4], B0[2], B1[2];
    typename Epi::Pre pre;
    const char* cB = (const char*)g.Bt + (size_t)cur.pn * tstep;
    S.a_ready(cur);
    S.rows(cur, RA0, rn); ro[0] = rn[0][0] | (rn[0][1] << 16); ro[1] = rn[1][0] | (rn[1][1] << 16);
    if constexpr (SP2) {
        PG8_STAGE(PG8_SB(0, 0), cB, voffB); PG8_STAGE(PG8_SB(0, 1), cB + hstep, voffB); PG8_STAGE_G(PG8_SA(0, 0), 0, ro[0]); PG8_STAGE_G(PG8_SA(0, 1), 0, ro[1]);
        if (wr == 1) PG8_BAR;
        PG8_WAIT_V(2); PG8_BAR;
        PG8_STAGE(PG8_SB(1, 0), cB + kstep, voffB); PG8_STAGE_G(PG8_SA(1, 0), kstep, ro[0]); PG8_STAGE(PG8_SB(1, 1), cB + hstep + kstep, voffB);
        PG8_WAIT_V(6); PG8_BAR;
    }
    for (;;) {
        const bool has_next = S.next(ui + 1, nxt);
        const char* nB = has_next ? (const char*)g.Bt + (size_t)nxt.pn * tstep : cB;
#pragma nounroll
        for (int t = 0; t < nt; t += 2) {
            const bool last = (t == nt - 2);
            const size_t k1 = (size_t)(t + 1) * kstep, k2 = last ? (size_t)0 : (size_t)(t + 2) * kstep, k3 = k2 + kstep;
            const char* b2 = last ? nB : cB + (size_t)(t + 2) * kstep; const char* b3 = b2 + kstep;
            if (t == nt - 4 && has_next) S.rows(nxt, RA0, rn);
            const unsigned c1 = ro[1];
            unsigned s0 = ro[0], s1 = ro[1];
            if (last && has_next) { unsigned q0 = rn[0][0], q1 = rn[0][1], q2 = rn[1][0], q3 = rn[1][1]; asm volatile("" : "+v"(q0), "+v"(q1), "+v"(q2), "+v"(q3));
                s0 = q0 | (q1 << 16); s1 = q2 | (q3 << 16); ro[0] = s0; ro[1] = s1; }
            if (last && has_next) S.a_ready(nxt);
            if (last) E.prefetch(pre, cur, wr, wc, fr, fq);
            if constexpr (SP2) {
            PG8_LDB(B0, 0, 0); PG8_LDB(B1, 0, 1); PG8_SCHED; PG8_LDA(At, 0, 0); PG8_STAGE_G(PG8_SA(1, 1), k1, c1);
            if (t == 0) PG8_SPH0(PG8_MMAZ(0, 0, At, B0), PG8_MMAZ(0, 1, At, B1)); else PG8_SPH(PG8_MMA(0, 0, At, B0), PG8_MMA(0, 1, At, B1));
            PG8_LDA(At, 0, 1); PG8_STAGE(PG8_SB(0, 0), b2, voffB); PG8_STAGE(PG8_SB(0, 1), b2 + hstep, voffB); PG8_STAGE_G(PG8_SA(0, 0), k2, s0);
            if (t == 0) PG8_SPH0(PG8_MMAZ(1, 0, At, B0), PG8_MMAZ(1, 1, At, B1)); else PG8_SPH(PG8_MMA(1, 0, At, B0), PG8_MMA(1, 1, At, B1));
            PG8_LDB(B0, 1, 0); PG8_LDB(B1, 1, 1); PG8_SCHED; PG8_LDA(At, 1, 0); PG8_STAGE_G(PG8_SA(0, 1), k2, s1);
            PG8_SPH(PG8_MMA(0, 0, At, B0), PG8_MMA(0, 1, At, B1));
            PG8_LDA(At, 1, 1); PG8_STAGE(PG8_SB(1, 0), b3, voffB); PG8_STAGE(PG8_SB(1, 1), b3 + hstep, voffB); PG8_STAGE_G(PG8_SA(1, 0), k3, s0);
            PG8_SPH(PG8_MMA(1, 0, At, B0), PG8_MMA(1, 1, At, B1));
            }
        }
        E.preload(pre, cur, wr, wc, fr, fq);
        asm volatile("s_nop 15\n\ts_nop 15" ::: "memory");
        if constexpr (ALIGN_EPI) { if (wr == 0) PG8_BAR; }
        if constexpr (!Epi::AFTER_DRAIN) { E(acc, cur, wr, wc, fr, fq, pre); S.done(cur); }
        if (!has_next) break;
#pragma unroll
        for (int a = 0; a < 2; ++a)
#pragma unroll
            for (int b = 0; b < 2; ++b)
#pragma unroll
                for (int m = 0; m < 4; ++m)
#pragma unroll
                    for (int n = 0; n < 2; ++n) (void)0;
        cur = nxt; cB = nB; ++ui;
        if constexpr (ALIGN_EPI) { if (wr == 1) PG8_BAR; }
    }
    PG8_WAIT_V(0);
    if constexpr (!ALIGN_EPI) { if (wr == 0) PG8_BAR; }
    PG8_BAR;
    if constexpr (Epi::AFTER_DRAIN) { E.fused(acc, cur, wr, wc, fr, fq, lds, wid, lane); S.done(cur); }
#undef PG8_SA
#undef PG8_SB
#undef PG8_STAGE
#undef PG8_STAGE_G
#undef PG8_LDA
#undef PG8_LDB
#undef PG8_MMA
#undef PG8_MMAZ
#undef PG8_WAIT_V
#undef PG8_WAIT_VN
#undef PG8_WAIT_L
#undef PG8_BAR
#undef PG8_SCHED
#undef PG8_SPH
#undef PG8_SPH0
}
}

#ifndef PG8_SP2
#define PG8_SP2 true
#endif
#ifndef PG8_ALIGN
#define PG8_ALIGN true
#endif

constexpr int NTOK = 65536, DM = 1024, NCOL = 7680, SEQ = 4096, NBATCH = 16, HTOK = 32768, MEMLEN = 256;
constexpr int C_HQ = 0, C_HF = 1024, C_HI = 2048, C_HG = 3072, C_SQ = 4096, C_SK = 5120, C_SV = 5376, C_GA = 5632, C_GB = 6656;
constexpr size_t PJ_HQ = 0, PJ_HF = 64 * ((size_t)1 << 20), PJ_HI = 128 * ((size_t)1 << 20), PJ_HG = 192 * ((size_t)1 << 20), PJ_SQ = 256 * ((size_t)1 << 20), PJ_SK = 320 * ((size_t)1 << 20), PJ_SV = 336 * ((size_t)1 << 20), PJ_GA = 352 * ((size_t)1 << 20), PJ_GB = 416 * ((size_t)1 << 20);
constexpr int NEXP = 32, TOPK = 4, CAPH = HTOK * TOPK + NEXP * 256;
constexpr float RMS_EPS = 1e-5f;
constexpr size_t MiB = (size_t)1 << 20;
constexpr size_t WS_ZERO_BYTES = 2 * MiB;
constexpr size_t WS_GCNT = 1 * MiB;
constexpr int CW_TMO = 0, CW_BAR = 4096;
constexpr size_t WS_LB = 2 * MiB, WS_LUT = 2 * MiB + 4096, WS_BLKE = 2 * MiB + 16384, WS_NBT = 2 * MiB + 32768;
constexpr size_t WS_TOPE = 3 * MiB, WS_TOPG = 4 * MiB, WS_TOPR = 5 * MiB, WS_TOPP = 6 * MiB, WS_RGATE = 7 * MiB, WS_RRSTD = 8 * MiB, WS_D12 = 10 * MiB;
constexpr size_t WS_WIN = 16 * MiB, WS_WA = 31 * MiB, WS_WB = 33 * MiB, WS_WMIX = 35 * MiB, WS_WQ = 37 * MiB, WS_WK = 39 * MiB, WS_WV = 41 * MiB, WS_WO = 43 * MiB, WS_WR = 45 * MiB;
constexpr size_t WS_MEMBF = 46 * MiB, WS_KX = 54 * MiB, WS_VXT = 62 * MiB;
constexpr size_t WS_XBF = 72 * MiB;
constexpr size_t WS_PROJ = 200 * MiB, WS_OA = 680 * MiB, WS_OB = 744 * MiB, WS_TM = 808 * MiB;
constexpr size_t WS_Q = 664 * MiB, WS_O = 792 * MiB;
constexpr size_t WS_X1F8 = 872 * MiB;
constexpr size_t WS_X2F8 = 296 * MiB;
constexpr size_t WS_WD = 200 * MiB, WS_WGU = 232 * MiB, WS_Y1 = 232 * MiB, WS_ACT = 392 * MiB, WS_Y = 664 * MiB,     WS_SSQ1 = 936 * MiB, WS_SSQ2 = 940 * MiB, WS_RTOK = 944 * MiB, WS_RGATE2 = 952 * MiB, WS_RRSTD2 = 960 * MiB, WS_END = 968 * MiB;
constexpr size_t ACT_HALF = (size_t)CAPH * 1024;
constexpr size_t OUT_US = 128 * MiB;

#define GAS __attribute__((address_space(1)))
#define LAS __attribute__((address_space(3)))
typedef unsigned short bf16;
typedef unsigned v4u __attribute__((ext_vector_type(4)));
typedef unsigned v2u __attribute__((ext_vector_type(2)));
typedef float f32x4 __attribute__((ext_vector_type(4)));
typedef short bf16x8 __attribute__((ext_vector_type(8)));
typedef short s16x4 __attribute__((ext_vector_type(4)));
#define RLX_AGENT __ATOMIC_RELAXED, __HIP_MEMORY_SCOPE_AGENT
#define LDS_WAIT() asm volatile("s_waitcnt lgkmcnt(0)" ::: "memory")
#define CFENCE() asm volatile("" ::: "memory")
__device__ __forceinline__ unsigned f2bf(float f) { unsigned u = __builtin_bit_cast(unsigned, f); return (u + 0x7fffu + ((u >> 16) & 1u)) >> 16; }
typedef float f32x2_t __attribute__((ext_vector_type(2))); typedef __bf16 bf16x2_t __attribute__((ext_vector_type(2)));
__device__ __forceinline__ unsigned pk2(float lo, float hi) { f32x2_t v = {lo, hi}; bf16x2_t b = __builtin_convertvector(v, bf16x2_t); return __builtin_bit_cast(unsigned, b); }
__device__ __forceinline__ unsigned pk4f8(float a, float b, float c, float d) { int r = 0; r = __builtin_amdgcn_cvt_pk_fp8_f32(a, b, r, false); r = __builtin_amdgcn_cvt_pk_fp8_f32(c, d, r, true); return (unsigned)r; }
constexpr float F8_WSCALE = 64.f, F8_WINV = 1.f / 64.f;
__device__ __forceinline__ float bflo(unsigned w) { return __builtin_bit_cast(float, w << 16); }
__device__ __forceinline__ float bfhi(unsigned w) { return __builtin_bit_cast(float, w & 0xffff0000u); }
__device__ __forceinline__ float fexp(float x) { return __builtin_amdgcn_exp2f(x * 1.4426950408889634f); }
__device__ __forceinline__ float flog(float x) { return __builtin_amdgcn_logf(x) * 0.6931471805599453f; }
__device__ __forceinline__ float sigm(float x) { return __builtin_amdgcn_rcpf(1.f + fexp(-x)); }
__device__ __forceinline__ float shx(float v, int mask, int lane) { return __builtin_bit_cast(float, __builtin_amdgcn_ds_bpermute((lane ^ mask) << 2, __builtin_bit_cast(int, v))); }
__device__ __forceinline__ float wave_sum(float v, int lane) {
#pragma unroll
    for (int o = 1; o < 64; o <<= 1) v += shx(v, o, lane);
    return v;
}
__device__ __forceinline__ f32x4 mfma16(bf16x8 a, bf16x8 b, f32x4 c) { return __builtin_amdgcn_mfma_f32_16x16x32_bf16(a, b, c, 0, 0, 0); }
__device__ __forceinline__ s16x4 vtr(const LAS unsigned char* p) { return __builtin_bit_cast(s16x4, __builtin_amdgcn_ds_read_tr16_b64_v4i16((LAS s16x4*)p)); }
__device__ __forceinline__ bf16x8 cat8(s16x4 lo, s16x4 hi) { return __builtin_shufflevector(lo, hi, 0, 1, 2, 3, 4, 5, 6, 7); }
__device__ __forceinline__ bf16x8 pack8(f32x4 a, f32x4 b) { v4u w; w.x = pk2(a[0], a[1]); w.y = pk2(a[2], a[3]); w.z = pk2(b[0], b[1]); w.w = pk2(b[2], b[3]); return __builtin_bit_cast(bf16x8, w); }
__device__ __forceinline__ float rstd16(const float* ssqp, size_t row) { const f32x4* p = (const f32x4*)(ssqp + row * 16); const f32x4 a = p[0], b = p[1], c = p[2], d = p[3];
    const float s = ((a[0] + a[1]) + (a[2] + a[3])) + ((b[0] + b[1]) + (b[2] + b[3])) + ((c[0] + c[1]) + (c[2] + c[3])) + ((d[0] + d[1]) + (d[2] + d[3])); return rsqrtf(s * (1.f / 1024.f) + 1e-5f); }
__device__ __forceinline__ unsigned ld_agent(const unsigned* p) { return __hip_atomic_load(p, RLX_AGENT); }


#define XB_TMO      128
#define XB_XCNT(j)  (256  + 64 * (j))
#define XB_XSUB(j)  (1280 + 64 * (j))
#define XB_XGEN(j)  (2304 + 64 * (j))
#define XB_TOP      3328
#define XB_TOPGEN   3392
#define XCD_BAR_WORDS 3456
#define XB_SPIN_CAP (1u << 18)

__device__ __forceinline__ unsigned xb_ld(unsigned* p)              { return __hip_atomic_load(p, __ATOMIC_RELAXED, __HIP_MEMORY_SCOPE_AGENT); }
__device__ __forceinline__ unsigned xb_add(unsigned* p, unsigned v) { return __hip_atomic_fetch_add(p, v, __ATOMIC_RELAXED, __HIP_MEMORY_SCOPE_AGENT); }
__device__ __forceinline__ unsigned xb_xcc_id() { return (unsigned)__builtin_amdgcn_s_getreg((3 << 11) | 20) & 0xFu; }
#define XB_SPIN(cond, bar) do { unsigned _sp = 0; while (cond) { __builtin_amdgcn_s_sleep(1); \
    if ((++_sp & 255u) == 0u) { if (xb_ld(&(bar)[XB_TMO])) break; if (_sp > XB_SPIN_CAP) { atomicAdd(&(bar)[XB_TMO], 1u); break; } } } } while (0)

struct XcdBarrier {
    unsigned* bar; unsigned x; int t0;
    volatile LAS unsigned* st;
};

__device__ __forceinline__ bool xb_is_t0(int wave) { return wave == 0 && __builtin_amdgcn_mbcnt_hi(~0u, __builtin_amdgcn_mbcnt_lo(~0u, 0u)) == 0u; }
__device__ __forceinline__ XcdBarrier xcd_barrier_post(unsigned* bar, volatile LAS unsigned* st, int wave) {
    XcdBarrier b; b.bar = bar; b.x = xb_xcc_id(); b.st = st; b.t0 = wave;
    if (xb_is_t0(wave)) (void)xb_add(&bar[XB_XCNT(b.x)], 1u);
    return b;
}
__device__ __forceinline__ void xcd_barrier_complete(unsigned* bar, unsigned x, unsigned& nloc, unsigned& nx) {
    const unsigned G = gridDim.x * gridDim.y * gridDim.z;
    unsigned sum, cnt, mine, sp = 0u;
    for (;;) {
        sum = 0u; cnt = 0u; mine = 0u;
#pragma unroll
        for (unsigned j = 0; j < 16; ++j) { const unsigned c = xb_ld(&bar[XB_XCNT(j)]); sum += c; cnt += (c > 0u) ? 1u : 0u; mine = (j == x) ? c : mine; }
        if (sum == G) break;
        __builtin_amdgcn_s_sleep(1);
        if ((++sp & 255u) == 0u) { if (xb_ld(&bar[XB_TMO])) break; if (sp > XB_SPIN_CAP) { atomicAdd(&bar[XB_TMO], 1u); break; } }
    }
    nloc = mine > 0u ? mine : 1u; nx = cnt > 0u ? cnt : 1u;
}

__device__ __forceinline__ void xcd_barrier(const XcdBarrier& b) {
    asm volatile("s_waitcnt vmcnt(0)" ::: "memory");
    __syncthreads();
    if (xb_is_t0(b.t0)) {
        unsigned* bar = b.bar;
        __builtin_amdgcn_s_waitcnt(0);
        unsigned nloc = b.st[0], nx = b.st[1];
        if (nloc == 0u) { xcd_barrier_complete(bar, b.x, nloc, nx); b.st[0] = nloc; b.st[1] = nx; }
        const unsigned old = xb_add(&bar[XB_XSUB(b.x)], 1u);
        const unsigned gen = old / nloc;
        if (old + 1u == (gen + 1u) * nloc) {
            __builtin_amdgcn_fence(__ATOMIC_RELEASE, "agent");
            asm volatile("s_waitcnt vmcnt(0)" ::: "memory");
            const unsigned og = xb_add(&bar[XB_TOP], 1u);
            const unsigned tg = og / nx;
            if (og + 1u == (tg + 1u) * nx) xb_add(&bar[XB_TOPGEN], 1u);
            else XB_SPIN(xb_ld(&bar[XB_TOPGEN]) == tg, bar);
            __builtin_amdgcn_fence(__ATOMIC_ACQUIRE, "agent");
            xb_add(&bar[XB_XGEN(b.x)], 1u);
            asm volatile("s_waitcnt vmcnt(0)" ::: "memory");
        } else {
            XB_SPIN(xb_ld(&bar[XB_XGEN(b.x)]) == gen, bar);
            __builtin_amdgcn_fence(__ATOMIC_ACQUIRE, "agent");
            asm volatile("s_waitcnt vmcnt(0)" ::: "memory");
        }
    }
    __syncthreads();
}

struct Args {
    const float* in[25];
    float* out; unsigned char* ws;
    int ph_lo, ph_hi;
};

using pg8::Unit;
struct NoPre {};
struct EpiStore {
    static constexpr int NST = 16; static constexpr bool PERM = true, AFTER_DRAIN = false; typedef NoPre Pre;
    __device__ __forceinline__ void prefetch(Pre&, const Unit&, int, int, int, int) const {}
    __device__ __forceinline__ void preload(Pre&, const Unit&, int, int, int, int) const {}
    __device__ __forceinline__ void operator()(const f32x4 (&acc)[2][2][4][2], const Unit& u, int wr, int wc, int fr, int fq, const Pre&) const { (*this)(acc, u, wr, wc, fr, fq); }
    bf16* O; int ldc; const float* ssq; float scl;
    __device__ __forceinline__ void operator()(const f32x4 (&acc)[2][2][4][2], const Unit& u, int wr, int wc, int fr, int fq) const {
        const int row0 = u.pm * 256 + wr * 64 + fr, col0 = u.pn * 256 + wc * 32 + 8 * fq;
#pragma unroll
        for (int ai = 0; ai < 2; ++ai) { float sc[4];
#pragma unroll
            for (int m = 0; m < 4; ++m) sc[m] = (ssq ? rstd16(ssq, (size_t)(row0 + ai * 128 + m * 16)) : 1.f) * scl;
#pragma unroll
            for (int m = 0; m < 4; ++m) { const int row = row0 + ai * 128 + m * 16; bf16* rowp = O + (size_t)row * ldc + col0;
#pragma unroll
                for (int bj = 0; bj < 2; ++bj) { const f32x4 v0 = acc[ai][bj][m][0] * sc[m], v1 = acc[ai][bj][m][1] * sc[m];
                    v4u w; w.x = pk2(v0[0], v0[1]); w.y = pk2(v0[2], v0[3]); w.z = pk2(v1[0], v1[1]); w.w = pk2(v1[2], v1[3]);
                    __builtin_nontemporal_store(w, (v4u*)(rowp + bj * 128)); } } }
    }
};
struct EpiProj {
    static constexpr int NST = 16; static constexpr bool PERM = true, AFTER_DRAIN = false;
    unsigned char* pj; const float* lb;
    __device__ __forceinline__ void operator()(const f32x4 (&acc)[2][2][4][2], const Unit& u, int wr, int wc, int fr, int fq) const {
        const int row0 = u.pm * 256 + wr * 64 + fr, pn = u.pn;
        bf16* base[2]; unsigned rowmul, blmul;
        if (pn < 16) { const int T = pn >> 2; rowmul = 256u; blmul = 8u * 4096u * 256u;
#pragma unroll
            for (int bj = 0; bj < 2; ++bj) base[bj] = (bf16*)(pj + (size_t)T * (64u << 20) + (size_t)(2 * (pn & 3) + bj) * (4096u * 256u)) + wc * 32 + 8 * fq; }
        else if (pn < 20) { rowmul = 128u; blmul = 16u * 4096u * 128u;
#pragma unroll
            for (int bj = 0; bj < 2; ++bj) base[bj] = (bf16*)(pj + PJ_SQ + (size_t)(4 * (pn - 16) + 2 * bj + (wc >> 1)) * (4096u * 128u)) + (wc & 1) * 32 + 8 * fq; }
        else if (pn < 22) { rowmul = 128u; blmul = 4u * 4096u * 128u;
#pragma unroll
            for (int bj = 0; bj < 2; ++bj) base[bj] = (bf16*)(pj + (pn == 20 ? PJ_SK : PJ_SV) + (size_t)(2 * bj + (wc >> 1)) * (4096u * 128u)) + (wc & 1) * 32 + 8 * fq; }
        else { rowmul = 2048u; blmul = 4096u * 2048u;
#pragma unroll
            for (int bj = 0; bj < 2; ++bj) base[bj] = (bf16*)(pj + (pn < 26 ? PJ_GA : PJ_GB)) + ((pn - 22) & 3) * 256 + bj * 128 + wc * 32 + 8 * fq; }
        const int kind = pn < 16 ? (pn >> 2) : 2;
        f32x4 lbv[2][2];
        if (kind == 1) {
#pragma unroll
            for (int bj = 0; bj < 2; ++bj)
#pragma unroll
                for (int n = 0; n < 2; ++n) lbv[bj][n] = *(const f32x4*)(lb + (2 * (pn & 3) + bj) * 128 + wc * 32 + 8 * fq + 4 * n); }
#pragma unroll
        for (int ai = 0; ai < 2; ++ai)
#pragma unroll
            for (int m = 0; m < 4; ++m) { const int row = row0 + ai * 128 + m * 16; const size_t ro = (size_t)(row >> 12) * blmul + (size_t)(row & 4095) * rowmul;
#pragma unroll
                for (int bj = 0; bj < 2; ++bj) { f32x4 v[2] = {acc[ai][bj][m][0], acc[ai][bj][m][1]};
                    if (kind == 0 || kind == 3) {
#pragma unroll
                        for (int n = 0; n < 2; ++n)
#pragma unroll
                            for (int j = 0; j < 4; ++j) v[n][j] = v[n][j] * sigm(v[n][j]); }
                    else if (kind == 1) {
#pragma unroll
                        for (int n = 0; n < 2; ++n)
#pragma unroll
                            for (int j = 0; j < 4; ++j) v[n][j] = lbv[bj][n][j] + (1.f - lbv[bj][n][j]) * sigm(v[n][j]); }
                    v4u w; w.x = pk2(v[0][0], v[0][1]); w.y = pk2(v[0][2], v[0][3]); w.z = pk2(v[1][0], v[1][1]); w.w = pk2(v[1][2], v[1][3]);
                    *(v4u*)((unsigned char*)base[bj] + ro) = w; } }
    }
};
template <bool ADD> struct EpiGate {
    static constexpr int NST = 16; static constexpr bool PERM = true, AFTER_DRAIN = false;
    bf16* T; const bf16* gl; const float* bias;
    __device__ __forceinline__ void operator()(const f32x4 (&acc)[2][2][4][2], const Unit& u, int wr, int wc, int fr, int fq) const {
        const int row0 = u.pm * 256 + wr * 64 + fr, col0 = u.pn * 256 + wc * 32 + 8 * fq;
        f32x4 bv[2][2];
#pragma unroll
        for (int bj = 0; bj < 2; ++bj)
#pragma unroll
            for (int n = 0; n < 2; ++n) bv[bj][n] = *(const f32x4*)(bias + col0 + bj * 128 + 4 * n);
#pragma unroll
        for (int am = 0; am < 4; ++am) { const int ai = am >> 1, mh = am & 1; v4u gw[2][2], tw[2][2];
#pragma unroll
            for (int mm = 0; mm < 2; ++mm)
#pragma unroll
                for (int bj = 0; bj < 2; ++bj) { const int row = row0 + ai * 128 + (2 * mh + mm) * 16; gw[mm][bj] = *(const v4u*)(gl + (size_t)row * DM + col0 + bj * 128);
                    if (ADD) tw[mm][bj] = *(const v4u*)(T + (size_t)row * DM + col0 + bj * 128); }
#pragma unroll
            for (int mm = 0; mm < 2; ++mm)
#pragma unroll
                for (int bj = 0; bj < 2; ++bj) { const int m = 2 * mh + mm; const int row = row0 + ai * 128 + m * 16; const v4u g4 = gw[mm][bj]; float r[8];
                    r[0] = sigm(bflo(g4.x) + bv[bj][0][0]) * acc[ai][bj][m][0][0]; r[1] = sigm(bfhi(g4.x) + bv[bj][0][1]) * acc[ai][bj][m][0][1];
                    r[2] = sigm(bflo(g4.y) + bv[bj][0][2]) * acc[ai][bj][m][0][2]; r[3] = sigm(bfhi(g4.y) + bv[bj][0][3]) * acc[ai][bj][m][0][3];
                    r[4] = sigm(bflo(g4.z) + bv[bj][1][0]) * acc[ai][bj][m][1][0]; r[5] = sigm(bfhi(g4.z) + bv[bj][1][1]) * acc[ai][bj][m][1][1];
                    r[6] = sigm(bflo(g4.w) + bv[bj][1][2]) * acc[ai][bj][m][1][2]; r[7] = sigm(bfhi(g4.w) + bv[bj][1][3]) * acc[ai][bj][m][1][3];
                    if (ADD) { const v4u t4 = tw[mm][bj];
                        r[0] += bflo(t4.x); r[1] += bfhi(t4.x); r[2] += bflo(t4.y); r[3] += bfhi(t4.y); r[4] += bflo(t4.z); r[5] += bfhi(t4.z); r[6] += bflo(t4.w); r[7] += bfhi(t4.w); }
                    v4u w; w.x = pk2(r[0], r[1]); w.y = pk2(r[2], r[3]); w.z = pk2(r[4], r[5]); w.w = pk2(r[6], r[7]);
                    *(v4u*)(T + (size_t)row * DM + col0 + bj * 128) = w; } }
    }
};
template <bool BF> struct EpiResid {
    static constexpr int NST = 16; static constexpr bool PERM = true, AFTER_DRAIN = false; typedef NoPre Pre;
    __device__ __forceinline__ void prefetch(Pre&, const Unit&, int, int, int, int) const {}
    __device__ __forceinline__ void preload(Pre&, const Unit&, int, int, int, int) const {}
    __device__ __forceinline__ void operator()(const f32x4 (&acc)[2][2][4][2], const Unit& u, int wr, int wc, int fr, int fq, const Pre&) const { (*this)(acc, u, wr, wc, fr, fq); }
    const float* base; bf16* obf; float* ssq; unsigned char* f8; float scl;
    __device__ __forceinline__ void operator()(const f32x4 (&acc)[2][2][4][2], const Unit& u, int wr, int wc, int fr, int fq) const {
        const int row0 = u.pm * 256 + wr * 64 + fr, col0 = u.pn * 256 + wc * 32 + 8 * fq;
#pragma unroll
        for (int ai = 0; ai < 2; ++ai)
#pragma unroll
            for (int mh = 0; mh < 2; ++mh) { f32x4 b0[2][2], b1[2][2];
#pragma unroll
                for (int mm = 0; mm < 2; ++mm)
#pragma unroll
                    for (int bj = 0; bj < 2; ++bj) { const size_t off = (size_t)(row0 + ai * 128 + (2 * mh + mm) * 16) * DM + col0 + bj * 128;
                        if (BF) { const v4u bw = *(const v4u*)(obf + off); b0[mm][bj] = (f32x4){bflo(bw.x), bfhi(bw.x), bflo(bw.y), bfhi(bw.y)}; b1[mm][bj] = (f32x4){bflo(bw.z), bfhi(bw.z), bflo(bw.w), bfhi(bw.w)}; }
                        else { b0[mm][bj] = *(const f32x4*)(base + off); b1[mm][bj] = *(const f32x4*)(base + off + 4); } }
#pragma unroll
                for (int mm = 0; mm < 2; ++mm) { const int m = 2 * mh + mm; const int row = row0 + ai * 128 + m * 16; float ss = 0.f;
#pragma unroll
                    for (int bj = 0; bj < 2; ++bj) { const size_t off = (size_t)row * DM + col0 + bj * 128;
                        const f32x4 v0 = b0[mm][bj] + acc[ai][bj][m][0] * scl, v1 = b1[mm][bj] + acc[ai][bj][m][1] * scl;
                        v4u w; w.x = pk2(v0[0], v0[1]); w.y = pk2(v0[2], v0[3]); w.z = pk2(v1[0], v1[1]); w.w = pk2(v1[2], v1[3]);
                        *(v4u*)(obf + off) = w;
                        if (f8) { v2u q; q.x = pk4f8(v0[0], v0[1], v0[2], v0[3]); q.y = pk4f8(v1[0], v1[1], v1[2], v1[3]); *(v2u*)(f8 + off) = q; }
                        ss += ((v0[0] * v0[0] + v0[1] * v0[1]) + (v0[2] * v0[2] + v0[3] * v0[3])) + ((v1[0] * v1[0] + v1[1] * v1[1]) + (v1[2] * v1[2] + v1[3] * v1[3])); }
                    { const int ln_ = fr + 16 * fq; ss += shx(ss, 16, ln_); ss += shx(ss, 32, ln_); }
                    if (fq == 0) ssq[(size_t)row * 16 + (u.pn & 3) * 4 + wc] = ss; } }
    }
};
struct EpiSwiglu {
    static constexpr int NST = 8; static constexpr bool PERM = true, AFTER_DRAIN = false;
    unsigned char* act; const float* bgu; const float* row_rstd;
    struct Pre { float rs[2][4]; f32x4 bg[2], bl[2]; };
    __device__ __forceinline__ void prefetch(Pre& p, const Unit& u, int wr, int wc, int fr, int fq) const {
        const int e = u.pn >> 3, pnl = u.pn & 7, rr0 = wr * 64 + fr, cl0 = pnl * 128 + wc * 32 + 8 * fq;
#pragma unroll
        for (int ai = 0; ai < 2; ++ai)
#pragma unroll
            for (int m = 0; m < 4; ++m) p.rs[ai][m] = row_rstd[u.aux + rr0 + ai * 128 + m * 16];
        (void)e; (void)cl0;
    }
    __device__ __forceinline__ void preload(Pre& p, const Unit& u, int wr, int wc, int fr, int fq) const {
        const int e = u.pn >> 3, pnl = u.pn & 7, cl0 = pnl * 128 + wc * 32 + 8 * fq; (void)wr; (void)fr;
#pragma unroll
        for (int n = 0; n < 2; ++n) { p.bg[n] = *(const f32x4*)(bgu + e * 2048 + cl0 + 4 * n); p.bl[n] = *(const f32x4*)(bgu + e * 2048 + 1024 + cl0 + 4 * n); }
    }
    __device__ __forceinline__ void operator()(const f32x4 (&acc)[2][2][4][2], const Unit& u, int wr, int wc, int fr, int fq, const Pre& p) const {
        const int pnl = u.pn & 7;
        const int rr0 = wr * 64 + fr, cl0 = pnl * 128 + wc * 32 + 8 * fq;
        typedef float f32x2 __attribute__((ext_vector_type(2)));
        f32x4 bg[2], bl[2];
#pragma unroll
        for (int n = 0; n < 2; ++n) { bg[n] = p.bg[n]; bl[n] = p.bl[n] + 1.0f; }
#pragma unroll
        for (int ai = 0; ai < 2; ++ai)
#pragma unroll
            for (int m = 0; m < 4; ++m) { const int row = u.pm * 256 + rr0 + ai * 128 + m * 16; const float rs1 = p.rs[ai][m] * F8_WINV; const f32x2 rs = {rs1, rs1};
                float r[8];
#pragma unroll
                for (int n = 0; n < 2; ++n)
#pragma unroll
                    for (int jp = 0; jp < 2; ++jp) {
                        f32x2 gl = (f32x2){acc[ai][0][m][n][2 * jp], acc[ai][0][m][n][2 * jp + 1]} * rs + (f32x2){bg[n][2 * jp], bg[n][2 * jp + 1]};
                        f32x2 li = (f32x2){acc[ai][1][m][n][2 * jp], acc[ai][1][m][n][2 * jp + 1]} * rs + (f32x2){bl[n][2 * jp], bl[n][2 * jp + 1]};
                        gl = (f32x2){fminf(gl[0], 7.0f), fminf(gl[1], 7.0f)}; li = (f32x2){__builtin_amdgcn_fmed3f(li[0], -6.0f, 8.0f), __builtin_amdgcn_fmed3f(li[1], -6.0f, 8.0f)};
                        const f32x2 t = gl * (-1.702f * 1.4426950408889634f);
                        const f32x2 d = (f32x2){__builtin_amdgcn_exp2f(t[0]), __builtin_amdgcn_exp2f(t[1])} + 1.0f;
                        const f32x2 o = gl * (f32x2){__builtin_amdgcn_rcpf(d[0]), __builtin_amdgcn_rcpf(d[1])} * li;
                        r[n * 4 + 2 * jp] = o[0]; r[n * 4 + 2 * jp + 1] = o[1]; }
                v2u w; w.x = pk4f8(r[0], r[1], r[2], r[3]); w.y = pk4f8(r[4], r[5], r[6], r[7]);
                *(v2u*)(act + (size_t)row * DM + cl0) = w; }
    }
};
struct EpiDown {
    static constexpr int NST = 16; static constexpr bool PERM = true, AFTER_DRAIN = false;
    bf16* y; const float* bd; const float* row_gate;
    struct Pre { float gt[2][4]; f32x4 bv[2][2]; };
    __device__ __forceinline__ void prefetch(Pre& p, const Unit& u, int wr, int wc, int fr, int fq) const {
        const int e = u.pn >> 2, pnl = u.pn & 3, rr0 = wr * 64 + fr, col0 = pnl * 256 + wc * 32 + 8 * fq;
#pragma unroll
        for (int ai = 0; ai < 2; ++ai)
#pragma unroll
            for (int m = 0; m < 4; ++m) p.gt[ai][m] = row_gate[u.aux + rr0 + ai * 128 + m * 16];
        (void)e; (void)col0;
    }
    __device__ __forceinline__ void preload(Pre& p, const Unit& u, int wr, int wc, int fr, int fq) const {
        const int e = u.pn >> 2, pnl = u.pn & 3, col0 = pnl * 256 + wc * 32 + 8 * fq; (void)wr; (void)fr;
#pragma unroll
        for (int bj = 0; bj < 2; ++bj)
#pragma unroll
            for (int n = 0; n < 2; ++n) p.bv[bj][n] = *(const f32x4*)(bd + e * 1024 + col0 + bj * 128 + 4 * n);
    }
    __device__ __forceinline__ void operator()(const f32x4 (&acc)[2][2][4][2], const Unit& u, int wr, int wc, int fr, int fq, const Pre& p) const {
        const int pnl = u.pn & 3;
        const int rr0 = wr * 64 + fr, col0 = pnl * 256 + wc * 32 + 8 * fq;
        f32x4 bv[2][2];
#pragma unroll
        for (int bj = 0; bj < 2; ++bj)
#pragma unroll
            for (int n = 0; n < 2; ++n) bv[bj][n] = p.bv[bj][n];
#pragma unroll
        for (int ai = 0; ai < 2; ++ai)
#pragma unroll
            for (int m = 0; m < 4; ++m) { const int row = u.pm * 256 + rr0 + ai * 128 + m * 16;
#pragma unroll
                for (int bj = 0; bj < 2; ++bj) { const f32x4 v0 = (acc[ai][bj][m][0] * F8_WINV + bv[bj][0]) * p.gt[ai][m], v1 = (acc[ai][bj][m][1] * F8_WINV + bv[bj][1]) * p.gt[ai][m];
                    v4u w; w.x = pk2(v0[0], v0[1]); w.y = pk2(v0[2], v0[3]); w.z = pk2(v1[0], v1[1]); w.w = pk2(v1[2], v1[3]);
                    *(v4u*)(y + (size_t)row * DM + col0 + bj * 128) = w; } }
    }
};
struct GroupedOrder {
    int nunits, npn, G, c, half; const LAS unsigned* tab; const int* row_tok; int i0 = 0, i1 = 0x7fffffff;
    __device__ __forceinline__ bool next(int i, Unit& u) const {
        i += i0; if (i >= i1) return false;
        const int spx = G >> 3, xcd = c & 7, slot = c >> 3;
        const long L = ((long)i * 8 + xcd) * spx + slot; if (L >= nunits) return false;
        const int rb = (int)(L / npn), pn = (int)(L % npn);
        unsigned z_ = 0u; asm volatile("" : "+v"(z_)); const int l31 = (int)__builtin_amdgcn_mbcnt_hi(~0u, __builtin_amdgcn_mbcnt_lo(~0u, z_)) & 31;
        const unsigned st = tab[32 + l31], ct = tab[l31];
        const int e = __builtin_popcount((unsigned)__builtin_amdgcn_ballot_w64((unsigned)rb >= st)) - 1;
        const int j = rb - __builtin_amdgcn_readlane((int)st, e), cn = __builtin_amdgcn_readlane((int)ct, e) - 256 * j;
        u.pm = rb; u.pn = e * npn + pn; u.aux = (half * 32 + e) * HTOK + 256 * j; u.cnt = cn < 256 ? cn : 256; return true;
    }
    __device__ __forceinline__ void rows(const Unit& u, int RA0, unsigned (&rn)[2][2]) const {
#pragma unroll
        for (int h = 0; h < 2; ++h) { const int r0 = h * 128 + RA0, r1 = r0 + 64, cm = u.cnt - 1;
            rn[h][0] = (unsigned)row_tok[u.aux + (r0 < cm ? r0 : cm)]; rn[h][1] = (unsigned)row_tok[u.aux + (r1 < cm ? r1 : cm)]; }
    }
    __device__ __forceinline__ void a_ready(const Unit&) const {}
    __device__ __forceinline__ void done(const Unit&) const {}
};
constexpr int MOE_TAB_OFF = 131072 + 1024;
__device__ __forceinline__ void moe_tables(const unsigned char* ws, int hb, LAS unsigned char* lds, int tid, int off = MOE_TAB_OFF) {
    LAS unsigned* tab = (LAS unsigned*)(lds + off); const unsigned* gcnt = (const unsigned*)(ws + WS_GCNT);
    __syncthreads();
    if (tid < 32) tab[tid] = ld_agent(gcnt + (hb * 32 + tid) * 16);
    __syncthreads();
    if (tid < 32) { unsigned acc = 0, tot = 0;
        for (int e = 0; e < 32; ++e) { const unsigned nb = (tab[e] + 255u) >> 8; acc += e < tid ? nb : 0u; tot += nb; }
        tab[32 + tid] = acc; if (tid == 0) tab[64] = tot; }
    __syncthreads();
}

constexpr int RING_BYTES = 131072, MISC_OFF = RING_BYTES + 320, LDS_BYTES = 147456;

struct Ctx { LAS unsigned char* lds; int tid, lane, wave, G, gw, ngw; };

struct TItem { f32x4 v[8]; float gv[8]; };
__device__ __forceinline__ void titem_load(TItem& t, const float* W, int N, const float* gain, int k0, int n0, int lane) {
#pragma unroll
    for (int i = 0; i < 8; ++i) { const int kk = 8 * i + (lane >> 3); t.v[i] = *(const f32x4*)(W + (size_t)(k0 + kk) * N + n0 + (lane & 7) * 4); t.gv[i] = gain ? gain[k0 + kk] : 1.f; }
}
__device__ __forceinline__ void titem_to_lds(const TItem& t, LAS float* scr, int lane) {
#pragma unroll
    for (int i = 0; i < 8; ++i) { const int kk = 8 * i + (lane >> 3); LAS float* p = scr + kk * 33 + (lane & 7) * 4;
        p[0] = t.v[i][0] * t.gv[i]; p[1] = t.v[i][1] * t.gv[i]; p[2] = t.v[i][2] * t.gv[i]; p[3] = t.v[i][3] * t.gv[i]; }
    LDS_WAIT();
}
template <class RowMap>
__device__ __forceinline__ void titem_out(int K, bf16* WT, const LAS float* scr, int k0, int n0, int lane, RowMap rm) {
    const int c = lane & 7;
#pragma unroll
    for (int j = 0; j < 4; ++j) { const int n = (lane >> 3) + 8 * j; const LAS float* s = scr + (8 * c) * 33 + n;
        v4u o; o.x = pk2(s[0 * 33], s[1 * 33]); o.y = pk2(s[2 * 33], s[3 * 33]); o.z = pk2(s[4 * 33], s[5 * 33]); o.w = pk2(s[6 * 33], s[7 * 33]);
        *(v4u*)(WT + (size_t)rm(n0 + n) * K + k0 + 8 * c) = o; }
    LDS_WAIT();
}
template <class RowMap>
__device__ __forceinline__ void titem_out8(int K, unsigned char* WT, const LAS float* scr, int k0, int n0, int lane, RowMap rm) {
    const int c = lane & 7;
#pragma unroll
    for (int j = 0; j < 4; ++j) { const int n = (lane >> 3) + 8 * j; const LAS float* s = scr + (8 * c) * 33 + n;
        v2u o; o.x = pk4f8(s[0 * 33] * F8_WSCALE, s[1 * 33] * F8_WSCALE, s[2 * 33] * F8_WSCALE, s[3 * 33] * F8_WSCALE); o.y = pk4f8(s[4 * 33] * F8_WSCALE, s[5 * 33] * F8_WSCALE, s[6 * 33] * F8_WSCALE, s[7 * 33] * F8_WSCALE);
        *(v2u*)(WT + (size_t)rm(n0 + n) * K + k0 + 8 * c) = o; }
    LDS_WAIT();
}
template <class RowMap>
__device__ __forceinline__ void transpose_item(const float* W, int K, int N, bf16* WT, const float* gain, LAS float* scr, int item, int lane, RowMap rm) {
    const int nblk = N / 32, kb = item / nblk, nb = item % nblk, k0 = 64 * kb, n0 = 32 * nb;
    TItem t; titem_load(t, W, N, gain, k0, n0, lane); titem_to_lds(t, scr, lane); titem_out(K, WT, scr, k0, n0, lane, rm);
}
template <class RowMap>
__device__ __forceinline__ void transpose_item8(const float* W, int K, int N, unsigned char* WT, const float* gain, LAS float* scr, int item, int lane, RowMap rm) {
    const int nblk = N / 32, kb = item / nblk, nb = item % nblk, k0 = 64 * kb, n0 = 32 * nb;
    TItem t; titem_load(t, W, N, gain, k0, n0, lane); titem_to_lds(t, scr, lane); titem_out8(K, WT, scr, k0, n0, lane, rm);
}
struct RowId { int off; __device__ __forceinline__ int operator()(int n) const { return off + n; } };
struct RowGU { int e; __device__ __forceinline__ int operator()(int n) const { const int j = n & 1023; return e * 2048 + (j >> 7) * 256 + (n >> 10) * 128 + (j & 127); } };

__device__ __forceinline__ void rms_row_to_bf16(const float* xrow, const float* gain, bf16* orow, int lane) {
    const f32x4* xr = (const f32x4*)xrow + lane; const f32x4* gr = (const f32x4*)gain + lane;
    f32x4 v[4]; float s = 0.f;
#pragma unroll
    for (int j = 0; j < 4; ++j) { v[j] = xr[64 * j]; s += (v[j][0] * v[j][0] + v[j][1] * v[j][1]) + (v[j][2] * v[j][2] + v[j][3] * v[j][3]); }
    const float rstd = rsqrtf(wave_sum(s, lane) * (1.f / DM) + RMS_EPS);
    unsigned long long* o8 = (unsigned long long*)orow + lane;
#pragma unroll
    for (int j = 0; j < 4; ++j) { const f32x4 g = gr[64 * j]; const f32x4 w = v[j] * rstd * g;
        o8[64 * j] = (unsigned long long)pk2(w[0], w[1]) | ((unsigned long long)pk2(w[2], w[3]) << 32); }
}

__device__ __forceinline__ void phase_prologue(const Args& a, const Ctx& c) {
    LAS float* scr = (LAS float*)(c.lds + c.wave * 16384);
    unsigned char* ws = a.ws;
    constexpr int I_IN = 16 * (NCOL / 32), I_SQ = 16 * 32, I_R = 16;
    constexpr int NIT = I_IN + 7 * I_SQ + I_R;
    for (int it = c.gw; it < NIT; it += c.ngw) {
        int r = it;
        if (r < I_IN) { transpose_item(a.in[5], DM, NCOL, (bf16*)(ws + WS_WIN), nullptr, scr, r, c.lane, RowId{0}); continue; } r -= I_IN;
        if (r < I_SQ) { transpose_item(a.in[9], DM, DM, (bf16*)(ws + WS_WA), nullptr, scr, r, c.lane, RowId{0}); continue; } r -= I_SQ;
        if (r < I_SQ) { transpose_item(a.in[10], DM, DM, (bf16*)(ws + WS_WB), nullptr, scr, r, c.lane, RowId{0}); continue; } r -= I_SQ;
        if (r < I_SQ) { transpose_item(a.in[11], DM, DM, (bf16*)(ws + WS_WMIX), nullptr, scr, r, c.lane, RowId{0}); continue; } r -= I_SQ;
        if (r < I_SQ) { transpose_item8(a.in[13], DM, DM, ws + WS_WQ, a.in[12], scr, r, c.lane, RowId{0}); continue; } r -= I_SQ;
        if (r < I_SQ) { transpose_item(a.in[14], DM, DM, (bf16*)(ws + WS_WK), nullptr, scr, r, c.lane, RowId{0}); continue; } r -= I_SQ;
        if (r < I_SQ) { transpose_item(a.in[15], DM, DM, (bf16*)(ws + WS_WV), nullptr, scr, r, c.lane, RowId{0}); continue; } r -= I_SQ;
        if (r < I_SQ) { transpose_item8(a.in[16], DM, DM, ws + WS_WO, nullptr, scr, r, c.lane, RowId{0}); continue; } r -= I_SQ;
        transpose_item(a.in[18], DM, NEXP, (bf16*)(ws + WS_WR), a.in[17], scr, r, c.lane, RowId{0});
    }
    { const size_t n8 = (size_t)NBATCH * MEMLEN * DM / 8; const float* mem = a.in[1]; bf16* mb = (bf16*)(ws + WS_MEMBF);
      for (size_t i = (size_t)c.gw * 64 + c.lane; i < n8; i += (size_t)c.ngw * 64) { const f32x4 v0 = *(const f32x4*)(mem + i * 8), v1 = *(const f32x4*)(mem + i * 8 + 4);
          v4u w; w.x = pk2(v0[0], v0[1]); w.y = pk2(v0[2], v0[3]); w.z = pk2(v1[0], v1[1]); w.w = pk2(v1[2], v1[3]); *(v4u*)(mb + i * 8) = w; } }
    if (c.gw == 0) {
        float* lb = (float*)(ws + WS_LB); const float* lbl = a.in[3];
        for (int k = c.lane; k < 1024; k += 64) lb[k] = 1.f / (1.f + expf(lbl[1024 + k] - lbl[k]));
    }
    if (c.gw == 1) {
        float* lut = (float*)(ws + WS_LUT); const float* t5 = a.in[2];
        for (int i = c.lane; i < 16 * 128; i += 64) { const int h = i >> 7, d = i & 127; int b = d;
            if (d >= 16) { b = 16 + (int)(logf((float)d * (1.f / 16.f)) / logf(8.f) * 16.f); b = b < 31 ? b : 31; }
            lut[i] = t5[b * 16 + h]; }
    }
}

__device__ __forceinline__ void phase_norm1(const Args& a, const Ctx& c, int hb) {
    const float* x = a.in[0] + (size_t)hb * HTOK * DM; bf16* xn = (bf16*)(a.ws + (hb ? WS_OA : WS_TM));
    f32x4 g[4];
#pragma unroll
    for (int j = 0; j < 4; ++j) g[j] = ((const f32x4*)a.in[4])[c.lane + 64 * j];
#pragma nounroll
    for (int m = c.gw; m < HTOK; m += 4 * c.ngw) { f32x4 v[4][4];
#pragma unroll
        for (int b = 0; b < 4; ++b) { const int mm = (m + b * c.ngw < HTOK) ? m + b * c.ngw : m; const f32x4* xr = (const f32x4*)(x + (size_t)mm * DM) + c.lane;
#pragma unroll
            for (int j = 0; j < 4; ++j) v[b][j] = xr[64 * j]; }
#pragma unroll
        for (int b = 0; b < 4; ++b) { float s = 0.f;
#pragma unroll
            for (int j = 0; j < 4; ++j) s += (v[b][j][0] * v[b][j][0] + v[b][j][1] * v[b][j][1]) + (v[b][j][2] * v[b][j][2] + v[b][j][3] * v[b][j][3]);
            const float rstd = rsqrtf(wave_sum(s, c.lane) * (1.f / DM) + RMS_EPS);
            if (m + b * c.ngw < HTOK) { unsigned long long* o8 = (unsigned long long*)(xn + (size_t)(m + b * c.ngw) * DM) + c.lane;
#pragma unroll
                for (int j = 0; j < 4; ++j) { const f32x4 w = v[b][j] * rstd * g[j]; o8[64 * j] = (unsigned long long)pk2(w[0], w[1]) | ((unsigned long long)pk2(w[2], w[3]) << 32); } } }
    }
}

constexpr int SWA_VB = 32 * 144;
constexpr int SWA_LUT_OFF = 8 * 2 * SWA_VB;
__device__ __forceinline__ void swa_unit(const bf16* proj, bf16* ob, int bl, int kvh, int tt, const LAS float* lut, LAS unsigned char* vbuf, const float* sinks, int lane) {
    const int l15 = lane & 15, g = lane >> 4, q4 = l15 >> 2, p4 = lane & 3;
    const int t0 = tt * 16; const size_t rowb = (size_t)bl * SEQ;
    const bf16* sq = (const bf16*)((const unsigned char*)proj + PJ_SQ) + (size_t)(bl * 16 + kvh * 4) * SEQ * 64;
    const bf16* sk = (const bf16*)((const unsigned char*)proj + PJ_SK) + (size_t)(bl * 4 + kvh) * SEQ * 64;
    const bf16* sv = (const bf16*)((const unsigned char*)proj + PJ_SV) + (size_t)(bl * 4 + kvh) * SEQ * 64;
    bf16x8 qf[4][2];
#pragma unroll
    for (int gq = 0; gq < 4; ++gq)
#pragma unroll
        for (int ks = 0; ks < 2; ++ks) qf[gq][ks] = *(const bf16x8*)(sq + ((size_t)gq * SEQ + t0 + l15) * 64 + ks * 32 + 8 * g);
    float mx[4], ls[4]; f32x4 o[4][4];
#pragma unroll
    for (int gq = 0; gq < 4; ++gq) { mx[gq] = sinks[kvh * 4 + gq]; ls[gq] = 1.f;
#pragma unroll
        for (int dt = 0; dt < 4; ++dt) o[gq][dt] = (f32x4){0.f, 0.f, 0.f, 0.f}; }
    for (int c = 0; c < 5; ++c) {
        const int kc = t0 - 144 + 32 * c;
        if (kc + 31 < 0) continue;
        LAS unsigned char* vb = vbuf + (c & 1) * SWA_VB;
#pragma unroll
        for (int i = 0; i < 4; ++i) { const int p = lane + 64 * i, key = p >> 3, d8 = p & 7; int kr = kc + key; kr = kr < 0 ? 0 : kr;
            const v4u vv = *(const v4u*)(sv + (size_t)kr * 64 + d8 * 8);
            *(LAS v4u*)(vb + key * 144 + d8 * 16) = vv; }
        f32x4 s[4][2];
#pragma unroll
        for (int ksub = 0; ksub < 2; ++ksub) { int kr = kc + 16 * ksub + l15; kr = kr < 0 ? 0 : kr;
            const bf16* kp = sk + (size_t)kr * 64 + 8 * g;
            const bf16x8 k0 = *(const bf16x8*)kp, k1 = *(const bf16x8*)(kp + 32);
#pragma unroll
            for (int gq = 0; gq < 4; ++gq) { f32x4 z = (f32x4){0.f, 0.f, 0.f, 0.f}; z = mfma16(k0, qf[gq][0], z); s[gq][ksub] = mfma16(k1, qf[gq][1], z); } }
        bf16x8 pf[4];
#pragma unroll
        for (int gq = 0; gq < 4; ++gq) { const int hq = kvh * 4 + gq; float cm = -1e30f;
#pragma unroll
            for (int ksub = 0; ksub < 2; ++ksub)
#pragma unroll
                for (int r = 0; r < 4; ++r) { const int key = kc + 16 * ksub + 4 * g + r, dist = t0 + l15 - key; const bool ok = (dist >= 0) && (dist < 128) && (key >= 0);
                    const int di = dist < 0 ? 0 : (dist > 127 ? 127 : dist);
                    float v = s[gq][ksub][r] * 0.125f + lut[hq * 128 + di]; v = ok ? v : -1e30f; s[gq][ksub][r] = v; cm = fmaxf(cm, v); }
            cm = fmaxf(cm, shx(cm, 16, lane)); cm = fmaxf(cm, shx(cm, 32, lane));
            const float mn = fmaxf(mx[gq], cm), alpha = fexp(mx[gq] - mn); mx[gq] = mn; float rs = 0.f;
#pragma unroll
            for (int ksub = 0; ksub < 2; ++ksub)
#pragma unroll
                for (int r = 0; r < 4; ++r) { const float p = fexp(s[gq][ksub][r] - mn); s[gq][ksub][r] = p; rs += p; }
            rs += shx(rs, 16, lane); rs += shx(rs, 32, lane);
            ls[gq] = ls[gq] * alpha + rs;
#pragma unroll
            for (int dt = 0; dt < 4; ++dt) o[gq][dt] = o[gq][dt] * alpha;
            pf[gq] = pack8(s[gq][0], s[gq][1]); }
        CFENCE();
#pragma unroll
        for (int dt = 0; dt < 4; ++dt) {
            const s16x4 lo = vtr(vb + (4 * g + q4) * 144 + (16 * dt + 4 * p4) * 2), hi = vtr(vb + (16 + 4 * g + q4) * 144 + (16 * dt + 4 * p4) * 2);
            const bf16x8 vf = cat8(lo, hi);
#pragma unroll
            for (int gq = 0; gq < 4; ++gq) o[gq][dt] = mfma16(vf, pf[gq], o[gq][dt]); }
        CFENCE();
    }
#pragma unroll
    for (int gq = 0; gq < 4; ++gq) { const float inv = __builtin_amdgcn_rcpf(ls[gq]);
#pragma unroll
        for (int dt = 0; dt < 4; ++dt) { const f32x4 v = o[gq][dt] * inv; v2u w; w.x = pk2(v[0], v[1]); w.y = pk2(v[2], v[3]);
            *(v2u*)(ob + (rowb + t0 + l15) * DM + (kvh * 4 + gq) * 64 + 16 * dt + 4 * g) = w; } }
}
constexpr int HGB_WAVES = 4;
template <int NW> __device__ __forceinline__ void hgB_work(const Args& a, const Ctx& c);
template <int HW  > __device__ __forceinline__ void phase_swa_hgB(const Args& a, const Ctx& c) {
    const bf16* proj = (const bf16*)(a.ws + WS_PROJ); bf16* ob = (bf16*)(a.ws + WS_OB);
    LAS float* lut = (LAS float*)(c.lds + SWA_LUT_OFF); const float* glut = (const float*)(a.ws + WS_LUT);
    for (int i = c.tid; i < 16 * 128; i += 512) lut[i] = glut[i];
    __syncthreads();
    if (c.wave < HW) hgB_work<HW>(a, c);
    else {
        LAS unsigned char* vbuf = c.lds + c.wave * 2 * SWA_VB;
        constexpr int NU = 8 * 4 * 256;
        const int nsw = c.G * (8 - HW), sw = (int)blockIdx.x * (8 - HW) + (c.wave - HW);
        for (int u = sw; u < NU; u += nsw) { const int tt = u & 255, kvh = (u >> 8) & 3, bl = u >> 10; swa_unit(proj, ob, bl, kvh, tt, lut, vbuf, a.in[8], c.lane); }
    }
    __syncthreads();
}

constexpr int HG_LF = 0, HG_KP = 33792, HG_VT = 51200, HG_GT = 68608, HG_QP = 70656, HG_SSQ = 88064;
__device__ __forceinline__ void hg_scan(LAS unsigned char* lds, int tid, float (&loc)[16], float& pre, float& Gm, float& Gl) {
    const int ch = tid & 127, grp = tid >> 7;
    const LAS float* LF = (const LAS float*)(lds + HG_LF); LAS float* GT = (LAS float*)(lds + HG_GT);
    float run = 0.f;
#pragma unroll
    for (int i = 0; i < 16; ++i) { run += LF[(16 * grp + i) * 132 + ch]; loc[i] = run; }
    GT[grp * 128 + ch] = run;
    __syncthreads();
    const float g0 = GT[ch], g1 = GT[128 + ch], g2 = GT[256 + ch], g3 = GT[384 + ch];
    pre = (grp > 0 ? g0 : 0.f) + (grp > 1 ? g1 : 0.f) + (grp > 2 ? g2 : 0.f);
    Gm = g0 + g1; Gl = Gm + g2 + g3;
}
constexpr size_t OUT_KP = 0, OUT_QP = 64 * MiB;
constexpr int HCH = 128, HNCH = SEQ / HCH, HNU = 8 * 8 * HNCH;
constexpr int HS_FT = 0, HS_QT = 34816, HS_VT = 69632, HS_GT = 104448, HS_SSQ = 106496;
__device__ __forceinline__ void phase_hgA(const Args& a, const Ctx& c) {
    const bf16* proj = (const bf16*)(a.ws + WS_PROJ); bf16* US = (bf16*)((unsigned char*)a.out + OUT_US); float* D12 = (float*)(a.ws + WS_D12);
    bf16* KPg = (bf16*)((unsigned char*)a.out + OUT_KP); bf16* QPg = (bf16*)((unsigned char*)a.out + OUT_QP);
    LAS unsigned char* lds = c.lds; const int tid = c.tid, lane = c.lane, w = c.wave;
    const int l15 = lane & 15, g = lane >> 4, q4 = l15 >> 2, p4 = lane & 3, ch = tid & 127, grp = tid >> 7;
    int u = blockIdx.x; if (u >= HNU) return;
    v4u rq[4], rf[4], rv[4];
#define HGA_LOAD(uu) do { const size_t uo = (size_t)(uu) * (HCH * 128);      \
        _Pragma("unroll") for (int i = 0; i < 4; ++i) { const size_t po = uo + (size_t)(tid + 512 * i) * 8; \
            rq[i] = *(const v4u*)((const bf16*)((const unsigned char*)proj + PJ_HQ) + po); rf[i] = *(const v4u*)((const bf16*)((const unsigned char*)proj + PJ_HF) + po); rv[i] = *(const v4u*)((const bf16*)((const unsigned char*)proj + PJ_HI) + po); } } while (0)
    HGA_LOAD(u);
    for (;;) {
#pragma unroll
        for (int i = 0; i < 4; ++i) { const int p = tid + 512 * i, tok = p >> 4, c8 = p & 15; LAS unsigned char* sb = lds + tok * 272 + c8 * 16;
            *(LAS v4u*)(sb + HS_FT) = rf[i]; *(LAS v4u*)(sb + HS_QT) = rq[i]; *(LAS v4u*)(sb + HS_VT) = rv[i]; }
        const int ucur = u; const int un = u + gridDim.x; const bool has_next = un < HNU;
        LDS_WAIT();
        if (has_next) HGA_LOAD(un);
        __syncthreads();
        float loc[32], kt[32];
        { const LAS bf16* FT = (const LAS bf16*)(lds + HS_FT); float run = 0.f;
#pragma unroll
          for (int i = 0; i < 32; ++i) { const float f = __builtin_bit_cast(float, (unsigned)FT[(32 * grp + i) * 136 + ch] << 16); kt[i] = 1.f - f; run += flog(f); loc[i] = run; }
          ((LAS float*)(lds + HS_GT))[grp * 128 + ch] = run; }
        __syncthreads();
        { const LAS float* GT = (const LAS float*)(lds + HS_GT);
          const float g0 = GT[ch], g1 = GT[128 + ch], g2 = GT[256 + ch], g3 = GT[384 + ch];
          const float pre = (grp > 0 ? g0 : 0.f) + (grp > 1 ? g1 : 0.f) + (grp > 2 ? g2 : 0.f), Gm = g0 + g1, Gl = Gm + g2 + g3;
          LAS bf16* KP = (LAS bf16*)(lds + HS_FT); LAS bf16* QP = (LAS bf16*)(lds + HS_QT);
#pragma unroll
          for (int hf = 0; hf < 2; ++hf) { float qr[16];
#pragma unroll
              for (int i = 0; i < 16; ++i) qr[i] = __builtin_bit_cast(float, (unsigned)QP[(32 * grp + 16 * hf + i) * 136 + ch] << 16);
#pragma unroll
              for (int i = 0; i < 16; ++i) { const int ii = 16 * hf + i; const float G = pre + loc[ii];
                  const float ed = fexp(fminf(Gm - G, 80.f));
                  KP[(32 * grp + ii) * 136 + ch] = (bf16)pk2(kt[ii] * ed, 0.f);
                  QP[(32 * grp + ii) * 136 + ch] = (bf16)pk2(qr[i] * __builtin_amdgcn_rcpf(ed), 0.f); } }
          if (grp == 0) { D12[(size_t)ucur * 256 + ch] = fexp(Gm); D12[(size_t)ucur * 256 + 128 + ch] = fexp(Gl - Gm); } }
        __syncthreads();
#pragma unroll
        for (int i = 0; i < 4; ++i) { const int p = tid + 512 * i, tok = p >> 4, c8 = p & 15; const size_t go = (size_t)ucur * (HCH * 128) + (size_t)p * 8;
            *(v4u*)(KPg + go) = *(const LAS v4u*)(lds + HS_FT + tok * 272 + c8 * 16); *(v4u*)(QPg + go) = *(const LAS v4u*)(lds + HS_QT + tok * 272 + c8 * 16); }
        { bf16x8 af[4];
#pragma unroll
          for (int ks = 0; ks < 4; ++ks) { const LAS unsigned char* bp = lds + HS_FT + (32 * ks + 8 * g + q4) * 272 + (16 * w + 4 * p4) * 2; af[ks] = cat8(vtr(bp), vtr(bp + 4 * 272)); }
#pragma unroll
          for (int vt = 0; vt < 8; ++vt) { f32x4 acc = (f32x4){0.f, 0.f, 0.f, 0.f};
#pragma unroll
              for (int ks = 0; ks < 4; ++ks) { const LAS unsigned char* bp = lds + HS_VT + (32 * ks + 8 * g + q4) * 272 + (16 * vt + 4 * p4) * 2; acc = mfma16(af[ks], cat8(vtr(bp), vtr(bp + 4 * 272)), acc); }
              v2u wv; wv.x = pk2(acc[0], acc[1]); wv.y = pk2(acc[2], acc[3]);
              *(v2u*)(US + ((size_t)ucur * 128 + 16 * vt + l15) * 128 + 16 * w + 4 * g) = wv; } }
        __syncthreads();
        if (!has_next) break;
        u = un;
    }
#undef HGA_LOAD
}
template <int NW> __device__ __forceinline__ void hgB_work(const Args& a, const Ctx& c) {
    bf16* US = (bf16*)((unsigned char*)a.out + OUT_US); const float* D12 = (const float*)(a.ws + WS_D12);
    const int nthr = c.G * NW * 64, gt = ((int)blockIdx.x * NW + c.wave) * 64 + c.lane;
    for (int e = gt; e < 64 * 2048; e += nthr) {
        const int bh = e >> 11, r = e & 2047, k8 = r & 15;
        float S[8];
#pragma unroll
        for (int j = 0; j < 8; ++j) S[j] = 0.f;
        for (int c0 = 0; c0 < HNCH; c0 += 8) {
            v4u uw[8];
#pragma unroll
            for (int cc = 0; cc < 8; ++cc) uw[cc] = *(const v4u*)(US + ((size_t)bh * HNCH + c0 + cc) * 16384 + (size_t)r * 8);
#pragma unroll
            for (int cc = 0; cc < 8; ++cc) { const size_t un = (size_t)bh * HNCH + c0 + cc;
                const f32x4 d1a = *(const f32x4*)(D12 + un * 256 + k8 * 8), d1b = *(const f32x4*)(D12 + un * 256 + k8 * 8 + 4);
                const f32x4 d2a = *(const f32x4*)(D12 + un * 256 + 128 + k8 * 8), d2b = *(const f32x4*)(D12 + un * 256 + 128 + k8 * 8 + 4);
                const unsigned ww[4] = {uw[cc].x, uw[cc].y, uw[cc].z, uw[cc].w}; float sp[8];
#pragma unroll
                for (int j = 0; j < 8; ++j) { const float d1v = j < 4 ? d1a[j & 3] : d1b[j & 3], d2v = j < 4 ? d2a[j & 3] : d2b[j & 3]; const float uv = (j & 1) ? bfhi(ww[j >> 1]) : bflo(ww[j >> 1]);
                    sp[j] = d1v * S[j]; S[j] = d2v * (sp[j] + uv); }
                v4u o; o.x = pk2(sp[0], sp[1]); o.y = pk2(sp[2], sp[3]); o.z = pk2(sp[4], sp[5]); o.w = pk2(sp[6], sp[7]);
                *(v4u*)(US + un * 16384 + (size_t)r * 8) = o; }
        }
    }
}
__device__ __forceinline__ void phase_hgC(const Args& a, const Ctx& c) {
    const bf16* proj = (const bf16*)(a.ws + WS_PROJ); const bf16* US = (const bf16*)((unsigned char*)a.out + OUT_US); bf16* oa = (bf16*)(a.ws + WS_OA);
    const bf16* KPg = (const bf16*)((unsigned char*)a.out + OUT_KP); const bf16* QPg = (const bf16*)((unsigned char*)a.out + OUT_QP);
    const float* hgain = a.in[7];
    LAS unsigned char* lds = c.lds; const int tid = c.tid, lane = c.lane, w = c.wave;
    const int l15 = lane & 15, g = lane >> 4, q4 = l15 >> 2, p4 = lane & 3;
    int u = blockIdx.x; if (u >= HNU) return;
    v4u rk[4], rq[4], rv[4];
#define HGC_LOAD(uu) do { const size_t uo = (size_t)(uu) * (HCH * 128); \
        _Pragma("unroll") for (int i = 0; i < 4; ++i) { const size_t po = uo + (size_t)(tid + 512 * i) * 8; \
            rk[i] = *(const v4u*)(KPg + po); rq[i] = *(const v4u*)(QPg + po); rv[i] = *(const v4u*)((const bf16*)((const unsigned char*)proj + PJ_HI) + po); } } while (0)
    HGC_LOAD(u);
    const f32x4 gn = *(const f32x4*)(hgain + 16 * w + 4 * g);
    for (;;) {
#pragma unroll
        for (int i = 0; i < 4; ++i) { const int p = tid + 512 * i, tok = p >> 4, c8 = p & 15; LAS unsigned char* sb = lds + tok * 272 + c8 * 16;
            *(LAS v4u*)(sb + HS_FT) = rk[i]; *(LAS v4u*)(sb + HS_QT) = rq[i]; *(LAS v4u*)(sb + HS_VT) = rv[i]; }
        const int ucur = u; const int un = u + gridDim.x; const bool has_next = un < HNU;
        const int cc = ucur % HNCH, h = (ucur / HNCH) & 7, bl = ucur / (HNCH * 8); const size_t row0 = (size_t)bl * SEQ + cc * HCH;
        bf16x8 sf[4]; v2u gwv[8];
#pragma unroll
        for (int ks = 0; ks < 4; ++ks) sf[ks] = *(const bf16x8*)(US + ((size_t)ucur * 128 + 16 * w + l15) * 128 + 32 * ks + 8 * g);
        LDS_WAIT();
        if (has_next) HGC_LOAD(un);
        __syncthreads();
        f32x4 o[8];
        {
            bf16x8 vf[4];
#pragma unroll
            for (int kk = 0; kk < 4; ++kk) { const LAS unsigned char* bp = lds + HS_VT + (32 * kk + 4 * g + q4) * 272 + (16 * w + 4 * p4) * 2; vf[kk] = cat8(vtr(bp), vtr(bp + 16 * 272)); }
#pragma unroll
            for (int tt = 0; tt < 8; ++tt) {
                bf16x8 qf[4];
#pragma unroll
                for (int ks = 0; ks < 4; ++ks) qf[ks] = *(const LAS bf16x8*)(lds + HS_QT + (16 * tt + l15) * 272 + (32 * ks + 8 * g) * 2);
                f32x4 acc = (f32x4){0.f, 0.f, 0.f, 0.f};
#pragma unroll
                for (int ks = 0; ks < 4; ++ks) acc = mfma16(sf[ks], qf[ks], acc);
#pragma unroll
                for (int kk = 0; kk < 4; ++kk) {
                    if (2 * kk <= tt) { f32x4 at[2];
#pragma unroll
                        for (int e = 0; e < 2; ++e) { const int st = 2 * kk + e; at[e] = (f32x4){0.f, 0.f, 0.f, 0.f};
                            if (st <= tt) {
#pragma unroll
                                for (int ks = 0; ks < 4; ++ks) { const bf16x8 kf = *(const LAS bf16x8*)(lds + HS_FT + (16 * st + l15) * 272 + (32 * ks + 8 * g) * 2); at[e] = mfma16(kf, qf[ks], at[e]); }
                                if (st == tt) {
#pragma unroll
                                    for (int r = 0; r < 4; ++r) at[e][r] = (4 * g + r <= l15) ? at[e][r] : 0.f; } } }
                        acc = mfma16(vf[kk], pack8(at[0], at[1]), acc); } }
                o[tt] = acc; CFENCE(); }
        }
#pragma unroll
        for (int tt = 0; tt < 8; ++tt) gwv[tt] = *(const v2u*)((const bf16*)((const unsigned char*)proj + PJ_HG) + (size_t)ucur * (HCH * 128) + (16 * tt + l15) * 128 + 16 * w + 4 * g);
        { LAS float* SSQ = (LAS float*)(lds + HS_SSQ);
#pragma unroll
          for (int tt = 0; tt < 8; ++tt) { float q = (o[tt][0] * o[tt][0] + o[tt][1] * o[tt][1]) + (o[tt][2] * o[tt][2] + o[tt][3] * o[tt][3]);
              q += shx(q, 16, lane); q += shx(q, 32, lane); if (g == 0) SSQ[w * 128 + 16 * tt + l15] = q; } }
        __syncthreads();
        { const LAS float* SSQ = (const LAS float*)(lds + HS_SSQ);
#pragma unroll
          for (int tt = 0; tt < 8; ++tt) { float q = 0.f;
#pragma unroll
              for (int ww = 0; ww < 8; ++ww) q += SSQ[ww * 128 + 16 * tt + l15];
              const float rstd = rsqrtf(q * (1.f / 128.f) + RMS_EPS);
              const size_t row = row0 + 16 * tt + l15;
              const v2u gw = gwv[tt];
              const float g0 = bflo(gw.x), g1 = bfhi(gw.x), g2 = bflo(gw.y), g3 = bfhi(gw.y);
              const float r0 = o[tt][0] * rstd * gn[0] * g0, r1 = o[tt][1] * rstd * gn[1] * g1;
              const float r2 = o[tt][2] * rstd * gn[2] * g2, r3 = o[tt][3] * rstd * gn[3] * g3;
              v2u wv; wv.x = pk2(r0, r1); wv.y = pk2(r2, r3);
              *(v2u*)(oa + row * DM + h * 128 + 16 * w + 4 * g) = wv; } }
        __syncthreads();
        if (!has_next) break;
        u = un;
    }
#undef HGC_LOAD
}

typedef float f32x16 __attribute__((ext_vector_type(16)));
constexpr int XA_KROW = 528, XA_VROW = 72, XA_KB = 32 * XA_KROW, XA_VB = 256 * XA_VROW, XA_STAGE = XA_KB + XA_VB;
__device__ __forceinline__ void phase_xa(const Args& a, const Ctx& c) {
    const bf16* qg = (const bf16*)(a.ws + WS_Q); unsigned char* og = a.ws + WS_O;     const bf16* kx = (const bf16*)(a.ws + WS_KX); const bf16* vxt = (const bf16*)(a.ws + WS_VXT);
    LAS unsigned char* lds = c.lds; const int tid = c.tid, lane = c.lane, w = c.wave;
    const int l31 = lane & 31, hh = lane >> 5, qt = w & 3, dh = w >> 2;
    constexpr int NU = NBATCH * 4 * (SEQ / 128);
    int u = blockIdx.x; if (u >= NU) return;
    v4u rk[2], rv[2];
#define XA_LOAD(uu, kc) do { const int b_ = (uu) >> 7, h_ = ((uu) >> 5) & 3; \
        _Pragma("unroll") for (int i = 0; i < 2; ++i) { const int p = tid + 512 * i; \
            rk[i] = *(const v4u*)(kx + (size_t)(b_ * MEMLEN + (kc) * 32 + (p >> 5)) * DM + h_ * 256 + (p & 31) * 8); \
            rv[i] = *(const v4u*)(vxt + (size_t)(h_ * 256 + (p >> 2)) * (NBATCH * MEMLEN) + b_ * MEMLEN + (kc) * 32 + (p & 3) * 8); } } while (0)
#define XA_STORE(buf) do { LAS unsigned char* sb = lds + (buf) * XA_STAGE; \
        _Pragma("unroll") for (int i = 0; i < 2; ++i) { const int p = tid + 512 * i; \
            *(LAS v4u*)(sb + (p >> 5) * XA_KROW + (p & 31) * 16) = rk[i]; \
            LAS v2u* vp = (LAS v2u*)(sb + XA_KB + (p >> 2) * XA_VROW + (p & 3) * 16); v2u lo; lo.x = rv[i].x; lo.y = rv[i].y; v2u hi; hi.x = rv[i].z; hi.y = rv[i].w; vp[0] = lo; vp[1] = hi; } } while (0)
    XA_LOAD(u, 0); XA_STORE(0);
    int par = 0;
    bf16x8 qf[16];
#define XA_QLOAD(uu) do { const int b_ = (uu) >> 7, h_ = ((uu) >> 5) & 3, qb_ = (uu) & 31; const size_t r_ = (size_t)b_ * SEQ + qb_ * 128 + qt * 32 + l31; \
        _Pragma("unroll") for (int ks = 0; ks < 16; ++ks) qf[ks] = *(const bf16x8*)(qg + r_ * DM + h_ * 256 + 16 * ks + 8 * hh); } while (0)
    XA_QLOAD(u);
    for (;;) {
        const int b = u >> 7, h = (u >> 5) & 3, qb = u & 31;
        const size_t row0 = (size_t)b * SEQ + qb * 128 + qt * 32;
        float mx = -1e30f, ls = 0.f; f32x16 o[4];
#pragma unroll
        for (int dt = 0; dt < 4; ++dt)
#pragma unroll
            for (int r = 0; r < 16; ++r) o[dt][r] = 0.f;
        const int un = u + gridDim.x; const bool has_next = un < NU;
        for (int kc = 0; kc < 8; ++kc) {
            __syncthreads();
            const bool more = (kc < 7) || has_next;
            if (more) { if (kc < 7) XA_LOAD(u, kc + 1); else XA_LOAD(un, 0); }
            const LAS unsigned char* kb = lds + par * XA_STAGE; const LAS unsigned char* vb = kb + XA_KB;
            f32x16 s, s2;
#pragma unroll
            for (int r = 0; r < 16; ++r) { s[r] = 0.f; s2[r] = 0.f; }
#pragma unroll
            for (int ks = 0; ks < 16; ks += 2) { const bf16x8 kf = *(const LAS bf16x8*)(kb + l31 * XA_KROW + (16 * ks + 8 * hh) * 2), kf2 = *(const LAS bf16x8*)(kb + l31 * XA_KROW + (16 * ks + 16 + 8 * hh) * 2);
                s = __builtin_amdgcn_mfma_f32_32x32x16_bf16(kf, qf[ks], s, 0, 0, 0); s2 = __builtin_amdgcn_mfma_f32_32x32x16_bf16(kf2, qf[ks + 1], s2, 0, 0, 0); }
            if (kc == 7 && has_next) XA_QLOAD(un);
#pragma unroll
            for (int r = 0; r < 16; ++r) s[r] += s2[r];
            float cm = -1e30f;
#pragma unroll
            for (int r = 0; r < 16; ++r) { s[r] *= 0.0625f; cm = fmaxf(cm, s[r]); }
            cm = fmaxf(cm, shx(cm, 32, lane));
            const float mn = fmaxf(mx, cm), alpha = fexp(mx - mn); mx = mn; float rs = 0.f;
#pragma unroll
            for (int r = 0; r < 16; ++r) { s[r] = fexp(s[r] - mn); rs += s[r]; }
            rs += shx(rs, 32, lane); ls = ls * alpha + rs;
#pragma unroll
            for (int dt = 0; dt < 4; ++dt)
#pragma unroll
                for (int r = 0; r < 16; ++r) o[dt][r] *= alpha;
            bf16x8 pf[2];
#pragma unroll
            for (int st = 0; st < 2; ++st) { v4u pw; pw.x = pk2(s[8 * st], s[8 * st + 1]); pw.y = pk2(s[8 * st + 2], s[8 * st + 3]); pw.z = pk2(s[8 * st + 4], s[8 * st + 5]); pw.w = pk2(s[8 * st + 6], s[8 * st + 7]); pf[st] = __builtin_bit_cast(bf16x8, pw); }
#pragma unroll
            for (int dt = 0; dt < 4; ++dt) { const LAS unsigned char* vrow = vb + (128 * dh + 32 * dt + l31) * XA_VROW + 8 * hh;
#pragma unroll
                for (int st = 0; st < 2; ++st) { const s16x4 lo = *(const LAS s16x4*)(vrow + 32 * st), hi = *(const LAS s16x4*)(vrow + 32 * st + 16);
                    o[dt] = __builtin_amdgcn_mfma_f32_32x32x16_bf16(cat8(lo, hi), pf[st], o[dt], 0, 0, 0); } }
            if (more) XA_STORE(par ^ 1);
            par ^= 1;
        }
        const float inv = __builtin_amdgcn_rcpf(ls);
#pragma unroll
        for (int dt = 0; dt < 4; ++dt)
#pragma unroll
            for (int rg = 0; rg < 4; ++rg)
                *(unsigned*)(og + (row0 + l31) * DM + h * 256 + 128 * dh + 32 * dt + 8 * rg + 4 * hh) = pk4f8(o[dt][4 * rg] * inv, o[dt][4 * rg + 1] * inv, o[dt][4 * rg + 2] * inv, o[dt][4 * rg + 3] * inv);
        if (!has_next) break;
        u = un;
    }
    __syncthreads();
#undef XA_LOAD
#undef XA_STORE
#undef XA_QLOAD
}

__device__ __forceinline__ void phase_expert_weights(const Args& a, const Ctx& c) {
    LAS float* scr = (LAS float*)(c.lds + c.wave * 16384);
    constexpr int I_GU = 16 * 64, I_D = 16 * 32;
    constexpr int NGU = NEXP * I_GU, NIT = NEXP * (I_GU + I_D);
#define EW_GEO(it, W_, N_, k0_, n0_) const bool gu_##W_ = (it) < NGU; const int r_##W_ = gu_##W_ ? (it) : (it) - NGU; const int e_##W_ = gu_##W_ ? r_##W_ / I_GU : r_##W_ / I_D; \
        const int q_##W_ = gu_##W_ ? r_##W_ % I_GU : r_##W_ % I_D; const int N_ = gu_##W_ ? 2048 : 1024; const int nblk_##W_ = N_ / 32; const int k0_ = 64 * (q_##W_ / nblk_##W_), n0_ = 32 * (q_##W_ % nblk_##W_); \
        const float* W_ = gu_##W_ ? a.in[20] + (size_t)e_##W_ * DM * 2048 : a.in[22] + (size_t)e_##W_ * DM * DM
    int it = c.gw; if (it >= NIT) { __syncthreads(); return; }
    TItem t;
    { EW_GEO(it, W0, N0, k00, n00); titem_load(t, W0, N0, gu_W0 ? a.in[17] : nullptr, k00, n00, c.lane); }
    for (;;) {
        EW_GEO(it, Wc, Nc, k0c, n0c);
        titem_to_lds(t, scr, c.lane);
        const int itn = it + c.ngw; const bool more = itn < NIT;
        if (more) { EW_GEO(itn, Wn, Nn, k0n, n0n); titem_load(t, Wn, Nn, gu_Wn ? a.in[17] : nullptr, k0n, n0n, c.lane); }
        if (gu_Wc) titem_out8(DM, a.ws + WS_WGU, scr, k0c, n0c, c.lane, RowGU{e_Wc});
        else titem_out8(DM, a.ws + WS_WD, scr, k0c, n0c, c.lane, RowId{e_Wc * 1024});
        if (!more) break;
        it = itn;
    }
#undef EW_GEO
    __syncthreads();
}
__device__ __forceinline__ void phase_router(const Args& a, const Ctx& c) {
    const bf16* xb = (const bf16*)(a.ws + WS_XBF); const bf16* wr = (const bf16*)(a.ws + WS_WR); const float* ssq2 = (const float*)(a.ws + WS_SSQ2); const float* br = a.in[19];
    int* tope = (int*)(a.ws + WS_TOPE); float* topg = (float*)(a.ws + WS_TOPG); int* topr = (int*)(a.ws + WS_TOPR); unsigned* gcnt = (unsigned*)(a.ws + WS_GCNT);
    LAS unsigned char* lds = c.lds; const int lane = c.lane, w = c.wave, l15 = lane & 15, g = lane >> 4;
    LAS float* LG = (LAS float*)(lds + w * 4096);
    LAS int* LE = (LAS int*)(lds + w * 4096 + 2560); LAS float* LGT = (LAS float*)(lds + w * 4096 + 2816);
    int* rtok = (int*)(a.ws + WS_RTOK); float* rgate = (float*)(a.ws + WS_RGATE2); float* rrstd = (float*)(a.ws + WS_RRSTD2);
    LAS unsigned* CNT = (LAS unsigned*)(lds + 32768); LAS unsigned* BASE = CNT + 32;
    for (int it = blockIdx.x; it < NTOK / 128; it += gridDim.x) {
        const int tok0 = it * 128 + w * 16; const int half = tok0 >= HTOK;
        if (c.tid < 32) CNT[c.tid] = 0u;
        f32x4 acc[2] = {(f32x4){0.f, 0.f, 0.f, 0.f}, (f32x4){0.f, 0.f, 0.f, 0.f}};
        const bf16* ap = xb + (size_t)(tok0 + l15) * DM + 8 * g;
#pragma unroll 16
        for (int ks = 0; ks < 32; ++ks) { const bf16x8 af = *(const bf16x8*)(ap + 32 * ks);
#pragma unroll
            for (int nt = 0; nt < 2; ++nt) { const bf16x8 bf = *(const bf16x8*)(wr + (size_t)(16 * nt + l15) * DM + 32 * ks + 8 * g); acc[nt] = mfma16(af, bf, acc[nt]); } }
#pragma unroll
        for (int nt = 0; nt < 2; ++nt)
#pragma unroll
            for (int r = 0; r < 4; ++r) { const int t = 4 * g + r; const float rs = rstd16(ssq2, (size_t)(tok0 + t)); LG[t * 33 + 16 * nt + l15] = acc[nt][r] * rs + br[16 * nt + l15]; }
        LDS_WAIT();
        if (lane < 16) { float v[32];
#pragma unroll
            for (int e = 0; e < 32; ++e) v[e] = LG[lane * 33 + e];
            int se[4]; float sv[4];
#pragma unroll
            for (int k = 0; k < 4; ++k) { float best = -3e38f; int bi = 0;
#pragma unroll
                for (int e = 0; e < 32; ++e) { const bool bt = v[e] > best; best = bt ? v[e] : best; bi = bt ? e : bi; }
                se[k] = bi; sv[k] = best;
#pragma unroll
                for (int e = 0; e < 32; ++e) v[e] = (e == bi) ? -3e38f : v[e]; }
            const float e1 = fexp(sv[1] - sv[0]), e2 = fexp(sv[2] - sv[0]), e3 = fexp(sv[3] - sv[0]); const float inv = 1.f / (1.f + e1 + e2 + e3);
            const int tok = tok0 + lane;
            *(int4*)(tope + (size_t)tok * 4) = make_int4(se[0], se[1], se[2], se[3]);
            *(float4*)(topg + (size_t)tok * 4) = make_float4(inv, e1 * inv, e2 * inv, e3 * inv);
#pragma unroll
            for (int k = 0; k < 4; ++k) LE[lane * 4 + k] = se[k];
            LGT[lane * 4 + 0] = inv; LGT[lane * 4 + 1] = e1 * inv; LGT[lane * 4 + 2] = e2 * inv; LGT[lane * 4 + 3] = e3 * inv; }
        __syncthreads();
        const int myE = LE[lane];
        const unsigned lr = atomicAdd((unsigned*)&CNT[myE], 1u);
        __syncthreads();
        if (c.tid < 32) { const unsigned n = CNT[c.tid]; BASE[c.tid] = n ? atomicAdd(gcnt + (half * 32 + c.tid) * 16, n) : 0u; }
        __syncthreads();
        { const int rank = (int)(BASE[myE] + lr), tok = tok0 + (lane >> 2); topr[(size_t)tok * 4 + (lane & 3)] = rank;
          const size_t ri = (size_t)(half * 32 + myE) * HTOK + rank; rtok[ri] = tok; rgate[ri] = LGT[lane]; rrstd[ri] = rstd16(ssq2, (size_t)tok); }
        __syncthreads();
    }
}
__device__ __forceinline__ void add16(f32x4 (&v)[4], const v4u y0, const v4u y1) {
    v[0][0] += bflo(y0.x); v[0][1] += bfhi(y0.x); v[0][2] += bflo(y0.y); v[0][3] += bfhi(y0.y); v[1][0] += bflo(y0.z); v[1][1] += bfhi(y0.z); v[1][2] += bflo(y0.w); v[1][3] += bfhi(y0.w);
    v[2][0] += bflo(y1.x); v[2][1] += bfhi(y1.x); v[2][2] += bflo(y1.y); v[2][3] += bfhi(y1.y); v[3][0] += bflo(y1.z); v[3][1] += bfhi(y1.z); v[3][2] += bflo(y1.w); v[3][3] += bfhi(y1.w);
}
__device__ __forceinline__ void comb_issue(const bf16* y, const bf16* xb, const LAS unsigned* tab, int tok, const int4 ee, const int4 rr, int lane, v2u (&R)[20]) {
    const int ps[4] = {(int)tab[32 + ee.x] * 256 + rr.x, (int)tab[32 + ee.y] * 256 + rr.y, (int)tab[32 + ee.z] * 256 + rr.z, (int)tab[32 + ee.w] * 256 + rr.w};
    { const bf16* xp = xb + (size_t)tok * DM + lane * 4;
#pragma unroll
      for (int j = 0; j < 4; ++j) R[j] = *(const v2u*)(xp + j * 256); }
#pragma unroll
    for (int k = 0; k < 4; ++k) { const bf16* yp = y + (size_t)ps[k] * DM + lane * 4;
#pragma unroll
        for (int j = 0; j < 4; ++j) R[4 + 4 * k + j] = *(const v2u*)(yp + j * 256); }
}
__device__ __forceinline__ void comb_sum(f32x4 (&v)[4], const v2u (&R)[20]) {
#pragma unroll
    for (int j = 0; j < 4; ++j) v[j] = (f32x4){0.f, 0.f, 0.f, 0.f};
#pragma unroll
    for (int k = 0; k < 5; ++k)
#pragma unroll
        for (int j = 0; j < 4; ++j) { const v2u w = R[4 * k + j]; v[j][0] += bflo(w.x); v[j][1] += bfhi(w.x); v[j][2] += bflo(w.y); v[j][3] += bfhi(w.y); }
}
__device__ __forceinline__ void comb_store(float* out, const f32x4 (&gg)[4], int tok, int lane, const f32x4 (&v)[4]) {
    float s = 0.f;
#pragma unroll
    for (int j = 0; j < 4; ++j) s += (v[j][0] * v[j][0] + v[j][1] * v[j][1]) + (v[j][2] * v[j][2] + v[j][3] * v[j][3]);
    const float rstd = rsqrtf(wave_sum(s, lane) * (1.f / DM) + RMS_EPS);
    float* xr = out + (size_t)tok * DM + lane * 4;
#pragma unroll
    for (int j = 0; j < 4; ++j) *(f32x4*)(xr + j * 256) = v[j] * rstd * gg[j];
}
__device__ __forceinline__ void phase_combine(const Args& a, const Ctx& c, int hb, size_t yoff, int taboff) {
    const bf16* y = (const bf16*)(a.ws + yoff); const bf16* xb = (const bf16*)(a.ws + WS_XBF); const int* tope = (const int*)(a.ws + WS_TOPE); const int* topr = (const int*)(a.ws + WS_TOPR); const float* gf = a.in[24];
    moe_tables(a.ws, hb, c.lds, c.tid, taboff);
    const LAS unsigned* tab = (const LAS unsigned*)(c.lds + taboff);
    const int base = hb * HTOK, st = c.ngw, i0 = c.gw;
    if (i0 >= HTOK) return;
    int4 e0, r0, e1, r1; v2u R0[20], R1[20];
    f32x4 gg[4];
#pragma unroll
    for (int j = 0; j < 4; ++j) gg[j] = *(const f32x4*)(gf + j * 256 + c.lane * 4);
    e0 = *(const int4*)(tope + (size_t)(base + i0) * 4); r0 = *(const int4*)(topr + (size_t)(base + i0) * 4);
    e1 = e0; r1 = r0; if (i0 + st < HTOK) { e1 = *(const int4*)(tope + (size_t)(base + i0 + st) * 4); r1 = *(const int4*)(topr + (size_t)(base + i0 + st) * 4); }
    comb_issue(y, xb, tab, base + i0, e0, r0, c.lane, R0);
    if (i0 + st < HTOK) comb_issue(y, xb, tab, base + i0 + st, e1, r1, c.lane, R1);
    if (i0 + 2 * st < HTOK) { e0 = *(const int4*)(tope + (size_t)(base + i0 + 2 * st) * 4); r0 = *(const int4*)(topr + (size_t)(base + i0 + 2 * st) * 4); }
    if (i0 + 3 * st < HTOK) { e1 = *(const int4*)(tope + (size_t)(base + i0 + 3 * st) * 4); r1 = *(const int4*)(topr + (size_t)(base + i0 + 3 * st) * 4); }
#pragma nounroll
    for (int i = i0; i < HTOK; i += 2 * st) {
        f32x4 v[4];
        comb_sum(v, R0);
        if (i + 2 * st < HTOK) { comb_issue(y, xb, tab, base + i + 2 * st, e0, r0, c.lane, R0);
            if (i + 4 * st < HTOK) { e0 = *(const int4*)(tope + (size_t)(base + i + 4 * st) * 4); r0 = *(const int4*)(topr + (size_t)(base + i + 4 * st) * 4); } }
        comb_store(a.out, gg, base + i, c.lane, v);
        if (i + st < HTOK) {
            comb_sum(v, R1);
            if (i + 3 * st < HTOK) { comb_issue(y, xb, tab, base + i + 3 * st, e1, r1, c.lane, R1);
                if (i + 5 * st < HTOK) { e1 = *(const int4*)(tope + (size_t)(base + i + 5 * st) * 4); r1 = *(const int4*)(topr + (size_t)(base + i + 5 * st) * 4); } }
            comb_store(a.out, gg, base + i + st, c.lane, v); }
    }
}

#ifndef MK_PER_PHASE_LAUNCH
#define MK_PER_PHASE_LAUNCH 0
#endif
#if defined(MK_SPLIT_SWA)
constexpr int NPHASES = 24;
#else
constexpr int NPHASES = 21;
#endif
#ifndef MK_OFF
#define MK_OFF 0u
#endif
#define MKP(k) (((MK_OFF >> (k)) & 1u) == 0u)
#define GSCHED PG8_ALIGN, PG8_SP2
typedef const __attribute__((address_space(4))) Args* KArgP;
#if defined(__HIP_DEVICE_COMPILE__)
__device__ __forceinline__ Args ldargs() { KArgP kp = (KArgP)__builtin_amdgcn_kernarg_segment_ptr(); asm volatile("" : "+s"(kp)); Args r;
#pragma unroll
    for (int i = 0; i < 25; ++i) r.in[i] = kp->in[i];
    r.out = kp->out; r.ws = kp->ws; r.ph_lo = kp->ph_lo; r.ph_hi = kp->ph_hi; return r; }
#else
__device__ __forceinline__ Args ldargs() { return Args{}; }
#endif
__global__ void __launch_bounds__(512, 2) mk_fwd(Args a_) {
    extern __shared__ __attribute__((aligned(16))) unsigned char lds_raw[];
    Ctx c; c.lds = (LAS unsigned char*)lds_raw; c.tid = threadIdx.x; c.lane = c.tid & 63; c.wave = __builtin_amdgcn_readfirstlane(c.tid >> 6); const int wv = c.wave;
    c.G = gridDim.x; c.gw = blockIdx.x * 8 + c.wave; c.ngw = c.G * 8;
    volatile LAS unsigned* MISC = (volatile LAS unsigned*)(c.lds + MISC_OFF);
    for (int u = c.tid; u < (LDS_BYTES - RING_BYTES) / 4; u += 512) ((LAS unsigned*)(c.lds + RING_BYTES))[u] = 0u;
    __syncthreads();
    const int ph_lo = a_.ph_lo, ph_hi = a_.ph_hi;
    const bool fused = (ph_hi - ph_lo) > 1;
    unsigned* barw = (unsigned*)a_.ws + CW_BAR;
    XcdBarrier bar; bar.bar = barw; bar.x = 0; bar.st = MISC + 8; bar.t0 = wv;
    if (fused) bar = xcd_barrier_post(barw, MISC + 8, wv);
    int pc = 0;
#define PH_ON (pc >= ph_lo && pc < ph_hi)
#define PH_END do { if (PH_ON && pc + 1 < ph_hi) xcd_barrier(bar); ++pc; OPQ(c); } while (0)
    LAS unsigned char* ring = c.lds;
#define OPQ(cc) do { { unsigned z_ = 0u; asm volatile("" : "+v"(z_)); cc.lane = (int)__builtin_amdgcn_mbcnt_hi(~0u, __builtin_amdgcn_mbcnt_lo(~0u, z_)); } cc.wave = wv; cc.tid = wv * 64 + cc.lane; { int gw_ = (int)blockIdx.x * 8 + wv; asm volatile("" : "+s"(gw_)); cc.gw = gw_; } } while (0)

    if (MKP(0) && PH_ON) { const Args a = ldargs(); unsigned char* ws = a.ws; (void)ws;  phase_prologue(a, c); __syncthreads(); phase_norm1(a, c, 0); }
    PH_END;
#pragma unroll
    for (int hb = 0; hb < 2; ++hb) {
        const size_t toff = (size_t)hb * HTOK;

        if (MKP(2) && PH_ON) { const Args a = ldargs(); unsigned char* ws = a.ws; (void)ws;  pg8::Gemm g{(const bf16*)(ws + (hb ? WS_OA : WS_TM)), (const bf16*)(ws + WS_WIN), HTOK, NCOL, DM};        pg8::StaticOrder S; S.init(HTOK, NCOL, c.G, (int)blockIdx.x);
            EpiProj E{ws + WS_PROJ, (const float*)(ws + WS_LB)}; pg8::gemm_phase<EpiProj, pg8::StaticOrder, GSCHED>(ring, g, S, E, wv); }
        PH_END;
        if (MKP(3) && PH_ON) { const Args a = ldargs(); unsigned char* ws = a.ws; (void)ws;  phase_hgA(a, c); }
        PH_END;
#if defined(MK_SPLIT_SWA)
        if (MKP(4) && PH_ON) { const Args a = ldargs(); phase_swa_hgB<8>(a, c); }
        PH_END;
        if (MKP(4) && PH_ON) { const Args a = ldargs(); phase_swa_hgB<0>(a, c); }
        PH_END;
#else
        if (MKP(4) && PH_ON) { const Args a = ldargs(); phase_swa_hgB<HGB_WAVES>(a, c); }
        PH_END;
#endif
        if (MKP(5) && PH_ON) { const Args a = ldargs(); phase_hgC(a, c); }
        PH_END;
        if (MKP(6) && PH_ON) { const Args a = ldargs(); unsigned char* ws = a.ws; (void)ws;  pg8::Gemm g{(const bf16*)(ws + WS_OA), (const bf16*)(ws + WS_WA), HTOK, DM, DM}; pg8::StaticOrder S; S.init(HTOK, DM, c.G, (int)blockIdx.x);
            EpiGate<false> E{(bf16*)(ws + WS_TM), (const bf16*)(ws + WS_PROJ + PJ_GA), a.in[6]}; pg8::gemm_phase<EpiGate<false>, pg8::StaticOrder, GSCHED>(ring, g, S, E, wv); }
        if (MKP(7) && PH_ON) { const Args a = ldargs(); unsigned char* ws = a.ws; (void)ws;  pg8::Gemm g{(const bf16*)(ws + WS_OB), (const bf16*)(ws + WS_WB), HTOK, DM, DM}; pg8::StaticOrder S; S.init(HTOK, DM, c.G, (int)blockIdx.x);
            EpiGate<true> E{(bf16*)(ws + WS_TM), (const bf16*)(ws + WS_PROJ + PJ_GB), a.in[6] + DM}; pg8::gemm_phase<EpiGate<true>, pg8::StaticOrder, GSCHED>(ring, g, S, E, wv); }
        PH_END;
        if (MKP(8) && PH_ON) { const Args a = ldargs(); unsigned char* ws = a.ws; (void)ws;  pg8::Gemm g{(const bf16*)(ws + WS_TM), (const bf16*)(ws + WS_WMIX), HTOK, DM, DM}; pg8::StaticOrder S; S.init(HTOK, DM, c.G, (int)blockIdx.x);
            EpiResid<false> E{a.in[0] + toff * DM, (bf16*)(ws + WS_XBF) + toff * DM, (float*)(ws + WS_SSQ1) + toff * 16, ws + WS_X1F8 + toff * DM, 1.f}; pg8::gemm_phase<EpiResid<false>, pg8::StaticOrder, GSCHED>(ring, g, S, E, wv);
            if (hb == 0) phase_norm1(a, c, 1); }
        PH_END;
    }
    if (MKP(9) && PH_ON) { const Args a = ldargs(); unsigned char* ws = a.ws; (void)ws;
        phase_expert_weights(a, c);
        { pg8::Gemm g{(const bf16*)(ws + WS_MEMBF), (const bf16*)(ws + WS_WK), NBATCH * MEMLEN, DM, DM}; pg8::StaticOrder S; S.init(NBATCH * MEMLEN, DM, c.G, (int)blockIdx.x);
          EpiStore E{(bf16*)(ws + WS_KX), DM, nullptr, 1.f}; pg8::gemm_phase<EpiStore, pg8::StaticOrder, GSCHED>(ring, g, S, E, wv); }
        { pg8::Gemm g{(const bf16*)(ws + WS_WV), (const bf16*)(ws + WS_MEMBF), DM, NBATCH * MEMLEN, DM}; pg8::StaticOrder S; S.init(DM, NBATCH * MEMLEN, c.G, (int)((blockIdx.x + 64) % c.G));
          EpiStore E{(bf16*)(ws + WS_VXT), NBATCH * MEMLEN, nullptr, 1.f}; pg8::gemm_phase<EpiStore, pg8::StaticOrder, GSCHED>(ring, g, S, E, wv); }
        { pg8::Gemm g{(const bf16*)(ws + WS_X1F8), (const bf16*)(ws + WS_WQ), NTOK, DM, DM}; pg8::StaticOrder S; S.init(NTOK, DM, c.G, (int)blockIdx.x);
          EpiStore E{(bf16*)(ws + WS_Q), DM, (const float*)(ws + WS_SSQ1), F8_WINV}; pg8::gemm_phase8<EpiStore, pg8::StaticOrder, GSCHED>(ring, g, S, E, wv); }
    }
    PH_END;
    if (MKP(10) && PH_ON) { const Args a = ldargs(); phase_xa(a, c); }
    PH_END;
    if (MKP(11) && PH_ON) { const Args a = ldargs(); unsigned char* ws = a.ws; (void)ws;  pg8::Gemm g{(const bf16*)(ws + WS_O), (const bf16*)(ws + WS_WO), NTOK, DM, DM}; pg8::StaticOrder S; S.init(NTOK, DM, c.G, (int)blockIdx.x);
        EpiResid<true> E{nullptr, (bf16*)(ws + WS_XBF), (float*)(ws + WS_SSQ2), ws + WS_X2F8, F8_WINV}; pg8::gemm_phase8<EpiResid<true>, pg8::StaticOrder, GSCHED>(ring, g, S, E, wv); }
    PH_END;
    if (MKP(12) && PH_ON) { const Args a = ldargs(); phase_router(a, c); }
    PH_END;
#define MOE_GEMM1(hb_) do { const Args a = ldargs(); unsigned char* ws = a.ws; moe_tables(ws, (hb_), c.lds, c.tid); \
        const LAS unsigned* tab = (const LAS unsigned*)(c.lds + MOE_TAB_OFF); const int nb = (int)__builtin_amdgcn_readfirstlane(tab[64]); \
        pg8::Gemm g{(const bf16*)(ws + WS_X2F8), (const bf16*)(ws + WS_WGU), NTOK, NEXP * 2048, DM}; GroupedOrder S{nb * 8, 8, c.G, (int)blockIdx.x, (hb_), tab, (const int*)(ws + WS_RTOK)}; \
        EpiSwiglu E{ws + WS_ACT + (size_t)(hb_) * ACT_HALF, a.in[21], (const float*)(ws + WS_RRSTD2)}; pg8::gemm_phase_gather8<EpiSwiglu, GroupedOrder>(ring, g, S, E, wv); } while (0)
#define MOE_GEMM2(hb_, yoff_, i0_, i1_) do { const Args a = ldargs(); unsigned char* ws = a.ws; moe_tables(ws, (hb_), c.lds, c.tid); \
        const LAS unsigned* tab = (const LAS unsigned*)(c.lds + MOE_TAB_OFF); const int nb = (int)__builtin_amdgcn_readfirstlane(tab[64]); \
        pg8::Gemm g{(const bf16*)(ws + WS_ACT + (size_t)(hb_) * ACT_HALF), (const bf16*)(ws + WS_WD), CAPH, NEXP * 1024, DM}; GroupedOrder S{nb * 4, 4, c.G, (int)blockIdx.x, (hb_), tab, (const int*)(ws + WS_RTOK), (i0_), (i1_)}; \
        EpiDown E{(bf16*)(ws + (yoff_)), a.in[23], (const float*)(ws + WS_RGATE2)}; pg8::gemm_phase8<EpiDown, GroupedOrder, GSCHED>(ring, g, S, E, wv); } while (0)
    if (MKP(14) && PH_ON) { MOE_GEMM1(0); }
    PH_END;
    if (MKP(15) && PH_ON) { MOE_GEMM2(0, WS_Y, 0, 0x7fffffff); MOE_GEMM1(1); }
    PH_END;
    if (MKP(15) && PH_ON) { int kq = ((int)blockIdx.x >> 3) % 9; asm volatile("" : "+s"(kq));
#pragma nounroll
        for (int part = 0; part < 2; ++part) { MOE_GEMM2(1, WS_Y1, part ? kq : 0, part ? 0x7fffffff : kq); OPQ(c);
            if (part == 0) { const Args a = ldargs(); phase_combine(a, c, 0, WS_Y, MOE_TAB_OFF + 512); OPQ(c); } } }
    PH_END;
    if (MKP(16) && PH_ON) { const Args a = ldargs(); phase_combine(a, c, 1, WS_Y1, MOE_TAB_OFF); }
    PH_END;
#undef MOE_GEMM1
#undef MOE_GEMM2
#undef PH_ON
#undef PH_END
}

#if defined(MK_DBG_STOP)
#ifndef MK_DBG_SRC_OUT
#define MK_DBG_SRC_OUT 0
#endif
#ifndef MK_DBG_F32
#define MK_DBG_F32 0
#endif
__global__ void dbg_dump(const unsigned short* src, float* out, size_t n, size_t N) {
    for (size_t i = (size_t)blockIdx.x * blockDim.x + threadIdx.x; i < N; i += (size_t)gridDim.x * blockDim.x) {
        if (i < n) { float v = MK_DBG_F32 ? ((const float*)src)[i] : __builtin_bit_cast(float, (unsigned)src[i] << 16); if (!(fabsf(v) < 1e30f)) v = 12345.f; out[i] = v; }
        else if (!MK_DBG_SRC_OUT) out[i] = 0.f;
    }
}
__global__ void dbg_zero_upper(float* out, size_t n0, size_t N) { for (size_t i = n0 + (size_t)blockIdx.x * blockDim.x + threadIdx.x; i < N; i += (size_t)gridDim.x * blockDim.x) out[i] = 0.f; }
#endif
#if defined(MK_REP_THRASH)
__global__ void dbg_thrash(const f32x4* a, size_t na, const f32x4* b, size_t nb, float* sink) {
    f32x4 acc = (f32x4){0.f, 0.f, 0.f, 0.f};
    for (size_t i = (size_t)blockIdx.x * blockDim.x + threadIdx.x; i < na; i += (size_t)gridDim.x * blockDim.x) acc += a[i];
    for (size_t i = (size_t)blockIdx.x * blockDim.x + threadIdx.x; i < nb; i += (size_t)gridDim.x * blockDim.x) acc += b[i];
    if (acc[0] + acc[1] + acc[2] + acc[3] == 12345.678f) sink[0] = 1.f;
}
#endif
extern "C" void kernel_launch(void* const* d_in, const int* in_sizes, int n_in, void* d_out, int out_size, void* d_ws, size_t ws_size, hipStream_t stream) {
    static int grid = 0;
    if (grid == 0) {
        if (n_in != 25 || out_size != NTOK * DM || ws_size < WS_END) { fprintf(stderr, "kernel_launch: unexpected problem shape (n_in %d, out %d, ws %zu); nothing launched\n", n_in, out_size, ws_size); grid = -1; return; }
        int dev = 0, cus = 0, per_cu = 0;
        if (hipGetDevice(&dev) != hipSuccess || hipDeviceGetAttribute(&cus, hipDeviceAttributeMultiprocessorCount, dev) != hipSuccess) { grid = -1; return; }
        if (hipFuncSetAttribute((const void*)mk_fwd, hipFuncAttributeMaxDynamicSharedMemorySize, LDS_BYTES) != hipSuccess) { fprintf(stderr, "kernel_launch: hipFuncSetAttribute failed\n"); grid = -1; return; }
        if (hipOccupancyMaxActiveBlocksPerMultiprocessor(&per_cu, (const void*)mk_fwd, 512, LDS_BYTES) != hipSuccess || per_cu < 1) { fprintf(stderr, "kernel_launch: occupancy query reports %d blocks per CU\n", per_cu); }
        (void)hipGetLastError();
        grid = cus;
    }
    if (grid < 0) return;
    (void)in_sizes;
    hipMemsetAsync(d_ws, 0, WS_ZERO_BYTES, stream);
    Args a{};
    for (int i = 0; i < 25; ++i) a.in[i] = (const float*)d_in[i];
    a.out = (float*)d_out; a.ws = (unsigned char*)d_ws;
#if defined(MK_DBG_STOP)
    for (int p = 0; p < MK_DBG_STOP; ++p) { a.ph_lo = p; a.ph_hi = p + 1; hipLaunchKernelGGL(mk_fwd, dim3(grid), dim3(512), LDS_BYTES, stream, a); }
    hipLaunchKernelGGL(dbg_dump, dim3(2048), dim3(256), 0, stream, (const unsigned short*)((const unsigned char*)(MK_DBG_SRC_OUT ? d_out : d_ws) + (size_t)MK_DBG_OFF_MIB * MiB), (float*)d_out, (size_t)MK_DBG_MIB * MiB / (MK_DBG_F32 ? 4 : 2), (size_t)NTOK * DM);
    if (MK_DBG_SRC_OUT) hipLaunchKernelGGL(dbg_zero_upper, dim3(2048), dim3(256), 0, stream, (float*)d_out, (size_t)MK_DBG_MIB * MiB / 2, (size_t)NTOK * DM);
#elif MK_PER_PHASE_LAUNCH
#if defined(MK_REP_THRASH) && defined(MK_REP_PC)
    if (MK_REP_PC < 0) for (int r = 0; r < MK_REP_N; ++r) hipLaunchKernelGGL(dbg_thrash, dim3(2048), dim3(256), 0, stream, (const f32x4*)d_in[20], (size_t)NEXP * DM * 2048 / 4, (const f32x4*)d_in[22], (size_t)NEXP * DM * DM / 4, (float*)((char*)d_ws + WS_LB + 8192));
#endif
    for (int p = 0; p < NPHASES; ++p) { a.ph_lo = p; a.ph_hi = p + 1; hipLaunchKernelGGL(mk_fwd, dim3(grid), dim3(512), LDS_BYTES, stream, a);
#if defined(MK_REP_PC)
        if (p == MK_REP_PC) for (int r = 0; r < MK_REP_N; ++r) {
#if defined(MK_REP_THRASH)
            hipLaunchKernelGGL(dbg_thrash, dim3(2048), dim3(256), 0, stream, (const f32x4*)d_in[20], (size_t)NEXP * DM * 2048 / 4, (const f32x4*)d_in[22], (size_t)NEXP * DM * DM / 4, (float*)((char*)d_ws + WS_LB + 8192));
#endif
 if (p == 22 && false) (void)hipMemsetAsync((char*)d_ws + WS_GCNT, 0, 4096, stream); hipLaunchKernelGGL(mk_fwd, dim3(grid), dim3(512), LDS_BYTES, stream, a); }
#endif
    }
#else
    a.ph_lo = 0; a.ph_hi = NPHASES;
    hipLaunchKernelGGL(mk_fwd, dim3(grid), dim3(512), LDS_BYTES, stream, a);
#endif
}
```
